# Optimizing an MI355X kernel written in HIP

```python
import jax, jax.numpy as jnp
from jax import lax
import numpy as np

D_MODEL = 1024
BATCH = 8
SEQ = 2048
DEPTH = 1
DEC_BATCH = 128
DEC_SEQ = 1
PAST_LEN = 16384
PAGE_SIZE = 128

H_R = 4
DK_R = 128
DV_R = 256
H_G = 8
DK_G = 128
DV_G = 128
D_FF = 4 * D_MODEL
D_PLE = 256
CHUNK = 64
ROPE_BASE = 10000.0
EPS = 1e-6
QK_R = H_R * DK_R
V_R = H_R * DV_R
F_G = H_G * DK_G
V_G = H_G * DV_G
IN_SPLITS = (QK_R, QK_R, V_R, V_R, F_G, F_G, V_G, V_G, D_MODEL, D_MODEL)
D_IN = 2 * QK_R + 2 * V_R + 2 * F_G + 2 * V_G + 2 * D_MODEL

kernel_name = "retnet_hgrn2_gated_parallel_decoder_step"

F32 = jnp.float32


def rms_norm(x, g):
    xf = x.astype(F32)
    y = xf * lax.rsqrt(jnp.mean(xf * xf, axis=-1, keepdims=True) + EPS)
    return (y * g.astype(F32)).astype(x.dtype)


def head_norm_gate(o, gain, gate):
    B, T, H, Dv = o.shape
    o = o * lax.rsqrt(jnp.mean(o * o, axis=-1, keepdims=True) + EPS)
    return o.reshape(B, T, H * Dv) * gain.astype(F32) * jax.nn.silu(gate.astype(F32))


def rotary(x, pos):
    half = x.shape[-1] // 2
    inv = ROPE_BASE ** (-jnp.arange(half, dtype=F32) / half)
    ang = pos[:, None] * inv[None, :]
    cos = jnp.cos(ang)[None, :, None, :]
    sin = jnp.sin(ang)[None, :, None, :]
    x1, x2 = x[..., :half], x[..., half:]
    return jnp.concatenate([x1 * cos - x2 * sin, x1 * sin + x2 * cos], axis=-1)


def chunk_len(T):
    return CHUNK if T % CHUNK == 0 else T


def to_chunks(x, C):
    B, T, H, D = x.shape
    return x.reshape(B, T // C, C, H, D).transpose(1, 0, 3, 2, 4)


def from_chunks(o):
    n, B, H, C, D = o.shape
    return o.transpose(1, 0, 3, 2, 4).reshape(B, n * C, H, D)


def retention_chunked(q, k, v, log_gamma, S0):
    T = q.shape[1]
    C = chunk_len(T)
    idx = jnp.arange(C, dtype=F32)
    rel = idx[:, None] - idx[None, :]
    lg = log_gamma[:, None, None]
    decay_mask = jnp.where(rel >= 0, jnp.exp(lg * jnp.maximum(rel, 0.0)), 0.0)
    q_decay = jnp.exp(log_gamma[:, None] * (idx + 1.0))[None, :, :, None]
    k_decay = jnp.exp(log_gamma[:, None] * (C - 1.0 - idx))[None, :, :, None]
    chunk_decay = jnp.exp(log_gamma * C)[None, :, None, None]

    def step(S, inp):
        qb, kb, vb = inp
        scores = jnp.einsum('bhtk,bhsk->bhts', qb, kb) * decay_mask[None]
        o = jnp.einsum('bhts,bhsv->bhtv', scores, vb) + jnp.einsum('bhtk,bhkv->bhtv', qb * q_decay, S)
        S = chunk_decay * S + jnp.einsum('bhsk,bhsv->bhkv', kb * k_decay, vb)
        return S, o

    S, o = lax.scan(step, S0, (to_chunks(q, C), to_chunks(k, C), to_chunks(v, C)))
    return from_chunks(o), S


def gla_chunked(q, k, v, log_f, S0):
    T = q.shape[1]
    C = chunk_len(T)
    ar = jnp.arange(C)
    causal = (ar[:, None] >= ar[None, :])[None, None, :, :, None]

    def step(S, inp):
        qb, kb, vb, lfb = inp
        b = jnp.cumsum(lfb, axis=2)
        diff = b[:, :, :, None, :] - b[:, :, None, :, :]
        dec = jnp.where(causal, jnp.exp(jnp.minimum(diff, 0.0)), 0.0)
        A = jnp.einsum('bhtk,bhsk,bhtsk->bhts', qb, kb, dec)
        o = jnp.einsum('bhts,bhsv->bhtv', A, vb) + jnp.einsum('bhtk,bhkv->bhtv', qb * jnp.exp(b), S)
        b_last = b[:, :, -1:, :]
        S = jnp.exp(b_last[:, :, 0, :])[..., None] * S + jnp.einsum('bhsk,bhsv->bhkv', kb * jnp.exp(b_last - b), vb)
        return S, o

    S, o = lax.scan(step, S0, (to_chunks(q, C), to_chunks(k, C), to_chunks(v, C), to_chunks(log_f, C)))
    return from_chunks(o), S


def layer_step(r, p_l, s_ret0, s_hg0, pos, lb, norm_mix_g, w_in, ret_norm_g, hg_norm_g,
               w_up_ret, w_up_hg, w_o, norm_mlp_g, w_ff1, w_ff2, norm_ple_g, w_ple_gate, w_ple_proj):
    B, T, _ = r.shape
    h = rms_norm(r, norm_mix_g)
    z = h @ w_in
    split_at = [int(i) for i in np.cumsum(IN_SPLITS)[:-1]]
    rq, rk, rv, rg, gq, gf, gi, gg, a_ret, a_hg = jnp.split(z, split_at, axis=-1)

    log_gamma = jnp.log(1.0 - 2.0 ** (-5.0 - jnp.arange(H_R, dtype=F32)))
    q_r = rotary(rq.astype(F32).reshape(B, T, H_R, DK_R), pos)
    k_r = rotary(rk.astype(F32).reshape(B, T, H_R, DK_R), pos) * (DK_R ** -0.5)
    v_r = rv.astype(F32).reshape(B, T, H_R, DV_R)
    o_r, s_ret = retention_chunked(q_r, k_r, v_r, log_gamma, s_ret0.astype(F32))
    u_r = head_norm_gate(o_r, ret_norm_g, rg).astype(r.dtype) @ w_up_ret

    gf32 = gf.astype(F32)
    log_f = jnp.logaddexp(jnp.log(lb), jnp.log1p(-lb) + jax.nn.log_sigmoid(gf32))
    k_g = (1.0 - jnp.exp(log_f)).reshape(B, T, H_G, DK_G)
    q_g = jax.nn.silu(gq.astype(F32)).reshape(B, T, H_G, DK_G)
    v_g = gi.astype(F32).reshape(B, T, H_G, DV_G)
    o_g, s_hg = gla_chunked(q_g, k_g, v_g, log_f.reshape(B, T, H_G, DK_G), s_hg0.astype(F32))
    u_g = head_norm_gate(o_g, hg_norm_g, gg).astype(r.dtype) @ w_up_hg

    m = jax.nn.sigmoid(a_ret) * u_r + jax.nn.sigmoid(a_hg) * u_g
    r = r + m @ w_o

    hm = rms_norm(r, norm_mlp_g)
    r = r + jnp.square(jax.nn.relu(hm @ w_ff1)) @ w_ff2

    hp = rms_norm(r, norm_ple_g)
    r = r + jax.nn.sigmoid(hp @ w_ple_gate) * (p_l @ w_ple_proj)
    return r, s_ret, s_hg


def setup_inputs(seed: int = 0) -> dict:
    key = jax.random.key(seed)
    ks = jax.random.split(key, 24)
    n = lambda k, s, sc: jax.random.normal(k, s, F32) * sc
    gain = lambda k, s: 1.0 + 0.02 * jax.random.normal(k, s, F32)
    return {
        "x_prompt": n(ks[0], (BATCH, SEQ, D_MODEL), 1.0),
        "x_sample": n(ks[1], (DEC_BATCH, DEC_SEQ, D_MODEL), 1.0),
        "state_ret": n(ks[2], (DEPTH, DEC_BATCH, H_R, DK_R, DV_R), 0.5),
        "state_hgrn": n(ks[3], (DEPTH, DEC_BATCH, H_G, DK_G, DV_G), 0.5),
        "p_prompt": n(ks[4], (DEPTH, BATCH, SEQ, D_PLE), 1.0),
        "p_sample": n(ks[5], (DEPTH, DEC_BATCH, DEC_SEQ, D_PLE), 1.0),
        "norm_mix_g": gain(ks[6], (DEPTH, D_MODEL)),
        "w_in": n(ks[7], (DEPTH, D_MODEL, D_IN), D_MODEL ** -0.5),
        "ret_norm_g": gain(ks[8], (DEPTH, V_R)),
        "hg_norm_g": gain(ks[9], (DEPTH, V_G)),
        "hg_lb": n(ks[10], (DEPTH + 1, F_G), 0.1),
        "w_up_ret": n(ks[11], (DEPTH, V_R, D_MODEL), V_R ** -0.5),
        "w_up_hg": n(ks[12], (DEPTH, V_G, D_MODEL), V_G ** -0.5),
        "w_o": n(ks[13], (DEPTH, D_MODEL, D_MODEL), D_MODEL ** -0.5),
        "norm_mlp_g": gain(ks[14], (DEPTH, D_MODEL)),
        "w_ff1": n(ks[15], (DEPTH, D_MODEL, D_FF), D_MODEL ** -0.5),
        "w_ff2": n(ks[16], (DEPTH, D_FF, D_MODEL), D_FF ** -0.5),
        "norm_ple_g": gain(ks[17], (DEPTH, D_MODEL)),
        "w_ple_gate": n(ks[18], (DEPTH, D_MODEL, D_MODEL), D_MODEL ** -0.5),
        "w_ple_proj": n(ks[19], (DEPTH, D_PLE, D_MODEL), D_PLE ** -0.5),
        "norm_final_g": gain(ks[20], (D_MODEL,)),
    }


def reference(x_prompt, x_sample, state_ret, state_hgrn, p_prompt, p_sample, norm_mix_g, w_in,
              ret_norm_g, hg_norm_g, hg_lb, w_up_ret, w_up_hg, w_o, norm_mlp_g, w_ff1, w_ff2,
              norm_ple_g, w_ple_gate, w_ple_proj, norm_final_g):
    B, T = x_prompt.shape[0], x_prompt.shape[1]
    Td = x_sample.shape[1]
    pos_p = jnp.arange(T, dtype=F32)
    pos_s = PAST_LEN + jnp.arange(Td, dtype=F32)
    lb_all = jnp.cumsum(jax.nn.softmax(hg_lb.astype(F32), axis=0), axis=0)
    rp, rs = x_prompt, x_sample
    ret_p, hg_p, ret_s, hg_s = [], [], [], []
    for l in range(DEPTH):
        wl = (norm_mix_g[l], w_in[l], ret_norm_g[l], hg_norm_g[l], w_up_ret[l], w_up_hg[l], w_o[l],
              norm_mlp_g[l], w_ff1[l], w_ff2[l], norm_ple_g[l], w_ple_gate[l], w_ple_proj[l])
        zr = jnp.zeros((B, H_R, DK_R, DV_R), F32)
        zg = jnp.zeros((B, H_G, DK_G, DV_G), F32)
        rp, sr_p, sg_p = layer_step(rp, p_prompt[l], zr, zg, pos_p, lb_all[l], *wl)
        rs, sr_s, sg_s = layer_step(rs, p_sample[l], state_ret[l], state_hgrn[l], pos_s, lb_all[l], *wl)
        ret_p.append(sr_p.astype(state_ret.dtype))
        hg_p.append(sg_p.astype(state_hgrn.dtype))
        ret_s.append(sr_s.astype(state_ret.dtype))
        hg_s.append(sg_s.astype(state_hgrn.dtype))
    y_prompt = rms_norm(rp, norm_final_g)
    y_sample = rms_norm(rs, norm_final_g)
    return (y_prompt, y_sample, jnp.stack(ret_p), jnp.stack(hg_p), jnp.stack(ret_s), jnp.stack(hg_s))
```

```cpp
#include <hip/hip_runtime.h>
#include <cstdio>
#include <cstdint>
namespace pg8 {
#define PG8_LAS __attribute__((address_space(3)))
typedef unsigned short bf16_t;
typedef short bf16x8 __attribute__((ext_vector_type(8)));
typedef float f32x4 __attribute__((ext_vector_type(4)));
typedef unsigned u32x4 __attribute__((ext_vector_type(4)));
constexpr int BM = 256, BK = 64, HALF = 128, HTB = HALF * BK * 2  , STAGE_BYTES = 8 * HTB, NXCD = 8, WGM = 8;

__host__ __device__ __forceinline__ int lds_byte(int r, int c) { const int st = (r >> 4) * 2 + (c >> 5), rr = r & 15, cc = c & 31, ob = rr * 64 + cc * 2; return st * 1024 + (ob ^ (((ob >> 9) & 1) << 5)); }
__host__ __device__ __forceinline__ void stage_rc(int b, int& R, int& C) { const int st = b / 1024, sb = b % 1024, swz = sb ^ (((sb >> 9) & 1) << 5); R = (st >> 1) * 16 + swz / 64; C = (st & 1) * 32 + (swz % 64) / 2; }
__host__ __device__ __forceinline__ int perm32(int rho) { const int n = rho >> 4, i = rho & 15; return 8 * (i >> 2) + 4 * n + (i & 3); }

struct Unit { int pm, pn; };
struct Gemm { const bf16_t* A; const bf16_t* Bt; int M, N, K; };

struct StaticOrder {
    int nM, nN, nwg, G, c;
    __host__ __device__ void init(int M, int N, int G_, int c_) { nM = M / BM; nN = N / BM; nwg = nM * nN; G = G_; c = c_; }
    __host__ __device__ bool next(int i, Unit& u) const {
        const long L = (long)i * G + c; if (L >= nwg) return false;
        int wgid = (int)L; { const int q = nwg / NXCD, r = nwg % NXCD, xcd = wgid % NXCD, off = wgid / NXCD; wgid = (xcd < r ? xcd * (q + 1) : r * (q + 1) + (xcd - r) * q) + off; }
        const int nig = WGM * nN, gid = wgid / nig, fm = gid * WGM, gsz = (nM - fm) < WGM ? (nM - fm) : WGM;
        u.pm = fm + ((wgid % nig) % gsz); u.pn = (wgid % nig) / gsz; return true;
    }
    __device__ __forceinline__ void a_ready(const Unit&) const {}
    __device__ __forceinline__ void done(const Unit&) const {}
};

__device__ __forceinline__ unsigned cvt_pk_bf16(float lo, float hi) { unsigned r; asm volatile("v_cvt_pk_bf16_f32 %0, %1, %2" : "=v"(r) : "v"(lo), "v"(hi)); return r; }

template <class Epi, class Sched, bool ALIGN_EPI = false, bool SP2 = false>
__device__ __forceinline__ void gemm_phase(PG8_LAS unsigned char* lds, const Gemm g, const Sched& S, const Epi& E) {
    const int tid = threadIdx.x, wid = __builtin_amdgcn_readfirstlane(tid >> 6), lane = tid & 63, wr = wid >> 2, wc = wid & 3, fr = lane & 15, fq = lane >> 4;
    const int K = g.K, nt = K / BK;
    unsigned voffA[2], voffB[2];
#pragma unroll
    for (int i = 0; i < 2; ++i) { int R, C; stage_rc(tid * 16 + i * 8192, R, C); const int Rb = Epi::PERM ? ((R & ~31) + perm32(R & 31)) : R;
        voffA[i] = (unsigned)(R * K + C) * 2u; voffB[i] = (unsigned)(Rb * K + C) * 2u; }
    const size_t kstep = (size_t)(BK * 2);
    const size_t hstep = (size_t)HALF * K * 2;
    const size_t tstep = 2 * hstep;
    const unsigned ldsw = (unsigned)wid * 1024u;
    const int aoff = lds_byte(wr * 64 + fr, fq * 8), boff = lds_byte(wc * 32 + fr, fq * 8);
#define PG8_SA(b, h) (((b) * 2 + (h)) * HTB)
#define PG8_SB(b, h) ((4 + (b) * 2 + (h)) * HTB)
#define PG8_STAGE(bufoff, gbase, voff) do { _Pragma("unroll") for (int _i = 0; _i < 2; ++_i) \
        __builtin_amdgcn_global_load_lds((const unsigned*)((const char*)(gbase) + (voff)[_i]), (PG8_LAS unsigned*)(lds + (bufoff) + ldsw + _i * 8192), 16, 0, 0); } while (0)
#define PG8_LDA(dst, b, h) do { _Pragma("unroll") for (int m = 0; m < 4; ++m) _Pragma("unroll") for (int k = 0; k < 2; ++k) dst[m][k] = *(const PG8_LAS bf16x8*)(lds + PG8_SA(b, h) + aoff + m * 2048 + k * 1024); } while (0)
#define PG8_LDB(dst, b, h) do { _Pragma("unroll") for (int n = 0; n < 2; ++n) _Pragma("unroll") for (int k = 0; k < 2; ++k) dst[n][k] = *(const PG8_LAS bf16x8*)(lds + PG8_SB(b, h) + boff + n * 2048 + k * 1024); } while (0)
#define PG8_MMA(ai, bj, At, Bt) do { __builtin_amdgcn_s_setprio(1); _Pragma("unroll") for (int m = 0; m < 4; ++m) _Pragma("unroll") for (int n = 0; n < 2; ++n) _Pragma("unroll") for (int k = 0; k < 2; ++k) \
        acc[ai][bj][m][n] = __builtin_amdgcn_mfma_f32_16x16x32_bf16(Bt[n][k], At[m][k], acc[ai][bj][m][n], 0, 0, 0); __builtin_amdgcn_s_setprio(0); } while (0)
#define PG8_WAIT_V(n) asm volatile("s_waitcnt vmcnt(" #n ")" ::: "memory")
#define PG8_WAIT_L(n) asm volatile("s_waitcnt lgkmcnt(" #n ")" ::: "memory")
#define PG8_BAR __builtin_amdgcn_s_barrier()
#define PG8_SCHED __builtin_amdgcn_sched_barrier(0)
    Unit cur, nxt; int ui = 0;
    if (!S.next(0, cur)) return;
    f32x4 acc[2][2][4][2];
#pragma unroll
    for (int a = 0; a < 2; ++a)
#pragma unroll
        for (int b = 0; b < 2; ++b)
#pragma unroll
            for (int m = 0; m < 4; ++m)
#pragma unroll
                for (int n = 0; n < 2; ++n) acc[a][b][m][n] = (f32x4){0.f, 0.f, 0.f, 0.f};
    bf16x8 At[4][2], B0[2][2], B1[2][2];
    const char* cA = (const char*)g.A + (size_t)cur.pm * tstep; const char* cB = (const char*)g.Bt + (size_t)cur.pn * tstep;
    S.a_ready(cur);
    if constexpr (SP2) {
        PG8_STAGE(PG8_SB(0, 0), cB, voffB); PG8_STAGE(PG8_SB(0, 1), cB + hstep, voffB); PG8_STAGE(PG8_SA(0, 0), cA, voffA); PG8_STAGE(PG8_SA(0, 1), cA + hstep, voffA);
        if (wr == 1) PG8_BAR;
        PG8_WAIT_V(2); PG8_BAR;
        PG8_STAGE(PG8_SB(1, 0), cB + kstep, voffB); PG8_STAGE(PG8_SA(1, 0), cA + kstep, voffA); PG8_STAGE(PG8_SB(1, 1), cB + hstep + kstep, voffB);
        PG8_WAIT_V(6); PG8_BAR;
    } else {
        PG8_STAGE(PG8_SB(0, 0), cB, voffB); PG8_STAGE(PG8_SA(0, 0), cA, voffA); PG8_STAGE(PG8_SB(0, 1), cB + hstep, voffB); PG8_STAGE(PG8_SA(0, 1), cA + hstep, voffA);
        if (wr == 1) PG8_BAR;
        PG8_WAIT_V(4); PG8_BAR;
        PG8_STAGE(PG8_SB(1, 0), cB + kstep, voffB); PG8_STAGE(PG8_SA(1, 0), cA + kstep, voffA); PG8_STAGE(PG8_SB(1, 1), cB + hstep + kstep, voffB);
        PG8_WAIT_V(6); PG8_BAR;
    }
    for (;;) {
        const bool has_next = S.next(ui + 1, nxt);
        const char* nA = has_next ? (const char*)g.A + (size_t)nxt.pm * tstep : cA; const char* nB = has_next ? (const char*)g.Bt + (size_t)nxt.pn * tstep : cB;
        for (int t = 0; t < nt; t += 2) {
            const bool last = (t == nt - 2);
            const char* a1 = cA + (size_t)(t + 1) * kstep;
            const char* a2 = last ? nA : cA + (size_t)(t + 2) * kstep; const char* b2 = last ? nB : cB + (size_t)(t + 2) * kstep;
            const char* a3 = a2 + kstep; const char* b3 = b2 + kstep;
            if (last && has_next) S.a_ready(nxt);
            if constexpr (SP2) {
            PG8_LDB(B0, 0, 0); PG8_LDB(B1, 0, 1); PG8_SCHED; PG8_LDA(At, 0, 0); PG8_STAGE(PG8_SA(1, 1), a1 + hstep, voffA);
            PG8_WAIT_V(8); PG8_WAIT_L(0); PG8_BAR; PG8_MMA(0, 0, At, B0); PG8_MMA(0, 1, At, B1); PG8_BAR; PG8_SCHED;
            PG8_LDA(At, 0, 1); PG8_STAGE(PG8_SB(0, 0), b2, voffB); PG8_STAGE(PG8_SB(0, 1), b2 + hstep, voffB); PG8_STAGE(PG8_SA(0, 0), a2, voffA);
            PG8_WAIT_V(8); PG8_WAIT_L(0); PG8_BAR; PG8_MMA(1, 0, At, B0); PG8_MMA(1, 1, At, B1); PG8_BAR; PG8_SCHED;
            PG8_LDB(B0, 1, 0); PG8_LDB(B1, 1, 1); PG8_SCHED; PG8_LDA(At, 1, 0); PG8_STAGE(PG8_SA(0, 1), a2 + hstep, voffA);
            PG8_WAIT_V(8); PG8_WAIT_L(0); PG8_BAR; PG8_MMA(0, 0, At, B0); PG8_MMA(0, 1, At, B1); PG8_BAR; PG8_SCHED;
            PG8_LDA(At, 1, 1); PG8_STAGE(PG8_SB(1, 0), b3, voffB); PG8_STAGE(PG8_SB(1, 1), b3 + hstep, voffB); PG8_STAGE(PG8_SA(1, 0), a3, voffA);
            PG8_WAIT_V(8); PG8_WAIT_L(0); PG8_BAR; PG8_MMA(1, 0, At, B0); PG8_MMA(1, 1, At, B1); PG8_BAR; PG8_SCHED;
            } else {
            PG8_LDB(B0, 0, 0); PG8_SCHED; PG8_LDA(At, 0, 0); PG8_STAGE(PG8_SA(1, 1), a1 + hstep, voffA);
            PG8_WAIT_L(8); PG8_BAR; PG8_WAIT_L(0); PG8_MMA(0, 0, At, B0); PG8_BAR; PG8_SCHED;
            PG8_LDB(B1, 0, 1); PG8_STAGE(PG8_SB(0, 0), b2, voffB);
            PG8_BAR; PG8_WAIT_L(0); PG8_MMA(0, 1, At, B1); PG8_BAR;
            PG8_LDA(At, 0, 1); PG8_STAGE(PG8_SA(0, 0), a2, voffA);
            PG8_BAR; PG8_WAIT_L(0); PG8_MMA(1, 0, At, B0); PG8_BAR; PG8_SCHED;
            PG8_STAGE(PG8_SB(0, 1), b2 + hstep, voffB);
            PG8_WAIT_V(6); PG8_BAR; PG8_MMA(1, 1, At, B1); PG8_BAR;
            PG8_LDB(B0, 1, 0); PG8_SCHED; PG8_LDA(At, 1, 0); PG8_STAGE(PG8_SA(0, 1), a2 + hstep, voffA);
            PG8_WAIT_L(8); PG8_BAR; PG8_WAIT_L(0); PG8_MMA(0, 0, At, B0); PG8_BAR; PG8_SCHED;
            PG8_LDB(B1, 1, 1); PG8_STAGE(PG8_SB(1, 0), b3, voffB);
            PG8_BAR; PG8_WAIT_L(0); PG8_MMA(0, 1, At, B1); PG8_BAR;
            PG8_LDA(At, 1, 1); PG8_STAGE(PG8_SA(1, 0), a3, voffA);
            PG8_BAR; PG8_WAIT_L(0); PG8_MMA(1, 0, At, B0); PG8_BAR; PG8_SCHED;
            PG8_STAGE(PG8_SB(1, 1), b3 + hstep, voffB);
            PG8_WAIT_V(6); PG8_BAR; PG8_MMA(1, 1, At, B1); PG8_BAR;
            }
        }
        if constexpr (ALIGN_EPI) { if (wr == 0) PG8_BAR; }
        if constexpr (!Epi::AFTER_DRAIN) { E(acc, cur, wr, wc, fr, fq); S.done(cur); }
        if (!has_next) break;
#pragma unroll
        for (int a = 0; a < 2; ++a)
#pragma unroll
            for (int b = 0; b < 2; ++b)
#pragma unroll
                for (int m = 0; m < 4; ++m)
#pragma unroll
                    for (int n = 0; n < 2; ++n) acc[a][b][m][n] = (f32x4){0.f, 0.f, 0.f, 0.f};
        cur = nxt; cA = nA; cB = nB; ++ui;
        if constexpr (ALIGN_EPI) { if (wr == 1) PG8_BAR; }
    }
    PG8_WAIT_V(0);
    if constexpr (!ALIGN_EPI) { if (wr == 0) PG8_BAR; }
    PG8_BAR;
    if constexpr (Epi::AFTER_DRAIN) { E.fused(acc, cur, wr, wc, fr, fq, lds, wid, lane); S.done(cur); }
#undef PG8_SA
#undef PG8_SB
#undef PG8_STAGE
#undef PG8_LDA
#undef PG8_LDB
#undef PG8_MMA
#undef PG8_WAIT_V
#undef PG8_WAIT_L
#undef PG8_BAR
#undef PG8_SCHED
}
}


constexpr int DM = 1024, NB = 8, SEQ = 2048, NDEC = 128, MPROMPT = NB * SEQ, MTOT = MPROMPT + NDEC, MP = 16640  ;
constexpr int HR = 4, DKR = 128, DVR = 256, HG = 8, DKG = 128, DVG = 128, DFF = 4096, DPLE = 256, DIN = 9216, CH = 64, NCHUNK = MPROMPT / CH;
constexpr float EPS = 1e-6f;
constexpr size_t OFF_Y = 0, OFF_RETP = (size_t)MTOT * DM, OFF_HGP = OFF_RETP + (size_t)NB * HR * DKR * DVR, OFF_RETS = OFF_HGP + (size_t)NB * HG * DKG * DVG,
                 OFF_HGS = OFF_RETS + (size_t)NDEC * HR * DKR * DVR, OUT_TOTAL = OFF_HGS + (size_t)NDEC * HG * DKG * DVG;
static_assert(OUT_TOTAL == 52559872, "output size");

namespace pg8 {
typedef unsigned u32x2 __attribute__((ext_vector_type(2)));
typedef float f32x2 __attribute__((ext_vector_type(2)));
__device__ __forceinline__ float bf2f(unsigned short b) { return __uint_as_float((unsigned)b << 16); }
__device__ __forceinline__ float bflo(unsigned w) { return __uint_as_float(w << 16); }
__device__ __forceinline__ float bfhi(unsigned w) { return __uint_as_float(w & 0xffff0000u); }
__device__ __forceinline__ float sigmoidf_(float x) { return 1.0f / (1.0f + __expf(-x)); }
__device__ __forceinline__ float siluf_(float x) { return x / (1.0f + __expf(-x)); }
__device__ __forceinline__ u32x2 pack4(f32x4 v) { u32x2 w; w.x = cvt_pk_bf16(v[0], v[1]); w.y = cvt_pk_bf16(v[2], v[3]); return w; }
__device__ __forceinline__ f32x4 unpack4(u32x2 w) { return (f32x4){bflo(w.x), bfhi(w.x), bflo(w.y), bfhi(w.y)}; }

struct EpiIn {
    static constexpr bool PERM = false, AFTER_DRAIN = false;
    const float* rstd0; const float* cs; const float* lb;
    bf16_t *QR, *KR, *VR, *GR, *QG, *KG, *VG, *GG, *AR, *AH; float *GL, *FS;
    __device__ __forceinline__ void operator()(const f32x4 (&acc)[2][2][4][2], const Unit& u, int wr, int wc, int fr, int fq) const {
        const int pn = u.pn;
#pragma unroll
        for (int ai = 0; ai < 2; ++ai) {
            const int rbase = u.pm * BM + ai * HALF + wr * 64;
            if (rbase >= MTOT) continue;
            const bool samp = rbase >= MPROMPT;
            float rs[4];
#pragma unroll
            for (int m = 0; m < 4; ++m) rs[m] = rstd0[rbase + m * 16 + fr];
            if (pn < 4) {
                const bool isk = pn >= 2; bf16_t* dst = isk ? KR : QR;
#pragma unroll
                for (int bj = 0; bj < 2; ++bj) {
                    const int head = 2 * (pn & 1) + bj;
                    const float lg = __logf(1.0f - exp2f(-5.0f - (float)head));
                    float sc[4];
#pragma unroll
                    for (int m = 0; m < 4; ++m) { const float e = lg * (float)(m * 16 + fr + 1);
                        sc[m] = samp ? (isk ? 0.08838834764831845f : 1.0f) : (isk ? 0.08838834764831845f * __expf(-e) : __expf(e)); }
#pragma unroll
                    for (int m = 0; m < 4; ++m) {
                        const int row = rbase + m * 16 + fr; const int pidx = samp ? SEQ : (row & (SEQ - 1));
#pragma unroll
                        for (int n = 0; n < 2; ++n) {
                            const int j = 16 * wc + 8 * n + 2 * fq;
                            const f32x4 t = *(const f32x4*)(cs + ((size_t)pidx * 64 + j) * 2);
                            const f32x4 v = acc[ai][bj][m][n] * (rs[m] * sc[m]);
                            const float o1a = v[0] * t[0] - v[1] * t[1], o2a = v[0] * t[1] + v[1] * t[0];
                            const float o1b = v[2] * t[2] - v[3] * t[3], o2b = v[2] * t[3] + v[3] * t[2];
                            bf16_t* p = dst + (size_t)row * 512 + head * 128 + j;
                            *(unsigned*)p = cvt_pk_bf16(o1a, o1b); *(unsigned*)(p + 64) = cvt_pk_bf16(o2a, o2b);
                        }
                    }
                }
            } else if (pn >= 12 && pn < 20) {
                const int head = pn - 12;
#pragma unroll
                for (int bj = 0; bj < 2; ++bj)
#pragma unroll
                    for (int n = 0; n < 2; ++n) {
                        const int j = 64 * bj + 16 * wc + 8 * n + 2 * fq, c = head * 128 + j;
                        float qa[4][2], ka[4][2], ba[4][2];
#pragma unroll
                        for (int e = 0; e < 2; ++e) {
                            const float one_m_lb = 1.0f - lb[c + e]; float carry = 0.f;
#pragma unroll
                            for (int m = 0; m < 4; ++m) {
                                const float vq = acc[ai][bj][m][n][2 * e] * rs[m], vf = acc[ai][bj][m][n][2 * e + 1] * rs[m];
                                const float kk = one_m_lb / (1.0f + __expf(vf));
                                float x = __logf(1.0f - kk);
                                if (!samp) {
#pragma unroll
                                    for (int d = 1; d < 16; d <<= 1) { const float y = __shfl_up(x, d, 16); if (fr >= d) x += y; }
                                    x += carry; carry = __shfl(x, 15, 16);
                                }
                                qa[m][e] = siluf_(vq); ka[m][e] = kk; ba[m][e] = x;
                            }
                        }
#pragma unroll
                        for (int m = 0; m < 4; ++m) {
                            const int row = rbase + m * 16 + fr;
                            if (samp) {
                                *(unsigned*)(QG + (size_t)row * DM + c) = cvt_pk_bf16(qa[m][0], qa[m][1]);
                                *(unsigned*)(KG + (size_t)row * DM + c) = cvt_pk_bf16(ka[m][0], ka[m][1]);
                                *(f32x2*)(FS + (size_t)(row - MPROMPT) * DM + c) = (f32x2){1.0f - ka[m][0], 1.0f - ka[m][1]};
                            } else {
                                const float e0 = __expf(ba[m][0]), e1 = __expf(ba[m][1]);
                                *(unsigned*)(QG + (size_t)row * DM + c) = cvt_pk_bf16(qa[m][0] * e0, qa[m][1] * e1);
                                *(unsigned*)(KG + (size_t)row * DM + c) = cvt_pk_bf16(ka[m][0] * __expf(-ba[m][0]), ka[m][1] * __expf(-ba[m][1]));
                                if (m == 3 && fr == 15) *(f32x2*)(GL + (size_t)(row >> 6) * DM + c) = (f32x2){e0, e1};
                            }
                        }
                    }
            } else {
                int mode, cbase; bf16_t* dst;
                if (pn < 8) { dst = VR; cbase = (pn - 4) * BM; mode = 0; } else if (pn < 12) { dst = GR; cbase = (pn - 8) * BM; mode = 1; }
                else if (pn < 24) { dst = VG; cbase = (pn - 20) * BM; mode = 0; } else if (pn < 28) { dst = GG; cbase = (pn - 24) * BM; mode = 1; }
                else if (pn < 32) { dst = AR; cbase = (pn - 28) * BM; mode = 2; } else { dst = AH; cbase = (pn - 32) * BM; mode = 2; }
#pragma unroll
                for (int m = 0; m < 4; ++m) {
                    const int row = rbase + m * 16 + fr;
#pragma unroll
                    for (int bj = 0; bj < 2; ++bj)
#pragma unroll
                        for (int n = 0; n < 2; ++n) {
                            f32x4 v = acc[ai][bj][m][n] * rs[m];
                            if (mode == 1) { v[0] = siluf_(v[0]); v[1] = siluf_(v[1]); v[2] = siluf_(v[2]); v[3] = siluf_(v[3]); }
                            else if (mode == 2) { v[0] = sigmoidf_(v[0]); v[1] = sigmoidf_(v[1]); v[2] = sigmoidf_(v[2]); v[3] = sigmoidf_(v[3]); }
                            *(u32x2*)(dst + (size_t)row * DM + cbase + bj * HALF + wc * 32 + n * 16 + fq * 4) = pack4(v);
                        }
                }
            }
        }
    }
};

template <int MODE> struct EpiN {
    static constexpr bool PERM = false, AFTER_DRAIN = false;
    const bf16_t* gate; bf16_t* out16; int ld16; const float* xp; const float* xs; float* R; const float* g; float* PS; const float* PSin;
    __device__ __forceinline__ void operator()(const f32x4 (&acc)[2][2][4][2], const Unit& u, int wr, int wc, int fr, int fq) const {
#pragma unroll
        for (int ai = 0; ai < 2; ++ai) {
            const int rbase = u.pm * BM + ai * HALF + wr * 64;
            if (rbase >= MTOT) continue;
#pragma unroll
            for (int m = 0; m < 4; ++m) {
                const int row = rbase + m * 16 + fr;
                float rstd = 1.f;
                if (MODE == 3 || MODE == 4) {
                    const f32x4* p = (const f32x4*)(PSin + (size_t)row * 16); const f32x4 a = p[0], b = p[1], c = p[2], d = p[3];
                    const float s = ((a[0] + a[1]) + (a[2] + a[3])) + ((b[0] + b[1]) + (b[2] + b[3])) + ((c[0] + c[1]) + (c[2] + c[3])) + ((d[0] + d[1]) + (d[2] + d[3]));
                    rstd = rsqrtf(s * (1.0f / 1024.0f) + EPS);
                }
                float ss = 0.f;
#pragma unroll
                for (int bj = 0; bj < 2; ++bj)
#pragma unroll
                    for (int n = 0; n < 2; ++n) {
                        const int col = u.pn * BM + bj * HALF + wc * 32 + n * 16 + fq * 4;
                        const f32x4 a = acc[ai][bj][m][n];
                        if (MODE == 0) { const f32x4 gt = unpack4(*(const u32x2*)(gate + (size_t)row * DM + col)); *(u32x2*)(out16 + (size_t)row * ld16 + col) = pack4(gt * a); }
                        else if (MODE == 1) { const f32x4 gt = unpack4(*(const u32x2*)(gate + (size_t)row * DM + col)); u32x2* o = (u32x2*)(out16 + (size_t)row * ld16 + col); const f32x4 t = unpack4(*o); *o = pack4(t + gt * a); }
                        else if (MODE == 2) {
                            const float* bp = (xs != nullptr && row >= MPROMPT) ? xs + (size_t)(row - MPROMPT) * DM + col : xp + (size_t)row * DM + col;
                            const f32x4 r = *(const f32x4*)bp + a; *(f32x4*)(R + (size_t)row * DM + col) = r;
                            ss += (r[0] * r[0] + r[1] * r[1]) + (r[2] * r[2] + r[3] * r[3]);
                            *(u32x2*)(out16 + (size_t)row * ld16 + col) = pack4(r * *(const f32x4*)(g + col));
                        }
                        else if (MODE == 3) { f32x4 v = a * rstd; v[0] = fmaxf(v[0], 0.f); v[1] = fmaxf(v[1], 0.f); v[2] = fmaxf(v[2], 0.f); v[3] = fmaxf(v[3], 0.f); *(u32x2*)(out16 + (size_t)row * ld16 + col) = pack4(v * v); }
                        else if (MODE == 4) { f32x4 v = a * rstd; v[0] = sigmoidf_(v[0]); v[1] = sigmoidf_(v[1]); v[2] = sigmoidf_(v[2]); v[3] = sigmoidf_(v[3]); *(u32x2*)(out16 + (size_t)row * ld16 + col) = pack4(v); }
                        else if (MODE == 5) { const f32x4 t = unpack4(*(const u32x2*)(out16 + (size_t)row * ld16 + col)); float* rp = R + (size_t)row * DM + col; const f32x4 r = *(const f32x4*)rp + t * a; *(f32x4*)rp = r;
                            ss += (r[0] * r[0] + r[1] * r[1]) + (r[2] * r[2] + r[3] * r[3]); }
                    }
                if (MODE == 2 || MODE == 5) { ss += __shfl_xor(ss, 16); ss += __shfl_xor(ss, 32); if (fq == 0) PS[(size_t)row * 16 + u.pn * 4 + wc] = ss; }
            }
        }
    }
};
}


constexpr int NWAVES = 8;
constexpr int NPH = 10;
#ifndef MK_ONE_LAUNCH
#define MK_ONE_LAUNCH 1
#endif

constexpr size_t MiB = 1u << 20;
constexpr size_t WS_CTL = 0, CTL_ZERO_BYTES = 1 * MiB;
constexpr size_t WS_WIN = 1 * MiB;
constexpr size_t WS_WUPR = WS_WIN + (size_t)DIN * DM * 2;
constexpr size_t WS_WUPH = WS_WUPR + (size_t)DM * DM * 2;
constexpr size_t WS_WO = WS_WUPH + (size_t)DM * DM * 2;
constexpr size_t WS_WFF1 = WS_WO + (size_t)DM * DM * 2;
constexpr size_t WS_WFF2 = WS_WFF1 + (size_t)DFF * DM * 2;
constexpr size_t WS_WGATE = WS_WFF2 + (size_t)DFF * DM * 2;
constexpr size_t WS_WPROJ = WS_WGATE + (size_t)DM * DM * 2;
constexpr size_t WS_Z6 = WS_WPROJ + (size_t)DM * DPLE * 2;
constexpr size_t Z_QR = WS_Z6, Z_KR = Z_QR + (size_t)MP * 512 * 2, Z_VR = Z_KR + (size_t)MP * 512 * 2, Z_QG = Z_VR + (size_t)MP * DM * 2, Z_KG = Z_QG + (size_t)MP * DM * 2,
                 Z_VG = Z_KG + (size_t)MP * DM * 2, Z_END = Z_VG + (size_t)MP * DM * 2;
constexpr size_t WS_H = WS_Z6, WS_MB = WS_Z6 + (size_t)MP * DFF * 2;
static_assert(WS_MB == Z_VG, "MB overlays VG exactly");
constexpr size_t WS_GR = Z_END, WS_GG = WS_GR + (size_t)MP * DM * 2, WS_A5 = WS_GR, WS_A7 = WS_GG;
constexpr size_t WS_PB = WS_GG + (size_t)MP * DM * 2;
constexpr size_t WS_CS = WS_PB + (size_t)MP * DPLE * 2;
constexpr size_t WS_GL = WS_CS + (size_t)2049 * 64 * 8;
constexpr size_t WS_FS = WS_GL + (size_t)NCHUNK * DM * 4;
constexpr size_t WS_RSTD0 = WS_FS + (size_t)NDEC * DM * 4;
constexpr size_t WS_LB = WS_RSTD0 + (size_t)MP * 4;
constexpr size_t WS_PS1 = WS_LB + 4096, WS_PS2 = WS_PS1 + (size_t)MP * 64, WS_PS3 = WS_PS2 + (size_t)MP * 64, WS_END = WS_PS3 + (size_t)MP * 64;
static_assert(WS_END <= 307920896, "d_ws map must fit sum(inputs) bytes");
static_assert(WS_WIN % 256 == 0 && WS_Z6 % 256 == 0 && WS_GR % 256 == 0 && WS_PB % 256 == 0 && WS_CS % 16 == 0 && WS_GL % 16 == 0 && WS_PS1 % 16 == 0, "alignment");
constexpr int CW_TMO = 0, CW_BAR = 4096;

constexpr int RING_OFF = 0, RING_BYTES = 131072;
constexpr int LDSCTL_OFF = RING_BYTES, MISC_OFF = LDSCTL_OFF + 320;
constexpr int LDS_BYTES = 147456;

#define GAS __attribute__((address_space(1)))
#define LAS __attribute__((address_space(3)))
typedef unsigned short bf16;
typedef unsigned v4u __attribute__((ext_vector_type(4)));
typedef float f32x4 __attribute__((ext_vector_type(4)));
typedef short bf16x8 __attribute__((ext_vector_type(8)));
typedef GAS unsigned gu32;
typedef GAS unsigned long long gu64;
#define RLX_AGENT __ATOMIC_RELAXED, __HIP_MEMORY_SCOPE_AGENT
#define LDS_WAIT() asm volatile("s_waitcnt lgkmcnt(0)" ::: "memory")
#define VM_WAIT() asm volatile("s_waitcnt vmcnt(0)" ::: "memory")
__device__ __forceinline__ unsigned long long rt() { return __builtin_amdgcn_s_memrealtime(); }
__device__ __forceinline__ unsigned f2bf(float f) { unsigned u = __builtin_bit_cast(unsigned, f); return (u + 0x7fffu + ((u >> 16) & 1u)) >> 16; }
__device__ __forceinline__ unsigned pk2(float lo, float hi) { return f2bf(lo) | (f2bf(hi) << 16); }

#define XB_TMO      128
#define XB_XCNT(j)  (256  + 64 * (j))
#define XB_XSUB(j)  (1280 + 64 * (j))
#define XB_XGEN(j)  (2304 + 64 * (j))
#define XB_TOP      3328
#define XB_TOPGEN   3392
#define XCD_BAR_WORDS 3456
#define XB_SPIN_CAP (1u << 18)

__device__ __forceinline__ unsigned xb_ld(unsigned* p)              { return __hip_atomic_load(p, __ATOMIC_RELAXED, __HIP_MEMORY_SCOPE_AGENT); }
__device__ __forceinline__ unsigned xb_add(unsigned* p, unsigned v) { return __hip_atomic_fetch_add(p, v, __ATOMIC_RELAXED, __HIP_MEMORY_SCOPE_AGENT); }
__device__ __forceinline__ unsigned xb_xcc_id() { return (unsigned)__builtin_amdgcn_s_getreg((3 << 11) | 20) & 0xFu; }
#define XB_SPIN(cond, bar) do { unsigned _sp = 0; while (cond) { __builtin_amdgcn_s_sleep(1); \
    if ((++_sp & 255u) == 0u) { if (xb_ld(&(bar)[XB_TMO])) break; if (_sp > XB_SPIN_CAP) { atomicAdd(&(bar)[XB_TMO], 1u); break; } } } } while (0)

struct XcdBarrier {
    unsigned* bar; unsigned x;
    volatile LAS unsigned* st;
};

__device__ __forceinline__ XcdBarrier xcd_barrier_post(unsigned* bar, volatile LAS unsigned* st) {
    XcdBarrier b; b.bar = bar; b.x = xb_xcc_id(); b.st = st;
    if (threadIdx.x == 0) (void)xb_add(&bar[XB_XCNT(b.x)], 1u);
    return b;
}
__device__ __forceinline__ void xcd_barrier_complete(unsigned* bar, unsigned x, unsigned& nloc, unsigned& nx) {
    const unsigned G = gridDim.x * gridDim.y * gridDim.z;
    unsigned sum, cnt, mine, sp = 0u;
    for (;;) {
        sum = 0u; cnt = 0u; mine = 0u;
#pragma unroll
        for (unsigned j = 0; j < 16; ++j) { const unsigned c = xb_ld(&bar[XB_XCNT(j)]); sum += c; cnt += (c > 0u) ? 1u : 0u; mine = (j == x) ? c : mine; }
        if (sum == G) break;
        __builtin_amdgcn_s_sleep(1);
        if ((++sp & 255u) == 0u) { if (xb_ld(&bar[XB_TMO])) break; if (sp > XB_SPIN_CAP) { atomicAdd(&bar[XB_TMO], 1u); break; } }
    }
    nloc = mine > 0u ? mine : 1u; nx = cnt > 0u ? cnt : 1u;
}

__device__ __forceinline__ void xcd_barrier(const XcdBarrier& b) {
    asm volatile("s_waitcnt vmcnt(0)" ::: "memory");
    __syncthreads();
    if (threadIdx.x == 0) {
        unsigned* bar = b.bar;
        __builtin_amdgcn_s_waitcnt(0);
        unsigned nloc = b.st[0], nx = b.st[1];
        if (nloc == 0u) { xcd_barrier_complete(bar, b.x, nloc, nx); b.st[0] = nloc; b.st[1] = nx; }
        const unsigned old = xb_add(&bar[XB_XSUB(b.x)], 1u);
        const unsigned gen = old / nloc;
        if (old + 1u == (gen + 1u) * nloc) {
            __builtin_amdgcn_fence(__ATOMIC_RELEASE, "agent");
            asm volatile("s_waitcnt vmcnt(0)" ::: "memory");
            const unsigned og = xb_add(&bar[XB_TOP], 1u);
            const unsigned tg = og / nx;
            if (og + 1u == (tg + 1u) * nx) xb_add(&bar[XB_TOPGEN], 1u);
            else XB_SPIN(xb_ld(&bar[XB_TOPGEN]) == tg, bar);
            __builtin_amdgcn_fence(__ATOMIC_ACQUIRE, "agent");
            xb_add(&bar[XB_XGEN(b.x)], 1u);
            asm volatile("s_waitcnt vmcnt(0)" ::: "memory");
        } else {
            XB_SPIN(xb_ld(&bar[XB_XGEN(b.x)]) == gen, bar);
            __builtin_amdgcn_fence(__ATOMIC_ACQUIRE, "agent");
            asm volatile("s_waitcnt vmcnt(0)" ::: "memory");
        }
    }
    __syncthreads();
}


struct Args { const float* in[21]; float* out; unsigned char* ws; int ph_lo, ph_hi, use_bar, pad; };
struct Frame {
    LAS unsigned char* lds; volatile LAS unsigned* MISC; gu32* ctl;
    int tid, lane, wave, vcu, G;
};
__device__ __forceinline__ float wave_sum(float v) {
#pragma unroll
    for (int o = 1; o < 64; o <<= 1) v += __shfl_xor(v, o);
    return v;
}
__device__ __forceinline__ float bf2f_(unsigned short b) { return __uint_as_float((unsigned)b << 16); }
__device__ __forceinline__ float bflo_(unsigned w) { return __uint_as_float(w << 16); }
__device__ __forceinline__ float bfhi_(unsigned w) { return __uint_as_float(w & 0xffff0000u); }

__device__ __forceinline__ int win_src_col(int np) {
    const int tile = np >> 8, p = np & 255;
    if (tile < 4) { const int base = (tile >> 1) * 512, head = 2 * (tile & 1) + (p >> 7), pp = p & 127; return base + head * 128 + (pp & 1) * 64 + (pp >> 1); }
    if (tile >= 12 && tile < 20) { const int h = tile - 12; return 3072 + (p & 1) * 1024 + h * 128 + (p >> 1); }
    return np;
}
template <bool MAP> __device__ __forceinline__ void p0_transpose_item(const float* W, int K, int N, bf16* WT, LAS float* scr, int item, int lane) {
    const int nblk = N / 32, kb = item / nblk, nb = item % nblk, k0 = 64 * kb, n0 = 32 * nb;
    const int srcc = MAP ? win_src_col(n0 + (lane & 31)) : n0 + (lane & 31);
#pragma unroll 8
    for (int i = 0; i < 32; ++i) { const int kk = 2 * i + (lane >> 5); scr[kk * 33 + (lane & 31)] = W[(size_t)(k0 + kk) * N + srcc]; }
    LDS_WAIT(); asm volatile("" ::: "memory");
    const int c = lane & 7;
#pragma unroll
    for (int j = 0; j < 4; ++j) { const int n = (lane >> 3) + 8 * j; const LAS float* s = scr + (8 * c) * 33 + n;
        v4u o; o.x = pk2(s[0 * 33], s[1 * 33]); o.y = pk2(s[2 * 33], s[3 * 33]); o.z = pk2(s[4 * 33], s[5 * 33]); o.w = pk2(s[6 * 33], s[7 * 33]);
        *(GAS v4u*)(WT + (size_t)(n0 + n) * K + k0 + 8 * c) = o; }
    LDS_WAIT(); asm volatile("" ::: "memory");
}
__device__ __forceinline__ void p0_prologue(Frame& F, const Args& a) {
    unsigned char* ws = a.ws;
    LAS float* scr = (LAS float*)(F.lds + RING_OFF + F.wave * 16384);
    const int gw = F.vcu * NWAVES + F.wave, NGW = F.G * NWAVES;
    constexpr int I_IN = (DM / 64) * (DIN / 32), I_SQ = (DM / 64) * (DM / 32), I_F1 = (DM / 64) * (DFF / 32), I_F2 = (DFF / 64) * (DM / 32), I_PJ = (DPLE / 64) * (DM / 32);
    constexpr int NITEMS = I_IN + 4 * I_SQ + I_F1 + I_F2 + I_PJ;
    for (int it = gw; it < NITEMS; it += NGW) {
        int r = it;
        if (r < I_IN) { p0_transpose_item<true>(a.in[7], DM, DIN, (bf16*)(ws + WS_WIN), scr, r, F.lane); continue; } r -= I_IN;
        if (r < I_SQ) { p0_transpose_item<false>(a.in[11], DM, DM, (bf16*)(ws + WS_WUPR), scr, r, F.lane); continue; } r -= I_SQ;
        if (r < I_SQ) { p0_transpose_item<false>(a.in[12], DM, DM, (bf16*)(ws + WS_WUPH), scr, r, F.lane); continue; } r -= I_SQ;
        if (r < I_SQ) { p0_transpose_item<false>(a.in[13], DM, DM, (bf16*)(ws + WS_WO), scr, r, F.lane); continue; } r -= I_SQ;
        if (r < I_SQ) { p0_transpose_item<false>(a.in[18], DM, DM, (bf16*)(ws + WS_WGATE), scr, r, F.lane); continue; } r -= I_SQ;
        if (r < I_F1) { p0_transpose_item<false>(a.in[15], DM, DFF, (bf16*)(ws + WS_WFF1), scr, r, F.lane); continue; } r -= I_F1;
        if (r < I_F2) { p0_transpose_item<false>(a.in[16], DFF, DM, (bf16*)(ws + WS_WFF2), scr, r, F.lane); continue; } r -= I_F2;
        p0_transpose_item<false>(a.in[19], DPLE, DM, (bf16*)(ws + WS_WPROJ), scr, r, F.lane);
    }
    bf16* XB = (bf16*)(a.out + OFF_RETS); float* RSTD0 = (float*)(ws + WS_RSTD0); bf16* PB = (bf16*)(ws + WS_PB);
    const float* gmix = a.in[6];
    for (int m = gw; m < MP; m += NGW) {
        GAS unsigned long long* o8 = (GAS unsigned long long*)(XB + (size_t)m * DM) + F.lane;
        GAS unsigned long long* p8 = (GAS unsigned long long*)(PB + (size_t)m * DPLE) + F.lane;
        if (m >= MTOT) {
#pragma unroll
            for (int j = 0; j < 4; ++j) o8[64 * j] = 0ull;
            p8[0] = 0ull; if (F.lane == 0) RSTD0[m] = 0.f; continue;
        }
        const float* xrow = m < MPROMPT ? a.in[0] + (size_t)m * DM : a.in[1] + (size_t)(m - MPROMPT) * DM;
        const float* prow = m < MPROMPT ? a.in[4] + (size_t)m * DPLE : a.in[5] + (size_t)(m - MPROMPT) * DPLE;
        const GAS f32x4* xr = (const GAS f32x4*)xrow + F.lane;
        f32x4 v[4]; float s = 0.f;
#pragma unroll
        for (int j = 0; j < 4; ++j) { v[j] = xr[64 * j]; s += (v[j].x * v[j].x + v[j].y * v[j].y) + (v[j].z * v[j].z + v[j].w * v[j].w); }
        s = wave_sum(s);
        if (F.lane == 0) RSTD0[m] = rsqrtf(s * (1.0f / DM) + EPS);
#pragma unroll
        for (int j = 0; j < 4; ++j) { const f32x4 gv = *((const GAS f32x4*)gmix + 64 * j + F.lane);
            o8[64 * j] = (unsigned long long)pk2(v[j].x * gv.x, v[j].y * gv.y) | ((unsigned long long)pk2(v[j].z * gv.z, v[j].w * gv.w) << 32); }
        const f32x4 pv = *((const GAS f32x4*)prow + F.lane);
        p8[0] = (unsigned long long)pk2(pv.x, pv.y) | ((unsigned long long)pk2(pv.z, pv.w) << 32);
    }
    float* CS = (float*)(ws + WS_CS); float* LB = (float*)(ws + WS_LB);
    const int gt = (F.vcu * NWAVES + F.wave) * 64 + F.lane, NGT = NGW * 64;
    for (int i = gt; i < 2049 * 64; i += NGT) {
        const int pi = i >> 6, j = i & 63; const double pos = pi == SEQ ? 16384.0 : (double)pi;
        const double ang = pos * pow(10000.0, -(double)j / 64.0);
        CS[2 * i] = (float)cos(ang); CS[2 * i + 1] = (float)sin(ang);
    }
    for (int i = gt; i < DM; i += NGT) { const float a0 = a.in[10][i], a1 = a.in[10][DM + i]; LB[i] = 1.0f / (1.0f + expf(a1 - a0)); }
}

__device__ __forceinline__ void scan_item(Frame& F, const Args& a, int item) {
    unsigned char* ws = a.ws;
    const bool isg = item >= 128; const int it = isg ? item - 128 : item;
    int b, h, dv0, ldq; const bf16 *Qp, *Kp; bf16* Vp; float* Sout; const float* GLp = nullptr; float sdec = 1.f;
    if (!isg) { b = it >> 4; h = (it >> 2) & 3; dv0 = (it & 3) * 64; ldq = 512;
        Qp = (const bf16*)(ws + Z_QR) + h * 128; Kp = (const bf16*)(ws + Z_KR) + h * 128; Vp = (bf16*)(ws + Z_VR) + h * 256 + dv0;
        Sout = a.out + OFF_RETP + ((size_t)(b * HR + h) * DKR) * DVR + dv0; sdec = __expf(64.0f * __logf(1.0f - exp2f(-5.0f - (float)h))); }
    else { b = it >> 4; h = (it >> 1) & 7; dv0 = (it & 1) * 64; ldq = 1024;
        Qp = (const bf16*)(ws + Z_QG) + h * 128; Kp = (const bf16*)(ws + Z_KG) + h * 128; Vp = (bf16*)(ws + Z_VG) + h * 128 + dv0;
        Sout = a.out + OFF_HGP + ((size_t)(b * HG + h) * DKG) * DVG + dv0; GLp = (const float*)(ws + WS_GL) + h * 128; }
    const int ldo = isg ? DVG : DVR;
    LAS float* Qs = (LAS float*)(F.lds);
    LAS float* KsT = Qs + 64 * 128;
    LAS float* Vs = KsT + 128 * 64;
    LAS float* Ps = Vs + 64 * 64;
    LAS float* Ss = Ps + 64 * 64;
    const int tid = F.tid, lane = F.lane, w = F.wave;
    for (int i = tid; i < 128 * 64; i += 512) Ss[i] = 0.f;
    __syncthreads();
    for (int c = 0; c < SEQ / CH; ++c) {
        const size_t row0 = (size_t)b * SEQ + (size_t)c * CH;
        {
            const int r = tid >> 3, c0 = (tid & 7) * 16;
            const v4u q0 = *(const v4u*)(Qp + (row0 + r) * ldq + c0), q1 = *(const v4u*)(Qp + (row0 + r) * ldq + c0 + 8);
            LAS float* d = Qs + r * 128 + c0;
            d[0] = bflo_(q0.x); d[1] = bfhi_(q0.x); d[2] = bflo_(q0.y); d[3] = bfhi_(q0.y); d[4] = bflo_(q0.z); d[5] = bfhi_(q0.z); d[6] = bflo_(q0.w); d[7] = bfhi_(q0.w);
            d[8] = bflo_(q1.x); d[9] = bfhi_(q1.x); d[10] = bflo_(q1.y); d[11] = bfhi_(q1.y); d[12] = bflo_(q1.z); d[13] = bfhi_(q1.z); d[14] = bflo_(q1.w); d[15] = bfhi_(q1.w);
            const int s = tid & 63, kc = tid >> 6;
#pragma unroll
            for (int p = 0; p < 2; ++p) { const int k0 = (p * 8 + kc) * 8; const v4u kv = *(const v4u*)(Kp + (row0 + s) * ldq + k0);
                KsT[(k0 + 0) * 64 + s] = bflo_(kv.x); KsT[(k0 + 1) * 64 + s] = bfhi_(kv.x); KsT[(k0 + 2) * 64 + s] = bflo_(kv.y); KsT[(k0 + 3) * 64 + s] = bfhi_(kv.y);
                KsT[(k0 + 4) * 64 + s] = bflo_(kv.z); KsT[(k0 + 5) * 64 + s] = bfhi_(kv.z); KsT[(k0 + 6) * 64 + s] = bflo_(kv.w); KsT[(k0 + 7) * 64 + s] = bfhi_(kv.w); }
            const int vr = tid >> 3, vc = (tid & 7) * 8; const v4u vv = *(const v4u*)(Vp + (row0 + vr) * DM + vc);
            LAS float* dv = Vs + vr * 64 + vc;
            dv[0] = bflo_(vv.x); dv[1] = bfhi_(vv.x); dv[2] = bflo_(vv.y); dv[3] = bfhi_(vv.y); dv[4] = bflo_(vv.z); dv[5] = bfhi_(vv.z); dv[6] = bflo_(vv.w); dv[7] = bfhi_(vv.w);
        }
        __syncthreads();
        {
            float p[8];
#pragma unroll
            for (int i = 0; i < 8; ++i) p[i] = 0.f;
            for (int k4 = 0; k4 < 32; ++k4) {
                const float k0 = KsT[(4 * k4 + 0) * 64 + lane], k1 = KsT[(4 * k4 + 1) * 64 + lane], k2 = KsT[(4 * k4 + 2) * 64 + lane], k3 = KsT[(4 * k4 + 3) * 64 + lane];
#pragma unroll
                for (int i = 0; i < 8; ++i) { const f32x4 q = *(const LAS f32x4*)(Qs + (8 * w + i) * 128 + 4 * k4); p[i] += (q.x * k0 + q.y * k1) + (q.z * k2 + q.w * k3); }
            }
#pragma unroll
            for (int i = 0; i < 8; ++i) Ps[(8 * w + i) * 64 + lane] = (lane <= 8 * w + i) ? p[i] : 0.f;
        }
        __syncthreads();
        {
            float o[8];
#pragma unroll
            for (int i = 0; i < 8; ++i) o[i] = 0.f;
            for (int s4 = 0; s4 < 16; ++s4) {
                const float v0 = Vs[(4 * s4 + 0) * 64 + lane], v1 = Vs[(4 * s4 + 1) * 64 + lane], v2 = Vs[(4 * s4 + 2) * 64 + lane], v3 = Vs[(4 * s4 + 3) * 64 + lane];
#pragma unroll
                for (int i = 0; i < 8; ++i) { const f32x4 p = *(const LAS f32x4*)(Ps + (8 * w + i) * 64 + 4 * s4); o[i] += (p.x * v0 + p.y * v1) + (p.z * v2 + p.w * v3); }
            }
            for (int k4 = 0; k4 < 32; ++k4) {
                const float s0 = Ss[(4 * k4 + 0) * 64 + lane], s1 = Ss[(4 * k4 + 1) * 64 + lane], s2 = Ss[(4 * k4 + 2) * 64 + lane], s3 = Ss[(4 * k4 + 3) * 64 + lane];
#pragma unroll
                for (int i = 0; i < 8; ++i) { const f32x4 q = *(const LAS f32x4*)(Qs + (8 * w + i) * 128 + 4 * k4); o[i] += (q.x * s0 + q.y * s1) + (q.z * s2 + q.w * s3); }
            }
#pragma unroll
            for (int i = 0; i < 8; ++i) Vp[(row0 + 8 * w + i) * DM + lane] = (bf16)f2bf(o[i]);
        }
        __syncthreads();
        {
            float acc[16];
#pragma unroll
            for (int i = 0; i < 16; ++i) acc[i] = 0.f;
            for (int s4 = 0; s4 < 16; ++s4) {
                const float v0 = Vs[(4 * s4 + 0) * 64 + lane], v1 = Vs[(4 * s4 + 1) * 64 + lane], v2 = Vs[(4 * s4 + 2) * 64 + lane], v3 = Vs[(4 * s4 + 3) * 64 + lane];
#pragma unroll
                for (int i = 0; i < 16; ++i) { const f32x4 k = *(const LAS f32x4*)(KsT + (16 * w + i) * 64 + 4 * s4); acc[i] += (k.x * v0 + k.y * v1) + (k.z * v2 + k.w * v3); }
            }
#pragma unroll
            for (int i = 0; i < 16; ++i) { const int k = 16 * w + i; const float dec = isg ? GLp[((size_t)b * (SEQ / CH) + c) * DM + k] : sdec;
                Ss[k * 64 + lane] = dec * (Ss[k * 64 + lane] + acc[i]); }
        }
        __syncthreads();
    }
#pragma unroll
    for (int i = 0; i < 16; ++i) Sout[(size_t)(16 * w + i) * ldo + lane] = Ss[(16 * w + i) * 64 + lane];
    __syncthreads();
}

__device__ __forceinline__ void decode_ret(Frame& F, const Args& a, int item) {
    unsigned char* ws = a.ws; const int n = item >> 2, h = item & 3, row = MPROMPT + n;
    LAS float* qs = (LAS float*)(F.lds); LAS float* ks = qs + 128; LAS float* red = ks + 128;
    LAS float* part = red + 8 * 256;
    const int tid = F.tid, lane = F.lane, w = F.wave;
    if (tid < 128) qs[tid] = bf2f_(((const bf16*)(ws + Z_QR))[(size_t)row * 512 + h * 128 + tid]);
    else if (tid < 256) ks[tid - 128] = bf2f_(((const bf16*)(ws + Z_KR))[(size_t)row * 512 + h * 128 + tid - 128]);
    const unsigned long long vw = *(const unsigned long long*)((const bf16*)(ws + Z_VR) + (size_t)row * DM + h * 256 + 4 * lane);
    const f32x4 v = (f32x4){bflo_((unsigned)vw), bfhi_((unsigned)vw), bflo_((unsigned)(vw >> 32)), bfhi_((unsigned)(vw >> 32))};
    const float gam = 1.0f - exp2f(-5.0f - (float)h);
    __syncthreads();
    const float* S0 = a.in[2] + ((size_t)(n * HR + h) * DKR) * DVR; float* S1 = a.out + OFF_RETS + ((size_t)(n * HR + h) * DKR) * DVR;
    f32x4 o = (f32x4){0.f, 0.f, 0.f, 0.f};
    f32x4 s[16];
#pragma unroll
    for (int i = 0; i < 16; ++i) s[i] = *(const f32x4*)(S0 + (size_t)(w + 8 * i) * DVR + 4 * lane);
#pragma unroll
    for (int i = 0; i < 16; ++i) { const int k = w + 8 * i; const f32x4 sn = s[i] * gam + v * ks[k]; *(f32x4*)(S1 + (size_t)k * DVR + 4 * lane) = sn; o += sn * qs[k]; }
    *(LAS f32x4*)(red + w * 256 + 4 * lane) = o;
    __syncthreads();
    float ov = 0.f;
    if (tid < 256) {
#pragma unroll
        for (int i = 0; i < 8; ++i) ov += red[i * 256 + tid];
        const float ss = wave_sum(ov * ov); if (lane == 0) part[w] = ss;
    }
    __syncthreads();
    if (tid < 256) {
        const float rstd = rsqrtf(((part[0] + part[1]) + (part[2] + part[3])) * (1.0f / DVR) + EPS);
        bf16* gp = (bf16*)(ws + WS_GR) + (size_t)row * DM + h * 256 + tid;
        *gp = (bf16)f2bf(ov * rstd * a.in[8][h * 256 + tid] * bf2f_(*gp));
    }
    __syncthreads();
}
__device__ __forceinline__ void decode_hg(Frame& F, const Args& a, int item) {
    unsigned char* ws = a.ws; const int n = item >> 3, h = item & 7, row = MPROMPT + n;
    LAS float* qs = (LAS float*)(F.lds); LAS float* ks = qs + 128; LAS float* fs = ks + 128; LAS float* red = fs + 128;
    LAS float* part = red + 16 * 128;
    const int tid = F.tid, lane = F.lane, w = F.wave, l32 = lane & 31, half = lane >> 5;
    if (tid < 128) qs[tid] = bf2f_(((const bf16*)(ws + Z_QG))[(size_t)row * DM + h * 128 + tid]);
    else if (tid < 256) ks[tid - 128] = bf2f_(((const bf16*)(ws + Z_KG))[(size_t)row * DM + h * 128 + tid - 128]);
    else if (tid < 384) fs[tid - 256] = ((const float*)(ws + WS_FS))[(size_t)n * DM + h * 128 + tid - 256];
    const unsigned long long vw = *(const unsigned long long*)((const bf16*)(ws + Z_VG) + (size_t)row * DM + h * 128 + 4 * l32);
    const f32x4 v = (f32x4){bflo_((unsigned)vw), bfhi_((unsigned)vw), bflo_((unsigned)(vw >> 32)), bfhi_((unsigned)(vw >> 32))};
    __syncthreads();
    const float* S0 = a.in[3] + ((size_t)(n * HG + h) * DKG) * DVG; float* S1 = a.out + OFF_HGS + ((size_t)(n * HG + h) * DKG) * DVG;
    f32x4 o = (f32x4){0.f, 0.f, 0.f, 0.f};
    f32x4 s[8];
#pragma unroll
    for (int i = 0; i < 8; ++i) s[i] = *(const f32x4*)(S0 + (size_t)(2 * (w + 8 * i) + half) * DVG + 4 * l32);
#pragma unroll
    for (int i = 0; i < 8; ++i) { const int k = 2 * (w + 8 * i) + half; const f32x4 sn = s[i] * fs[k] + v * ks[k]; *(f32x4*)(S1 + (size_t)k * DVG + 4 * l32) = sn; o += sn * qs[k]; }
    *(LAS f32x4*)(red + (2 * w + half) * 128 + 4 * l32) = o;
    __syncthreads();
    float ov = 0.f;
    if (tid < 128) {
#pragma unroll
        for (int i = 0; i < 16; ++i) ov += red[i * 128 + tid];
        const float ss = wave_sum(ov * ov); if (lane == 0) part[w] = ss;
    }
    __syncthreads();
    if (tid < 128) {
        const float rstd = rsqrtf((part[0] + part[1]) * (1.0f / DVG) + EPS);
        bf16* gp = (bf16*)(ws + WS_GG) + (size_t)row * DM + h * 128 + tid;
        *gp = (bf16)f2bf(ov * rstd * a.in[9][h * 128 + tid] * bf2f_(*gp));
    }
    __syncthreads();
}

__device__ __forceinline__ void p3_headnorm(Frame& F, const Args& a) {
    unsigned char* ws = a.ws; const int gw = F.vcu * NWAVES + F.wave, NGW = F.G * NWAVES, lane = F.lane;
    for (int it = gw; it < MPROMPT * 8; it += NGW) {
        const bool isg = it >= MPROMPT * 4; const int i2 = isg ? it - MPROMPT * 4 : it; const int row = i2 >> 2, q = i2 & 3;
        const size_t off = (size_t)row * DM + q * 256 + 4 * lane;
        const unsigned long long ow = *(const unsigned long long*)((const bf16*)(ws + (isg ? Z_VG : Z_VR)) + off);
        unsigned long long* gp = (unsigned long long*)((bf16*)(ws + (isg ? WS_GG : WS_GR)) + off); const unsigned long long gwd = *gp;
        const f32x4 gn = *(const f32x4*)(a.in[isg ? 9 : 8] + q * 256 + 4 * lane);
        const f32x4 o = (f32x4){bflo_((unsigned)ow), bfhi_((unsigned)ow), bflo_((unsigned)(ow >> 32)), bfhi_((unsigned)(ow >> 32))};
        const f32x4 gt = (f32x4){bflo_((unsigned)gwd), bfhi_((unsigned)gwd), bflo_((unsigned)(gwd >> 32)), bfhi_((unsigned)(gwd >> 32))};
        float ss = (o.x * o.x + o.y * o.y) + (o.z * o.z + o.w * o.w);
#pragma unroll
        for (int d = 1; d < 32; d <<= 1) ss += __shfl_xor(ss, d);
        if (!isg) ss += __shfl_xor(ss, 32);
        const float rstd = rsqrtf(ss * (isg ? 1.0f / DVG : 1.0f / DVR) + EPS);
        const f32x4 x = o * rstd * gn * gt;
        *gp = (unsigned long long)pk2(x.x, x.y) | ((unsigned long long)pk2(x.z, x.w) << 32);
    }
}

__device__ __forceinline__ void p9_final(Frame& F, const Args& a) {
    const int gw = F.vcu * NWAVES + F.wave, NGW = F.G * NWAVES, lane = F.lane; const float* PS3 = (const float*)(a.ws + WS_PS3); const float* gf = a.in[20];
    for (int m = gw; m < MTOT; m += NGW) {
        const float pv = lane < 16 ? PS3[(size_t)m * 16 + lane] : 0.f; const float rstd = rsqrtf(wave_sum(pv) * (1.0f / DM) + EPS);
        f32x4* r = (f32x4*)(a.out + (size_t)m * DM) + lane;
#pragma unroll
        for (int j = 0; j < 4; ++j) { const f32x4 gv = *((const f32x4*)gf + 64 * j + lane); r[64 * j] = r[64 * j] * rstd * gv; }
    }
}

__global__ void __launch_bounds__(NWAVES * 64, 2) fwd_kernel(Args args) {
    extern __shared__ __attribute__((aligned(16))) unsigned char lds[];
    Frame F;
    F.lds = (LAS unsigned char*)lds;
    F.MISC = (volatile LAS unsigned*)(F.lds + MISC_OFF);
    F.tid = threadIdx.x; F.lane = F.tid & 63; F.wave = __builtin_amdgcn_readfirstlane(F.tid >> 6);
    F.G = gridDim.x; { const int bx = blockIdx.x; F.vcu = (F.G % 8 == 0) ? (bx % 8) * (F.G / 8) + bx / 8 : bx; }
    unsigned char* ws = args.ws;
    F.ctl = (gu32*)(ws + WS_CTL);
    for (int u = F.tid; u < (LDS_BYTES - LDSCTL_OFF) / 4; u += NWAVES * 64) ((LAS unsigned*)(F.lds + LDSCTL_OFF))[u] = 0u;
    __syncthreads();
    XcdBarrier bar; bar.bar = (unsigned*)(F.ctl + CW_BAR); bar.x = 0; bar.st = nullptr;
    if (args.use_bar) bar = xcd_barrier_post((unsigned*)(F.ctl + CW_BAR), F.MISC + 8);
    const int lo = args.ph_lo, hi = args.ph_hi;
#define IN(k) (lo <= (k) && (k) < hi)
#define SEAM(k) do { if (IN(k) && IN((k) + 1)) xcd_barrier(bar); } while (0)
    using namespace pg8;
    bf16_t* XB = (bf16_t*)(args.out + OFF_RETS);
    bf16_t* AR = (bf16_t*)(args.out + OFF_Y); bf16_t* AH = AR + (size_t)MTOT * DM;
    float* R = args.out + OFF_Y;
    float* PS1 = (float*)(ws + WS_PS1); float* PS2 = (float*)(ws + WS_PS2); float* PS3 = (float*)(ws + WS_PS3);

    if (IN(0)) { p0_prologue(F, args); SEAM(0); }
    if (IN(1)) {
        Gemm g{XB, (const bf16_t*)(ws + WS_WIN), MP, DIN, DM}; StaticOrder S; S.init(MP, DIN, F.G, (int)blockIdx.x);
        EpiIn E{(const float*)(ws + WS_RSTD0), (const float*)(ws + WS_CS), (const float*)(ws + WS_LB),
                (bf16_t*)(ws + Z_QR), (bf16_t*)(ws + Z_KR), (bf16_t*)(ws + Z_VR), (bf16_t*)(ws + WS_GR), (bf16_t*)(ws + Z_QG), (bf16_t*)(ws + Z_KG), (bf16_t*)(ws + Z_VG), (bf16_t*)(ws + WS_GG),
                AR, AH, (float*)(ws + WS_GL), (float*)(ws + WS_FS)};
        gemm_phase<EpiIn, StaticOrder, true, true>(F.lds + RING_OFF, g, S, E);
        SEAM(1);
    }
    if (IN(2)) {
        for (int it = F.vcu; it < 256; it += F.G) scan_item(F, args, it);
        for (int it = F.vcu; it < NDEC * HR; it += F.G) decode_ret(F, args, it);
        for (int it = F.vcu; it < NDEC * HG; it += F.G) decode_hg(F, args, it);
        SEAM(2);
    }
    if (IN(3)) { p3_headnorm(F, args); SEAM(3); }
    if (IN(4)) {
        { Gemm g{(const bf16_t*)(ws + WS_GG), (const bf16_t*)(ws + WS_WUPH), MP, DM, DM}; StaticOrder S; S.init(MP, DM, F.G, (int)blockIdx.x);
          EpiN<0> E{AH, (bf16_t*)(ws + WS_MB), DM, nullptr, nullptr, nullptr, nullptr, nullptr, nullptr};
          gemm_phase<EpiN<0>, StaticOrder, true, true>(F.lds + RING_OFF, g, S, E); }
        { Gemm g{(const bf16_t*)(ws + WS_GR), (const bf16_t*)(ws + WS_WUPR), MP, DM, DM}; StaticOrder S; S.init(MP, DM, F.G, (int)blockIdx.x);
          EpiN<1> E{AR, (bf16_t*)(ws + WS_MB), DM, nullptr, nullptr, nullptr, nullptr, nullptr, nullptr};
          gemm_phase<EpiN<1>, StaticOrder, true, true>(F.lds + RING_OFF, g, S, E); }
        SEAM(4);
    }
    if (IN(5)) {
        Gemm g{(const bf16_t*)(ws + WS_MB), (const bf16_t*)(ws + WS_WO), MP, DM, DM}; StaticOrder S; S.init(MP, DM, F.G, (int)blockIdx.x);
        EpiN<2> E{nullptr, (bf16_t*)(ws + WS_A5), DM, args.in[0], args.in[1], R, args.in[14], PS1, nullptr};
        gemm_phase<EpiN<2>, StaticOrder, true, true>(F.lds + RING_OFF, g, S, E);
        SEAM(5);
    }
    if (IN(6)) {
        Gemm g{(const bf16_t*)(ws + WS_A5), (const bf16_t*)(ws + WS_WFF1), MP, DFF, DM}; StaticOrder S; S.init(MP, DFF, F.G, (int)blockIdx.x);
        EpiN<3> E{nullptr, (bf16_t*)(ws + WS_H), DFF, nullptr, nullptr, nullptr, nullptr, nullptr, PS1};
        gemm_phase<EpiN<3>, StaticOrder, true, true>(F.lds + RING_OFF, g, S, E);
        SEAM(6);
    }
    if (IN(7)) {
        Gemm g{(const bf16_t*)(ws + WS_H), (const bf16_t*)(ws + WS_WFF2), MP, DM, DFF}; StaticOrder S; S.init(MP, DM, F.G, (int)blockIdx.x);
        EpiN<2> E{nullptr, (bf16_t*)(ws + WS_A7), DM, R, nullptr, R, args.in[17], PS2, nullptr};
        gemm_phase<EpiN<2>, StaticOrder, true, true>(F.lds + RING_OFF, g, S, E);
        SEAM(7);
    }
    if (IN(8)) {
        { Gemm g{(const bf16_t*)(ws + WS_A7), (const bf16_t*)(ws + WS_WGATE), MP, DM, DM}; StaticOrder S; S.init(MP, DM, F.G, (int)blockIdx.x);
          EpiN<4> E{nullptr, (bf16_t*)(ws + WS_MB), DM, nullptr, nullptr, nullptr, nullptr, nullptr, PS2};
          gemm_phase<EpiN<4>, StaticOrder, true, true>(F.lds + RING_OFF, g, S, E); }
        { Gemm g{(const bf16_t*)(ws + WS_PB), (const bf16_t*)(ws + WS_WPROJ), MP, DM, DPLE}; StaticOrder S; S.init(MP, DM, F.G, (int)blockIdx.x);
          EpiN<5> E{nullptr, (bf16_t*)(ws + WS_MB), DM, nullptr, nullptr, R, nullptr, PS3, nullptr};
          gemm_phase<EpiN<5>, StaticOrder, true, true>(F.lds + RING_OFF, g, S, E); }
        SEAM(8);
    }
    if (IN(9)) { p9_final(F, args); }
#undef IN
#undef SEAM
}

extern "C" void kernel_launch(void* const* d_in, const int* in_sizes, int n_in, void* d_out, int out_size, void* d_ws, size_t ws_size, hipStream_t stream) {
    static int grid = 0;
    if (grid == 0) {
        if (n_in != 21 || out_size != (int)OUT_TOTAL || ws_size < WS_END) { fprintf(stderr, "kernel_launch: unexpected problem (n_in %d out %d ws %zu need %zu)\n", n_in, out_size, ws_size, (size_t)WS_END); grid = -1; return; }
        int dev = 0, cus = 0;
        if (hipGetDevice(&dev) != hipSuccess || hipDeviceGetAttribute(&cus, hipDeviceAttributeMultiprocessorCount, dev) != hipSuccess) { grid = -1; return; }
        if (hipFuncSetAttribute((const void*)fwd_kernel, hipFuncAttributeMaxDynamicSharedMemorySize, LDS_BYTES) != hipSuccess) { fprintf(stderr, "kernel_launch: hipFuncSetAttribute failed\n"); grid = -1; return; }
        (void)hipGetLastError();
        grid = cus;
    }
    if (grid < 0) return;
    (void)hipMemsetAsync((char*)d_ws + WS_CTL, 0, CTL_ZERO_BYTES, stream);
    Args a{};
    for (int i = 0; i < 21; ++i) a.in[i] = (const float*)d_in[i];
    a.out = (float*)d_out; a.ws = (unsigned char*)d_ws;
#if MK_ONE_LAUNCH
    a.ph_lo = 0; a.ph_hi = NPH; a.use_bar = 1;
    hipLaunchKernelGGL(fwd_kernel, dim3(grid), dim3(NWAVES * 64), LDS_BYTES, stream, a);
#else
    for (int p = 0; p < NPH; ++p) { a.ph_lo = p; a.ph_hi = p + 1; a.use_bar = 0; hipLaunchKernelGGL(fwd_kernel, dim3(grid), dim3(NWAVES * 64), LDS_BYTES, stream, a); }
#endif
}
```

```cpp
#include <hip/hip_runtime.h>
#include <cstdio>
#include <cstdint>
namespace pg8 {
#define PG8_LAS __attribute__((address_space(3)))
typedef unsigned short bf16_t;
typedef short bf16x8 __attribute__((ext_vector_type(8)));
typedef float f32x4 __attribute__((ext_vector_type(4)));
typedef unsigned u32x4 __attribute__((ext_vector_type(4)));
constexpr int BM = 256, BK = 64, HALF = 128, HTB = HALF * BK * 2  , STAGE_BYTES = 8 * HTB, NXCD = 8, WGM = 8;

__host__ __device__ __forceinline__ int lds_byte(int r, int c) { const int st = (r >> 4) * 2 + (c >> 5), rr = r & 15, cc = c & 31, ob = rr * 64 + cc * 2; return st * 1024 + (ob ^ (((ob >> 9) & 1) << 5)); }
__host__ __device__ __forceinline__ void stage_rc(int b, int& R, int& C) { const int st = b / 1024, sb = b % 1024, swz = sb ^ (((sb >> 9) & 1) << 5); R = (st >> 1) * 16 + swz / 64; C = (st & 1) * 32 + (swz % 64) / 2; }
__host__ __device__ __forceinline__ int perm32(int rho) { const int n = rho >> 4, i = rho & 15; return 8 * (i >> 2) + 4 * n + (i & 3); }

struct Unit { int pm, pn; };
struct Gemm { const bf16_t* A; const bf16_t* Bt; int M, N, K; };

struct StaticOrder {
    int nM, nN, nwg, G, c;
    __host__ __device__ void init(int M, int N, int G_, int c_) { nM = M / BM; nN = N / BM; nwg = nM * nN; G = G_; c = c_; }
    __host__ __device__ bool next(int i, Unit& u) const {
        const long L = (long)i * G + c; if (L >= nwg) return false;
        int wgid = (int)L; { const int q = nwg / NXCD, r = nwg % NXCD, xcd = wgid % NXCD, off = wgid / NXCD; wgid = (xcd < r ? xcd * (q + 1) : r * (q + 1) + (xcd - r) * q) + off; }
        const int nig = WGM * nN, gid = wgid / nig, fm = gid * WGM, gsz = (nM - fm) < WGM ? (nM - fm) : WGM;
        u.pm = fm + ((wgid % nig) % gsz); u.pn = (wgid % nig) / gsz; return true;
    }
    __device__ __forceinline__ void a_ready(const Unit&) const {}
    __device__ __forceinline__ void done(const Unit&) const {}
};

__device__ __forceinline__ unsigned cvt_pk_bf16(float lo, float hi) { unsigned r; asm volatile("v_cvt_pk_bf16_f32 %0, %1, %2" : "=v"(r) : "v"(lo), "v"(hi)); return r; }

template <class Epi, class Sched, bool ALIGN_EPI = false, bool SP2 = false>
__device__ __forceinline__ void gemm_phase(PG8_LAS unsigned char* lds, const Gemm g, const Sched& S, const Epi& E) {
    const int tid = threadIdx.x, wid = __builtin_amdgcn_readfirstlane(tid >> 6), lane = tid & 63, wr = wid >> 2, wc = wid & 3, fr = lane & 15, fq = lane >> 4;
    const int K = g.K, nt = K / BK;
    unsigned voffA[2], voffB[2];
#pragma unroll
    for (int i = 0; i < 2; ++i) { int R, C; stage_rc(tid * 16 + i * 8192, R, C); const int Rb = Epi::PERM ? ((R & ~31) + perm32(R & 31)) : R;
        voffA[i] = (unsigned)(R * K + C) * 2u; voffB[i] = (unsigned)(Rb * K + C) * 2u; }
    const size_t kstep = (size_t)(BK * 2);
    const size_t hstep = (size_t)HALF * K * 2;
    const size_t tstep = 2 * hstep;
    const unsigned ldsw = (unsigned)wid * 1024u;
    const int aoff = lds_byte(wr * 64 + fr, fq * 8), boff = lds_byte(wc * 32 + fr, fq * 8);
#define PG8_SA(b, h) (((b) * 2 + (h)) * HTB)
#define PG8_SB(b, h) ((4 + (b) * 2 + (h)) * HTB)
#define PG8_STAGE(bufoff, gbase, voff) do { _Pragma("unroll") for (int _i = 0; _i < 2; ++_i) \
        __builtin_amdgcn_global_load_lds((const unsigned*)((const char*)(gbase) + (voff)[_i]), (PG8_LAS unsigned*)(lds + (bufoff) + ldsw + _i * 8192), 16, 0, 0); } while (0)
#define PG8_LDA(dst, b, h) do { _Pragma("unroll") for (int m = 0; m < 4; ++m) _Pragma("unroll") for (int k = 0; k < 2; ++k) dst[m][k] = *(const PG8_LAS bf16x8*)(lds + PG8_SA(b, h) + aoff + m * 2048 + k * 1024); } while (0)
#define PG8_LDB(dst, b, h) do { _Pragma("unroll") for (int n = 0; n < 2; ++n) _Pragma("unroll") for (int k = 0; k < 2; ++k) dst[n][k] = *(const PG8_LAS bf16x8*)(lds + PG8_SB(b, h) + boff + n * 2048 + k * 1024); } while (0)
#define PG8_MMA(ai, bj, At, Bt) do { __builtin_amdgcn_s_setprio(1); _Pragma("unroll") for (int m = 0; m < 4; ++m) _Pragma("unroll") for (int n = 0; n < 2; ++n) _Pragma("unroll") for (int k = 0; k < 2; ++k) \
        acc[ai][bj][m][n] = __builtin_amdgcn_mfma_f32_16x16x32_bf16(Bt[n][k], At[m][k], acc[ai][bj][m][n], 0, 0, 0); __builtin_amdgcn_s_setprio(0); } while (0)
#define PG8_WAIT_V(n) asm volatile("s_waitcnt vmcnt(" #n ")" ::: "memory")
#define PG8_WAIT_L(n) asm volatile("s_waitcnt lgkmcnt(" #n ")" ::: "memory")
#define PG8_BAR __builtin_amdgcn_s_barrier()
#define PG8_SCHED __builtin_amdgcn_sched_barrier(0)
    Unit cur, nxt; int ui = 0;
    if (!S.next(0, cur)) return;
    f32x4 acc[2][2][4][2];
#pragma unroll
    for (int a = 0; a < 2; ++a)
#pragma unroll
        for (int b = 0; b < 2; ++b)
#pragma unroll
            for (int m = 0; m < 4; ++m)
#pragma unroll
                for (int n = 0; n < 2; ++n) acc[a][b][m][n] = (f32x4){0.f, 0.f, 0.f, 0.f};
    bf16x8 At[4][2], B0[2][2], B1[2][2];
    const char* cA = (const char*)g.A + (size_t)cur.pm * tstep; const char* cB = (const char*)g.Bt + (size_t)cur.pn * tstep;
    S.a_ready(cur);
    if constexpr (SP2) {
        PG8_STAGE(PG8_SB(0, 0), cB, voffB); PG8_STAGE(PG8_SB(0, 1), cB + hstep, voffB); PG8_STAGE(PG8_SA(0, 0), cA, voffA); PG8_STAGE(PG8_SA(0, 1), cA + hstep, voffA);
        if (wr == 1) PG8_BAR;
        PG8_WAIT_V(2); PG8_BAR;
        PG8_STAGE(PG8_SB(1, 0), cB + kstep, voffB); PG8_STAGE(PG8_SA(1, 0), cA + kstep, voffA); PG8_STAGE(PG8_SB(1, 1), cB + hstep + kstep, voffB);
        PG8_WAIT_V(6); PG8_BAR;
    } else {
        PG8_STAGE(PG8_SB(0, 0), cB, voffB); PG8_STAGE(PG8_SA(0, 0), cA, voffA); PG8_STAGE(PG8_SB(0, 1), cB + hstep, voffB); PG8_STAGE(PG8_SA(0, 1), cA + hstep, voffA);
        if (wr == 1) PG8_BAR;
        PG8_WAIT_V(4); PG8_BAR;
        PG8_STAGE(PG8_SB(1, 0), cB + kstep, voffB); PG8_STAGE(PG8_SA(1, 0), cA + kstep, voffA); PG8_STAGE(PG8_SB(1, 1), cB + hstep + kstep, voffB);
        PG8_WAIT_V(6); PG8_BAR;
    }
    for (;;) {
        const bool has_next = S.next(ui + 1, nxt);
        const char* nA = has_next ? (const char*)g.A + (size_t)nxt.pm * tstep : cA; const char* nB = has_next ? (const char*)g.Bt + (size_t)nxt.pn * tstep : cB;
        for (int t = 0; t < nt; t += 2) {
            const bool last = (t == nt - 2);
            const char* a1 = cA + (size_t)(t + 1) * kstep;
            const char* a2 = last ? nA : cA + (size_t)(t + 2) * kstep; const char* b2 = last ? nB : cB + (size_t)(t + 2) * kstep;
            const char* a3 = a2 + kstep; const char* b3 = b2 + kstep;
            if (last && has_next) S.a_ready(nxt);
            if constexpr (SP2) {
            PG8_LDB(B0, 0, 0); PG8_LDB(B1, 0, 1); PG8_SCHED; PG8_LDA(At, 0, 0); PG8_STAGE(PG8_SA(1, 1), a1 + hstep, voffA);
            PG8_WAIT_V(8); PG8_WAIT_L(0); PG8_BAR; PG8_MMA(0, 0, At, B0); PG8_MMA(0, 1, At, B1); PG8_BAR; PG8_SCHED;
            PG8_LDA(At, 0, 1); PG8_STAGE(PG8_SB(0, 0), b2, voffB); PG8_STAGE(PG8_SB(0, 1), b2 + hstep, voffB); PG8_STAGE(PG8_SA(0, 0), a2, voffA);
            PG8_WAIT_V(8); PG8_WAIT_L(0); PG8_BAR; PG8_MMA(1, 0, At, B0); PG8_MMA(1, 1, At, B1); PG8_BAR; PG8_SCHED;
            PG8_LDB(B0, 1, 0); PG8_LDB(B1, 1, 1); PG8_SCHED; PG8_LDA(At, 1, 0); PG8_STAGE(PG8_SA(0, 1), a2 + hstep, voffA);
            PG8_WAIT_V(8); PG8_WAIT_L(0); PG8_BAR; PG8_MMA(0, 0, At, B0); PG8_MMA(0, 1, At, B1); PG8_BAR; PG8_SCHED;
            PG8_LDA(At, 1, 1); PG8_STAGE(PG8_SB(1, 0), b3, voffB); PG8_STAGE(PG8_SB(1, 1), b3 + hstep, voffB); PG8_STAGE(PG8_SA(1, 0), a3, voffA);
            PG8_WAIT_V(8); PG8_WAIT_L(0); PG8_BAR; PG8_MMA(1, 0, At, B0); PG8_MMA(1, 1, At, B1); PG8_BAR; PG8_SCHED;
            } else {
            PG8_LDB(B0, 0, 0); PG8_SCHED; PG8_LDA(At, 0, 0); PG8_STAGE(PG8_SA(1, 1), a1 + hstep, voffA);
            PG8_WAIT_L(8); PG8_BAR; PG8_WAIT_L(0); PG8_MMA(0, 0, At, B0); PG8_BAR; PG8_SCHED;
            PG8_LDB(B1, 0, 1); PG8_STAGE(PG8_SB(0, 0), b2, voffB);
            PG8_BAR; PG8_WAIT_L(0); PG8_MMA(0, 1, At, B1); PG8_BAR;
            PG8_LDA(At, 0, 1); PG8_STAGE(PG8_SA(0, 0), a2, voffA);
            PG8_BAR; PG8_WAIT_L(0); PG8_MMA(1, 0, At, B0); PG8_BAR; PG8_SCHED;
            PG8_STAGE(PG8_SB(0, 1), b2 + hstep, voffB);
            PG8_WAIT_V(6); PG8_BAR; PG8_MMA(1, 1, At, B1); PG8_BAR;
            PG8_LDB(B0, 1, 0); PG8_SCHED; PG8_LDA(At, 1, 0); PG8_STAGE(PG8_SA(0, 1), a2 + hstep, voffA);
            PG8_WAIT_L(8); PG8_BAR; PG8_WAIT_L(0); PG8_MMA(0, 0, At, B0); PG8_BAR; PG8_SCHED;
            PG8_LDB(B1, 1, 1); PG8_STAGE(PG8_SB(1, 0), b3, voffB);
            PG8_BAR; PG8_WAIT_L(0); PG8_MMA(0, 1, At, B1); PG8_BAR;
            PG8_LDA(At, 1, 1); PG8_STAGE(PG8_SA(1, 0), a3, voffA);
            PG8_BAR; PG8_WAIT_L(0); PG8_MMA(1, 0, At, B0); PG8_BAR; PG8_SCHED;
            PG8_STAGE(PG8_SB(1, 1), b3 + hstep, voffB);
            PG8_WAIT_V(6); PG8_BAR; PG8_MMA(1, 1, At, B1); PG8_BAR;
            }
        }
        if constexpr (ALIGN_EPI) { if (wr == 0) PG8_BAR; }
        if constexpr (!Epi::AFTER_DRAIN) { E(acc, cur, wr, wc, fr, fq); S.done(cur); }
        if (!has_next) break;
#pragma unroll
        for (int a = 0; a < 2; ++a)
#pragma unroll
            for (int b = 0; b < 2; ++b)
#pragma unroll
                for (int m = 0; m < 4; ++m)
#pragma unroll
                    for (int n = 0; n < 2; ++n) acc[a][b][m][n] = (f32x4){0.f, 0.f, 0.f, 0.f};
        cur = nxt; cA = nA; cB = nB; ++ui;
        if constexpr (ALIGN_EPI) { if (wr == 1) PG8_BAR; }
    }
    PG8_WAIT_V(0);
    if constexpr (!ALIGN_EPI) { if (wr == 0) PG8_BAR; }
    PG8_BAR;
    if constexpr (Epi::AFTER_DRAIN) { E.fused(acc, cur, wr, wc, fr, fq, lds, wid, lane); S.done(cur); }
#undef PG8_SA
#undef PG8_SB
#undef PG8_STAGE
#undef PG8_LDA
#undef PG8_LDB
#undef PG8_MMA
#undef PG8_WAIT_V
#undef PG8_WAIT_L
#undef PG8_BAR
#undef PG8_SCHED
}
}


constexpr int DM = 1024, NB = 8, SEQ = 2048, NDEC = 128, MPROMPT = NB * SEQ, MTOT = MPROMPT + NDEC, MP = 16640  ;
constexpr int HR = 4, DKR = 128, DVR = 256, HG = 8, DKG = 128, DVG = 128, DFF = 4096, DPLE = 256, DIN = 9216, CH = 64, NCHUNK = MPROMPT / CH;
constexpr float EPS = 1e-6f;
constexpr size_t OFF_Y = 0, OFF_RETP = (size_t)MTOT * DM, OFF_HGP = OFF_RETP + (size_t)NB * HR * DKR * DVR, OFF_RETS = OFF_HGP + (size_t)NB * HG * DKG * DVG,
                 OFF_HGS = OFF_RETS + (size_t)NDEC * HR * DKR * DVR, OUT_TOTAL = OFF_HGS + (size_t)NDEC * HG * DKG * DVG;
static_assert(OUT_TOTAL == 52559872, "output size");

namespace pg8 {
typedef unsigned u32x2 __attribute__((ext_vector_type(2)));
typedef float f32x2 __attribute__((ext_vector_type(2)));
__device__ __forceinline__ float bf2f(unsigned short b) { return __uint_as_float((unsigned)b << 16); }
__device__ __forceinline__ float bflo(unsigned w) { return __uint_as_float(w << 16); }
__device__ __forceinline__ float bfhi(unsigned w) { return __uint_as_float(w & 0xffff0000u); }
__device__ __forceinline__ float sigmoidf_(float x) { return 1.0f / (1.0f + __expf(-x)); }
__device__ __forceinline__ float siluf_(float x) { return x / (1.0f + __expf(-x)); }
__device__ __forceinline__ u32x2 pack4(f32x4 v) { u32x2 w; w.x = cvt_pk_bf16(v[0], v[1]); w.y = cvt_pk_bf16(v[2], v[3]); return w; }
__device__ __forceinline__ f32x4 unpack4(u32x2 w) { return (f32x4){bflo(w.x), bfhi(w.x), bflo(w.y), bfhi(w.y)}; }

struct EpiIn {
    static constexpr bool PERM = false, AFTER_DRAIN = false;
    const float* rstd0; const float* cs; const float* lb;
    bf16_t *QR, *KR, *VR, *GR, *QG, *KG, *VG, *GG, *AR, *AH; float *GL, *FS;
    __device__ __forceinline__ void operator()(const f32x4 (&acc)[2][2][4][2], const Unit& u, int wr, int wc, int fr, int fq) const {
        const int pn = u.pn;
#pragma unroll
        for (int ai = 0; ai < 2; ++ai) {
            const int rbase = u.pm * BM + ai * HALF + wr * 64;
            if (rbase >= MTOT) continue;
            const bool samp = rbase >= MPROMPT;
            float rs[4];
#pragma unroll
            for (int m = 0; m < 4; ++m) rs[m] = rstd0[rbase + m * 16 + fr];
            if (pn < 4) {
                const bool isk = pn >= 2; bf16_t* dst = isk ? KR : QR;
#pragma unroll
                for (int bj = 0; bj < 2; ++bj) {
                    const int head = 2 * (pn & 1) + bj;
                    const float lg = __logf(1.0f - exp2f(-5.0f - (float)head));
                    float sc[4];
#pragma unroll
                    for (int m = 0; m < 4; ++m) { const float e = lg * (float)(m * 16 + fr + 1);
                        sc[m] = samp ? (isk ? 0.08838834764831845f : 1.0f) : (isk ? 0.08838834764831845f * __expf(-e) : __expf(e)); }
#pragma unroll
                    for (int m = 0; m < 4; ++m) {
                        const int row = rbase + m * 16 + fr; const int pidx = samp ? SEQ : (row & (SEQ - 1));
#pragma unroll
                        for (int n = 0; n < 2; ++n) {
                            const int j = 16 * wc + 8 * n + 2 * fq;
                            const f32x4 t = *(const f32x4*)(cs + ((size_t)pidx * 64 + j) * 2);
                            const f32x4 v = acc[ai][bj][m][n] * (rs[m] * sc[m]);
                            const float o1a = v[0] * t[0] - v[1] * t[1], o2a = v[0] * t[1] + v[1] * t[0];
                            const float o1b = v[2] * t[2] - v[3] * t[3], o2b = v[2] * t[3] + v[3] * t[2];
                            bf16_t* p = dst + (size_t)row * 512 + head * 128 + j;
                            *(unsigned*)p = cvt_pk_bf16(o1a, o1b); *(unsigned*)(p + 64) = cvt_pk_bf16(o2a, o2b);
                        }
                    }
                }
            } else if (pn >= 12 && pn < 20) {
                const int head = pn - 12;
#pragma unroll
                for (int bj = 0; bj < 2; ++bj)
#pragma unroll
                    for (int n = 0; n < 2; ++n) {
                        const int j = 64 * bj + 16 * wc + 8 * n + 2 * fq, c = head * 128 + j;
                        float qa[4][2], ka[4][2], ba[4][2];
#pragma unroll
                        for (int e = 0; e < 2; ++e) {
                            const float one_m_lb = 1.0f - lb[c + e]; float carry = 0.f;
#pragma unroll
                            for (int m = 0; m < 4; ++m) {
                                const float vq = acc[ai][bj][m][n][2 * e] * rs[m], vf = acc[ai][bj][m][n][2 * e + 1] * rs[m];
                                const float kk = one_m_lb / (1.0f + __expf(vf));
                                float x = __logf(1.0f - kk);
                                if (!samp) {
#pragma unroll
                                    for (int d = 1; d < 16; d <<= 1) { const float y = __shfl_up(x, d, 16); if (fr >= d) x += y; }
                                    x += carry; carry = __shfl(x, 15, 16);
                                }
                                qa[m][e] = siluf_(vq); ka[m][e] = kk; ba[m][e] = x;
                            }
                        }
#pragma unroll
                        for (int m = 0; m < 4; ++m) {
                            const int row = rbase + m * 16 + fr;
                            if (samp) {
                                *(unsigned*)(QG + (size_t)row * DM + c) = cvt_pk_bf16(qa[m][0], qa[m][1]);
                                *(unsigned*)(KG + (size_t)row * DM + c) = cvt_pk_bf16(ka[m][0], ka[m][1]);
                                *(f32x2*)(FS + (size_t)(row - MPROMPT) * DM + c) = (f32x2){1.0f - ka[m][0], 1.0f - ka[m][1]};
                            } else {
                                const float e0 = __expf(ba[m][0]), e1 = __expf(ba[m][1]);
                                *(unsigned*)(QG + (size_t)row * DM + c) = cvt_pk_bf16(qa[m][0] * e0, qa[m][1] * e1);
                                *(unsigned*)(KG + (size_t)row * DM + c) = cvt_pk_bf16(ka[m][0] * __expf(-ba[m][0]), ka[m][1] * __expf(-ba[m][1]));
                                if (m == 3 && fr == 15) *(f32x2*)(GL + (size_t)(row >> 6) * DM + c) = (f32x2){e0, e1};
                            }
                        }
                    }
            } else {
                int mode, cbase; bf16_t* dst;
                if (pn < 8) { dst = VR; cbase = (pn - 4) * BM; mode = 0; } else if (pn < 12) { dst = GR; cbase = (pn - 8) * BM; mode = 1; }
                else if (pn < 24) { dst = VG; cbase = (pn - 20) * BM; mode = 0; } else if (pn < 28) { dst = GG; cbase = (pn - 24) * BM; mode = 1; }
                else if (pn < 32) { dst = AR; cbase = (pn - 28) * BM; mode = 2; } else { dst = AH; cbase = (pn - 32) * BM; mode = 2; }
#pragma unroll
                for (int m = 0; m < 4; ++m) {
                    const int row = rbase + m * 16 + fr;
#pragma unroll
                    for (int bj = 0; bj < 2; ++bj)
#pragma unroll
                        for (int n = 0; n < 2; ++n) {
                            f32x4 v = acc[ai][bj][m][n] * rs[m];
                            if (mode == 1) { v[0] = siluf_(v[0]); v[1] = siluf_(v[1]); v[2] = siluf_(v[2]); v[3] = siluf_(v[3]); }
                            else if (mode == 2) { v[0] = sigmoidf_(v[0]); v[1] = sigmoidf_(v[1]); v[2] = sigmoidf_(v[2]); v[3] = sigmoidf_(v[3]); }
                            *(u32x2*)(dst + (size_t)row * DM + cbase + bj * HALF + wc * 32 + n * 16 + fq * 4) = pack4(v);
                        }
                }
            }
        }
    }
};

template <int MODE> struct EpiN {
    static constexpr bool PERM = false, AFTER_DRAIN = false;
    const bf16_t* gate; bf16_t* out16; int ld16; const float* xp; const float* xs; float* R; const float* g; float* PS; const float* PSin;
    __device__ __forceinline__ void operator()(const f32x4 (&acc)[2][2][4][2], const Unit& u, int wr, int wc, int fr, int fq) const {
#pragma unroll
        for (int ai = 0; ai < 2; ++ai) {
            const int rbase = u.pm * BM + ai * HALF + wr * 64;
            if (rbase >= MTOT) continue;
#pragma unroll
            for (int m = 0; m < 4; ++m) {
                const int row = rbase + m * 16 + fr;
                float rstd = 1.f;
                if (MODE == 3 || MODE == 4) {
                    const f32x4* p = (const f32x4*)(PSin + (size_t)row * 16); const f32x4 a = p[0], b = p[1], c = p[2], d = p[3];
                    const float s = ((a[0] + a[1]) + (a[2] + a[3])) + ((b[0] + b[1]) + (b[2] + b[3])) + ((c[0] + c[1]) + (c[2] + c[3])) + ((d[0] + d[1]) + (d[2] + d[3]));
                    rstd = rsqrtf(s * (1.0f / 1024.0f) + EPS);
                }
                float ss = 0.f;
#pragma unroll
                for (int bj = 0; bj < 2; ++bj)
#pragma unroll
                    for (int n = 0; n < 2; ++n) {
                        const int col = u.pn * BM + bj * HALF + wc * 32 + n * 16 + fq * 4;
                        const f32x4 a = acc[ai][bj][m][n];
                        if (MODE == 0) { const f32x4 gt = unpack4(*(const u32x2*)(gate + (size_t)row * DM + col)); *(u32x2*)(out16 + (size_t)row * ld16 + col) = pack4(gt * a); }
                        else if (MODE == 1) { const f32x4 gt = unpack4(*(const u32x2*)(gate + (size_t)row * DM + col)); u32x2* o = (u32x2*)(out16 + (size_t)row * ld16 + col); const f32x4 t = unpack4(*o); *o = pack4(t + gt * a); }
                        else if (MODE == 2) {
                            const float* bp = (xs != nullptr && row >= MPROMPT) ? xs + (size_t)(row - MPROMPT) * DM + col : xp + (size_t)row * DM + col;
                            const f32x4 r = *(const f32x4*)bp + a; *(f32x4*)(R + (size_t)row * DM + col) = r;
                            ss += (r[0] * r[0] + r[1] * r[1]) + (r[2] * r[2] + r[3] * r[3]);
                            *(u32x2*)(out16 + (size_t)row * ld16 + col) = pack4(r * *(const f32x4*)(g + col));
                        }
                        else if (MODE == 3) { f32x4 v = a * rstd; v[0] = fmaxf(v[0], 0.f); v[1] = fmaxf(v[1], 0.f); v[2] = fmaxf(v[2], 0.f); v[3] = fmaxf(v[3], 0.f); *(u32x2*)(out16 + (size_t)row * ld16 + col) = pack4(v * v); }
                        else if (MODE == 4) { f32x4 v = a * rstd; v[0] = sigmoidf_(v[0]); v[1] = sigmoidf_(v[1]); v[2] = sigmoidf_(v[2]); v[3] = sigmoidf_(v[3]); *(u32x2*)(out16 + (size_t)row * ld16 + col) = pack4(v); }
                        else if (MODE == 5) { const f32x4 t = unpack4(*(const u32x2*)(out16 + (size_t)row * ld16 + col)); float* rp = R + (size_t)row * DM + col; const f32x4 r = *(const f32x4*)rp + t * a; *(f32x4*)rp = r;
                            ss += (r[0] * r[0] + r[1] * r[1]) + (r[2] * r[2] + r[3] * r[3]); }
                    }
                if (MODE == 2 || MODE == 5) { ss += __shfl_xor(ss, 16); ss += __shfl_xor(ss, 32); if (fq == 0) PS[(size_t)row * 16 + u.pn * 4 + wc] = ss; }
            }
        }
    }
};
}


constexpr int NWAVES = 8;
constexpr int NPH = 10;
#ifndef MK_ONE_LAUNCH
#define MK_ONE_LAUNCH 1
#endif

constexpr size_t MiB = 1u << 20;
constexpr size_t WS_CTL = 0, CTL_ZERO_BYTES = 1 * MiB;
constexpr size_t WS_WIN = 1 * MiB;
constexpr size_t WS_WUPR = WS_WIN + (size_t)DIN * DM * 2;
constexpr size_t WS_WUPH = WS_WUPR + (size_t)DM * DM * 2;
constexpr size_t WS_WO = WS_WUPH + (size_t)DM * DM * 2;
constexpr size_t WS_WFF1 = WS_WO + (size_t)DM * DM * 2;
constexpr size_t WS_WFF2 = WS_WFF1 + (size_t)DFF * DM * 2;
constexpr size_t WS_WGATE = WS_WFF2 + (size_t)DFF * DM * 2;
constexpr size_t WS_WPROJ = WS_WGATE + (size_t)DM * DM * 2;
constexpr size_t WS_Z6 = WS_WPROJ + (size_t)DM * DPLE * 2;
constexpr size_t Z_QR = WS_Z6, Z_KR = Z_QR + (size_t)MP * 512 * 2, Z_VR = Z_KR + (size_t)MP * 512 * 2, Z_QG = Z_VR + (size_t)MP * DM * 2, Z_KG = Z_QG + (size_t)MP * DM * 2,
                 Z_VG = Z_KG + (size_t)MP * DM * 2, Z_END = Z_VG + (size_t)MP * DM * 2;
constexpr size_t WS_H = WS_Z6, WS_MB = WS_Z6 + (size_t)MP * DFF * 2;
static_assert(WS_MB == Z_VG, "MB overlays VG exactly");
constexpr size_t WS_GR = Z_END, WS_GG = WS_GR + (size_t)MP * DM * 2, WS_A5 = WS_GR, WS_A7 = WS_GG;
constexpr size_t WS_PB = WS_GG + (size_t)MP * DM * 2;
constexpr size_t WS_CS = WS_PB + (size_t)MP * DPLE * 2;
constexpr size_t WS_GL = WS_CS + (size_t)2049 * 64 * 8;
constexpr size_t WS_FS = WS_GL + (size_t)NCHUNK * DM * 4;
constexpr size_t WS_RSTD0 = WS_FS + (size_t)NDEC * DM * 4;
constexpr size_t WS_LB = WS_RSTD0 + (size_t)MP * 4;
constexpr size_t WS_PS1 = WS_LB + 4096, WS_PS2 = WS_PS1 + (size_t)MP * 64, WS_PS3 = WS_PS2 + (size_t)MP * 64, WS_END = WS_PS3 + (size_t)MP * 64;
static_assert(WS_END <= 307920896, "d_ws map must fit sum(inputs) bytes");
static_assert(WS_WIN % 256 == 0 && WS_Z6 % 256 == 0 && WS_GR % 256 == 0 && WS_PB % 256 == 0 && WS_CS % 16 == 0 && WS_GL % 16 == 0 && WS_PS1 % 16 == 0, "alignment");
constexpr int CW_TMO = 0, CW_BAR = 4096;

constexpr int RING_OFF = 0, RING_BYTES = 131072;
constexpr int LDSCTL_OFF = RING_BYTES, MISC_OFF = LDSCTL_OFF + 320;
constexpr int LDS_BYTES = 147456;

#define GAS __attribute__((address_space(1)))
#define LAS __attribute__((address_space(3)))
typedef unsigned short bf16;
typedef unsigned v4u __attribute__((ext_vector_type(4)));
typedef float f32x4 __attribute__((ext_vector_type(4)));
typedef short bf16x8 __attribute__((ext_vector_type(8)));
typedef GAS unsigned gu32;
typedef GAS unsigned long long gu64;
#define RLX_AGENT __ATOMIC_RELAXED, __HIP_MEMORY_SCOPE_AGENT
#define LDS_WAIT() asm volatile("s_waitcnt lgkmcnt(0)" ::: "memory")
#define VM_WAIT() asm volatile("s_waitcnt vmcnt(0)" ::: "memory")
__device__ __forceinline__ unsigned long long rt() { return __builtin_amdgcn_s_memrealtime(); }
__device__ __forceinline__ unsigned f2bf(float f) { unsigned u = __builtin_bit_cast(unsigned, f); return (u + 0x7fffu + ((u >> 16) & 1u)) >> 16; }
__device__ __forceinline__ unsigned pk2(float lo, float hi) { return f2bf(lo) | (f2bf(hi) << 16); }

#define XB_TMO      128
#define XB_XCNT(j)  (256  + 64 * (j))
#define XB_XSUB(j)  (1280 + 64 * (j))
#define XB_XGEN(j)  (2304 + 64 * (j))
#define XB_TOP      3328
#define XB_TOPGEN   3392
#define XCD_BAR_WORDS 3456
#define XB_SPIN_CAP (1u << 18)

__device__ __forceinline__ unsigned xb_ld(unsigned* p)              { return __hip_atomic_load(p, __ATOMIC_RELAXED, __HIP_MEMORY_SCOPE_AGENT); }
__device__ __forceinline__ unsigned xb_add(unsigned* p, unsigned v) { return __hip_atomic_fetch_add(p, v, __ATOMIC_RELAXED, __HIP_MEMORY_SCOPE_AGENT); }
__device__ __forceinline__ unsigned xb_xcc_id() { return (unsigned)__builtin_amdgcn_s_getreg((3 << 11) | 20) & 0xFu; }
#define XB_SPIN(cond, bar) do { unsigned _sp = 0; while (cond) { __builtin_amdgcn_s_sleep(1); \
    if ((++_sp & 255u) == 0u) { if (xb_ld(&(bar)[XB_TMO])) break; if (_sp > XB_SPIN_CAP) { atomicAdd(&(bar)[XB_TMO], 1u); break; } } } } while (0)

struct XcdBarrier {
    unsigned* bar; unsigned x;
    volatile LAS unsigned* st;
};

__device__ __forceinline__ XcdBarrier xcd_barrier_post(unsigned* bar, volatile LAS unsigned* st) {
    XcdBarrier b; b.bar = bar; b.x = xb_xcc_id(); b.st = st;
    if (threadIdx.x == 0) (void)xb_add(&bar[XB_XCNT(b.x)], 1u);
    return b;
}
__device__ __forceinline__ void xcd_barrier_complete(unsigned* bar, unsigned x, unsigned& nloc, unsigned& nx) {
    const unsigned G = gridDim.x * gridDim.y * gridDim.z;
    unsigned sum, cnt, mine, sp = 0u;
    for (;;) {
        sum = 0u; cnt = 0u; mine = 0u;
#pragma unroll
        for (unsigned j = 0; j < 16; ++j) { const unsigned c = xb_ld(&bar[XB_XCNT(j)]); sum += c; cnt += (c > 0u) ? 1u : 0u; mine = (j == x) ? c : mine; }
        if (sum == G) break;
        __builtin_amdgcn_s_sleep(1);
        if ((++sp & 255u) == 0u) { if (xb_ld(&bar[XB_TMO])) break; if (sp > XB_SPIN_CAP) { atomicAdd(&bar[XB_TMO], 1u); break; } }
    }
    nloc = mine > 0u ? mine : 1u; nx = cnt > 0u ? cnt : 1u;
}

__device__ __forceinline__ void xcd_barrier(const XcdBarrier& b) {
    asm volatile("s_waitcnt vmcnt(0)" ::: "memory");
    __syncthreads();
    if (threadIdx.x == 0) {
        unsigned* bar = b.bar;
        __builtin_amdgcn_s_waitcnt(0);
        unsigned nloc = b.st[0], nx = b.st[1];
        if (nloc == 0u) { xcd_barrier_complete(bar, b.x, nloc, nx); b.st[0] = nloc; b.st[1] = nx; }
        const unsigned old = xb_add(&bar[XB_XSUB(b.x)], 1u);
        const unsigned gen = old / nloc;
        if (old + 1u == (gen + 1u) * nloc) {
            __builtin_amdgcn_fence(__ATOMIC_RELEASE, "agent");
            asm volatile("s_waitcnt vmcnt(0)" ::: "memory");
            const unsigned og = xb_add(&bar[XB_TOP], 1u);
            const unsigned tg = og / nx;
            if (og + 1u == (tg + 1u) * nx) xb_add(&bar[XB_TOPGEN], 1u);
            else XB_SPIN(xb_ld(&bar[XB_TOPGEN]) == tg, bar);
            __builtin_amdgcn_fence(__ATOMIC_ACQUIRE, "agent");
            xb_add(&bar[XB_XGEN(b.x)], 1u);
            asm volatile("s_waitcnt vmcnt(0)" ::: "memory");
        } else {
            XB_SPIN(xb_ld(&bar[XB_XGEN(b.x)]) == gen, bar);
            __builtin_amdgcn_fence(__ATOMIC_ACQUIRE, "agent");
            asm volatile("s_waitcnt vmcnt(0)" ::: "memory");
        }
    }
    __syncthreads();
}


struct Args { const float* in[21]; float* out; unsigned char* ws; int ph_lo, ph_hi, use_bar, pad; };
struct Frame {
    LAS unsigned char* lds; volatile LAS unsigned* MISC; gu32* ctl;
    int tid, lane, wave, vcu, G;
};
__device__ __forceinline__ float wave_sum(float v) {
#pragma unroll
    for (int o = 1; o < 64; o <<= 1) v += __shfl_xor(v, o);
    return v;
}
__device__ __forceinline__ float bf2f_(unsigned short b) { return __uint_as_float((unsigned)b << 16); }
__device__ __forceinline__ float bflo_(unsigned w) { return __uint_as_float(w << 16); }
__device__ __forceinline__ float bfhi_(unsigned w) { return __uint_as_float(w & 0xffff0000u); }

__device__ __forceinline__ int win_src_col(int np) {
    const int tile = np >> 8, p = np & 255;
    if (tile < 4) { const int base = (tile >> 1) * 512, head = 2 * (tile & 1) + (p >> 7), pp = p & 127; return base + head * 128 + (pp & 1) * 64 + (pp >> 1); }
    if (tile >= 12 && tile < 20) { const int h = tile - 12; return 3072 + (p & 1) * 1024 + h * 128 + (p >> 1); }
    return np;
}
template <bool MAP> __device__ __forceinline__ void p0_transpose_item(const float* W, int K, int N, bf16* WT, LAS float* scr, int item, int lane) {
    const int nblk = N / 32, kb = item / nblk, nb = item % nblk, k0 = 64 * kb, n0 = 32 * nb;
    const int srcc = MAP ? win_src_col(n0 + (lane & 31)) : n0 + (lane & 31);
#pragma unroll 8
    for (int i = 0; i < 32; ++i) { const int kk = 2 * i + (lane >> 5); scr[kk * 33 + (lane & 31)] = W[(size_t)(k0 + kk) * N + srcc]; }
    LDS_WAIT(); asm volatile("" ::: "memory");
    const int c = lane & 7;
#pragma unroll
    for (int j = 0; j < 4; ++j) { const int n = (lane >> 3) + 8 * j; const LAS float* s = scr + (8 * c) * 33 + n;
        v4u o; o.x = pk2(s[0 * 33], s[1 * 33]); o.y = pk2(s[2 * 33], s[3 * 33]); o.z = pk2(s[4 * 33], s[5 * 33]); o.w = pk2(s[6 * 33], s[7 * 33]);
        *(GAS v4u*)(WT + (size_t)(n0 + n) * K + k0 + 8 * c) = o; }
    LDS_WAIT(); asm volatile("" ::: "memory");
}
__device__ __forceinline__ void p0_prologue(Frame& F, const Args& a) {
    unsigned char* ws = a.ws;
    LAS float* scr = (LAS float*)(F.lds + RING_OFF + F.wave * 16384);
    const int gw = F.vcu * NWAVES + F.wave, NGW = F.G * NWAVES;
    constexpr int I_IN = (DM / 64) * (DIN / 32), I_SQ = (DM / 64) * (DM / 32), I_F1 = (DM / 64) * (DFF / 32), I_F2 = (DFF / 64) * (DM / 32), I_PJ = (DPLE / 64) * (DM / 32);
    constexpr int NITEMS = I_IN + 4 * I_SQ + I_F1 + I_F2 + I_PJ;
    for (int it = gw; it < NITEMS; it += NGW) {
        int r = it;
        if (r < I_IN) { p0_transpose_item<true>(a.in[7], DM, DIN, (bf16*)(ws + WS_WIN), scr, r, F.lane); continue; } r -= I_IN;
        if (r < I_SQ) { p0_transpose_item<false>(a.in[11], DM, DM, (bf16*)(ws + WS_WUPR), scr, r, F.lane); continue; } r -= I_SQ;
        if (r < I_SQ) { p0_transpose_item<false>(a.in[12], DM, DM, (bf16*)(ws + WS_WUPH), scr, r, F.lane); continue; } r -= I_SQ;
        if (r < I_SQ) { p0_transpose_item<false>(a.in[13], DM, DM, (bf16*)(ws + WS_WO), scr, r, F.lane); continue; } r -= I_SQ;
        if (r < I_SQ) { p0_transpose_item<false>(a.in[18], DM, DM, (bf16*)(ws + WS_WGATE), scr, r, F.lane); continue; } r -= I_SQ;
        if (r < I_F1) { p0_transpose_item<false>(a.in[15], DM, DFF, (bf16*)(ws + WS_WFF1), scr, r, F.lane); continue; } r -= I_F1;
        if (r < I_F2) { p0_transpose_item<false>(a.in[16], DFF, DM, (bf16*)(ws + WS_WFF2), scr, r, F.lane); continue; } r -= I_F2;
        p0_transpose_item<false>(a.in[19], DPLE, DM, (bf16*)(ws + WS_WPROJ), scr, r, F.lane);
    }
    bf16* XB = (bf16*)(a.out + OFF_RETS); float* RSTD0 = (float*)(ws + WS_RSTD0); bf16* PB = (bf16*)(ws + WS_PB);
    const float* gmix = a.in[6];
    for (int m = gw; m < MP; m += NGW) {
        GAS unsigned long long* o8 = (GAS unsigned long long*)(XB + (size_t)m * DM) + F.lane;
        GAS unsigned long long* p8 = (GAS unsigned long long*)(PB + (size_t)m * DPLE) + F.lane;
        if (m >= MTOT) {
#pragma unroll
            for (int j = 0; j < 4; ++j) o8[64 * j] = 0ull;
            p8[0] = 0ull; if (F.lane == 0) RSTD0[m] = 0.f; continue;
        }
        const float* xrow = m < MPROMPT ? a.in[0] + (size_t)m * DM : a.in[1] + (size_t)(m - MPROMPT) * DM;
        const float* prow = m < MPROMPT ? a.in[4] + (size_t)m * DPLE : a.in[5] + (size_t)(m - MPROMPT) * DPLE;
        const GAS f32x4* xr = (const GAS f32x4*)xrow + F.lane;
        f32x4 v[4]; float s = 0.f;
#pragma unroll
        for (int j = 0; j < 4; ++j) { v[j] = xr[64 * j]; s += (v[j].x * v[j].x + v[j].y * v[j].y) + (v[j].z * v[j].z + v[j].w * v[j].w); }
        s = wave_sum(s);
        if (F.lane == 0) RSTD0[m] = rsqrtf(s * (1.0f / DM) + EPS);
#pragma unroll
        for (int j = 0; j < 4; ++j) { const f32x4 gv = *((const GAS f32x4*)gmix + 64 * j + F.lane);
            o8[64 * j] = (unsigned long long)pk2(v[j].x * gv.x, v[j].y * gv.y) | ((unsigned long long)pk2(v[j].z * gv.z, v[j].w * gv.w) << 32); }
        const f32x4 pv = *((const GAS f32x4*)prow + F.lane);
        p8[0] = (unsigned long long)pk2(pv.x, pv.y) | ((unsigned long long)pk2(pv.z, pv.w) << 32);
    }
    float* CS = (float*)(ws + WS_CS); float* LB = (float*)(ws + WS_LB);
    const int gt = (F.vcu * NWAVES + F.wave) * 64 + F.lane, NGT = NGW * 64;
    for (int i = gt; i < 2049 * 64; i += NGT) {
        const int pi = i >> 6, j = i & 63; const double pos = pi == SEQ ? 16384.0 : (double)pi;
        const double ang = pos * pow(10000.0, -(double)j / 64.0);
        CS[2 * i] = (float)cos(ang); CS[2 * i + 1] = (float)sin(ang);
    }
    for (int i = gt; i < DM; i += NGT) { const float a0 = a.in[10][i], a1 = a.in[10][DM + i]; LB[i] = 1.0f / (1.0f + expf(a1 - a0)); }
}

typedef float f32x16 __attribute__((ext_vector_type(16)));
typedef short v4i16_t __attribute__((ext_vector_type(4)));
typedef unsigned u32x2 __attribute__((ext_vector_type(2)));
typedef float f32x2_t __attribute__((ext_vector_type(2))); typedef __bf16 bf16x2_t __attribute__((ext_vector_type(2)));
__device__ __forceinline__ unsigned cvtpk_s(float lo, float hi) { f32x2_t v = {lo, hi}; bf16x2_t b = __builtin_convertvector(v, bf16x2_t); return __builtin_bit_cast(unsigned, b); }
__device__ __forceinline__ unsigned off_b(unsigned row, unsigned ch) { return 256u * row + 16u * (ch ^ (((row & 3) << 2) | ((row >> 2) & 3))); }
__device__ __forceinline__ bf16x8 rd_row(LAS unsigned char* img, unsigned row, unsigned ks, unsigned h) { return *(const LAS bf16x8*)(img + off_b(row, 2 * ks + h)); }
__device__ __forceinline__ bf16x8 rd_tr(LAS unsigned char* img, unsigned lane, unsigned c, unsigned ks) {
    const unsigned h = lane >> 5, blk = (lane >> 4) & 1, q = (lane & 15) >> 2, p = lane & 3;
    const unsigned a0 = off_b(16 * ks + 8 * h + q, 4 * c + 2 * blk + (p >> 1)) + 8 * (p & 1);
    const unsigned a1 = off_b(16 * ks + 8 * h + 4 + q, 4 * c + 2 * blk + (p >> 1)) + 8 * (p & 1);
    const v4i16_t lo = __builtin_amdgcn_ds_read_tr16_b64_v4i16((LAS v4i16_t*)(img + a0));
    const v4i16_t hi = __builtin_amdgcn_ds_read_tr16_b64_v4i16((LAS v4i16_t*)(img + a1));
    return __builtin_shufflevector(lo, hi, 0, 1, 2, 3, 4, 5, 6, 7);
}
#define MFMA32(a, b, c) __builtin_amdgcn_mfma_f32_32x32x16_bf16((a), (b), (c), 0, 0, 0)
__device__ __forceinline__ void scan_item(Frame& F, const Args& a, int item) {
    unsigned char* ws = a.ws;
    const bool isg = item >= 128; const int it = isg ? item - 128 : item;
    int b, hd, dv0, ldq; const bf16 *Qp, *Kp; bf16* Vp; float* Sout; const float* GLp = nullptr; float sdec = 1.f;
    if (!isg) { b = it >> 4; hd = (it >> 2) & 3; dv0 = (it & 3) * 64; ldq = 512;
        Qp = (const bf16*)(ws + Z_QR) + hd * 128; Kp = (const bf16*)(ws + Z_KR) + hd * 128; Vp = (bf16*)(ws + Z_VR) + hd * 256 + dv0;
        Sout = a.out + OFF_RETP + ((size_t)(b * HR + hd) * DKR) * DVR + dv0; sdec = __expf(64.0f * __logf(1.0f - exp2f(-5.0f - (float)hd))); }
    else { b = it >> 4; hd = (it >> 1) & 7; dv0 = (it & 1) * 64; ldq = 1024;
        Qp = (const bf16*)(ws + Z_QG) + hd * 128; Kp = (const bf16*)(ws + Z_KG) + hd * 128; Vp = (bf16*)(ws + Z_VG) + hd * 128 + dv0;
        Sout = a.out + OFF_HGP + ((size_t)(b * HG + hd) * DKG) * DVG + dv0; GLp = (const float*)(ws + WS_GL) + hd * 128; }
    const int ldo = isg ? DVG : DVR;
    LAS unsigned char* QI = F.lds; LAS unsigned char* KI = QI + 16384; LAS unsigned char* VI = KI + 16384; LAS unsigned char* PI = VI + 16384; LAS unsigned char* SI = PI + 16384;
    const int tid = F.tid, lane = F.lane, w = F.wave; const unsigned r = lane & 31, h = lane >> 5;
    const int kb = w >> 1, dvb = w & 1;
    for (int i = tid; i < 16384 / 4; i += 512) ((LAS unsigned*)SI)[i] = 0u;
    f32x16 S;
#pragma unroll
    for (int i = 0; i < 16; ++i) S[i] = 0.f;
    const int qr0 = tid >> 4, qc0 = tid & 15, vr0 = tid >> 3, vc0 = tid & 7;
    const size_t rowb = (size_t)b * SEQ;
    v4u pq0, pq1, pk0, pk1, pv;
#define SCAN_LOAD(c) do { const size_t r0_ = rowb + (size_t)(c) * CH; \
        pq0 = *(const v4u*)(Qp + (r0_ + qr0) * ldq + qc0 * 8); pq1 = *(const v4u*)(Qp + (r0_ + qr0 + 32) * ldq + qc0 * 8); \
        pk0 = *(const v4u*)(Kp + (r0_ + qr0) * ldq + qc0 * 8); pk1 = *(const v4u*)(Kp + (r0_ + qr0 + 32) * ldq + qc0 * 8); \
        pv = *(const v4u*)(Vp + (r0_ + vr0) * DM + vc0 * 8); } while (0)
    SCAN_LOAD(0);
    for (int c = 0; c < SEQ / CH; ++c) {
        const size_t row0 = rowb + (size_t)c * CH;
        __syncthreads();
        *(LAS v4u*)(QI + off_b(qr0, qc0)) = pq0; *(LAS v4u*)(QI + off_b(qr0 + 32, qc0)) = pq1;
        *(LAS v4u*)(KI + off_b(qr0, qc0)) = pk0; *(LAS v4u*)(KI + off_b(qr0 + 32, qc0)) = pk1;
        *(LAS v4u*)(VI + off_b(vr0, vc0)) = pv;
        if (c > 0) {
#pragma unroll
            for (int g = 0; g < 4; ++g) { u32x2 wv; wv.x = cvtpk_s(S[4 * g], S[4 * g + 1]); wv.y = cvtpk_s(S[4 * g + 2], S[4 * g + 3]);
                *(LAS u32x2*)(SI + off_b(32 * dvb + r, 4 * kb + g) + 8 * h) = wv; }
        }
        if (c + 1 < SEQ / CH) SCAN_LOAD(c + 1);
        __syncthreads();
        {
            f32x16 d;
#pragma unroll
            for (int i = 0; i < 16; ++i) d[i] = 0.f;
#pragma unroll
            for (int ks = 0; ks < 4; ++ks) { const bf16x8 A = rd_tr(KI, lane, kb, ks); const bf16x8 B = rd_tr(VI, lane, dvb, ks); d = MFMA32(A, B, d); }
            if (isg) {
                const float* gl = GLp + ((size_t)b * (SEQ / CH) + c) * DM + 32 * kb + 4 * h;
#pragma unroll
                for (int g = 0; g < 4; ++g) { const f32x4 dc = *(const f32x4*)(gl + 8 * g);
#pragma unroll
                    for (int i = 0; i < 4; ++i) S[4 * g + i] = dc[i] * (S[4 * g + i] + d[4 * g + i]); }
            } else {
#pragma unroll
                for (int i = 0; i < 16; ++i) S[i] = sdec * (S[i] + d[i]);
            }
        }
        if (w < 3) {
            const int sb = w >> 1, tb = (w + 1) >> 1;
            f32x16 p;
#pragma unroll
            for (int i = 0; i < 16; ++i) p[i] = 0.f;
#pragma unroll
            for (int ks = 0; ks < 8; ++ks) { const bf16x8 A = rd_row(KI, 32 * sb + r, ks, h); const bf16x8 B = rd_row(QI, 32 * tb + r, ks, h); p = MFMA32(A, B, p); }
#pragma unroll
            for (int g = 0; g < 4; ++g) {
                float v[4];
#pragma unroll
                for (int i = 0; i < 4; ++i) { const int sl = 8 * g + 4 * (int)h + i; v[i] = (sb != tb || sl <= (int)r) ? p[4 * g + i] : 0.f; }
                u32x2 wv; wv.x = cvtpk_s(v[0], v[1]); wv.y = cvtpk_s(v[2], v[3]);
                *(LAS u32x2*)(PI + off_b(32 * tb + r, 4 * sb + g) + 8 * h) = wv;
            }
        }
        __syncthreads();
        if (w < 4) {
            const int ob = w >> 1, tb = w & 1;
            f32x16 o;
#pragma unroll
            for (int i = 0; i < 16; ++i) o[i] = 0.f;
#pragma unroll
            for (int ks = 0; ks < 4; ++ks) if (ks < 2 || tb == 1) { const bf16x8 A = rd_tr(VI, lane, ob, ks); const bf16x8 B = rd_row(PI, 32 * tb + r, ks, h); o = MFMA32(A, B, o); }
#pragma unroll
            for (int ks = 0; ks < 8; ++ks) { const bf16x8 A = rd_row(SI, 32 * ob + r, ks, h); const bf16x8 B = rd_row(QI, 32 * tb + r, ks, h); o = MFMA32(A, B, o); }
            bf16* orow = Vp + (row0 + 32 * tb + r) * DM + 32 * ob + 4 * h;
#pragma unroll
            for (int g = 0; g < 4; ++g) { u32x2 wv; wv.x = cvtpk_s(o[4 * g], o[4 * g + 1]); wv.y = cvtpk_s(o[4 * g + 2], o[4 * g + 3]); *(u32x2*)(orow + 8 * g) = wv; }
        }
    }
#undef SCAN_LOAD
#pragma unroll
    for (int i = 0; i < 16; ++i) { const int k = 32 * kb + (i & 3) + 8 * (i >> 2) + 4 * (int)h; Sout[(size_t)k * ldo + 32 * dvb + r] = S[i]; }
    __syncthreads();
}

__device__ __forceinline__ void decode_ret(Frame& F, const Args& a, int item) {
    unsigned char* ws = a.ws; const int n = item >> 2, h = item & 3, row = MPROMPT + n;
    LAS float* qs = (LAS float*)(F.lds); LAS float* ks = qs + 128; LAS float* red = ks + 128;
    LAS float* part = red + 8 * 256;
    const int tid = F.tid, lane = F.lane, w = F.wave;
    if (tid < 128) qs[tid] = bf2f_(((const bf16*)(ws + Z_QR))[(size_t)row * 512 + h * 128 + tid]);
    else if (tid < 256) ks[tid - 128] = bf2f_(((const bf16*)(ws + Z_KR))[(size_t)row * 512 + h * 128 + tid - 128]);
    const unsigned long long vw = *(const unsigned long long*)((const bf16*)(ws + Z_VR) + (size_t)row * DM + h * 256 + 4 * lane);
    const f32x4 v = (f32x4){bflo_((unsigned)vw), bfhi_((unsigned)vw), bflo_((unsigned)(vw >> 32)), bfhi_((unsigned)(vw >> 32))};
    const float gam = 1.0f - exp2f(-5.0f - (float)h);
    __syncthreads();
    const float* S0 = a.in[2] + ((size_t)(n * HR + h) * DKR) * DVR; float* S1 = a.out + OFF_RETS + ((size_t)(n * HR + h) * DKR) * DVR;
    f32x4 o = (f32x4){0.f, 0.f, 0.f, 0.f};
    f32x4 s[16];
#pragma unroll
    for (int i = 0; i < 16; ++i) s[i] = *(const f32x4*)(S0 + (size_t)(w + 8 * i) * DVR + 4 * lane);
#pragma unroll
    for (int i = 0; i < 16; ++i) { const int k = w + 8 * i; const f32x4 sn = s[i] * gam + v * ks[k]; *(f32x4*)(S1 + (size_t)k * DVR + 4 * lane) = sn; o += sn * qs[k]; }
    *(LAS f32x4*)(red + w * 256 + 4 * lane) = o;
    __syncthreads();
    float ov = 0.f;
    if (tid < 256) {
#pragma unroll
        for (int i = 0; i < 8; ++i) ov += red[i * 256 + tid];
        const float ss = wave_sum(ov * ov); if (lane == 0) part[w] = ss;
    }
    __syncthreads();
    if (tid < 256) {
        const float rstd = rsqrtf(((part[0] + part[1]) + (part[2] + part[3])) * (1.0f / DVR) + EPS);
        bf16* gp = (bf16*)(ws + WS_GR) + (size_t)row * DM + h * 256 + tid;
        *gp = (bf16)f2bf(ov * rstd * a.in[8][h * 256 + tid] * bf2f_(*gp));
    }
    __syncthreads();
}
__device__ __forceinline__ void decode_hg(Frame& F, const Args& a, int item) {
    unsigned char* ws = a.ws; const int n = item >> 3, h = item & 7, row = MPROMPT + n;
    LAS float* qs = (LAS float*)(F.lds); LAS float* ks = qs + 128; LAS float* fs = ks + 128; LAS float* red = fs + 128;
    LAS float* part = red + 16 * 128;
    const int tid = F.tid, lane = F.lane, w = F.wave, l32 = lane & 31, half = lane >> 5;
    if (tid < 128) qs[tid] = bf2f_(((const bf16*)(ws + Z_QG))[(size_t)row * DM + h * 128 + tid]);
    else if (tid < 256) ks[tid - 128] = bf2f_(((const bf16*)(ws + Z_KG))[(size_t)row * DM + h * 128 + tid - 128]);
    else if (tid < 384) fs[tid - 256] = ((const float*)(ws + WS_FS))[(size_t)n * DM + h * 128 + tid - 256];
    const unsigned long long vw = *(const unsigned long long*)((const bf16*)(ws + Z_VG) + (size_t)row * DM + h * 128 + 4 * l32);
    const f32x4 v = (f32x4){bflo_((unsigned)vw), bfhi_((unsigned)vw), bflo_((unsigned)(vw >> 32)), bfhi_((unsigned)(vw >> 32))};
    __syncthreads();
    const float* S0 = a.in[3] + ((size_t)(n * HG + h) * DKG) * DVG; float* S1 = a.out + OFF_HGS + ((size_t)(n * HG + h) * DKG) * DVG;
    f32x4 o = (f32x4){0.f, 0.f, 0.f, 0.f};
    f32x4 s[8];
#pragma unroll
    for (int i = 0; i < 8; ++i) s[i] = *(const f32x4*)(S0 + (size_t)(2 * (w + 8 * i) + half) * DVG + 4 * l32);
#pragma unroll
    for (int i = 0; i < 8; ++i) { const int k = 2 * (w + 8 * i) + half; const f32x4 sn = s[i] * fs[k] + v * ks[k]; *(f32x4*)(S1 + (size_t)k * DVG + 4 * l32) = sn; o += sn * qs[k]; }
    *(LAS f32x4*)(red + (2 * w + half) * 128 + 4 * l32) = o;
    __syncthreads();
    float ov = 0.f;
    if (tid < 128) {
#pragma unroll
        for (int i = 0; i < 16; ++i) ov += red[i * 128 + tid];
        const float ss = wave_sum(ov * ov); if (lane == 0) part[w] = ss;
    }
    __syncthreads();
    if (tid < 128) {
        const float rstd = rsqrtf((part[0] + part[1]) * (1.0f / DVG) + EPS);
        bf16* gp = (bf16*)(ws + WS_GG) + (size_t)row * DM + h * 128 + tid;
        *gp = (bf16)f2bf(ov * rstd * a.in[9][h * 128 + tid] * bf2f_(*gp));
    }
    __syncthreads();
}

__device__ __forceinline__ void p3_headnorm(Frame& F, const Args& a) {
    unsigned char* ws = a.ws; const int gw = F.vcu * NWAVES + F.wave, NGW = F.G * NWAVES, lane = F.lane;
    for (int it = gw; it < MPROMPT * 8; it += NGW) {
        const bool isg = it >= MPROMPT * 4; const int i2 = isg ? it - MPROMPT * 4 : it; const int row = i2 >> 2, q = i2 & 3;
        const size_t off = (size_t)row * DM + q * 256 + 4 * lane;
        const unsigned long long ow = *(const unsigned long long*)((const bf16*)(ws + (isg ? Z_VG : Z_VR)) + off);
        unsigned long long* gp = (unsigned long long*)((bf16*)(ws + (isg ? WS_GG : WS_GR)) + off); const unsigned long long gwd = *gp;
        const f32x4 gn = *(const f32x4*)(a.in[isg ? 9 : 8] + q * 256 + 4 * lane);
        const f32x4 o = (f32x4){bflo_((unsigned)ow), bfhi_((unsigned)ow), bflo_((unsigned)(ow >> 32)), bfhi_((unsigned)(ow >> 32))};
        const f32x4 gt = (f32x4){bflo_((unsigned)gwd), bfhi_((unsigned)gwd), bflo_((unsigned)(gwd >> 32)), bfhi_((unsigned)(gwd >> 32))};
        float ss = (o.x * o.x + o.y * o.y) + (o.z * o.z + o.w * o.w);
#pragma unroll
        for (int d = 1; d < 32; d <<= 1) ss += __shfl_xor(ss, d);
        if (!isg) ss += __shfl_xor(ss, 32);
        const float rstd = rsqrtf(ss * (isg ? 1.0f / DVG : 1.0f / DVR) + EPS);
        const f32x4 x = o * rstd * gn * gt;
        *gp = (unsigned long long)pk2(x.x, x.y) | ((unsigned long long)pk2(x.z, x.w) << 32);
    }
}

__device__ __forceinline__ void p9_final(Frame& F, const Args& a) {
    const int gw = F.vcu * NWAVES + F.wave, NGW = F.G * NWAVES, lane = F.lane; const float* PS3 = (const float*)(a.ws + WS_PS3); const float* gf = a.in[20];
    for (int m = gw; m < MTOT; m += NGW) {
        const float pv = lane < 16 ? PS3[(size_t)m * 16 + lane] : 0.f; const float rstd = rsqrtf(wave_sum(pv) * (1.0f / DM) + EPS);
        f32x4* r = (f32x4*)(a.out + (size_t)m * DM) + lane;
#pragma unroll
        for (int j = 0; j < 4; ++j) { const f32x4 gv = *((const f32x4*)gf + 64 * j + lane); r[64 * j] = r[64 * j] * rstd * gv; }
    }
}

__global__ void __launch_bounds__(NWAVES * 64, 2) fwd_kernel(Args args) {
    extern __shared__ __attribute__((aligned(16))) unsigned char lds[];
    Frame F;
    F.lds = (LAS unsigned char*)lds;
    F.MISC = (volatile LAS unsigned*)(F.lds + MISC_OFF);
    F.tid = threadIdx.x; F.lane = F.tid & 63; F.wave = __builtin_amdgcn_readfirstlane(F.tid >> 6);
    F.G = gridDim.x; { const int bx = blockIdx.x; F.vcu = (F.G % 8 == 0) ? (bx % 8) * (F.G / 8) + bx / 8 : bx; }
    unsigned char* ws = args.ws;
    F.ctl = (gu32*)(ws + WS_CTL);
    for (int u = F.tid; u < (LDS_BYTES - LDSCTL_OFF) / 4; u += NWAVES * 64) ((LAS unsigned*)(F.lds + LDSCTL_OFF))[u] = 0u;
    __syncthreads();
    XcdBarrier bar; bar.bar = (unsigned*)(F.ctl + CW_BAR); bar.x = 0; bar.st = nullptr;
    if (args.use_bar) bar = xcd_barrier_post((unsigned*)(F.ctl + CW_BAR), F.MISC + 8);
    const int lo = args.ph_lo, hi = args.ph_hi;
#define IN(k) (lo <= (k) && (k) < hi)
#define SEAM(k) do { if (IN(k) && IN((k) + 1)) xcd_barrier(bar); } while (0)
    using namespace pg8;
    bf16_t* XB = (bf16_t*)(args.out + OFF_RETS);
    bf16_t* AR = (bf16_t*)(args.out + OFF_Y); bf16_t* AH = AR + (size_t)MTOT * DM;
    float* R = args.out + OFF_Y;
    float* PS1 = (float*)(ws + WS_PS1); float* PS2 = (float*)(ws + WS_PS2); float* PS3 = (float*)(ws + WS_PS3);

    if (IN(0)) { p0_prologue(F, args); SEAM(0); }
    if (IN(1)) {
        Gemm g{XB, (const bf16_t*)(ws + WS_WIN), MP, DIN, DM}; StaticOrder S; S.init(MP, DIN, F.G, (int)blockIdx.x);
        EpiIn E{(const float*)(ws + WS_RSTD0), (const float*)(ws + WS_CS), (const float*)(ws + WS_LB),
                (bf16_t*)(ws + Z_QR), (bf16_t*)(ws + Z_KR), (bf16_t*)(ws + Z_VR), (bf16_t*)(ws + WS_GR), (bf16_t*)(ws + Z_QG), (bf16_t*)(ws + Z_KG), (bf16_t*)(ws + Z_VG), (bf16_t*)(ws + WS_GG),
                AR, AH, (float*)(ws + WS_GL), (float*)(ws + WS_FS)};
        gemm_phase<EpiIn, StaticOrder, true, true>(F.lds + RING_OFF, g, S, E);
        SEAM(1);
    }
    if (IN(2)) {
        for (int it = F.vcu; it < 256; it += F.G) scan_item(F, args, it);
        for (int it = F.vcu; it < NDEC * HR; it += F.G) decode_ret(F, args, it);
        for (int it = F.vcu; it < NDEC * HG; it += F.G) decode_hg(F, args, it);
        SEAM(2);
    }
    if (IN(3)) { p3_headnorm(F, args); SEAM(3); }
    if (IN(4)) {
        { Gemm g{(const bf16_t*)(ws + WS_GG), (const bf16_t*)(ws + WS_WUPH), MP, DM, DM}; StaticOrder S; S.init(MP, DM, F.G, (int)blockIdx.x);
          EpiN<0> E{AH, (bf16_t*)(ws + WS_MB), DM, nullptr, nullptr, nullptr, nullptr, nullptr, nullptr};
          gemm_phase<EpiN<0>, StaticOrder, true, true>(F.lds + RING_OFF, g, S, E); }
        { Gemm g{(const bf16_t*)(ws + WS_GR), (const bf16_t*)(ws + WS_WUPR), MP, DM, DM}; StaticOrder S; S.init(MP, DM, F.G, (int)blockIdx.x);
          EpiN<1> E{AR, (bf16_t*)(ws + WS_MB), DM, nullptr, nullptr, nullptr, nullptr, nullptr, nullptr};
          gemm_phase<EpiN<1>, StaticOrder, true, true>(F.lds + RING_OFF, g, S, E); }
        SEAM(4);
    }
    if (IN(5)) {
        Gemm g{(const bf16_t*)(ws + WS_MB), (const bf16_t*)(ws + WS_WO), MP, DM, DM}; StaticOrder S; S.init(MP, DM, F.G, (int)blockIdx.x);
        EpiN<2> E{nullptr, (bf16_t*)(ws + WS_A5), DM, args.in[0], args.in[1], R, args.in[14], PS1, nullptr};
        gemm_phase<EpiN<2>, StaticOrder, true, true>(F.lds + RING_OFF, g, S, E);
        SEAM(5);
    }
    if (IN(6)) {
        Gemm g{(const bf16_t*)(ws + WS_A5), (const bf16_t*)(ws + WS_WFF1), MP, DFF, DM}; StaticOrder S; S.init(MP, DFF, F.G, (int)blockIdx.x);
        EpiN<3> E{nullptr, (bf16_t*)(ws + WS_H), DFF, nullptr, nullptr, nullptr, nullptr, nullptr, PS1};
        gemm_phase<EpiN<3>, StaticOrder, true, true>(F.lds + RING_OFF, g, S, E);
        SEAM(6);
    }
    if (IN(7)) {
        Gemm g{(const bf16_t*)(ws + WS_H), (const bf16_t*)(ws + WS_WFF2), MP, DM, DFF}; StaticOrder S; S.init(MP, DM, F.G, (int)blockIdx.x);
        EpiN<2> E{nullptr, (bf16_t*)(ws + WS_A7), DM, R, nullptr, R, args.in[17], PS2, nullptr};
        gemm_phase<EpiN<2>, StaticOrder, true, true>(F.lds + RING_OFF, g, S, E);
        SEAM(7);
    }
    if (IN(8)) {
        { Gemm g{(const bf16_t*)(ws + WS_A7), (const bf16_t*)(ws + WS_WGATE), MP, DM, DM}; StaticOrder S; S.init(MP, DM, F.G, (int)blockIdx.x);
          EpiN<4> E{nullptr, (bf16_t*)(ws + WS_MB), DM, nullptr, nullptr, nullptr, nullptr, nullptr, PS2};
          gemm_phase<EpiN<4>, StaticOrder, true, true>(F.lds + RING_OFF, g, S, E); }
        { Gemm g{(const bf16_t*)(ws + WS_PB), (const bf16_t*)(ws + WS_WPROJ), MP, DM, DPLE}; StaticOrder S; S.init(MP, DM, F.G, (int)blockIdx.x);
          EpiN<5> E{nullptr, (bf16_t*)(ws + WS_MB), DM, nullptr, nullptr, R, nullptr, PS3, nullptr};
          gemm_phase<EpiN<5>, StaticOrder, true, true>(F.lds + RING_OFF, g, S, E); }
        SEAM(8);
    }
    if (IN(9)) { p9_final(F, args); }
#undef IN
#undef SEAM
}

extern "C" void kernel_launch(void* const* d_in, const int* in_sizes, int n_in, void* d_out, int out_size, void* d_ws, size_t ws_size, hipStream_t stream) {
    static int grid = 0;
    if (grid == 0) {
        if (n_in != 21 || out_size != (int)OUT_TOTAL || ws_size < WS_END) { fprintf(stderr, "kernel_launch: unexpected problem (n_in %d out %d ws %zu need %zu)\n", n_in, out_size, ws_size, (size_t)WS_END); grid = -1; return; }
        int dev = 0, cus = 0;
        if (hipGetDevice(&dev) != hipSuccess || hipDeviceGetAttribute(&cus, hipDeviceAttributeMultiprocessorCount, dev) != hipSuccess) { grid = -1; return; }
        if (hipFuncSetAttribute((const void*)fwd_kernel, hipFuncAttributeMaxDynamicSharedMemorySize, LDS_BYTES) != hipSuccess) { fprintf(stderr, "kernel_launch: hipFuncSetAttribute failed\n"); grid = -1; return; }
        (void)hipGetLastError();
        grid = cus;
    }
    if (grid < 0) return;
    (void)hipMemsetAsync((char*)d_ws + WS_CTL, 0, CTL_ZERO_BYTES, stream);
    Args a{};
    for (int i = 0; i < 21; ++i) a.in[i] = (const float*)d_in[i];
    a.out = (float*)d_out; a.ws = (unsigned char*)d_ws;
#if MK_ONE_LAUNCH
    a.ph_lo = 0; a.ph_hi = NPH; a.use_bar = 1;
    hipLaunchKernelGGL(fwd_kernel, dim3(grid), dim3(NWAVES * 64), LDS_BYTES, stream, a);
#else
    for (int p = 0; p < NPH; ++p) { a.ph_lo = p; a.ph_hi = p + 1; a.use_bar = 0; hipLaunchKernelGGL(fwd_kernel, dim3(grid), dim3(NWAVES * 64), LDS_BYTES, stream, a); }
#endif
}
```

```cpp
#include <hip/hip_runtime.h>
#include <cstdio>
#include <cstdint>
namespace pg8 {
#define PG8_LAS __attribute__((address_space(3)))
typedef unsigned short bf16_t;
typedef short bf16x8 __attribute__((ext_vector_type(8)));
typedef float f32x4 __attribute__((ext_vector_type(4)));
typedef unsigned u32x4 __attribute__((ext_vector_type(4)));
constexpr int BM = 256, BK = 64, HALF = 128, HTB = HALF * BK * 2  , STAGE_BYTES = 8 * HTB, NXCD = 8, WGM = 8;

__host__ __device__ __forceinline__ int lds_byte(int r, int c) { const int st = (r >> 4) * 2 + (c >> 5), rr = r & 15, cc = c & 31, ob = rr * 64 + cc * 2; return st * 1024 + (ob ^ (((ob >> 9) & 1) << 5)); }
__host__ __device__ __forceinline__ void stage_rc(int b, int& R, int& C) { const int st = b / 1024, sb = b % 1024, swz = sb ^ (((sb >> 9) & 1) << 5); R = (st >> 1) * 16 + swz / 64; C = (st & 1) * 32 + (swz % 64) / 2; }
__host__ __device__ __forceinline__ int perm32(int rho) { const int n = rho >> 4, i = rho & 15; return 8 * (i >> 2) + 4 * n + (i & 3); }

struct Unit { int pm, pn; };
struct Gemm { const bf16_t* A; const bf16_t* Bt; int M, N, K; };

struct StaticOrder {
    int nM, nN, nwg, G, c;
    __host__ __device__ void init(int M, int N, int G_, int c_) { nM = M / BM; nN = N / BM; nwg = nM * nN; G = G_; c = c_; }
    __host__ __device__ bool next(int i, Unit& u) const {
        const long L = (long)i * G + c; if (L >= nwg) return false;
        int wgid = (int)L; { const int q = nwg / NXCD, r = nwg % NXCD, xcd = wgid % NXCD, off = wgid / NXCD; wgid = (xcd < r ? xcd * (q + 1) : r * (q + 1) + (xcd - r) * q) + off; }
        const int nig = WGM * nN, gid = wgid / nig, fm = gid * WGM, gsz = (nM - fm) < WGM ? (nM - fm) : WGM;
        u.pm = fm + ((wgid % nig) % gsz); u.pn = (wgid % nig) / gsz; return true;
    }
    __device__ __forceinline__ void a_ready(const Unit&) const {}
    __device__ __forceinline__ void done(const Unit&) const {}
};

__device__ __forceinline__ unsigned cvt_pk_bf16(float lo, float hi) { unsigned r; asm volatile("v_cvt_pk_bf16_f32 %0, %1, %2" : "=v"(r) : "v"(lo), "v"(hi)); return r; }

template <class Epi, class Sched, bool ALIGN_EPI = false, bool SP2 = false>
__device__ __forceinline__ void gemm_phase(PG8_LAS unsigned char* lds, const Gemm g, const Sched& S, const Epi& E) {
    const int tid = threadIdx.x, wid = __builtin_amdgcn_readfirstlane(tid >> 6), lane = tid & 63, wr = wid >> 2, wc = wid & 3, fr = lane & 15, fq = lane >> 4;
    const int K = g.K, nt = K / BK;
    unsigned voffA[2], voffB[2];
#pragma unroll
    for (int i = 0; i < 2; ++i) { int R, C; stage_rc(tid * 16 + i * 8192, R, C); const int Rb = Epi::PERM ? ((R & ~31) + perm32(R & 31)) : R;
        voffA[i] = (unsigned)(R * K + C) * 2u; voffB[i] = (unsigned)(Rb * K + C) * 2u; }
    const size_t kstep = (size_t)(BK * 2);
    const size_t hstep = (size_t)HALF * K * 2;
    const size_t tstep = 2 * hstep;
    const unsigned ldsw = (unsigned)wid * 1024u;
    const int aoff = lds_byte(wr * 64 + fr, fq * 8), boff = lds_byte(wc * 32 + fr, fq * 8);
#define PG8_SA(b, h) (((b) * 2 + (h)) * HTB)
#define PG8_SB(b, h) ((4 + (b) * 2 + (h)) * HTB)
#define PG8_STAGE(bufoff, gbase, voff) do { _Pragma("unroll") for (int _i = 0; _i < 2; ++_i) \
        __builtin_amdgcn_global_load_lds((const unsigned*)((const char*)(gbase) + (voff)[_i]), (PG8_LAS unsigned*)(lds + (bufoff) + ldsw + _i * 8192), 16, 0, 0); } while (0)
#define PG8_LDA(dst, b, h) do { _Pragma("unroll") for (int m = 0; m < 4; ++m) _Pragma("unroll") for (int k = 0; k < 2; ++k) dst[m][k] = *(const PG8_LAS bf16x8*)(lds + PG8_SA(b, h) + aoff + m * 2048 + k * 1024); } while (0)
#define PG8_LDB(dst, b, h) do { _Pragma("unroll") for (int n = 0; n < 2; ++n) _Pragma("unroll") for (int k = 0; k < 2; ++k) dst[n][k] = *(const PG8_LAS bf16x8*)(lds + PG8_SB(b, h) + boff + n * 2048 + k * 1024); } while (0)
#define PG8_MMA(ai, bj, At, Bt) do { __builtin_amdgcn_s_setprio(1); _Pragma("unroll") for (int m = 0; m < 4; ++m) _Pragma("unroll") for (int n = 0; n < 2; ++n) _Pragma("unroll") for (int k = 0; k < 2; ++k) \
        acc[ai][bj][m][n] = __builtin_amdgcn_mfma_f32_16x16x32_bf16(Bt[n][k], At[m][k], acc[ai][bj][m][n], 0, 0, 0); __builtin_amdgcn_s_setprio(0); } while (0)
#define PG8_WAIT_V(n) asm volatile("s_waitcnt vmcnt(" #n ")" ::: "memory")
#define PG8_WAIT_L(n) asm volatile("s_waitcnt lgkmcnt(" #n ")" ::: "memory")
#define PG8_BAR __builtin_amdgcn_s_barrier()
#define PG8_SCHED __builtin_amdgcn_sched_barrier(0)
    Unit cur, nxt; int ui = 0;
    if (!S.next(0, cur)) return;
    f32x4 acc[2][2][4][2];
#pragma unroll
    for (int a = 0; a < 2; ++a)
#pragma unroll
        for (int b = 0; b < 2; ++b)
#pragma unroll
            for (int m = 0; m < 4; ++m)
#pragma unroll
                for (int n = 0; n < 2; ++n) acc[a][b][m][n] = (f32x4){0.f, 0.f, 0.f, 0.f};
    bf16x8 At[4][2], B0[2][2], B1[2][2];
    const char* cA = (const char*)g.A + (size_t)cur.pm * tstep; const char* cB = (const char*)g.Bt + (size_t)cur.pn * tstep;
    S.a_ready(cur);
    if constexpr (SP2) {
        PG8_STAGE(PG8_SB(0, 0), cB, voffB); PG8_STAGE(PG8_SB(0, 1), cB + hstep, voffB); PG8_STAGE(PG8_SA(0, 0), cA, voffA); PG8_STAGE(PG8_SA(0, 1), cA + hstep, voffA);
        if (wr == 1) PG8_BAR;
        PG8_WAIT_V(2); PG8_BAR;
        PG8_STAGE(PG8_SB(1, 0), cB + kstep, voffB); PG8_STAGE(PG8_SA(1, 0), cA + kstep, voffA); PG8_STAGE(PG8_SB(1, 1), cB + hstep + kstep, voffB);
        PG8_WAIT_V(6); PG8_BAR;
    } else {
        PG8_STAGE(PG8_SB(0, 0), cB, voffB); PG8_STAGE(PG8_SA(0, 0), cA, voffA); PG8_STAGE(PG8_SB(0, 1), cB + hstep, voffB); PG8_STAGE(PG8_SA(0, 1), cA + hstep, voffA);
        if (wr == 1) PG8_BAR;
        PG8_WAIT_V(4); PG8_BAR;
        PG8_STAGE(PG8_SB(1, 0), cB + kstep, voffB); PG8_STAGE(PG8_SA(1, 0), cA + kstep, voffA); PG8_STAGE(PG8_SB(1, 1), cB + hstep + kstep, voffB);
        PG8_WAIT_V(6); PG8_BAR;
    }
    for (;;) {
        const bool has_next = S.next(ui + 1, nxt);
        const char* nA = has_next ? (const char*)g.A + (size_t)nxt.pm * tstep : cA; const char* nB = has_next ? (const char*)g.Bt + (size_t)nxt.pn * tstep : cB;
        for (int t = 0; t < nt; t += 2) {
            const bool last = (t == nt - 2);
            const char* a1 = cA + (size_t)(t + 1) * kstep;
            const char* a2 = last ? nA : cA + (size_t)(t + 2) * kstep; const char* b2 = last ? nB : cB + (size_t)(t + 2) * kstep;
            const char* a3 = a2 + kstep; const char* b3 = b2 + kstep;
            if (last && has_next) S.a_ready(nxt);
            if constexpr (SP2) {
            PG8_LDB(B0, 0, 0); PG8_LDB(B1, 0, 1); PG8_SCHED; PG8_LDA(At, 0, 0); PG8_STAGE(PG8_SA(1, 1), a1 + hstep, voffA);
            PG8_WAIT_V(8); PG8_WAIT_L(0); PG8_BAR; PG8_MMA(0, 0, At, B0); PG8_MMA(0, 1, At, B1); PG8_BAR; PG8_SCHED;
            PG8_LDA(At, 0, 1); PG8_STAGE(PG8_SB(0, 0), b2, voffB); PG8_STAGE(PG8_SB(0, 1), b2 + hstep, voffB); PG8_STAGE(PG8_SA(0, 0), a2, voffA);
            PG8_WAIT_V(8); PG8_WAIT_L(0); PG8_BAR; PG8_MMA(1, 0, At, B0); PG8_MMA(1, 1, At, B1); PG8_BAR; PG8_SCHED;
            PG8_LDB(B0, 1, 0); PG8_LDB(B1, 1, 1); PG8_SCHED; PG8_LDA(At, 1, 0); PG8_STAGE(PG8_SA(0, 1), a2 + hstep, voffA);
            PG8_WAIT_V(8); PG8_WAIT_L(0); PG8_BAR; PG8_MMA(0, 0, At, B0); PG8_MMA(0, 1, At, B1); PG8_BAR; PG8_SCHED;
            PG8_LDA(At, 1, 1); PG8_STAGE(PG8_SB(1, 0), b3, voffB); PG8_STAGE(PG8_SB(1, 1), b3 + hstep, voffB); PG8_STAGE(PG8_SA(1, 0), a3, voffA);
            PG8_WAIT_V(8); PG8_WAIT_L(0); PG8_BAR; PG8_MMA(1, 0, At, B0); PG8_MMA(1, 1, At, B1); PG8_BAR; PG8_SCHED;
            } else {
            PG8_LDB(B0, 0, 0); PG8_SCHED; PG8_LDA(At, 0, 0); PG8_STAGE(PG8_SA(1, 1), a1 + hstep, voffA);
            PG8_WAIT_L(8); PG8_BAR; PG8_WAIT_L(0); PG8_MMA(0, 0, At, B0); PG8_BAR; PG8_SCHED;
            PG8_LDB(B1, 0, 1); PG8_STAGE(PG8_SB(0, 0), b2, voffB);
            PG8_BAR; PG8_WAIT_L(0); PG8_MMA(0, 1, At, B1); PG8_BAR;
            PG8_LDA(At, 0, 1); PG8_STAGE(PG8_SA(0, 0), a2, voffA);
            PG8_BAR; PG8_WAIT_L(0); PG8_MMA(1, 0, At, B0); PG8_BAR; PG8_SCHED;
            PG8_STAGE(PG8_SB(0, 1), b2 + hstep, voffB);
            PG8_WAIT_V(6); PG8_BAR; PG8_MMA(1, 1, At, B1); PG8_BAR;
            PG8_LDB(B0, 1, 0); PG8_SCHED; PG8_LDA(At, 1, 0); PG8_STAGE(PG8_SA(0, 1), a2 + hstep, voffA);
            PG8_WAIT_L(8); PG8_BAR; PG8_WAIT_L(0); PG8_MMA(0, 0, At, B0); PG8_BAR; PG8_SCHED;
            PG8_LDB(B1, 1, 1); PG8_STAGE(PG8_SB(1, 0), b3, voffB);
            PG8_BAR; PG8_WAIT_L(0); PG8_MMA(0, 1, At, B1); PG8_BAR;
            PG8_LDA(At, 1, 1); PG8_STAGE(PG8_SA(1, 0), a3, voffA);
            PG8_BAR; PG8_WAIT_L(0); PG8_MMA(1, 0, At, B0); PG8_BAR; PG8_SCHED;
            PG8_STAGE(PG8_SB(1, 1), b3 + hstep, voffB);
            PG8_WAIT_V(6); PG8_BAR; PG8_MMA(1, 1, At, B1); PG8_BAR;
            }
        }
        if constexpr (ALIGN_EPI) { if (wr == 0) PG8_BAR; }
        if constexpr (!Epi::AFTER_DRAIN) { E(acc, cur, wr, wc, fr, fq); S.done(cur); }
        if (!has_next) break;
#pragma unroll
        for (int a = 0; a < 2; ++a)
#pragma unroll
            for (int b = 0; b < 2; ++b)
#pragma unroll
                for (int m = 0; m < 4; ++m)
#pragma unroll
                    for (int n = 0; n < 2; ++n) acc[a][b][m][n] = (f32x4){0.f, 0.f, 0.f, 0.f};
        cur = nxt; cA = nA; cB = nB; ++ui;
        if constexpr (ALIGN_EPI) { if (wr == 1) PG8_BAR; }
    }
    PG8_WAIT_V(0);
    if constexpr (!ALIGN_EPI) { if (wr == 0) PG8_BAR; }
    PG8_BAR;
    if constexpr (Epi::AFTER_DRAIN) { E.fused(acc, cur, wr, wc, fr, fq, lds, wid, lane); S.done(cur); }
#undef PG8_SA
#undef PG8_SB
#undef PG8_STAGE
#undef PG8_LDA
#undef PG8_LDB
#undef PG8_MMA
#undef PG8_WAIT_V
#undef PG8_WAIT_L
#undef PG8_BAR
#undef PG8_SCHED
}
}


constexpr int DM = 1024, NB = 8, SEQ = 2048, NDEC = 128, MPROMPT = NB * SEQ, MTOT = MPROMPT + NDEC, MP = 16640  ;
constexpr int HR = 4, DKR = 128, DVR = 256, HG = 8, DKG = 128, DVG = 128, DFF = 4096, DPLE = 256, DIN = 9216, CH = 64, NCHUNK = MPROMPT / CH;
constexpr float EPS = 1e-6f;
constexpr size_t OFF_Y = 0, OFF_RETP = (size_t)MTOT * DM, OFF_HGP = OFF_RETP + (size_t)NB * HR * DKR * DVR, OFF_RETS = OFF_HGP + (size_t)NB * HG * DKG * DVG,
                 OFF_HGS = OFF_RETS + (size_t)NDEC * HR * DKR * DVR, OUT_TOTAL = OFF_HGS + (size_t)NDEC * HG * DKG * DVG;
static_assert(OUT_TOTAL == 52559872, "output size");

namespace pg8 {
typedef unsigned u32x2 __attribute__((ext_vector_type(2)));
typedef float f32x2 __attribute__((ext_vector_type(2)));
__device__ __forceinline__ float bf2f(unsigned short b) { return __uint_as_float((unsigned)b << 16); }
__device__ __forceinline__ float bflo(unsigned w) { return __uint_as_float(w << 16); }
__device__ __forceinline__ float bfhi(unsigned w) { return __uint_as_float(w & 0xffff0000u); }
__device__ __forceinline__ float sigmoidf_(float x) { return 1.0f / (1.0f + __expf(-x)); }
__device__ __forceinline__ float siluf_(float x) { return x / (1.0f + __expf(-x)); }
__device__ __forceinline__ u32x2 pack4(f32x4 v) { u32x2 w; w.x = cvt_pk_bf16(v[0], v[1]); w.y = cvt_pk_bf16(v[2], v[3]); return w; }
__device__ __forceinline__ f32x4 unpack4(u32x2 w) { return (f32x4){bflo(w.x), bfhi(w.x), bflo(w.y), bfhi(w.y)}; }

struct EpiIn {
    static constexpr bool PERM = false, AFTER_DRAIN = false;
    const float* rstd0; const float* cs; const float* lb;
    bf16_t *QR, *KR, *VR, *GR, *QG, *KG, *VG, *GG, *AR, *AH; float *GL, *FS;
    __device__ __forceinline__ void operator()(const f32x4 (&acc)[2][2][4][2], const Unit& u, int wr, int wc, int fr, int fq) const {
        const int pn = u.pn;
#pragma unroll
        for (int ai = 0; ai < 2; ++ai) {
            const int rbase = u.pm * BM + ai * HALF + wr * 64;
            constexpr bool samp = false;
            float rs[4];
#pragma unroll
            for (int m = 0; m < 4; ++m) rs[m] = rstd0[rbase + m * 16 + fr];
            if (pn < 4) {
                const bool isk = pn >= 2; bf16_t* dst = isk ? KR : QR;
#pragma unroll
                for (int bj = 0; bj < 2; ++bj) {
                    const int head = 2 * (pn & 1) + bj;
                    const float lg = __logf(1.0f - exp2f(-5.0f - (float)head));
                    float sc[4];
#pragma unroll
                    for (int m = 0; m < 4; ++m) { const float e = lg * (float)(m * 16 + fr + 1);
                        sc[m] = samp ? (isk ? 0.08838834764831845f : 1.0f) : (isk ? 0.08838834764831845f * __expf(-e) : __expf(e)); }
#pragma unroll
                    for (int m = 0; m < 4; ++m) {
                        const int row = rbase + m * 16 + fr; const int pidx = samp ? SEQ : (row & (SEQ - 1));
#pragma unroll
                        for (int n = 0; n < 2; ++n) {
                            const int j = 16 * wc + 8 * n + 2 * fq;
                            const f32x4 t = *(const f32x4*)(cs + ((size_t)pidx * 64 + j) * 2);
                            const f32x4 v = acc[ai][bj][m][n] * (rs[m] * sc[m]);
                            const float o1a = v[0] * t[0] - v[1] * t[1], o2a = v[0] * t[1] + v[1] * t[0];
                            const float o1b = v[2] * t[2] - v[3] * t[3], o2b = v[2] * t[3] + v[3] * t[2];
                            bf16_t* p = dst + (size_t)row * 512 + head * 128 + j;
                            *(unsigned*)p = cvt_pk_bf16(o1a, o1b); *(unsigned*)(p + 64) = cvt_pk_bf16(o2a, o2b);
                        }
                    }
                }
            } else if (pn >= 12 && pn < 20) {
                const int head = pn - 12;
#pragma unroll
                for (int bj = 0; bj < 2; ++bj)
#pragma unroll
                    for (int n = 0; n < 2; ++n) {
                        const int j = 64 * bj + 16 * wc + 8 * n + 2 * fq, c = head * 128 + j;
                        float qa[4][2], ka[4][2], ba[4][2];
#pragma unroll
                        for (int e = 0; e < 2; ++e) {
                            const float one_m_lb = 1.0f - lb[c + e]; float carry = 0.f;
#pragma unroll
                            for (int m = 0; m < 4; ++m) {
                                const float vq = acc[ai][bj][m][n][2 * e] * rs[m], vf = acc[ai][bj][m][n][2 * e + 1] * rs[m];
                                const float kk = one_m_lb / (1.0f + __expf(vf));
                                float x = __logf(1.0f - kk);
                                if (!samp) {
#pragma unroll
                                    for (int d = 1; d < 16; d <<= 1) { const float y = __shfl_up(x, d, 16); if (fr >= d) x += y; }
                                    x += carry; carry = __shfl(x, 15, 16);
                                }
                                qa[m][e] = siluf_(vq); ka[m][e] = kk; ba[m][e] = x;
                            }
                        }
#pragma unroll
                        for (int m = 0; m < 4; ++m) {
                            const int row = rbase + m * 16 + fr;
                            if (samp) {
                                *(unsigned*)(QG + (size_t)row * DM + c) = cvt_pk_bf16(qa[m][0], qa[m][1]);
                                *(unsigned*)(KG + (size_t)row * DM + c) = cvt_pk_bf16(ka[m][0], ka[m][1]);
                                *(f32x2*)(FS + (size_t)(row - MPROMPT) * DM + c) = (f32x2){1.0f - ka[m][0], 1.0f - ka[m][1]};
                            } else {
                                const float e0 = __expf(ba[m][0]), e1 = __expf(ba[m][1]);
                                *(unsigned*)(QG + (size_t)row * DM + c) = cvt_pk_bf16(qa[m][0] * e0, qa[m][1] * e1);
                                *(unsigned*)(KG + (size_t)row * DM + c) = cvt_pk_bf16(ka[m][0] * __expf(-ba[m][0]), ka[m][1] * __expf(-ba[m][1]));
                                if (m == 3 && fr == 15) *(f32x2*)(GL + (size_t)(row >> 6) * DM + c) = (f32x2){e0, e1};
                            }
                        }
                    }
            } else {
                int mode, cbase; bf16_t* dst;
                if (pn < 8) { dst = VR; cbase = (pn - 4) * BM; mode = 0; } else if (pn < 12) { dst = GR; cbase = (pn - 8) * BM; mode = 1; }
                else if (pn < 24) { dst = VG; cbase = (pn - 20) * BM; mode = 0; } else if (pn < 28) { dst = GG; cbase = (pn - 24) * BM; mode = 1; }
                else if (pn < 32) { dst = AR; cbase = (pn - 28) * BM; mode = 2; } else { dst = AH; cbase = (pn - 32) * BM; mode = 2; }
#pragma unroll
                for (int m = 0; m < 4; ++m) {
                    const int row = rbase + m * 16 + fr;
#pragma unroll
                    for (int bj = 0; bj < 2; ++bj)
#pragma unroll
                        for (int n = 0; n < 2; ++n) {
                            f32x4 v = acc[ai][bj][m][n] * rs[m];
                            if (mode == 1) { v[0] = siluf_(v[0]); v[1] = siluf_(v[1]); v[2] = siluf_(v[2]); v[3] = siluf_(v[3]); }
                            else if (mode == 2) { v[0] = sigmoidf_(v[0]); v[1] = sigmoidf_(v[1]); v[2] = sigmoidf_(v[2]); v[3] = sigmoidf_(v[3]); }
                            *(u32x2*)(dst + (size_t)row * DM + cbase + bj * HALF + wc * 32 + n * 16 + fq * 4) = pack4(v);
                        }
                }
            }
        }
    }
};

template <int MODE> struct EpiN {
    static constexpr bool PERM = false, AFTER_DRAIN = false;
    const bf16_t* gate; bf16_t* out16; int ld16; const float* xp; const float* xs; float* R; const float* g; float* PS; const float* PSin;
    __device__ __forceinline__ void operator()(const f32x4 (&acc)[2][2][4][2], const Unit& u, int wr, int wc, int fr, int fq) const {
#pragma unroll
        for (int ai = 0; ai < 2; ++ai) {
            const int rbase = u.pm * BM + ai * HALF + wr * 64;
#pragma unroll
            for (int m = 0; m < 4; ++m) {
                const int row = rbase + m * 16 + fr;
                float rstd = 1.f;
                if (MODE == 3 || MODE == 4) {
                    const f32x4* p = (const f32x4*)(PSin + (size_t)row * 16); const f32x4 a = p[0], b = p[1], c = p[2], d = p[3];
                    const float s = ((a[0] + a[1]) + (a[2] + a[3])) + ((b[0] + b[1]) + (b[2] + b[3])) + ((c[0] + c[1]) + (c[2] + c[3])) + ((d[0] + d[1]) + (d[2] + d[3]));
                    rstd = rsqrtf(s * (1.0f / 1024.0f) + EPS);
                }
                float ss = 0.f;
#pragma unroll
                for (int bj = 0; bj < 2; ++bj)
#pragma unroll
                    for (int n = 0; n < 2; ++n) {
                        const int col = u.pn * BM + bj * HALF + wc * 32 + n * 16 + fq * 4;
                        const f32x4 a = acc[ai][bj][m][n];
                        if (MODE == 0) { const f32x4 gt = unpack4(*(const u32x2*)(gate + (size_t)row * DM + col)); *(u32x2*)(out16 + (size_t)row * ld16 + col) = pack4(gt * a); }
                        else if (MODE == 1) { const f32x4 gt = unpack4(*(const u32x2*)(gate + (size_t)row * DM + col)); u32x2* o = (u32x2*)(out16 + (size_t)row * ld16 + col); const f32x4 t = unpack4(*o); *o = pack4(t + gt * a); }
                        else if (MODE == 2) {
                            const float* bp = xp + (size_t)row * DM + col;
                            const f32x4 r = *(const f32x4*)bp + a; *(f32x4*)(R + (size_t)row * DM + col) = r;
                            ss += (r[0] * r[0] + r[1] * r[1]) + (r[2] * r[2] + r[3] * r[3]);
                            *(u32x2*)(out16 + (size_t)row * ld16 + col) = pack4(r * *(const f32x4*)(g + col));
                        }
                        else if (MODE == 3) { f32x4 v = a * rstd; v[0] = fmaxf(v[0], 0.f); v[1] = fmaxf(v[1], 0.f); v[2] = fmaxf(v[2], 0.f); v[3] = fmaxf(v[3], 0.f); *(u32x2*)(out16 + (size_t)row * ld16 + col) = pack4(v * v); }
                        else if (MODE == 4) { f32x4 v = a * rstd; v[0] = sigmoidf_(v[0]); v[1] = sigmoidf_(v[1]); v[2] = sigmoidf_(v[2]); v[3] = sigmoidf_(v[3]); *(u32x2*)(out16 + (size_t)row * ld16 + col) = pack4(v); }
                        else if (MODE == 5) { const f32x4 t = unpack4(*(const u32x2*)(out16 + (size_t)row * ld16 + col)); float* rp = R + (size_t)row * DM + col; const f32x4 r = *(const f32x4*)rp + t * a; *(f32x4*)rp = r;
                            ss += (r[0] * r[0] + r[1] * r[1]) + (r[2] * r[2] + r[3] * r[3]); }
                    }
                if (MODE == 2 || MODE == 5) { ss += __shfl_xor(ss, 16); ss += __shfl_xor(ss, 32); if (fq == 0) PS[(size_t)row * 16 + u.pn * 4 + wc] = ss; }
            }
        }
    }
};

__device__ __forceinline__ void samp_in(const EpiIn& E, int row, int pcol, f32x4 v) {
    const float rs = E.rstd0[row]; const int pn = __builtin_amdgcn_readfirstlane(pcol >> 8), p = pcol & 255;
    if (pn < 4) {
        const bool isk = pn >= 2; bf16_t* dst = isk ? E.KR : E.QR; const int head = 2 * (pn & 1) + (p >> 7), j = (p & 127) >> 1;
        const f32x4 t = *(const f32x4*)(E.cs + ((size_t)SEQ * 64 + j) * 2);
        v = v * (rs * (isk ? 0.08838834764831845f : 1.0f));
        const float o1a = v[0] * t[0] - v[1] * t[1], o2a = v[0] * t[1] + v[1] * t[0], o1b = v[2] * t[2] - v[3] * t[3], o2b = v[2] * t[3] + v[3] * t[2];
        bf16_t* q = dst + (size_t)row * 512 + head * 128 + j;
        *(unsigned*)q = cvt_pk_bf16(o1a, o1b); *(unsigned*)(q + 64) = cvt_pk_bf16(o2a, o2b);
    } else if (pn >= 12 && pn < 20) {
        const int c = (pn - 12) * 128 + (p >> 1);
        const float k0 = (1.0f - E.lb[c]) / (1.0f + __expf(v[1] * rs)), k1 = (1.0f - E.lb[c + 1]) / (1.0f + __expf(v[3] * rs));
        *(unsigned*)(E.QG + (size_t)row * DM + c) = cvt_pk_bf16(siluf_(v[0] * rs), siluf_(v[2] * rs));
        *(unsigned*)(E.KG + (size_t)row * DM + c) = cvt_pk_bf16(k0, k1);
        *(f32x2*)(E.FS + (size_t)(row - MPROMPT) * DM + c) = (f32x2){1.0f - k0, 1.0f - k1};
    } else {
        v = v * rs;
        const bool sl = (pn >= 8 && pn < 12) || (pn >= 24 && pn < 28), sg = pn >= 28;
        if (sl) { v[0] = siluf_(v[0]); v[1] = siluf_(v[1]); v[2] = siluf_(v[2]); v[3] = siluf_(v[3]); }
        else if (sg) { v[0] = sigmoidf_(v[0]); v[1] = sigmoidf_(v[1]); v[2] = sigmoidf_(v[2]); v[3] = sigmoidf_(v[3]); }
        const u32x2 w = pack4(v); const size_t ro = (size_t)row * DM + p;
        if (pn < 8) *(u32x2*)(E.VR + ro + (pn - 4) * BM) = w;
        else if (pn < 12) *(u32x2*)(E.GR + ro + (pn - 8) * BM) = w;
        else if (pn < 24) *(u32x2*)(E.VG + ro + (pn - 20) * BM) = w;
        else if (pn < 28) *(u32x2*)(E.GG + ro + (pn - 24) * BM) = w;
        else if (pn < 32) *(u32x2*)(E.AR + ro + (pn - 28) * BM) = w;
        else *(u32x2*)(E.AH + ro + (pn - 32) * BM) = w;
    }
}
template <int MODE> __device__ __forceinline__ void samp_n(const EpiN<MODE>& E, const float* xs, float* PSS, const float* PSSin, int row, int col, f32x4 a) {
    const int rs_ = row - MPROMPT; float rstd = 1.f;
    if (MODE == 3 || MODE == 4) { const f32x4* p = (const f32x4*)(PSSin + (size_t)rs_ * 64); float s = 0.f;
#pragma unroll
        for (int i = 0; i < 16; ++i) { const f32x4 q = p[i]; s += (q[0] + q[1]) + (q[2] + q[3]); }
        rstd = rsqrtf(s * (1.0f / 1024.0f) + EPS); }
    float ss = 0.f;
    if (MODE == 0) { const f32x4 gt = unpack4(*(const u32x2*)(E.gate + (size_t)row * DM + col)); *(u32x2*)(E.out16 + (size_t)row * E.ld16 + col) = pack4(gt * a); }
    else if (MODE == 1) { const f32x4 gt = unpack4(*(const u32x2*)(E.gate + (size_t)row * DM + col)); u32x2* o = (u32x2*)(E.out16 + (size_t)row * E.ld16 + col); const f32x4 t = unpack4(*o); *o = pack4(t + gt * a); }
    else if (MODE == 2) { const float* bp = xs ? xs + (size_t)rs_ * DM + col : E.R + (size_t)row * DM + col; const f32x4 r = *(const f32x4*)bp + a; *(f32x4*)(E.R + (size_t)row * DM + col) = r;
        ss = (r[0] * r[0] + r[1] * r[1]) + (r[2] * r[2] + r[3] * r[3]); *(u32x2*)(E.out16 + (size_t)row * E.ld16 + col) = pack4(r * *(const f32x4*)(E.g + col)); }
    else if (MODE == 3) { f32x4 v = a * rstd; v[0] = fmaxf(v[0], 0.f); v[1] = fmaxf(v[1], 0.f); v[2] = fmaxf(v[2], 0.f); v[3] = fmaxf(v[3], 0.f); *(u32x2*)(E.out16 + (size_t)row * E.ld16 + col) = pack4(v * v); }
    else if (MODE == 4) { f32x4 v = a * rstd; v[0] = sigmoidf_(v[0]); v[1] = sigmoidf_(v[1]); v[2] = sigmoidf_(v[2]); v[3] = sigmoidf_(v[3]); *(u32x2*)(E.out16 + (size_t)row * E.ld16 + col) = pack4(v); }
    else if (MODE == 5) { const f32x4 t = unpack4(*(const u32x2*)(E.out16 + (size_t)row * E.ld16 + col)); float* rp = E.R + (size_t)row * DM + col; const f32x4 r = *(const f32x4*)rp + t * a; *(f32x4*)rp = r;
        ss = (r[0] * r[0] + r[1] * r[1]) + (r[2] * r[2] + r[3] * r[3]); }
    if (MODE == 2 || MODE == 5) { ss += __shfl_xor(ss, 16); ss += __shfl_xor(ss, 32); if ((threadIdx.x & 63) < 16) PSS[(size_t)rs_ * 64 + (col >> 4)] = ss; }
}
}


constexpr int NWAVES = 8;
constexpr int NPH = 10;
#ifndef MK_ONE_LAUNCH
#define MK_ONE_LAUNCH 1
#endif

constexpr size_t MiB = 1u << 20;
constexpr size_t WS_CTL = 0, CTL_ZERO_BYTES = 1 * MiB;
constexpr size_t WS_WIN = 1 * MiB;
constexpr size_t WS_WUPR = WS_WIN + (size_t)DIN * DM * 2;
constexpr size_t WS_WUPH = WS_WUPR + (size_t)DM * DM * 2;
constexpr size_t WS_WO = WS_WUPH + (size_t)DM * DM * 2;
constexpr size_t WS_WFF1 = WS_WO + (size_t)DM * DM * 2;
constexpr size_t WS_WFF2 = WS_WFF1 + (size_t)DFF * DM * 2;
constexpr size_t WS_WGATE = WS_WFF2 + (size_t)DFF * DM * 2;
constexpr size_t WS_WPROJ = WS_WGATE + (size_t)DM * DM * 2;
constexpr size_t WS_Z6 = WS_WPROJ + (size_t)DM * DPLE * 2;
constexpr size_t Z_QR = WS_Z6, Z_KR = Z_QR + (size_t)MP * 512 * 2, Z_VR = Z_KR + (size_t)MP * 512 * 2, Z_QG = Z_VR + (size_t)MP * DM * 2, Z_KG = Z_QG + (size_t)MP * DM * 2,
                 Z_VG = Z_KG + (size_t)MP * DM * 2, Z_END = Z_VG + (size_t)MP * DM * 2;
constexpr size_t WS_H = WS_Z6, WS_MB = WS_Z6 + (size_t)MP * DFF * 2;
static_assert(WS_MB == Z_VG, "MB overlays VG exactly");
constexpr size_t WS_GR = Z_END, WS_GG = WS_GR + (size_t)MP * DM * 2, WS_A5 = WS_GR, WS_A7 = WS_GG;
constexpr size_t WS_PB = WS_GG + (size_t)MP * DM * 2;
constexpr size_t WS_CS = WS_PB + (size_t)MP * DPLE * 2;
constexpr size_t WS_GL = WS_CS + (size_t)2049 * 64 * 8;
constexpr size_t WS_FS = WS_GL + (size_t)NCHUNK * DM * 4;
constexpr size_t WS_RSTD0 = WS_FS + (size_t)NDEC * DM * 4;
constexpr size_t WS_LB = WS_RSTD0 + (size_t)MP * 4;
constexpr size_t WS_PS1 = WS_LB + 4096, WS_PS2 = WS_PS1 + (size_t)MP * 64, WS_PS3 = WS_PS2 + (size_t)MP * 64, WS_PSS1 = WS_PS3 + (size_t)MP * 64, WS_PSS2 = WS_PSS1 + (size_t)NDEC * 256, WS_PSS3 = WS_PSS2 + (size_t)NDEC * 256, WS_END = WS_PSS3 + (size_t)NDEC * 256;
static_assert(WS_END <= 307920896, "d_ws map must fit sum(inputs) bytes");
static_assert(WS_WIN % 256 == 0 && WS_Z6 % 256 == 0 && WS_GR % 256 == 0 && WS_PB % 256 == 0 && WS_CS % 16 == 0 && WS_GL % 16 == 0 && WS_PS1 % 16 == 0, "alignment");
constexpr int CW_TMO = 0, CW_BAR = 4096;

constexpr int RING_OFF = 0, RING_BYTES = 131072;
constexpr int LDSCTL_OFF = RING_BYTES, MISC_OFF = LDSCTL_OFF + 320;
constexpr int LDS_BYTES = 147456;

#define GAS __attribute__((address_space(1)))
#define LAS __attribute__((address_space(3)))
typedef unsigned short bf16;
typedef unsigned v4u __attribute__((ext_vector_type(4)));
typedef float f32x4 __attribute__((ext_vector_type(4)));
typedef short bf16x8 __attribute__((ext_vector_type(8)));
typedef GAS unsigned gu32;
typedef GAS unsigned long long gu64;
#define RLX_AGENT __ATOMIC_RELAXED, __HIP_MEMORY_SCOPE_AGENT
#define LDS_WAIT() asm volatile("s_waitcnt lgkmcnt(0)" ::: "memory")
#define VM_WAIT() asm volatile("s_waitcnt vmcnt(0)" ::: "memory")
__device__ __forceinline__ unsigned long long rt() { return __builtin_amdgcn_s_memrealtime(); }
__device__ __forceinline__ unsigned f2bf(float f) { unsigned u = __builtin_bit_cast(unsigned, f); return (u + 0x7fffu + ((u >> 16) & 1u)) >> 16; }
__device__ __forceinline__ unsigned pk2(float lo, float hi) { return f2bf(lo) | (f2bf(hi) << 16); }

#define XB_TMO      128
#define XB_XCNT(j)  (256  + 64 * (j))
#define XB_XSUB(j)  (1280 + 64 * (j))
#define XB_XGEN(j)  (2304 + 64 * (j))
#define XB_TOP      3328
#define XB_TOPGEN   3392
#define XCD_BAR_WORDS 3456
#define XB_SPIN_CAP (1u << 18)

__device__ __forceinline__ unsigned xb_ld(unsigned* p)              { return __hip_atomic_load(p, __ATOMIC_RELAXED, __HIP_MEMORY_SCOPE_AGENT); }
__device__ __forceinline__ unsigned xb_add(unsigned* p, unsigned v) { return __hip_atomic_fetch_add(p, v, __ATOMIC_RELAXED, __HIP_MEMORY_SCOPE_AGENT); }
__device__ __forceinline__ unsigned xb_xcc_id() { return (unsigned)__builtin_amdgcn_s_getreg((3 << 11) | 20) & 0xFu; }
#define XB_SPIN(cond, bar) do { unsigned _sp = 0; while (cond) { __builtin_amdgcn_s_sleep(1); \
    if ((++_sp & 255u) == 0u) { if (xb_ld(&(bar)[XB_TMO])) break; if (_sp > XB_SPIN_CAP) { atomicAdd(&(bar)[XB_TMO], 1u); break; } } } } while (0)

struct XcdBarrier {
    unsigned* bar; unsigned x;
    volatile LAS unsigned* st;
};

__device__ __forceinline__ XcdBarrier xcd_barrier_post(unsigned* bar, volatile LAS unsigned* st) {
    XcdBarrier b; b.bar = bar; b.x = xb_xcc_id(); b.st = st;
    if (threadIdx.x == 0) (void)xb_add(&bar[XB_XCNT(b.x)], 1u);
    return b;
}
__device__ __forceinline__ void xcd_barrier_complete(unsigned* bar, unsigned x, unsigned& nloc, unsigned& nx) {
    const unsigned G = gridDim.x * gridDim.y * gridDim.z;
    unsigned sum, cnt, mine, sp = 0u;
    for (;;) {
        sum = 0u; cnt = 0u; mine = 0u;
#pragma unroll
        for (unsigned j = 0; j < 16; ++j) { const unsigned c = xb_ld(&bar[XB_XCNT(j)]); sum += c; cnt += (c > 0u) ? 1u : 0u; mine = (j == x) ? c : mine; }
        if (sum == G) break;
        __builtin_amdgcn_s_sleep(1);
        if ((++sp & 255u) == 0u) { if (xb_ld(&bar[XB_TMO])) break; if (sp > XB_SPIN_CAP) { atomicAdd(&bar[XB_TMO], 1u); break; } }
    }
    nloc = mine > 0u ? mine : 1u; nx = cnt > 0u ? cnt : 1u;
}

__device__ __forceinline__ void xcd_barrier(const XcdBarrier& b) {
    asm volatile("s_waitcnt vmcnt(0)" ::: "memory");
    __syncthreads();
    if (threadIdx.x == 0) {
        unsigned* bar = b.bar;
        __builtin_amdgcn_s_waitcnt(0);
        unsigned nloc = b.st[0], nx = b.st[1];
        if (nloc == 0u) { xcd_barrier_complete(bar, b.x, nloc, nx); b.st[0] = nloc; b.st[1] = nx; }
        const unsigned old = xb_add(&bar[XB_XSUB(b.x)], 1u);
        const unsigned gen = old / nloc;
        if (old + 1u == (gen + 1u) * nloc) {
            __builtin_amdgcn_fence(__ATOMIC_RELEASE, "agent");
            asm volatile("s_waitcnt vmcnt(0)" ::: "memory");
            const unsigned og = xb_add(&bar[XB_TOP], 1u);
            const unsigned tg = og / nx;
            if (og + 1u == (tg + 1u) * nx) xb_add(&bar[XB_TOPGEN], 1u);
            else XB_SPIN(xb_ld(&bar[XB_TOPGEN]) == tg, bar);
            __builtin_amdgcn_fence(__ATOMIC_ACQUIRE, "agent");
            xb_add(&bar[XB_XGEN(b.x)], 1u);
            asm volatile("s_waitcnt vmcnt(0)" ::: "memory");
        } else {
            XB_SPIN(xb_ld(&bar[XB_XGEN(b.x)]) == gen, bar);
            __builtin_amdgcn_fence(__ATOMIC_ACQUIRE, "agent");
            asm volatile("s_waitcnt vmcnt(0)" ::: "memory");
        }
    }
    __syncthreads();
}


#ifndef PROBE_ON
#define PROBE_ON 0
#endif
#define PROBE_UNIT 800ull
#ifndef PROBE_A
#define PROBE_A 0
#define PROBE_B 1
#define PROBE_C 2
#endif
struct Args { const float* in[21]; float* out; unsigned char* ws; int ph_lo, ph_hi, use_bar, pad; };
struct Frame {
    LAS unsigned char* lds; volatile LAS unsigned* MISC; gu32* ctl;
    int vcu, G;
};
__device__ __forceinline__ int tid_() { int t = threadIdx.x; asm volatile("" : "+v"(t)); return t; }
#define FTID (tid_())
#define FLANE (tid_() & 63)
#define FWAVE (__builtin_amdgcn_readfirstlane(tid_() >> 6))
__device__ __forceinline__ float wave_sum(float v) {
#pragma unroll
    for (int o = 1; o < 64; o <<= 1) v += __shfl_xor(v, o);
    return v;
}
__device__ __forceinline__ float bf2f_(unsigned short b) { return __uint_as_float((unsigned)b << 16); }
__device__ __forceinline__ float bflo_(unsigned w) { return __uint_as_float(w << 16); }
__device__ __forceinline__ float bfhi_(unsigned w) { return __uint_as_float(w & 0xffff0000u); }

__device__ __forceinline__ int win_src_col(int np) {
    const int tile = np >> 8, p = np & 255;
    if (tile < 4) { const int base = (tile >> 1) * 512, head = 2 * (tile & 1) + (p >> 7), pp = p & 127; return base + head * 128 + (pp & 1) * 64 + (pp >> 1); }
    if (tile >= 12 && tile < 20) { const int h = tile - 12; return 3072 + (p & 1) * 1024 + h * 128 + (p >> 1); }
    return np;
}
template <bool MAP> __device__ __forceinline__ void p0_transpose_item(const float* W, int K, int N, bf16* WT, LAS float* scr, int item, int lane) {
    const int nblk = N / 32, kb = item / nblk, nb = item % nblk, k0 = 64 * kb, n0 = 32 * nb;
    const int srcc = MAP ? win_src_col(n0 + (lane & 31)) : n0 + (lane & 31);
#pragma unroll 8
    for (int i = 0; i < 32; ++i) { const int kk = 2 * i + (lane >> 5); scr[kk * 33 + (lane & 31)] = W[(size_t)(k0 + kk) * N + srcc]; }
    LDS_WAIT(); asm volatile("" ::: "memory");
    const int c = lane & 7;
#pragma unroll
    for (int j = 0; j < 4; ++j) { const int n = (lane >> 3) + 8 * j; const LAS float* s = scr + (8 * c) * 33 + n;
        v4u o; o.x = pk2(s[0 * 33], s[1 * 33]); o.y = pk2(s[2 * 33], s[3 * 33]); o.z = pk2(s[4 * 33], s[5 * 33]); o.w = pk2(s[6 * 33], s[7 * 33]);
        *(GAS v4u*)(WT + (size_t)(n0 + n) * K + k0 + 8 * c) = o; }
    LDS_WAIT(); asm volatile("" ::: "memory");
}
__device__ __forceinline__ void p0_prologue(Frame& F, const Args& a) { const int tid_v = tid_(); const int lane_v = tid_v & 63; const int wave_v = __builtin_amdgcn_readfirstlane(tid_v >> 6); (void)lane_v; (void)wave_v;
    unsigned char* ws = a.ws;
    LAS float* scr = (LAS float*)(F.lds + RING_OFF + wave_v * 16384);
    const int gw = F.vcu * NWAVES + wave_v, NGW = F.G * NWAVES;
    constexpr int I_IN = (DM / 64) * (DIN / 32), I_SQ = (DM / 64) * (DM / 32), I_F1 = (DM / 64) * (DFF / 32), I_F2 = (DFF / 64) * (DM / 32), I_PJ = (DPLE / 64) * (DM / 32);
    constexpr int NITEMS = I_IN + 4 * I_SQ + I_F1 + I_F2 + I_PJ;
    for (int it = gw; it < NITEMS; it += NGW) {
        int r = it;
        if (r < I_IN) { p0_transpose_item<true>(a.in[7], DM, DIN, (bf16*)(ws + WS_WIN), scr, r, lane_v); continue; } r -= I_IN;
        if (r < I_SQ) { p0_transpose_item<false>(a.in[11], DM, DM, (bf16*)(ws + WS_WUPR), scr, r, lane_v); continue; } r -= I_SQ;
        if (r < I_SQ) { p0_transpose_item<false>(a.in[12], DM, DM, (bf16*)(ws + WS_WUPH), scr, r, lane_v); continue; } r -= I_SQ;
        if (r < I_SQ) { p0_transpose_item<false>(a.in[13], DM, DM, (bf16*)(ws + WS_WO), scr, r, lane_v); continue; } r -= I_SQ;
        if (r < I_SQ) { p0_transpose_item<false>(a.in[18], DM, DM, (bf16*)(ws + WS_WGATE), scr, r, lane_v); continue; } r -= I_SQ;
        if (r < I_F1) { p0_transpose_item<false>(a.in[15], DM, DFF, (bf16*)(ws + WS_WFF1), scr, r, lane_v); continue; } r -= I_F1;
        if (r < I_F2) { p0_transpose_item<false>(a.in[16], DFF, DM, (bf16*)(ws + WS_WFF2), scr, r, lane_v); continue; } r -= I_F2;
        p0_transpose_item<false>(a.in[19], DPLE, DM, (bf16*)(ws + WS_WPROJ), scr, r, lane_v);
    }
    bf16* XB = (bf16*)(a.out + OFF_RETS); float* RSTD0 = (float*)(ws + WS_RSTD0); bf16* PB = (bf16*)(ws + WS_PB);
    const float* gmix = a.in[6];
    for (int m = gw; m < MP; m += NGW) {
        GAS unsigned long long* o8 = (GAS unsigned long long*)(XB + (size_t)m * DM) + lane_v;
        GAS unsigned long long* p8 = (GAS unsigned long long*)(PB + (size_t)m * DPLE) + lane_v;
        if (m >= MTOT) {
#pragma unroll
            for (int j = 0; j < 4; ++j) o8[64 * j] = 0ull;
            p8[0] = 0ull; if (lane_v == 0) RSTD0[m] = 0.f; continue;
        }
        const float* xrow = m < MPROMPT ? a.in[0] + (size_t)m * DM : a.in[1] + (size_t)(m - MPROMPT) * DM;
        const float* prow = m < MPROMPT ? a.in[4] + (size_t)m * DPLE : a.in[5] + (size_t)(m - MPROMPT) * DPLE;
        const GAS f32x4* xr = (const GAS f32x4*)xrow + lane_v;
        f32x4 v[4]; float s = 0.f;
#pragma unroll
        for (int j = 0; j < 4; ++j) { v[j] = xr[64 * j]; s += (v[j].x * v[j].x + v[j].y * v[j].y) + (v[j].z * v[j].z + v[j].w * v[j].w); }
        s = wave_sum(s);
        if (lane_v == 0) RSTD0[m] = rsqrtf(s * (1.0f / DM) + EPS);
#pragma unroll
        for (int j = 0; j < 4; ++j) { const f32x4 gv = *((const GAS f32x4*)gmix + 64 * j + lane_v);
            o8[64 * j] = (unsigned long long)pk2(v[j].x * gv.x, v[j].y * gv.y) | ((unsigned long long)pk2(v[j].z * gv.z, v[j].w * gv.w) << 32); }
        const f32x4 pv = *((const GAS f32x4*)prow + lane_v);
        p8[0] = (unsigned long long)pk2(pv.x, pv.y) | ((unsigned long long)pk2(pv.z, pv.w) << 32);
    }
    float* CS = (float*)(ws + WS_CS); float* LB = (float*)(ws + WS_LB);
    const int gt = (F.vcu * NWAVES + wave_v) * 64 + lane_v, NGT = NGW * 64;
    for (int i = gt; i < 2049 * 64; i += NGT) {
        const int pi = i >> 6, j = i & 63; const double pos = pi == SEQ ? 16384.0 : (double)pi;
        const double ang = pos * pow(10000.0, -(double)j / 64.0);
        CS[2 * i] = (float)cos(ang); CS[2 * i + 1] = (float)sin(ang);
    }
    for (int i = gt; i < DM; i += NGT) { const float a0 = a.in[10][i], a1 = a.in[10][DM + i]; LB[i] = 1.0f / (1.0f + expf(a1 - a0)); }
}

typedef float f32x16 __attribute__((ext_vector_type(16)));
typedef short v4i16_t __attribute__((ext_vector_type(4)));
typedef unsigned u32x2 __attribute__((ext_vector_type(2)));
typedef float f32x2_t __attribute__((ext_vector_type(2))); typedef __bf16 bf16x2_t __attribute__((ext_vector_type(2)));
__device__ __forceinline__ unsigned cvtpk_s(float lo, float hi) { f32x2_t v = {lo, hi}; bf16x2_t b = __builtin_convertvector(v, bf16x2_t); return __builtin_bit_cast(unsigned, b); }
__device__ __forceinline__ unsigned off_b(unsigned row, unsigned ch) { return 256u * row + 16u * (ch ^ (((row & 3) << 2) | ((row >> 2) & 3))); }
__device__ __forceinline__ bf16x8 rd_row(LAS unsigned char* img, unsigned row, unsigned ks, unsigned h) { return *(const LAS bf16x8*)(img + off_b(row, 2 * ks + h)); }
__device__ __forceinline__ bf16x8 rd_tr(LAS unsigned char* img, unsigned lane, unsigned c, unsigned ks) {
    const unsigned h = lane >> 5, blk = (lane >> 4) & 1, q = (lane & 15) >> 2, p = lane & 3;
    const unsigned a0 = off_b(16 * ks + 8 * h + q, 4 * c + 2 * blk + (p >> 1)) + 8 * (p & 1);
    const unsigned a1 = off_b(16 * ks + 8 * h + 4 + q, 4 * c + 2 * blk + (p >> 1)) + 8 * (p & 1);
    const v4i16_t lo = __builtin_amdgcn_ds_read_tr16_b64_v4i16((LAS v4i16_t*)(img + a0));
    const v4i16_t hi = __builtin_amdgcn_ds_read_tr16_b64_v4i16((LAS v4i16_t*)(img + a1));
    return __builtin_shufflevector(lo, hi, 0, 1, 2, 3, 4, 5, 6, 7);
}
#define MFMA32(a, b, c) __builtin_amdgcn_mfma_f32_32x32x16_bf16((a), (b), (c), 0, 0, 0)
__device__ __forceinline__ void scan_item(Frame& F, const Args& a, int item) { const int tid_v = tid_(); const int lane_v = tid_v & 63; const int wave_v = __builtin_amdgcn_readfirstlane(tid_v >> 6); (void)lane_v; (void)wave_v;
    unsigned char* ws = a.ws;
    const bool isg = item >= 128; const int it = isg ? item - 128 : item;
    int b, hd, dv0, ldq; const bf16 *Qp, *Kp; bf16* Vp; float* Sout; const float* GLp = nullptr; float sdec = 1.f;
    if (!isg) { b = it >> 4; hd = (it >> 2) & 3; dv0 = (it & 3) * 64; ldq = 512;
        Qp = (const bf16*)(ws + Z_QR) + hd * 128; Kp = (const bf16*)(ws + Z_KR) + hd * 128; Vp = (bf16*)(ws + Z_VR) + hd * 256 + dv0;
        Sout = a.out + OFF_RETP + ((size_t)(b * HR + hd) * DKR) * DVR + dv0; sdec = __expf(64.0f * __logf(1.0f - exp2f(-5.0f - (float)hd))); }
    else { b = it >> 4; hd = (it >> 1) & 7; dv0 = (it & 1) * 64; ldq = 1024;
        Qp = (const bf16*)(ws + Z_QG) + hd * 128; Kp = (const bf16*)(ws + Z_KG) + hd * 128; Vp = (bf16*)(ws + Z_VG) + hd * 128 + dv0;
        Sout = a.out + OFF_HGP + ((size_t)(b * HG + hd) * DKG) * DVG + dv0; GLp = (const float*)(ws + WS_GL) + hd * 128; }
    const int ldo = isg ? DVG : DVR;
    LAS unsigned char* QI = F.lds; LAS unsigned char* KI = QI + 16384; LAS unsigned char* VI = KI + 16384; LAS unsigned char* PI = VI + 16384; LAS unsigned char* SI = PI + 16384;
    const int tid = tid_v, lane = lane_v, w = wave_v; const unsigned r = lane & 31, h = lane >> 5;
    const int kb = w >> 1, dvb = w & 1;
    for (int i = tid; i < 16384 / 4; i += 512) ((LAS unsigned*)SI)[i] = 0u;
    f32x16 S;
#pragma unroll
    for (int i = 0; i < 16; ++i) S[i] = 0.f;
    const int qr0 = tid >> 4, qc0 = tid & 15, vr0 = tid >> 3, vc0 = tid & 7;
    const size_t rowb = (size_t)b * SEQ;
    v4u pq0, pq1, pk0, pk1, pv;
#define SCAN_LOAD(c) do { const size_t r0_ = rowb + (size_t)(c) * CH; \
        pq0 = *(const v4u*)(Qp + (r0_ + qr0) * ldq + qc0 * 8); pq1 = *(const v4u*)(Qp + (r0_ + qr0 + 32) * ldq + qc0 * 8); \
        pk0 = *(const v4u*)(Kp + (r0_ + qr0) * ldq + qc0 * 8); pk1 = *(const v4u*)(Kp + (r0_ + qr0 + 32) * ldq + qc0 * 8); \
        pv = *(const v4u*)(Vp + (r0_ + vr0) * DM + vc0 * 8); } while (0)
    SCAN_LOAD(0);
    for (int c = 0; c < SEQ / CH; ++c) {
        const size_t row0 = rowb + (size_t)c * CH;
        __syncthreads();
        *(LAS v4u*)(QI + off_b(qr0, qc0)) = pq0; *(LAS v4u*)(QI + off_b(qr0 + 32, qc0)) = pq1;
        *(LAS v4u*)(KI + off_b(qr0, qc0)) = pk0; *(LAS v4u*)(KI + off_b(qr0 + 32, qc0)) = pk1;
        *(LAS v4u*)(VI + off_b(vr0, vc0)) = pv;
        if (c > 0) {
#pragma unroll
            for (int g = 0; g < 4; ++g) { u32x2 wv; wv.x = cvtpk_s(S[4 * g], S[4 * g + 1]); wv.y = cvtpk_s(S[4 * g + 2], S[4 * g + 3]);
                *(LAS u32x2*)(SI + off_b(32 * dvb + r, 4 * kb + g) + 8 * h) = wv; }
        }
        if (c + 1 < SEQ / CH) SCAN_LOAD(c + 1);
        __syncthreads();
        {
            f32x16 d;
#pragma unroll
            for (int i = 0; i < 16; ++i) d[i] = 0.f;
#pragma unroll
            for (int ks = 0; ks < 4; ++ks) { const bf16x8 A = rd_tr(KI, lane, kb, ks); const bf16x8 B = rd_tr(VI, lane, dvb, ks); d = MFMA32(A, B, d); }
            if (isg) {
                const float* gl = GLp + ((size_t)b * (SEQ / CH) + c) * DM + 32 * kb + 4 * h;
#pragma unroll
                for (int g = 0; g < 4; ++g) { const f32x4 dc = *(const f32x4*)(gl + 8 * g);
#pragma unroll
                    for (int i = 0; i < 4; ++i) S[4 * g + i] = dc[i] * (S[4 * g + i] + d[4 * g + i]); }
            } else {
#pragma unroll
                for (int i = 0; i < 16; ++i) S[i] = sdec * (S[i] + d[i]);
            }
        }
        if (w < 3) {
            const int sb = w >> 1, tb = (w + 1) >> 1;
            f32x16 p;
#pragma unroll
            for (int i = 0; i < 16; ++i) p[i] = 0.f;
#pragma unroll
            for (int ks = 0; ks < 8; ++ks) { const bf16x8 A = rd_row(KI, 32 * sb + r, ks, h); const bf16x8 B = rd_row(QI, 32 * tb + r, ks, h); p = MFMA32(A, B, p); }
#pragma unroll
            for (int g = 0; g < 4; ++g) {
                float v[4];
#pragma unroll
                for (int i = 0; i < 4; ++i) { const int sl = 8 * g + 4 * (int)h + i; v[i] = (sb != tb || sl <= (int)r) ? p[4 * g + i] : 0.f; }
                u32x2 wv; wv.x = cvtpk_s(v[0], v[1]); wv.y = cvtpk_s(v[2], v[3]);
                *(LAS u32x2*)(PI + off_b(32 * tb + r, 4 * sb + g) + 8 * h) = wv;
            }
        }
        __syncthreads();
        if (w < 4) {
            const int ob = w >> 1, tb = w & 1;
            f32x16 o;
#pragma unroll
            for (int i = 0; i < 16; ++i) o[i] = 0.f;
#pragma unroll
            for (int ks = 0; ks < 4; ++ks) if (ks < 2 || tb == 1) { const bf16x8 A = rd_tr(VI, lane, ob, ks); const bf16x8 B = rd_row(PI, 32 * tb + r, ks, h); o = MFMA32(A, B, o); }
#pragma unroll
            for (int ks = 0; ks < 8; ++ks) { const bf16x8 A = rd_row(SI, 32 * ob + r, ks, h); const bf16x8 B = rd_row(QI, 32 * tb + r, ks, h); o = MFMA32(A, B, o); }
            bf16* orow = Vp + (row0 + 32 * tb + r) * DM + 32 * ob + 4 * h;
#pragma unroll
            for (int g = 0; g < 4; ++g) { u32x2 wv; wv.x = cvtpk_s(o[4 * g], o[4 * g + 1]); wv.y = cvtpk_s(o[4 * g + 2], o[4 * g + 3]); *(u32x2*)(orow + 8 * g) = wv; }
        }
    }
#undef SCAN_LOAD
#pragma unroll
    for (int i = 0; i < 16; ++i) { const int k = 32 * kb + (i & 3) + 8 * (i >> 2) + 4 * (int)h; Sout[(size_t)k * ldo + 32 * dvb + r] = S[i]; }
    __syncthreads();
}

__device__ __forceinline__ void decode_ret(Frame& F, const Args& a, int item) { const int tid_v = tid_(); const int lane_v = tid_v & 63; const int wave_v = __builtin_amdgcn_readfirstlane(tid_v >> 6); (void)lane_v; (void)wave_v;
    unsigned char* ws = a.ws; const int n = item >> 2, h = item & 3, row = MPROMPT + n;
    LAS float* qs = (LAS float*)(F.lds); LAS float* ks = qs + 128; LAS float* red = ks + 128;
    LAS float* part = red + 8 * 256;
    const int tid = tid_v, lane = lane_v, w = wave_v;
    if (tid < 128) qs[tid] = bf2f_(((const bf16*)(ws + Z_QR))[(size_t)row * 512 + h * 128 + tid]);
    else if (tid < 256) ks[tid - 128] = bf2f_(((const bf16*)(ws + Z_KR))[(size_t)row * 512 + h * 128 + tid - 128]);
    const unsigned long long vw = *(const unsigned long long*)((const bf16*)(ws + Z_VR) + (size_t)row * DM + h * 256 + 4 * lane);
    const f32x4 v = (f32x4){bflo_((unsigned)vw), bfhi_((unsigned)vw), bflo_((unsigned)(vw >> 32)), bfhi_((unsigned)(vw >> 32))};
    const float gam = 1.0f - exp2f(-5.0f - (float)h);
    __syncthreads();
    const float* S0 = a.in[2] + ((size_t)(n * HR + h) * DKR) * DVR; float* S1 = a.out + OFF_RETS + ((size_t)(n * HR + h) * DKR) * DVR;
    f32x4 o = (f32x4){0.f, 0.f, 0.f, 0.f};
    f32x4 s[16];
#pragma unroll
    for (int i = 0; i < 16; ++i) s[i] = *(const f32x4*)(S0 + (size_t)(w + 8 * i) * DVR + 4 * lane);
#pragma unroll
    for (int i = 0; i < 16; ++i) { const int k = w + 8 * i; const f32x4 sn = s[i] * gam + v * ks[k]; *(f32x4*)(S1 + (size_t)k * DVR + 4 * lane) = sn; o += sn * qs[k]; }
    *(LAS f32x4*)(red + w * 256 + 4 * lane) = o;
    __syncthreads();
    float ov = 0.f;
    if (tid < 256) {
#pragma unroll
        for (int i = 0; i < 8; ++i) ov += red[i * 256 + tid];
        const float ss = wave_sum(ov * ov); if (lane == 0) part[w] = ss;
    }
    __syncthreads();
    if (tid < 256) {
        const float rstd = rsqrtf(((part[0] + part[1]) + (part[2] + part[3])) * (1.0f / DVR) + EPS);
        bf16* gp = (bf16*)(ws + WS_GR) + (size_t)row * DM + h * 256 + tid;
        *gp = (bf16)f2bf(ov * rstd * a.in[8][h * 256 + tid] * bf2f_(*gp));
    }
    __syncthreads();
}
__device__ __forceinline__ void decode_hg(Frame& F, const Args& a, int item) { const int tid_v = tid_(); const int lane_v = tid_v & 63; const int wave_v = __builtin_amdgcn_readfirstlane(tid_v >> 6); (void)lane_v; (void)wave_v;
    unsigned char* ws = a.ws; const int n = item >> 3, h = item & 7, row = MPROMPT + n;
    LAS float* qs = (LAS float*)(F.lds); LAS float* ks = qs + 128; LAS float* fs = ks + 128; LAS float* red = fs + 128;
    LAS float* part = red + 16 * 128;
    const int tid = tid_v, lane = lane_v, w = wave_v, l32 = lane & 31, half = lane >> 5;
    if (tid < 128) qs[tid] = bf2f_(((const bf16*)(ws + Z_QG))[(size_t)row * DM + h * 128 + tid]);
    else if (tid < 256) ks[tid - 128] = bf2f_(((const bf16*)(ws + Z_KG))[(size_t)row * DM + h * 128 + tid - 128]);
    else if (tid < 384) fs[tid - 256] = ((const float*)(ws + WS_FS))[(size_t)n * DM + h * 128 + tid - 256];
    const unsigned long long vw = *(const unsigned long long*)((const bf16*)(ws + Z_VG) + (size_t)row * DM + h * 128 + 4 * l32);
    const f32x4 v = (f32x4){bflo_((unsigned)vw), bfhi_((unsigned)vw), bflo_((unsigned)(vw >> 32)), bfhi_((unsigned)(vw >> 32))};
    __syncthreads();
    const float* S0 = a.in[3] + ((size_t)(n * HG + h) * DKG) * DVG; float* S1 = a.out + OFF_HGS + ((size_t)(n * HG + h) * DKG) * DVG;
    f32x4 o = (f32x4){0.f, 0.f, 0.f, 0.f};
    f32x4 s[8];
#pragma unroll
    for (int i = 0; i < 8; ++i) s[i] = *(const f32x4*)(S0 + (size_t)(2 * (w + 8 * i) + half) * DVG + 4 * l32);
#pragma unroll
    for (int i = 0; i < 8; ++i) { const int k = 2 * (w + 8 * i) + half; const f32x4 sn = s[i] * fs[k] + v * ks[k]; *(f32x4*)(S1 + (size_t)k * DVG + 4 * l32) = sn; o += sn * qs[k]; }
    *(LAS f32x4*)(red + (2 * w + half) * 128 + 4 * l32) = o;
    __syncthreads();
    float ov = 0.f;
    if (tid < 128) {
#pragma unroll
        for (int i = 0; i < 16; ++i) ov += red[i * 128 + tid];
        const float ss = wave_sum(ov * ov); if (lane == 0) part[w] = ss;
    }
    __syncthreads();
    if (tid < 128) {
        const float rstd = rsqrtf((part[0] + part[1]) * (1.0f / DVG) + EPS);
        bf16* gp = (bf16*)(ws + WS_GG) + (size_t)row * DM + h * 128 + tid;
        *gp = (bf16)f2bf(ov * rstd * a.in[9][h * 128 + tid] * bf2f_(*gp));
    }
    __syncthreads();
}

__device__ __forceinline__ void p3_headnorm(Frame& F, const Args& a) { const int tid_v = tid_(); const int lane_v = tid_v & 63; const int wave_v = __builtin_amdgcn_readfirstlane(tid_v >> 6); (void)lane_v; (void)wave_v;
    unsigned char* ws = a.ws; const int gw = F.vcu * NWAVES + wave_v, NGW = F.G * NWAVES, lane = lane_v;
    for (int it = gw; it < MPROMPT * 8; it += NGW) {
        const bool isg = it >= MPROMPT * 4; const int i2 = isg ? it - MPROMPT * 4 : it; const int row = i2 >> 2, q = i2 & 3;
        const size_t off = (size_t)row * DM + q * 256 + 4 * lane;
        const unsigned long long ow = *(const unsigned long long*)((const bf16*)(ws + (isg ? Z_VG : Z_VR)) + off);
        unsigned long long* gp = (unsigned long long*)((bf16*)(ws + (isg ? WS_GG : WS_GR)) + off); const unsigned long long gwd = *gp;
        const f32x4 gn = *(const f32x4*)(a.in[isg ? 9 : 8] + q * 256 + 4 * lane);
        const f32x4 o = (f32x4){bflo_((unsigned)ow), bfhi_((unsigned)ow), bflo_((unsigned)(ow >> 32)), bfhi_((unsigned)(ow >> 32))};
        const f32x4 gt = (f32x4){bflo_((unsigned)gwd), bfhi_((unsigned)gwd), bflo_((unsigned)(gwd >> 32)), bfhi_((unsigned)(gwd >> 32))};
        float ss = (o.x * o.x + o.y * o.y) + (o.z * o.z + o.w * o.w);
#pragma unroll
        for (int d = 1; d < 32; d <<= 1) ss += __shfl_xor(ss, d);
        if (!isg) ss += __shfl_xor(ss, 32);
        const float rstd = rsqrtf(ss * (isg ? 1.0f / DVG : 1.0f / DVR) + EPS);
        const f32x4 x = o * rstd * gn * gt;
        *gp = (unsigned long long)pk2(x.x, x.y) | ((unsigned long long)pk2(x.z, x.w) << 32);
    }
}

__device__ __forceinline__ void p9_final(Frame& F, const Args& a) { const int tid_v = tid_(); const int lane_v = tid_v & 63; const int wave_v = __builtin_amdgcn_readfirstlane(tid_v >> 6); (void)lane_v; (void)wave_v;
    const int gw = F.vcu * NWAVES + wave_v, NGW = F.G * NWAVES, lane = lane_v; const float* PS3 = (const float*)(a.ws + WS_PS3); const float* gf = a.in[20];
    for (int m = gw; m < MTOT; m += NGW) {
        const float pv = m < MPROMPT ? (lane < 16 ? PS3[(size_t)m * 16 + lane] : 0.f) : ((const float*)(a.ws + WS_PSS3))[(size_t)(m - MPROMPT) * 64 + lane];
        const float rstd = rsqrtf(wave_sum(pv) * (1.0f / DM) + EPS);
        f32x4* r = (f32x4*)(a.out + (size_t)m * DM) + lane;
#pragma unroll
        for (int j = 0; j < 4; ++j) { const f32x4 gv = *((const f32x4*)gf + 64 * j + lane); r[64 * j] = r[64 * j] * rstd * gv; }
    }
}

template <int K, class FE> __device__ __forceinline__ void skinny_gemm(Frame& F, const bf16* As, const bf16* Wt, int N, const FE& fe) { const int tid_v = tid_(); const int lane_v = tid_v & 63; const int wave_v = __builtin_amdgcn_readfirstlane(tid_v >> 6); (void)lane_v; (void)wave_v;
    constexpr int KW = K / 4, NKS = KW / 32, CH_KS = NKS < 8 ? NKS : 8, NCH = NKS / CH_KS;
    const int lane = lane_v, fr = lane & 15, fq = lane >> 4, rg = wave_v >> 2, ks = wave_v & 3;
    LAS f32x4* red = (LAS f32x4*)(F.lds);
    const int ntile = 4 * (N / 16);
    for (int tile = F.vcu; tile < ntile; tile += F.G) {
        const int rb = tile & 3, cb = tile >> 2;
        const bf16* ap = Wt + (size_t)(16 * cb + fr) * K + ks * KW + 8 * fq;
        const bf16* bp = As + (size_t)(32 * rb + 16 * rg + fr) * K + ks * KW + 8 * fq;
        f32x4 acc = (f32x4){0.f, 0.f, 0.f, 0.f};
#pragma unroll 1
        for (int c = 0; c < NCH; ++c) {
            bf16x8 a[CH_KS], b[CH_KS];
#pragma unroll
            for (int i = 0; i < CH_KS; ++i) { a[i] = *(const bf16x8*)(ap + (c * CH_KS + i) * 32); b[i] = *(const bf16x8*)(bp + (c * CH_KS + i) * 32); }
#pragma unroll
            for (int i = 0; i < CH_KS; ++i) acc = __builtin_amdgcn_mfma_f32_16x16x32_bf16(a[i], b[i], acc, 0, 0, 0);
        }
        red[wave_v * 64 + lane] = acc;
        __syncthreads();
        if (ks == 0) {
            const f32x4 v = (red[(4 * rg + 0) * 64 + lane] + red[(4 * rg + 1) * 64 + lane]) + (red[(4 * rg + 2) * 64 + lane] + red[(4 * rg + 3) * 64 + lane]);
            fe(MPROMPT + 32 * rb + 16 * rg + fr, 16 * cb + 4 * fq, v);
        }
        __syncthreads();
    }
}
struct FeIn { pg8::EpiIn E; __device__ __forceinline__ void operator()(int row, int col, f32x4 v) const { pg8::samp_in(E, row, col, v); } };
template <int MODE> struct FeN { pg8::EpiN<MODE> E; const float* xs; float* PSS; const float* PSSin;
    __device__ __forceinline__ void operator()(int row, int col, f32x4 v) const { pg8::samp_n<MODE>(E, xs, PSS, PSSin, row, col, v); } };

__global__ void __launch_bounds__(NWAVES * 64, 2) fwd_kernel(Args args) {
#define tid_v ((int)threadIdx.x)
    extern __shared__ __attribute__((aligned(16))) unsigned char lds[];
    Frame F;
    F.lds = (LAS unsigned char*)lds;
    F.MISC = (volatile LAS unsigned*)(F.lds + MISC_OFF);
        F.G = gridDim.x; { const int bx = blockIdx.x; F.vcu = (F.G % 8 == 0) ? (bx % 8) * (F.G / 8) + bx / 8 : bx; }
    unsigned char* ws = args.ws;
    F.ctl = (gu32*)(ws + WS_CTL);
    for (int u = tid_v; u < (LDS_BYTES - LDSCTL_OFF) / 4; u += NWAVES * 64) ((LAS unsigned*)(F.lds + LDSCTL_OFF))[u] = 0u;
    __syncthreads();
    XcdBarrier bar; bar.bar = (unsigned*)(F.ctl + CW_BAR); bar.x = 0; bar.st = nullptr;
    if (args.use_bar) bar = xcd_barrier_post((unsigned*)(F.ctl + CW_BAR), F.MISC + 8);
    const int lo = args.ph_lo, hi = args.ph_hi;
#define IN(k) (lo <= (k) && (k) < hi)
#if PROBE_ON
    volatile LAS unsigned* PW = F.MISC + 16;
    if (tid_v == 0) { PW[0] = (unsigned)rt(); PW[1] = 0u; }
#define STAMP(k) do { if (blockIdx.x == 0 && tid_v == 0) { const unsigned t_ = (unsigned)rt(); unsigned q_ = (t_ - PW[0] + (unsigned)PROBE_UNIT / 2) / (unsigned)PROBE_UNIT; if (q_ > 49u) q_ = 49u; \
        if ((k) == PROBE_A) PW[1] += q_ * 400u; else if ((k) == PROBE_B) PW[1] += q_ * 20000u; else if ((k) == PROBE_C) PW[1] += q_ * 1000000u; PW[0] = t_; } } while (0)
#else
#define STAMP(k) do { } while (0)
#endif
#define SEAM(k) do { if (IN(k) && IN((k) + 1)) xcd_barrier(bar); STAMP(k); } while (0)
    using namespace pg8;
    bf16_t* XB = (bf16_t*)(args.out + OFF_RETS);
    bf16_t* AR = (bf16_t*)(args.out + OFF_Y); bf16_t* AH = AR + (size_t)MTOT * DM;
    float* R = args.out + OFF_Y;
    float* PS1 = (float*)(ws + WS_PS1); float* PS2 = (float*)(ws + WS_PS2); float* PS3 = (float*)(ws + WS_PS3);

    if (IN(0)) { p0_prologue(F, args); SEAM(0); }
    const bf16_t* SROW = nullptr; (void)SROW;
    float* PSS1 = (float*)(ws + WS_PSS1); float* PSS2 = (float*)(ws + WS_PSS2); float* PSS3 = (float*)(ws + WS_PSS3);
#define SAMP(buf, ld) ((const bf16*)(buf) + (size_t)MPROMPT * (ld))
    if (IN(1)) {
        Gemm g{XB, (const bf16_t*)(ws + WS_WIN), MPROMPT, DIN, DM}; StaticOrder S; S.init(MPROMPT, DIN, F.G, (int)blockIdx.x);
        EpiIn E{(const float*)(ws + WS_RSTD0), (const float*)(ws + WS_CS), (const float*)(ws + WS_LB),
                (bf16_t*)(ws + Z_QR), (bf16_t*)(ws + Z_KR), (bf16_t*)(ws + Z_VR), (bf16_t*)(ws + WS_GR), (bf16_t*)(ws + Z_QG), (bf16_t*)(ws + Z_KG), (bf16_t*)(ws + Z_VG), (bf16_t*)(ws + WS_GG),
                AR, AH, (float*)(ws + WS_GL), (float*)(ws + WS_FS)};
        gemm_phase<EpiIn, StaticOrder, true, true>(F.lds + RING_OFF, g, S, E);
        { FeIn fe{E}; skinny_gemm<DM>(F, SAMP(XB, DM), (const bf16*)(ws + WS_WIN), DIN, fe); }
        SEAM(1);
    }
    if (IN(2)) {
        for (int it = F.vcu; it < 256; it += F.G) scan_item(F, args, it);
        for (int it = F.vcu; it < NDEC * HR; it += F.G) decode_ret(F, args, it);
        for (int it = F.vcu; it < NDEC * HG; it += F.G) decode_hg(F, args, it);
        SEAM(2);
    }
    if (IN(3)) { p3_headnorm(F, args); SEAM(3); }
    if (IN(4)) {
        { Gemm g{(const bf16_t*)(ws + WS_GG), (const bf16_t*)(ws + WS_WUPH), MPROMPT, DM, DM}; StaticOrder S; S.init(MPROMPT, DM, F.G, (int)blockIdx.x);
          EpiN<0> E{AH, (bf16_t*)(ws + WS_MB), DM, nullptr, nullptr, nullptr, nullptr, nullptr, nullptr};
          gemm_phase<EpiN<0>, StaticOrder, true, true>(F.lds + RING_OFF, g, S, E);
          FeN<0> fe{E, nullptr, nullptr, nullptr}; skinny_gemm<DM>(F, SAMP(ws + WS_GG, DM), (const bf16*)(ws + WS_WUPH), DM, fe); }
        { Gemm g{(const bf16_t*)(ws + WS_GR), (const bf16_t*)(ws + WS_WUPR), MPROMPT, DM, DM}; StaticOrder S; S.init(MPROMPT, DM, F.G, (int)blockIdx.x);
          EpiN<1> E{AR, (bf16_t*)(ws + WS_MB), DM, nullptr, nullptr, nullptr, nullptr, nullptr, nullptr};
          gemm_phase<EpiN<1>, StaticOrder, true, true>(F.lds + RING_OFF, g, S, E);
          FeN<1> fe{E, nullptr, nullptr, nullptr}; skinny_gemm<DM>(F, SAMP(ws + WS_GR, DM), (const bf16*)(ws + WS_WUPR), DM, fe); }
        SEAM(4);
    }
    if (IN(5)) {
        Gemm g{(const bf16_t*)(ws + WS_MB), (const bf16_t*)(ws + WS_WO), MPROMPT, DM, DM}; StaticOrder S; S.init(MPROMPT, DM, F.G, (int)blockIdx.x);
        EpiN<2> E{nullptr, (bf16_t*)(ws + WS_A5), DM, args.in[0], nullptr, R, args.in[14], PS1, nullptr};
        gemm_phase<EpiN<2>, StaticOrder, true, true>(F.lds + RING_OFF, g, S, E);
        FeN<2> fe{E, args.in[1], PSS1, nullptr}; skinny_gemm<DM>(F, SAMP(ws + WS_MB, DM), (const bf16*)(ws + WS_WO), DM, fe);
        SEAM(5);
    }
    if (IN(6)) {
        Gemm g{(const bf16_t*)(ws + WS_A5), (const bf16_t*)(ws + WS_WFF1), MPROMPT, DFF, DM}; StaticOrder S; S.init(MPROMPT, DFF, F.G, (int)blockIdx.x);
        EpiN<3> E{nullptr, (bf16_t*)(ws + WS_H), DFF, nullptr, nullptr, nullptr, nullptr, nullptr, PS1};
        gemm_phase<EpiN<3>, StaticOrder, true, true>(F.lds + RING_OFF, g, S, E);
        FeN<3> fe{E, nullptr, nullptr, PSS1}; skinny_gemm<DM>(F, SAMP(ws + WS_A5, DM), (const bf16*)(ws + WS_WFF1), DFF, fe);
        SEAM(6);
    }
    if (IN(7)) {
        Gemm g{(const bf16_t*)(ws + WS_H), (const bf16_t*)(ws + WS_WFF2), MPROMPT, DM, DFF}; StaticOrder S; S.init(MPROMPT, DM, F.G, (int)blockIdx.x);
        EpiN<2> E{nullptr, (bf16_t*)(ws + WS_A7), DM, R, nullptr, R, args.in[17], PS2, nullptr};
        gemm_phase<EpiN<2>, StaticOrder, true, true>(F.lds + RING_OFF, g, S, E);
        FeN<2> fe{E, nullptr, PSS2, nullptr}; skinny_gemm<DFF>(F, SAMP(ws + WS_H, DFF), (const bf16*)(ws + WS_WFF2), DM, fe);
        SEAM(7);
    }
    if (IN(8)) {
        { Gemm g{(const bf16_t*)(ws + WS_A7), (const bf16_t*)(ws + WS_WGATE), MPROMPT, DM, DM}; StaticOrder S; S.init(MPROMPT, DM, F.G, (int)blockIdx.x);
          EpiN<4> E{nullptr, (bf16_t*)(ws + WS_MB), DM, nullptr, nullptr, nullptr, nullptr, nullptr, PS2};
          gemm_phase<EpiN<4>, StaticOrder, true, true>(F.lds + RING_OFF, g, S, E);
          FeN<4> fe{E, nullptr, nullptr, PSS2}; skinny_gemm<DM>(F, SAMP(ws + WS_A7, DM), (const bf16*)(ws + WS_WGATE), DM, fe); }
        { Gemm g{(const bf16_t*)(ws + WS_PB), (const bf16_t*)(ws + WS_WPROJ), MPROMPT, DM, DPLE}; StaticOrder S; S.init(MPROMPT, DM, F.G, (int)blockIdx.x);
          EpiN<5> E{nullptr, (bf16_t*)(ws + WS_MB), DM, nullptr, nullptr, R, nullptr, PS3, nullptr};
          gemm_phase<EpiN<5>, StaticOrder, true, true>(F.lds + RING_OFF, g, S, E);
          FeN<5> fe{E, nullptr, PSS3, nullptr}; skinny_gemm<DPLE>(F, SAMP(ws + WS_PB, DPLE), (const bf16*)(ws + WS_WPROJ), DM, fe); }
        SEAM(8);
    }
    if (IN(9)) { p9_final(F, args); }
#if PROBE_ON
    STAMP(9);
    if (blockIdx.x == 0 && tid_v == 0) { const unsigned t0_ = (unsigned)rt(); const unsigned dly_ = PW[1]; while ((unsigned)rt() - t0_ < dly_) __builtin_amdgcn_s_sleep(16); }
#endif
#undef IN
#undef SEAM
#undef tid_v
}

extern "C" void kernel_launch(void* const* d_in, const int* in_sizes, int n_in, void* d_out, int out_size, void* d_ws, size_t ws_size, hipStream_t stream) {
    static int grid = 0;
    if (grid == 0) {
        if (n_in != 21 || out_size != (int)OUT_TOTAL || ws_size < WS_END) { fprintf(stderr, "kernel_launch: unexpected problem (n_in %d out %d ws %zu need %zu)\n", n_in, out_size, ws_size, (size_t)WS_END); grid = -1; return; }
        int dev = 0, cus = 0;
        if (hipGetDevice(&dev) != hipSuccess || hipDeviceGetAttribute(&cus, hipDeviceAttributeMultiprocessorCount, dev) != hipSuccess) { grid = -1; return; }
        if (hipFuncSetAttribute((const void*)fwd_kernel, hipFuncAttributeMaxDynamicSharedMemorySize, LDS_BYTES) != hipSuccess) { fprintf(stderr, "kernel_launch: hipFuncSetAttribute failed\n"); grid = -1; return; }
        (void)hipGetLastError();
        grid = cus;
    }
    if (grid < 0) return;
    (void)hipMemsetAsync((char*)d_ws + WS_CTL, 0, CTL_ZERO_BYTES, stream);
    Args a{};
    for (int i = 0; i < 21; ++i) a.in[i] = (const float*)d_in[i];
    a.out = (float*)d_out; a.ws = (unsigned char*)d_ws;
#if MK_ONE_LAUNCH
    a.ph_lo = 0; a.ph_hi = NPH; a.use_bar = 1;
    hipLaunchKernelGGL(fwd_kernel, dim3(grid), dim3(NWAVES * 64), LDS_BYTES, stream, a);
#else
    for (int p = 0; p < NPH; ++p) { a.ph_lo = p; a.ph_hi = p + 1; a.use_bar = 0; hipLaunchKernelGGL(fwd_kernel, dim3(grid), dim3(NWAVES * 64), LDS_BYTES, stream, a); }
#endif
}
```

```cpp
#include <hip/hip_runtime.h>
#include <cstdio>
#include <cstdint>
namespace pg8 {
#define PG8_LAS __attribute__((address_space(3)))
typedef unsigned short bf16_t;
typedef short bf16x8 __attribute__((ext_vector_type(8)));
typedef float f32x4 __attribute__((ext_vector_type(4)));
typedef unsigned u32x4 __attribute__((ext_vector_type(4)));
constexpr int BM = 256, BK = 64, HALF = 128, HTB = HALF * BK * 2  , STAGE_BYTES = 8 * HTB, NXCD = 8, WGM = 8;

__host__ __device__ __forceinline__ int lds_byte(int r, int c) { const int st = (r >> 4) * 2 + (c >> 5), rr = r & 15, cc = c & 31, ob = rr * 64 + cc * 2; return st * 1024 + (ob ^ (((ob >> 9) & 1) << 5)); }
__host__ __device__ __forceinline__ void stage_rc(int b, int& R, int& C) { const int st = b / 1024, sb = b % 1024, swz = sb ^ (((sb >> 9) & 1) << 5); R = (st >> 1) * 16 + swz / 64; C = (st & 1) * 32 + (swz % 64) / 2; }
__host__ __device__ __forceinline__ int perm32(int rho) { const int n = rho >> 4, i = rho & 15; return 8 * (i >> 2) + 4 * n + (i & 3); }

struct Unit { int pm, pn; };
struct Gemm { const bf16_t* A; const bf16_t* Bt; int M, N, K; };

struct StaticOrder {
    int nM, nN, nwg, G, c;
    __host__ __device__ void init(int M, int N, int G_, int c_) { nM = M / BM; nN = N / BM; nwg = nM * nN; G = G_; c = c_; }
    __host__ __device__ bool next(int i, Unit& u) const {
        const long L = (long)i * G + c; if (L >= nwg) return false;
        int wgid = (int)L; { const int q = nwg / NXCD, r = nwg % NXCD, xcd = wgid % NXCD, off = wgid / NXCD; wgid = (xcd < r ? xcd * (q + 1) : r * (q + 1) + (xcd - r) * q) + off; }
        const int nig = WGM * nN, gid = wgid / nig, fm = gid * WGM, gsz = (nM - fm) < WGM ? (nM - fm) : WGM;
        u.pm = fm + ((wgid % nig) % gsz); u.pn = (wgid % nig) / gsz; return true;
    }
    __device__ __forceinline__ void a_ready(const Unit&) const {}
    __device__ __forceinline__ void done(const Unit&) const {}
};

__device__ __forceinline__ unsigned cvt_pk_bf16(float lo, float hi) { unsigned r; asm volatile("v_cvt_pk_bf16_f32 %0, %1, %2" : "=v"(r) : "v"(lo), "v"(hi)); return r; }

template <class Epi, class Sched, bool ALIGN_EPI = false, bool SP2 = false>
__device__ __forceinline__ void gemm_phase(PG8_LAS unsigned char* lds, const Gemm g, const Sched& S, const Epi& E) {
    const int tid = threadIdx.x, wid = __builtin_amdgcn_readfirstlane(tid >> 6), lane = tid & 63, wr = wid >> 2, wc = wid & 3, fr = lane & 15, fq = lane >> 4;
    const int K = g.K, nt = K / BK;
    unsigned voffA[2], voffB[2];
#pragma unroll
    for (int i = 0; i < 2; ++i) { int R, C; stage_rc(tid * 16 + i * 8192, R, C); const int Rb = Epi::PERM ? ((R & ~31) + perm32(R & 31)) : R;
        voffA[i] = (unsigned)(R * K + C) * 2u; voffB[i] = (unsigned)(Rb * K + C) * 2u; }
    const size_t kstep = (size_t)(BK * 2);
    const size_t hstep = (size_t)HALF * K * 2;
    const size_t tstep = 2 * hstep;
    const unsigned ldsw = (unsigned)wid * 1024u;
    const int aoff = lds_byte(wr * 64 + fr, fq * 8), boff = lds_byte(wc * 32 + fr, fq * 8);
#define PG8_SA(b, h) (((b) * 2 + (h)) * HTB)
#define PG8_SB(b, h) ((4 + (b) * 2 + (h)) * HTB)
#define PG8_STAGE(bufoff, gbase, voff) do { _Pragma("unroll") for (int _i = 0; _i < 2; ++_i) \
        __builtin_amdgcn_global_load_lds((const unsigned*)((const char*)(gbase) + (voff)[_i]), (PG8_LAS unsigned*)(lds + (bufoff) + ldsw + _i * 8192), 16, 0, 0); } while (0)
#define PG8_LDA(dst, b, h) do { _Pragma("unroll") for (int m = 0; m < 4; ++m) _Pragma("unroll") for (int k = 0; k < 2; ++k) dst[m][k] = *(const PG8_LAS bf16x8*)(lds + PG8_SA(b, h) + aoff + m * 2048 + k * 1024); } while (0)
#define PG8_LDB(dst, b, h) do { _Pragma("unroll") for (int n = 0; n < 2; ++n) _Pragma("unroll") for (int k = 0; k < 2; ++k) dst[n][k] = *(const PG8_LAS bf16x8*)(lds + PG8_SB(b, h) + boff + n * 2048 + k * 1024); } while (0)
#define PG8_MMA(ai, bj, At, Bt) do { __builtin_amdgcn_s_setprio(1); _Pragma("unroll") for (int m = 0; m < 4; ++m) _Pragma("unroll") for (int n = 0; n < 2; ++n) _Pragma("unroll") for (int k = 0; k < 2; ++k) \
        acc[ai][bj][m][n] = __builtin_amdgcn_mfma_f32_16x16x32_bf16(Bt[n][k], At[m][k], acc[ai][bj][m][n], 0, 0, 0); __builtin_amdgcn_s_setprio(0); } while (0)
#define PG8_WAIT_V(n) asm volatile("s_waitcnt vmcnt(" #n ")" ::: "memory")
#define PG8_WAIT_L(n) asm volatile("s_waitcnt lgkmcnt(" #n ")" ::: "memory")
#define PG8_BAR __builtin_amdgcn_s_barrier()
#define PG8_SCHED __builtin_amdgcn_sched_barrier(0)
    Unit cur, nxt; int ui = 0;
    if (!S.next(0, cur)) return;
    f32x4 acc[2][2][4][2];
#pragma unroll
    for (int a = 0; a < 2; ++a)
#pragma unroll
        for (int b = 0; b < 2; ++b)
#pragma unroll
            for (int m = 0; m < 4; ++m)
#pragma unroll
                for (int n = 0; n < 2; ++n) acc[a][b][m][n] = (f32x4){0.f, 0.f, 0.f, 0.f};
    bf16x8 At[4][2], B0[2][2], B1[2][2];
    const char* cA = (const char*)g.A + (size_t)cur.pm * tstep; const char* cB = (const char*)g.Bt + (size_t)cur.pn * tstep;
    S.a_ready(cur);
    if constexpr (SP2) {
        PG8_STAGE(PG8_SB(0, 0), cB, voffB); PG8_STAGE(PG8_SB(0, 1), cB + hstep, voffB); PG8_STAGE(PG8_SA(0, 0), cA, voffA); PG8_STAGE(PG8_SA(0, 1), cA + hstep, voffA);
        if (wr == 1) PG8_BAR;
        PG8_WAIT_V(2); PG8_BAR;
        PG8_STAGE(PG8_SB(1, 0), cB + kstep, voffB); PG8_STAGE(PG8_SA(1, 0), cA + kstep, voffA); PG8_STAGE(PG8_SB(1, 1), cB + hstep + kstep, voffB);
        PG8_WAIT_V(6); PG8_BAR;
    } else {
        PG8_STAGE(PG8_SB(0, 0), cB, voffB); PG8_STAGE(PG8_SA(0, 0), cA, voffA); PG8_STAGE(PG8_SB(0, 1), cB + hstep, voffB); PG8_STAGE(PG8_SA(0, 1), cA + hstep, voffA);
        if (wr == 1) PG8_BAR;
        PG8_WAIT_V(4); PG8_BAR;
        PG8_STAGE(PG8_SB(1, 0), cB + kstep, voffB); PG8_STAGE(PG8_SA(1, 0), cA + kstep, voffA); PG8_STAGE(PG8_SB(1, 1), cB + hstep + kstep, voffB);
        PG8_WAIT_V(6); PG8_BAR;
    }
    for (;;) {
        const bool has_next = S.next(ui + 1, nxt);
        const char* nA = has_next ? (const char*)g.A + (size_t)nxt.pm * tstep : cA; const char* nB = has_next ? (const char*)g.Bt + (size_t)nxt.pn * tstep : cB;
        for (int t = 0; t < nt; t += 2) {
            const bool last = (t == nt - 2);
            const char* a1 = cA + (size_t)(t + 1) * kstep;
            const char* a2 = last ? nA : cA + (size_t)(t + 2) * kstep; const char* b2 = last ? nB : cB + (size_t)(t + 2) * kstep;
            const char* a3 = a2 + kstep; const char* b3 = b2 + kstep;
            if (last && has_next) S.a_ready(nxt);
            if constexpr (SP2) {
            PG8_LDB(B0, 0, 0); PG8_LDB(B1, 0, 1); PG8_SCHED; PG8_LDA(At, 0, 0); PG8_STAGE(PG8_SA(1, 1), a1 + hstep, voffA);
            PG8_WAIT_V(8); PG8_WAIT_L(0); PG8_BAR; PG8_MMA(0, 0, At, B0); PG8_MMA(0, 1, At, B1); PG8_BAR; PG8_SCHED;
            PG8_LDA(At, 0, 1); PG8_STAGE(PG8_SB(0, 0), b2, voffB); PG8_STAGE(PG8_SB(0, 1), b2 + hstep, voffB); PG8_STAGE(PG8_SA(0, 0), a2, voffA);
            PG8_WAIT_V(8); PG8_WAIT_L(0); PG8_BAR; PG8_MMA(1, 0, At, B0); PG8_MMA(1, 1, At, B1); PG8_BAR; PG8_SCHED;
            PG8_LDB(B0, 1, 0); PG8_LDB(B1, 1, 1); PG8_SCHED; PG8_LDA(At, 1, 0); PG8_STAGE(PG8_SA(0, 1), a2 + hstep, voffA);
            PG8_WAIT_V(8); PG8_WAIT_L(0); PG8_BAR; PG8_MMA(0, 0, At, B0); PG8_MMA(0, 1, At, B1); PG8_BAR; PG8_SCHED;
            PG8_LDA(At, 1, 1); PG8_STAGE(PG8_SB(1, 0), b3, voffB); PG8_STAGE(PG8_SB(1, 1), b3 + hstep, voffB); PG8_STAGE(PG8_SA(1, 0), a3, voffA);
            PG8_WAIT_V(8); PG8_WAIT_L(0); PG8_BAR; PG8_MMA(1, 0, At, B0); PG8_MMA(1, 1, At, B1); PG8_BAR; PG8_SCHED;
            } else {
            PG8_LDB(B0, 0, 0); PG8_SCHED; PG8_LDA(At, 0, 0); PG8_STAGE(PG8_SA(1, 1), a1 + hstep, voffA);
            PG8_WAIT_L(8); PG8_BAR; PG8_WAIT_L(0); PG8_MMA(0, 0, At, B0); PG8_BAR; PG8_SCHED;
            PG8_LDB(B1, 0, 1); PG8_STAGE(PG8_SB(0, 0), b2, voffB);
            PG8_BAR; PG8_WAIT_L(0); PG8_MMA(0, 1, At, B1); PG8_BAR;
            PG8_LDA(At, 0, 1); PG8_STAGE(PG8_SA(0, 0), a2, voffA);
            PG8_BAR; PG8_WAIT_L(0); PG8_MMA(1, 0, At, B0); PG8_BAR; PG8_SCHED;
            PG8_STAGE(PG8_SB(0, 1), b2 + hstep, voffB);
            PG8_WAIT_V(6); PG8_BAR; PG8_MMA(1, 1, At, B1); PG8_BAR;
            PG8_LDB(B0, 1, 0); PG8_SCHED; PG8_LDA(At, 1, 0); PG8_STAGE(PG8_SA(0, 1), a2 + hstep, voffA);
            PG8_WAIT_L(8); PG8_BAR; PG8_WAIT_L(0); PG8_MMA(0, 0, At, B0); PG8_BAR; PG8_SCHED;
            PG8_LDB(B1, 1, 1); PG8_STAGE(PG8_SB(1, 0), b3, voffB);
            PG8_BAR; PG8_WAIT_L(0); PG8_MMA(0, 1, At, B1); PG8_BAR;
            PG8_LDA(At, 1, 1); PG8_STAGE(PG8_SA(1, 0), a3, voffA);
            PG8_BAR; PG8_WAIT_L(0); PG8_MMA(1, 0, At, B0); PG8_BAR; PG8_SCHED;
            PG8_STAGE(PG8_SB(1, 1), b3 + hstep, voffB);
            PG8_WAIT_V(6); PG8_BAR; PG8_MMA(1, 1, At, B1); PG8_BAR;
            }
        }
        if constexpr (ALIGN_EPI) { if (wr == 0) PG8_BAR; }
        if constexpr (!Epi::AFTER_DRAIN) { E(acc, cur, wr, wc, fr, fq); S.done(cur); }
        if (!has_next) break;
#pragma unroll
        for (int a = 0; a < 2; ++a)
#pragma unroll
            for (int b = 0; b < 2; ++b)
#pragma unroll
                for (int m = 0; m < 4; ++m)
#pragma unroll
                    for (int n = 0; n < 2; ++n) acc[a][b][m][n] = (f32x4){0.f, 0.f, 0.f, 0.f};
        cur = nxt; cA = nA; cB = nB; ++ui;
        if constexpr (ALIGN_EPI) { if (wr == 1) PG8_BAR; }
    }
    PG8_WAIT_V(0);
    if constexpr (!ALIGN_EPI) { if (wr == 0) PG8_BAR; }
    PG8_BAR;
    if constexpr (Epi::AFTER_DRAIN) { E.fused(acc, cur, wr, wc, fr, fq, lds, wid, lane); S.done(cur); }
#undef PG8_SA
#undef PG8_SB
#undef PG8_STAGE
#undef PG8_LDA
#undef PG8_LDB
#undef PG8_MMA
#undef PG8_WAIT_V
#undef PG8_WAIT_L
#undef PG8_BAR
#undef PG8_SCHED
}
}


constexpr int DM = 1024, NB = 8, SEQ = 2048, NDEC = 128, MPROMPT = NB * SEQ, MTOT = MPROMPT + NDEC, MP = 16640  ;
constexpr int HR = 4, DKR = 128, DVR = 256, HG = 8, DKG = 128, DVG = 128, DFF = 4096, DPLE = 256, DIN = 9216, CH = 64, NCHUNK = MPROMPT / CH;
constexpr float EPS = 1e-6f;
constexpr size_t OFF_Y = 0, OFF_RETP = (size_t)MTOT * DM, OFF_HGP = OFF_RETP + (size_t)NB * HR * DKR * DVR, OFF_RETS = OFF_HGP + (size_t)NB * HG * DKG * DVG,
                 OFF_HGS = OFF_RETS + (size_t)NDEC * HR * DKR * DVR, OUT_TOTAL = OFF_HGS + (size_t)NDEC * HG * DKG * DVG;
static_assert(OUT_TOTAL == 52559872, "output size");

namespace pg8 {
typedef unsigned u32x2 __attribute__((ext_vector_type(2)));
typedef float f32x2 __attribute__((ext_vector_type(2)));
__device__ __forceinline__ float bf2f(unsigned short b) { return __uint_as_float((unsigned)b << 16); }
__device__ __forceinline__ float bflo(unsigned w) { return __uint_as_float(w << 16); }
__device__ __forceinline__ float bfhi(unsigned w) { return __uint_as_float(w & 0xffff0000u); }
__device__ __forceinline__ float sigmoidf_(float x) { return 1.0f / (1.0f + __expf(-x)); }
__device__ __forceinline__ float siluf_(float x) { return x / (1.0f + __expf(-x)); }
__device__ __forceinline__ u32x2 pack4(f32x4 v) { u32x2 w; w.x = cvt_pk_bf16(v[0], v[1]); w.y = cvt_pk_bf16(v[2], v[3]); return w; }
__device__ __forceinline__ f32x4 unpack4(u32x2 w) { return (f32x4){bflo(w.x), bfhi(w.x), bflo(w.y), bfhi(w.y)}; }

typedef unsigned u32x4 __attribute__((ext_vector_type(4)));
#define DPP_ROW_SHR(x, n) __int_as_float(__builtin_amdgcn_update_dpp(0, __float_as_int(x), 0x110 + (n), 0xf, 0xf, true))
#define DPP_ROW_BCAST15(x) __int_as_float(__builtin_amdgcn_update_dpp(0, __float_as_int(x), 0x15F, 0xf, 0xf, false))
struct EpiIn {
    static constexpr bool PERM = true, AFTER_DRAIN = false;
    const float* rstd0; const float* cs; const float* lb;
    bf16_t *QR, *KR, *VR, *GR, *QG, *KG, *VG, *GG, *AR, *AH; float *GL, *FS;
    __device__ __forceinline__ void operator()(const f32x4 (&acc)[2][2][4][2], const Unit& u, int wr, int wc, int fr, int fq) const {
        const int pn = u.pn;
#pragma unroll
        for (int ai = 0; ai < 2; ++ai) {
            const int rbase = u.pm * BM + ai * HALF + wr * 64;
            float rs[4];
#pragma unroll
            for (int m = 0; m < 4; ++m) rs[m] = rstd0[rbase + m * 16 + fr];
            if (pn < 4) {
                const bool isk = pn >= 2; bf16_t* dst = isk ? KR : QR;
#pragma unroll
                for (int bj = 0; bj < 2; ++bj) {
                    const int head = 2 * (pn & 1) + bj;
                    const float lg = __logf(1.0f - exp2f(-5.0f - (float)head));
                    const int j0 = 16 * wc + 4 * fq;
#pragma unroll
                    for (int m = 0; m < 4; ++m) {
                        const int row = rbase + m * 16 + fr; const int pidx = row & (SEQ - 1);
                        const float e = lg * (float)(m * 16 + fr + 1);
                        const float sc = rs[m] * (isk ? 0.08838834764831845f * __expf(-e) : __expf(e));
                        const f32x4 t0 = *(const f32x4*)(cs + ((size_t)pidx * 64 + j0) * 2), t1 = *(const f32x4*)(cs + ((size_t)pidx * 64 + j0 + 2) * 2);
                        const f32x4 v0 = acc[ai][bj][m][0] * sc, v1 = acc[ai][bj][m][1] * sc;
                        u32x2 o1, o2;
                        o1.x = cvt_pk_bf16(v0[0] * t0[0] - v0[1] * t0[1], v0[2] * t0[2] - v0[3] * t0[3]); o1.y = cvt_pk_bf16(v1[0] * t1[0] - v1[1] * t1[1], v1[2] * t1[2] - v1[3] * t1[3]);
                        o2.x = cvt_pk_bf16(v0[0] * t0[1] + v0[1] * t0[0], v0[2] * t0[3] + v0[3] * t0[2]); o2.y = cvt_pk_bf16(v1[0] * t1[1] + v1[1] * t1[0], v1[2] * t1[3] + v1[3] * t1[2]);
                        bf16_t* p = dst + (size_t)row * 512 + head * 128 + j0;
                        *(u32x2*)p = o1; *(u32x2*)(p + 64) = o2;
                    }
                }
            } else if (pn >= 12 && pn < 20) {
                const int head = pn - 12;
#pragma unroll
                for (int bj = 0; bj < 2; ++bj) {
                    const int j0 = 64 * bj + 16 * wc + 4 * fq, c = head * 128 + j0;
                    const f32x4 lbv = *(const f32x4*)(lb + c);
                    float qa[4][4], ka[4][4], ba[4][4];
#pragma unroll
                    for (int q = 0; q < 4; ++q) {
                        const int n = q >> 1, e = q & 1; const float one_m_lb = 1.0f - lbv[q]; float carry = 0.f;
#pragma unroll
                        for (int m = 0; m < 4; ++m) {
                            const float vq = acc[ai][bj][m][n][2 * e] * rs[m], vf = acc[ai][bj][m][n][2 * e + 1] * rs[m];
                            const float kk = one_m_lb / (1.0f + __expf(vf));
                            float x = __logf(1.0f - kk);
                            x += DPP_ROW_SHR(x, 1); x += DPP_ROW_SHR(x, 2); x += DPP_ROW_SHR(x, 4); x += DPP_ROW_SHR(x, 8);
                            x += carry; carry = DPP_ROW_BCAST15(x);
                            qa[m][q] = siluf_(vq); ka[m][q] = kk; ba[m][q] = x;
                        }
                    }
#pragma unroll
                    for (int m = 0; m < 4; ++m) {
                        const int row = rbase + m * 16 + fr;
                        const float e0 = __expf(ba[m][0]), e1 = __expf(ba[m][1]), e2 = __expf(ba[m][2]), e3 = __expf(ba[m][3]);
                        u32x2 qw, kw;
                        qw.x = cvt_pk_bf16(qa[m][0] * e0, qa[m][1] * e1); qw.y = cvt_pk_bf16(qa[m][2] * e2, qa[m][3] * e3);
                        kw.x = cvt_pk_bf16(ka[m][0] * __expf(-ba[m][0]), ka[m][1] * __expf(-ba[m][1])); kw.y = cvt_pk_bf16(ka[m][2] * __expf(-ba[m][2]), ka[m][3] * __expf(-ba[m][3]));
                        *(u32x2*)(QG + (size_t)row * DM + c) = qw; *(u32x2*)(KG + (size_t)row * DM + c) = kw;
                        if (m == 3 && fr == 15) *(f32x4*)(GL + (size_t)(row >> 6) * DM + c) = (f32x4){e0, e1, e2, e3};
                    }
                }
            } else {
                int mode, cbase; bf16_t* dst;
                if (pn < 8) { dst = VR; cbase = (pn - 4) * BM; mode = 0; } else if (pn < 12) { dst = GR; cbase = (pn - 8) * BM; mode = 1; }
                else if (pn < 24) { dst = VG; cbase = (pn - 20) * BM; mode = 0; } else if (pn < 28) { dst = GG; cbase = (pn - 24) * BM; mode = 1; }
                else if (pn < 32) { dst = AR; cbase = (pn - 28) * BM; mode = 2; } else { dst = AH; cbase = (pn - 32) * BM; mode = 2; }
#pragma unroll
                for (int m = 0; m < 4; ++m) {
                    const int row = rbase + m * 16 + fr;
#pragma unroll
                    for (int bj = 0; bj < 2; ++bj) {
                        f32x4 v0 = acc[ai][bj][m][0] * rs[m], v1 = acc[ai][bj][m][1] * rs[m];
                        if (mode == 1) { v0[0] = siluf_(v0[0]); v0[1] = siluf_(v0[1]); v0[2] = siluf_(v0[2]); v0[3] = siluf_(v0[3]); v1[0] = siluf_(v1[0]); v1[1] = siluf_(v1[1]); v1[2] = siluf_(v1[2]); v1[3] = siluf_(v1[3]); }
                        else if (mode == 2) { v0[0] = sigmoidf_(v0[0]); v0[1] = sigmoidf_(v0[1]); v0[2] = sigmoidf_(v0[2]); v0[3] = sigmoidf_(v0[3]); v1[0] = sigmoidf_(v1[0]); v1[1] = sigmoidf_(v1[1]); v1[2] = sigmoidf_(v1[2]); v1[3] = sigmoidf_(v1[3]); }
                        const u32x2 a = pack4(v0), b = pack4(v1);
                        *(u32x4*)(dst + (size_t)row * DM + cbase + bj * HALF + wc * 32 + fq * 8) = (u32x4){a.x, a.y, b.x, b.y};
                    }
                }
            }
        }
    }
};

__device__ __forceinline__ void unpack8(u32x4 w, f32x4& a, f32x4& b) { a = (f32x4){bflo(w.x), bfhi(w.x), bflo(w.y), bfhi(w.y)}; b = (f32x4){bflo(w.z), bfhi(w.z), bflo(w.w), bfhi(w.w)}; }
__device__ __forceinline__ u32x4 pack8(f32x4 a, f32x4 b) { const u32x2 x = pack4(a), y = pack4(b); return (u32x4){x.x, x.y, y.x, y.y}; }
__device__ __forceinline__ float sumsq4(f32x4 r) { return (r[0] * r[0] + r[1] * r[1]) + (r[2] * r[2] + r[3] * r[3]); }
template <int MODE> struct EpiN {
    static constexpr bool PERM = true, AFTER_DRAIN = false;
    const bf16_t* gate; bf16_t* out16; int ld16; const float* xp; const float* xs; float* R; const float* g; float* PS; const float* PSin;
    __device__ __forceinline__ void operator()(const f32x4 (&acc)[2][2][4][2], const Unit& u, int wr, int wc, int fr, int fq) const {
#pragma unroll
        for (int ai = 0; ai < 2; ++ai) {
            const int rbase = u.pm * BM + ai * HALF + wr * 64;
#pragma unroll
            for (int m = 0; m < 4; ++m) {
                const int row = rbase + m * 16 + fr;
                float rstd = 1.f;
                if (MODE == 3 || MODE == 4) {
                    const f32x4* p = (const f32x4*)(PSin + (size_t)row * 16); const f32x4 a = p[0], b = p[1], c = p[2], d = p[3];
                    const float s = ((a[0] + a[1]) + (a[2] + a[3])) + ((b[0] + b[1]) + (b[2] + b[3])) + ((c[0] + c[1]) + (c[2] + c[3])) + ((d[0] + d[1]) + (d[2] + d[3]));
                    rstd = rsqrtf(s * (1.0f / 1024.0f) + EPS);
                }
                float ss = 0.f;
#pragma unroll
                for (int bj = 0; bj < 2; ++bj) {
                    const int col = u.pn * BM + bj * HALF + wc * 32 + fq * 8;
                    const f32x4 a0 = acc[ai][bj][m][0], a1 = acc[ai][bj][m][1];
                    if (MODE == 0) { f32x4 g0, g1; unpack8(*(const u32x4*)(gate + (size_t)row * DM + col), g0, g1); *(u32x4*)(out16 + (size_t)row * ld16 + col) = pack8(g0 * a0, g1 * a1); }
                    else if (MODE == 1) { f32x4 g0, g1, t0, t1; unpack8(*(const u32x4*)(gate + (size_t)row * DM + col), g0, g1); u32x4* o = (u32x4*)(out16 + (size_t)row * ld16 + col); unpack8(*o, t0, t1); *o = pack8(t0 + g0 * a0, t1 + g1 * a1); }
                    else if (MODE == 2) {
                        const float* bp = xp + (size_t)row * DM + col;
                        const f32x4 r0 = *(const f32x4*)bp + a0, r1 = *(const f32x4*)(bp + 4) + a1; float* rp = R + (size_t)row * DM + col; *(f32x4*)rp = r0; *(f32x4*)(rp + 4) = r1;
                        ss += sumsq4(r0) + sumsq4(r1);
                        *(u32x4*)(out16 + (size_t)row * ld16 + col) = pack8(r0 * *(const f32x4*)(g + col), r1 * *(const f32x4*)(g + col + 4));
                    }
                    else if (MODE == 3) { f32x4 v0 = a0 * rstd, v1 = a1 * rstd;
                        v0[0] = fmaxf(v0[0], 0.f); v0[1] = fmaxf(v0[1], 0.f); v0[2] = fmaxf(v0[2], 0.f); v0[3] = fmaxf(v0[3], 0.f); v1[0] = fmaxf(v1[0], 0.f); v1[1] = fmaxf(v1[1], 0.f); v1[2] = fmaxf(v1[2], 0.f); v1[3] = fmaxf(v1[3], 0.f);
                        *(u32x4*)(out16 + (size_t)row * ld16 + col) = pack8(v0 * v0, v1 * v1); }
                    else if (MODE == 4) { f32x4 v0 = a0 * rstd, v1 = a1 * rstd;
                        v0[0] = sigmoidf_(v0[0]); v0[1] = sigmoidf_(v0[1]); v0[2] = sigmoidf_(v0[2]); v0[3] = sigmoidf_(v0[3]); v1[0] = sigmoidf_(v1[0]); v1[1] = sigmoidf_(v1[1]); v1[2] = sigmoidf_(v1[2]); v1[3] = sigmoidf_(v1[3]);
                        *(u32x4*)(out16 + (size_t)row * ld16 + col) = pack8(v0, v1); }
                    else if (MODE == 5) { f32x4 t0, t1; unpack8(*(const u32x4*)(out16 + (size_t)row * ld16 + col), t0, t1); float* rp = R + (size_t)row * DM + col;
                        const f32x4 r0 = *(const f32x4*)rp + t0 * a0, r1 = *(const f32x4*)(rp + 4) + t1 * a1; *(f32x4*)rp = r0; *(f32x4*)(rp + 4) = r1; ss += sumsq4(r0) + sumsq4(r1); }
                }
                if (MODE == 2 || MODE == 5) { ss += __shfl_xor(ss, 16); ss += __shfl_xor(ss, 32); if (fq == 0) PS[(size_t)row * 16 + u.pn * 4 + wc] = ss; }
            }
        }
    }
};

__device__ __forceinline__ void samp_in(const EpiIn& E, int row, int pcol, f32x4 v) {
    const float rs = E.rstd0[row]; const int pn = __builtin_amdgcn_readfirstlane(pcol >> 8), p = pcol & 255;
    if (pn < 4) {
        const bool isk = pn >= 2; bf16_t* dst = isk ? E.KR : E.QR; const int head = 2 * (pn & 1) + (p >> 7), j = (p & 127) >> 1;
        const f32x4 t = *(const f32x4*)(E.cs + ((size_t)SEQ * 64 + j) * 2);
        v = v * (rs * (isk ? 0.08838834764831845f : 1.0f));
        const float o1a = v[0] * t[0] - v[1] * t[1], o2a = v[0] * t[1] + v[1] * t[0], o1b = v[2] * t[2] - v[3] * t[3], o2b = v[2] * t[3] + v[3] * t[2];
        bf16_t* q = dst + (size_t)row * 512 + head * 128 + j;
        *(unsigned*)q = cvt_pk_bf16(o1a, o1b); *(unsigned*)(q + 64) = cvt_pk_bf16(o2a, o2b);
    } else if (pn >= 12 && pn < 20) {
        const int c = (pn - 12) * 128 + (p >> 1);
        const float k0 = (1.0f - E.lb[c]) / (1.0f + __expf(v[1] * rs)), k1 = (1.0f - E.lb[c + 1]) / (1.0f + __expf(v[3] * rs));
        *(unsigned*)(E.QG + (size_t)row * DM + c) = cvt_pk_bf16(siluf_(v[0] * rs), siluf_(v[2] * rs));
        *(unsigned*)(E.KG + (size_t)row * DM + c) = cvt_pk_bf16(k0, k1);
        *(f32x2*)(E.FS + (size_t)(row - MPROMPT) * DM + c) = (f32x2){1.0f - k0, 1.0f - k1};
    } else {
        v = v * rs;
        const bool sl = (pn >= 8 && pn < 12) || (pn >= 24 && pn < 28), sg = pn >= 28;
        if (sl) { v[0] = siluf_(v[0]); v[1] = siluf_(v[1]); v[2] = siluf_(v[2]); v[3] = siluf_(v[3]); }
        else if (sg) { v[0] = sigmoidf_(v[0]); v[1] = sigmoidf_(v[1]); v[2] = sigmoidf_(v[2]); v[3] = sigmoidf_(v[3]); }
        const u32x2 w = pack4(v); const size_t ro = (size_t)row * DM + p;
        if (pn < 8) *(u32x2*)(E.VR + ro + (pn - 4) * BM) = w;
        else if (pn < 12) *(u32x2*)(E.GR + ro + (pn - 8) * BM) = w;
        else if (pn < 24) *(u32x2*)(E.VG + ro + (pn - 20) * BM) = w;
        else if (pn < 28) *(u32x2*)(E.GG + ro + (pn - 24) * BM) = w;
        else if (pn < 32) *(u32x2*)(E.AR + ro + (pn - 28) * BM) = w;
        else *(u32x2*)(E.AH + ro + (pn - 32) * BM) = w;
    }
}
template <int MODE> __device__ __forceinline__ void samp_n(const EpiN<MODE>& E, const float* xs, float* PSS, const float* PSSin, int row, int col, f32x4 a) {
    const int rs_ = row - MPROMPT; float rstd = 1.f;
    if (MODE == 3 || MODE == 4) { const f32x4* p = (const f32x4*)(PSSin + (size_t)rs_ * 64); float s = 0.f;
#pragma unroll
        for (int i = 0; i < 16; ++i) { const f32x4 q = p[i]; s += (q[0] + q[1]) + (q[2] + q[3]); }
        rstd = rsqrtf(s * (1.0f / 1024.0f) + EPS); }
    float ss = 0.f;
    if (MODE == 0) { const f32x4 gt = unpack4(*(const u32x2*)(E.gate + (size_t)row * DM + col)); *(u32x2*)(E.out16 + (size_t)row * E.ld16 + col) = pack4(gt * a); }
    else if (MODE == 1) { const f32x4 gt = unpack4(*(const u32x2*)(E.gate + (size_t)row * DM + col)); u32x2* o = (u32x2*)(E.out16 + (size_t)row * E.ld16 + col); const f32x4 t = unpack4(*o); *o = pack4(t + gt * a); }
    else if (MODE == 2) { const float* bp = xs ? xs + (size_t)rs_ * DM + col : E.R + (size_t)row * DM + col; const f32x4 r = *(const f32x4*)bp + a; *(f32x4*)(E.R + (size_t)row * DM + col) = r;
        ss = (r[0] * r[0] + r[1] * r[1]) + (r[2] * r[2] + r[3] * r[3]); *(u32x2*)(E.out16 + (size_t)row * E.ld16 + col) = pack4(r * *(const f32x4*)(E.g + col)); }
    else if (MODE == 3) { f32x4 v = a * rstd; v[0] = fmaxf(v[0], 0.f); v[1] = fmaxf(v[1], 0.f); v[2] = fmaxf(v[2], 0.f); v[3] = fmaxf(v[3], 0.f); *(u32x2*)(E.out16 + (size_t)row * E.ld16 + col) = pack4(v * v); }
    else if (MODE == 4) { f32x4 v = a * rstd; v[0] = sigmoidf_(v[0]); v[1] = sigmoidf_(v[1]); v[2] = sigmoidf_(v[2]); v[3] = sigmoidf_(v[3]); *(u32x2*)(E.out16 + (size_t)row * E.ld16 + col) = pack4(v); }
    else if (MODE == 5) { const f32x4 t = unpack4(*(const u32x2*)(E.out16 + (size_t)row * E.ld16 + col)); float* rp = E.R + (size_t)row * DM + col; const f32x4 r = *(const f32x4*)rp + t * a; *(f32x4*)rp = r;
        ss = (r[0] * r[0] + r[1] * r[1]) + (r[2] * r[2] + r[3] * r[3]); }
    if (MODE == 2 || MODE == 5) { ss += __shfl_xor(ss, 16); ss += __shfl_xor(ss, 32); if ((threadIdx.x & 63) < 16) PSS[(size_t)rs_ * 64 + (col >> 4)] = ss; }
}
}


constexpr int NWAVES = 8;
constexpr int NPH = 10;
#ifndef MK_ONE_LAUNCH
#define MK_ONE_LAUNCH 1
#endif

constexpr size_t MiB = 1u << 20;
constexpr size_t WS_CTL = 0, CTL_ZERO_BYTES = 1 * MiB;
constexpr size_t WS_WIN = 1 * MiB;
constexpr size_t WS_WUPR = WS_WIN + (size_t)DIN * DM * 2;
constexpr size_t WS_WUPH = WS_WUPR + (size_t)DM * DM * 2;
constexpr size_t WS_WO = WS_WUPH + (size_t)DM * DM * 2;
constexpr size_t WS_WFF1 = WS_WO + (size_t)DM * DM * 2;
constexpr size_t WS_WFF2 = WS_WFF1 + (size_t)DFF * DM * 2;
constexpr size_t WS_WGATE = WS_WFF2 + (size_t)DFF * DM * 2;
constexpr size_t WS_WPROJ = WS_WGATE + (size_t)DM * DM * 2;
constexpr size_t WS_Z6 = WS_WPROJ + (size_t)DM * DPLE * 2;
constexpr size_t Z_QR = WS_Z6, Z_KR = Z_QR + (size_t)MP * 512 * 2, Z_VR = Z_KR + (size_t)MP * 512 * 2, Z_QG = Z_VR + (size_t)MP * DM * 2, Z_KG = Z_QG + (size_t)MP * DM * 2,
                 Z_VG = Z_KG + (size_t)MP * DM * 2, Z_END = Z_VG + (size_t)MP * DM * 2;
constexpr size_t WS_H = WS_Z6, WS_MB = WS_Z6 + (size_t)MP * DFF * 2;
static_assert(WS_MB == Z_VG, "MB overlays VG exactly");
constexpr size_t WS_GR = Z_END, WS_GG = WS_GR + (size_t)MP * DM * 2, WS_A5 = WS_GR, WS_A7 = WS_GG;
constexpr size_t WS_PB = WS_GG + (size_t)MP * DM * 2;
constexpr size_t WS_CS = WS_PB + (size_t)MP * DPLE * 2;
constexpr size_t WS_GL = WS_CS + (size_t)2049 * 64 * 8;
constexpr size_t WS_FS = WS_GL + (size_t)NCHUNK * DM * 4;
constexpr size_t WS_RSTD0 = WS_FS + (size_t)NDEC * DM * 4;
constexpr size_t WS_LB = WS_RSTD0 + (size_t)MP * 4;
constexpr size_t WS_PS1 = WS_LB + 4096, WS_PS2 = WS_PS1 + (size_t)MP * 64, WS_PS3 = WS_PS2 + (size_t)MP * 64, WS_PSS1 = WS_PS3 + (size_t)MP * 64, WS_PSS2 = WS_PSS1 + (size_t)NDEC * 256, WS_PSS3 = WS_PSS2 + (size_t)NDEC * 256, WS_END = WS_PSS3 + (size_t)NDEC * 256;
static_assert(WS_END <= 307920896, "d_ws map must fit sum(inputs) bytes");
static_assert(WS_WIN % 256 == 0 && WS_Z6 % 256 == 0 && WS_GR % 256 == 0 && WS_PB % 256 == 0 && WS_CS % 16 == 0 && WS_GL % 16 == 0 && WS_PS1 % 16 == 0, "alignment");
constexpr int CW_TMO = 0, CW_BAR = 4096;

constexpr int RING_OFF = 0, RING_BYTES = 131072;
constexpr int LDSCTL_OFF = RING_BYTES, MISC_OFF = LDSCTL_OFF + 320;
constexpr int LDS_BYTES = 147456;

#define GAS __attribute__((address_space(1)))
#define LAS __attribute__((address_space(3)))
typedef unsigned short bf16;
typedef unsigned v4u __attribute__((ext_vector_type(4)));
typedef float f32x4 __attribute__((ext_vector_type(4)));
typedef short bf16x8 __attribute__((ext_vector_type(8)));
typedef GAS unsigned gu32;
typedef GAS unsigned long long gu64;
#define RLX_AGENT __ATOMIC_RELAXED, __HIP_MEMORY_SCOPE_AGENT
#define LDS_WAIT() asm volatile("s_waitcnt lgkmcnt(0)" ::: "memory")
#define VM_WAIT() asm volatile("s_waitcnt vmcnt(0)" ::: "memory")
__device__ __forceinline__ unsigned long long rt() { return __builtin_amdgcn_s_memrealtime(); }
__device__ __forceinline__ unsigned f2bf(float f) { unsigned u = __builtin_bit_cast(unsigned, f); return (u + 0x7fffu + ((u >> 16) & 1u)) >> 16; }
__device__ __forceinline__ unsigned pk2(float lo, float hi) { return f2bf(lo) | (f2bf(hi) << 16); }

#define XB_TMO      128
#define XB_XCNT(j)  (256  + 64 * (j))
#define XB_XSUB(j)  (1280 + 64 * (j))
#define XB_XGEN(j)  (2304 + 64 * (j))
#define XB_TOP      3328
#define XB_TOPGEN   3392
#define XCD_BAR_WORDS 3456
#define XB_SPIN_CAP (1u << 18)

__device__ __forceinline__ unsigned xb_ld(unsigned* p)              { return __hip_atomic_load(p, __ATOMIC_RELAXED, __HIP_MEMORY_SCOPE_AGENT); }
__device__ __forceinline__ unsigned xb_add(unsigned* p, unsigned v) { return __hip_atomic_fetch_add(p, v, __ATOMIC_RELAXED, __HIP_MEMORY_SCOPE_AGENT); }
__device__ __forceinline__ unsigned xb_xcc_id() { return (unsigned)__builtin_amdgcn_s_getreg((3 << 11) | 20) & 0xFu; }
#define XB_SPIN(cond, bar) do { unsigned _sp = 0; while (cond) { __builtin_amdgcn_s_sleep(1); \
    if ((++_sp & 255u) == 0u) { if (xb_ld(&(bar)[XB_TMO])) break; if (_sp > XB_SPIN_CAP) { atomicAdd(&(bar)[XB_TMO], 1u); break; } } } } while (0)

struct XcdBarrier {
    unsigned* bar; unsigned x;
    volatile LAS unsigned* st;
};

__device__ __forceinline__ XcdBarrier xcd_barrier_post(unsigned* bar, volatile LAS unsigned* st) {
    XcdBarrier b; b.bar = bar; b.x = xb_xcc_id(); b.st = st;
    if (threadIdx.x == 0) (void)xb_add(&bar[XB_XCNT(b.x)], 1u);
    return b;
}
__device__ __forceinline__ void xcd_barrier_complete(unsigned* bar, unsigned x, unsigned& nloc, unsigned& nx) {
    const unsigned G = gridDim.x * gridDim.y * gridDim.z;
    unsigned sum, cnt, mine, sp = 0u;
    for (;;) {
        sum = 0u; cnt = 0u; mine = 0u;
#pragma unroll
        for (unsigned j = 0; j < 16; ++j) { const unsigned c = xb_ld(&bar[XB_XCNT(j)]); sum += c; cnt += (c > 0u) ? 1u : 0u; mine = (j == x) ? c : mine; }
        if (sum == G) break;
        __builtin_amdgcn_s_sleep(1);
        if ((++sp & 255u) == 0u) { if (xb_ld(&bar[XB_TMO])) break; if (sp > XB_SPIN_CAP) { atomicAdd(&bar[XB_TMO], 1u); break; } }
    }
    nloc = mine > 0u ? mine : 1u; nx = cnt > 0u ? cnt : 1u;
}

__device__ __forceinline__ void xcd_barrier(const XcdBarrier& b) {
    asm volatile("s_waitcnt vmcnt(0)" ::: "memory");
    __syncthreads();
    if (threadIdx.x == 0) {
        unsigned* bar = b.bar;
        __builtin_amdgcn_s_waitcnt(0);
        unsigned nloc = b.st[0], nx = b.st[1];
        if (nloc == 0u) { xcd_barrier_complete(bar, b.x, nloc, nx); b.st[0] = nloc; b.st[1] = nx; }
        const unsigned old = xb_add(&bar[XB_XSUB(b.x)], 1u);
        const unsigned gen = old / nloc;
        if (old + 1u == (gen + 1u) * nloc) {
            __builtin_amdgcn_fence(__ATOMIC_RELEASE, "agent");
            asm volatile("s_waitcnt vmcnt(0)" ::: "memory");
            const unsigned og = xb_add(&bar[XB_TOP], 1u);
            const unsigned tg = og / nx;
            if (og + 1u == (tg + 1u) * nx) xb_add(&bar[XB_TOPGEN], 1u);
            else XB_SPIN(xb_ld(&bar[XB_TOPGEN]) == tg, bar);
            __builtin_amdgcn_fence(__ATOMIC_ACQUIRE, "agent");
            xb_add(&bar[XB_XGEN(b.x)], 1u);
            asm volatile("s_waitcnt vmcnt(0)" ::: "memory");
        } else {
            XB_SPIN(xb_ld(&bar[XB_XGEN(b.x)]) == gen, bar);
            __builtin_amdgcn_fence(__ATOMIC_ACQUIRE, "agent");
            asm volatile("s_waitcnt vmcnt(0)" ::: "memory");
        }
    }
    __syncthreads();
}


#ifndef PROBE_ON
#define PROBE_ON 0
#endif
#define PROBE_UNIT 800ull
#ifndef PROBE_A
#define PROBE_A 0
#define PROBE_B 1
#define PROBE_C 2
#endif
struct Args { const float* in[21]; float* out; unsigned char* ws; int ph_lo, ph_hi, use_bar, pad; };
struct Frame {
    LAS unsigned char* lds; volatile LAS unsigned* MISC; gu32* ctl;
    int vcu, G;
};
__device__ __forceinline__ int tid_() { int t = threadIdx.x; asm volatile("" : "+v"(t)); return t; }
#define FTID (tid_())
#define FLANE (tid_() & 63)
#define FWAVE (__builtin_amdgcn_readfirstlane(tid_() >> 6))
__device__ __forceinline__ float wave_sum(float v) {
#pragma unroll
    for (int o = 1; o < 64; o <<= 1) v += __shfl_xor(v, o);
    return v;
}
__device__ __forceinline__ float bf2f_(unsigned short b) { return __uint_as_float((unsigned)b << 16); }
__device__ __forceinline__ float bflo_(unsigned w) { return __uint_as_float(w << 16); }
__device__ __forceinline__ float bfhi_(unsigned w) { return __uint_as_float(w & 0xffff0000u); }

__device__ __forceinline__ int win_src_col(int np) {
    const int tile = np >> 8, p = np & 255;
    if (tile < 4) { const int base = (tile >> 1) * 512, head = 2 * (tile & 1) + (p >> 7), pp = p & 127; return base + head * 128 + (pp & 1) * 64 + (pp >> 1); }
    if (tile >= 12 && tile < 20) { const int h = tile - 12; return 3072 + (p & 1) * 1024 + h * 128 + (p >> 1); }
    return np;
}
template <bool MAP> __device__ __forceinline__ void p0_transpose_item(const float* W, int K, int N, bf16* WT, LAS float* scr, int item, int lane) {
    const int nblk = N / 32, kb = item / nblk, nb = item % nblk, k0 = 64 * kb, n0 = 32 * nb;
    const int srcc = MAP ? win_src_col(n0 + (lane & 31)) : n0 + (lane & 31);
#pragma unroll 8
    for (int i = 0; i < 32; ++i) { const int kk = 2 * i + (lane >> 5); scr[kk * 33 + (lane & 31)] = W[(size_t)(k0 + kk) * N + srcc]; }
    LDS_WAIT(); asm volatile("" ::: "memory");
    const int c = lane & 7;
#pragma unroll
    for (int j = 0; j < 4; ++j) { const int n = (lane >> 3) + 8 * j; const LAS float* s = scr + (8 * c) * 33 + n;
        v4u o; o.x = pk2(s[0 * 33], s[1 * 33]); o.y = pk2(s[2 * 33], s[3 * 33]); o.z = pk2(s[4 * 33], s[5 * 33]); o.w = pk2(s[6 * 33], s[7 * 33]);
        *(GAS v4u*)(WT + (size_t)(n0 + n) * K + k0 + 8 * c) = o; }
    LDS_WAIT(); asm volatile("" ::: "memory");
}
__device__ __forceinline__ void p0_prologue(Frame& F, const Args& a) { const int tid_v = tid_(); const int lane_v = tid_v & 63; const int wave_v = __builtin_amdgcn_readfirstlane(tid_v >> 6); (void)lane_v; (void)wave_v;
    unsigned char* ws = a.ws;
    LAS float* scr = (LAS float*)(F.lds + RING_OFF + wave_v * 16384);
    const int gw = F.vcu * NWAVES + wave_v, NGW = F.G * NWAVES;
    constexpr int I_IN = (DM / 64) * (DIN / 32), I_SQ = (DM / 64) * (DM / 32), I_F1 = (DM / 64) * (DFF / 32), I_F2 = (DFF / 64) * (DM / 32), I_PJ = (DPLE / 64) * (DM / 32);
    constexpr int NITEMS = I_IN + 4 * I_SQ + I_F1 + I_F2 + I_PJ;
    for (int it = gw; it < NITEMS; it += NGW) {
        int r = it;
        if (r < I_IN) { p0_transpose_item<true>(a.in[7], DM, DIN, (bf16*)(ws + WS_WIN), scr, r, lane_v); continue; } r -= I_IN;
        if (r < I_SQ) { p0_transpose_item<false>(a.in[11], DM, DM, (bf16*)(ws + WS_WUPR), scr, r, lane_v); continue; } r -= I_SQ;
        if (r < I_SQ) { p0_transpose_item<false>(a.in[12], DM, DM, (bf16*)(ws + WS_WUPH), scr, r, lane_v); continue; } r -= I_SQ;
        if (r < I_SQ) { p0_transpose_item<false>(a.in[13], DM, DM, (bf16*)(ws + WS_WO), scr, r, lane_v); continue; } r -= I_SQ;
        if (r < I_SQ) { p0_transpose_item<false>(a.in[18], DM, DM, (bf16*)(ws + WS_WGATE), scr, r, lane_v); continue; } r -= I_SQ;
        if (r < I_F1) { p0_transpose_item<false>(a.in[15], DM, DFF, (bf16*)(ws + WS_WFF1), scr, r, lane_v); continue; } r -= I_F1;
        if (r < I_F2) { p0_transpose_item<false>(a.in[16], DFF, DM, (bf16*)(ws + WS_WFF2), scr, r, lane_v); continue; } r -= I_F2;
        p0_transpose_item<false>(a.in[19], DPLE, DM, (bf16*)(ws + WS_WPROJ), scr, r, lane_v);
    }
    bf16* XB = (bf16*)(a.out + OFF_RETS); float* RSTD0 = (float*)(ws + WS_RSTD0); bf16* PB = (bf16*)(ws + WS_PB);
    const float* gmix = a.in[6];
    for (int m = gw; m < MP; m += NGW) {
        GAS unsigned long long* o8 = (GAS unsigned long long*)(XB + (size_t)m * DM) + lane_v;
        GAS unsigned long long* p8 = (GAS unsigned long long*)(PB + (size_t)m * DPLE) + lane_v;
        if (m >= MTOT) {
#pragma unroll
            for (int j = 0; j < 4; ++j) o8[64 * j] = 0ull;
            p8[0] = 0ull; if (lane_v == 0) RSTD0[m] = 0.f; continue;
        }
        const float* xrow = m < MPROMPT ? a.in[0] + (size_t)m * DM : a.in[1] + (size_t)(m - MPROMPT) * DM;
        const float* prow = m < MPROMPT ? a.in[4] + (size_t)m * DPLE : a.in[5] + (size_t)(m - MPROMPT) * DPLE;
        const GAS f32x4* xr = (const GAS f32x4*)xrow + lane_v;
        f32x4 v[4]; float s = 0.f;
#pragma unroll
        for (int j = 0; j < 4; ++j) { v[j] = xr[64 * j]; s += (v[j].x * v[j].x + v[j].y * v[j].y) + (v[j].z * v[j].z + v[j].w * v[j].w); }
        s = wave_sum(s);
        if (lane_v == 0) RSTD0[m] = rsqrtf(s * (1.0f / DM) + EPS);
#pragma unroll
        for (int j = 0; j < 4; ++j) { const f32x4 gv = *((const GAS f32x4*)gmix + 64 * j + lane_v);
            o8[64 * j] = (unsigned long long)pk2(v[j].x * gv.x, v[j].y * gv.y) | ((unsigned long long)pk2(v[j].z * gv.z, v[j].w * gv.w) << 32); }
        const f32x4 pv = *((const GAS f32x4*)prow + lane_v);
        p8[0] = (unsigned long long)pk2(pv.x, pv.y) | ((unsigned long long)pk2(pv.z, pv.w) << 32);
    }
    float* CS = (float*)(ws + WS_CS); float* LB = (float*)(ws + WS_LB);
    const int gt = (F.vcu * NWAVES + wave_v) * 64 + lane_v, NGT = NGW * 64;
    for (int i = gt; i < 2049 * 64; i += NGT) {
        const int pi = i >> 6, j = i & 63; const double pos = pi == SEQ ? 16384.0 : (double)pi;
        const double ang = pos * pow(10000.0, -(double)j / 64.0);
        CS[2 * i] = (float)cos(ang); CS[2 * i + 1] = (float)sin(ang);
    }
    for (int i = gt; i < DM; i += NGT) { const float a0 = a.in[10][i], a1 = a.in[10][DM + i]; LB[i] = 1.0f / (1.0f + expf(a1 - a0)); }
}

typedef float f32x16 __attribute__((ext_vector_type(16)));
typedef short v4i16_t __attribute__((ext_vector_type(4)));
typedef unsigned u32x2 __attribute__((ext_vector_type(2)));
typedef float f32x2_t __attribute__((ext_vector_type(2))); typedef __bf16 bf16x2_t __attribute__((ext_vector_type(2)));
__device__ __forceinline__ unsigned cvtpk_s(float lo, float hi) { f32x2_t v = {lo, hi}; bf16x2_t b = __builtin_convertvector(v, bf16x2_t); return __builtin_bit_cast(unsigned, b); }
__device__ __forceinline__ unsigned off_b(unsigned row, unsigned ch) { return 256u * row + 16u * (ch ^ (((row & 3) << 2) | ((row >> 2) & 3))); }
__device__ __forceinline__ bf16x8 rd_row(LAS unsigned char* img, unsigned row, unsigned ks, unsigned h) { return *(const LAS bf16x8*)(img + off_b(row, 2 * ks + h)); }
__device__ __forceinline__ bf16x8 rd_tr(LAS unsigned char* img, unsigned lane, unsigned c, unsigned ks) {
    const unsigned h = lane >> 5, blk = (lane >> 4) & 1, q = (lane & 15) >> 2, p = lane & 3;
    const unsigned a0 = off_b(16 * ks + 8 * h + q, 4 * c + 2 * blk + (p >> 1)) + 8 * (p & 1);
    const unsigned a1 = off_b(16 * ks + 8 * h + 4 + q, 4 * c + 2 * blk + (p >> 1)) + 8 * (p & 1);
    const v4i16_t lo = __builtin_amdgcn_ds_read_tr16_b64_v4i16((LAS v4i16_t*)(img + a0));
    const v4i16_t hi = __builtin_amdgcn_ds_read_tr16_b64_v4i16((LAS v4i16_t*)(img + a1));
    return __builtin_shufflevector(lo, hi, 0, 1, 2, 3, 4, 5, 6, 7);
}
#define MFMA32(a, b, c) __builtin_amdgcn_mfma_f32_32x32x16_bf16((a), (b), (c), 0, 0, 0)
__device__ __forceinline__ void scan_item(Frame& F, const Args& a, int item) { const int tid_v = tid_(); const int lane_v = tid_v & 63; const int wave_v = __builtin_amdgcn_readfirstlane(tid_v >> 6); (void)lane_v; (void)wave_v;
    unsigned char* ws = a.ws;
    const bool isg = item >= 128; const int it = isg ? item - 128 : item;
    int b, hd, dv0, ldq; const bf16 *Qp, *Kp; bf16* Vp; float* Sout; const float* GLp = nullptr; float sdec = 1.f;
    if (!isg) { b = it >> 4; hd = (it >> 2) & 3; dv0 = (it & 3) * 64; ldq = 512;
        Qp = (const bf16*)(ws + Z_QR) + hd * 128; Kp = (const bf16*)(ws + Z_KR) + hd * 128; Vp = (bf16*)(ws + Z_VR) + hd * 256 + dv0;
        Sout = a.out + OFF_RETP + ((size_t)(b * HR + hd) * DKR) * DVR + dv0; sdec = __expf(64.0f * __logf(1.0f - exp2f(-5.0f - (float)hd))); }
    else { b = it >> 4; hd = (it >> 1) & 7; dv0 = (it & 1) * 64; ldq = 1024;
        Qp = (const bf16*)(ws + Z_QG) + hd * 128; Kp = (const bf16*)(ws + Z_KG) + hd * 128; Vp = (bf16*)(ws + Z_VG) + hd * 128 + dv0;
        Sout = a.out + OFF_HGP + ((size_t)(b * HG + hd) * DKG) * DVG + dv0; GLp = (const float*)(ws + WS_GL) + hd * 128; }
    const int ldo = isg ? DVG : DVR;
    LAS unsigned char* QI = F.lds; LAS unsigned char* KI = QI + 16384; LAS unsigned char* VI = KI + 16384; LAS unsigned char* PI = VI + 16384; LAS unsigned char* SI = PI + 16384;
    const int tid = tid_v, lane = lane_v, w = wave_v; const unsigned r = lane & 31, h = lane >> 5;
    const int kb = w >> 1, dvb = w & 1;
    for (int i = tid; i < 16384 / 4; i += 512) ((LAS unsigned*)SI)[i] = 0u;
    f32x16 S;
#pragma unroll
    for (int i = 0; i < 16; ++i) S[i] = 0.f;
    const int qr0 = tid >> 4, qc0 = tid & 15, vr0 = tid >> 3, vc0 = tid & 7;
    const size_t rowb = (size_t)b * SEQ;
    v4u pq0, pq1, pk0, pk1, pv;
#define SCAN_LOAD(c) do { const size_t r0_ = rowb + (size_t)(c) * CH; \
        pq0 = *(const v4u*)(Qp + (r0_ + qr0) * ldq + qc0 * 8); pq1 = *(const v4u*)(Qp + (r0_ + qr0 + 32) * ldq + qc0 * 8); \
        pk0 = *(const v4u*)(Kp + (r0_ + qr0) * ldq + qc0 * 8); pk1 = *(const v4u*)(Kp + (r0_ + qr0 + 32) * ldq + qc0 * 8); \
        pv = *(const v4u*)(Vp + (r0_ + vr0) * DM + vc0 * 8); } while (0)
    SCAN_LOAD(0);
    for (int c = 0; c < SEQ / CH; ++c) {
        const size_t row0 = rowb + (size_t)c * CH;
        __syncthreads();
        *(LAS v4u*)(QI + off_b(qr0, qc0)) = pq0; *(LAS v4u*)(QI + off_b(qr0 + 32, qc0)) = pq1;
        *(LAS v4u*)(KI + off_b(qr0, qc0)) = pk0; *(LAS v4u*)(KI + off_b(qr0 + 32, qc0)) = pk1;
        *(LAS v4u*)(VI + off_b(vr0, vc0)) = pv;
        if (c > 0) {
#pragma unroll
            for (int g = 0; g < 4; ++g) { u32x2 wv; wv.x = cvtpk_s(S[4 * g], S[4 * g + 1]); wv.y = cvtpk_s(S[4 * g + 2], S[4 * g + 3]);
                *(LAS u32x2*)(SI + off_b(32 * dvb + r, 4 * kb + g) + 8 * h) = wv; }
        }
        if (c + 1 < SEQ / CH) SCAN_LOAD(c + 1);
        __syncthreads();
        {
            f32x16 d;
#pragma unroll
            for (int i = 0; i < 16; ++i) d[i] = 0.f;
#pragma unroll
            for (int ks = 0; ks < 4; ++ks) { const bf16x8 A = rd_tr(KI, lane, kb, ks); const bf16x8 B = rd_tr(VI, lane, dvb, ks); d = MFMA32(A, B, d); }
            if (isg) {
                const float* gl = GLp + ((size_t)b * (SEQ / CH) + c) * DM + 32 * kb + 4 * h;
#pragma unroll
                for (int g = 0; g < 4; ++g) { const f32x4 dc = *(const f32x4*)(gl + 8 * g);
#pragma unroll
                    for (int i = 0; i < 4; ++i) S[4 * g + i] = dc[i] * (S[4 * g + i] + d[4 * g + i]); }
            } else {
#pragma unroll
                for (int i = 0; i < 16; ++i) S[i] = sdec * (S[i] + d[i]);
            }
        }
        if (w < 3) {
            const int sb = w >> 1, tb = (w + 1) >> 1;
            f32x16 p;
#pragma unroll
            for (int i = 0; i < 16; ++i) p[i] = 0.f;
#pragma unroll
            for (int ks = 0; ks < 8; ++ks) { const bf16x8 A = rd_row(KI, 32 * sb + r, ks, h); const bf16x8 B = rd_row(QI, 32 * tb + r, ks, h); p = MFMA32(A, B, p); }
#pragma unroll
            for (int g = 0; g < 4; ++g) {
                float v[4];
#pragma unroll
                for (int i = 0; i < 4; ++i) { const int sl = 8 * g + 4 * (int)h + i; v[i] = (sb != tb || sl <= (int)r) ? p[4 * g + i] : 0.f; }
                u32x2 wv; wv.x = cvtpk_s(v[0], v[1]); wv.y = cvtpk_s(v[2], v[3]);
                *(LAS u32x2*)(PI + off_b(32 * tb + r, 4 * sb + g) + 8 * h) = wv;
            }
        }
        __syncthreads();
        if (w < 4) {
            const int ob = w >> 1, tb = w & 1;
            f32x16 o;
#pragma unroll
            for (int i = 0; i < 16; ++i) o[i] = 0.f;
#pragma unroll
            for (int ks = 0; ks < 4; ++ks) if (ks < 2 || tb == 1) { const bf16x8 A = rd_tr(VI, lane, ob, ks); const bf16x8 B = rd_row(PI, 32 * tb + r, ks, h); o = MFMA32(A, B, o); }
#pragma unroll
            for (int ks = 0; ks < 8; ++ks) { const bf16x8 A = rd_row(SI, 32 * ob + r, ks, h); const bf16x8 B = rd_row(QI, 32 * tb + r, ks, h); o = MFMA32(A, B, o); }
            bf16* orow = Vp + (row0 + 32 * tb + r) * DM + 32 * ob + 4 * h;
#pragma unroll
            for (int g = 0; g < 4; ++g) { u32x2 wv; wv.x = cvtpk_s(o[4 * g], o[4 * g + 1]); wv.y = cvtpk_s(o[4 * g + 2], o[4 * g + 3]); *(u32x2*)(orow + 8 * g) = wv; }
        }
    }
#undef SCAN_LOAD
#pragma unroll
    for (int i = 0; i < 16; ++i) { const int k = 32 * kb + (i & 3) + 8 * (i >> 2) + 4 * (int)h; Sout[(size_t)k * ldo + 32 * dvb + r] = S[i]; }
    __syncthreads();
}

__device__ __forceinline__ void decode_ret(Frame& F, const Args& a, int item) { const int tid_v = tid_(); const int lane_v = tid_v & 63; const int wave_v = __builtin_amdgcn_readfirstlane(tid_v >> 6); (void)lane_v; (void)wave_v;
    unsigned char* ws = a.ws; const int n = item >> 2, h = item & 3, row = MPROMPT + n;
    LAS float* qs = (LAS float*)(F.lds); LAS float* ks = qs + 128; LAS float* red = ks + 128;
    LAS float* part = red + 8 * 256;
    const int tid = tid_v, lane = lane_v, w = wave_v;
    if (tid < 128) qs[tid] = bf2f_(((const bf16*)(ws + Z_QR))[(size_t)row * 512 + h * 128 + tid]);
    else if (tid < 256) ks[tid - 128] = bf2f_(((const bf16*)(ws + Z_KR))[(size_t)row * 512 + h * 128 + tid - 128]);
    const unsigned long long vw = *(const unsigned long long*)((const bf16*)(ws + Z_VR) + (size_t)row * DM + h * 256 + 4 * lane);
    const f32x4 v = (f32x4){bflo_((unsigned)vw), bfhi_((unsigned)vw), bflo_((unsigned)(vw >> 32)), bfhi_((unsigned)(vw >> 32))};
    const float gam = 1.0f - exp2f(-5.0f - (float)h);
    __syncthreads();
    const float* S0 = a.in[2] + ((size_t)(n * HR + h) * DKR) * DVR; float* S1 = a.out + OFF_RETS + ((size_t)(n * HR + h) * DKR) * DVR;
    f32x4 o = (f32x4){0.f, 0.f, 0.f, 0.f};
    f32x4 s[16];
#pragma unroll
    for (int i = 0; i < 16; ++i) s[i] = *(const f32x4*)(S0 + (size_t)(w + 8 * i) * DVR + 4 * lane);
#pragma unroll
    for (int i = 0; i < 16; ++i) { const int k = w + 8 * i; const f32x4 sn = s[i] * gam + v * ks[k]; *(f32x4*)(S1 + (size_t)k * DVR + 4 * lane) = sn; o += sn * qs[k]; }
    *(LAS f32x4*)(red + w * 256 + 4 * lane) = o;
    __syncthreads();
    float ov = 0.f;
    if (tid < 256) {
#pragma unroll
        for (int i = 0; i < 8; ++i) ov += red[i * 256 + tid];
        const float ss = wave_sum(ov * ov); if (lane == 0) part[w] = ss;
    }
    __syncthreads();
    if (tid < 256) {
        const float rstd = rsqrtf(((part[0] + part[1]) + (part[2] + part[3])) * (1.0f / DVR) + EPS);
        bf16* gp = (bf16*)(ws + WS_GR) + (size_t)row * DM + h * 256 + tid;
        *gp = (bf16)f2bf(ov * rstd * a.in[8][h * 256 + tid] * bf2f_(*gp));
    }
    __syncthreads();
}
__device__ __forceinline__ void decode_hg(Frame& F, const Args& a, int item) { const int tid_v = tid_(); const int lane_v = tid_v & 63; const int wave_v = __builtin_amdgcn_readfirstlane(tid_v >> 6); (void)lane_v; (void)wave_v;
    unsigned char* ws = a.ws; const int n = item >> 3, h = item & 7, row = MPROMPT + n;
    LAS float* qs = (LAS float*)(F.lds); LAS float* ks = qs + 128; LAS float* fs = ks + 128; LAS float* red = fs + 128;
    LAS float* part = red + 16 * 128;
    const int tid = tid_v, lane = lane_v, w = wave_v, l32 = lane & 31, half = lane >> 5;
    if (tid < 128) qs[tid] = bf2f_(((const bf16*)(ws + Z_QG))[(size_t)row * DM + h * 128 + tid]);
    else if (tid < 256) ks[tid - 128] = bf2f_(((const bf16*)(ws + Z_KG))[(size_t)row * DM + h * 128 + tid - 128]);
    else if (tid < 384) fs[tid - 256] = ((const float*)(ws + WS_FS))[(size_t)n * DM + h * 128 + tid - 256];
    const unsigned long long vw = *(const unsigned long long*)((const bf16*)(ws + Z_VG) + (size_t)row * DM + h * 128 + 4 * l32);
    const f32x4 v = (f32x4){bflo_((unsigned)vw), bfhi_((unsigned)vw), bflo_((unsigned)(vw >> 32)), bfhi_((unsigned)(vw >> 32))};
    __syncthreads();
    const float* S0 = a.in[3] + ((size_t)(n * HG + h) * DKG) * DVG; float* S1 = a.out + OFF_HGS + ((size_t)(n * HG + h) * DKG) * DVG;
    f32x4 o = (f32x4){0.f, 0.f, 0.f, 0.f};
    f32x4 s[8];
#pragma unroll
    for (int i = 0; i < 8; ++i) s[i] = *(const f32x4*)(S0 + (size_t)(2 * (w + 8 * i) + half) * DVG + 4 * l32);
#pragma unroll
    for (int i = 0; i < 8; ++i) { const int k = 2 * (w + 8 * i) + half; const f32x4 sn = s[i] * fs[k] + v * ks[k]; *(f32x4*)(S1 + (size_t)k * DVG + 4 * l32) = sn; o += sn * qs[k]; }
    *(LAS f32x4*)(red + (2 * w + half) * 128 + 4 * l32) = o;
    __syncthreads();
    float ov = 0.f;
    if (tid < 128) {
#pragma unroll
        for (int i = 0; i < 16; ++i) ov += red[i * 128 + tid];
        const float ss = wave_sum(ov * ov); if (lane == 0) part[w] = ss;
    }
    __syncthreads();
    if (tid < 128) {
        const float rstd = rsqrtf((part[0] + part[1]) * (1.0f / DVG) + EPS);
        bf16* gp = (bf16*)(ws + WS_GG) + (size_t)row * DM + h * 128 + tid;
        *gp = (bf16)f2bf(ov * rstd * a.in[9][h * 128 + tid] * bf2f_(*gp));
    }
    __syncthreads();
}

__device__ __forceinline__ void p3_headnorm(Frame& F, const Args& a) { const int tid_v = tid_(); const int lane_v = tid_v & 63; const int wave_v = __builtin_amdgcn_readfirstlane(tid_v >> 6); (void)lane_v; (void)wave_v;
    unsigned char* ws = a.ws; const int gw = F.vcu * NWAVES + wave_v, NGW = F.G * NWAVES, lane = lane_v;
    for (int it = gw; it < MPROMPT * 8; it += NGW) {
        const bool isg = it >= MPROMPT * 4; const int i2 = isg ? it - MPROMPT * 4 : it; const int row = i2 >> 2, q = i2 & 3;
        const size_t off = (size_t)row * DM + q * 256 + 4 * lane;
        const unsigned long long ow = *(const unsigned long long*)((const bf16*)(ws + (isg ? Z_VG : Z_VR)) + off);
        unsigned long long* gp = (unsigned long long*)((bf16*)(ws + (isg ? WS_GG : WS_GR)) + off); const unsigned long long gwd = *gp;
        const f32x4 gn = *(const f32x4*)(a.in[isg ? 9 : 8] + q * 256 + 4 * lane);
        const f32x4 o = (f32x4){bflo_((unsigned)ow), bfhi_((unsigned)ow), bflo_((unsigned)(ow >> 32)), bfhi_((unsigned)(ow >> 32))};
        const f32x4 gt = (f32x4){bflo_((unsigned)gwd), bfhi_((unsigned)gwd), bflo_((unsigned)(gwd >> 32)), bfhi_((unsigned)(gwd >> 32))};
        float ss = (o.x * o.x + o.y * o.y) + (o.z * o.z + o.w * o.w);
#pragma unroll
        for (int d = 1; d < 32; d <<= 1) ss += __shfl_xor(ss, d);
        if (!isg) ss += __shfl_xor(ss, 32);
        const float rstd = rsqrtf(ss * (isg ? 1.0f / DVG : 1.0f / DVR) + EPS);
        const f32x4 x = o * rstd * gn * gt;
        *gp = (unsigned long long)pk2(x.x, x.y) | ((unsigned long long)pk2(x.z, x.w) << 32);
    }
}

__device__ __forceinline__ void p9_final(Frame& F, const Args& a) { const int tid_v = tid_(); const int lane_v = tid_v & 63; const int wave_v = __builtin_amdgcn_readfirstlane(tid_v >> 6); (void)lane_v; (void)wave_v;
    const int gw = F.vcu * NWAVES + wave_v, NGW = F.G * NWAVES, lane = lane_v; const float* PS3 = (const float*)(a.ws + WS_PS3); const float* gf = a.in[20];
    for (int m = gw; m < MTOT; m += NGW) {
        const float pv = m < MPROMPT ? (lane < 16 ? PS3[(size_t)m * 16 + lane] : 0.f) : ((const float*)(a.ws + WS_PSS3))[(size_t)(m - MPROMPT) * 64 + lane];
        const float rstd = rsqrtf(wave_sum(pv) * (1.0f / DM) + EPS);
        f32x4* r = (f32x4*)(a.out + (size_t)m * DM) + lane;
#pragma unroll
        for (int j = 0; j < 4; ++j) { const f32x4 gv = *((const f32x4*)gf + 64 * j + lane); r[64 * j] = r[64 * j] * rstd * gv; }
    }
}

template <int K, class FE> __device__ __forceinline__ void skinny_gemm(Frame& F, const bf16* As, const bf16* Wt, int N, const FE& fe) { const int tid_v = tid_(); const int lane_v = tid_v & 63; const int wave_v = __builtin_amdgcn_readfirstlane(tid_v >> 6); (void)lane_v; (void)wave_v;
    constexpr int KW = K / 4, NKS = KW / 32, CH_KS = NKS < 8 ? NKS : 8, NCH = NKS / CH_KS;
    const int lane = lane_v, fr = lane & 15, fq = lane >> 4, rg = wave_v >> 2, ks = wave_v & 3;
    LAS f32x4* red = (LAS f32x4*)(F.lds);
    const int ntile = 4 * (N / 16);
    for (int tile = F.vcu; tile < ntile; tile += F.G) {
        const int rb = tile & 3, cb = tile >> 2;
        const bf16* ap = Wt + (size_t)(16 * cb + fr) * K + ks * KW + 8 * fq;
        const bf16* bp = As + (size_t)(32 * rb + 16 * rg + fr) * K + ks * KW + 8 * fq;
        f32x4 acc = (f32x4){0.f, 0.f, 0.f, 0.f};
#pragma unroll 1
        for (int c = 0; c < NCH; ++c) {
            bf16x8 a[CH_KS], b[CH_KS];
#pragma unroll
            for (int i = 0; i < CH_KS; ++i) { a[i] = *(const bf16x8*)(ap + (c * CH_KS + i) * 32); b[i] = *(const bf16x8*)(bp + (c * CH_KS + i) * 32); }
#pragma unroll
            for (int i = 0; i < CH_KS; ++i) acc = __builtin_amdgcn_mfma_f32_16x16x32_bf16(a[i], b[i], acc, 0, 0, 0);
        }
        red[wave_v * 64 + lane] = acc;
        __syncthreads();
        if (ks == 0) {
            const f32x4 v = (red[(4 * rg + 0) * 64 + lane] + red[(4 * rg + 1) * 64 + lane]) + (red[(4 * rg + 2) * 64 + lane] + red[(4 * rg + 3) * 64 + lane]);
            fe(MPROMPT + 32 * rb + 16 * rg + fr, 16 * cb + 4 * fq, v);
        }
        __syncthreads();
    }
}
struct FeIn { pg8::EpiIn E; __device__ __forceinline__ void operator()(int row, int col, f32x4 v) const { pg8::samp_in(E, row, col, v); } };
template <int MODE> struct FeN { pg8::EpiN<MODE> E; const float* xs; float* PSS; const float* PSSin;
    __device__ __forceinline__ void operator()(int row, int col, f32x4 v) const { pg8::samp_n<MODE>(E, xs, PSS, PSSin, row, col, v); } };

__global__ void __launch_bounds__(NWAVES * 64, 2) fwd_kernel(Args args) {
#define tid_v ((int)threadIdx.x)
    extern __shared__ __attribute__((aligned(16))) unsigned char lds[];
    Frame F;
    F.lds = (LAS unsigned char*)lds;
    F.MISC = (volatile LAS unsigned*)(F.lds + MISC_OFF);
        F.G = gridDim.x; { const int bx = blockIdx.x; F.vcu = (F.G % 8 == 0) ? (bx % 8) * (F.G / 8) + bx / 8 : bx; }
    unsigned char* ws = args.ws;
    F.ctl = (gu32*)(ws + WS_CTL);
    for (int u = tid_v; u < (LDS_BYTES - LDSCTL_OFF) / 4; u += NWAVES * 64) ((LAS unsigned*)(F.lds + LDSCTL_OFF))[u] = 0u;
    __syncthreads();
    XcdBarrier bar; bar.bar = (unsigned*)(F.ctl + CW_BAR); bar.x = 0; bar.st = nullptr;
    if (args.use_bar) bar = xcd_barrier_post((unsigned*)(F.ctl + CW_BAR), F.MISC + 8);
    const int lo = args.ph_lo, hi = args.ph_hi;
#define IN(k) (lo <= (k) && (k) < hi)
#if PROBE_ON
    volatile LAS unsigned* PW = F.MISC + 16;
    if (tid_v == 0) { PW[0] = (unsigned)rt(); PW[1] = 0u; }
#define STAMP(k) do { if (blockIdx.x == 0 && tid_v == 0) { const unsigned t_ = (unsigned)rt(); unsigned q_ = (t_ - PW[0] + (unsigned)PROBE_UNIT / 2) / (unsigned)PROBE_UNIT; if (q_ > 49u) q_ = 49u; \
        if ((k) == PROBE_A) PW[1] += q_ * 400u; else if ((k) == PROBE_B) PW[1] += q_ * 20000u; else if ((k) == PROBE_C) PW[1] += q_ * 1000000u; PW[0] = t_; } } while (0)
#else
#define STAMP(k) do { } while (0)
#endif
#define SEAM(k) do { if (IN(k) && IN((k) + 1)) xcd_barrier(bar); STAMP(k); } while (0)
    using namespace pg8;
    bf16_t* XB = (bf16_t*)(args.out + OFF_RETS);
    bf16_t* AR = (bf16_t*)(args.out + OFF_Y); bf16_t* AH = AR + (size_t)MTOT * DM;
    float* R = args.out + OFF_Y;
    float* PS1 = (float*)(ws + WS_PS1); float* PS2 = (float*)(ws + WS_PS2); float* PS3 = (float*)(ws + WS_PS3);

    if (IN(0)) { p0_prologue(F, args); SEAM(0); }
    const bf16_t* SROW = nullptr; (void)SROW;
    float* PSS1 = (float*)(ws + WS_PSS1); float* PSS2 = (float*)(ws + WS_PSS2); float* PSS3 = (float*)(ws + WS_PSS3);
#define SAMP(buf, ld) ((const bf16*)(buf) + (size_t)MPROMPT * (ld))
    if (IN(1)) {
        Gemm g{XB, (const bf16_t*)(ws + WS_WIN), MPROMPT, DIN, DM}; StaticOrder S; S.init(MPROMPT, DIN, F.G, (int)blockIdx.x);
        EpiIn E{(const float*)(ws + WS_RSTD0), (const float*)(ws + WS_CS), (const float*)(ws + WS_LB),
                (bf16_t*)(ws + Z_QR), (bf16_t*)(ws + Z_KR), (bf16_t*)(ws + Z_VR), (bf16_t*)(ws + WS_GR), (bf16_t*)(ws + Z_QG), (bf16_t*)(ws + Z_KG), (bf16_t*)(ws + Z_VG), (bf16_t*)(ws + WS_GG),
                AR, AH, (float*)(ws + WS_GL), (float*)(ws + WS_FS)};
        gemm_phase<EpiIn, StaticOrder, true, true>(F.lds + RING_OFF, g, S, E);
        { FeIn fe{E}; skinny_gemm<DM>(F, SAMP(XB, DM), (const bf16*)(ws + WS_WIN), DIN, fe); }
        SEAM(1);
    }
    if (IN(2)) {
        for (int it = F.vcu; it < 256; it += F.G) scan_item(F, args, it);
        for (int it = F.vcu; it < NDEC * HR; it += F.G) decode_ret(F, args, it);
        for (int it = F.vcu; it < NDEC * HG; it += F.G) decode_hg(F, args, it);
        SEAM(2);
    }
    if (IN(3)) { p3_headnorm(F, args); SEAM(3); }
    if (IN(4)) {
        { Gemm g{(const bf16_t*)(ws + WS_GG), (const bf16_t*)(ws + WS_WUPH), MPROMPT, DM, DM}; StaticOrder S; S.init(MPROMPT, DM, F.G, (int)blockIdx.x);
          EpiN<0> E{AH, (bf16_t*)(ws + WS_MB), DM, nullptr, nullptr, nullptr, nullptr, nullptr, nullptr};
          gemm_phase<EpiN<0>, StaticOrder, true, true>(F.lds + RING_OFF, g, S, E);
          FeN<0> fe{E, nullptr, nullptr, nullptr}; skinny_gemm<DM>(F, SAMP(ws + WS_GG, DM), (const bf16*)(ws + WS_WUPH), DM, fe); }
        { Gemm g{(const bf16_t*)(ws + WS_GR), (const bf16_t*)(ws + WS_WUPR), MPROMPT, DM, DM}; StaticOrder S; S.init(MPROMPT, DM, F.G, (int)blockIdx.x);
          EpiN<1> E{AR, (bf16_t*)(ws + WS_MB), DM, nullptr, nullptr, nullptr, nullptr, nullptr, nullptr};
          gemm_phase<EpiN<1>, StaticOrder, true, true>(F.lds + RING_OFF, g, S, E);
          FeN<1> fe{E, nullptr, nullptr, nullptr}; skinny_gemm<DM>(F, SAMP(ws + WS_GR, DM), (const bf16*)(ws + WS_WUPR), DM, fe); }
        SEAM(4);
    }
    if (IN(5)) {
        Gemm g{(const bf16_t*)(ws + WS_MB), (const bf16_t*)(ws + WS_WO), MPROMPT, DM, DM}; StaticOrder S; S.init(MPROMPT, DM, F.G, (int)blockIdx.x);
        EpiN<2> E{nullptr, (bf16_t*)(ws + WS_A5), DM, args.in[0], nullptr, R, args.in[14], PS1, nullptr};
        gemm_phase<EpiN<2>, StaticOrder, true, true>(F.lds + RING_OFF, g, S, E);
        FeN<2> fe{E, args.in[1], PSS1, nullptr}; skinny_gemm<DM>(F, SAMP(ws + WS_MB, DM), (const bf16*)(ws + WS_WO), DM, fe);
        SEAM(5);
    }
    if (IN(6)) {
        Gemm g{(const bf16_t*)(ws + WS_A5), (const bf16_t*)(ws + WS_WFF1), MPROMPT, DFF, DM}; StaticOrder S; S.init(MPROMPT, DFF, F.G, (int)blockIdx.x);
        EpiN<3> E{nullptr, (bf16_t*)(ws + WS_H), DFF, nullptr, nullptr, nullptr, nullptr, nullptr, PS1};
        gemm_phase<EpiN<3>, StaticOrder, true, true>(F.lds + RING_OFF, g, S, E);
        FeN<3> fe{E, nullptr, nullptr, PSS1}; skinny_gemm<DM>(F, SAMP(ws + WS_A5, DM), (const bf16*)(ws + WS_WFF1), DFF, fe);
        SEAM(6);
    }
    if (IN(7)) {
        Gemm g{(const bf16_t*)(ws + WS_H), (const bf16_t*)(ws + WS_WFF2), MPROMPT, DM, DFF}; StaticOrder S; S.init(MPROMPT, DM, F.G, (int)blockIdx.x);
        EpiN<2> E{nullptr, (bf16_t*)(ws + WS_A7), DM, R, nullptr, R, args.in[17], PS2, nullptr};
        gemm_phase<EpiN<2>, StaticOrder, true, true>(F.lds + RING_OFF, g, S, E);
        FeN<2> fe{E, nullptr, PSS2, nullptr}; skinny_gemm<DFF>(F, SAMP(ws + WS_H, DFF), (const bf16*)(ws + WS_WFF2), DM, fe);
        SEAM(7);
    }
    if (IN(8)) {
        { Gemm g{(const bf16_t*)(ws + WS_A7), (const bf16_t*)(ws + WS_WGATE), MPROMPT, DM, DM}; StaticOrder S; S.init(MPROMPT, DM, F.G, (int)blockIdx.x);
          EpiN<4> E{nullptr, (bf16_t*)(ws + WS_MB), DM, nullptr, nullptr, nullptr, nullptr, nullptr, PS2};
          gemm_phase<EpiN<4>, StaticOrder, true, true>(F.lds + RING_OFF, g, S, E);
          FeN<4> fe{E, nullptr, nullptr, PSS2}; skinny_gemm<DM>(F, SAMP(ws + WS_A7, DM), (const bf16*)(ws + WS_WGATE), DM, fe); }
        { Gemm g{(const bf16_t*)(ws + WS_PB), (const bf16_t*)(ws + WS_WPROJ), MPROMPT, DM, DPLE}; StaticOrder S; S.init(MPROMPT, DM, F.G, (int)blockIdx.x);
          EpiN<5> E{nullptr, (bf16_t*)(ws + WS_MB), DM, nullptr, nullptr, R, nullptr, PS3, nullptr};
          gemm_phase<EpiN<5>, StaticOrder, true, true>(F.lds + RING_OFF, g, S, E);
          FeN<5> fe{E, nullptr, PSS3, nullptr}; skinny_gemm<DPLE>(F, SAMP(ws + WS_PB, DPLE), (const bf16*)(ws + WS_WPROJ), DM, fe); }
        SEAM(8);
    }
    if (IN(9)) { p9_final(F, args); }
#if PROBE_ON
    STAMP(9);
    if (blockIdx.x == 0 && tid_v == 0) { const unsigned t0_ = (unsigned)rt(); const unsigned dly_ = PW[1]; while ((unsigned)rt() - t0_ < dly_) __builtin_amdgcn_s_sleep(16); }
#endif
#undef IN
#undef SEAM
#undef tid_v
}

extern "C" void kernel_launch(void* const* d_in, const int* in_sizes, int n_in, void* d_out, int out_size, void* d_ws, size_t ws_size, hipStream_t stream) {
    static int grid = 0;
    if (grid == 0) {
        if (n_in != 21 || out_size != (int)OUT_TOTAL || ws_size < WS_END) { fprintf(stderr, "kernel_launch: unexpected problem (n_in %d out %d ws %zu need %zu)\n", n_in, out_size, ws_size, (size_t)WS_END); grid = -1; return; }
        int dev = 0, cus = 0;
        if (hipGetDevice(&dev) != hipSuccess || hipDeviceGetAttribute(&cus, hipDeviceAttributeMultiprocessorCount, dev) != hipSuccess) { grid = -1; return; }
        if (hipFuncSetAttribute((const void*)fwd_kernel, hipFuncAttributeMaxDynamicSharedMemorySize, LDS_BYTES) != hipSuccess) { fprintf(stderr, "kernel_launch: hipFuncSetAttribute failed\n"); grid = -1; return; }
        (void)hipGetLastError();
        grid = cus;
    }
    if (grid < 0) return;
    (void)hipMemsetAsync((char*)d_ws + WS_CTL, 0, CTL_ZERO_BYTES, stream);
    Args a{};
    for (int i = 0; i < 21; ++i) a.in[i] = (const float*)d_in[i];
    a.out = (float*)d_out; a.ws = (unsigned char*)d_ws;
#if MK_ONE_LAUNCH
    a.ph_lo = 0; a.ph_hi = NPH; a.use_bar = 1;
    hipLaunchKernelGGL(fwd_kernel, dim3(grid), dim3(NWAVES * 64), LDS_BYTES, stream, a);
#else
    for (int p = 0; p < NPH; ++p) { a.ph_lo = p; a.ph_hi = p + 1; a.use_bar = 0; hipLaunchKernelGGL(fwd_kernel, dim3(grid), dim3(NWAVES * 64), LDS_BYTES, stream, a); }
#endif
}
```

```cpp
#include <hip/hip_runtime.h>
#include <cstdio>
#include <cstdint>
namespace pg8 {
#define PG8_LAS __attribute__((address_space(3)))
typedef unsigned short bf16_t;
typedef short bf16x8 __attribute__((ext_vector_type(8)));
typedef float f32x4 __attribute__((ext_vector_type(4)));
typedef unsigned u32x4 __attribute__((ext_vector_type(4)));
constexpr int BM = 256, BK = 64, HALF = 128, HTB = HALF * BK * 2  , STAGE_BYTES = 8 * HTB, NXCD = 8, WGM = 8;

__host__ __device__ __forceinline__ int lds_byte(int r, int c) { const int st = (r >> 4) * 2 + (c >> 5), rr = r & 15, cc = c & 31, ob = rr * 64 + cc * 2; return st * 1024 + (ob ^ (((ob >> 9) & 1) << 5)); }
__host__ __device__ __forceinline__ void stage_rc(int b, int& R, int& C) { const int st = b / 1024, sb = b % 1024, swz = sb ^ (((sb >> 9) & 1) << 5); R = (st >> 1) * 16 + swz / 64; C = (st & 1) * 32 + (swz % 64) / 2; }
__host__ __device__ __forceinline__ int perm32(int rho) { const int n = rho >> 4, i = rho & 15; return 8 * (i >> 2) + 4 * n + (i & 3); }

struct Unit { int pm, pn; };
struct Gemm { const bf16_t* A; const bf16_t* Bt; int M, N, K; };

struct StaticOrder {
    int nM, nN, nwg, G, c;
    __host__ __device__ void init(int M, int N, int G_, int c_) { nM = M / BM; nN = N / BM; nwg = nM * nN; G = G_; c = c_; }
    __host__ __device__ bool next(int i, Unit& u) const {
        const long L = (long)i * G + c; if (L >= nwg) return false;
        int wgid = (int)L; { const int q = nwg / NXCD, r = nwg % NXCD, xcd = wgid % NXCD, off = wgid / NXCD; wgid = (xcd < r ? xcd * (q + 1) : r * (q + 1) + (xcd - r) * q) + off; }
        const int nig = WGM * nN, gid = wgid / nig, fm = gid * WGM, gsz = (nM - fm) < WGM ? (nM - fm) : WGM;
        u.pm = fm + ((wgid % nig) % gsz); u.pn = (wgid % nig) / gsz; return true;
    }
    __device__ __forceinline__ void a_ready(const Unit&) const {}
    __device__ __forceinline__ void done(const Unit&) const {}
};

__device__ __forceinline__ unsigned cvt_pk_bf16(float lo, float hi) { unsigned r; asm volatile("v_cvt_pk_bf16_f32 %0, %1, %2" : "=v"(r) : "v"(lo), "v"(hi)); return r; }

template <class Epi, class Sched, bool ALIGN_EPI = false, bool SP2 = false>
__device__ __forceinline__ void gemm_phase(PG8_LAS unsigned char* lds, const Gemm g, const Sched& S, const Epi& E) {
    const int tid = threadIdx.x, wid = __builtin_amdgcn_readfirstlane(tid >> 6), lane = tid & 63, wr = wid >> 2, wc = wid & 3, fr = lane & 15, fq = lane >> 4;
    const int K = g.K, nt = K / BK;
    unsigned voffA[2], voffB[2];
#pragma unroll
    for (int i = 0; i < 2; ++i) { int R, C; stage_rc(tid * 16 + i * 8192, R, C); const int Rb = Epi::PERM ? ((R & ~31) + perm32(R & 31)) : R;
        voffA[i] = (unsigned)(R * K + C) * 2u; voffB[i] = (unsigned)(Rb * K + C) * 2u; }
    const size_t kstep = (size_t)(BK * 2);
    const size_t hstep = (size_t)HALF * K * 2;
    const size_t tstep = 2 * hstep;
    const unsigned ldsw = (unsigned)wid * 1024u;
    const int aoff = lds_byte(wr * 64 + fr, fq * 8), boff = lds_byte(wc * 32 + fr, fq * 8);
#define PG8_SA(b, h) (((b) * 2 + (h)) * HTB)
#define PG8_SB(b, h) ((4 + (b) * 2 + (h)) * HTB)
#define PG8_STAGE(bufoff, gbase, voff) do { _Pragma("unroll") for (int _i = 0; _i < 2; ++_i) \
        __builtin_amdgcn_global_load_lds((const unsigned*)((const char*)(gbase) + (voff)[_i]), (PG8_LAS unsigned*)(lds + (bufoff) + ldsw + _i * 8192), 16, 0, 0); } while (0)
#define PG8_LDA(dst, b, h) do { _Pragma("unroll") for (int m = 0; m < 4; ++m) _Pragma("unroll") for (int k = 0; k < 2; ++k) dst[m][k] = *(const PG8_LAS bf16x8*)(lds + PG8_SA(b, h) + aoff + m * 2048 + k * 1024); } while (0)
#define PG8_LDB(dst, b, h) do { _Pragma("unroll") for (int n = 0; n < 2; ++n) _Pragma("unroll") for (int k = 0; k < 2; ++k) dst[n][k] = *(const PG8_LAS bf16x8*)(lds + PG8_SB(b, h) + boff + n * 2048 + k * 1024); } while (0)
#define PG8_MMA(ai, bj, At, Bt) do { __builtin_amdgcn_s_setprio(1); _Pragma("unroll") for (int m = 0; m < 4; ++m) _Pragma("unroll") for (int n = 0; n < 2; ++n) _Pragma("unroll") for (int k = 0; k < 2; ++k) \
        acc[ai][bj][m][n] = __builtin_amdgcn_mfma_f32_16x16x32_bf16(Bt[n][k], At[m][k], acc[ai][bj][m][n], 0, 0, 0); __builtin_amdgcn_s_setprio(0); } while (0)
#define PG8_WAIT_V(n) asm volatile("s_waitcnt vmcnt(" #n ")" ::: "memory")
#define PG8_WAIT_L(n) asm volatile("s_waitcnt lgkmcnt(" #n ")" ::: "memory")
#define PG8_BAR __builtin_amdgcn_s_barrier()
#define PG8_SCHED __builtin_amdgcn_sched_barrier(0)
    Unit cur, nxt; int ui = 0;
    if (!S.next(0, cur)) return;
    f32x4 acc[2][2][4][2];
#pragma unroll
    for (int a = 0; a < 2; ++a)
#pragma unroll
        for (int b = 0; b < 2; ++b)
#pragma unroll
            for (int m = 0; m < 4; ++m)
#pragma unroll
                for (int n = 0; n < 2; ++n) acc[a][b][m][n] = (f32x4){0.f, 0.f, 0.f, 0.f};
    bf16x8 At[4][2], B0[2][2], B1[2][2];
    const char* cA = (const char*)g.A + (size_t)cur.pm * tstep; const char* cB = (const char*)g.Bt + (size_t)cur.pn * tstep;
    S.a_ready(cur);
    if constexpr (SP2) {
        PG8_STAGE(PG8_SB(0, 0), cB, voffB); PG8_STAGE(PG8_SB(0, 1), cB + hstep, voffB); PG8_STAGE(PG8_SA(0, 0), cA, voffA); PG8_STAGE(PG8_SA(0, 1), cA + hstep, voffA);
        if (wr == 1) PG8_BAR;
        PG8_WAIT_V(2); PG8_BAR;
        PG8_STAGE(PG8_SB(1, 0), cB + kstep, voffB); PG8_STAGE(PG8_SA(1, 0), cA + kstep, voffA); PG8_STAGE(PG8_SB(1, 1), cB + hstep + kstep, voffB);
        PG8_WAIT_V(6); PG8_BAR;
    } else {
        PG8_STAGE(PG8_SB(0, 0), cB, voffB); PG8_STAGE(PG8_SA(0, 0), cA, voffA); PG8_STAGE(PG8_SB(0, 1), cB + hstep, voffB); PG8_STAGE(PG8_SA(0, 1), cA + hstep, voffA);
        if (wr == 1) PG8_BAR;
        PG8_WAIT_V(4); PG8_BAR;
        PG8_STAGE(PG8_SB(1, 0), cB + kstep, voffB); PG8_STAGE(PG8_SA(1, 0), cA + kstep, voffA); PG8_STAGE(PG8_SB(1, 1), cB + hstep + kstep, voffB);
        PG8_WAIT_V(6); PG8_BAR;
    }
    for (;;) {
        const bool has_next = S.next(ui + 1, nxt);
        const char* nA = has_next ? (const char*)g.A + (size_t)nxt.pm * tstep : cA; const char* nB = has_next ? (const char*)g.Bt + (size_t)nxt.pn * tstep : cB;
        for (int t = 0; t < nt; t += 2) {
            const bool last = (t == nt - 2);
            const char* a1 = cA + (size_t)(t + 1) * kstep;
            const char* a2 = last ? nA : cA + (size_t)(t + 2) * kstep; const char* b2 = last ? nB : cB + (size_t)(t + 2) * kstep;
            const char* a3 = a2 + kstep; const char* b3 = b2 + kstep;
            if (last && has_next) S.a_ready(nxt);
            if constexpr (SP2) {
            PG8_LDB(B0, 0, 0); PG8_LDB(B1, 0, 1); PG8_SCHED; PG8_LDA(At, 0, 0); PG8_STAGE(PG8_SA(1, 1), a1 + hstep, voffA);
            PG8_WAIT_V(8); PG8_WAIT_L(0); PG8_BAR; PG8_MMA(0, 0, At, B0); PG8_MMA(0, 1, At, B1); PG8_BAR; PG8_SCHED;
            PG8_LDA(At, 0, 1); PG8_STAGE(PG8_SB(0, 0), b2, voffB); PG8_STAGE(PG8_SB(0, 1), b2 + hstep, voffB); PG8_STAGE(PG8_SA(0, 0), a2, voffA);
            PG8_WAIT_V(8); PG8_WAIT_L(0); PG8_BAR; PG8_MMA(1, 0, At, B0); PG8_MMA(1, 1, At, B1); PG8_BAR; PG8_SCHED;
            PG8_LDB(B0, 1, 0); PG8_LDB(B1, 1, 1); PG8_SCHED; PG8_LDA(At, 1, 0); PG8_STAGE(PG8_SA(0, 1), a2 + hstep, voffA);
            PG8_WAIT_V(8); PG8_WAIT_L(0); PG8_BAR; PG8_MMA(0, 0, At, B0); PG8_MMA(0, 1, At, B1); PG8_BAR; PG8_SCHED;
            PG8_LDA(At, 1, 1); PG8_STAGE(PG8_SB(1, 0), b3, voffB); PG8_STAGE(PG8_SB(1, 1), b3 + hstep, voffB); PG8_STAGE(PG8_SA(1, 0), a3, voffA);
            PG8_WAIT_V(8); PG8_WAIT_L(0); PG8_BAR; PG8_MMA(1, 0, At, B0); PG8_MMA(1, 1, At, B1); PG8_BAR; PG8_SCHED;
            } else {
            PG8_LDB(B0, 0, 0); PG8_SCHED; PG8_LDA(At, 0, 0); PG8_STAGE(PG8_SA(1, 1), a1 + hstep, voffA);
            PG8_WAIT_L(8); PG8_BAR; PG8_WAIT_L(0); PG8_MMA(0, 0, At, B0); PG8_BAR; PG8_SCHED;
            PG8_LDB(B1, 0, 1); PG8_STAGE(PG8_SB(0, 0), b2, voffB);
            PG8_BAR; PG8_WAIT_L(0); PG8_MMA(0, 1, At, B1); PG8_BAR;
            PG8_LDA(At, 0, 1); PG8_STAGE(PG8_SA(0, 0), a2, voffA);
            PG8_BAR; PG8_WAIT_L(0); PG8_MMA(1, 0, At, B0); PG8_BAR; PG8_SCHED;
            PG8_STAGE(PG8_SB(0, 1), b2 + hstep, voffB);
            PG8_WAIT_V(6); PG8_BAR; PG8_MMA(1, 1, At, B1); PG8_BAR;
            PG8_LDB(B0, 1, 0); PG8_SCHED; PG8_LDA(At, 1, 0); PG8_STAGE(PG8_SA(0, 1), a2 + hstep, voffA);
            PG8_WAIT_L(8); PG8_BAR; PG8_WAIT_L(0); PG8_MMA(0, 0, At, B0); PG8_BAR; PG8_SCHED;
            PG8_LDB(B1, 1, 1); PG8_STAGE(PG8_SB(1, 0), b3, voffB);
            PG8_BAR; PG8_WAIT_L(0); PG8_MMA(0, 1, At, B1); PG8_BAR;
            PG8_LDA(At, 1, 1); PG8_STAGE(PG8_SA(1, 0), a3, voffA);
            PG8_BAR; PG8_WAIT_L(0); PG8_MMA(1, 0, At, B0); PG8_BAR; PG8_SCHED;
            PG8_STAGE(PG8_SB(1, 1), b3 + hstep, voffB);
            PG8_WAIT_V(6); PG8_BAR; PG8_MMA(1, 1, At, B1); PG8_BAR;
            }
        }
        if constexpr (ALIGN_EPI) { if (wr == 0) PG8_BAR; }
        if constexpr (!Epi::AFTER_DRAIN) { E(acc, cur, wr, wc, fr, fq); S.done(cur); }
        if (!has_next) break;
#pragma unroll
        for (int a = 0; a < 2; ++a)
#pragma unroll
            for (int b = 0; b < 2; ++b)
#pragma unroll
                for (int m = 0; m < 4; ++m)
#pragma unroll
                    for (int n = 0; n < 2; ++n) acc[a][b][m][n] = (f32x4){0.f, 0.f, 0.f, 0.f};
        cur = nxt; cA = nA; cB = nB; ++ui;
        if constexpr (ALIGN_EPI) { if (wr == 1) PG8_BAR; }
    }
    PG8_WAIT_V(0);
    if constexpr (!ALIGN_EPI) { if (wr == 0) PG8_BAR; }
    PG8_BAR;
    if constexpr (Epi::AFTER_DRAIN) { E.fused(acc, cur, wr, wc, fr, fq, lds, wid, lane); S.done(cur); }
#undef PG8_SA
#undef PG8_SB
#undef PG8_STAGE
#undef PG8_LDA
#undef PG8_LDB
#undef PG8_MMA
#undef PG8_WAIT_V
#undef PG8_WAIT_L
#undef PG8_BAR
#undef PG8_SCHED
}
}


constexpr int DM = 1024, NB = 8, SEQ = 2048, NDEC = 128, MPROMPT = NB * SEQ, MTOT = MPROMPT + NDEC, MP = 16640  ;
constexpr int HR = 4, DKR = 128, DVR = 256, HG = 8, DKG = 128, DVG = 128, DFF = 4096, DPLE = 256, DIN = 9216, CH = 64, NCHUNK = MPROMPT / CH;
constexpr float EPS = 1e-6f;
constexpr size_t OFF_Y = 0, OFF_RETP = (size_t)MTOT * DM, OFF_HGP = OFF_RETP + (size_t)NB * HR * DKR * DVR, OFF_RETS = OFF_HGP + (size_t)NB * HG * DKG * DVG,
                 OFF_HGS = OFF_RETS + (size_t)NDEC * HR * DKR * DVR, OUT_TOTAL = OFF_HGS + (size_t)NDEC * HG * DKG * DVG;
static_assert(OUT_TOTAL == 52559872, "output size");

namespace pg8 {
typedef unsigned u32x2 __attribute__((ext_vector_type(2)));
typedef float f32x2 __attribute__((ext_vector_type(2)));
__device__ __forceinline__ float bf2f(unsigned short b) { return __uint_as_float((unsigned)b << 16); }
__device__ __forceinline__ float bflo(unsigned w) { return __uint_as_float(w << 16); }
__device__ __forceinline__ float bfhi(unsigned w) { return __uint_as_float(w & 0xffff0000u); }
__device__ __forceinline__ float sigmoidf_(float x) { return 1.0f / (1.0f + __expf(-x)); }
__device__ __forceinline__ float siluf_(float x) { return x / (1.0f + __expf(-x)); }
__device__ __forceinline__ u32x2 pack4(f32x4 v) { u32x2 w; w.x = cvt_pk_bf16(v[0], v[1]); w.y = cvt_pk_bf16(v[2], v[3]); return w; }
__device__ __forceinline__ f32x4 unpack4(u32x2 w) { return (f32x4){bflo(w.x), bfhi(w.x), bflo(w.y), bfhi(w.y)}; }

typedef unsigned u32x4 __attribute__((ext_vector_type(4)));
#define DPP_ROW_SHR(x, n) __int_as_float(__builtin_amdgcn_update_dpp(0, __float_as_int(x), 0x110 + (n), 0xf, 0xf, true))
#define DPP_ROW_BCAST15(x) __int_as_float(__builtin_amdgcn_update_dpp(0, __float_as_int(x), 0x15F, 0xf, 0xf, false))
struct EpiIn {
    static constexpr bool PERM = true, AFTER_DRAIN = false;
    const float* rstd0; const float* cs; const float* lb;
    bf16_t *QR, *KR, *VR, *GR, *QG, *KG, *VG, *GG, *AR, *AH; float *GL, *FS;
    __device__ __forceinline__ void operator()(const f32x4 (&acc)[2][2][4][2], const Unit& u, int wr, int wc, int fr, int fq) const {
        const int pn = u.pn;
#pragma unroll
        for (int ai = 0; ai < 2; ++ai) {
            const int rbase = u.pm * BM + ai * HALF + wr * 64;
            float rs[4];
#pragma unroll
            for (int m = 0; m < 4; ++m) rs[m] = rstd0[rbase + m * 16 + fr];
            if (pn < 4) {
                const bool isk = pn >= 2; bf16_t* dst = isk ? KR : QR;
#pragma unroll
                for (int bj = 0; bj < 2; ++bj) {
                    const int head = 2 * (pn & 1) + bj;
                    const float lg = __logf(1.0f - exp2f(-5.0f - (float)head));
                    const int j0 = 16 * wc + 4 * fq;
#pragma unroll
                    for (int m = 0; m < 4; ++m) {
                        const int row = rbase + m * 16 + fr; const int pidx = row & (SEQ - 1);
                        const float e = lg * (float)(m * 16 + fr + 1);
                        const float sc = rs[m] * (isk ? 0.08838834764831845f * __expf(-e) : __expf(e));
                        const f32x4 t0 = *(const f32x4*)(cs + ((size_t)pidx * 64 + j0) * 2), t1 = *(const f32x4*)(cs + ((size_t)pidx * 64 + j0 + 2) * 2);
                        const f32x4 v0 = acc[ai][bj][m][0] * sc, v1 = acc[ai][bj][m][1] * sc;
                        u32x2 o1, o2;
                        o1.x = cvt_pk_bf16(v0[0] * t0[0] - v0[1] * t0[1], v0[2] * t0[2] - v0[3] * t0[3]); o1.y = cvt_pk_bf16(v1[0] * t1[0] - v1[1] * t1[1], v1[2] * t1[2] - v1[3] * t1[3]);
                        o2.x = cvt_pk_bf16(v0[0] * t0[1] + v0[1] * t0[0], v0[2] * t0[3] + v0[3] * t0[2]); o2.y = cvt_pk_bf16(v1[0] * t1[1] + v1[1] * t1[0], v1[2] * t1[3] + v1[3] * t1[2]);
                        bf16_t* p = dst + (size_t)row * 512 + head * 128 + j0;
                        *(u32x2*)p = o1; *(u32x2*)(p + 64) = o2;
                    }
                }
            } else if (pn >= 12 && pn < 20) {
                const int head = pn - 12;
#pragma unroll
                for (int bj = 0; bj < 2; ++bj) {
                    const int j0 = 64 * bj + 16 * wc + 4 * fq, c = head * 128 + j0;
                    const f32x4 lbv = *(const f32x4*)(lb + c);
                    float qa[4][4], ka[4][4], ba[4][4];
#pragma unroll
                    for (int q = 0; q < 4; ++q) {
                        const int n = q >> 1, e = q & 1; const float one_m_lb = 1.0f - lbv[q]; float carry = 0.f;
#pragma unroll
                        for (int m = 0; m < 4; ++m) {
                            const float vq = acc[ai][bj][m][n][2 * e] * rs[m], vf = acc[ai][bj][m][n][2 * e + 1] * rs[m];
                            const float kk = one_m_lb / (1.0f + __expf(vf));
                            float x = __logf(1.0f - kk);
                            x += DPP_ROW_SHR(x, 1); x += DPP_ROW_SHR(x, 2); x += DPP_ROW_SHR(x, 4); x += DPP_ROW_SHR(x, 8);
                            x += carry; carry = DPP_ROW_BCAST15(x);
                            qa[m][q] = siluf_(vq); ka[m][q] = kk; ba[m][q] = x;
                        }
                    }
#pragma unroll
                    for (int m = 0; m < 4; ++m) {
                        const int row = rbase + m * 16 + fr;
                        const float e0 = __expf(ba[m][0]), e1 = __expf(ba[m][1]), e2 = __expf(ba[m][2]), e3 = __expf(ba[m][3]);
                        u32x2 qw, kw;
                        qw.x = cvt_pk_bf16(qa[m][0] * e0, qa[m][1] * e1); qw.y = cvt_pk_bf16(qa[m][2] * e2, qa[m][3] * e3);
                        kw.x = cvt_pk_bf16(ka[m][0] * __expf(-ba[m][0]), ka[m][1] * __expf(-ba[m][1])); kw.y = cvt_pk_bf16(ka[m][2] * __expf(-ba[m][2]), ka[m][3] * __expf(-ba[m][3]));
                        *(u32x2*)(QG + (size_t)row * DM + c) = qw; *(u32x2*)(KG + (size_t)row * DM + c) = kw;
                        if (m == 3 && fr == 15) *(f32x4*)(GL + (size_t)(row >> 6) * DM + c) = (f32x4){e0, e1, e2, e3};
                    }
                }
            } else {
                int mode, cbase; bf16_t* dst;
                if (pn < 8) { dst = VR; cbase = (pn - 4) * BM; mode = 0; } else if (pn < 12) { dst = GR; cbase = (pn - 8) * BM; mode = 1; }
                else if (pn < 24) { dst = VG; cbase = (pn - 20) * BM; mode = 0; } else if (pn < 28) { dst = GG; cbase = (pn - 24) * BM; mode = 1; }
                else if (pn < 32) { dst = AR; cbase = (pn - 28) * BM; mode = 2; } else { dst = AH; cbase = (pn - 32) * BM; mode = 2; }
#pragma unroll
                for (int m = 0; m < 4; ++m) {
                    const int row = rbase + m * 16 + fr;
#pragma unroll
                    for (int bj = 0; bj < 2; ++bj) {
                        f32x4 v0 = acc[ai][bj][m][0] * rs[m], v1 = acc[ai][bj][m][1] * rs[m];
                        if (mode == 1) { v0[0] = siluf_(v0[0]); v0[1] = siluf_(v0[1]); v0[2] = siluf_(v0[2]); v0[3] = siluf_(v0[3]); v1[0] = siluf_(v1[0]); v1[1] = siluf_(v1[1]); v1[2] = siluf_(v1[2]); v1[3] = siluf_(v1[3]); }
                        else if (mode == 2) { v0[0] = sigmoidf_(v0[0]); v0[1] = sigmoidf_(v0[1]); v0[2] = sigmoidf_(v0[2]); v0[3] = sigmoidf_(v0[3]); v1[0] = sigmoidf_(v1[0]); v1[1] = sigmoidf_(v1[1]); v1[2] = sigmoidf_(v1[2]); v1[3] = sigmoidf_(v1[3]); }
                        const u32x2 a = pack4(v0), b = pack4(v1);
                        *(u32x4*)(dst + (size_t)row * DM + cbase + bj * HALF + wc * 32 + fq * 8) = (u32x4){a.x, a.y, b.x, b.y};
                    }
                }
            }
        }
    }
};

__device__ __forceinline__ void unpack8(u32x4 w, f32x4& a, f32x4& b) { a = (f32x4){bflo(w.x), bfhi(w.x), bflo(w.y), bfhi(w.y)}; b = (f32x4){bflo(w.z), bfhi(w.z), bflo(w.w), bfhi(w.w)}; }
__device__ __forceinline__ u32x4 pack8(f32x4 a, f32x4 b) { const u32x2 x = pack4(a), y = pack4(b); return (u32x4){x.x, x.y, y.x, y.y}; }
__device__ __forceinline__ float sumsq4(f32x4 r) { return (r[0] * r[0] + r[1] * r[1]) + (r[2] * r[2] + r[3] * r[3]); }
template <int MODE> struct EpiN {
    static constexpr bool PERM = true, AFTER_DRAIN = false;
    const bf16_t* gate; bf16_t* out16; int ld16; const float* xp; const float* xs; float* R; const float* g; float* PS; const float* PSin;
    __device__ __forceinline__ void operator()(const f32x4 (&acc)[2][2][4][2], const Unit& u, int wr, int wc, int fr, int fq) const {
#pragma unroll
        for (int ai = 0; ai < 2; ++ai) {
            const int rbase = u.pm * BM + ai * HALF + wr * 64;
#pragma unroll
            for (int m = 0; m < 4; ++m) {
                const int row = rbase + m * 16 + fr;
                float rstd = 1.f;
                if (MODE == 3 || MODE == 4) {
                    const f32x4* p = (const f32x4*)(PSin + (size_t)row * 16); const f32x4 a = p[0], b = p[1], c = p[2], d = p[3];
                    const float s = ((a[0] + a[1]) + (a[2] + a[3])) + ((b[0] + b[1]) + (b[2] + b[3])) + ((c[0] + c[1]) + (c[2] + c[3])) + ((d[0] + d[1]) + (d[2] + d[3]));
                    rstd = rsqrtf(s * (1.0f / 1024.0f) + EPS);
                }
                float ss = 0.f;
#pragma unroll
                for (int bj = 0; bj < 2; ++bj) {
                    const int col = u.pn * BM + bj * HALF + wc * 32 + fq * 8;
                    const f32x4 a0 = acc[ai][bj][m][0], a1 = acc[ai][bj][m][1];
                    if (MODE == 0) { f32x4 g0, g1; unpack8(*(const u32x4*)(gate + (size_t)row * DM + col), g0, g1); *(u32x4*)(out16 + (size_t)row * ld16 + col) = pack8(g0 * a0, g1 * a1); }
                    else if (MODE == 1) { f32x4 g0, g1, t0, t1; unpack8(*(const u32x4*)(gate + (size_t)row * DM + col), g0, g1); u32x4* o = (u32x4*)(out16 + (size_t)row * ld16 + col); unpack8(*o, t0, t1); *o = pack8(t0 + g0 * a0, t1 + g1 * a1); }
                    else if (MODE == 2) {
                        const float* bp = xp + (size_t)row * DM + col;
                        const f32x4 r0 = *(const f32x4*)bp + a0, r1 = *(const f32x4*)(bp + 4) + a1; float* rp = R + (size_t)row * DM + col; *(f32x4*)rp = r0; *(f32x4*)(rp + 4) = r1;
                        ss += sumsq4(r0) + sumsq4(r1);
                        *(u32x4*)(out16 + (size_t)row * ld16 + col) = pack8(r0 * *(const f32x4*)(g + col), r1 * *(const f32x4*)(g + col + 4));
                    }
                    else if (MODE == 3) { f32x4 v0 = a0 * rstd, v1 = a1 * rstd;
                        v0[0] = fmaxf(v0[0], 0.f); v0[1] = fmaxf(v0[1], 0.f); v0[2] = fmaxf(v0[2], 0.f); v0[3] = fmaxf(v0[3], 0.f); v1[0] = fmaxf(v1[0], 0.f); v1[1] = fmaxf(v1[1], 0.f); v1[2] = fmaxf(v1[2], 0.f); v1[3] = fmaxf(v1[3], 0.f);
                        *(u32x4*)(out16 + (size_t)row * ld16 + col) = pack8(v0 * v0, v1 * v1); }
                    else if (MODE == 4) { f32x4 v0 = a0 * rstd, v1 = a1 * rstd;
                        v0[0] = sigmoidf_(v0[0]); v0[1] = sigmoidf_(v0[1]); v0[2] = sigmoidf_(v0[2]); v0[3] = sigmoidf_(v0[3]); v1[0] = sigmoidf_(v1[0]); v1[1] = sigmoidf_(v1[1]); v1[2] = sigmoidf_(v1[2]); v1[3] = sigmoidf_(v1[3]);
                        *(u32x4*)(out16 + (size_t)row * ld16 + col) = pack8(v0, v1); }
                    else if (MODE == 5) { f32x4 t0, t1; unpack8(*(const u32x4*)(out16 + (size_t)row * ld16 + col), t0, t1); float* rp = R + (size_t)row * DM + col;
                        const f32x4 r0 = *(const f32x4*)rp + t0 * a0, r1 = *(const f32x4*)(rp + 4) + t1 * a1; *(f32x4*)rp = r0; *(f32x4*)(rp + 4) = r1; ss += sumsq4(r0) + sumsq4(r1); }
                }
                if (MODE == 2 || MODE == 5) { ss += __shfl_xor(ss, 16); ss += __shfl_xor(ss, 32); if (fq == 0) PS[(size_t)row * 16 + u.pn * 4 + wc] = ss; }
            }
        }
    }
};

__device__ __forceinline__ void samp_in(const EpiIn& E, int row, int pcol, f32x4 v) {
    const float rs = E.rstd0[row]; const int pn = __builtin_amdgcn_readfirstlane(pcol >> 8), p = pcol & 255;
    if (pn < 4) {
        const bool isk = pn >= 2; bf16_t* dst = isk ? E.KR : E.QR; const int head = 2 * (pn & 1) + (p >> 7), j = (p & 127) >> 1;
        const f32x4 t = *(const f32x4*)(E.cs + ((size_t)SEQ * 64 + j) * 2);
        v = v * (rs * (isk ? 0.08838834764831845f : 1.0f));
        const float o1a = v[0] * t[0] - v[1] * t[1], o2a = v[0] * t[1] + v[1] * t[0], o1b = v[2] * t[2] - v[3] * t[3], o2b = v[2] * t[3] + v[3] * t[2];
        bf16_t* q = dst + (size_t)row * 512 + head * 128 + j;
        *(unsigned*)q = cvt_pk_bf16(o1a, o1b); *(unsigned*)(q + 64) = cvt_pk_bf16(o2a, o2b);
    } else if (pn >= 12 && pn < 20) {
        const int c = (pn - 12) * 128 + (p >> 1);
        const float k0 = (1.0f - E.lb[c]) / (1.0f + __expf(v[1] * rs)), k1 = (1.0f - E.lb[c + 1]) / (1.0f + __expf(v[3] * rs));
        *(unsigned*)(E.QG + (size_t)row * DM + c) = cvt_pk_bf16(siluf_(v[0] * rs), siluf_(v[2] * rs));
        *(unsigned*)(E.KG + (size_t)row * DM + c) = cvt_pk_bf16(k0, k1);
        *(f32x2*)(E.FS + (size_t)(row - MPROMPT) * DM + c) = (f32x2){1.0f - k0, 1.0f - k1};
    } else {
        v = v * rs;
        const bool sl = (pn >= 8 && pn < 12) || (pn >= 24 && pn < 28), sg = pn >= 28;
        if (sl) { v[0] = siluf_(v[0]); v[1] = siluf_(v[1]); v[2] = siluf_(v[2]); v[3] = siluf_(v[3]); }
        else if (sg) { v[0] = sigmoidf_(v[0]); v[1] = sigmoidf_(v[1]); v[2] = sigmoidf_(v[2]); v[3] = sigmoidf_(v[3]); }
        const u32x2 w = pack4(v); const size_t ro = (size_t)row * DM + p;
        if (pn < 8) *(u32x2*)(E.VR + ro + (pn - 4) * BM) = w;
        else if (pn < 12) *(u32x2*)(E.GR + ro + (pn - 8) * BM) = w;
        else if (pn < 24) *(u32x2*)(E.VG + ro + (pn - 20) * BM) = w;
        else if (pn < 28) *(u32x2*)(E.GG + ro + (pn - 24) * BM) = w;
        else if (pn < 32) *(u32x2*)(E.AR + ro + (pn - 28) * BM) = w;
        else *(u32x2*)(E.AH + ro + (pn - 32) * BM) = w;
    }
}
template <int MODE> __device__ __forceinline__ void samp_n(const EpiN<MODE>& E, const float* xs, float* PSS, const float* PSSin, int row, int col, f32x4 a) {
    const int rs_ = row - MPROMPT; float rstd = 1.f;
    if (MODE == 3 || MODE == 4) { const f32x4* p = (const f32x4*)(PSSin + (size_t)rs_ * 64); float s = 0.f;
#pragma unroll
        for (int i = 0; i < 16; ++i) { const f32x4 q = p[i]; s += (q[0] + q[1]) + (q[2] + q[3]); }
        rstd = rsqrtf(s * (1.0f / 1024.0f) + EPS); }
    float ss = 0.f;
    if (MODE == 0) { const f32x4 gt = unpack4(*(const u32x2*)(E.gate + (size_t)row * DM + col)); *(u32x2*)(E.out16 + (size_t)row * E.ld16 + col) = pack4(gt * a); }
    else if (MODE == 1) { const f32x4 gt = unpack4(*(const u32x2*)(E.gate + (size_t)row * DM + col)); u32x2* o = (u32x2*)(E.out16 + (size_t)row * E.ld16 + col); const f32x4 t = unpack4(*o); *o = pack4(t + gt * a); }
    else if (MODE == 2) { const float* bp = xs ? xs + (size_t)rs_ * DM + col : E.R + (size_t)row * DM + col; const f32x4 r = *(const f32x4*)bp + a; *(f32x4*)(E.R + (size_t)row * DM + col) = r;
        ss = (r[0] * r[0] + r[1] * r[1]) + (r[2] * r[2] + r[3] * r[3]); *(u32x2*)(E.out16 + (size_t)row * E.ld16 + col) = pack4(r * *(const f32x4*)(E.g + col)); }
    else if (MODE == 3) { f32x4 v = a * rstd; v[0] = fmaxf(v[0], 0.f); v[1] = fmaxf(v[1], 0.f); v[2] = fmaxf(v[2], 0.f); v[3] = fmaxf(v[3], 0.f); *(u32x2*)(E.out16 + (size_t)row * E.ld16 + col) = pack4(v * v); }
    else if (MODE == 4) { f32x4 v = a * rstd; v[0] = sigmoidf_(v[0]); v[1] = sigmoidf_(v[1]); v[2] = sigmoidf_(v[2]); v[3] = sigmoidf_(v[3]); *(u32x2*)(E.out16 + (size_t)row * E.ld16 + col) = pack4(v); }
    else if (MODE == 5) { const f32x4 t = unpack4(*(const u32x2*)(E.out16 + (size_t)row * E.ld16 + col)); float* rp = E.R + (size_t)row * DM + col; const f32x4 r = *(const f32x4*)rp + t * a; *(f32x4*)rp = r;
        ss = (r[0] * r[0] + r[1] * r[1]) + (r[2] * r[2] + r[3] * r[3]); }
    if (MODE == 2 || MODE == 5) { ss += __shfl_xor(ss, 16); ss += __shfl_xor(ss, 32); if ((threadIdx.x & 63) < 16) PSS[(size_t)rs_ * 64 + (col >> 4)] = ss; }
}
}


constexpr int NWAVES = 8;
constexpr int NPH = 10;
#ifndef MK_ONE_LAUNCH
#define MK_ONE_LAUNCH 1
#endif

constexpr size_t MiB = 1u << 20;
constexpr size_t WS_CTL = 0, CTL_ZERO_BYTES = 1 * MiB;
constexpr size_t WS_WIN = 1 * MiB;
constexpr size_t WS_WUPR = WS_WIN + (size_t)DIN * DM * 2;
constexpr size_t WS_WUPH = WS_WUPR + (size_t)DM * DM * 2;
constexpr size_t WS_WO = WS_WUPH + (size_t)DM * DM * 2;
constexpr size_t WS_WFF1 = WS_WO + (size_t)DM * DM * 2;
constexpr size_t WS_WFF2 = WS_WFF1 + (size_t)DFF * DM * 2;
constexpr size_t WS_WGATE = WS_WFF2 + (size_t)DFF * DM * 2;
constexpr size_t WS_WPROJ = WS_WGATE + (size_t)DM * DM * 2;
constexpr size_t WS_Z6 = WS_WPROJ + (size_t)DM * DPLE * 2;
constexpr size_t Z_QR = WS_Z6, Z_KR = Z_QR + (size_t)MP * 512 * 2, Z_VR = Z_KR + (size_t)MP * 512 * 2, Z_QG = Z_VR + (size_t)MP * DM * 2, Z_KG = Z_QG + (size_t)MP * DM * 2,
                 Z_VG = Z_KG + (size_t)MP * DM * 2, Z_END = Z_VG + (size_t)MP * DM * 2;
constexpr size_t WS_H = WS_Z6, WS_MB = WS_Z6 + (size_t)MP * DFF * 2;
static_assert(WS_MB == Z_VG, "MB overlays VG exactly");
constexpr size_t WS_GR = Z_END, WS_GG = WS_GR + (size_t)MP * DM * 2, WS_A5 = WS_GR, WS_A7 = WS_GG;
constexpr size_t WS_PB = WS_GG + (size_t)MP * DM * 2;
constexpr size_t WS_CS = WS_PB + (size_t)MP * DPLE * 2;
constexpr size_t WS_GL = WS_CS + (size_t)2049 * 64 * 8;
constexpr size_t WS_FS = WS_GL + (size_t)NCHUNK * DM * 4;
constexpr size_t WS_RSTD0 = WS_FS + (size_t)NDEC * DM * 4;
constexpr size_t WS_LB = WS_RSTD0 + (size_t)MP * 4;
constexpr size_t WS_PS1 = WS_LB + 4096, WS_PS2 = WS_PS1 + (size_t)MP * 64, WS_PS3 = WS_PS2 + (size_t)MP * 64, WS_PSS1 = WS_PS3 + (size_t)MP * 64, WS_PSS2 = WS_PSS1 + (size_t)NDEC * 256, WS_PSS3 = WS_PSS2 + (size_t)NDEC * 256, WS_END = WS_PSS3 + (size_t)NDEC * 256;
static_assert(WS_END <= 307920896, "d_ws map must fit sum(inputs) bytes");
static_assert(WS_WIN % 256 == 0 && WS_Z6 % 256 == 0 && WS_GR % 256 == 0 && WS_PB % 256 == 0 && WS_CS % 16 == 0 && WS_GL % 16 == 0 && WS_PS1 % 16 == 0, "alignment");
constexpr int CW_TMO = 0, CW_BAR = 4096;

constexpr int RING_OFF = 0, RING_BYTES = 131072;
constexpr int LDSCTL_OFF = RING_BYTES, MISC_OFF = LDSCTL_OFF + 320;
constexpr int LDS_BYTES = 147456;

#define GAS __attribute__((address_space(1)))
#define LAS __attribute__((address_space(3)))
typedef unsigned short bf16;
typedef unsigned v4u __attribute__((ext_vector_type(4)));
typedef float f32x4 __attribute__((ext_vector_type(4)));
typedef short bf16x8 __attribute__((ext_vector_type(8)));
typedef GAS unsigned gu32;
typedef GAS unsigned long long gu64;
#define RLX_AGENT __ATOMIC_RELAXED, __HIP_MEMORY_SCOPE_AGENT
#define LDS_WAIT() asm volatile("s_waitcnt lgkmcnt(0)" ::: "memory")
#define VM_WAIT() asm volatile("s_waitcnt vmcnt(0)" ::: "memory")
__device__ __forceinline__ unsigned long long rt() { return __builtin_amdgcn_s_memrealtime(); }
__device__ __forceinline__ unsigned f2bf(float f) { unsigned u = __builtin_bit_cast(unsigned, f); return (u + 0x7fffu + ((u >> 16) & 1u)) >> 16; }
__device__ __forceinline__ unsigned pk2(float lo, float hi) { return f2bf(lo) | (f2bf(hi) << 16); }

#define XB_TMO      128
#define XB_XCNT(j)  (256  + 64 * (j))
#define XB_XSUB(j)  (1280 + 64 * (j))
#define XB_XGEN(j)  (2304 + 64 * (j))
#define XB_TOP      3328
#define XB_TOPGEN   3392
#define XCD_BAR_WORDS 3456
#define XB_SPIN_CAP (1u << 18)

__device__ __forceinline__ unsigned xb_ld(unsigned* p)              { return __hip_atomic_load(p, __ATOMIC_RELAXED, __HIP_MEMORY_SCOPE_AGENT); }
__device__ __forceinline__ unsigned xb_add(unsigned* p, unsigned v) { return __hip_atomic_fetch_add(p, v, __ATOMIC_RELAXED, __HIP_MEMORY_SCOPE_AGENT); }
__device__ __forceinline__ unsigned xb_xcc_id() { return (unsigned)__builtin_amdgcn_s_getreg((3 << 11) | 20) & 0xFu; }
#define XB_SPIN(cond, bar) do { unsigned _sp = 0; while (cond) { __builtin_amdgcn_s_sleep(1); \
    if ((++_sp & 255u) == 0u) { if (xb_ld(&(bar)[XB_TMO])) break; if (_sp > XB_SPIN_CAP) { atomicAdd(&(bar)[XB_TMO], 1u); break; } } } } while (0)

struct XcdBarrier {
    unsigned* bar; unsigned x;
    volatile LAS unsigned* st;
};

__device__ __forceinline__ XcdBarrier xcd_barrier_post(unsigned* bar, volatile LAS unsigned* st) {
    XcdBarrier b; b.bar = bar; b.x = xb_xcc_id(); b.st = st;
    if (threadIdx.x == 0) (void)xb_add(&bar[XB_XCNT(b.x)], 1u);
    return b;
}
__device__ __forceinline__ void xcd_barrier_complete(unsigned* bar, unsigned x, unsigned& nloc, unsigned& nx) {
    const unsigned G = gridDim.x * gridDim.y * gridDim.z;
    unsigned sum, cnt, mine, sp = 0u;
    for (;;) {
        sum = 0u; cnt = 0u; mine = 0u;
#pragma unroll
        for (unsigned j = 0; j < 16; ++j) { const unsigned c = xb_ld(&bar[XB_XCNT(j)]); sum += c; cnt += (c > 0u) ? 1u : 0u; mine = (j == x) ? c : mine; }
        if (sum == G) break;
        __builtin_amdgcn_s_sleep(1);
        if ((++sp & 255u) == 0u) { if (xb_ld(&bar[XB_TMO])) break; if (sp > XB_SPIN_CAP) { atomicAdd(&bar[XB_TMO], 1u); break; } }
    }
    nloc = mine > 0u ? mine : 1u; nx = cnt > 0u ? cnt : 1u;
}

__device__ __forceinline__ void xcd_barrier(const XcdBarrier& b) {
    asm volatile("s_waitcnt vmcnt(0)" ::: "memory");
    __syncthreads();
    if (threadIdx.x == 0) {
        unsigned* bar = b.bar;
        __builtin_amdgcn_s_waitcnt(0);
        unsigned nloc = b.st[0], nx = b.st[1];
        if (nloc == 0u) { xcd_barrier_complete(bar, b.x, nloc, nx); b.st[0] = nloc; b.st[1] = nx; }
        const unsigned old = xb_add(&bar[XB_XSUB(b.x)], 1u);
        const unsigned gen = old / nloc;
        if (old + 1u == (gen + 1u) * nloc) {
            __builtin_amdgcn_fence(__ATOMIC_RELEASE, "agent");
            asm volatile("s_waitcnt vmcnt(0)" ::: "memory");
            const unsigned og = xb_add(&bar[XB_TOP], 1u);
            const unsigned tg = og / nx;
            if (og + 1u == (tg + 1u) * nx) xb_add(&bar[XB_TOPGEN], 1u);
            else XB_SPIN(xb_ld(&bar[XB_TOPGEN]) == tg, bar);
            __builtin_amdgcn_fence(__ATOMIC_ACQUIRE, "agent");
            xb_add(&bar[XB_XGEN(b.x)], 1u);
            asm volatile("s_waitcnt vmcnt(0)" ::: "memory");
        } else {
            XB_SPIN(xb_ld(&bar[XB_XGEN(b.x)]) == gen, bar);
            __builtin_amdgcn_fence(__ATOMIC_ACQUIRE, "agent");
            asm volatile("s_waitcnt vmcnt(0)" ::: "memory");
        }
    }
    __syncthreads();
}


#ifndef PROBE_ON
#define PROBE_ON 0
#endif
#define PROBE_UNIT 800ull
#ifndef PROBE_A
#define PROBE_A 0
#define PROBE_B 1
#define PROBE_C 2
#endif
struct Args { const float* in[21]; float* out; unsigned char* ws; int ph_lo, ph_hi, use_bar, pad; };
struct Frame {
    LAS unsigned char* lds; volatile LAS unsigned* MISC; gu32* ctl;
    int vcu, G;
};
__device__ __forceinline__ int tid_() { int t = threadIdx.x; asm volatile("" : "+v"(t)); return t; }
#define FTID (tid_())
#define FLANE (tid_() & 63)
#define FWAVE (__builtin_amdgcn_readfirstlane(tid_() >> 6))
__device__ __forceinline__ float wave_sum(float v) {
#pragma unroll
    for (int o = 1; o < 64; o <<= 1) v += __shfl_xor(v, o);
    return v;
}
#define LBAR() do { asm volatile("s_waitcnt lgkmcnt(0)" ::: "memory"); __builtin_amdgcn_s_barrier(); asm volatile("" ::: "memory"); } while (0)
__device__ __forceinline__ float bf2f_(unsigned short b) { return __uint_as_float((unsigned)b << 16); }
__device__ __forceinline__ float bflo_(unsigned w) { return __uint_as_float(w << 16); }
__device__ __forceinline__ float bfhi_(unsigned w) { return __uint_as_float(w & 0xffff0000u); }

__device__ __forceinline__ int win_src_col(int np) {
    const int tile = np >> 8, p = np & 255;
    if (tile < 4) { const int base = (tile >> 1) * 512, head = 2 * (tile & 1) + (p >> 7), pp = p & 127; return base + head * 128 + (pp & 1) * 64 + (pp >> 1); }
    if (tile >= 12 && tile < 20) { const int h = tile - 12; return 3072 + (p & 1) * 1024 + h * 128 + (p >> 1); }
    return np;
}
template <bool MAP> __device__ __forceinline__ void p0_transpose_item(const float* W, int K, int N, bf16* WT, LAS float* scr, int item, int lane) {
    const int nblk = N / 32, kb = item / nblk, nb = item % nblk, k0 = 64 * kb, n0 = 32 * nb;
    const int srcc = MAP ? win_src_col(n0 + (lane & 31)) : n0 + (lane & 31);
#pragma unroll 8
    for (int i = 0; i < 32; ++i) { const int kk = 2 * i + (lane >> 5); scr[kk * 33 + (lane & 31)] = W[(size_t)(k0 + kk) * N + srcc]; }
    LDS_WAIT(); asm volatile("" ::: "memory");
    const int c = lane & 7;
#pragma unroll
    for (int j = 0; j < 4; ++j) { const int n = (lane >> 3) + 8 * j; const LAS float* s = scr + (8 * c) * 33 + n;
        v4u o; o.x = pk2(s[0 * 33], s[1 * 33]); o.y = pk2(s[2 * 33], s[3 * 33]); o.z = pk2(s[4 * 33], s[5 * 33]); o.w = pk2(s[6 * 33], s[7 * 33]);
        *(GAS v4u*)(WT + (size_t)(n0 + n) * K + k0 + 8 * c) = o; }
    LDS_WAIT(); asm volatile("" ::: "memory");
}
__device__ __forceinline__ void p0_prologue(Frame& F, const Args& a) { const int tid_v = tid_(); const int lane_v = tid_v & 63; const int wave_v = __builtin_amdgcn_readfirstlane(tid_v >> 6); (void)lane_v; (void)wave_v;
    unsigned char* ws = a.ws;
    LAS float* scr = (LAS float*)(F.lds + RING_OFF + wave_v * 16384);
    const int gw = F.vcu * NWAVES + wave_v, NGW = F.G * NWAVES;
    constexpr int I_IN = (DM / 64) * (DIN / 32), I_SQ = (DM / 64) * (DM / 32), I_F1 = (DM / 64) * (DFF / 32), I_F2 = (DFF / 64) * (DM / 32), I_PJ = (DPLE / 64) * (DM / 32);
    constexpr int NITEMS = I_IN + 4 * I_SQ + I_F1 + I_F2 + I_PJ;
    for (int it = gw; it < NITEMS; it += NGW) {
        int r = it;
        if (r < I_IN) { p0_transpose_item<true>(a.in[7], DM, DIN, (bf16*)(ws + WS_WIN), scr, r, lane_v); continue; } r -= I_IN;
        if (r < I_SQ) { p0_transpose_item<false>(a.in[11], DM, DM, (bf16*)(ws + WS_WUPR), scr, r, lane_v); continue; } r -= I_SQ;
        if (r < I_SQ) { p0_transpose_item<false>(a.in[12], DM, DM, (bf16*)(ws + WS_WUPH), scr, r, lane_v); continue; } r -= I_SQ;
        if (r < I_SQ) { p0_transpose_item<false>(a.in[13], DM, DM, (bf16*)(ws + WS_WO), scr, r, lane_v); continue; } r -= I_SQ;
        if (r < I_SQ) { p0_transpose_item<false>(a.in[18], DM, DM, (bf16*)(ws + WS_WGATE), scr, r, lane_v); continue; } r -= I_SQ;
        if (r < I_F1) { p0_transpose_item<false>(a.in[15], DM, DFF, (bf16*)(ws + WS_WFF1), scr, r, lane_v); continue; } r -= I_F1;
        if (r < I_F2) { p0_transpose_item<false>(a.in[16], DFF, DM, (bf16*)(ws + WS_WFF2), scr, r, lane_v); continue; } r -= I_F2;
        p0_transpose_item<false>(a.in[19], DPLE, DM, (bf16*)(ws + WS_WPROJ), scr, r, lane_v);
    }
    bf16* XB = (bf16*)(a.out + OFF_RETS); float* RSTD0 = (float*)(ws + WS_RSTD0); bf16* PB = (bf16*)(ws + WS_PB);
    const float* gmix = a.in[6];
    for (int m = gw; m < MP; m += NGW) {
        GAS unsigned long long* o8 = (GAS unsigned long long*)(XB + (size_t)m * DM) + lane_v;
        GAS unsigned long long* p8 = (GAS unsigned long long*)(PB + (size_t)m * DPLE) + lane_v;
        if (m >= MTOT) {
#pragma unroll
            for (int j = 0; j < 4; ++j) o8[64 * j] = 0ull;
            p8[0] = 0ull; if (lane_v == 0) RSTD0[m] = 0.f; continue;
        }
        const float* xrow = m < MPROMPT ? a.in[0] + (size_t)m * DM : a.in[1] + (size_t)(m - MPROMPT) * DM;
        const float* prow = m < MPROMPT ? a.in[4] + (size_t)m * DPLE : a.in[5] + (size_t)(m - MPROMPT) * DPLE;
        const GAS f32x4* xr = (const GAS f32x4*)xrow + lane_v;
        f32x4 v[4]; float s = 0.f;
#pragma unroll
        for (int j = 0; j < 4; ++j) { v[j] = xr[64 * j]; s += (v[j].x * v[j].x + v[j].y * v[j].y) + (v[j].z * v[j].z + v[j].w * v[j].w); }
        s = wave_sum(s);
        if (lane_v == 0) RSTD0[m] = rsqrtf(s * (1.0f / DM) + EPS);
#pragma unroll
        for (int j = 0; j < 4; ++j) { const f32x4 gv = *((const GAS f32x4*)gmix + 64 * j + lane_v);
            o8[64 * j] = (unsigned long long)pk2(v[j].x * gv.x, v[j].y * gv.y) | ((unsigned long long)pk2(v[j].z * gv.z, v[j].w * gv.w) << 32); }
        const f32x4 pv = *((const GAS f32x4*)prow + lane_v);
        p8[0] = (unsigned long long)pk2(pv.x, pv.y) | ((unsigned long long)pk2(pv.z, pv.w) << 32);
    }
    float* CS = (float*)(ws + WS_CS); float* LB = (float*)(ws + WS_LB);
    const int gt = (F.vcu * NWAVES + wave_v) * 64 + lane_v, NGT = NGW * 64;
    for (int i = gt; i < 2049 * 64; i += NGT) {
        const int pi = i >> 6, j = i & 63; const double pos = pi == SEQ ? 16384.0 : (double)pi;
        const double ang = pos * pow(10000.0, -(double)j / 64.0);
        CS[2 * i] = (float)cos(ang); CS[2 * i + 1] = (float)sin(ang);
    }
    for (int i = gt; i < DM; i += NGT) { const float a0 = a.in[10][i], a1 = a.in[10][DM + i]; LB[i] = 1.0f / (1.0f + expf(a1 - a0)); }
}

typedef float f32x16 __attribute__((ext_vector_type(16)));
typedef short v4i16_t __attribute__((ext_vector_type(4)));
typedef unsigned u32x2 __attribute__((ext_vector_type(2)));
typedef float f32x2_t __attribute__((ext_vector_type(2))); typedef __bf16 bf16x2_t __attribute__((ext_vector_type(2)));
__device__ __forceinline__ unsigned cvtpk_s(float lo, float hi) { f32x2_t v = {lo, hi}; bf16x2_t b = __builtin_convertvector(v, bf16x2_t); return __builtin_bit_cast(unsigned, b); }
__device__ __forceinline__ unsigned off_b(unsigned row, unsigned ch) { return 256u * row + 16u * (ch ^ (((row & 3) << 2) | ((row >> 2) & 3))); }
__device__ __forceinline__ bf16x8 rd_row(LAS unsigned char* img, unsigned row, unsigned ks, unsigned h) { return *(const LAS bf16x8*)(img + off_b(row, 2 * ks + h)); }
__device__ __forceinline__ bf16x8 rd_tr(LAS unsigned char* img, unsigned lane, unsigned c, unsigned ks) {
    const unsigned h = lane >> 5, blk = (lane >> 4) & 1, q = (lane & 15) >> 2, p = lane & 3;
    const unsigned a0 = off_b(16 * ks + 8 * h + q, 4 * c + 2 * blk + (p >> 1)) + 8 * (p & 1);
    const unsigned a1 = off_b(16 * ks + 8 * h + 4 + q, 4 * c + 2 * blk + (p >> 1)) + 8 * (p & 1);
    const v4i16_t lo = __builtin_amdgcn_ds_read_tr16_b64_v4i16((LAS v4i16_t*)(img + a0));
    const v4i16_t hi = __builtin_amdgcn_ds_read_tr16_b64_v4i16((LAS v4i16_t*)(img + a1));
    return __builtin_shufflevector(lo, hi, 0, 1, 2, 3, 4, 5, 6, 7);
}
#define MFMA32(a, b, c) __builtin_amdgcn_mfma_f32_32x32x16_bf16((a), (b), (c), 0, 0, 0)
__device__ __forceinline__ void scan_item(Frame& F, const Args& a, int item) { const int tid_v = tid_(); const int lane_v = tid_v & 63; const int wave_v = __builtin_amdgcn_readfirstlane(tid_v >> 6); (void)lane_v; (void)wave_v;
    unsigned char* ws = a.ws;
    const bool isg = item >= 128; const int it = isg ? item - 128 : item;
    int b, hd, dv0, ldq; const bf16 *Qp, *Kp; bf16* Vp; float* Sout; const float* GLp = nullptr; float sdec = 1.f;
    if (!isg) { b = it >> 4; hd = (it >> 2) & 3; dv0 = (it & 3) * 64; ldq = 512;
        Qp = (const bf16*)(ws + Z_QR) + hd * 128; Kp = (const bf16*)(ws + Z_KR) + hd * 128; Vp = (bf16*)(ws + Z_VR) + hd * 256 + dv0;
        Sout = a.out + OFF_RETP + ((size_t)(b * HR + hd) * DKR) * DVR + dv0; sdec = __expf(64.0f * __logf(1.0f - exp2f(-5.0f - (float)hd))); }
    else { b = it >> 4; hd = (it >> 1) & 7; dv0 = (it & 1) * 64; ldq = 1024;
        Qp = (const bf16*)(ws + Z_QG) + hd * 128; Kp = (const bf16*)(ws + Z_KG) + hd * 128; Vp = (bf16*)(ws + Z_VG) + hd * 128 + dv0;
        Sout = a.out + OFF_HGP + ((size_t)(b * HG + hd) * DKG) * DVG + dv0; GLp = (const float*)(ws + WS_GL) + hd * 128; }
    const int ldo = isg ? DVG : DVR;
    LAS unsigned char* QI = F.lds; LAS unsigned char* KI = QI + 16384; LAS unsigned char* VI = KI + 16384; LAS unsigned char* PI = VI + 16384; LAS unsigned char* SI = PI + 16384;
    LAS unsigned char* OI = SI + 16384;
    const int tid = tid_v, lane = lane_v, w = wave_v; const unsigned r = lane & 31, h = lane >> 5;
    const int kb = w >> 1, dvb = w & 1;
    for (int i = tid; i < 16384 / 4; i += 512) ((LAS unsigned*)SI)[i] = 0u;
    f32x16 S;
#pragma unroll
    for (int i = 0; i < 16; ++i) S[i] = 0.f;
    const int qr0 = tid >> 4, qc0 = tid & 15, vr0 = tid >> 3, vc0 = tid & 7;
    const size_t rowb = (size_t)b * SEQ;
    v4u pq0, pq1, pk0, pk1, pv; f32x4 gn0, gn1, gn2, gn3;
    const float* glb = isg ? GLp + (size_t)b * (SEQ / CH) * DM + 32 * kb + 4 * h : nullptr;
#define SCAN_LOAD(c) do { const size_t r0_ = rowb + (size_t)(c) * CH; \
        pq0 = *(const v4u*)(Qp + (r0_ + qr0) * ldq + qc0 * 8); pq1 = *(const v4u*)(Qp + (r0_ + qr0 + 32) * ldq + qc0 * 8); \
        pk0 = *(const v4u*)(Kp + (r0_ + qr0) * ldq + qc0 * 8); pk1 = *(const v4u*)(Kp + (r0_ + qr0 + 32) * ldq + qc0 * 8); \
        pv = *(const v4u*)(Vp + (r0_ + vr0) * DM + vc0 * 8); \
        if (isg) { const float* g_ = glb + (size_t)(c) * DM; gn0 = *(const f32x4*)g_; gn1 = *(const f32x4*)(g_ + 8); gn2 = *(const f32x4*)(g_ + 16); gn3 = *(const f32x4*)(g_ + 24); } } while (0)
    gn0 = gn1 = gn2 = gn3 = (f32x4){sdec, sdec, sdec, sdec};
    SCAN_LOAD(0);
    const unsigned oi_off = (unsigned)(vr0 * 128 + 16 * (vc0 ^ (vr0 & 7)));
    for (int c = 0; c < SEQ / CH; ++c) {
        LBAR();
        if (c > 0) *(v4u*)(Vp + (rowb + (size_t)(c - 1) * CH + vr0) * DM + vc0 * 8) = *(const LAS v4u*)(OI + oi_off);
        *(LAS v4u*)(QI + off_b(qr0, qc0)) = pq0; *(LAS v4u*)(QI + off_b(qr0 + 32, qc0)) = pq1;
        *(LAS v4u*)(KI + off_b(qr0, qc0)) = pk0; *(LAS v4u*)(KI + off_b(qr0 + 32, qc0)) = pk1;
        *(LAS v4u*)(VI + off_b(vr0, vc0)) = pv;
        const f32x4 g0 = gn0, g1 = gn1, g2 = gn2, g3 = gn3;
        if (c > 0) {
#pragma unroll
            for (int g = 0; g < 4; ++g) { u32x2 wv; wv.x = cvtpk_s(S[4 * g], S[4 * g + 1]); wv.y = cvtpk_s(S[4 * g + 2], S[4 * g + 3]);
                *(LAS u32x2*)(SI + off_b(32 * dvb + r, 4 * kb + g) + 8 * h) = wv; }
        }
        if (c + 1 < SEQ / CH) SCAN_LOAD(c + 1);
        LBAR();
        {
            bf16x8 A[4], B[4];
#pragma unroll
            for (int ks = 0; ks < 4; ++ks) { A[ks] = rd_tr(KI, lane, kb, ks); B[ks] = rd_tr(VI, lane, dvb, ks); }
            __builtin_amdgcn_sched_barrier(0);
            f32x16 d;
#pragma unroll
            for (int i = 0; i < 16; ++i) d[i] = 0.f;
#pragma unroll
            for (int ks = 0; ks < 4; ++ks) d = MFMA32(A[ks], B[ks], d);
#pragma unroll
            for (int i = 0; i < 4; ++i) { S[i] = g0[i] * (S[i] + d[i]); S[4 + i] = g1[i] * (S[4 + i] + d[4 + i]); S[8 + i] = g2[i] * (S[8 + i] + d[8 + i]); S[12 + i] = g3[i] * (S[12 + i] + d[12 + i]); }
        }
        if (w < 3) {
            const int sb = w >> 1, tb = (w + 1) >> 1;
            bf16x8 A[8], B[8];
#pragma unroll
            for (int ks = 0; ks < 8; ++ks) { A[ks] = rd_row(KI, 32 * sb + r, ks, h); B[ks] = rd_row(QI, 32 * tb + r, ks, h); }
            __builtin_amdgcn_sched_barrier(0);
            f32x16 p;
#pragma unroll
            for (int i = 0; i < 16; ++i) p[i] = 0.f;
#pragma unroll
            for (int ks = 0; ks < 8; ++ks) p = MFMA32(A[ks], B[ks], p);
#pragma unroll
            for (int g = 0; g < 4; ++g) {
                float v[4];
#pragma unroll
                for (int i = 0; i < 4; ++i) { const int sl = 8 * g + 4 * (int)h + i; v[i] = (sb != tb || sl <= (int)r) ? p[4 * g + i] : 0.f; }
                u32x2 wv; wv.x = cvtpk_s(v[0], v[1]); wv.y = cvtpk_s(v[2], v[3]);
                *(LAS u32x2*)(PI + off_b(32 * tb + r, 4 * sb + g) + 8 * h) = wv;
            }
        }
        LBAR();
        if (w < 4) {
            const int ob = w >> 1, tb = w & 1;
            f32x16 o;
#pragma unroll
            for (int i = 0; i < 16; ++i) o[i] = 0.f;
            {   bf16x8 A[4], B[4];
#pragma unroll
                for (int ks = 0; ks < 4; ++ks) { A[ks] = rd_tr(VI, lane, ob, ks); B[ks] = rd_row(PI, 32 * tb + r, ks, h); }
                __builtin_amdgcn_sched_barrier(0);
#pragma unroll
                for (int ks = 0; ks < 4; ++ks) if (ks < 2 || tb == 1) o = MFMA32(A[ks], B[ks], o); }
            {   bf16x8 A[8], B[8];
#pragma unroll
                for (int ks = 0; ks < 8; ++ks) { A[ks] = rd_row(SI, 32 * ob + r, ks, h); B[ks] = rd_row(QI, 32 * tb + r, ks, h); }
                __builtin_amdgcn_sched_barrier(0);
#pragma unroll
                for (int ks = 0; ks < 8; ++ks) o = MFMA32(A[ks], B[ks], o); }
#pragma unroll
            for (int g = 0; g < 4; ++g) { u32x2 wv; wv.x = cvtpk_s(o[4 * g], o[4 * g + 1]); wv.y = cvtpk_s(o[4 * g + 2], o[4 * g + 3]);
                const unsigned t_ = 32 * tb + r, ch_ = 4 * ob + g; *(LAS u32x2*)(OI + t_ * 128 + 16 * (ch_ ^ (t_ & 7)) + 8 * h) = wv; }
        }
    }
#undef SCAN_LOAD
    LBAR();
    *(v4u*)(Vp + (rowb + (size_t)(SEQ / CH - 1) * CH + vr0) * DM + vc0 * 8) = *(const LAS v4u*)(OI + oi_off);
#pragma unroll
    for (int i = 0; i < 16; ++i) { const int k = 32 * kb + (i & 3) + 8 * (i >> 2) + 4 * (int)h; Sout[(size_t)k * ldo + 32 * dvb + r] = S[i]; }
    __syncthreads();
}

__device__ __forceinline__ void decode_ret(Frame& F, const Args& a, int item) { const int tid_v = tid_(); const int lane_v = tid_v & 63; const int wave_v = __builtin_amdgcn_readfirstlane(tid_v >> 6); (void)lane_v; (void)wave_v;
    unsigned char* ws = a.ws; const int n = item >> 2, h = item & 3, row = MPROMPT + n;
    LAS float* qs = (LAS float*)(F.lds); LAS float* ks = qs + 128; LAS float* red = ks + 128;
    LAS float* part = red + 8 * 256;
    const int tid = tid_v, lane = lane_v, w = wave_v;
    if (tid < 128) qs[tid] = bf2f_(((const bf16*)(ws + Z_QR))[(size_t)row * 512 + h * 128 + tid]);
    else if (tid < 256) ks[tid - 128] = bf2f_(((const bf16*)(ws + Z_KR))[(size_t)row * 512 + h * 128 + tid - 128]);
    const unsigned long long vw = *(const unsigned long long*)((const bf16*)(ws + Z_VR) + (size_t)row * DM + h * 256 + 4 * lane);
    const f32x4 v = (f32x4){bflo_((unsigned)vw), bfhi_((unsigned)vw), bflo_((unsigned)(vw >> 32)), bfhi_((unsigned)(vw >> 32))};
    const float gam = 1.0f - exp2f(-5.0f - (float)h);
    LBAR();
    const float* S0 = a.in[2] + ((size_t)(n * HR + h) * DKR) * DVR; float* S1 = a.out + OFF_RETS + ((size_t)(n * HR + h) * DKR) * DVR;
    f32x4 o = (f32x4){0.f, 0.f, 0.f, 0.f};
    f32x4 s[16];
#pragma unroll
    for (int i = 0; i < 16; ++i) s[i] = *(const f32x4*)(S0 + (size_t)(w + 8 * i) * DVR + 4 * lane);
#pragma unroll
    for (int i = 0; i < 16; ++i) { const int k = w + 8 * i; const f32x4 sn = s[i] * gam + v * ks[k]; *(f32x4*)(S1 + (size_t)k * DVR + 4 * lane) = sn; o += sn * qs[k]; }
    *(LAS f32x4*)(red + w * 256 + 4 * lane) = o;
    LBAR();
    float ov = 0.f;
    if (tid < 256) {
#pragma unroll
        for (int i = 0; i < 8; ++i) ov += red[i * 256 + tid];
        const float ss = wave_sum(ov * ov); if (lane == 0) part[w] = ss;
    }
    LBAR();
    if (tid < 256) {
        const float rstd = rsqrtf(((part[0] + part[1]) + (part[2] + part[3])) * (1.0f / DVR) + EPS);
        bf16* gp = (bf16*)(ws + WS_GR) + (size_t)row * DM + h * 256 + tid;
        *gp = (bf16)f2bf(ov * rstd * a.in[8][h * 256 + tid] * bf2f_(*gp));
    }
    LBAR();
}
__device__ __forceinline__ void decode_hg(Frame& F, const Args& a, int item) { const int tid_v = tid_(); const int lane_v = tid_v & 63; const int wave_v = __builtin_amdgcn_readfirstlane(tid_v >> 6); (void)lane_v; (void)wave_v;
    unsigned char* ws = a.ws; const int n = item >> 3, h = item & 7, row = MPROMPT + n;
    LAS float* qs = (LAS float*)(F.lds); LAS float* ks = qs + 128; LAS float* fs = ks + 128; LAS float* red = fs + 128;
    LAS float* part = red + 16 * 128;
    const int tid = tid_v, lane = lane_v, w = wave_v, l32 = lane & 31, half = lane >> 5;
    if (tid < 128) qs[tid] = bf2f_(((const bf16*)(ws + Z_QG))[(size_t)row * DM + h * 128 + tid]);
    else if (tid < 256) ks[tid - 128] = bf2f_(((const bf16*)(ws + Z_KG))[(size_t)row * DM + h * 128 + tid - 128]);
    else if (tid < 384) fs[tid - 256] = ((const float*)(ws + WS_FS))[(size_t)n * DM + h * 128 + tid - 256];
    const unsigned long long vw = *(const unsigned long long*)((const bf16*)(ws + Z_VG) + (size_t)row * DM + h * 128 + 4 * l32);
    const f32x4 v = (f32x4){bflo_((unsigned)vw), bfhi_((unsigned)vw), bflo_((unsigned)(vw >> 32)), bfhi_((unsigned)(vw >> 32))};
    LBAR();
    const float* S0 = a.in[3] + ((size_t)(n * HG + h) * DKG) * DVG; float* S1 = a.out + OFF_HGS + ((size_t)(n * HG + h) * DKG) * DVG;
    f32x4 o = (f32x4){0.f, 0.f, 0.f, 0.f};
    f32x4 s[8];
#pragma unroll
    for (int i = 0; i < 8; ++i) s[i] = *(const f32x4*)(S0 + (size_t)(2 * (w + 8 * i) + half) * DVG + 4 * l32);
#pragma unroll
    for (int i = 0; i < 8; ++i) { const int k = 2 * (w + 8 * i) + half; const f32x4 sn = s[i] * fs[k] + v * ks[k]; *(f32x4*)(S1 + (size_t)k * DVG + 4 * l32) = sn; o += sn * qs[k]; }
    *(LAS f32x4*)(red + (2 * w + half) * 128 + 4 * l32) = o;
    LBAR();
    float ov = 0.f;
    if (tid < 128) {
#pragma unroll
        for (int i = 0; i < 16; ++i) ov += red[i * 128 + tid];
        const float ss = wave_sum(ov * ov); if (lane == 0) part[w] = ss;
    }
    LBAR();
    if (tid < 128) {
        const float rstd = rsqrtf((part[0] + part[1]) * (1.0f / DVG) + EPS);
        bf16* gp = (bf16*)(ws + WS_GG) + (size_t)row * DM + h * 128 + tid;
        *gp = (bf16)f2bf(ov * rstd * a.in[9][h * 128 + tid] * bf2f_(*gp));
    }
    LBAR();
}

__device__ __forceinline__ void p3_headnorm(Frame& F, const Args& a) { const int tid_v = tid_(); const int lane_v = tid_v & 63; const int wave_v = __builtin_amdgcn_readfirstlane(tid_v >> 6); (void)lane_v; (void)wave_v;
    unsigned char* ws = a.ws; const int gw = F.vcu * NWAVES + wave_v, NGW = F.G * NWAVES, lane = lane_v;
    for (int it = gw; it < MPROMPT * 8; it += NGW) {
        const bool isg = it >= MPROMPT * 4; const int i2 = isg ? it - MPROMPT * 4 : it; const int row = i2 >> 2, q = i2 & 3;
        const size_t off = (size_t)row * DM + q * 256 + 4 * lane;
        const unsigned long long ow = *(const unsigned long long*)((const bf16*)(ws + (isg ? Z_VG : Z_VR)) + off);
        unsigned long long* gp = (unsigned long long*)((bf16*)(ws + (isg ? WS_GG : WS_GR)) + off); const unsigned long long gwd = *gp;
        const f32x4 gn = *(const f32x4*)(a.in[isg ? 9 : 8] + q * 256 + 4 * lane);
        const f32x4 o = (f32x4){bflo_((unsigned)ow), bfhi_((unsigned)ow), bflo_((unsigned)(ow >> 32)), bfhi_((unsigned)(ow >> 32))};
        const f32x4 gt = (f32x4){bflo_((unsigned)gwd), bfhi_((unsigned)gwd), bflo_((unsigned)(gwd >> 32)), bfhi_((unsigned)(gwd >> 32))};
        float ss = (o.x * o.x + o.y * o.y) + (o.z * o.z + o.w * o.w);
#pragma unroll
        for (int d = 1; d < 32; d <<= 1) ss += __shfl_xor(ss, d);
        if (!isg) ss += __shfl_xor(ss, 32);
        const float rstd = rsqrtf(ss * (isg ? 1.0f / DVG : 1.0f / DVR) + EPS);
        const f32x4 x = o * rstd * gn * gt;
        *gp = (unsigned long long)pk2(x.x, x.y) | ((unsigned long long)pk2(x.z, x.w) << 32);
    }
}

__device__ __forceinline__ void p9_final(Frame& F, const Args& a) { const int tid_v = tid_(); const int lane_v = tid_v & 63; const int wave_v = __builtin_amdgcn_readfirstlane(tid_v >> 6); (void)lane_v; (void)wave_v;
    const int gw = F.vcu * NWAVES + wave_v, NGW = F.G * NWAVES, lane = lane_v; const float* PS3 = (const float*)(a.ws + WS_PS3); const float* gf = a.in[20];
    for (int m = gw; m < MTOT; m += NGW) {
        const float pv = m < MPROMPT ? (lane < 16 ? PS3[(size_t)m * 16 + lane] : 0.f) : ((const float*)(a.ws + WS_PSS3))[(size_t)(m - MPROMPT) * 64 + lane];
        const float rstd = rsqrtf(wave_sum(pv) * (1.0f / DM) + EPS);
        f32x4* r = (f32x4*)(a.out + (size_t)m * DM) + lane;
#pragma unroll
        for (int j = 0; j < 4; ++j) { const f32x4 gv = *((const f32x4*)gf + 64 * j + lane); r[64 * j] = r[64 * j] * rstd * gv; }
    }
}

template <int K, class FE> __device__ __forceinline__ void skinny_gemm(Frame& F, const bf16* As, const bf16* Wt, int N, const FE& fe) { const int tid_v = tid_(); const int lane_v = tid_v & 63; const int wave_v = __builtin_amdgcn_readfirstlane(tid_v >> 6); (void)lane_v; (void)wave_v;
    constexpr int KW = K / 4, NKS = KW / 32, CH_KS = NKS < 8 ? NKS : 8, NCH = NKS / CH_KS;
    const int lane = lane_v, fr = lane & 15, fq = lane >> 4, rg = wave_v >> 2, ks = wave_v & 3;
    LAS f32x4* red = (LAS f32x4*)(F.lds);
    const int ntile = 4 * (N / 16);
    for (int tile = F.vcu; tile < ntile; tile += F.G) {
        const int rb = tile & 3, cb = tile >> 2;
        const bf16* ap = Wt + (size_t)(16 * cb + fr) * K + ks * KW + 8 * fq;
        const bf16* bp = As + (size_t)(32 * rb + 16 * rg + fr) * K + ks * KW + 8 * fq;
        f32x4 acc = (f32x4){0.f, 0.f, 0.f, 0.f};
#pragma unroll 1
        for (int c = 0; c < NCH; ++c) {
            bf16x8 a[CH_KS], b[CH_KS];
#pragma unroll
            for (int i = 0; i < CH_KS; ++i) { a[i] = *(const bf16x8*)(ap + (c * CH_KS + i) * 32); b[i] = *(const bf16x8*)(bp + (c * CH_KS + i) * 32); }
#pragma unroll
            for (int i = 0; i < CH_KS; ++i) acc = __builtin_amdgcn_mfma_f32_16x16x32_bf16(a[i], b[i], acc, 0, 0, 0);
        }
        red[wave_v * 64 + lane] = acc;
        __syncthreads();
        if (ks == 0) {
            const f32x4 v = (red[(4 * rg + 0) * 64 + lane] + red[(4 * rg + 1) * 64 + lane]) + (red[(4 * rg + 2) * 64 + lane] + red[(4 * rg + 3) * 64 + lane]);
            fe(MPROMPT + 32 * rb + 16 * rg + fr, 16 * cb + 4 * fq, v);
        }
        __syncthreads();
    }
}
struct FeIn { pg8::EpiIn E; __device__ __forceinline__ void operator()(int row, int col, f32x4 v) const { pg8::samp_in(E, row, col, v); } };
template <int MODE> struct FeN { pg8::EpiN<MODE> E; const float* xs; float* PSS; const float* PSSin;
    __device__ __forceinline__ void operator()(int row, int col, f32x4 v) const { pg8::samp_n<MODE>(E, xs, PSS, PSSin, row, col, v); } };

__global__ void __launch_bounds__(NWAVES * 64, 2) fwd_kernel(Args args) {
#define tid_v ((int)threadIdx.x)
    extern __shared__ __attribute__((aligned(16))) unsigned char lds[];
    Frame F;
    F.lds = (LAS unsigned char*)lds;
    F.MISC = (volatile LAS unsigned*)(F.lds + MISC_OFF);
        F.G = gridDim.x; { const int bx = blockIdx.x; F.vcu = (F.G % 8 == 0) ? (bx % 8) * (F.G / 8) + bx / 8 : bx; }
    unsigned char* ws = args.ws;
    F.ctl = (gu32*)(ws + WS_CTL);
    for (int u = tid_v; u < (LDS_BYTES - LDSCTL_OFF) / 4; u += NWAVES * 64) ((LAS unsigned*)(F.lds + LDSCTL_OFF))[u] = 0u;
    __syncthreads();
    XcdBarrier bar; bar.bar = (unsigned*)(F.ctl + CW_BAR); bar.x = 0; bar.st = nullptr;
    if (args.use_bar) bar = xcd_barrier_post((unsigned*)(F.ctl + CW_BAR), F.MISC + 8);
    const int lo = args.ph_lo, hi = args.ph_hi;
#define IN(k) (lo <= (k) && (k) < hi)
#if PROBE_ON
    volatile LAS unsigned* PW = F.MISC + 16;
    if (tid_v == 0) { PW[0] = (unsigned)rt(); PW[1] = 0u; }
#define STAMP(k) do { if (blockIdx.x == 0 && tid_v == 0) { const unsigned t_ = (unsigned)rt(); unsigned q_ = (t_ - PW[0] + (unsigned)PROBE_UNIT / 2) / (unsigned)PROBE_UNIT; if (q_ > 49u) q_ = 49u; \
        if ((k) == PROBE_A) PW[1] += q_ * 400u; else if ((k) == PROBE_B) PW[1] += q_ * 20000u; else if ((k) == PROBE_C) PW[1] += q_ * 1000000u; PW[0] = t_; } } while (0)
#else
#define STAMP(k) do { } while (0)
#endif
#define SEAM(k) do { if (IN(k) && IN((k) + 1)) xcd_barrier(bar); STAMP(k); } while (0)
    using namespace pg8;
    bf16_t* XB = (bf16_t*)(args.out + OFF_RETS);
    bf16_t* AR = (bf16_t*)(args.out + OFF_Y); bf16_t* AH = AR + (size_t)MTOT * DM;
    float* R = args.out + OFF_Y;
    float* PS1 = (float*)(ws + WS_PS1); float* PS2 = (float*)(ws + WS_PS2); float* PS3 = (float*)(ws + WS_PS3);

    if (IN(0)) { p0_prologue(F, args); SEAM(0); }
    const bf16_t* SROW = nullptr; (void)SROW;
    float* PSS1 = (float*)(ws + WS_PSS1); float* PSS2 = (float*)(ws + WS_PSS2); float* PSS3 = (float*)(ws + WS_PSS3);
#define SAMP(buf, ld) ((const bf16*)(buf) + (size_t)MPROMPT * (ld))
    if (IN(1)) {
        Gemm g{XB, (const bf16_t*)(ws + WS_WIN), MPROMPT, DIN, DM}; StaticOrder S; S.init(MPROMPT, DIN, F.G, (int)blockIdx.x);
        EpiIn E{(const float*)(ws + WS_RSTD0), (const float*)(ws + WS_CS), (const float*)(ws + WS_LB),
                (bf16_t*)(ws + Z_QR), (bf16_t*)(ws + Z_KR), (bf16_t*)(ws + Z_VR), (bf16_t*)(ws + WS_GR), (bf16_t*)(ws + Z_QG), (bf16_t*)(ws + Z_KG), (bf16_t*)(ws + Z_VG), (bf16_t*)(ws + WS_GG),
                AR, AH, (float*)(ws + WS_GL), (float*)(ws + WS_FS)};
        gemm_phase<EpiIn, StaticOrder, true, true>(F.lds + RING_OFF, g, S, E);
        { FeIn fe{E}; skinny_gemm<DM>(F, SAMP(XB, DM), (const bf16*)(ws + WS_WIN), DIN, fe); }
        SEAM(1);
    }
    if (IN(2)) {
        const bool dec_first = (F.vcu & 1) != 0;
        if (dec_first) {
            for (int it = F.vcu; it < NDEC * HR; it += F.G) decode_ret(F, args, it);
            for (int it = F.vcu; it < NDEC * HG; it += F.G) decode_hg(F, args, it);
        }
        for (int it = F.vcu; it < 256; it += F.G) scan_item(F, args, it);
#if PROBE_ON
        xcd_barrier(bar); STAMP(10);
#endif
        if (!dec_first) {
            for (int it = F.vcu; it < NDEC * HR; it += F.G) decode_ret(F, args, it);
            for (int it = F.vcu; it < NDEC * HG; it += F.G) decode_hg(F, args, it);
        }
        SEAM(2);
    }
    if (IN(3)) { p3_headnorm(F, args); SEAM(3); }
    if (IN(4)) {
        { Gemm g{(const bf16_t*)(ws + WS_GG), (const bf16_t*)(ws + WS_WUPH), MPROMPT, DM, DM}; StaticOrder S; S.init(MPROMPT, DM, F.G, (int)blockIdx.x);
          EpiN<0> E{AH, (bf16_t*)(ws + WS_MB), DM, nullptr, nullptr, nullptr, nullptr, nullptr, nullptr};
          gemm_phase<EpiN<0>, StaticOrder, true, true>(F.lds + RING_OFF, g, S, E);
          FeN<0> fe{E, nullptr, nullptr, nullptr}; skinny_gemm<DM>(F, SAMP(ws + WS_GG, DM), (const bf16*)(ws + WS_WUPH), DM, fe); }
        { Gemm g{(const bf16_t*)(ws + WS_GR), (const bf16_t*)(ws + WS_WUPR), MPROMPT, DM, DM}; StaticOrder S; S.init(MPROMPT, DM, F.G, (int)blockIdx.x);
          EpiN<1> E{AR, (bf16_t*)(ws + WS_MB), DM, nullptr, nullptr, nullptr, nullptr, nullptr, nullptr};
          gemm_phase<EpiN<1>, StaticOrder, true, true>(F.lds + RING_OFF, g, S, E);
          FeN<1> fe{E, nullptr, nullptr, nullptr}; skinny_gemm<DM>(F, SAMP(ws + WS_GR, DM), (const bf16*)(ws + WS_WUPR), DM, fe); }
        SEAM(4);
    }
    if (IN(5)) {
        Gemm g{(const bf16_t*)(ws + WS_MB), (const bf16_t*)(ws + WS_WO), MPROMPT, DM, DM}; StaticOrder S; S.init(MPROMPT, DM, F.G, (int)blockIdx.x);
        EpiN<2> E{nullptr, (bf16_t*)(ws + WS_A5), DM, args.in[0], nullptr, R, args.in[14], PS1, nullptr};
        gemm_phase<EpiN<2>, StaticOrder, true, true>(F.lds + RING_OFF, g, S, E);
        FeN<2> fe{E, args.in[1], PSS1, nullptr}; skinny_gemm<DM>(F, SAMP(ws + WS_MB, DM), (const bf16*)(ws + WS_WO), DM, fe);
        SEAM(5);
    }
    if (IN(6)) {
        Gemm g{(const bf16_t*)(ws + WS_A5), (const bf16_t*)(ws + WS_WFF1), MPROMPT, DFF, DM}; StaticOrder S; S.init(MPROMPT, DFF, F.G, (int)blockIdx.x);
        EpiN<3> E{nullptr, (bf16_t*)(ws + WS_H), DFF, nullptr, nullptr, nullptr, nullptr, nullptr, PS1};
        gemm_phase<EpiN<3>, StaticOrder, true, true>(F.lds + RING_OFF, g, S, E);
        FeN<3> fe{E, nullptr, nullptr, PSS1}; skinny_gemm<DM>(F, SAMP(ws + WS_A5, DM), (const bf16*)(ws + WS_WFF1), DFF, fe);
        SEAM(6);
    }
    if (IN(7)) {
        Gemm g{(const bf16_t*)(ws + WS_H), (const bf16_t*)(ws + WS_WFF2), MPROMPT, DM, DFF}; StaticOrder S; S.init(MPROMPT, DM, F.G, (int)blockIdx.x);
        EpiN<2> E{nullptr, (bf16_t*)(ws + WS_A7), DM, R, nullptr, R, args.in[17], PS2, nullptr};
        gemm_phase<EpiN<2>, StaticOrder, true, true>(F.lds + RING_OFF, g, S, E);
        FeN<2> fe{E, nullptr, PSS2, nullptr}; skinny_gemm<DFF>(F, SAMP(ws + WS_H, DFF), (const bf16*)(ws + WS_WFF2), DM, fe);
        SEAM(7);
    }
    if (IN(8)) {
        { Gemm g{(const bf16_t*)(ws + WS_A7), (const bf16_t*)(ws + WS_WGATE), MPROMPT, DM, DM}; StaticOrder S; S.init(MPROMPT, DM, F.G, (int)blockIdx.x);
          EpiN<4> E{nullptr, (bf16_t*)(ws + WS_MB), DM, nullptr, nullptr, nullptr, nullptr, nullptr, PS2};
          gemm_phase<EpiN<4>, StaticOrder, true, true>(F.lds + RING_OFF, g, S, E);
          FeN<4> fe{E, nullptr, nullptr, PSS2}; skinny_gemm<DM>(F, SAMP(ws + WS_A7, DM), (const bf16*)(ws + WS_WGATE), DM, fe); }
        { Gemm g{(const bf16_t*)(ws + WS_PB), (const bf16_t*)(ws + WS_WPROJ), MPROMPT, DM, DPLE}; StaticOrder S; S.init(MPROMPT, DM, F.G, (int)blockIdx.x);
          EpiN<5> E{nullptr, (bf16_t*)(ws + WS_MB), DM, nullptr, nullptr, R, nullptr, PS3, nullptr};
          gemm_phase<EpiN<5>, StaticOrder, true, true>(F.lds + RING_OFF, g, S, E);
          FeN<5> fe{E, nullptr, PSS3, nullptr}; skinny_gemm<DPLE>(F, SAMP(ws + WS_PB, DPLE), (const bf16*)(ws + WS_WPROJ), DM, fe); }
        SEAM(8);
    }
    if (IN(9)) { p9_final(F, args); }
#if PROBE_ON
    STAMP(9);
    if (blockIdx.x == 0 && tid_v == 0) { const unsigned t0_ = (unsigned)rt(); const unsigned dly_ = PW[1]; while ((unsigned)rt() - t0_ < dly_) __builtin_amdgcn_s_sleep(16); }
#endif
#undef IN
#undef SEAM
#undef tid_v
}

extern "C" void kernel_launch(void* const* d_in, const int* in_sizes, int n_in, void* d_out, int out_size, void* d_ws, size_t ws_size, hipStream_t stream) {
    static int grid = 0;
    if (grid == 0) {
        if (n_in != 21 || out_size != (int)OUT_TOTAL || ws_size < WS_END) { fprintf(stderr, "kernel_launch: unexpected problem (n_in %d out %d ws %zu need %zu)\n", n_in, out_size, ws_size, (size_t)WS_END); grid = -1; return; }
        int dev = 0, cus = 0;
        if (hipGetDevice(&dev) != hipSuccess || hipDeviceGetAttribute(&cus, hipDeviceAttributeMultiprocessorCount, dev) != hipSuccess) { grid = -1; return; }
        if (hipFuncSetAttribute((const void*)fwd_kernel, hipFuncAttributeMaxDynamicSharedMemorySize, LDS_BYTES) != hipSuccess) { fprintf(stderr, "kernel_launch: hipFuncSetAttribute failed\n"); grid = -1; return; }
        (void)hipGetLastError();
        grid = cus;
    }
    if (grid < 0) return;
    (void)hipMemsetAsync((char*)d_ws + WS_CTL, 0, CTL_ZERO_BYTES, stream);
    Args a{};
    for (int i = 0; i < 21; ++i) a.in[i] = (const float*)d_in[i];
    a.out = (float*)d_out; a.ws = (unsigned char*)d_ws;
#if MK_ONE_LAUNCH
    a.ph_lo = 0; a.ph_hi = NPH; a.use_bar = 1;
    hipLaunchKernelGGL(fwd_kernel, dim3(grid), dim3(NWAVES * 64), LDS_BYTES, stream, a);
#else
    for (int p = 0; p < NPH; ++p) { a.ph_lo = p; a.ph_hi = p + 1; a.use_bar = 0; hipLaunchKernelGGL(fwd_kernel, dim3(grid), dim3(NWAVES * 64), LDS_BYTES, stream, a); }
#endif
}
```

```cpp
#include <hip/hip_runtime.h>
#include <cstdio>
#include <cstdint>
#ifndef PROBE_ON
#define PROBE_ON 0
#endif
#define PROBE_UNIT 800ull
#ifndef PROBE_A
#define PROBE_A 0
#define PROBE_B 1
#define PROBE_C 2
#endif
#ifndef PROBE_E
#define PROBE_E -1
#endif
#ifndef PROBE_SKINNY
#define PROBE_SKINNY 0
#endif
namespace pg8 {
#define PG8_LAS __attribute__((address_space(3)))
typedef unsigned short bf16_t;
typedef short bf16x8 __attribute__((ext_vector_type(8)));
typedef float f32x4 __attribute__((ext_vector_type(4)));
typedef unsigned u32x4 __attribute__((ext_vector_type(4)));
constexpr int BM = 256, BK = 64, HALF = 128, HTB = HALF * BK * 2  , STAGE_BYTES = 8 * HTB, NXCD = 8, WGM = 8;

__host__ __device__ __forceinline__ int lds_byte(int r, int c) { const int st = (r >> 4) * 2 + (c >> 5), rr = r & 15, cc = c & 31, ob = rr * 64 + cc * 2; return st * 1024 + (ob ^ (((ob >> 9) & 1) << 5)); }
__host__ __device__ __forceinline__ void stage_rc(int b, int& R, int& C) { const int st = b / 1024, sb = b % 1024, swz = sb ^ (((sb >> 9) & 1) << 5); R = (st >> 1) * 16 + swz / 64; C = (st & 1) * 32 + (swz % 64) / 2; }
__host__ __device__ __forceinline__ int perm32(int rho) { const int n = rho >> 4, i = rho & 15; return 8 * (i >> 2) + 4 * n + (i & 3); }

struct Unit { int pm, pn; };
struct Gemm { const bf16_t* A; const bf16_t* Bt; int M, N, K; };

struct StaticOrder {
    int nM, nN, nwg, G, c;
    __host__ __device__ void init(int M, int N, int G_, int c_) { nM = M / BM; nN = N / BM; nwg = nM * nN; G = G_; c = c_; }
    __host__ __device__ bool next(int i, Unit& u) const {
        const long L = (long)i * G + c; if (L >= nwg) return false;
        int wgid = (int)L; { const int q = nwg / NXCD, r = nwg % NXCD, xcd = wgid % NXCD, off = wgid / NXCD; wgid = (xcd < r ? xcd * (q + 1) : r * (q + 1) + (xcd - r) * q) + off; }
        const int nig = WGM * nN, gid = wgid / nig, fm = gid * WGM, gsz = (nM - fm) < WGM ? (nM - fm) : WGM;
        u.pm = fm + ((wgid % nig) % gsz); u.pn = (wgid % nig) / gsz; return true;
    }
    __device__ __forceinline__ void a_ready(const Unit&) const {}
    __device__ __forceinline__ void done(const Unit&) const {}
};

__device__ __forceinline__ unsigned cvt_pk_bf16(float lo, float hi) { unsigned r; asm volatile("v_cvt_pk_bf16_f32 %0, %1, %2" : "=v"(r) : "v"(lo), "v"(hi)); return r; }

template <class Epi, class Sched, bool ALIGN_EPI = false, bool SP2 = false>
__device__ __forceinline__ void gemm_phase(PG8_LAS unsigned char* lds, const Gemm g, const Sched& S, const Epi& E) {
    const int tid = threadIdx.x, wid = __builtin_amdgcn_readfirstlane(tid >> 6), lane = tid & 63, wr = wid >> 2, wc = wid & 3, fr = lane & 15, fq = lane >> 4;
    const int K = g.K, nt = K / BK;
    unsigned voffA[2], voffB[2];
#pragma unroll
    for (int i = 0; i < 2; ++i) { int R, C; stage_rc(tid * 16 + i * 8192, R, C); const int Rb = Epi::PERM ? ((R & ~31) + perm32(R & 31)) : R;
        voffA[i] = (unsigned)(R * K + C) * 2u; voffB[i] = (unsigned)(Rb * K + C) * 2u; }
    const size_t kstep = (size_t)(BK * 2);
    const size_t hstep = (size_t)HALF * K * 2;
    const size_t tstep = 2 * hstep;
    const unsigned ldsw = (unsigned)wid * 1024u;
    const int aoff = lds_byte(wr * 64 + fr, fq * 8), boff = lds_byte(wc * 32 + fr, fq * 8);
#define PG8_SA(b, h) (((b) * 2 + (h)) * HTB)
#define PG8_SB(b, h) ((4 + (b) * 2 + (h)) * HTB)
#define PG8_STAGE(bufoff, gbase, voff) do { _Pragma("unroll") for (int _i = 0; _i < 2; ++_i) \
        __builtin_amdgcn_global_load_lds((const unsigned*)((const char*)(gbase) + (voff)[_i]), (PG8_LAS unsigned*)(lds + (bufoff) + ldsw + _i * 8192), 16, 0, 0); } while (0)
#define PG8_LDA(dst, b, h) do { _Pragma("unroll") for (int m = 0; m < 4; ++m) _Pragma("unroll") for (int k = 0; k < 2; ++k) dst[m][k] = *(const PG8_LAS bf16x8*)(lds + PG8_SA(b, h) + aoff + m * 2048 + k * 1024); } while (0)
#define PG8_LDB(dst, b, h) do { _Pragma("unroll") for (int n = 0; n < 2; ++n) _Pragma("unroll") for (int k = 0; k < 2; ++k) dst[n][k] = *(const PG8_LAS bf16x8*)(lds + PG8_SB(b, h) + boff + n * 2048 + k * 1024); } while (0)
#define PG8_MMA(ai, bj, At, Bt) do { __builtin_amdgcn_s_setprio(1); _Pragma("unroll") for (int m = 0; m < 4; ++m) _Pragma("unroll") for (int n = 0; n < 2; ++n) _Pragma("unroll") for (int k = 0; k < 2; ++k) \
        acc[ai][bj][m][n] = __builtin_amdgcn_mfma_f32_16x16x32_bf16(Bt[n][k], At[m][k], acc[ai][bj][m][n], 0, 0, 0); __builtin_amdgcn_s_setprio(0); } while (0)
#define PG8_WAIT_V(n) asm volatile("s_waitcnt vmcnt(" #n ")" ::: "memory")
#define PG8_WAIT_L(n) asm volatile("s_waitcnt lgkmcnt(" #n ")" ::: "memory")
#define PG8_BAR __builtin_amdgcn_s_barrier()
#define PG8_SCHED __builtin_amdgcn_sched_barrier(0)
    Unit cur, nxt; int ui = 0;
    if (!S.next(0, cur)) return;
    f32x4 acc[2][2][4][2];
#pragma unroll
    for (int a = 0; a < 2; ++a)
#pragma unroll
        for (int b = 0; b < 2; ++b)
#pragma unroll
            for (int m = 0; m < 4; ++m)
#pragma unroll
                for (int n = 0; n < 2; ++n) acc[a][b][m][n] = (f32x4){0.f, 0.f, 0.f, 0.f};
    bf16x8 At[4][2], B0[2][2], B1[2][2];
    const char* cA = (const char*)g.A + (size_t)cur.pm * tstep; const char* cB = (const char*)g.Bt + (size_t)cur.pn * tstep;
    S.a_ready(cur);
    if constexpr (SP2) {
        PG8_STAGE(PG8_SB(0, 0), cB, voffB); PG8_STAGE(PG8_SB(0, 1), cB + hstep, voffB); PG8_STAGE(PG8_SA(0, 0), cA, voffA); PG8_STAGE(PG8_SA(0, 1), cA + hstep, voffA);
        if (wr == 1) PG8_BAR;
        PG8_WAIT_V(2); PG8_BAR;
        PG8_STAGE(PG8_SB(1, 0), cB + kstep, voffB); PG8_STAGE(PG8_SA(1, 0), cA + kstep, voffA); PG8_STAGE(PG8_SB(1, 1), cB + hstep + kstep, voffB);
        PG8_WAIT_V(6); PG8_BAR;
    } else {
        PG8_STAGE(PG8_SB(0, 0), cB, voffB); PG8_STAGE(PG8_SA(0, 0), cA, voffA); PG8_STAGE(PG8_SB(0, 1), cB + hstep, voffB); PG8_STAGE(PG8_SA(0, 1), cA + hstep, voffA);
        if (wr == 1) PG8_BAR;
        PG8_WAIT_V(4); PG8_BAR;
        PG8_STAGE(PG8_SB(1, 0), cB + kstep, voffB); PG8_STAGE(PG8_SA(1, 0), cA + kstep, voffA); PG8_STAGE(PG8_SB(1, 1), cB + hstep + kstep, voffB);
        PG8_WAIT_V(6); PG8_BAR;
    }
    for (;;) {
        const bool has_next = S.next(ui + 1, nxt);
        const char* nA = has_next ? (const char*)g.A + (size_t)nxt.pm * tstep : cA; const char* nB = has_next ? (const char*)g.Bt + (size_t)nxt.pn * tstep : cB;
        for (int t = 0; t < nt; t += 2) {
            const bool last = (t == nt - 2);
            const char* a1 = cA + (size_t)(t + 1) * kstep;
            const char* a2 = last ? nA : cA + (size_t)(t + 2) * kstep; const char* b2 = last ? nB : cB + (size_t)(t + 2) * kstep;
            const char* a3 = a2 + kstep; const char* b3 = b2 + kstep;
            if (last && has_next) S.a_ready(nxt);
            if constexpr (SP2) {
            PG8_LDB(B0, 0, 0); PG8_LDB(B1, 0, 1); PG8_SCHED; PG8_LDA(At, 0, 0); PG8_STAGE(PG8_SA(1, 1), a1 + hstep, voffA);
            PG8_WAIT_V(8); PG8_WAIT_L(0); PG8_BAR; PG8_MMA(0, 0, At, B0); PG8_MMA(0, 1, At, B1); PG8_BAR; PG8_SCHED;
            PG8_LDA(At, 0, 1); PG8_STAGE(PG8_SB(0, 0), b2, voffB); PG8_STAGE(PG8_SB(0, 1), b2 + hstep, voffB); PG8_STAGE(PG8_SA(0, 0), a2, voffA);
            PG8_WAIT_V(8); PG8_WAIT_L(0); PG8_BAR; PG8_MMA(1, 0, At, B0); PG8_MMA(1, 1, At, B1); PG8_BAR; PG8_SCHED;
            PG8_LDB(B0, 1, 0); PG8_LDB(B1, 1, 1); PG8_SCHED; PG8_LDA(At, 1, 0); PG8_STAGE(PG8_SA(0, 1), a2 + hstep, voffA);
            PG8_WAIT_V(8); PG8_WAIT_L(0); PG8_BAR; PG8_MMA(0, 0, At, B0); PG8_MMA(0, 1, At, B1); PG8_BAR; PG8_SCHED;
            PG8_LDA(At, 1, 1); PG8_STAGE(PG8_SB(1, 0), b3, voffB); PG8_STAGE(PG8_SB(1, 1), b3 + hstep, voffB); PG8_STAGE(PG8_SA(1, 0), a3, voffA);
            PG8_WAIT_V(8); PG8_WAIT_L(0); PG8_BAR; PG8_MMA(1, 0, At, B0); PG8_MMA(1, 1, At, B1); PG8_BAR; PG8_SCHED;
            } else {
            PG8_LDB(B0, 0, 0); PG8_SCHED; PG8_LDA(At, 0, 0); PG8_STAGE(PG8_SA(1, 1), a1 + hstep, voffA);
            PG8_WAIT_L(8); PG8_BAR; PG8_WAIT_L(0); PG8_MMA(0, 0, At, B0); PG8_BAR; PG8_SCHED;
            PG8_LDB(B1, 0, 1); PG8_STAGE(PG8_SB(0, 0), b2, voffB);
            PG8_BAR; PG8_WAIT_L(0); PG8_MMA(0, 1, At, B1); PG8_BAR;
            PG8_LDA(At, 0, 1); PG8_STAGE(PG8_SA(0, 0), a2, voffA);
            PG8_BAR; PG8_WAIT_L(0); PG8_MMA(1, 0, At, B0); PG8_BAR; PG8_SCHED;
            PG8_STAGE(PG8_SB(0, 1), b2 + hstep, voffB);
            PG8_WAIT_V(6); PG8_BAR; PG8_MMA(1, 1, At, B1); PG8_BAR;
            PG8_LDB(B0, 1, 0); PG8_SCHED; PG8_LDA(At, 1, 0); PG8_STAGE(PG8_SA(0, 1), a2 + hstep, voffA);
            PG8_WAIT_L(8); PG8_BAR; PG8_WAIT_L(0); PG8_MMA(0, 0, At, B0); PG8_BAR; PG8_SCHED;
            PG8_LDB(B1, 1, 1); PG8_STAGE(PG8_SB(1, 0), b3, voffB);
            PG8_BAR; PG8_WAIT_L(0); PG8_MMA(0, 1, At, B1); PG8_BAR;
            PG8_LDA(At, 1, 1); PG8_STAGE(PG8_SA(1, 0), a3, voffA);
            PG8_BAR; PG8_WAIT_L(0); PG8_MMA(1, 0, At, B0); PG8_BAR; PG8_SCHED;
            PG8_STAGE(PG8_SB(1, 1), b3 + hstep, voffB);
            PG8_WAIT_V(6); PG8_BAR; PG8_MMA(1, 1, At, B1); PG8_BAR;
            }
        }
        if constexpr (ALIGN_EPI) { if (wr == 0) PG8_BAR; }
#if PROBE_ON && !PROBE_SKINNY
        const unsigned pe0_ = (unsigned)__builtin_amdgcn_s_memrealtime();
#endif
        if constexpr (!Epi::AFTER_DRAIN) { E(acc, cur, wr, wc, fr, fq); S.done(cur); }
#if PROBE_ON && !PROBE_SKINNY
        if (threadIdx.x == 0) { *(volatile PG8_LAS unsigned*)(lds + 131072 + 320 + 4 * 18) += (unsigned)__builtin_amdgcn_s_memrealtime() - pe0_; }
#endif
        if (!has_next) break;
#pragma unroll
        for (int a = 0; a < 2; ++a)
#pragma unroll
            for (int b = 0; b < 2; ++b)
#pragma unroll
                for (int m = 0; m < 4; ++m)
#pragma unroll
                    for (int n = 0; n < 2; ++n) acc[a][b][m][n] = (f32x4){0.f, 0.f, 0.f, 0.f};
        cur = nxt; cA = nA; cB = nB; ++ui;
        if constexpr (ALIGN_EPI) { if (wr == 1) PG8_BAR; }
    }
    PG8_WAIT_V(0);
    if constexpr (!ALIGN_EPI) { if (wr == 0) PG8_BAR; }
    PG8_BAR;
    if constexpr (Epi::AFTER_DRAIN) { E.fused(acc, cur, wr, wc, fr, fq, lds, wid, lane); S.done(cur); }
#undef PG8_SA
#undef PG8_SB
#undef PG8_STAGE
#undef PG8_LDA
#undef PG8_LDB
#undef PG8_MMA
#undef PG8_WAIT_V
#undef PG8_WAIT_L
#undef PG8_BAR
#undef PG8_SCHED
}
}


constexpr int DM = 1024, NB = 8, SEQ = 2048, NDEC = 128, MPROMPT = NB * SEQ, MTOT = MPROMPT + NDEC, MP = 16640  ;
constexpr int HR = 4, DKR = 128, DVR = 256, HG = 8, DKG = 128, DVG = 128, DFF = 4096, DPLE = 256, DIN = 9216, CH = 64, NCHUNK = MPROMPT / CH;
constexpr float EPS = 1e-6f;
constexpr size_t OFF_Y = 0, OFF_RETP = (size_t)MTOT * DM, OFF_HGP = OFF_RETP + (size_t)NB * HR * DKR * DVR, OFF_RETS = OFF_HGP + (size_t)NB * HG * DKG * DVG,
                 OFF_HGS = OFF_RETS + (size_t)NDEC * HR * DKR * DVR, OUT_TOTAL = OFF_HGS + (size_t)NDEC * HG * DKG * DVG;
static_assert(OUT_TOTAL == 52559872, "output size");

namespace pg8 {
typedef unsigned u32x2 __attribute__((ext_vector_type(2)));
typedef float f32x2 __attribute__((ext_vector_type(2)));
__device__ __forceinline__ float bf2f(unsigned short b) { return __uint_as_float((unsigned)b << 16); }
__device__ __forceinline__ float bflo(unsigned w) { return __uint_as_float(w << 16); }
__device__ __forceinline__ float bfhi(unsigned w) { return __uint_as_float(w & 0xffff0000u); }
__device__ __forceinline__ float sigmoidf_(float x) { return 1.0f / (1.0f + __expf(-x)); }
__device__ __forceinline__ float siluf_(float x) { return x / (1.0f + __expf(-x)); }
__device__ __forceinline__ u32x2 pack4(f32x4 v) { u32x2 w; w.x = cvt_pk_bf16(v[0], v[1]); w.y = cvt_pk_bf16(v[2], v[3]); return w; }
__device__ __forceinline__ f32x4 unpack4(u32x2 w) { return (f32x4){bflo(w.x), bfhi(w.x), bflo(w.y), bfhi(w.y)}; }

typedef unsigned u32x4 __attribute__((ext_vector_type(4)));
#define DPP_ROW_SHR(x, n) __int_as_float(__builtin_amdgcn_update_dpp(0, __float_as_int(x), 0x110 + (n), 0xf, 0xf, true))
#define DPP_ROW_BCAST15(x) __int_as_float(__builtin_amdgcn_update_dpp(0, __float_as_int(x), 0x15F, 0xf, 0xf, false))
struct EpiIn {
    static constexpr bool PERM = true, AFTER_DRAIN = false;
    const float* rstd0; const float* cs; const float* lb;
    bf16_t *QR, *KR, *VR, *GR, *QG, *KG, *VG, *GG, *AR, *AH; float *GL, *FS;
    __device__ __forceinline__ void operator()(const f32x4 (&acc)[2][2][4][2], const Unit& u, int wr, int wc, int fr, int fq) const {
        const int pn = u.pn;
#pragma unroll
        for (int ai = 0; ai < 2; ++ai) {
            const int rbase = u.pm * BM + ai * HALF + wr * 64;
            float rs[4];
#pragma unroll
            for (int m = 0; m < 4; ++m) rs[m] = rstd0[rbase + m * 16 + fr];
            if (pn < 4) {
                const bool isk = pn >= 2; bf16_t* dst = isk ? KR : QR;
#pragma unroll
                for (int bj = 0; bj < 2; ++bj) {
                    const int head = 2 * (pn & 1) + bj;
                    const float lg = __logf(1.0f - exp2f(-5.0f - (float)head));
                    const int j0 = 16 * wc + 4 * fq;
#pragma unroll
                    for (int m = 0; m < 4; ++m) {
                        const int row = rbase + m * 16 + fr; const int pidx = row & (SEQ - 1);
                        const float e = lg * (float)(m * 16 + fr + 1);
                        const float sc = rs[m] * (isk ? 0.08838834764831845f * __expf(-e) : __expf(e));
                        const f32x4 t0 = *(const f32x4*)(cs + ((size_t)pidx * 64 + j0) * 2), t1 = *(const f32x4*)(cs + ((size_t)pidx * 64 + j0 + 2) * 2);
                        const f32x4 v0 = acc[ai][bj][m][0] * sc, v1 = acc[ai][bj][m][1] * sc;
                        u32x2 o1, o2;
                        o1.x = cvt_pk_bf16(v0[0] * t0[0] - v0[1] * t0[1], v0[2] * t0[2] - v0[3] * t0[3]); o1.y = cvt_pk_bf16(v1[0] * t1[0] - v1[1] * t1[1], v1[2] * t1[2] - v1[3] * t1[3]);
                        o2.x = cvt_pk_bf16(v0[0] * t0[1] + v0[1] * t0[0], v0[2] * t0[3] + v0[3] * t0[2]); o2.y = cvt_pk_bf16(v1[0] * t1[1] + v1[1] * t1[0], v1[2] * t1[3] + v1[3] * t1[2]);
                        bf16_t* p = dst + (size_t)row * 512 + head * 128 + j0;
                        *(u32x2*)p = o1; *(u32x2*)(p + 64) = o2;
                    }
                }
            } else if (pn >= 12 && pn < 20) {
                const int head = pn - 12;
#pragma unroll
                for (int bj = 0; bj < 2; ++bj) {
                    const int j0 = 64 * bj + 16 * wc + 4 * fq, c = head * 128 + j0;
                    const f32x4 lbv = *(const f32x4*)(lb + c);
                    float qa[4][4], ka[4][4], ba[4][4];
#pragma unroll
                    for (int q = 0; q < 4; ++q) {
                        const int n = q >> 1, e = q & 1; const float one_m_lb = 1.0f - lbv[q]; float carry = 0.f;
#pragma unroll
                        for (int m = 0; m < 4; ++m) {
                            const float vq = acc[ai][bj][m][n][2 * e] * rs[m], vf = acc[ai][bj][m][n][2 * e + 1] * rs[m];
                            const float kk = one_m_lb / (1.0f + __expf(vf));
                            float x = __logf(1.0f - kk);
                            x += DPP_ROW_SHR(x, 1); x += DPP_ROW_SHR(x, 2); x += DPP_ROW_SHR(x, 4); x += DPP_ROW_SHR(x, 8);
                            x += carry; carry = DPP_ROW_BCAST15(x);
                            qa[m][q] = siluf_(vq); ka[m][q] = kk; ba[m][q] = x;
                        }
                    }
#pragma unroll
                    for (int m = 0; m < 4; ++m) {
                        const int row = rbase + m * 16 + fr;
                        const float e0 = __expf(ba[m][0]), e1 = __expf(ba[m][1]), e2 = __expf(ba[m][2]), e3 = __expf(ba[m][3]);
                        u32x2 qw, kw;
                        qw.x = cvt_pk_bf16(qa[m][0] * e0, qa[m][1] * e1); qw.y = cvt_pk_bf16(qa[m][2] * e2, qa[m][3] * e3);
                        kw.x = cvt_pk_bf16(ka[m][0] * __expf(-ba[m][0]), ka[m][1] * __expf(-ba[m][1])); kw.y = cvt_pk_bf16(ka[m][2] * __expf(-ba[m][2]), ka[m][3] * __expf(-ba[m][3]));
                        *(u32x2*)(QG + (size_t)row * DM + c) = qw; *(u32x2*)(KG + (size_t)row * DM + c) = kw;
                        if (m == 3 && fr == 15) *(f32x4*)(GL + (size_t)(row >> 6) * DM + c) = (f32x4){e0, e1, e2, e3};
                    }
                }
            } else {
                int mode, cbase; bf16_t* dst;
                if (pn < 8) { dst = VR; cbase = (pn - 4) * BM; mode = 0; } else if (pn < 12) { dst = GR; cbase = (pn - 8) * BM; mode = 1; }
                else if (pn < 24) { dst = VG; cbase = (pn - 20) * BM; mode = 0; } else if (pn < 28) { dst = GG; cbase = (pn - 24) * BM; mode = 1; }
                else if (pn < 32) { dst = AR; cbase = (pn - 28) * BM; mode = 2; } else { dst = AH; cbase = (pn - 32) * BM; mode = 2; }
#pragma unroll
                for (int m = 0; m < 4; ++m) {
                    const int row = rbase + m * 16 + fr;
#pragma unroll
                    for (int bj = 0; bj < 2; ++bj) {
                        f32x4 v0 = acc[ai][bj][m][0] * rs[m], v1 = acc[ai][bj][m][1] * rs[m];
                        if (mode == 1) { v0[0] = siluf_(v0[0]); v0[1] = siluf_(v0[1]); v0[2] = siluf_(v0[2]); v0[3] = siluf_(v0[3]); v1[0] = siluf_(v1[0]); v1[1] = siluf_(v1[1]); v1[2] = siluf_(v1[2]); v1[3] = siluf_(v1[3]); }
                        else if (mode == 2) { v0[0] = sigmoidf_(v0[0]); v0[1] = sigmoidf_(v0[1]); v0[2] = sigmoidf_(v0[2]); v0[3] = sigmoidf_(v0[3]); v1[0] = sigmoidf_(v1[0]); v1[1] = sigmoidf_(v1[1]); v1[2] = sigmoidf_(v1[2]); v1[3] = sigmoidf_(v1[3]); }
                        const u32x2 a = pack4(v0), b = pack4(v1);
                        *(u32x4*)(dst + (size_t)row * DM + cbase + bj * HALF + wc * 32 + fq * 8) = (u32x4){a.x, a.y, b.x, b.y};
                    }
                }
            }
        }
    }
};

__device__ __forceinline__ void unpack8(u32x4 w, f32x4& a, f32x4& b) { a = (f32x4){bflo(w.x), bfhi(w.x), bflo(w.y), bfhi(w.y)}; b = (f32x4){bflo(w.z), bfhi(w.z), bflo(w.w), bfhi(w.w)}; }
__device__ __forceinline__ u32x4 pack8(f32x4 a, f32x4 b) { const u32x2 x = pack4(a), y = pack4(b); return (u32x4){x.x, x.y, y.x, y.y}; }
__device__ __forceinline__ float sumsq4(f32x4 r) { return (r[0] * r[0] + r[1] * r[1]) + (r[2] * r[2] + r[3] * r[3]); }
template <int MODE> struct EpiN {
    static constexpr bool PERM = true, AFTER_DRAIN = false;
    const bf16_t* gate; bf16_t* out16; int ld16; const float* xp; const float* xs; float* R; const float* g; float* PS; const float* PSin;
    __device__ __forceinline__ void operator()(const f32x4 (&acc)[2][2][4][2], const Unit& u, int wr, int wc, int fr, int fq) const {
#pragma unroll
        for (int ai = 0; ai < 2; ++ai) {
            const int rbase = u.pm * BM + ai * HALF + wr * 64;
#pragma unroll
            for (int m = 0; m < 4; ++m) {
                const int row = rbase + m * 16 + fr;
                float rstd = 1.f;
                if (MODE == 3 || MODE == 4) {
                    const f32x4* p = (const f32x4*)(PSin + (size_t)row * 16); const f32x4 a = p[0], b = p[1], c = p[2], d = p[3];
                    const float s = ((a[0] + a[1]) + (a[2] + a[3])) + ((b[0] + b[1]) + (b[2] + b[3])) + ((c[0] + c[1]) + (c[2] + c[3])) + ((d[0] + d[1]) + (d[2] + d[3]));
                    rstd = rsqrtf(s * (1.0f / 1024.0f) + EPS);
                }
                float ss = 0.f;
#pragma unroll
                for (int bj = 0; bj < 2; ++bj) {
                    const int col = u.pn * BM + bj * HALF + wc * 32 + fq * 8;
                    const f32x4 a0 = acc[ai][bj][m][0], a1 = acc[ai][bj][m][1];
                    if (MODE == 0) { f32x4 g0, g1; unpack8(*(const u32x4*)(gate + (size_t)row * DM + col), g0, g1); *(u32x4*)(out16 + (size_t)row * ld16 + col) = pack8(g0 * a0, g1 * a1); }
                    else if (MODE == 1) { f32x4 g0, g1, t0, t1; unpack8(*(const u32x4*)(gate + (size_t)row * DM + col), g0, g1); u32x4* o = (u32x4*)(out16 + (size_t)row * ld16 + col); unpack8(*o, t0, t1); *o = pack8(t0 + g0 * a0, t1 + g1 * a1); }
                    else if (MODE == 2) {
                        const float* bp = xp + (size_t)row * DM + col;
                        const f32x4 r0 = *(const f32x4*)bp + a0, r1 = *(const f32x4*)(bp + 4) + a1; float* rp = R + (size_t)row * DM + col; *(f32x4*)rp = r0; *(f32x4*)(rp + 4) = r1;
                        ss += sumsq4(r0) + sumsq4(r1);
                        *(u32x4*)(out16 + (size_t)row * ld16 + col) = pack8(r0 * *(const f32x4*)(g + col), r1 * *(const f32x4*)(g + col + 4));
                    }
                    else if (MODE == 3) { f32x4 v0 = a0 * rstd, v1 = a1 * rstd;
                        v0[0] = fmaxf(v0[0], 0.f); v0[1] = fmaxf(v0[1], 0.f); v0[2] = fmaxf(v0[2], 0.f); v0[3] = fmaxf(v0[3], 0.f); v1[0] = fmaxf(v1[0], 0.f); v1[1] = fmaxf(v1[1], 0.f); v1[2] = fmaxf(v1[2], 0.f); v1[3] = fmaxf(v1[3], 0.f);
                        *(u32x4*)(out16 + (size_t)row * ld16 + col) = pack8(v0 * v0, v1 * v1); }
                    else if (MODE == 4) { f32x4 v0 = a0 * rstd, v1 = a1 * rstd;
                        v0[0] = sigmoidf_(v0[0]); v0[1] = sigmoidf_(v0[1]); v0[2] = sigmoidf_(v0[2]); v0[3] = sigmoidf_(v0[3]); v1[0] = sigmoidf_(v1[0]); v1[1] = sigmoidf_(v1[1]); v1[2] = sigmoidf_(v1[2]); v1[3] = sigmoidf_(v1[3]);
                        *(u32x4*)(out16 + (size_t)row * ld16 + col) = pack8(v0, v1); }
                    else if (MODE == 5) { f32x4 t0, t1; unpack8(*(const u32x4*)(out16 + (size_t)row * ld16 + col), t0, t1); float* rp = R + (size_t)row * DM + col;
                        const f32x4 r0 = *(const f32x4*)rp + t0 * a0, r1 = *(const f32x4*)(rp + 4) + t1 * a1; *(f32x4*)rp = r0; *(f32x4*)(rp + 4) = r1; ss += sumsq4(r0) + sumsq4(r1); }
                }
                if (MODE == 2 || MODE == 5) { ss += __shfl_xor(ss, 16); ss += __shfl_xor(ss, 32); if (fq == 0) PS[(size_t)row * 16 + u.pn * 4 + wc] = ss; }
            }
        }
    }
};

__device__ __forceinline__ void samp_in(const EpiIn& E, int row, int pcol, f32x4 v) {
    const float rs = E.rstd0[row]; const int pn = __builtin_amdgcn_readfirstlane(pcol >> 8), p = pcol & 255;
    if (pn < 4) {
        const bool isk = pn >= 2; bf16_t* dst = isk ? E.KR : E.QR; const int head = 2 * (pn & 1) + (p >> 7), j = (p & 127) >> 1;
        const f32x4 t = *(const f32x4*)(E.cs + ((size_t)SEQ * 64 + j) * 2);
        v = v * (rs * (isk ? 0.08838834764831845f : 1.0f));
        const float o1a = v[0] * t[0] - v[1] * t[1], o2a = v[0] * t[1] + v[1] * t[0], o1b = v[2] * t[2] - v[3] * t[3], o2b = v[2] * t[3] + v[3] * t[2];
        bf16_t* q = dst + (size_t)row * 512 + head * 128 + j;
        *(unsigned*)q = cvt_pk_bf16(o1a, o1b); *(unsigned*)(q + 64) = cvt_pk_bf16(o2a, o2b);
    } else if (pn >= 12 && pn < 20) {
        const int c = (pn - 12) * 128 + (p >> 1);
        const float k0 = (1.0f - E.lb[c]) / (1.0f + __expf(v[1] * rs)), k1 = (1.0f - E.lb[c + 1]) / (1.0f + __expf(v[3] * rs));
        *(unsigned*)(E.QG + (size_t)row * DM + c) = cvt_pk_bf16(siluf_(v[0] * rs), siluf_(v[2] * rs));
        *(unsigned*)(E.KG + (size_t)row * DM + c) = cvt_pk_bf16(k0, k1);
        *(f32x2*)(E.FS + (size_t)(row - MPROMPT) * DM + c) = (f32x2){1.0f - k0, 1.0f - k1};
    } else {
        v = v * rs;
        const bool sl = (pn >= 8 && pn < 12) || (pn >= 24 && pn < 28), sg = pn >= 28;
        if (sl) { v[0] = siluf_(v[0]); v[1] = siluf_(v[1]); v[2] = siluf_(v[2]); v[3] = siluf_(v[3]); }
        else if (sg) { v[0] = sigmoidf_(v[0]); v[1] = sigmoidf_(v[1]); v[2] = sigmoidf_(v[2]); v[3] = sigmoidf_(v[3]); }
        const u32x2 w = pack4(v); const size_t ro = (size_t)row * DM + p;
        if (pn < 8) *(u32x2*)(E.VR + ro + (pn - 4) * BM) = w;
        else if (pn < 12) *(u32x2*)(E.GR + ro + (pn - 8) * BM) = w;
        else if (pn < 24) *(u32x2*)(E.VG + ro + (pn - 20) * BM) = w;
        else if (pn < 28) *(u32x2*)(E.GG + ro + (pn - 24) * BM) = w;
        else if (pn < 32) *(u32x2*)(E.AR + ro + (pn - 28) * BM) = w;
        else *(u32x2*)(E.AH + ro + (pn - 32) * BM) = w;
    }
}
template <int MODE> __device__ __forceinline__ void samp_n(const EpiN<MODE>& E, const float* xs, float* PSS, const float* PSSin, int row, int col, f32x4 a) {
    const int rs_ = row - MPROMPT; float rstd = 1.f;
    if (MODE == 3 || MODE == 4) { const f32x4* p = (const f32x4*)(PSSin + (size_t)rs_ * 64); float s = 0.f;
#pragma unroll
        for (int i = 0; i < 16; ++i) { const f32x4 q = p[i]; s += (q[0] + q[1]) + (q[2] + q[3]); }
        rstd = rsqrtf(s * (1.0f / 1024.0f) + EPS); }
    float ss = 0.f;
    if (MODE == 0) { const f32x4 gt = unpack4(*(const u32x2*)(E.gate + (size_t)row * DM + col)); *(u32x2*)(E.out16 + (size_t)row * E.ld16 + col) = pack4(gt * a); }
    else if (MODE == 1) { const f32x4 gt = unpack4(*(const u32x2*)(E.gate + (size_t)row * DM + col)); u32x2* o = (u32x2*)(E.out16 + (size_t)row * E.ld16 + col); const f32x4 t = unpack4(*o); *o = pack4(t + gt * a); }
    else if (MODE == 2) { const float* bp = xs ? xs + (size_t)rs_ * DM + col : E.R + (size_t)row * DM + col; const f32x4 r = *(const f32x4*)bp + a; *(f32x4*)(E.R + (size_t)row * DM + col) = r;
        ss = (r[0] * r[0] + r[1] * r[1]) + (r[2] * r[2] + r[3] * r[3]); *(u32x2*)(E.out16 + (size_t)row * E.ld16 + col) = pack4(r * *(const f32x4*)(E.g + col)); }
    else if (MODE == 3) { f32x4 v = a * rstd; v[0] = fmaxf(v[0], 0.f); v[1] = fmaxf(v[1], 0.f); v[2] = fmaxf(v[2], 0.f); v[3] = fmaxf(v[3], 0.f); *(u32x2*)(E.out16 + (size_t)row * E.ld16 + col) = pack4(v * v); }
    else if (MODE == 4) { f32x4 v = a * rstd; v[0] = sigmoidf_(v[0]); v[1] = sigmoidf_(v[1]); v[2] = sigmoidf_(v[2]); v[3] = sigmoidf_(v[3]); *(u32x2*)(E.out16 + (size_t)row * E.ld16 + col) = pack4(v); }
    else if (MODE == 5) { const f32x4 t = unpack4(*(const u32x2*)(E.out16 + (size_t)row * E.ld16 + col)); float* rp = E.R + (size_t)row * DM + col; const f32x4 r = *(const f32x4*)rp + t * a; *(f32x4*)rp = r;
        ss = (r[0] * r[0] + r[1] * r[1]) + (r[2] * r[2] + r[3] * r[3]); }
    if (MODE == 2 || MODE == 5) { ss += __shfl_xor(ss, 16); ss += __shfl_xor(ss, 32); if ((threadIdx.x & 63) < 16) PSS[(size_t)rs_ * 64 + (col >> 4)] = ss; }
}
}


constexpr int NWAVES = 8;
constexpr int NPH = 10;
#ifndef MK_ONE_LAUNCH
#define MK_ONE_LAUNCH 1
#endif

constexpr size_t MiB = 1u << 20;
constexpr size_t WS_CTL = 0, CTL_ZERO_BYTES = 1 * MiB;
constexpr size_t WS_WIN = 1 * MiB;
constexpr size_t WS_WUPR = WS_WIN + (size_t)DIN * DM * 2;
constexpr size_t WS_WUPH = WS_WUPR + (size_t)DM * DM * 2;
constexpr size_t WS_WO = WS_WUPH + (size_t)DM * DM * 2;
constexpr size_t WS_WFF1 = WS_WO + (size_t)DM * DM * 2;
constexpr size_t WS_WFF2 = WS_WFF1 + (size_t)DFF * DM * 2;
constexpr size_t WS_WGATE = WS_WFF2 + (size_t)DFF * DM * 2;
constexpr size_t WS_WPROJ = WS_WGATE + (size_t)DM * DM * 2;
constexpr size_t WS_Z6 = WS_WPROJ + (size_t)DM * DPLE * 2;
constexpr size_t Z_QR = WS_Z6, Z_KR = Z_QR + (size_t)MP * 512 * 2, Z_VR = Z_KR + (size_t)MP * 512 * 2, Z_QG = Z_VR + (size_t)MP * DM * 2, Z_KG = Z_QG + (size_t)MP * DM * 2,
                 Z_VG = Z_KG + (size_t)MP * DM * 2, Z_END = Z_VG + (size_t)MP * DM * 2;
constexpr size_t WS_H = WS_Z6, WS_MB = WS_Z6 + (size_t)MP * DFF * 2;
static_assert(WS_MB == Z_VG, "MB overlays VG exactly");
constexpr size_t WS_GR = Z_END, WS_GG = WS_GR + (size_t)MP * DM * 2, WS_A5 = WS_GR, WS_A7 = WS_GG;
constexpr size_t WS_PB = WS_GG + (size_t)MP * DM * 2;
constexpr size_t WS_CS = WS_PB + (size_t)MP * DPLE * 2;
constexpr size_t WS_GL = WS_CS + (size_t)2049 * 64 * 8;
constexpr size_t WS_FS = WS_GL + (size_t)NCHUNK * DM * 4;
constexpr size_t WS_RSTD0 = WS_FS + (size_t)NDEC * DM * 4;
constexpr size_t WS_LB = WS_RSTD0 + (size_t)MP * 4;
constexpr size_t WS_PS1 = WS_LB + 4096, WS_PS2 = WS_PS1 + (size_t)MP * 64, WS_PS3 = WS_PS2 + (size_t)MP * 64, WS_PSS1 = WS_PS3 + (size_t)MP * 64, WS_PSS2 = WS_PSS1 + (size_t)NDEC * 256, WS_PSS3 = WS_PSS2 + (size_t)NDEC * 256, WS_END = WS_PSS3 + (size_t)NDEC * 256;
static_assert(WS_END <= 307920896, "d_ws map must fit sum(inputs) bytes");
static_assert(WS_WIN % 256 == 0 && WS_Z6 % 256 == 0 && WS_GR % 256 == 0 && WS_PB % 256 == 0 && WS_CS % 16 == 0 && WS_GL % 16 == 0 && WS_PS1 % 16 == 0, "alignment");
constexpr int CW_TMO = 0, CW_BAR = 4096;

constexpr int RING_OFF = 0, RING_BYTES = 131072;
constexpr int LDSCTL_OFF = RING_BYTES, MISC_OFF = LDSCTL_OFF + 320;
constexpr int LDS_BYTES = 147456;

#define GAS __attribute__((address_space(1)))
#define LAS __attribute__((address_space(3)))
typedef unsigned short bf16;
typedef unsigned v4u __attribute__((ext_vector_type(4)));
typedef float f32x4 __attribute__((ext_vector_type(4)));
typedef short bf16x8 __attribute__((ext_vector_type(8)));
typedef GAS unsigned gu32;
typedef GAS unsigned long long gu64;
#define RLX_AGENT __ATOMIC_RELAXED, __HIP_MEMORY_SCOPE_AGENT
#define LDS_WAIT() asm volatile("s_waitcnt lgkmcnt(0)" ::: "memory")
#define VM_WAIT() asm volatile("s_waitcnt vmcnt(0)" ::: "memory")
__device__ __forceinline__ unsigned long long rt() { return __builtin_amdgcn_s_memrealtime(); }
__device__ __forceinline__ unsigned f2bf(float f) { unsigned u = __builtin_bit_cast(unsigned, f); return (u + 0x7fffu + ((u >> 16) & 1u)) >> 16; }
__device__ __forceinline__ unsigned pk2(float lo, float hi) { return f2bf(lo) | (f2bf(hi) << 16); }

#define XB_TMO      128
#define XB_XCNT(j)  (256  + 64 * (j))
#define XB_XSUB(j)  (1280 + 64 * (j))
#define XB_XGEN(j)  (2304 + 64 * (j))
#define XB_TOP      3328
#define XB_TOPGEN   3392
#define XCD_BAR_WORDS 3456
#define XB_SPIN_CAP (1u << 18)

__device__ __forceinline__ unsigned xb_ld(unsigned* p)              { return __hip_atomic_load(p, __ATOMIC_RELAXED, __HIP_MEMORY_SCOPE_AGENT); }
__device__ __forceinline__ unsigned xb_add(unsigned* p, unsigned v) { return __hip_atomic_fetch_add(p, v, __ATOMIC_RELAXED, __HIP_MEMORY_SCOPE_AGENT); }
__device__ __forceinline__ unsigned xb_xcc_id() { return (unsigned)__builtin_amdgcn_s_getreg((3 << 11) | 20) & 0xFu; }
#define XB_SPIN(cond, bar) do { unsigned _sp = 0; while (cond) { __builtin_amdgcn_s_sleep(1); \
    if ((++_sp & 255u) == 0u) { if (xb_ld(&(bar)[XB_TMO])) break; if (_sp > XB_SPIN_CAP) { atomicAdd(&(bar)[XB_TMO], 1u); break; } } } } while (0)

struct XcdBarrier {
    unsigned* bar; unsigned x;
    volatile LAS unsigned* st;
};

__device__ __forceinline__ XcdBarrier xcd_barrier_post(unsigned* bar, volatile LAS unsigned* st) {
    XcdBarrier b; b.bar = bar; b.x = xb_xcc_id(); b.st = st;
    if (threadIdx.x == 0) (void)xb_add(&bar[XB_XCNT(b.x)], 1u);
    return b;
}
__device__ __forceinline__ void xcd_barrier_complete(unsigned* bar, unsigned x, unsigned& nloc, unsigned& nx) {
    const unsigned G = gridDim.x * gridDim.y * gridDim.z;
    unsigned sum, cnt, mine, sp = 0u;
    for (;;) {
        sum = 0u; cnt = 0u; mine = 0u;
#pragma unroll
        for (unsigned j = 0; j < 16; ++j) { const unsigned c = xb_ld(&bar[XB_XCNT(j)]); sum += c; cnt += (c > 0u) ? 1u : 0u; mine = (j == x) ? c : mine; }
        if (sum == G) break;
        __builtin_amdgcn_s_sleep(1);
        if ((++sp & 255u) == 0u) { if (xb_ld(&bar[XB_TMO])) break; if (sp > XB_SPIN_CAP) { atomicAdd(&bar[XB_TMO], 1u); break; } }
    }
    nloc = mine > 0u ? mine : 1u; nx = cnt > 0u ? cnt : 1u;
}

__device__ __forceinline__ void xcd_barrier(const XcdBarrier& b) {
    asm volatile("s_waitcnt vmcnt(0)" ::: "memory");
    __syncthreads();
    if (threadIdx.x == 0) {
        unsigned* bar = b.bar;
        __builtin_amdgcn_s_waitcnt(0);
        unsigned nloc = b.st[0], nx = b.st[1];
        if (nloc == 0u) { xcd_barrier_complete(bar, b.x, nloc, nx); b.st[0] = nloc; b.st[1] = nx; }
        const unsigned old = xb_add(&bar[XB_XSUB(b.x)], 1u);
        const unsigned gen = old / nloc;
        if (old + 1u == (gen + 1u) * nloc) {
            __builtin_amdgcn_fence(__ATOMIC_RELEASE, "agent");
            asm volatile("s_waitcnt vmcnt(0)" ::: "memory");
            const unsigned og = xb_add(&bar[XB_TOP], 1u);
            const unsigned tg = og / nx;
            if (og + 1u == (tg + 1u) * nx) xb_add(&bar[XB_TOPGEN], 1u);
            else XB_SPIN(xb_ld(&bar[XB_TOPGEN]) == tg, bar);
            __builtin_amdgcn_fence(__ATOMIC_ACQUIRE, "agent");
            xb_add(&bar[XB_XGEN(b.x)], 1u);
            asm volatile("s_waitcnt vmcnt(0)" ::: "memory");
        } else {
            XB_SPIN(xb_ld(&bar[XB_XGEN(b.x)]) == gen, bar);
            __builtin_amdgcn_fence(__ATOMIC_ACQUIRE, "agent");
            asm volatile("s_waitcnt vmcnt(0)" ::: "memory");
        }
    }
    __syncthreads();
}


struct Args { const float* in[21]; float* out; unsigned char* ws; int ph_lo, ph_hi, use_bar, pad; };
struct Frame {
    LAS unsigned char* lds; volatile LAS unsigned* MISC; gu32* ctl;
    int vcu, G;
};
__device__ __forceinline__ int tid_() { int t = threadIdx.x; asm volatile("" : "+v"(t)); return t; }
#define FTID (tid_())
#define FLANE (tid_() & 63)
#define FWAVE (__builtin_amdgcn_readfirstlane(tid_() >> 6))
__device__ __forceinline__ float wave_sum(float v) {
#pragma unroll
    for (int o = 1; o < 64; o <<= 1) v += __shfl_xor(v, o);
    return v;
}
#define LBAR() do { asm volatile("s_waitcnt lgkmcnt(0)" ::: "memory"); __builtin_amdgcn_s_barrier(); asm volatile("" ::: "memory"); } while (0)
__device__ __forceinline__ float bf2f_(unsigned short b) { return __uint_as_float((unsigned)b << 16); }
__device__ __forceinline__ float bflo_(unsigned w) { return __uint_as_float(w << 16); }
__device__ __forceinline__ float bfhi_(unsigned w) { return __uint_as_float(w & 0xffff0000u); }

__device__ __forceinline__ int win_src_col(int np) {
    const int tile = np >> 8, p = np & 255;
    if (tile < 4) { const int base = (tile >> 1) * 512, head = 2 * (tile & 1) + (p >> 7), pp = p & 127; return base + head * 128 + (pp & 1) * 64 + (pp >> 1); }
    if (tile >= 12 && tile < 20) { const int h = tile - 12; return 3072 + (p & 1) * 1024 + h * 128 + (p >> 1); }
    return np;
}
template <bool MAP> __device__ __forceinline__ void p0_transpose_item(const float* W, int K, int N, bf16* WT, LAS float* scr, int item, int lane) {
    const int nblk = N / 32, kb = item / nblk, nb = item % nblk, k0 = 64 * kb, n0 = 32 * nb;
    const int srcc = MAP ? win_src_col(n0 + (lane & 31)) : n0 + (lane & 31);
#pragma unroll 8
    for (int i = 0; i < 32; ++i) { const int kk = 2 * i + (lane >> 5); scr[kk * 33 + (lane & 31)] = W[(size_t)(k0 + kk) * N + srcc]; }
    LDS_WAIT(); asm volatile("" ::: "memory");
    const int c = lane & 7;
#pragma unroll
    for (int j = 0; j < 4; ++j) { const int n = (lane >> 3) + 8 * j; const LAS float* s = scr + (8 * c) * 33 + n;
        v4u o; o.x = pk2(s[0 * 33], s[1 * 33]); o.y = pk2(s[2 * 33], s[3 * 33]); o.z = pk2(s[4 * 33], s[5 * 33]); o.w = pk2(s[6 * 33], s[7 * 33]);
        *(GAS v4u*)(WT + (size_t)(n0 + n) * K + k0 + 8 * c) = o; }
    LDS_WAIT(); asm volatile("" ::: "memory");
}
__device__ __forceinline__ void p0_prologue(Frame& F, const Args& a) { const int tid_v = tid_(); const int lane_v = tid_v & 63; const int wave_v = __builtin_amdgcn_readfirstlane(tid_v >> 6); (void)lane_v; (void)wave_v;
    unsigned char* ws = a.ws;
    LAS float* scr = (LAS float*)(F.lds + RING_OFF + wave_v * 16384);
    const int gw = F.vcu * NWAVES + wave_v, NGW = F.G * NWAVES;
    constexpr int I_IN = (DM / 64) * (DIN / 32), I_SQ = (DM / 64) * (DM / 32), I_F1 = (DM / 64) * (DFF / 32), I_F2 = (DFF / 64) * (DM / 32), I_PJ = (DPLE / 64) * (DM / 32);
    constexpr int NITEMS = I_IN + 4 * I_SQ + I_F1 + I_F2 + I_PJ;
    for (int it = gw; it < NITEMS; it += NGW) {
        int r = it;
        if (r < I_IN) { p0_transpose_item<true>(a.in[7], DM, DIN, (bf16*)(ws + WS_WIN), scr, r, lane_v); continue; } r -= I_IN;
        if (r < I_SQ) { p0_transpose_item<false>(a.in[11], DM, DM, (bf16*)(ws + WS_WUPR), scr, r, lane_v); continue; } r -= I_SQ;
        if (r < I_SQ) { p0_transpose_item<false>(a.in[12], DM, DM, (bf16*)(ws + WS_WUPH), scr, r, lane_v); continue; } r -= I_SQ;
        if (r < I_SQ) { p0_transpose_item<false>(a.in[13], DM, DM, (bf16*)(ws + WS_WO), scr, r, lane_v); continue; } r -= I_SQ;
        if (r < I_SQ) { p0_transpose_item<false>(a.in[18], DM, DM, (bf16*)(ws + WS_WGATE), scr, r, lane_v); continue; } r -= I_SQ;
        if (r < I_F1) { p0_transpose_item<false>(a.in[15], DM, DFF, (bf16*)(ws + WS_WFF1), scr, r, lane_v); continue; } r -= I_F1;
        if (r < I_F2) { p0_transpose_item<false>(a.in[16], DFF, DM, (bf16*)(ws + WS_WFF2), scr, r, lane_v); continue; } r -= I_F2;
        p0_transpose_item<false>(a.in[19], DPLE, DM, (bf16*)(ws + WS_WPROJ), scr, r, lane_v);
    }
    bf16* XB = (bf16*)(a.out + OFF_RETS); float* RSTD0 = (float*)(ws + WS_RSTD0); bf16* PB = (bf16*)(ws + WS_PB);
    const float* gmix = a.in[6];
    for (int m = gw; m < MP; m += NGW) {
        GAS unsigned long long* o8 = (GAS unsigned long long*)(XB + (size_t)m * DM) + lane_v;
        GAS unsigned long long* p8 = (GAS unsigned long long*)(PB + (size_t)m * DPLE) + lane_v;
        if (m >= MTOT) {
#pragma unroll
            for (int j = 0; j < 4; ++j) o8[64 * j] = 0ull;
            p8[0] = 0ull; if (lane_v == 0) RSTD0[m] = 0.f; continue;
        }
        const float* xrow = m < MPROMPT ? a.in[0] + (size_t)m * DM : a.in[1] + (size_t)(m - MPROMPT) * DM;
        const float* prow = m < MPROMPT ? a.in[4] + (size_t)m * DPLE : a.in[5] + (size_t)(m - MPROMPT) * DPLE;
        const GAS f32x4* xr = (const GAS f32x4*)xrow + lane_v;
        f32x4 v[4]; float s = 0.f;
#pragma unroll
        for (int j = 0; j < 4; ++j) { v[j] = xr[64 * j]; s += (v[j].x * v[j].x + v[j].y * v[j].y) + (v[j].z * v[j].z + v[j].w * v[j].w); }
        s = wave_sum(s);
        if (lane_v == 0) RSTD0[m] = rsqrtf(s * (1.0f / DM) + EPS);
#pragma unroll
        for (int j = 0; j < 4; ++j) { const f32x4 gv = *((const GAS f32x4*)gmix + 64 * j + lane_v);
            o8[64 * j] = (unsigned long long)pk2(v[j].x * gv.x, v[j].y * gv.y) | ((unsigned long long)pk2(v[j].z * gv.z, v[j].w * gv.w) << 32); }
        const f32x4 pv = *((const GAS f32x4*)prow + lane_v);
        p8[0] = (unsigned long long)pk2(pv.x, pv.y) | ((unsigned long long)pk2(pv.z, pv.w) << 32);
    }
    float* CS = (float*)(ws + WS_CS); float* LB = (float*)(ws + WS_LB);
    const int gt = (F.vcu * NWAVES + wave_v) * 64 + lane_v, NGT = NGW * 64;
    for (int i = gt; i < 2049 * 64; i += NGT) {
        const int pi = i >> 6, j = i & 63; const double pos = pi == SEQ ? 16384.0 : (double)pi;
        const double ang = pos * pow(10000.0, -(double)j / 64.0);
        CS[2 * i] = (float)cos(ang); CS[2 * i + 1] = (float)sin(ang);
    }
    for (int i = gt; i < DM; i += NGT) { const float a0 = a.in[10][i], a1 = a.in[10][DM + i]; LB[i] = 1.0f / (1.0f + expf(a1 - a0)); }
}

typedef float f32x16 __attribute__((ext_vector_type(16)));
typedef short v4i16_t __attribute__((ext_vector_type(4)));
typedef unsigned u32x2 __attribute__((ext_vector_type(2)));
typedef float f32x2_t __attribute__((ext_vector_type(2))); typedef __bf16 bf16x2_t __attribute__((ext_vector_type(2)));
__device__ __forceinline__ unsigned cvtpk_s(float lo, float hi) { f32x2_t v = {lo, hi}; bf16x2_t b = __builtin_convertvector(v, bf16x2_t); return __builtin_bit_cast(unsigned, b); }
__device__ __forceinline__ unsigned off_b(unsigned row, unsigned ch) { return 256u * row + 16u * (ch ^ (((row & 3) << 2) | ((row >> 2) & 3))); }
__device__ __forceinline__ bf16x8 rd_row(LAS unsigned char* img, unsigned row, unsigned ks, unsigned h) { return *(const LAS bf16x8*)(img + off_b(row, 2 * ks + h)); }
__device__ __forceinline__ bf16x8 rd_tr(LAS unsigned char* img, unsigned lane, unsigned c, unsigned ks) {
    const unsigned h = lane >> 5, blk = (lane >> 4) & 1, q = (lane & 15) >> 2, p = lane & 3;
    const unsigned a0 = off_b(16 * ks + 8 * h + q, 4 * c + 2 * blk + (p >> 1)) + 8 * (p & 1);
    const unsigned a1 = off_b(16 * ks + 8 * h + 4 + q, 4 * c + 2 * blk + (p >> 1)) + 8 * (p & 1);
    const v4i16_t lo = __builtin_amdgcn_ds_read_tr16_b64_v4i16((LAS v4i16_t*)(img + a0));
    const v4i16_t hi = __builtin_amdgcn_ds_read_tr16_b64_v4i16((LAS v4i16_t*)(img + a1));
    return __builtin_shufflevector(lo, hi, 0, 1, 2, 3, 4, 5, 6, 7);
}
#define MFMA32(a, b, c) __builtin_amdgcn_mfma_f32_32x32x16_bf16((a), (b), (c), 0, 0, 0)
__device__ __forceinline__ void scan_item(Frame& F, const Args& a, int item) { const int tid_v = tid_(); const int lane_v = tid_v & 63; const int wave_v = __builtin_amdgcn_readfirstlane(tid_v >> 6); (void)lane_v; (void)wave_v;
    unsigned char* ws = a.ws;
    const bool isg = item >= 128; const int it = isg ? item - 128 : item;
    int b, hd, dv0, ldq; const bf16 *Qp, *Kp; bf16* Vp; float* Sout; const float* GLp = nullptr; float sdec = 1.f;
    if (!isg) { b = it >> 4; hd = (it >> 2) & 3; dv0 = (it & 3) * 64; ldq = 512;
        Qp = (const bf16*)(ws + Z_QR) + hd * 128; Kp = (const bf16*)(ws + Z_KR) + hd * 128; Vp = (bf16*)(ws + Z_VR) + hd * 256 + dv0;
        Sout = a.out + OFF_RETP + ((size_t)(b * HR + hd) * DKR) * DVR + dv0; sdec = __expf(64.0f * __logf(1.0f - exp2f(-5.0f - (float)hd))); }
    else { b = it >> 4; hd = (it >> 1) & 7; dv0 = (it & 1) * 64; ldq = 1024;
        Qp = (const bf16*)(ws + Z_QG) + hd * 128; Kp = (const bf16*)(ws + Z_KG) + hd * 128; Vp = (bf16*)(ws + Z_VG) + hd * 128 + dv0;
        Sout = a.out + OFF_HGP + ((size_t)(b * HG + hd) * DKG) * DVG + dv0; GLp = (const float*)(ws + WS_GL) + hd * 128; }
    const int ldo = isg ? DVG : DVR;
    LAS unsigned char* QI = F.lds; LAS unsigned char* KI = QI + 16384; LAS unsigned char* VI = KI + 16384; LAS unsigned char* PI = VI + 16384; LAS unsigned char* SI = PI + 16384;
    LAS unsigned char* OI = SI + 16384;
    const int tid = tid_v, lane = lane_v, w = wave_v; const unsigned r = lane & 31, h = lane >> 5;
    const int kb = w >> 1, dvb = w & 1;
    for (int i = tid; i < 16384 / 4; i += 512) ((LAS unsigned*)SI)[i] = 0u;
    f32x16 S;
#pragma unroll
    for (int i = 0; i < 16; ++i) S[i] = 0.f;
    const int qr0 = tid >> 4, qc0 = tid & 15, vr0 = tid >> 3, vc0 = tid & 7;
    const size_t rowb = (size_t)b * SEQ;
    v4u pq0, pq1, pk0, pk1, pv; f32x4 gn0, gn1, gn2, gn3;
    const float* glb = isg ? GLp + (size_t)b * (SEQ / CH) * DM + 32 * kb + 4 * h : nullptr;
#define SCAN_LOAD(c) do { const size_t r0_ = rowb + (size_t)(c) * CH; \
        pq0 = *(const v4u*)(Qp + (r0_ + qr0) * ldq + qc0 * 8); pq1 = *(const v4u*)(Qp + (r0_ + qr0 + 32) * ldq + qc0 * 8); \
        pk0 = *(const v4u*)(Kp + (r0_ + qr0) * ldq + qc0 * 8); pk1 = *(const v4u*)(Kp + (r0_ + qr0 + 32) * ldq + qc0 * 8); \
        pv = *(const v4u*)(Vp + (r0_ + vr0) * DM + vc0 * 8); \
        if (isg) { const float* g_ = glb + (size_t)(c) * DM; gn0 = *(const f32x4*)g_; gn1 = *(const f32x4*)(g_ + 8); gn2 = *(const f32x4*)(g_ + 16); gn3 = *(const f32x4*)(g_ + 24); } } while (0)
    gn0 = gn1 = gn2 = gn3 = (f32x4){sdec, sdec, sdec, sdec};
    SCAN_LOAD(0);
    const unsigned oi_off = (unsigned)(vr0 * 128 + 16 * (vc0 ^ (vr0 & 7)));
    for (int c = 0; c < SEQ / CH; ++c) {
        LBAR();
        if (c > 0) *(v4u*)(Vp + (rowb + (size_t)(c - 1) * CH + vr0) * DM + vc0 * 8) = *(const LAS v4u*)(OI + oi_off);
        *(LAS v4u*)(QI + off_b(qr0, qc0)) = pq0; *(LAS v4u*)(QI + off_b(qr0 + 32, qc0)) = pq1;
        *(LAS v4u*)(KI + off_b(qr0, qc0)) = pk0; *(LAS v4u*)(KI + off_b(qr0 + 32, qc0)) = pk1;
        *(LAS v4u*)(VI + off_b(vr0, vc0)) = pv;
        const f32x4 g0 = gn0, g1 = gn1, g2 = gn2, g3 = gn3;
        if (c > 0) {
#pragma unroll
            for (int g = 0; g < 4; ++g) { u32x2 wv; wv.x = cvtpk_s(S[4 * g], S[4 * g + 1]); wv.y = cvtpk_s(S[4 * g + 2], S[4 * g + 3]);
                *(LAS u32x2*)(SI + off_b(32 * dvb + r, 4 * kb + g) + 8 * h) = wv; }
        }
        if (c + 1 < SEQ / CH) SCAN_LOAD(c + 1);
        LBAR();
        {
            bf16x8 A[4], B[4];
#pragma unroll
            for (int ks = 0; ks < 4; ++ks) { A[ks] = rd_tr(KI, lane, kb, ks); B[ks] = rd_tr(VI, lane, dvb, ks); }
            __builtin_amdgcn_sched_barrier(0);
            f32x16 d;
#pragma unroll
            for (int i = 0; i < 16; ++i) d[i] = 0.f;
#pragma unroll
            for (int ks = 0; ks < 4; ++ks) d = MFMA32(A[ks], B[ks], d);
#pragma unroll
            for (int i = 0; i < 4; ++i) { S[i] = g0[i] * (S[i] + d[i]); S[4 + i] = g1[i] * (S[4 + i] + d[4 + i]); S[8 + i] = g2[i] * (S[8 + i] + d[8 + i]); S[12 + i] = g3[i] * (S[12 + i] + d[12 + i]); }
        }
        if (w < 3) {
            const int sb = w >> 1, tb = (w + 1) >> 1;
            bf16x8 A[8], B[8];
#pragma unroll
            for (int ks = 0; ks < 8; ++ks) { A[ks] = rd_row(KI, 32 * sb + r, ks, h); B[ks] = rd_row(QI, 32 * tb + r, ks, h); }
            __builtin_amdgcn_sched_barrier(0);
            f32x16 p;
#pragma unroll
            for (int i = 0; i < 16; ++i) p[i] = 0.f;
#pragma unroll
            for (int ks = 0; ks < 8; ++ks) p = MFMA32(A[ks], B[ks], p);
#pragma unroll
            for (int g = 0; g < 4; ++g) {
                float v[4];
#pragma unroll
                for (int i = 0; i < 4; ++i) { const int sl = 8 * g + 4 * (int)h + i; v[i] = (sb != tb || sl <= (int)r) ? p[4 * g + i] : 0.f; }
                u32x2 wv; wv.x = cvtpk_s(v[0], v[1]); wv.y = cvtpk_s(v[2], v[3]);
                *(LAS u32x2*)(PI + off_b(32 * tb + r, 4 * sb + g) + 8 * h) = wv;
            }
        }
        LBAR();
        if (w < 4) {
            const int ob = w >> 1, tb = w & 1;
            f32x16 o;
#pragma unroll
            for (int i = 0; i < 16; ++i) o[i] = 0.f;
            {   bf16x8 A[4], B[4];
#pragma unroll
                for (int ks = 0; ks < 4; ++ks) { A[ks] = rd_tr(VI, lane, ob, ks); B[ks] = rd_row(PI, 32 * tb + r, ks, h); }
                __builtin_amdgcn_sched_barrier(0);
#pragma unroll
                for (int ks = 0; ks < 4; ++ks) if (ks < 2 || tb == 1) o = MFMA32(A[ks], B[ks], o); }
            {   bf16x8 A[8], B[8];
#pragma unroll
                for (int ks = 0; ks < 8; ++ks) { A[ks] = rd_row(SI, 32 * ob + r, ks, h); B[ks] = rd_row(QI, 32 * tb + r, ks, h); }
                __builtin_amdgcn_sched_barrier(0);
#pragma unroll
                for (int ks = 0; ks < 8; ++ks) o = MFMA32(A[ks], B[ks], o); }
#pragma unroll
            for (int g = 0; g < 4; ++g) { u32x2 wv; wv.x = cvtpk_s(o[4 * g], o[4 * g + 1]); wv.y = cvtpk_s(o[4 * g + 2], o[4 * g + 3]);
                const unsigned t_ = 32 * tb + r, ch_ = 4 * ob + g; *(LAS u32x2*)(OI + t_ * 128 + 16 * (ch_ ^ (t_ & 7)) + 8 * h) = wv; }
        }
    }
#undef SCAN_LOAD
    LBAR();
    *(v4u*)(Vp + (rowb + (size_t)(SEQ / CH - 1) * CH + vr0) * DM + vc0 * 8) = *(const LAS v4u*)(OI + oi_off);
#pragma unroll
    for (int i = 0; i < 16; ++i) { const int k = 32 * kb + (i & 3) + 8 * (i >> 2) + 4 * (int)h; Sout[(size_t)k * ldo + 32 * dvb + r] = S[i]; }
    __syncthreads();
}

__device__ __forceinline__ void decode_ret(Frame& F, const Args& a, int item) { const int tid_v = tid_(); const int lane_v = tid_v & 63; const int wave_v = __builtin_amdgcn_readfirstlane(tid_v >> 6); (void)lane_v; (void)wave_v;
    unsigned char* ws = a.ws; const int n = item >> 2, h = item & 3, row = MPROMPT + n;
    LAS float* qs = (LAS float*)(F.lds); LAS float* ks = qs + 128; LAS float* red = ks + 128;
    LAS float* part = red + 8 * 256;
    const int tid = tid_v, lane = lane_v, w = wave_v;
    if (tid < 128) qs[tid] = bf2f_(((const bf16*)(ws + Z_QR))[(size_t)row * 512 + h * 128 + tid]);
    else if (tid < 256) ks[tid - 128] = bf2f_(((const bf16*)(ws + Z_KR))[(size_t)row * 512 + h * 128 + tid - 128]);
    const unsigned long long vw = *(const unsigned long long*)((const bf16*)(ws + Z_VR) + (size_t)row * DM + h * 256 + 4 * lane);
    const f32x4 v = (f32x4){bflo_((unsigned)vw), bfhi_((unsigned)vw), bflo_((unsigned)(vw >> 32)), bfhi_((unsigned)(vw >> 32))};
    const float gam = 1.0f - exp2f(-5.0f - (float)h);
    LBAR();
    const float* S0 = a.in[2] + ((size_t)(n * HR + h) * DKR) * DVR; float* S1 = a.out + OFF_RETS + ((size_t)(n * HR + h) * DKR) * DVR;
    f32x4 o = (f32x4){0.f, 0.f, 0.f, 0.f};
    f32x4 s[16];
#pragma unroll
    for (int i = 0; i < 16; ++i) s[i] = *(const f32x4*)(S0 + (size_t)(w + 8 * i) * DVR + 4 * lane);
#pragma unroll
    for (int i = 0; i < 16; ++i) { const int k = w + 8 * i; const f32x4 sn = s[i] * gam + v * ks[k]; *(f32x4*)(S1 + (size_t)k * DVR + 4 * lane) = sn; o += sn * qs[k]; }
    *(LAS f32x4*)(red + w * 256 + 4 * lane) = o;
    LBAR();
    float ov = 0.f;
    if (tid < 256) {
#pragma unroll
        for (int i = 0; i < 8; ++i) ov += red[i * 256 + tid];
        const float ss = wave_sum(ov * ov); if (lane == 0) part[w] = ss;
    }
    LBAR();
    if (tid < 256) {
        const float rstd = rsqrtf(((part[0] + part[1]) + (part[2] + part[3])) * (1.0f / DVR) + EPS);
        bf16* gp = (bf16*)(ws + WS_GR) + (size_t)row * DM + h * 256 + tid;
        *gp = (bf16)f2bf(ov * rstd * a.in[8][h * 256 + tid] * bf2f_(*gp));
    }
    LBAR();
}
__device__ __forceinline__ void decode_hg(Frame& F, const Args& a, int item) { const int tid_v = tid_(); const int lane_v = tid_v & 63; const int wave_v = __builtin_amdgcn_readfirstlane(tid_v >> 6); (void)lane_v; (void)wave_v;
    unsigned char* ws = a.ws; const int n = item >> 3, h = item & 7, row = MPROMPT + n;
    LAS float* qs = (LAS float*)(F.lds); LAS float* ks = qs + 128; LAS float* fs = ks + 128; LAS float* red = fs + 128;
    LAS float* part = red + 16 * 128;
    const int tid = tid_v, lane = lane_v, w = wave_v, l32 = lane & 31, half = lane >> 5;
    if (tid < 128) qs[tid] = bf2f_(((const bf16*)(ws + Z_QG))[(size_t)row * DM + h * 128 + tid]);
    else if (tid < 256) ks[tid - 128] = bf2f_(((const bf16*)(ws + Z_KG))[(size_t)row * DM + h * 128 + tid - 128]);
    else if (tid < 384) fs[tid - 256] = ((const float*)(ws + WS_FS))[(size_t)n * DM + h * 128 + tid - 256];
    const unsigned long long vw = *(const unsigned long long*)((const bf16*)(ws + Z_VG) + (size_t)row * DM + h * 128 + 4 * l32);
    const f32x4 v = (f32x4){bflo_((unsigned)vw), bfhi_((unsigned)vw), bflo_((unsigned)(vw >> 32)), bfhi_((unsigned)(vw >> 32))};
    LBAR();
    const float* S0 = a.in[3] + ((size_t)(n * HG + h) * DKG) * DVG; float* S1 = a.out + OFF_HGS + ((size_t)(n * HG + h) * DKG) * DVG;
    f32x4 o = (f32x4){0.f, 0.f, 0.f, 0.f};
    f32x4 s[8];
#pragma unroll
    for (int i = 0; i < 8; ++i) s[i] = *(const f32x4*)(S0 + (size_t)(2 * (w + 8 * i) + half) * DVG + 4 * l32);
#pragma unroll
    for (int i = 0; i < 8; ++i) { const int k = 2 * (w + 8 * i) + half; const f32x4 sn = s[i] * fs[k] + v * ks[k]; *(f32x4*)(S1 + (size_t)k * DVG + 4 * l32) = sn; o += sn * qs[k]; }
    *(LAS f32x4*)(red + (2 * w + half) * 128 + 4 * l32) = o;
    LBAR();
    float ov = 0.f;
    if (tid < 128) {
#pragma unroll
        for (int i = 0; i < 16; ++i) ov += red[i * 128 + tid];
        const float ss = wave_sum(ov * ov); if (lane == 0) part[w] = ss;
    }
    LBAR();
    if (tid < 128) {
        const float rstd = rsqrtf((part[0] + part[1]) * (1.0f / DVG) + EPS);
        bf16* gp = (bf16*)(ws + WS_GG) + (size_t)row * DM + h * 128 + tid;
        *gp = (bf16)f2bf(ov * rstd * a.in[9][h * 128 + tid] * bf2f_(*gp));
    }
    LBAR();
}

__device__ __forceinline__ void p3_headnorm(Frame& F, const Args& a) { const int tid_v = tid_(); const int lane_v = tid_v & 63; const int wave_v = __builtin_amdgcn_readfirstlane(tid_v >> 6); (void)lane_v; (void)wave_v;
    unsigned char* ws = a.ws; const int gw = F.vcu * NWAVES + wave_v, NGW = F.G * NWAVES, lane = lane_v;
    for (int it = gw; it < MPROMPT * 8; it += NGW) {
        const bool isg = it >= MPROMPT * 4; const int i2 = isg ? it - MPROMPT * 4 : it; const int row = i2 >> 2, q = i2 & 3;
        const size_t off = (size_t)row * DM + q * 256 + 4 * lane;
        const unsigned long long ow = *(const unsigned long long*)((const bf16*)(ws + (isg ? Z_VG : Z_VR)) + off);
        unsigned long long* gp = (unsigned long long*)((bf16*)(ws + (isg ? WS_GG : WS_GR)) + off); const unsigned long long gwd = *gp;
        const f32x4 gn = *(const f32x4*)(a.in[isg ? 9 : 8] + q * 256 + 4 * lane);
        const f32x4 o = (f32x4){bflo_((unsigned)ow), bfhi_((unsigned)ow), bflo_((unsigned)(ow >> 32)), bfhi_((unsigned)(ow >> 32))};
        const f32x4 gt = (f32x4){bflo_((unsigned)gwd), bfhi_((unsigned)gwd), bflo_((unsigned)(gwd >> 32)), bfhi_((unsigned)(gwd >> 32))};
        float ss = (o.x * o.x + o.y * o.y) + (o.z * o.z + o.w * o.w);
#pragma unroll
        for (int d = 1; d < 32; d <<= 1) ss += __shfl_xor(ss, d);
        if (!isg) ss += __shfl_xor(ss, 32);
        const float rstd = rsqrtf(ss * (isg ? 1.0f / DVG : 1.0f / DVR) + EPS);
        const f32x4 x = o * rstd * gn * gt;
        *gp = (unsigned long long)pk2(x.x, x.y) | ((unsigned long long)pk2(x.z, x.w) << 32);
    }
}

__device__ __forceinline__ void p9_final(Frame& F, const Args& a) { const int tid_v = tid_(); const int lane_v = tid_v & 63; const int wave_v = __builtin_amdgcn_readfirstlane(tid_v >> 6); (void)lane_v; (void)wave_v;
    const int gw = F.vcu * NWAVES + wave_v, NGW = F.G * NWAVES, lane = lane_v; const float* PS3 = (const float*)(a.ws + WS_PS3); const float* gf = a.in[20];
    for (int m = gw; m < MTOT; m += NGW) {
        const float pv = m < MPROMPT ? (lane < 16 ? PS3[(size_t)m * 16 + lane] : 0.f) : ((const float*)(a.ws + WS_PSS3))[(size_t)(m - MPROMPT) * 64 + lane];
        const float rstd = rsqrtf(wave_sum(pv) * (1.0f / DM) + EPS);
        f32x4* r = (f32x4*)(a.out + (size_t)m * DM) + lane;
#pragma unroll
        for (int j = 0; j < 4; ++j) { const f32x4 gv = *((const f32x4*)gf + 64 * j + lane); r[64 * j] = r[64 * j] * rstd * gv; }
    }
}

template <int K, class FE> __device__ __forceinline__ void skinny_gemm(Frame& F, const bf16* As, const bf16* Wt, int N, const FE& fe) { const int tid_v = tid_(); const int lane_v = tid_v & 63; const int wave_v = __builtin_amdgcn_readfirstlane(tid_v >> 6); (void)lane_v; (void)wave_v;
    constexpr int KW = K / 4, NKS = KW / 32, CH_KS = NKS < 8 ? NKS : 8, NCH = NKS / CH_KS;
    const int lane = lane_v, fr = lane & 15, fq = lane >> 4, rg = wave_v >> 2, ks = wave_v & 3;
    LAS f32x4* red = (LAS f32x4*)(F.lds);
    const int ntile = 4 * (N / 16);
#if PROBE_ON && PROBE_SKINNY
    const unsigned ps0_ = (unsigned)rt();
#endif
    for (int tile = F.vcu; tile < ntile; tile += F.G) {
        const int rb = tile & 3, cb = tile >> 2;
        const bf16* ap = Wt + (size_t)(16 * cb + fr) * K + ks * KW + 8 * fq;
        const bf16* bp = As + (size_t)(32 * rb + 16 * rg + fr) * K + ks * KW + 8 * fq;
        f32x4 acc = (f32x4){0.f, 0.f, 0.f, 0.f};
#pragma unroll 1
        for (int c = 0; c < NCH; ++c) {
            bf16x8 a[CH_KS], b[CH_KS];
#pragma unroll
            for (int i = 0; i < CH_KS; ++i) { a[i] = *(const bf16x8*)(ap + (c * CH_KS + i) * 32); b[i] = *(const bf16x8*)(bp + (c * CH_KS + i) * 32); }
#pragma unroll
            for (int i = 0; i < CH_KS; ++i) acc = __builtin_amdgcn_mfma_f32_16x16x32_bf16(a[i], b[i], acc, 0, 0, 0);
        }
        red[wave_v * 64 + lane] = acc;
        __syncthreads();
        if (ks == 0) {
            const f32x4 v = (red[(4 * rg + 0) * 64 + lane] + red[(4 * rg + 1) * 64 + lane]) + (red[(4 * rg + 2) * 64 + lane] + red[(4 * rg + 3) * 64 + lane]);
            fe(MPROMPT + 32 * rb + 16 * rg + fr, 16 * cb + 4 * fq, v);
        }
        __syncthreads();
    }
#if PROBE_ON && PROBE_SKINNY
    if (threadIdx.x == 0) F.MISC[18] += (unsigned)rt() - ps0_;
#endif
}
struct FeIn { pg8::EpiIn E; __device__ __forceinline__ void operator()(int row, int col, f32x4 v) const { pg8::samp_in(E, row, col, v); } };
template <int MODE> struct FeN { pg8::EpiN<MODE> E; const float* xs; float* PSS; const float* PSSin;
    __device__ __forceinline__ void operator()(int row, int col, f32x4 v) const { pg8::samp_n<MODE>(E, xs, PSS, PSSin, row, col, v); } };

struct PairOrder { pg8::StaticOrder S0;
    __device__ __forceinline__ bool next(int i, pg8::Unit& u) const { pg8::Unit t; if (!S0.next(i >> 1, t)) return false; if ((i & 1) == 0) { u.pm = t.pm + MP / 256; u.pn = t.pn + DM / 256; } else u = t; return true; }
    __device__ __forceinline__ void a_ready(const pg8::Unit&) const {}
    __device__ __forceinline__ void done(const pg8::Unit&) const {} };
struct EpiUp { static constexpr bool PERM = true, AFTER_DRAIN = false; pg8::EpiN<0> E0; pg8::EpiN<1> E1;
    __device__ __forceinline__ void operator()(const f32x4 (&acc)[2][2][4][2], const pg8::Unit& u, int wr, int wc, int fr, int fq) const {
        if (u.pn >= DM / 256) { const pg8::Unit v{u.pm - MP / 256, u.pn - DM / 256}; E0(acc, v, wr, wc, fr, fq); } else E1(acc, u, wr, wc, fr, fq); } };

__global__ void __launch_bounds__(NWAVES * 64, 2) fwd_kernel(Args args) {
#define tid_v ((int)threadIdx.x)
    extern __shared__ __attribute__((aligned(16))) unsigned char lds[];
    Frame F;
    F.lds = (LAS unsigned char*)lds;
    F.MISC = (volatile LAS unsigned*)(F.lds + MISC_OFF);
        F.G = gridDim.x; { const int bx = blockIdx.x; F.vcu = (F.G % 8 == 0) ? (bx % 8) * (F.G / 8) + bx / 8 : bx; }
    unsigned char* ws = args.ws;
    F.ctl = (gu32*)(ws + WS_CTL);
    for (int u = tid_v; u < (LDS_BYTES - LDSCTL_OFF) / 4; u += NWAVES * 64) ((LAS unsigned*)(F.lds + LDSCTL_OFF))[u] = 0u;
    __syncthreads();
    XcdBarrier bar; bar.bar = (unsigned*)(F.ctl + CW_BAR); bar.x = 0; bar.st = nullptr;
    if (args.use_bar) bar = xcd_barrier_post((unsigned*)(F.ctl + CW_BAR), F.MISC + 8);
    const int lo = args.ph_lo, hi = args.ph_hi;
#define IN(k) (lo <= (k) && (k) < hi)
#if PROBE_ON
    volatile LAS unsigned* PW = F.MISC + 16;
    if (tid_v == 0) { PW[0] = (unsigned)rt(); PW[1] = 0u; PW[2] = 0u; }
#define STAMP(k) do { if (blockIdx.x == 0 && tid_v == 0) { const unsigned t_ = (unsigned)rt(); unsigned q_ = (t_ - PW[0] + (unsigned)PROBE_UNIT / 2) / (unsigned)PROBE_UNIT; if (q_ > 49u) q_ = 49u; \
        if ((k) == PROBE_A) PW[1] += q_ * 400u; else if ((k) == PROBE_B) PW[1] += q_ * 20000u; else if (PROBE_E < 0 && (k) == PROBE_C) PW[1] += q_ * 1000000u; \
        if ((k) == PROBE_E) { unsigned e_ = (PW[2] + (unsigned)PROBE_UNIT / 2) / (unsigned)PROBE_UNIT; if (e_ > 49u) e_ = 49u; PW[1] += e_ * 1000000u; } PW[2] = 0u; PW[0] = t_; } } while (0)
#else
#define STAMP(k) do { } while (0)
#endif
#define SEAM(k) do { if (IN(k) && IN((k) + 1)) xcd_barrier(bar); STAMP(k); } while (0)
    using namespace pg8;
    bf16_t* XB = (bf16_t*)(args.out + OFF_RETS);
    bf16_t* AR = (bf16_t*)(args.out + OFF_Y); bf16_t* AH = AR + (size_t)MTOT * DM;
    float* R = args.out + OFF_Y;
    float* PS1 = (float*)(ws + WS_PS1); float* PS2 = (float*)(ws + WS_PS2); float* PS3 = (float*)(ws + WS_PS3);

    if (IN(0)) { p0_prologue(F, args); SEAM(0); }
    const bf16_t* SROW = nullptr; (void)SROW;
    float* PSS1 = (float*)(ws + WS_PSS1); float* PSS2 = (float*)(ws + WS_PSS2); float* PSS3 = (float*)(ws + WS_PSS3);
#define SAMP(buf, ld) ((const bf16*)(buf) + (size_t)MPROMPT * (ld))
    if (IN(1)) {
        Gemm g{XB, (const bf16_t*)(ws + WS_WIN), MPROMPT, DIN, DM}; StaticOrder S; S.init(MPROMPT, DIN, F.G, (int)blockIdx.x);
        EpiIn E{(const float*)(ws + WS_RSTD0), (const float*)(ws + WS_CS), (const float*)(ws + WS_LB),
                (bf16_t*)(ws + Z_QR), (bf16_t*)(ws + Z_KR), (bf16_t*)(ws + Z_VR), (bf16_t*)(ws + WS_GR), (bf16_t*)(ws + Z_QG), (bf16_t*)(ws + Z_KG), (bf16_t*)(ws + Z_VG), (bf16_t*)(ws + WS_GG),
                AR, AH, (float*)(ws + WS_GL), (float*)(ws + WS_FS)};
        const bool sk_first = (F.vcu & 1) != 0;
        if (sk_first) { FeIn fe{E}; skinny_gemm<DM>(F, SAMP(XB, DM), (const bf16*)(ws + WS_WIN), DIN, fe); }
        gemm_phase<EpiIn, StaticOrder, true, true>(F.lds + RING_OFF, g, S, E);
        if (!sk_first) { FeIn fe{E}; skinny_gemm<DM>(F, SAMP(XB, DM), (const bf16*)(ws + WS_WIN), DIN, fe); }
        SEAM(1);
    }
    if (IN(2)) {
        const bool dec_first = (F.vcu & 1) != 0;
        if (dec_first) {
            for (int it = F.vcu; it < NDEC * HR; it += F.G) decode_ret(F, args, it);
            for (int it = F.vcu; it < NDEC * HG; it += F.G) decode_hg(F, args, it);
        }
        for (int it = F.vcu; it < 256; it += F.G) scan_item(F, args, it);
#if PROBE_ON
        xcd_barrier(bar); STAMP(10);
#endif
        if (!dec_first) {
            for (int it = F.vcu; it < NDEC * HR; it += F.G) decode_ret(F, args, it);
            for (int it = F.vcu; it < NDEC * HG; it += F.G) decode_hg(F, args, it);
        }
        SEAM(2);
    }
    if (IN(3)) { p3_headnorm(F, args); SEAM(3); }
    if (IN(4)) {
        Gemm g{(const bf16_t*)(ws + WS_GR), (const bf16_t*)(ws + WS_WUPR), 2 * MP, 2 * DM, DM}; PairOrder S; S.S0.init(MPROMPT, DM, F.G, (int)blockIdx.x);
        EpiN<0> E0{AH, (bf16_t*)(ws + WS_MB), DM, nullptr, nullptr, nullptr, nullptr, nullptr, nullptr};
        EpiN<1> E1{AR, (bf16_t*)(ws + WS_MB), DM, nullptr, nullptr, nullptr, nullptr, nullptr, nullptr};
        EpiUp E{E0, E1};
        gemm_phase<EpiUp, PairOrder, true, true>(F.lds + RING_OFF, g, S, E);
        { FeN<0> fe{E0, nullptr, nullptr, nullptr}; skinny_gemm<DM>(F, SAMP(ws + WS_GG, DM), (const bf16*)(ws + WS_WUPH), DM, fe); }
        { FeN<1> fe{E1, nullptr, nullptr, nullptr}; skinny_gemm<DM>(F, SAMP(ws + WS_GR, DM), (const bf16*)(ws + WS_WUPR), DM, fe); }
        SEAM(4);
    }
    if (IN(5)) {
        Gemm g{(const bf16_t*)(ws + WS_MB), (const bf16_t*)(ws + WS_WO), MPROMPT, DM, DM}; StaticOrder S; S.init(MPROMPT, DM, F.G, (int)blockIdx.x);
        EpiN<2> E{nullptr, (bf16_t*)(ws + WS_A5), DM, args.in[0], nullptr, R, args.in[14], PS1, nullptr};
        gemm_phase<EpiN<2>, StaticOrder, true, true>(F.lds + RING_OFF, g, S, E);
        FeN<2> fe{E, args.in[1], PSS1, nullptr}; skinny_gemm<DM>(F, SAMP(ws + WS_MB, DM), (const bf16*)(ws + WS_WO), DM, fe);
        SEAM(5);
    }
    if (IN(6)) {
        Gemm g{(const bf16_t*)(ws + WS_A5), (const bf16_t*)(ws + WS_WFF1), MPROMPT, DFF, DM}; StaticOrder S; S.init(MPROMPT, DFF, F.G, (int)blockIdx.x);
        EpiN<3> E{nullptr, (bf16_t*)(ws + WS_H), DFF, nullptr, nullptr, nullptr, nullptr, nullptr, PS1};
        const bool sk_first = (F.vcu & 1) != 0; FeN<3> fe{E, nullptr, nullptr, PSS1};
        if (sk_first) skinny_gemm<DM>(F, SAMP(ws + WS_A5, DM), (const bf16*)(ws + WS_WFF1), DFF, fe);
        gemm_phase<EpiN<3>, StaticOrder, true, true>(F.lds + RING_OFF, g, S, E);
        if (!sk_first) skinny_gemm<DM>(F, SAMP(ws + WS_A5, DM), (const bf16*)(ws + WS_WFF1), DFF, fe);
        SEAM(6);
    }
    if (IN(7)) {
        Gemm g{(const bf16_t*)(ws + WS_H), (const bf16_t*)(ws + WS_WFF2), MPROMPT, DM, DFF}; StaticOrder S; S.init(MPROMPT, DM, F.G, (int)blockIdx.x);
        EpiN<2> E{nullptr, (bf16_t*)(ws + WS_A7), DM, R, nullptr, R, args.in[17], PS2, nullptr};
        gemm_phase<EpiN<2>, StaticOrder, true, true>(F.lds + RING_OFF, g, S, E);
        FeN<2> fe{E, nullptr, PSS2, nullptr}; skinny_gemm<DFF>(F, SAMP(ws + WS_H, DFF), (const bf16*)(ws + WS_WFF2), DM, fe);
        SEAM(7);
    }
    if (IN(8)) {
        { Gemm g{(const bf16_t*)(ws + WS_A7), (const bf16_t*)(ws + WS_WGATE), MPROMPT, DM, DM}; StaticOrder S; S.init(MPROMPT, DM, F.G, (int)blockIdx.x);
          EpiN<4> E{nullptr, (bf16_t*)(ws + WS_MB), DM, nullptr, nullptr, nullptr, nullptr, nullptr, PS2};
          gemm_phase<EpiN<4>, StaticOrder, true, true>(F.lds + RING_OFF, g, S, E);
          FeN<4> fe{E, nullptr, nullptr, PSS2}; skinny_gemm<DM>(F, SAMP(ws + WS_A7, DM), (const bf16*)(ws + WS_WGATE), DM, fe); }
        { Gemm g{(const bf16_t*)(ws + WS_PB), (const bf16_t*)(ws + WS_WPROJ), MPROMPT, DM, DPLE}; StaticOrder S; S.init(MPROMPT, DM, F.G, (int)blockIdx.x);
          EpiN<5> E{nullptr, (bf16_t*)(ws + WS_MB), DM, nullptr, nullptr, R, nullptr, PS3, nullptr};
          gemm_phase<EpiN<5>, StaticOrder, true, true>(F.lds + RING_OFF, g, S, E);
          FeN<5> fe{E, nullptr, PSS3, nullptr}; skinny_gemm<DPLE>(F, SAMP(ws + WS_PB, DPLE), (const bf16*)(ws + WS_WPROJ), DM, fe); }
        SEAM(8);
    }
    if (IN(9)) { p9_final(F, args); }
#if PROBE_ON
    STAMP(9);
    if (blockIdx.x == 0 && tid_v == 0) { const unsigned t0_ = (unsigned)rt(); const unsigned dly_ = PW[1]; while ((unsigned)rt() - t0_ < dly_) __builtin_amdgcn_s_sleep(16); }
#endif
#undef IN
#undef SEAM
#undef tid_v
}

extern "C" void kernel_launch(void* const* d_in, const int* in_sizes, int n_in, void* d_out, int out_size, void* d_ws, size_t ws_size, hipStream_t stream) {
    static int grid = 0;
    if (grid == 0) {
        if (n_in != 21 || out_size != (int)OUT_TOTAL || ws_size < WS_END) { fprintf(stderr, "kernel_launch: unexpected problem (n_in %d out %d ws %zu need %zu)\n", n_in, out_size, ws_size, (size_t)WS_END); grid = -1; return; }
        int dev = 0, cus = 0;
        if (hipGetDevice(&dev) != hipSuccess || hipDeviceGetAttribute(&cus, hipDeviceAttributeMultiprocessorCount, dev) != hipSuccess) { grid = -1; return; }
        if (hipFuncSetAttribute((const void*)fwd_kernel, hipFuncAttributeMaxDynamicSharedMemorySize, LDS_BYTES) != hipSuccess) { fprintf(stderr, "kernel_launch: hipFuncSetAttribute failed\n"); grid = -1; return; }
        (void)hipGetLastError();
        grid = cus;
    }
    if (grid < 0) return;
    (void)hipMemsetAsync((char*)d_ws + WS_CTL, 0, CTL_ZERO_BYTES, stream);
    Args a{};
    for (int i = 0; i < 21; ++i) a.in[i] = (const float*)d_in[i];
    a.out = (float*)d_out; a.ws = (unsigned char*)d_ws;
#if MK_ONE_LAUNCH
    a.ph_lo = 0; a.ph_hi = NPH; a.use_bar = 1;
    hipLaunchKernelGGL(fwd_kernel, dim3(grid), dim3(NWAVES * 64), LDS_BYTES, stream, a);
#else
    for (int p = 0; p < NPH; ++p) { a.ph_lo = p; a.ph_hi = p + 1; a.use_bar = 0; hipLaunchKernelGGL(fwd_kernel, dim3(grid), dim3(NWAVES * 64), LDS_BYTES, stream, a); }
#endif
}
```

```cpp
#include <hip/hip_runtime.h>
#include <cstdio>
#include <cstdint>
#ifndef PROBE_ON
#define PROBE_ON 0
#endif
#define PROBE_UNIT 800ull
#ifndef PROBE_A
#define PROBE_A 0
#define PROBE_B 1
#define PROBE_C 2
#endif
#ifndef PROBE_E
#define PROBE_E -1
#endif
#ifndef PROBE_SKINNY
#define PROBE_SKINNY 0
#endif
namespace pg8 {
#define PG8_LAS __attribute__((address_space(3)))
typedef unsigned short bf16_t;
typedef short bf16x8 __attribute__((ext_vector_type(8)));
typedef float f32x4 __attribute__((ext_vector_type(4)));
typedef unsigned u32x4 __attribute__((ext_vector_type(4)));
constexpr int BM = 256, BK = 64, HALF = 128, HTB = HALF * BK * 2  , STAGE_BYTES = 8 * HTB, NXCD = 8, WGM = 8;

__host__ __device__ __forceinline__ int lds_byte(int r, int c) { const int st = (r >> 4) * 2 + (c >> 5), rr = r & 15, cc = c & 31, ob = rr * 64 + cc * 2; return st * 1024 + (ob ^ (((ob >> 9) & 1) << 5)); }
__host__ __device__ __forceinline__ void stage_rc(int b, int& R, int& C) { const int st = b / 1024, sb = b % 1024, swz = sb ^ (((sb >> 9) & 1) << 5); R = (st >> 1) * 16 + swz / 64; C = (st & 1) * 32 + (swz % 64) / 2; }
__host__ __device__ __forceinline__ int perm32(int rho) { const int n = rho >> 4, i = rho & 15; return 8 * (i >> 2) + 4 * n + (i & 3); }

struct Unit { int pm, pn; };
struct Gemm { const bf16_t* A; const bf16_t* Bt; int M, N, K; };

struct StaticOrder {
    int nM, nN, nwg, G, c;
    __host__ __device__ void init(int M, int N, int G_, int c_) { nM = M / BM; nN = N / BM; nwg = nM * nN; G = G_; c = c_; }
    __host__ __device__ bool next(int i, Unit& u) const {
        const long L = (long)i * G + c; if (L >= nwg) return false;
        int wgid = (int)L; { const int q = nwg / NXCD, r = nwg % NXCD, xcd = wgid % NXCD, off = wgid / NXCD; wgid = (xcd < r ? xcd * (q + 1) : r * (q + 1) + (xcd - r) * q) + off; }
        const int nig = WGM * nN, gid = wgid / nig, fm = gid * WGM, gsz = (nM - fm) < WGM ? (nM - fm) : WGM;
        u.pm = fm + ((wgid % nig) % gsz); u.pn = (wgid % nig) / gsz; return true;
    }
    __device__ __forceinline__ void a_ready(const Unit&) const {}
    __device__ __forceinline__ void done(const Unit&) const {}
};

__device__ __forceinline__ unsigned cvt_pk_bf16(float lo, float hi) { unsigned r; asm volatile("v_cvt_pk_bf16_f32 %0, %1, %2" : "=v"(r) : "v"(lo), "v"(hi)); return r; }

template <class Epi, class Sched, bool ALIGN_EPI = false, bool SP2 = false>
__device__ __forceinline__ void gemm_phase(PG8_LAS unsigned char* lds, const Gemm g, const Sched& S, const Epi& E) {
    const int tid = threadIdx.x, wid = __builtin_amdgcn_readfirstlane(tid >> 6), lane = tid & 63, wr = wid >> 2, wc = wid & 3, fr = lane & 15, fq = lane >> 4;
    const int K = g.K, nt = K / BK;
    unsigned voffA[2], voffB[2];
#pragma unroll
    for (int i = 0; i < 2; ++i) { int R, C; stage_rc(tid * 16 + i * 8192, R, C); const int Rb = Epi::PERM ? ((R & ~31) + perm32(R & 31)) : R;
        voffA[i] = (unsigned)(R * K + C) * 2u; voffB[i] = (unsigned)(Rb * K + C) * 2u; }
    const size_t kstep = (size_t)(BK * 2);
    const size_t hstep = (size_t)HALF * K * 2;
    const size_t tstep = 2 * hstep;
    const unsigned ldsw = (unsigned)wid * 1024u;
    const int aoff = lds_byte(wr * 64 + fr, fq * 8), boff = lds_byte(wc * 32 + fr, fq * 8);
#define PG8_SA(b, h) (((b) * 2 + (h)) * HTB)
#define PG8_SB(b, h) ((4 + (b) * 2 + (h)) * HTB)
#define PG8_STAGE(bufoff, gbase, voff) do { _Pragma("unroll") for (int _i = 0; _i < 2; ++_i) \
        __builtin_amdgcn_global_load_lds((const unsigned*)((const char*)(gbase) + (voff)[_i]), (PG8_LAS unsigned*)(lds + (bufoff) + ldsw + _i * 8192), 16, 0, 0); } while (0)
#define PG8_LDA(dst, b, h) do { _Pragma("unroll") for (int m = 0; m < 4; ++m) _Pragma("unroll") for (int k = 0; k < 2; ++k) dst[m][k] = *(const PG8_LAS bf16x8*)(lds + PG8_SA(b, h) + aoff + m * 2048 + k * 1024); } while (0)
#define PG8_LDB(dst, b, h) do { _Pragma("unroll") for (int n = 0; n < 2; ++n) _Pragma("unroll") for (int k = 0; k < 2; ++k) dst[n][k] = *(const PG8_LAS bf16x8*)(lds + PG8_SB(b, h) + boff + n * 2048 + k * 1024); } while (0)
#define PG8_MMA(ai, bj, At, Bt) do { __builtin_amdgcn_s_setprio(1); _Pragma("unroll") for (int m = 0; m < 4; ++m) _Pragma("unroll") for (int n = 0; n < 2; ++n) _Pragma("unroll") for (int k = 0; k < 2; ++k) \
        acc[ai][bj][m][n] = __builtin_amdgcn_mfma_f32_16x16x32_bf16(Bt[n][k], At[m][k], acc[ai][bj][m][n], 0, 0, 0); __builtin_amdgcn_s_setprio(0); } while (0)
#define PG8_WAIT_V(n) asm volatile("s_waitcnt vmcnt(" #n ")" ::: "memory")
#define PG8_WAIT_L(n) asm volatile("s_waitcnt lgkmcnt(" #n ")" ::: "memory")
#define PG8_BAR __builtin_amdgcn_s_barrier()
#define PG8_SCHED __builtin_amdgcn_sched_barrier(0)
    Unit cur, nxt; int ui = 0;
    if (!S.next(0, cur)) return;
    f32x4 acc[2][2][4][2];
#pragma unroll
    for (int a = 0; a < 2; ++a)
#pragma unroll
        for (int b = 0; b < 2; ++b)
#pragma unroll
            for (int m = 0; m < 4; ++m)
#pragma unroll
                for (int n = 0; n < 2; ++n) acc[a][b][m][n] = (f32x4){0.f, 0.f, 0.f, 0.f};
    bf16x8 At[4][2], B0[2][2], B1[2][2];
    const char* cA = (const char*)g.A + (size_t)cur.pm * tstep; const char* cB = (const char*)g.Bt + (size_t)cur.pn * tstep;
    S.a_ready(cur);
    if constexpr (SP2) {
        PG8_STAGE(PG8_SB(0, 0), cB, voffB); PG8_STAGE(PG8_SB(0, 1), cB + hstep, voffB); PG8_STAGE(PG8_SA(0, 0), cA, voffA); PG8_STAGE(PG8_SA(0, 1), cA + hstep, voffA);
        if (wr == 1) PG8_BAR;
        PG8_WAIT_V(2); PG8_BAR;
        PG8_STAGE(PG8_SB(1, 0), cB + kstep, voffB); PG8_STAGE(PG8_SA(1, 0), cA + kstep, voffA); PG8_STAGE(PG8_SB(1, 1), cB + hstep + kstep, voffB);
        PG8_WAIT_V(6); PG8_BAR;
    } else {
        PG8_STAGE(PG8_SB(0, 0), cB, voffB); PG8_STAGE(PG8_SA(0, 0), cA, voffA); PG8_STAGE(PG8_SB(0, 1), cB + hstep, voffB); PG8_STAGE(PG8_SA(0, 1), cA + hstep, voffA);
        if (wr == 1) PG8_BAR;
        PG8_WAIT_V(4); PG8_BAR;
        PG8_STAGE(PG8_SB(1, 0), cB + kstep, voffB); PG8_STAGE(PG8_SA(1, 0), cA + kstep, voffA); PG8_STAGE(PG8_SB(1, 1), cB + hstep + kstep, voffB);
        PG8_WAIT_V(6); PG8_BAR;
    }
    for (;;) {
        const bool has_next = S.next(ui + 1, nxt);
        const char* nA = has_next ? (const char*)g.A + (size_t)nxt.pm * tstep : cA; const char* nB = has_next ? (const char*)g.Bt + (size_t)nxt.pn * tstep : cB;
        for (int t = 0; t < nt; t += 2) {
            const bool last = (t == nt - 2);
            const char* a1 = cA + (size_t)(t + 1) * kstep;
            const char* a2 = last ? nA : cA + (size_t)(t + 2) * kstep; const char* b2 = last ? nB : cB + (size_t)(t + 2) * kstep;
            const char* a3 = a2 + kstep; const char* b3 = b2 + kstep;
            if (last && has_next) S.a_ready(nxt);
            if constexpr (SP2) {
            PG8_LDB(B0, 0, 0); PG8_LDB(B1, 0, 1); PG8_SCHED; PG8_LDA(At, 0, 0); PG8_STAGE(PG8_SA(1, 1), a1 + hstep, voffA);
            PG8_WAIT_V(8); PG8_WAIT_L(0); PG8_BAR; PG8_MMA(0, 0, At, B0); PG8_MMA(0, 1, At, B1); PG8_BAR; PG8_SCHED;
            PG8_LDA(At, 0, 1); PG8_STAGE(PG8_SB(0, 0), b2, voffB); PG8_STAGE(PG8_SB(0, 1), b2 + hstep, voffB); PG8_STAGE(PG8_SA(0, 0), a2, voffA);
            PG8_WAIT_V(8); PG8_WAIT_L(0); PG8_BAR; PG8_MMA(1, 0, At, B0); PG8_MMA(1, 1, At, B1); PG8_BAR; PG8_SCHED;
            PG8_LDB(B0, 1, 0); PG8_LDB(B1, 1, 1); PG8_SCHED; PG8_LDA(At, 1, 0); PG8_STAGE(PG8_SA(0, 1), a2 + hstep, voffA);
            PG8_WAIT_V(8); PG8_WAIT_L(0); PG8_BAR; PG8_MMA(0, 0, At, B0); PG8_MMA(0, 1, At, B1); PG8_BAR; PG8_SCHED;
            PG8_LDA(At, 1, 1); PG8_STAGE(PG8_SB(1, 0), b3, voffB); PG8_STAGE(PG8_SB(1, 1), b3 + hstep, voffB); PG8_STAGE(PG8_SA(1, 0), a3, voffA);
            PG8_WAIT_V(8); PG8_WAIT_L(0); PG8_BAR; PG8_MMA(1, 0, At, B0); PG8_MMA(1, 1, At, B1); PG8_BAR; PG8_SCHED;
            } else {
            PG8_LDB(B0, 0, 0); PG8_SCHED; PG8_LDA(At, 0, 0); PG8_STAGE(PG8_SA(1, 1), a1 + hstep, voffA);
            PG8_WAIT_L(8); PG8_BAR; PG8_WAIT_L(0); PG8_MMA(0, 0, At, B0); PG8_BAR; PG8_SCHED;
            PG8_LDB(B1, 0, 1); PG8_STAGE(PG8_SB(0, 0), b2, voffB);
            PG8_BAR; PG8_WAIT_L(0); PG8_MMA(0, 1, At, B1); PG8_BAR;
            PG8_LDA(At, 0, 1); PG8_STAGE(PG8_SA(0, 0), a2, voffA);
            PG8_BAR; PG8_WAIT_L(0); PG8_MMA(1, 0, At, B0); PG8_BAR; PG8_SCHED;
            PG8_STAGE(PG8_SB(0, 1), b2 + hstep, voffB);
            PG8_WAIT_V(6); PG8_BAR; PG8_MMA(1, 1, At, B1); PG8_BAR;
            PG8_LDB(B0, 1, 0); PG8_SCHED; PG8_LDA(At, 1, 0); PG8_STAGE(PG8_SA(0, 1), a2 + hstep, voffA);
            PG8_WAIT_L(8); PG8_BAR; PG8_WAIT_L(0); PG8_MMA(0, 0, At, B0); PG8_BAR; PG8_SCHED;
            PG8_LDB(B1, 1, 1); PG8_STAGE(PG8_SB(1, 0), b3, voffB);
            PG8_BAR; PG8_WAIT_L(0); PG8_MMA(0, 1, At, B1); PG8_BAR;
            PG8_LDA(At, 1, 1); PG8_STAGE(PG8_SA(1, 0), a3, voffA);
            PG8_BAR; PG8_WAIT_L(0); PG8_MMA(1, 0, At, B0); PG8_BAR; PG8_SCHED;
            PG8_STAGE(PG8_SB(1, 1), b3 + hstep, voffB);
            PG8_WAIT_V(6); PG8_BAR; PG8_MMA(1, 1, At, B1); PG8_BAR;
            }
        }
        if constexpr (ALIGN_EPI) { if (wr == 0) PG8_BAR; }
#if PROBE_ON && !PROBE_SKINNY
        const unsigned pe0_ = (unsigned)__builtin_amdgcn_s_memrealtime();
#endif
        if constexpr (!Epi::AFTER_DRAIN) { E(acc, cur, wr, wc, fr, fq); S.done(cur); }
#if PROBE_ON && !PROBE_SKINNY
        if (threadIdx.x == 0) { *(volatile PG8_LAS unsigned*)(lds + 131072 + 320 + 4 * 18) += (unsigned)__builtin_amdgcn_s_memrealtime() - pe0_; }
#endif
        if (!has_next) break;
#pragma unroll
        for (int a = 0; a < 2; ++a)
#pragma unroll
            for (int b = 0; b < 2; ++b)
#pragma unroll
                for (int m = 0; m < 4; ++m)
#pragma unroll
                    for (int n = 0; n < 2; ++n) acc[a][b][m][n] = (f32x4){0.f, 0.f, 0.f, 0.f};
        cur = nxt; cA = nA; cB = nB; ++ui;
        if constexpr (ALIGN_EPI) { if (wr == 1) PG8_BAR; }
    }
    PG8_WAIT_V(0);
    if constexpr (!ALIGN_EPI) { if (wr == 0) PG8_BAR; }
    PG8_BAR;
    if constexpr (Epi::AFTER_DRAIN) { E.fused(acc, cur, wr, wc, fr, fq, lds, wid, lane); S.done(cur); }
#undef PG8_SA
#undef PG8_SB
#undef PG8_STAGE
#undef PG8_LDA
#undef PG8_LDB
#undef PG8_MMA
#undef PG8_WAIT_V
#undef PG8_WAIT_L
#undef PG8_BAR
#undef PG8_SCHED
}
}


constexpr int DM = 1024, NB = 8, SEQ = 2048, NDEC = 128, MPROMPT = NB * SEQ, MTOT = MPROMPT + NDEC, MP = 16640  ;
constexpr int HR = 4, DKR = 128, DVR = 256, HG = 8, DKG = 128, DVG = 128, DFF = 4096, DPLE = 256, DIN = 9216, CH = 64, NCHUNK = MPROMPT / CH;
constexpr float EPS = 1e-6f;
constexpr size_t OFF_Y = 0, OFF_RETP = (size_t)MTOT * DM, OFF_HGP = OFF_RETP + (size_t)NB * HR * DKR * DVR, OFF_RETS = OFF_HGP + (size_t)NB * HG * DKG * DVG,
                 OFF_HGS = OFF_RETS + (size_t)NDEC * HR * DKR * DVR, OUT_TOTAL = OFF_HGS + (size_t)NDEC * HG * DKG * DVG;
static_assert(OUT_TOTAL == 52559872, "output size");

namespace pg8 {
typedef unsigned u32x2 __attribute__((ext_vector_type(2)));
typedef float f32x2 __attribute__((ext_vector_type(2)));
__device__ __forceinline__ float bf2f(unsigned short b) { return __uint_as_float((unsigned)b << 16); }
__device__ __forceinline__ float bflo(unsigned w) { return __uint_as_float(w << 16); }
__device__ __forceinline__ float bfhi(unsigned w) { return __uint_as_float(w & 0xffff0000u); }
__device__ __forceinline__ float sigmoidf_(float x) { return 1.0f / (1.0f + __expf(-x)); }
__device__ __forceinline__ float siluf_(float x) { return x / (1.0f + __expf(-x)); }
__device__ __forceinline__ u32x2 pack4(f32x4 v) { u32x2 w; w.x = cvt_pk_bf16(v[0], v[1]); w.y = cvt_pk_bf16(v[2], v[3]); return w; }
__device__ __forceinline__ f32x4 unpack4(u32x2 w) { return (f32x4){bflo(w.x), bfhi(w.x), bflo(w.y), bfhi(w.y)}; }

typedef unsigned u32x4 __attribute__((ext_vector_type(4)));
#define DPP_ROW_SHR(x, n) __int_as_float(__builtin_amdgcn_update_dpp(0, __float_as_int(x), 0x110 + (n), 0xf, 0xf, true))
#define DPP_ROW_BCAST15(x) __int_as_float(__builtin_amdgcn_update_dpp(0, __float_as_int(x), 0x15F, 0xf, 0xf, false))
struct EpiIn {
    static constexpr bool PERM = true, AFTER_DRAIN = false;
    const float* rstd0; const float* cs; const float* lb;
    bf16_t *QR, *KR, *VR, *GR, *QG, *KG, *VG, *GG, *AR, *AH; float *GL, *FS;
    __device__ __forceinline__ void operator()(const f32x4 (&acc)[2][2][4][2], const Unit& u, int wr, int wc, int fr, int fq) const {
        const int pn = u.pn;
#pragma unroll
        for (int ai = 0; ai < 2; ++ai) {
            const int rbase = u.pm * BM + ai * HALF + wr * 64;
            float rs[4];
#pragma unroll
            for (int m = 0; m < 4; ++m) rs[m] = rstd0[rbase + m * 16 + fr];
            if (pn < 4) {
                const bool isk = pn >= 2; bf16_t* dst = isk ? KR : QR;
#pragma unroll
                for (int bj = 0; bj < 2; ++bj) {
                    const int head = 2 * (pn & 1) + bj;
                    const float lg = __logf(1.0f - exp2f(-5.0f - (float)head));
                    const int j0 = 16 * wc + 4 * fq;
#pragma unroll
                    for (int m = 0; m < 4; ++m) {
                        const int row = rbase + m * 16 + fr; const int pidx = row & (SEQ - 1);
                        const float e = lg * (float)(m * 16 + fr + 1);
                        const float sc = rs[m] * (isk ? 0.08838834764831845f * __expf(-e) : __expf(e));
                        const f32x4 t0 = *(const f32x4*)(cs + ((size_t)pidx * 64 + j0) * 2), t1 = *(const f32x4*)(cs + ((size_t)pidx * 64 + j0 + 2) * 2);
                        const f32x4 v0 = acc[ai][bj][m][0] * sc, v1 = acc[ai][bj][m][1] * sc;
                        u32x2 o1, o2;
                        o1.x = cvt_pk_bf16(v0[0] * t0[0] - v0[1] * t0[1], v0[2] * t0[2] - v0[3] * t0[3]); o1.y = cvt_pk_bf16(v1[0] * t1[0] - v1[1] * t1[1], v1[2] * t1[2] - v1[3] * t1[3]);
                        o2.x = cvt_pk_bf16(v0[0] * t0[1] + v0[1] * t0[0], v0[2] * t0[3] + v0[3] * t0[2]); o2.y = cvt_pk_bf16(v1[0] * t1[1] + v1[1] * t1[0], v1[2] * t1[3] + v1[3] * t1[2]);
                        bf16_t* p = dst + (size_t)row * 512 + head * 128 + j0;
                        *(u32x2*)p = o1; *(u32x2*)(p + 64) = o2;
                    }
                }
            } else if (pn >= 12 && pn < 20) {
                const int head = pn - 12;
#pragma unroll
                for (int bj = 0; bj < 2; ++bj) {
                    const int j0 = 64 * bj + 16 * wc + 4 * fq, c = head * 128 + j0;
                    const f32x4 lbv = *(const f32x4*)(lb + c);
                    float qa[4][4], ka[4][4], ba[4][4];
#pragma unroll
                    for (int q = 0; q < 4; ++q) {
                        const int n = q >> 1, e = q & 1; const float one_m_lb = 1.0f - lbv[q]; float carry = 0.f;
#pragma unroll
                        for (int m = 0; m < 4; ++m) {
                            const float vq = acc[ai][bj][m][n][2 * e] * rs[m], vf = acc[ai][bj][m][n][2 * e + 1] * rs[m];
                            const float kk = one_m_lb / (1.0f + __expf(vf));
                            float x = __logf(1.0f - kk);
                            x += DPP_ROW_SHR(x, 1); x += DPP_ROW_SHR(x, 2); x += DPP_ROW_SHR(x, 4); x += DPP_ROW_SHR(x, 8);
                            x += carry; carry = DPP_ROW_BCAST15(x);
                            qa[m][q] = siluf_(vq); ka[m][q] = kk; ba[m][q] = x;
                        }
                    }
#pragma unroll
                    for (int m = 0; m < 4; ++m) {
                        const int row = rbase + m * 16 + fr;
                        const float e0 = __expf(ba[m][0]), e1 = __expf(ba[m][1]), e2 = __expf(ba[m][2]), e3 = __expf(ba[m][3]);
                        u32x2 qw, kw;
                        qw.x = cvt_pk_bf16(qa[m][0] * e0, qa[m][1] * e1); qw.y = cvt_pk_bf16(qa[m][2] * e2, qa[m][3] * e3);
                        kw.x = cvt_pk_bf16(ka[m][0] * __expf(-ba[m][0]), ka[m][1] * __expf(-ba[m][1])); kw.y = cvt_pk_bf16(ka[m][2] * __expf(-ba[m][2]), ka[m][3] * __expf(-ba[m][3]));
                        *(u32x2*)(QG + (size_t)row * DM + c) = qw; *(u32x2*)(KG + (size_t)row * DM + c) = kw;
                        if (m == 3 && fr == 15) *(f32x4*)(GL + (size_t)(row >> 6) * DM + c) = (f32x4){e0, e1, e2, e3};
                    }
                }
            } else {
                int mode, cbase; bf16_t* dst;
                if (pn < 8) { dst = VR; cbase = (pn - 4) * BM; mode = 0; } else if (pn < 12) { dst = GR; cbase = (pn - 8) * BM; mode = 1; }
                else if (pn < 24) { dst = VG; cbase = (pn - 20) * BM; mode = 0; } else if (pn < 28) { dst = GG; cbase = (pn - 24) * BM; mode = 1; }
                else if (pn < 32) { dst = AR; cbase = (pn - 28) * BM; mode = 2; } else { dst = AH; cbase = (pn - 32) * BM; mode = 2; }
#pragma unroll
                for (int m = 0; m < 4; ++m) {
                    const int row = rbase + m * 16 + fr;
#pragma unroll
                    for (int bj = 0; bj < 2; ++bj) {
                        f32x4 v0 = acc[ai][bj][m][0] * rs[m], v1 = acc[ai][bj][m][1] * rs[m];
                        if (mode == 1) { v0[0] = siluf_(v0[0]); v0[1] = siluf_(v0[1]); v0[2] = siluf_(v0[2]); v0[3] = siluf_(v0[3]); v1[0] = siluf_(v1[0]); v1[1] = siluf_(v1[1]); v1[2] = siluf_(v1[2]); v1[3] = siluf_(v1[3]); }
                        else if (mode == 2) { v0[0] = sigmoidf_(v0[0]); v0[1] = sigmoidf_(v0[1]); v0[2] = sigmoidf_(v0[2]); v0[3] = sigmoidf_(v0[3]); v1[0] = sigmoidf_(v1[0]); v1[1] = sigmoidf_(v1[1]); v1[2] = sigmoidf_(v1[2]); v1[3] = sigmoidf_(v1[3]); }
                        const u32x2 a = pack4(v0), b = pack4(v1);
                        *(u32x4*)(dst + (size_t)row * DM + cbase + bj * HALF + wc * 32 + fq * 8) = (u32x4){a.x, a.y, b.x, b.y};
                    }
                }
            }
        }
    }
};

__device__ __forceinline__ void unpack8(u32x4 w, f32x4& a, f32x4& b) { a = (f32x4){bflo(w.x), bfhi(w.x), bflo(w.y), bfhi(w.y)}; b = (f32x4){bflo(w.z), bfhi(w.z), bflo(w.w), bfhi(w.w)}; }
__device__ __forceinline__ u32x4 pack8(f32x4 a, f32x4 b) { const u32x2 x = pack4(a), y = pack4(b); return (u32x4){x.x, x.y, y.x, y.y}; }
__device__ __forceinline__ float sumsq4(f32x4 r) { return (r[0] * r[0] + r[1] * r[1]) + (r[2] * r[2] + r[3] * r[3]); }
template <int MODE> struct EpiN {
    static constexpr bool PERM = true, AFTER_DRAIN = false;
    const bf16_t* gate; bf16_t* out16; int ld16; const float* xp; const float* xs; float* R; const float* g; float* PS; const float* PSin;
    __device__ __forceinline__ void operator()(const f32x4 (&acc)[2][2][4][2], const Unit& u, int wr, int wc, int fr, int fq) const {
#pragma unroll
        for (int ai = 0; ai < 2; ++ai) {
            const int rbase = u.pm * BM + ai * HALF + wr * 64;
#pragma unroll
            for (int m = 0; m < 4; ++m) {
                const int row = rbase + m * 16 + fr;
                float rstd = 1.f;
                if (MODE == 3 || MODE == 4) {
                    const f32x4* p = (const f32x4*)(PSin + (size_t)row * 16); const f32x4 a = p[0], b = p[1], c = p[2], d = p[3];
                    const float s = ((a[0] + a[1]) + (a[2] + a[3])) + ((b[0] + b[1]) + (b[2] + b[3])) + ((c[0] + c[1]) + (c[2] + c[3])) + ((d[0] + d[1]) + (d[2] + d[3]));
                    rstd = rsqrtf(s * (1.0f / 1024.0f) + EPS);
                }
                float ss = 0.f;
#pragma unroll
                for (int bj = 0; bj < 2; ++bj) {
                    const int col = u.pn * BM + bj * HALF + wc * 32 + fq * 8;
                    const f32x4 a0 = acc[ai][bj][m][0], a1 = acc[ai][bj][m][1];
                    if (MODE == 0) { f32x4 g0, g1; unpack8(*(const u32x4*)(gate + (size_t)row * DM + col), g0, g1); *(u32x4*)(out16 + (size_t)row * ld16 + col) = pack8(g0 * a0, g1 * a1); }
                    else if (MODE == 1) { f32x4 g0, g1, t0, t1; unpack8(*(const u32x4*)(gate + (size_t)row * DM + col), g0, g1); u32x4* o = (u32x4*)(out16 + (size_t)row * ld16 + col); unpack8(*o, t0, t1); *o = pack8(t0 + g0 * a0, t1 + g1 * a1); }
                    else if (MODE == 2) {
                        const float* bp = xp + (size_t)row * DM + col;
                        const f32x4 r0 = *(const f32x4*)bp + a0, r1 = *(const f32x4*)(bp + 4) + a1;
                        ss += sumsq4(r0) + sumsq4(r1);
                        *(u32x4*)(out16 + (size_t)row * ld16 + col) = pack8(r0, r1);
                    }
                    else if (MODE == 6) {
                        f32x4 b0, b1; unpack8(*(const u32x4*)(gate + (size_t)row * DM + col), b0, b1);
                        const f32x4 r0 = b0 + a0, r1 = b1 + a1;
                        ss += sumsq4(r0) + sumsq4(r1);
                        *(u32x4*)(out16 + (size_t)row * ld16 + col) = pack8(r0, r1);
                    }
                    else if (MODE == 3) { f32x4 v0 = a0 * rstd, v1 = a1 * rstd;
                        v0[0] = fmaxf(v0[0], 0.f); v0[1] = fmaxf(v0[1], 0.f); v0[2] = fmaxf(v0[2], 0.f); v0[3] = fmaxf(v0[3], 0.f); v1[0] = fmaxf(v1[0], 0.f); v1[1] = fmaxf(v1[1], 0.f); v1[2] = fmaxf(v1[2], 0.f); v1[3] = fmaxf(v1[3], 0.f);
                        *(u32x4*)(out16 + (size_t)row * ld16 + col) = pack8(v0 * v0, v1 * v1); }
                    else if (MODE == 4) { f32x4 v0 = a0 * rstd, v1 = a1 * rstd;
                        v0[0] = sigmoidf_(v0[0]); v0[1] = sigmoidf_(v0[1]); v0[2] = sigmoidf_(v0[2]); v0[3] = sigmoidf_(v0[3]); v1[0] = sigmoidf_(v1[0]); v1[1] = sigmoidf_(v1[1]); v1[2] = sigmoidf_(v1[2]); v1[3] = sigmoidf_(v1[3]);
                        *(u32x4*)(out16 + (size_t)row * ld16 + col) = pack8(v0, v1); }
                    else if (MODE == 5) { f32x4 t0, t1, b0, b1; unpack8(*(const u32x4*)(out16 + (size_t)row * ld16 + col), t0, t1); unpack8(*(const u32x4*)(gate + (size_t)row * DM + col), b0, b1); float* rp = R + (size_t)row * DM + col;
                        const f32x4 r0 = b0 + t0 * a0, r1 = b1 + t1 * a1; *(f32x4*)rp = r0; *(f32x4*)(rp + 4) = r1; ss += sumsq4(r0) + sumsq4(r1); }
                }
                if (MODE == 2 || MODE == 5 || MODE == 6) { ss += __shfl_xor(ss, 16); ss += __shfl_xor(ss, 32); if (fq == 0) PS[(size_t)row * 16 + u.pn * 4 + wc] = ss; }
            }
        }
    }
};

__device__ __forceinline__ void samp_in(const EpiIn& E, int row, int pcol, f32x4 v) {
    const float rs = E.rstd0[row]; const int pn = __builtin_amdgcn_readfirstlane(pcol >> 8), p = pcol & 255;
    if (pn < 4) {
        const bool isk = pn >= 2; bf16_t* dst = isk ? E.KR : E.QR; const int head = 2 * (pn & 1) + (p >> 7), j = (p & 127) >> 1;
        const f32x4 t = *(const f32x4*)(E.cs + ((size_t)SEQ * 64 + j) * 2);
        v = v * (rs * (isk ? 0.08838834764831845f : 1.0f));
        const float o1a = v[0] * t[0] - v[1] * t[1], o2a = v[0] * t[1] + v[1] * t[0], o1b = v[2] * t[2] - v[3] * t[3], o2b = v[2] * t[3] + v[3] * t[2];
        bf16_t* q = dst + (size_t)row * 512 + head * 128 + j;
        *(unsigned*)q = cvt_pk_bf16(o1a, o1b); *(unsigned*)(q + 64) = cvt_pk_bf16(o2a, o2b);
    } else if (pn >= 12 && pn < 20) {
        const int c = (pn - 12) * 128 + (p >> 1);
        const float k0 = (1.0f - E.lb[c]) / (1.0f + __expf(v[1] * rs)), k1 = (1.0f - E.lb[c + 1]) / (1.0f + __expf(v[3] * rs));
        *(unsigned*)(E.QG + (size_t)row * DM + c) = cvt_pk_bf16(siluf_(v[0] * rs), siluf_(v[2] * rs));
        *(unsigned*)(E.KG + (size_t)row * DM + c) = cvt_pk_bf16(k0, k1);
        *(f32x2*)(E.FS + (size_t)(row - MPROMPT) * DM + c) = (f32x2){1.0f - k0, 1.0f - k1};
    } else {
        v = v * rs;
        const bool sl = (pn >= 8 && pn < 12) || (pn >= 24 && pn < 28), sg = pn >= 28;
        if (sl) { v[0] = siluf_(v[0]); v[1] = siluf_(v[1]); v[2] = siluf_(v[2]); v[3] = siluf_(v[3]); }
        else if (sg) { v[0] = sigmoidf_(v[0]); v[1] = sigmoidf_(v[1]); v[2] = sigmoidf_(v[2]); v[3] = sigmoidf_(v[3]); }
        const u32x2 w = pack4(v); const size_t ro = (size_t)row * DM + p;
        if (pn < 8) *(u32x2*)(E.VR + ro + (pn - 4) * BM) = w;
        else if (pn < 12) *(u32x2*)(E.GR + ro + (pn - 8) * BM) = w;
        else if (pn < 24) *(u32x2*)(E.VG + ro + (pn - 20) * BM) = w;
        else if (pn < 28) *(u32x2*)(E.GG + ro + (pn - 24) * BM) = w;
        else if (pn < 32) *(u32x2*)(E.AR + ro + (pn - 28) * BM) = w;
        else *(u32x2*)(E.AH + ro + (pn - 32) * BM) = w;
    }
}
template <int MODE> __device__ __forceinline__ void samp_n(const EpiN<MODE>& E, const float* xs, float* PSS, const float* PSSin, int row, int col, f32x4 a) {
    const int rs_ = row - MPROMPT; float rstd = 1.f;
    if (MODE == 3 || MODE == 4) { const f32x4* p = (const f32x4*)(PSSin + (size_t)rs_ * 64); float s = 0.f;
#pragma unroll
        for (int i = 0; i < 16; ++i) { const f32x4 q = p[i]; s += (q[0] + q[1]) + (q[2] + q[3]); }
        rstd = rsqrtf(s * (1.0f / 1024.0f) + EPS); }
    float ss = 0.f;
    if (MODE == 0) { const f32x4 gt = unpack4(*(const u32x2*)(E.gate + (size_t)row * DM + col)); *(u32x2*)(E.out16 + (size_t)row * E.ld16 + col) = pack4(gt * a); }
    else if (MODE == 1) { const f32x4 gt = unpack4(*(const u32x2*)(E.gate + (size_t)row * DM + col)); u32x2* o = (u32x2*)(E.out16 + (size_t)row * E.ld16 + col); const f32x4 t = unpack4(*o); *o = pack4(t + gt * a); }
    else if (MODE == 2) { const f32x4 r = *(const f32x4*)(xs + (size_t)rs_ * DM + col) + a; ss = sumsq4(r); *(u32x2*)(E.out16 + (size_t)row * E.ld16 + col) = pack4(r); }
    else if (MODE == 6) { const f32x4 r = unpack4(*(const u32x2*)(E.gate + (size_t)row * DM + col)) + a; ss = sumsq4(r); *(u32x2*)(E.out16 + (size_t)row * E.ld16 + col) = pack4(r); }
    else if (MODE == 3) { f32x4 v = a * rstd; v[0] = fmaxf(v[0], 0.f); v[1] = fmaxf(v[1], 0.f); v[2] = fmaxf(v[2], 0.f); v[3] = fmaxf(v[3], 0.f); *(u32x2*)(E.out16 + (size_t)row * E.ld16 + col) = pack4(v * v); }
    else if (MODE == 4) { f32x4 v = a * rstd; v[0] = sigmoidf_(v[0]); v[1] = sigmoidf_(v[1]); v[2] = sigmoidf_(v[2]); v[3] = sigmoidf_(v[3]); *(u32x2*)(E.out16 + (size_t)row * E.ld16 + col) = pack4(v); }
    else if (MODE == 5) { const f32x4 t = unpack4(*(const u32x2*)(E.out16 + (size_t)row * E.ld16 + col)), b = unpack4(*(const u32x2*)(E.gate + (size_t)row * DM + col));
        const f32x4 r = b + t * a; *(f32x4*)(E.R + (size_t)row * DM + col) = r; ss = sumsq4(r); }
    if (MODE == 2 || MODE == 5 || MODE == 6) { ss += __shfl_xor(ss, 16); ss += __shfl_xor(ss, 32); if ((threadIdx.x & 63) < 16) PSS[(size_t)rs_ * 64 + (col >> 4)] = ss; }
}
}


constexpr int NWAVES = 8;
constexpr int NPH = 10;
#ifndef MK_ONE_LAUNCH
#define MK_ONE_LAUNCH 1
#endif

constexpr size_t MiB = 1u << 20;
constexpr size_t WS_CTL = 0, CTL_ZERO_BYTES = 1 * MiB;
constexpr size_t WS_WIN = 1 * MiB;
constexpr size_t WS_WUPR = WS_WIN + (size_t)DIN * DM * 2;
constexpr size_t WS_WUPH = WS_WUPR + (size_t)DM * DM * 2;
constexpr size_t WS_WO = WS_WUPH + (size_t)DM * DM * 2;
constexpr size_t WS_WFF1 = WS_WO + (size_t)DM * DM * 2;
constexpr size_t WS_WFF2 = WS_WFF1 + (size_t)DFF * DM * 2;
constexpr size_t WS_WGATE = WS_WFF2 + (size_t)DFF * DM * 2;
constexpr size_t WS_WPROJ = WS_WGATE + (size_t)DM * DM * 2;
constexpr size_t WS_Z6 = WS_WPROJ + (size_t)DM * DPLE * 2;
constexpr size_t Z_QR = WS_Z6, Z_KR = Z_QR + (size_t)MP * 512 * 2, Z_VR = Z_KR + (size_t)MP * 512 * 2, Z_QG = Z_VR + (size_t)MP * DM * 2, Z_KG = Z_QG + (size_t)MP * DM * 2,
                 Z_VG = Z_KG + (size_t)MP * DM * 2, Z_END = Z_VG + (size_t)MP * DM * 2;
constexpr size_t WS_H = WS_Z6, WS_MB = WS_Z6 + (size_t)MP * DFF * 2;
static_assert(WS_MB == Z_VG, "MB overlays VG exactly");
constexpr size_t WS_GR = Z_END, WS_GG = WS_GR + (size_t)MP * DM * 2, WS_A5 = WS_GR, WS_A7 = WS_GG;
constexpr size_t WS_PB = WS_GG + (size_t)MP * DM * 2;
constexpr size_t WS_CS = WS_PB + (size_t)MP * DPLE * 2;
constexpr size_t WS_GL = WS_CS + (size_t)2049 * 64 * 8;
constexpr size_t WS_FS = WS_GL + (size_t)NCHUNK * DM * 4;
constexpr size_t WS_RSTD0 = WS_FS + (size_t)NDEC * DM * 4;
constexpr size_t WS_LB = WS_RSTD0 + (size_t)MP * 4;
constexpr size_t WS_PS1 = WS_LB + 4096, WS_PS2 = WS_PS1 + (size_t)MP * 64, WS_PS3 = WS_PS2 + (size_t)MP * 64, WS_PSS1 = WS_PS3 + (size_t)MP * 64, WS_PSS2 = WS_PSS1 + (size_t)NDEC * 256, WS_PSS3 = WS_PSS2 + (size_t)NDEC * 256, WS_END = WS_PSS3 + (size_t)NDEC * 256;
static_assert(WS_END <= 307920896, "d_ws map must fit sum(inputs) bytes");
static_assert(WS_WIN % 256 == 0 && WS_Z6 % 256 == 0 && WS_GR % 256 == 0 && WS_PB % 256 == 0 && WS_CS % 16 == 0 && WS_GL % 16 == 0 && WS_PS1 % 16 == 0, "alignment");
constexpr int CW_TMO = 0, CW_BAR = 4096;

constexpr int RING_OFF = 0, RING_BYTES = 131072;
constexpr int LDSCTL_OFF = RING_BYTES, MISC_OFF = LDSCTL_OFF + 320;
constexpr int LDS_BYTES = 147456;

#define GAS __attribute__((address_space(1)))
#define LAS __attribute__((address_space(3)))
typedef unsigned short bf16;
typedef unsigned v4u __attribute__((ext_vector_type(4)));
typedef float f32x4 __attribute__((ext_vector_type(4)));
typedef short bf16x8 __attribute__((ext_vector_type(8)));
typedef GAS unsigned gu32;
typedef GAS unsigned long long gu64;
#define RLX_AGENT __ATOMIC_RELAXED, __HIP_MEMORY_SCOPE_AGENT
#define LDS_WAIT() asm volatile("s_waitcnt lgkmcnt(0)" ::: "memory")
#define VM_WAIT() asm volatile("s_waitcnt vmcnt(0)" ::: "memory")
__device__ __forceinline__ unsigned long long rt() { return __builtin_amdgcn_s_memrealtime(); }
__device__ __forceinline__ unsigned f2bf(float f) { unsigned u = __builtin_bit_cast(unsigned, f); return (u + 0x7fffu + ((u >> 16) & 1u)) >> 16; }
__device__ __forceinline__ unsigned pk2(float lo, float hi) { return f2bf(lo) | (f2bf(hi) << 16); }

#define XB_TMO      128
#define XB_XCNT(j)  (256  + 64 * (j))
#define XB_XSUB(j)  (1280 + 64 * (j))
#define XB_XGEN(j)  (2304 + 64 * (j))
#define XB_TOP      3328
#define XB_TOPGEN   3392
#define XCD_BAR_WORDS 3456
#define XB_SPIN_CAP (1u << 18)

__device__ __forceinline__ unsigned xb_ld(unsigned* p)              { return __hip_atomic_load(p, __ATOMIC_RELAXED, __HIP_MEMORY_SCOPE_AGENT); }
__device__ __forceinline__ unsigned xb_add(unsigned* p, unsigned v) { return __hip_atomic_fetch_add(p, v, __ATOMIC_RELAXED, __HIP_MEMORY_SCOPE_AGENT); }
__device__ __forceinline__ unsigned xb_xcc_id() { return (unsigned)__builtin_amdgcn_s_getreg((3 << 11) | 20) & 0xFu; }
#define XB_SPIN(cond, bar) do { unsigned _sp = 0; while (cond) { __builtin_amdgcn_s_sleep(1); \
    if ((++_sp & 255u) == 0u) { if (xb_ld(&(bar)[XB_TMO])) break; if (_sp > XB_SPIN_CAP) { atomicAdd(&(bar)[XB_TMO], 1u); break; } } } } while (0)

struct XcdBarrier {
    unsigned* bar; unsigned x;
    volatile LAS unsigned* st;
};

__device__ __forceinline__ XcdBarrier xcd_barrier_post(unsigned* bar, volatile LAS unsigned* st) {
    XcdBarrier b; b.bar = bar; b.x = xb_xcc_id(); b.st = st;
    if (threadIdx.x == 0) (void)xb_add(&bar[XB_XCNT(b.x)], 1u);
    return b;
}
__device__ __forceinline__ void xcd_barrier_complete(unsigned* bar, unsigned x, unsigned& nloc, unsigned& nx) {
    const unsigned G = gridDim.x * gridDim.y * gridDim.z;
    unsigned sum, cnt, mine, sp = 0u;
    for (;;) {
        sum = 0u; cnt = 0u; mine = 0u;
#pragma unroll
        for (unsigned j = 0; j < 16; ++j) { const unsigned c = xb_ld(&bar[XB_XCNT(j)]); sum += c; cnt += (c > 0u) ? 1u : 0u; mine = (j == x) ? c : mine; }
        if (sum == G) break;
        __builtin_amdgcn_s_sleep(1);
        if ((++sp & 255u) == 0u) { if (xb_ld(&bar[XB_TMO])) break; if (sp > XB_SPIN_CAP) { atomicAdd(&bar[XB_TMO], 1u); break; } }
    }
    nloc = mine > 0u ? mine : 1u; nx = cnt > 0u ? cnt : 1u;
}

__device__ __forceinline__ void xcd_barrier(const XcdBarrier& b) {
    asm volatile("s_waitcnt vmcnt(0)" ::: "memory");
    __syncthreads();
    if (threadIdx.x == 0) {
        unsigned* bar = b.bar;
        __builtin_amdgcn_s_waitcnt(0);
        unsigned nloc = b.st[0], nx = b.st[1];
        if (nloc == 0u) { xcd_barrier_complete(bar, b.x, nloc, nx); b.st[0] = nloc; b.st[1] = nx; }
        const unsigned old = xb_add(&bar[XB_XSUB(b.x)], 1u);
        const unsigned gen = old / nloc;
        if (old + 1u == (gen + 1u) * nloc) {
            __builtin_amdgcn_fence(__ATOMIC_RELEASE, "agent");
            asm volatile("s_waitcnt vmcnt(0)" ::: "memory");
            const unsigned og = xb_add(&bar[XB_TOP], 1u);
            const unsigned tg = og / nx;
            if (og + 1u == (tg + 1u) * nx) xb_add(&bar[XB_TOPGEN], 1u);
            else XB_SPIN(xb_ld(&bar[XB_TOPGEN]) == tg, bar);
            __builtin_amdgcn_fence(__ATOMIC_ACQUIRE, "agent");
            xb_add(&bar[XB_XGEN(b.x)], 1u);
            asm volatile("s_waitcnt vmcnt(0)" ::: "memory");
        } else {
            XB_SPIN(xb_ld(&bar[XB_XGEN(b.x)]) == gen, bar);
            __builtin_amdgcn_fence(__ATOMIC_ACQUIRE, "agent");
            asm volatile("s_waitcnt vmcnt(0)" ::: "memory");
        }
    }
    __syncthreads();
}


struct Args { const float* in[21]; float* out; unsigned char* ws; int ph_lo, ph_hi, use_bar, pad; };
struct Frame {
    LAS unsigned char* lds; volatile LAS unsigned* MISC; gu32* ctl;
    int vcu, G;
};
__device__ __forceinline__ int tid_() { int t = threadIdx.x; asm volatile("" : "+v"(t)); return t; }
#define FTID (tid_())
#define FLANE (tid_() & 63)
#define FWAVE (__builtin_amdgcn_readfirstlane(tid_() >> 6))
__device__ __forceinline__ float wave_sum(float v) {
#pragma unroll
    for (int o = 1; o < 64; o <<= 1) v += __shfl_xor(v, o);
    return v;
}
#define LBAR() do { asm volatile("s_waitcnt lgkmcnt(0)" ::: "memory"); __builtin_amdgcn_s_barrier(); asm volatile("" ::: "memory"); } while (0)
__device__ __forceinline__ float bf2f_(unsigned short b) { return __uint_as_float((unsigned)b << 16); }
__device__ __forceinline__ float bflo_(unsigned w) { return __uint_as_float(w << 16); }
__device__ __forceinline__ float bfhi_(unsigned w) { return __uint_as_float(w & 0xffff0000u); }

__device__ __forceinline__ int win_src_col(int np) {
    const int tile = np >> 8, p = np & 255;
    if (tile < 4) { const int base = (tile >> 1) * 512, head = 2 * (tile & 1) + (p >> 7), pp = p & 127; return base + head * 128 + (pp & 1) * 64 + (pp >> 1); }
    if (tile >= 12 && tile < 20) { const int h = tile - 12; return 3072 + (p & 1) * 1024 + h * 128 + (p >> 1); }
    return np;
}
template <bool MAP> __device__ __forceinline__ void p0_transpose_item(const float* W, int K, int N, bf16* WT, LAS float* scr, int item, int lane, const float* gk = nullptr) {
    const int nblk = N / 32, kb = item / nblk, nb = item % nblk, k0 = 64 * kb, n0 = 32 * nb;
    const int srcc = MAP ? win_src_col(n0 + (lane & 31)) : n0 + (lane & 31);
#pragma unroll 8
    for (int i = 0; i < 32; ++i) { const int kk = 2 * i + (lane >> 5); scr[kk * 33 + (lane & 31)] = W[(size_t)(k0 + kk) * N + srcc]; }
    LDS_WAIT(); asm volatile("" ::: "memory");
    const int c = lane & 7;
    f32x4 ga = (f32x4){1.f, 1.f, 1.f, 1.f}, gb = ga;
    if (gk) { ga = *(const f32x4*)(gk + k0 + 8 * c); gb = *(const f32x4*)(gk + k0 + 8 * c + 4); }
#pragma unroll
    for (int j = 0; j < 4; ++j) { const int n = (lane >> 3) + 8 * j; const LAS float* s = scr + (8 * c) * 33 + n;
        v4u o; o.x = pk2(s[0 * 33] * ga.x, s[1 * 33] * ga.y); o.y = pk2(s[2 * 33] * ga.z, s[3 * 33] * ga.w); o.z = pk2(s[4 * 33] * gb.x, s[5 * 33] * gb.y); o.w = pk2(s[6 * 33] * gb.z, s[7 * 33] * gb.w);
        *(GAS v4u*)(WT + (size_t)(n0 + n) * K + k0 + 8 * c) = o; }
    LDS_WAIT(); asm volatile("" ::: "memory");
}
__device__ __forceinline__ void p0_prologue(Frame& F, const Args& a) { const int tid_v = tid_(); const int lane_v = tid_v & 63; const int wave_v = __builtin_amdgcn_readfirstlane(tid_v >> 6); (void)lane_v; (void)wave_v;
    unsigned char* ws = a.ws;
    LAS float* scr = (LAS float*)(F.lds + RING_OFF + wave_v * 16384);
    const int gw = F.vcu * NWAVES + wave_v, NGW = F.G * NWAVES;
    constexpr int I_IN = (DM / 64) * (DIN / 32), I_SQ = (DM / 64) * (DM / 32), I_F1 = (DM / 64) * (DFF / 32), I_F2 = (DFF / 64) * (DM / 32), I_PJ = (DPLE / 64) * (DM / 32);
    constexpr int NITEMS = I_IN + 4 * I_SQ + I_F1 + I_F2 + I_PJ;
    for (int it = gw; it < NITEMS; it += NGW) {
        int r = it;
        if (r < I_IN) { p0_transpose_item<true>(a.in[7], DM, DIN, (bf16*)(ws + WS_WIN), scr, r, lane_v, a.in[6]); continue; } r -= I_IN;
        if (r < I_SQ) { p0_transpose_item<false>(a.in[11], DM, DM, (bf16*)(ws + WS_WUPR), scr, r, lane_v); continue; } r -= I_SQ;
        if (r < I_SQ) { p0_transpose_item<false>(a.in[12], DM, DM, (bf16*)(ws + WS_WUPH), scr, r, lane_v); continue; } r -= I_SQ;
        if (r < I_SQ) { p0_transpose_item<false>(a.in[13], DM, DM, (bf16*)(ws + WS_WO), scr, r, lane_v); continue; } r -= I_SQ;
        if (r < I_SQ) { p0_transpose_item<false>(a.in[18], DM, DM, (bf16*)(ws + WS_WGATE), scr, r, lane_v, a.in[17]); continue; } r -= I_SQ;
        if (r < I_F1) { p0_transpose_item<false>(a.in[15], DM, DFF, (bf16*)(ws + WS_WFF1), scr, r, lane_v, a.in[14]); continue; } r -= I_F1;
        if (r < I_F2) { p0_transpose_item<false>(a.in[16], DFF, DM, (bf16*)(ws + WS_WFF2), scr, r, lane_v); continue; } r -= I_F2;
        p0_transpose_item<false>(a.in[19], DPLE, DM, (bf16*)(ws + WS_WPROJ), scr, r, lane_v);
    }
    bf16* XB = (bf16*)(a.out + OFF_RETS); float* RSTD0 = (float*)(ws + WS_RSTD0); bf16* PB = (bf16*)(ws + WS_PB);
    for (int m = gw; m < MP; m += NGW) {
        GAS unsigned long long* o8 = (GAS unsigned long long*)(XB + (size_t)m * DM) + lane_v;
        GAS unsigned long long* p8 = (GAS unsigned long long*)(PB + (size_t)m * DPLE) + lane_v;
        if (m >= MTOT) {
#pragma unroll
            for (int j = 0; j < 4; ++j) o8[64 * j] = 0ull;
            p8[0] = 0ull; if (lane_v == 0) RSTD0[m] = 0.f; continue;
        }
        const float* xrow = m < MPROMPT ? a.in[0] + (size_t)m * DM : a.in[1] + (size_t)(m - MPROMPT) * DM;
        const float* prow = m < MPROMPT ? a.in[4] + (size_t)m * DPLE : a.in[5] + (size_t)(m - MPROMPT) * DPLE;
        const GAS f32x4* xr = (const GAS f32x4*)xrow + lane_v;
        f32x4 v[4]; float s = 0.f;
#pragma unroll
        for (int j = 0; j < 4; ++j) { v[j] = xr[64 * j]; s += (v[j].x * v[j].x + v[j].y * v[j].y) + (v[j].z * v[j].z + v[j].w * v[j].w); }
        s = wave_sum(s);
        if (lane_v == 0) RSTD0[m] = rsqrtf(s * (1.0f / DM) + EPS);
#pragma unroll
        for (int j = 0; j < 4; ++j) o8[64 * j] = (unsigned long long)pk2(v[j].x, v[j].y) | ((unsigned long long)pk2(v[j].z, v[j].w) << 32);
        const f32x4 pv = *((const GAS f32x4*)prow + lane_v);
        p8[0] = (unsigned long long)pk2(pv.x, pv.y) | ((unsigned long long)pk2(pv.z, pv.w) << 32);
    }
    float* CS = (float*)(ws + WS_CS); float* LB = (float*)(ws + WS_LB);
    const int gt = (F.vcu * NWAVES + wave_v) * 64 + lane_v, NGT = NGW * 64;
    for (int i = gt; i < 2049 * 64; i += NGT) {
        const int pi = i >> 6, j = i & 63; const double pos = pi == SEQ ? 16384.0 : (double)pi;
        const double ang = pos * pow(10000.0, -(double)j / 64.0);
        CS[2 * i] = (float)cos(ang); CS[2 * i + 1] = (float)sin(ang);
    }
    for (int i = gt; i < DM; i += NGT) { const float a0 = a.in[10][i], a1 = a.in[10][DM + i]; LB[i] = 1.0f / (1.0f + expf(a1 - a0)); }
}

typedef float f32x16 __attribute__((ext_vector_type(16)));
typedef short v4i16_t __attribute__((ext_vector_type(4)));
typedef unsigned u32x2 __attribute__((ext_vector_type(2)));
typedef float f32x2_t __attribute__((ext_vector_type(2))); typedef __bf16 bf16x2_t __attribute__((ext_vector_type(2)));
__device__ __forceinline__ unsigned cvtpk_s(float lo, float hi) { f32x2_t v = {lo, hi}; bf16x2_t b = __builtin_convertvector(v, bf16x2_t); return __builtin_bit_cast(unsigned, b); }
__device__ __forceinline__ unsigned off_b(unsigned row, unsigned ch) { return 256u * row + 16u * (ch ^ (((row & 3) << 2) | ((row >> 2) & 3))); }
__device__ __forceinline__ bf16x8 rd_row(LAS unsigned char* img, unsigned row, unsigned ks, unsigned h) { return *(const LAS bf16x8*)(img + off_b(row, 2 * ks + h)); }
__device__ __forceinline__ bf16x8 rd_tr(LAS unsigned char* img, unsigned lane, unsigned c, unsigned ks) {
    const unsigned h = lane >> 5, blk = (lane >> 4) & 1, q = (lane & 15) >> 2, p = lane & 3;
    const unsigned a0 = off_b(16 * ks + 8 * h + q, 4 * c + 2 * blk + (p >> 1)) + 8 * (p & 1);
    const unsigned a1 = off_b(16 * ks + 8 * h + 4 + q, 4 * c + 2 * blk + (p >> 1)) + 8 * (p & 1);
    const v4i16_t lo = __builtin_amdgcn_ds_read_tr16_b64_v4i16((LAS v4i16_t*)(img + a0));
    const v4i16_t hi = __builtin_amdgcn_ds_read_tr16_b64_v4i16((LAS v4i16_t*)(img + a1));
    return __builtin_shufflevector(lo, hi, 0, 1, 2, 3, 4, 5, 6, 7);
}
#define MFMA32(a, b, c) __builtin_amdgcn_mfma_f32_32x32x16_bf16((a), (b), (c), 0, 0, 0)
__device__ __forceinline__ void scan_item(Frame& F, const Args& a, int item) { const int tid_v = tid_(); const int lane_v = tid_v & 63; const int wave_v = __builtin_amdgcn_readfirstlane(tid_v >> 6); (void)lane_v; (void)wave_v;
    unsigned char* ws = a.ws;
    const bool isg = item >= 128; const int it = isg ? item - 128 : item;
    int b, hd, dv0, ldq; const bf16 *Qp, *Kp; bf16* Vp; float* Sout; const float* GLp = nullptr; float sdec = 1.f;
    if (!isg) { b = it >> 4; hd = (it >> 2) & 3; dv0 = (it & 3) * 64; ldq = 512;
        Qp = (const bf16*)(ws + Z_QR) + hd * 128; Kp = (const bf16*)(ws + Z_KR) + hd * 128; Vp = (bf16*)(ws + Z_VR) + hd * 256 + dv0;
        Sout = a.out + OFF_RETP + ((size_t)(b * HR + hd) * DKR) * DVR + dv0; sdec = __expf(64.0f * __logf(1.0f - exp2f(-5.0f - (float)hd))); }
    else { b = it >> 4; hd = (it >> 1) & 7; dv0 = (it & 1) * 64; ldq = 1024;
        Qp = (const bf16*)(ws + Z_QG) + hd * 128; Kp = (const bf16*)(ws + Z_KG) + hd * 128; Vp = (bf16*)(ws + Z_VG) + hd * 128 + dv0;
        Sout = a.out + OFF_HGP + ((size_t)(b * HG + hd) * DKG) * DVG + dv0; GLp = (const float*)(ws + WS_GL) + hd * 128; }
    const int ldo = isg ? DVG : DVR;
    LAS unsigned char* QI = F.lds; LAS unsigned char* KI = QI + 16384; LAS unsigned char* VI = KI + 16384; LAS unsigned char* PI = VI + 16384; LAS unsigned char* SI = PI + 16384;
    LAS unsigned char* OI = SI + 16384;
    const int tid = tid_v, lane = lane_v, w = wave_v; const unsigned r = lane & 31, h = lane >> 5;
    const int kb = w >> 1, dvb = w & 1;
    for (int i = tid; i < 16384 / 4; i += 512) ((LAS unsigned*)SI)[i] = 0u;
    f32x16 S;
#pragma unroll
    for (int i = 0; i < 16; ++i) S[i] = 0.f;
    const int qr0 = tid >> 4, qc0 = tid & 15, vr0 = tid >> 3, vc0 = tid & 7;
    const size_t rowb = (size_t)b * SEQ;
    v4u pq0, pq1, pk0, pk1, pv; f32x4 gn0, gn1, gn2, gn3;
    const float* glb = isg ? GLp + (size_t)b * (SEQ / CH) * DM + 32 * kb + 4 * h : nullptr;
#define SCAN_LOAD(c) do { const size_t r0_ = rowb + (size_t)(c) * CH; \
        pq0 = *(const v4u*)(Qp + (r0_ + qr0) * ldq + qc0 * 8); pq1 = *(const v4u*)(Qp + (r0_ + qr0 + 32) * ldq + qc0 * 8); \
        pk0 = *(const v4u*)(Kp + (r0_ + qr0) * ldq + qc0 * 8); pk1 = *(const v4u*)(Kp + (r0_ + qr0 + 32) * ldq + qc0 * 8); \
        pv = *(const v4u*)(Vp + (r0_ + vr0) * DM + vc0 * 8); \
        if (isg) { const float* g_ = glb + (size_t)(c) * DM; gn0 = *(const f32x4*)g_; gn1 = *(const f32x4*)(g_ + 8); gn2 = *(const f32x4*)(g_ + 16); gn3 = *(const f32x4*)(g_ + 24); } } while (0)
    gn0 = gn1 = gn2 = gn3 = (f32x4){sdec, sdec, sdec, sdec};
    SCAN_LOAD(0);
    const unsigned oi_off = (unsigned)(vr0 * 128 + 16 * (vc0 ^ (vr0 & 7)));
    for (int c = 0; c < SEQ / CH; ++c) {
        LBAR();
        if (c > 0) *(v4u*)(Vp + (rowb + (size_t)(c - 1) * CH + vr0) * DM + vc0 * 8) = *(const LAS v4u*)(OI + oi_off);
        *(LAS v4u*)(QI + off_b(qr0, qc0)) = pq0; *(LAS v4u*)(QI + off_b(qr0 + 32, qc0)) = pq1;
        *(LAS v4u*)(KI + off_b(qr0, qc0)) = pk0; *(LAS v4u*)(KI + off_b(qr0 + 32, qc0)) = pk1;
        *(LAS v4u*)(VI + off_b(vr0, vc0)) = pv;
        const f32x4 g0 = gn0, g1 = gn1, g2 = gn2, g3 = gn3;
        if (c > 0) {
#pragma unroll
            for (int g = 0; g < 4; ++g) { u32x2 wv; wv.x = cvtpk_s(S[4 * g], S[4 * g + 1]); wv.y = cvtpk_s(S[4 * g + 2], S[4 * g + 3]);
                *(LAS u32x2*)(SI + off_b(32 * dvb + r, 4 * kb + g) + 8 * h) = wv; }
        }
        if (c + 1 < SEQ / CH) SCAN_LOAD(c + 1);
        LBAR();
        {
            bf16x8 A[4], B[4];
#pragma unroll
            for (int ks = 0; ks < 4; ++ks) { A[ks] = rd_tr(KI, lane, kb, ks); B[ks] = rd_tr(VI, lane, dvb, ks); }
            __builtin_amdgcn_sched_barrier(0);
            f32x16 d;
#pragma unroll
            for (int i = 0; i < 16; ++i) d[i] = 0.f;
#pragma unroll
            for (int ks = 0; ks < 4; ++ks) d = MFMA32(A[ks], B[ks], d);
#pragma unroll
            for (int i = 0; i < 4; ++i) { S[i] = g0[i] * (S[i] + d[i]); S[4 + i] = g1[i] * (S[4 + i] + d[4 + i]); S[8 + i] = g2[i] * (S[8 + i] + d[8 + i]); S[12 + i] = g3[i] * (S[12 + i] + d[12 + i]); }
        }
        if (w < 3) {
            const int sb = w >> 1, tb = (w + 1) >> 1;
            bf16x8 A[8], B[8];
#pragma unroll
            for (int ks = 0; ks < 8; ++ks) { A[ks] = rd_row(KI, 32 * sb + r, ks, h); B[ks] = rd_row(QI, 32 * tb + r, ks, h); }
            __builtin_amdgcn_sched_barrier(0);
            f32x16 p;
#pragma unroll
            for (int i = 0; i < 16; ++i) p[i] = 0.f;
#pragma unroll
            for (int ks = 0; ks < 8; ++ks) p = MFMA32(A[ks], B[ks], p);
#pragma unroll
            for (int g = 0; g < 4; ++g) {
                float v[4];
#pragma unroll
                for (int i = 0; i < 4; ++i) { const int sl = 8 * g + 4 * (int)h + i; v[i] = (sb != tb || sl <= (int)r) ? p[4 * g + i] : 0.f; }
                u32x2 wv; wv.x = cvtpk_s(v[0], v[1]); wv.y = cvtpk_s(v[2], v[3]);
                *(LAS u32x2*)(PI + off_b(32 * tb + r, 4 * sb + g) + 8 * h) = wv;
            }
        }
        LBAR();
        if (w < 4) {
            const int ob = w >> 1, tb = w & 1;
            f32x16 o;
#pragma unroll
            for (int i = 0; i < 16; ++i) o[i] = 0.f;
            {   bf16x8 A[4], B[4];
#pragma unroll
                for (int ks = 0; ks < 4; ++ks) { A[ks] = rd_tr(VI, lane, ob, ks); B[ks] = rd_row(PI, 32 * tb + r, ks, h); }
                __builtin_amdgcn_sched_barrier(0);
#pragma unroll
                for (int ks = 0; ks < 4; ++ks) if (ks < 2 || tb == 1) o = MFMA32(A[ks], B[ks], o); }
            {   bf16x8 A[8], B[8];
#pragma unroll
                for (int ks = 0; ks < 8; ++ks) { A[ks] = rd_row(SI, 32 * ob + r, ks, h); B[ks] = rd_row(QI, 32 * tb + r, ks, h); }
                __builtin_amdgcn_sched_barrier(0);
#pragma unroll
                for (int ks = 0; ks < 8; ++ks) o = MFMA32(A[ks], B[ks], o); }
#pragma unroll
            for (int g = 0; g < 4; ++g) { u32x2 wv; wv.x = cvtpk_s(o[4 * g], o[4 * g + 1]); wv.y = cvtpk_s(o[4 * g + 2], o[4 * g + 3]);
                const unsigned t_ = 32 * tb + r, ch_ = 4 * ob + g; *(LAS u32x2*)(OI + t_ * 128 + 16 * (ch_ ^ (t_ & 7)) + 8 * h) = wv; }
        }
    }
#undef SCAN_LOAD
    LBAR();
    *(v4u*)(Vp + (rowb + (size_t)(SEQ / CH - 1) * CH + vr0) * DM + vc0 * 8) = *(const LAS v4u*)(OI + oi_off);
#pragma unroll
    for (int i = 0; i < 16; ++i) { const int k = 32 * kb + (i & 3) + 8 * (i >> 2) + 4 * (int)h; Sout[(size_t)k * ldo + 32 * dvb + r] = S[i]; }
    __syncthreads();
}

__device__ __forceinline__ void decode_ret(Frame& F, const Args& a, int item) { const int tid_v = tid_(); const int lane_v = tid_v & 63; const int wave_v = __builtin_amdgcn_readfirstlane(tid_v >> 6); (void)lane_v; (void)wave_v;
    unsigned char* ws = a.ws; const int n = item >> 2, h = item & 3, row = MPROMPT + n;
    LAS float* qs = (LAS float*)(F.lds); LAS float* ks = qs + 128; LAS float* red = ks + 128;
    LAS float* part = red + 8 * 256;
    const int tid = tid_v, lane = lane_v, w = wave_v;
    if (tid < 128) qs[tid] = bf2f_(((const bf16*)(ws + Z_QR))[(size_t)row * 512 + h * 128 + tid]);
    else if (tid < 256) ks[tid - 128] = bf2f_(((const bf16*)(ws + Z_KR))[(size_t)row * 512 + h * 128 + tid - 128]);
    const unsigned long long vw = *(const unsigned long long*)((const bf16*)(ws + Z_VR) + (size_t)row * DM + h * 256 + 4 * lane);
    const f32x4 v = (f32x4){bflo_((unsigned)vw), bfhi_((unsigned)vw), bflo_((unsigned)(vw >> 32)), bfhi_((unsigned)(vw >> 32))};
    const float gam = 1.0f - exp2f(-5.0f - (float)h);
    LBAR();
    const float* S0 = a.in[2] + ((size_t)(n * HR + h) * DKR) * DVR; float* S1 = a.out + OFF_RETS + ((size_t)(n * HR + h) * DKR) * DVR;
    f32x4 o = (f32x4){0.f, 0.f, 0.f, 0.f};
    f32x4 s[16];
#pragma unroll
    for (int i = 0; i < 16; ++i) s[i] = *(const f32x4*)(S0 + (size_t)(w + 8 * i) * DVR + 4 * lane);
#pragma unroll
    for (int i = 0; i < 16; ++i) { const int k = w + 8 * i; const f32x4 sn = s[i] * gam + v * ks[k]; *(f32x4*)(S1 + (size_t)k * DVR + 4 * lane) = sn; o += sn * qs[k]; }
    *(LAS f32x4*)(red + w * 256 + 4 * lane) = o;
    LBAR();
    float ov = 0.f;
    if (tid < 256) {
#pragma unroll
        for (int i = 0; i < 8; ++i) ov += red[i * 256 + tid];
        const float ss = wave_sum(ov * ov); if (lane == 0) part[w] = ss;
    }
    LBAR();
    if (tid < 256) {
        const float rstd = rsqrtf(((part[0] + part[1]) + (part[2] + part[3])) * (1.0f / DVR) + EPS);
        bf16* gp = (bf16*)(ws + WS_GR) + (size_t)row * DM + h * 256 + tid;
        *gp = (bf16)f2bf(ov * rstd * a.in[8][h * 256 + tid] * bf2f_(*gp));
    }
    LBAR();
}
__device__ __forceinline__ void decode_hg(Frame& F, const Args& a, int item) { const int tid_v = tid_(); const int lane_v = tid_v & 63; const int wave_v = __builtin_amdgcn_readfirstlane(tid_v >> 6); (void)lane_v; (void)wave_v;
    unsigned char* ws = a.ws; const int n = item >> 3, h = item & 7, row = MPROMPT + n;
    LAS float* qs = (LAS float*)(F.lds); LAS float* ks = qs + 128; LAS float* fs = ks + 128; LAS float* red = fs + 128;
    LAS float* part = red + 16 * 128;
    const int tid = tid_v, lane = lane_v, w = wave_v, l32 = lane & 31, half = lane >> 5;
    if (tid < 128) qs[tid] = bf2f_(((const bf16*)(ws + Z_QG))[(size_t)row * DM + h * 128 + tid]);
    else if (tid < 256) ks[tid - 128] = bf2f_(((const bf16*)(ws + Z_KG))[(size_t)row * DM + h * 128 + tid - 128]);
    else if (tid < 384) fs[tid - 256] = ((const float*)(ws + WS_FS))[(size_t)n * DM + h * 128 + tid - 256];
    const unsigned long long vw = *(const unsigned long long*)((const bf16*)(ws + Z_VG) + (size_t)row * DM + h * 128 + 4 * l32);
    const f32x4 v = (f32x4){bflo_((unsigned)vw), bfhi_((unsigned)vw), bflo_((unsigned)(vw >> 32)), bfhi_((unsigned)(vw >> 32))};
    LBAR();
    const float* S0 = a.in[3] + ((size_t)(n * HG + h) * DKG) * DVG; float* S1 = a.out + OFF_HGS + ((size_t)(n * HG + h) * DKG) * DVG;
    f32x4 o = (f32x4){0.f, 0.f, 0.f, 0.f};
    f32x4 s[8];
#pragma unroll
    for (int i = 0; i < 8; ++i) s[i] = *(const f32x4*)(S0 + (size_t)(2 * (w + 8 * i) + half) * DVG + 4 * l32);
#pragma unroll
    for (int i = 0; i < 8; ++i) { const int k = 2 * (w + 8 * i) + half; const f32x4 sn = s[i] * fs[k] + v * ks[k]; *(f32x4*)(S1 + (size_t)k * DVG + 4 * l32) = sn; o += sn * qs[k]; }
    *(LAS f32x4*)(red + (2 * w + half) * 128 + 4 * l32) = o;
    LBAR();
    float ov = 0.f;
    if (tid < 128) {
#pragma unroll
        for (int i = 0; i < 16; ++i) ov += red[i * 128 + tid];
        const float ss = wave_sum(ov * ov); if (lane == 0) part[w] = ss;
    }
    LBAR();
    if (tid < 128) {
        const float rstd = rsqrtf((part[0] + part[1]) * (1.0f / DVG) + EPS);
        bf16* gp = (bf16*)(ws + WS_GG) + (size_t)row * DM + h * 128 + tid;
        *gp = (bf16)f2bf(ov * rstd * a.in[9][h * 128 + tid] * bf2f_(*gp));
    }
    LBAR();
}

__device__ __forceinline__ void p3_headnorm(Frame& F, const Args& a) { const int tid_v = tid_(); const int lane_v = tid_v & 63; const int wave_v = __builtin_amdgcn_readfirstlane(tid_v >> 6); (void)lane_v; (void)wave_v;
    unsigned char* ws = a.ws; const int gw = F.vcu * NWAVES + wave_v, NGW = F.G * NWAVES, lane = lane_v;
    for (int it = gw; it < MPROMPT * 8; it += NGW) {
        const bool isg = it >= MPROMPT * 4; const int i2 = isg ? it - MPROMPT * 4 : it; const int row = i2 >> 2, q = i2 & 3;
        const size_t off = (size_t)row * DM + q * 256 + 4 * lane;
        const unsigned long long ow = *(const unsigned long long*)((const bf16*)(ws + (isg ? Z_VG : Z_VR)) + off);
        unsigned long long* gp = (unsigned long long*)((bf16*)(ws + (isg ? WS_GG : WS_GR)) + off); const unsigned long long gwd = *gp;
        const f32x4 gn = *(const f32x4*)(a.in[isg ? 9 : 8] + q * 256 + 4 * lane);
        const f32x4 o = (f32x4){bflo_((unsigned)ow), bfhi_((unsigned)ow), bflo_((unsigned)(ow >> 32)), bfhi_((unsigned)(ow >> 32))};
        const f32x4 gt = (f32x4){bflo_((unsigned)gwd), bfhi_((unsigned)gwd), bflo_((unsigned)(gwd >> 32)), bfhi_((unsigned)(gwd >> 32))};
        float ss = (o.x * o.x + o.y * o.y) + (o.z * o.z + o.w * o.w);
#pragma unroll
        for (int d = 1; d < 32; d <<= 1) ss += __shfl_xor(ss, d);
        if (!isg) ss += __shfl_xor(ss, 32);
        const float rstd = rsqrtf(ss * (isg ? 1.0f / DVG : 1.0f / DVR) + EPS);
        const f32x4 x = o * rstd * gn * gt;
        *gp = (unsigned long long)pk2(x.x, x.y) | ((unsigned long long)pk2(x.z, x.w) << 32);
    }
}

__device__ __forceinline__ void p9_final(Frame& F, const Args& a) { const int tid_v = tid_(); const int lane_v = tid_v & 63; const int wave_v = __builtin_amdgcn_readfirstlane(tid_v >> 6); (void)lane_v; (void)wave_v;
    const int gw = F.vcu * NWAVES + wave_v, NGW = F.G * NWAVES, lane = lane_v; const float* PS3 = (const float*)(a.ws + WS_PS3); const float* gf = a.in[20];
    for (int m = gw; m < MTOT; m += NGW) {
        const float pv = m < MPROMPT ? (lane < 16 ? PS3[(size_t)m * 16 + lane] : 0.f) : ((const float*)(a.ws + WS_PSS3))[(size_t)(m - MPROMPT) * 64 + lane];
        const float rstd = rsqrtf(wave_sum(pv) * (1.0f / DM) + EPS);
        f32x4* r = (f32x4*)(a.out + (size_t)m * DM) + lane;
#pragma unroll
        for (int j = 0; j < 4; ++j) { const f32x4 gv = *((const f32x4*)gf + 64 * j + lane); r[64 * j] = r[64 * j] * rstd * gv; }
    }
}

template <int K, class FE> __device__ __forceinline__ void skinny_gemm(Frame& F, const bf16* As, const bf16* Wt, int N, const FE& fe, int it0 = 0, int it1 = 1 << 30) {     const int tid_v = tid_(); const int lane_v = tid_v & 63; const int wave_v = __builtin_amdgcn_readfirstlane(tid_v >> 6); (void)lane_v; (void)wave_v;
    constexpr int KW = K / 4, NKS = KW / 32, CH_KS = NKS < 8 ? NKS : 8, NCH = NKS / CH_KS;
    const int lane = lane_v, fr = lane & 15, fq = lane >> 4, rg = wave_v >> 2, ks = wave_v & 3;
    LAS f32x4* red = (LAS f32x4*)(F.lds);
    const int ntile = 4 * (N / 16);
#if PROBE_ON && PROBE_SKINNY
    const unsigned ps0_ = (unsigned)rt();
#endif
    for (int itn = it0; itn < it1; ++itn) {
        const int tile = F.vcu + itn * F.G; if (tile >= ntile) break;
        const int rb = tile & 3, cb = tile >> 2;
        const bf16* ap = Wt + (size_t)(16 * cb + fr) * K + ks * KW + 8 * fq;
        const bf16* bp = As + (size_t)(32 * rb + 16 * rg + fr) * K + ks * KW + 8 * fq;
        f32x4 acc = (f32x4){0.f, 0.f, 0.f, 0.f};
#pragma unroll 1
        for (int c = 0; c < NCH; ++c) {
            bf16x8 a[CH_KS], b[CH_KS];
#pragma unroll
            for (int i = 0; i < CH_KS; ++i) { a[i] = *(const bf16x8*)(ap + (c * CH_KS + i) * 32); b[i] = *(const bf16x8*)(bp + (c * CH_KS + i) * 32); }
#pragma unroll
            for (int i = 0; i < CH_KS; ++i) acc = __builtin_amdgcn_mfma_f32_16x16x32_bf16(a[i], b[i], acc, 0, 0, 0);
        }
        red[wave_v * 64 + lane] = acc;
        __syncthreads();
        if (ks == 0) {
            const f32x4 v = (red[(4 * rg + 0) * 64 + lane] + red[(4 * rg + 1) * 64 + lane]) + (red[(4 * rg + 2) * 64 + lane] + red[(4 * rg + 3) * 64 + lane]);
            fe(MPROMPT + 32 * rb + 16 * rg + fr, 16 * cb + 4 * fq, v);
        }
        __syncthreads();
    }
#if PROBE_ON && PROBE_SKINNY
    if (threadIdx.x == 0) F.MISC[18] += (unsigned)rt() - ps0_;
#endif
}
struct FeIn { pg8::EpiIn E; __device__ __forceinline__ void operator()(int row, int col, f32x4 v) const { pg8::samp_in(E, row, col, v); } };
template <int MODE> struct FeN { pg8::EpiN<MODE> E; const float* xs; float* PSS; const float* PSSin;
    __device__ __forceinline__ void operator()(int row, int col, f32x4 v) const { pg8::samp_n<MODE>(E, xs, PSS, PSSin, row, col, v); } };

struct PairOrder { pg8::StaticOrder S0;
    __device__ __forceinline__ bool next(int i, pg8::Unit& u) const { pg8::Unit t; if (!S0.next(i >> 1, t)) return false; if ((i & 1) == 0) { u.pm = t.pm + MP / 256; u.pn = t.pn + DM / 256; } else u = t; return true; }
    __device__ __forceinline__ void a_ready(const pg8::Unit&) const {}
    __device__ __forceinline__ void done(const pg8::Unit&) const {} };
struct EpiUp { static constexpr bool PERM = true, AFTER_DRAIN = false; pg8::EpiN<0> E0; pg8::EpiN<1> E1;
    __device__ __forceinline__ void operator()(const f32x4 (&acc)[2][2][4][2], const pg8::Unit& u, int wr, int wc, int fr, int fq) const {
        if (u.pn >= DM / 256) { const pg8::Unit v{u.pm - MP / 256, u.pn - DM / 256}; E0(acc, v, wr, wc, fr, fq); } else E1(acc, u, wr, wc, fr, fq); } };

__global__ void __launch_bounds__(NWAVES * 64, 2) fwd_kernel(Args args) {
#define tid_v ((int)threadIdx.x)
    extern __shared__ __attribute__((aligned(16))) unsigned char lds[];
    Frame F;
    F.lds = (LAS unsigned char*)lds;
    F.MISC = (volatile LAS unsigned*)(F.lds + MISC_OFF);
        F.G = gridDim.x; { const int bx = blockIdx.x; F.vcu = (F.G % 8 == 0) ? (bx % 8) * (F.G / 8) + bx / 8 : bx; }
    unsigned char* ws = args.ws;
    F.ctl = (gu32*)(ws + WS_CTL);
    for (int u = tid_v; u < (LDS_BYTES - LDSCTL_OFF) / 4; u += NWAVES * 64) ((LAS unsigned*)(F.lds + LDSCTL_OFF))[u] = 0u;
    __syncthreads();
    XcdBarrier bar; bar.bar = (unsigned*)(F.ctl + CW_BAR); bar.x = 0; bar.st = nullptr;
    if (args.use_bar) bar = xcd_barrier_post((unsigned*)(F.ctl + CW_BAR), F.MISC + 8);
    const int lo = args.ph_lo, hi = args.ph_hi;
#define IN(k) (lo <= (k) && (k) < hi)
#if PROBE_ON
    volatile LAS unsigned* PW = F.MISC + 16;
    if (tid_v == 0) { PW[0] = (unsigned)rt(); PW[1] = 0u; PW[2] = 0u; }
#define STAMP(k) do { if (blockIdx.x == 0 && tid_v == 0) { const unsigned t_ = (unsigned)rt(); unsigned q_ = (t_ - PW[0] + (unsigned)PROBE_UNIT / 2) / (unsigned)PROBE_UNIT; if (q_ > 49u) q_ = 49u; \
        if ((k) == PROBE_A) PW[1] += q_ * 400u; else if ((k) == PROBE_B) PW[1] += q_ * 20000u; else if (PROBE_E < 0 && (k) == PROBE_C) PW[1] += q_ * 1000000u; \
        if ((k) == PROBE_E) { unsigned e_ = (PW[2] + (unsigned)PROBE_UNIT / 2) / (unsigned)PROBE_UNIT; if (e_ > 49u) e_ = 49u; PW[1] += e_ * 1000000u; } PW[2] = 0u; PW[0] = t_; } } while (0)
#else
#define STAMP(k) do { } while (0)
#endif
#define SEAM(k) do { if (IN(k) && IN((k) + 1)) xcd_barrier(bar); STAMP(k); } while (0)
    using namespace pg8;
    bf16_t* XB = (bf16_t*)(args.out + OFF_RETS);
    bf16_t* AR = (bf16_t*)(args.out + OFF_Y); bf16_t* AH = AR + (size_t)MTOT * DM;
    float* R = args.out + OFF_Y;
    float* PS1 = (float*)(ws + WS_PS1); float* PS2 = (float*)(ws + WS_PS2); float* PS3 = (float*)(ws + WS_PS3);

    if (IN(0)) { p0_prologue(F, args); SEAM(0); }
    const bf16_t* SROW = nullptr; (void)SROW;
    float* PSS1 = (float*)(ws + WS_PSS1); float* PSS2 = (float*)(ws + WS_PSS2); float* PSS3 = (float*)(ws + WS_PSS3);
#define SAMP(buf, ld) ((const bf16*)(buf) + (size_t)MPROMPT * (ld))
    if (IN(1)) {
        Gemm g{XB, (const bf16_t*)(ws + WS_WIN), MPROMPT, DIN, DM}; StaticOrder S; S.init(MPROMPT, DIN, F.G, (int)blockIdx.x);
        EpiIn E{(const float*)(ws + WS_RSTD0), (const float*)(ws + WS_CS), (const float*)(ws + WS_LB),
                (bf16_t*)(ws + Z_QR), (bf16_t*)(ws + Z_KR), (bf16_t*)(ws + Z_VR), (bf16_t*)(ws + WS_GR), (bf16_t*)(ws + Z_QG), (bf16_t*)(ws + Z_KG), (bf16_t*)(ws + Z_VG), (bf16_t*)(ws + WS_GG),
                AR, AH, (float*)(ws + WS_GL), (float*)(ws + WS_FS)};
        const int nfirst = (F.vcu & 3) * 3;
        { FeIn fe{E}; skinny_gemm<DM>(F, SAMP(XB, DM), (const bf16*)(ws + WS_WIN), DIN, fe, 0, nfirst); }
        gemm_phase<EpiIn, StaticOrder, true, true>(F.lds + RING_OFF, g, S, E);
        { FeIn fe{E}; skinny_gemm<DM>(F, SAMP(XB, DM), (const bf16*)(ws + WS_WIN), DIN, fe, nfirst); }
        SEAM(1);
    }
    if (IN(2)) {
        const bool dec_first = (F.vcu & 1) != 0;
        if (dec_first) {
            for (int it = F.vcu; it < NDEC * HR; it += F.G) decode_ret(F, args, it);
            for (int it = F.vcu; it < NDEC * HG; it += F.G) decode_hg(F, args, it);
        }
        for (int it = F.vcu; it < 256; it += F.G) scan_item(F, args, it);
#if PROBE_ON
        xcd_barrier(bar); STAMP(10);
#endif
        if (!dec_first) {
            for (int it = F.vcu; it < NDEC * HR; it += F.G) decode_ret(F, args, it);
            for (int it = F.vcu; it < NDEC * HG; it += F.G) decode_hg(F, args, it);
        }
        SEAM(2);
    }
    if (IN(3)) { p3_headnorm(F, args); SEAM(3); }
    if (IN(4)) {
        Gemm g{(const bf16_t*)(ws + WS_GR), (const bf16_t*)(ws + WS_WUPR), 2 * MP, 2 * DM, DM}; PairOrder S; S.S0.init(MPROMPT, DM, F.G, (int)blockIdx.x);
        EpiN<0> E0{AH, (bf16_t*)(ws + WS_MB), DM, nullptr, nullptr, nullptr, nullptr, nullptr, nullptr};
        EpiN<1> E1{AR, (bf16_t*)(ws + WS_MB), DM, nullptr, nullptr, nullptr, nullptr, nullptr, nullptr};
        EpiUp E{E0, E1};
        gemm_phase<EpiUp, PairOrder, true, true>(F.lds + RING_OFF, g, S, E);
        { FeN<0> fe{E0, nullptr, nullptr, nullptr}; skinny_gemm<DM>(F, SAMP(ws + WS_GG, DM), (const bf16*)(ws + WS_WUPH), DM, fe); }
        { FeN<1> fe{E1, nullptr, nullptr, nullptr}; skinny_gemm<DM>(F, SAMP(ws + WS_GR, DM), (const bf16*)(ws + WS_WUPR), DM, fe); }
        SEAM(4);
    }
    if (IN(5)) {
        Gemm g{(const bf16_t*)(ws + WS_MB), (const bf16_t*)(ws + WS_WO), MPROMPT, DM, DM}; StaticOrder S; S.init(MPROMPT, DM, F.G, (int)blockIdx.x);
        EpiN<2> E{nullptr, (bf16_t*)(ws + WS_A5), DM, args.in[0], nullptr, nullptr, nullptr, PS1, nullptr};
        gemm_phase<EpiN<2>, StaticOrder, true, true>(F.lds + RING_OFF, g, S, E);
        FeN<2> fe{E, args.in[1], PSS1, nullptr}; skinny_gemm<DM>(F, SAMP(ws + WS_MB, DM), (const bf16*)(ws + WS_WO), DM, fe);
        SEAM(5);
    }
    if (IN(6)) {
        Gemm g{(const bf16_t*)(ws + WS_A5), (const bf16_t*)(ws + WS_WFF1), MPROMPT, DFF, DM}; StaticOrder S; S.init(MPROMPT, DFF, F.G, (int)blockIdx.x);
        EpiN<3> E{nullptr, (bf16_t*)(ws + WS_H), DFF, nullptr, nullptr, nullptr, nullptr, nullptr, PS1};
        const int nfirst = (F.vcu & 3) + ((F.vcu & 3) == 3 ? 1 : 0); FeN<3> fe{E, nullptr, nullptr, PSS1};
        skinny_gemm<DM>(F, SAMP(ws + WS_A5, DM), (const bf16*)(ws + WS_WFF1), DFF, fe, 0, nfirst);
        gemm_phase<EpiN<3>, StaticOrder, true, true>(F.lds + RING_OFF, g, S, E);
        skinny_gemm<DM>(F, SAMP(ws + WS_A5, DM), (const bf16*)(ws + WS_WFF1), DFF, fe, nfirst);
        SEAM(6);
    }
    if (IN(7)) {
        Gemm g{(const bf16_t*)(ws + WS_H), (const bf16_t*)(ws + WS_WFF2), MPROMPT, DM, DFF}; StaticOrder S; S.init(MPROMPT, DM, F.G, (int)blockIdx.x);
        EpiN<6> E{(const bf16_t*)(ws + WS_A5), (bf16_t*)(ws + WS_A7), DM, nullptr, nullptr, nullptr, nullptr, PS2, nullptr};
        gemm_phase<EpiN<6>, StaticOrder, true, true>(F.lds + RING_OFF, g, S, E);
        FeN<6> fe{E, nullptr, PSS2, nullptr}; skinny_gemm<DFF>(F, SAMP(ws + WS_H, DFF), (const bf16*)(ws + WS_WFF2), DM, fe);
        SEAM(7);
    }
    if (IN(8)) {
        { Gemm g{(const bf16_t*)(ws + WS_A7), (const bf16_t*)(ws + WS_WGATE), MPROMPT, DM, DM}; StaticOrder S; S.init(MPROMPT, DM, F.G, (int)blockIdx.x);
          EpiN<4> E{nullptr, (bf16_t*)(ws + WS_MB), DM, nullptr, nullptr, nullptr, nullptr, nullptr, PS2};
          gemm_phase<EpiN<4>, StaticOrder, true, true>(F.lds + RING_OFF, g, S, E);
          FeN<4> fe{E, nullptr, nullptr, PSS2}; skinny_gemm<DM>(F, SAMP(ws + WS_A7, DM), (const bf16*)(ws + WS_WGATE), DM, fe); }
        { Gemm g{(const bf16_t*)(ws + WS_PB), (const bf16_t*)(ws + WS_WPROJ), MPROMPT, DM, DPLE}; StaticOrder S; S.init(MPROMPT, DM, F.G, (int)blockIdx.x);
          EpiN<5> E{(const bf16_t*)(ws + WS_A7), (bf16_t*)(ws + WS_MB), DM, nullptr, nullptr, R, nullptr, PS3, nullptr};
          gemm_phase<EpiN<5>, StaticOrder, true, true>(F.lds + RING_OFF, g, S, E);
          FeN<5> fe{E, nullptr, PSS3, nullptr}; skinny_gemm<DPLE>(F, SAMP(ws + WS_PB, DPLE), (const bf16*)(ws + WS_WPROJ), DM, fe); }
        SEAM(8);
    }
    if (IN(9)) { p9_final(F, args); }
#if PROBE_ON
    STAMP(9);
    if (blockIdx.x == 0 && tid_v == 0) { const unsigned t0_ = (unsigned)rt(); const unsigned dly_ = PW[1]; while ((unsigned)rt() - t0_ < dly_) __builtin_amdgcn_s_sleep(16); }
#endif
#undef IN
#undef SEAM
#undef tid_v
}

extern "C" void kernel_launch(void* const* d_in, const int* in_sizes, int n_in, void* d_out, int out_size, void* d_ws, size_t ws_size, hipStream_t stream) {
    static int grid = 0;
    if (grid == 0) {
        if (n_in != 21 || out_size != (int)OUT_TOTAL || ws_size < WS_END) { fprintf(stderr, "kernel_launch: unexpected problem (n_in %d out %d ws %zu need %zu)\n", n_in, out_size, ws_size, (size_t)WS_END); grid = -1; return; }
        int dev = 0, cus = 0;
        if (hipGetDevice(&dev) != hipSuccess || hipDeviceGetAttribute(&cus, hipDeviceAttributeMultiprocessorCount, dev) != hipSuccess) { grid = -1; return; }
        if (hipFuncSetAttribute((const void*)fwd_kernel, hipFuncAttributeMaxDynamicSharedMemorySize, LDS_BYTES) != hipSuccess) { fprintf(stderr, "kernel_launch: hipFuncSetAttribute failed\n"); grid = -1; return; }
        (void)hipGetLastError();
        grid = cus;
    }
    if (grid < 0) return;
    (void)hipMemsetAsync((char*)d_ws + WS_CTL, 0, CTL_ZERO_BYTES, stream);
    Args a{};
    for (int i = 0; i < 21; ++i) a.in[i] = (const float*)d_in[i];
    a.out = (float*)d_out; a.ws = (unsigned char*)d_ws;
#if MK_ONE_LAUNCH
    a.ph_lo = 0; a.ph_hi = NPH; a.use_bar = 1;
    hipLaunchKernelGGL(fwd_kernel, dim3(grid), dim3(NWAVES * 64), LDS_BYTES, stream, a);
#else
    for (int p = 0; p < NPH; ++p) { a.ph_lo = p; a.ph_hi = p + 1; a.use_bar = 0; hipLaunchKernelGGL(fwd_kernel, dim3(grid), dim3(NWAVES * 64), LDS_BYTES, stream, a); }
#endif
}
```

```cpp
#include <hip/hip_runtime.h>
#include <cstdio>
#include <cstdint>
#ifndef PROBE_ON
#define PROBE_ON 0
#endif
#define PROBE_UNIT 800ull
#ifndef PROBE_A
#define PROBE_A 0
#define PROBE_B 1
#define PROBE_C 2
#endif
#ifndef PROBE_E
#define PROBE_E -1
#endif
#ifndef PROBE_SKINNY
#define PROBE_SKINNY 0
#endif
namespace pg8 {
#define PG8_LAS __attribute__((address_space(3)))
typedef unsigned short bf16_t;
typedef short bf16x8 __attribute__((ext_vector_type(8)));
typedef float f32x4 __attribute__((ext_vector_type(4)));
typedef unsigned u32x4 __attribute__((ext_vector_type(4)));
constexpr int BM = 256, BK = 64, HALF = 128, HTB = HALF * BK * 2  , STAGE_BYTES = 8 * HTB, NXCD = 8, WGM = 8;

__host__ __device__ __forceinline__ int lds_byte(int r, int c) { const int st = (r >> 4) * 2 + (c >> 5), rr = r & 15, cc = c & 31, ob = rr * 64 + cc * 2; return st * 1024 + (ob ^ (((ob >> 9) & 1) << 5)); }
__host__ __device__ __forceinline__ void stage_rc(int b, int& R, int& C) { const int st = b / 1024, sb = b % 1024, swz = sb ^ (((sb >> 9) & 1) << 5); R = (st >> 1) * 16 + swz / 64; C = (st & 1) * 32 + (swz % 64) / 2; }
__host__ __device__ __forceinline__ int perm32(int rho) { const int n = rho >> 4, i = rho & 15; return 8 * (i >> 2) + 4 * n + (i & 3); }

struct Unit { int pm, pn; };
struct Gemm { const bf16_t* A; const bf16_t* Bt; int M, N, K; };

struct StaticOrder {
    int nM, nN, nwg, G, c;
    __host__ __device__ void init(int M, int N, int G_, int c_) { nM = M / BM; nN = N / BM; nwg = nM * nN; G = G_; c = c_; }
    __host__ __device__ bool next(int i, Unit& u) const {
        const long L = (long)i * G + c; if (L >= nwg) return false;
        int wgid = (int)L; { const int q = nwg / NXCD, r = nwg % NXCD, xcd = wgid % NXCD, off = wgid / NXCD; wgid = (xcd < r ? xcd * (q + 1) : r * (q + 1) + (xcd - r) * q) + off; }
        const int nig = WGM * nN, gid = wgid / nig, fm = gid * WGM, gsz = (nM - fm) < WGM ? (nM - fm) : WGM;
        u.pm = fm + ((wgid % nig) % gsz); u.pn = (wgid % nig) / gsz; return true;
    }
    __device__ __forceinline__ void a_ready(const Unit&) const {}
    __device__ __forceinline__ void done(const Unit&) const {}
};

__device__ __forceinline__ unsigned cvt_pk_bf16(float lo, float hi) { unsigned r; asm volatile("v_cvt_pk_bf16_f32 %0, %1, %2" : "=v"(r) : "v"(lo), "v"(hi)); return r; }

template <class Epi, class Sched, bool ALIGN_EPI = false, bool SP2 = false>
__device__ __forceinline__ void gemm_phase(PG8_LAS unsigned char* lds, const Gemm g, const Sched& S, const Epi& E) {
    const int tid = threadIdx.x, wid = __builtin_amdgcn_readfirstlane(tid >> 6), lane = tid & 63, wr = wid >> 2, wc = wid & 3, fr = lane & 15, fq = lane >> 4;
    const int K = g.K, nt = K / BK;
    unsigned voffA[2], voffB[2];
#pragma unroll
    for (int i = 0; i < 2; ++i) { int R, C; stage_rc(tid * 16 + i * 8192, R, C); const int Rb = Epi::PERM ? ((R & ~31) + perm32(R & 31)) : R;
        voffA[i] = (unsigned)(R * K + C) * 2u; voffB[i] = (unsigned)(Rb * K + C) * 2u; }
    const size_t kstep = (size_t)(BK * 2);
    const size_t hstep = (size_t)HALF * K * 2;
    const size_t tstep = 2 * hstep;
    const unsigned ldsw = (unsigned)wid * 1024u;
    const int aoff = lds_byte(wr * 64 + fr, fq * 8), boff = lds_byte(wc * 32 + fr, fq * 8);
#define PG8_SA(b, h) (((b) * 2 + (h)) * HTB)
#define PG8_SB(b, h) ((4 + (b) * 2 + (h)) * HTB)
#define PG8_STAGE(bufoff, gbase, voff) do { _Pragma("unroll") for (int _i = 0; _i < 2; ++_i) \
        __builtin_amdgcn_global_load_lds((const unsigned*)((const char*)(gbase) + (voff)[_i]), (PG8_LAS unsigned*)(lds + (bufoff) + ldsw + _i * 8192), 16, 0, 0); } while (0)
#define PG8_LDA(dst, b, h) do { _Pragma("unroll") for (int m = 0; m < 4; ++m) _Pragma("unroll") for (int k = 0; k < 2; ++k) dst[m][k] = *(const PG8_LAS bf16x8*)(lds + PG8_SA(b, h) + aoff + m * 2048 + k * 1024); } while (0)
#define PG8_LDB(dst, b, h) do { _Pragma("unroll") for (int n = 0; n < 2; ++n) _Pragma("unroll") for (int k = 0; k < 2; ++k) dst[n][k] = *(const PG8_LAS bf16x8*)(lds + PG8_SB(b, h) + boff + n * 2048 + k * 1024); } while (0)
#define PG8_MMA(ai, bj, At, Bt) do { __builtin_amdgcn_s_setprio(1); _Pragma("unroll") for (int m = 0; m < 4; ++m) _Pragma("unroll") for (int n = 0; n < 2; ++n) _Pragma("unroll") for (int k = 0; k < 2; ++k) \
        acc[ai][bj][m][n] = __builtin_amdgcn_mfma_f32_16x16x32_bf16(Bt[n][k], At[m][k], acc[ai][bj][m][n], 0, 0, 0); __builtin_amdgcn_s_setprio(0); } while (0)
#define PG8_WAIT_V(n) asm volatile("s_waitcnt vmcnt(" #n ")" ::: "memory")
#define PG8_WAIT_L(n) asm volatile("s_waitcnt lgkmcnt(" #n ")" ::: "memory")
#define PG8_BAR __builtin_amdgcn_s_barrier()
#define PG8_SCHED __builtin_amdgcn_sched_barrier(0)
    Unit cur, nxt; int ui = 0;
    if (!S.next(0, cur)) return;
    f32x4 acc[2][2][4][2];
#pragma unroll
    for (int a = 0; a < 2; ++a)
#pragma unroll
        for (int b = 0; b < 2; ++b)
#pragma unroll
            for (int m = 0; m < 4; ++m)
#pragma unroll
                for (int n = 0; n < 2; ++n) acc[a][b][m][n] = (f32x4){0.f, 0.f, 0.f, 0.f};
    bf16x8 At[4][2], B0[2][2], B1[2][2];
    const char* cA = (const char*)g.A + (size_t)cur.pm * tstep; const char* cB = (const char*)g.Bt + (size_t)cur.pn * tstep;
    S.a_ready(cur);
    if constexpr (SP2) {
        PG8_STAGE(PG8_SB(0, 0), cB, voffB); PG8_STAGE(PG8_SB(0, 1), cB + hstep, voffB); PG8_STAGE(PG8_SA(0, 0), cA, voffA); PG8_STAGE(PG8_SA(0, 1), cA + hstep, voffA);
        if (wr == 1) PG8_BAR;
        PG8_WAIT_V(2); PG8_BAR;
        PG8_STAGE(PG8_SB(1, 0), cB + kstep, voffB); PG8_STAGE(PG8_SA(1, 0), cA + kstep, voffA); PG8_STAGE(PG8_SB(1, 1), cB + hstep + kstep, voffB);
        PG8_WAIT_V(6); PG8_BAR;
    } else {
        PG8_STAGE(PG8_SB(0, 0), cB, voffB); PG8_STAGE(PG8_SA(0, 0), cA, voffA); PG8_STAGE(PG8_SB(0, 1), cB + hstep, voffB); PG8_STAGE(PG8_SA(0, 1), cA + hstep, voffA);
        if (wr == 1) PG8_BAR;
        PG8_WAIT_V(4); PG8_BAR;
        PG8_STAGE(PG8_SB(1, 0), cB + kstep, voffB); PG8_STAGE(PG8_SA(1, 0), cA + kstep, voffA); PG8_STAGE(PG8_SB(1, 1), cB + hstep + kstep, voffB);
        PG8_WAIT_V(6); PG8_BAR;
    }
    for (;;) {
        const bool has_next = S.next(ui + 1, nxt);
        const char* nA = has_next ? (const char*)g.A + (size_t)nxt.pm * tstep : cA; const char* nB = has_next ? (const char*)g.Bt + (size_t)nxt.pn * tstep : cB;
        for (int t = 0; t < nt; t += 2) {
            const bool last = (t == nt - 2);
            const char* a1 = cA + (size_t)(t + 1) * kstep;
            const char* a2 = last ? nA : cA + (size_t)(t + 2) * kstep; const char* b2 = last ? nB : cB + (size_t)(t + 2) * kstep;
            const char* a3 = a2 + kstep; const char* b3 = b2 + kstep;
            if (last && has_next) S.a_ready(nxt);
            if constexpr (SP2) {
            PG8_LDB(B0, 0, 0); PG8_LDB(B1, 0, 1); PG8_SCHED; PG8_LDA(At, 0, 0); PG8_STAGE(PG8_SA(1, 1), a1 + hstep, voffA);
            PG8_WAIT_V(8); PG8_WAIT_L(0); PG8_BAR; PG8_MMA(0, 0, At, B0); PG8_MMA(0, 1, At, B1); PG8_BAR; PG8_SCHED;
            PG8_LDA(At, 0, 1); PG8_STAGE(PG8_SB(0, 0), b2, voffB); PG8_STAGE(PG8_SB(0, 1), b2 + hstep, voffB); PG8_STAGE(PG8_SA(0, 0), a2, voffA);
            PG8_WAIT_V(8); PG8_WAIT_L(0); PG8_BAR; PG8_MMA(1, 0, At, B0); PG8_MMA(1, 1, At, B1); PG8_BAR; PG8_SCHED;
            PG8_LDB(B0, 1, 0); PG8_LDB(B1, 1, 1); PG8_SCHED; PG8_LDA(At, 1, 0); PG8_STAGE(PG8_SA(0, 1), a2 + hstep, voffA);
            PG8_WAIT_V(8); PG8_WAIT_L(0); PG8_BAR; PG8_MMA(0, 0, At, B0); PG8_MMA(0, 1, At, B1); PG8_BAR; PG8_SCHED;
            PG8_LDA(At, 1, 1); PG8_STAGE(PG8_SB(1, 0), b3, voffB); PG8_STAGE(PG8_SB(1, 1), b3 + hstep, voffB); PG8_STAGE(PG8_SA(1, 0), a3, voffA);
            PG8_WAIT_V(8); PG8_WAIT_L(0); PG8_BAR; PG8_MMA(1, 0, At, B0); PG8_MMA(1, 1, At, B1); PG8_BAR; PG8_SCHED;
            } else {
            PG8_LDB(B0, 0, 0); PG8_SCHED; PG8_LDA(At, 0, 0); PG8_STAGE(PG8_SA(1, 1), a1 + hstep, voffA);
            PG8_WAIT_L(8); PG8_BAR; PG8_WAIT_L(0); PG8_MMA(0, 0, At, B0); PG8_BAR; PG8_SCHED;
            PG8_LDB(B1, 0, 1); PG8_STAGE(PG8_SB(0, 0), b2, voffB);
            PG8_BAR; PG8_WAIT_L(0); PG8_MMA(0, 1, At, B1); PG8_BAR;
            PG8_LDA(At, 0, 1); PG8_STAGE(PG8_SA(0, 0), a2, voffA);
            PG8_BAR; PG8_WAIT_L(0); PG8_MMA(1, 0, At, B0); PG8_BAR; PG8_SCHED;
            PG8_STAGE(PG8_SB(0, 1), b2 + hstep, voffB);
            PG8_WAIT_V(6); PG8_BAR; PG8_MMA(1, 1, At, B1); PG8_BAR;
            PG8_LDB(B0, 1, 0); PG8_SCHED; PG8_LDA(At, 1, 0); PG8_STAGE(PG8_SA(0, 1), a2 + hstep, voffA);
            PG8_WAIT_L(8); PG8_BAR; PG8_WAIT_L(0); PG8_MMA(0, 0, At, B0); PG8_BAR; PG8_SCHED;
            PG8_LDB(B1, 1, 1); PG8_STAGE(PG8_SB(1, 0), b3, voffB);
            PG8_BAR; PG8_WAIT_L(0); PG8_MMA(0, 1, At, B1); PG8_BAR;
            PG8_LDA(At, 1, 1); PG8_STAGE(PG8_SA(1, 0), a3, voffA);
            PG8_BAR; PG8_WAIT_L(0); PG8_MMA(1, 0, At, B0); PG8_BAR; PG8_SCHED;
            PG8_STAGE(PG8_SB(1, 1), b3 + hstep, voffB);
            PG8_WAIT_V(6); PG8_BAR; PG8_MMA(1, 1, At, B1); PG8_BAR;
            }
        }
        if constexpr (ALIGN_EPI) { if (wr == 0) PG8_BAR; }
#if PROBE_ON && !PROBE_SKINNY
        const unsigned pe0_ = (unsigned)__builtin_amdgcn_s_memrealtime();
#endif
        if constexpr (!Epi::AFTER_DRAIN) { E(acc, cur, wr, wc, fr, fq); S.done(cur); }
#if PROBE_ON && !PROBE_SKINNY
        if (threadIdx.x == 0) { *(volatile PG8_LAS unsigned*)(lds + 131072 + 320 + 4 * 18) += (unsigned)__builtin_amdgcn_s_memrealtime() - pe0_; }
#endif
        if (!has_next) break;
#pragma unroll
        for (int a = 0; a < 2; ++a)
#pragma unroll
            for (int b = 0; b < 2; ++b)
#pragma unroll
                for (int m = 0; m < 4; ++m)
#pragma unroll
                    for (int n = 0; n < 2; ++n) acc[a][b][m][n] = (f32x4){0.f, 0.f, 0.f, 0.f};
        cur = nxt; cA = nA; cB = nB; ++ui;
        if constexpr (ALIGN_EPI) { if (wr == 1) PG8_BAR; }
    }
    PG8_WAIT_V(0);
    if constexpr (!ALIGN_EPI) { if (wr == 0) PG8_BAR; }
    PG8_BAR;
    if constexpr (Epi::AFTER_DRAIN) { E.fused(acc, cur, wr, wc, fr, fq, lds, wid, lane); S.done(cur); }
#undef PG8_SA
#undef PG8_SB
#undef PG8_STAGE
#undef PG8_LDA
#undef PG8_LDB
#undef PG8_MMA
#undef PG8_WAIT_V
#undef PG8_WAIT_L
#undef PG8_BAR
#undef PG8_SCHED
}
}


constexpr int DM = 1024, NB = 8, SEQ = 2048, NDEC = 128, MPROMPT = NB * SEQ, MTOT = MPROMPT + NDEC, MP = 16640  ;
constexpr int HR = 4, DKR = 128, DVR = 256, HG = 8, DKG = 128, DVG = 128, DFF = 4096, DPLE = 256, DIN = 9216, CH = 64, NCHUNK = MPROMPT / CH;
constexpr float EPS = 1e-6f;
constexpr size_t OFF_Y = 0, OFF_RETP = (size_t)MTOT * DM, OFF_HGP = OFF_RETP + (size_t)NB * HR * DKR * DVR, OFF_RETS = OFF_HGP + (size_t)NB * HG * DKG * DVG,
                 OFF_HGS = OFF_RETS + (size_t)NDEC * HR * DKR * DVR, OUT_TOTAL = OFF_HGS + (size_t)NDEC * HG * DKG * DVG;
static_assert(OUT_TOTAL == 52559872, "output size");


constexpr int NWAVES = 8;
constexpr int NPH = 10;
#ifndef MK_ONE_LAUNCH
#define MK_ONE_LAUNCH 1
#endif

constexpr size_t MiB = 1u << 20;
constexpr size_t WS_CTL = 0, CTL_ZERO_BYTES = 1 * MiB;
constexpr size_t WS_WIN = 1 * MiB;
constexpr size_t WS_WUPR = WS_WIN + (size_t)DIN * DM * 2;
constexpr size_t WS_WUPH = WS_WUPR + (size_t)DM * DM * 2;
constexpr size_t WS_WO = WS_WUPH + (size_t)DM * DM * 2;
constexpr size_t WS_WFF1 = WS_WO + (size_t)DM * DM * 2;
constexpr size_t WS_WFF2 = WS_WFF1 + (size_t)DFF * DM * 2;
constexpr size_t WS_WGATE = WS_WFF2 + (size_t)DFF * DM * 2;
constexpr size_t WS_WPROJ = WS_WGATE + (size_t)DM * DM * 2;
constexpr size_t WS_Z6 = WS_WPROJ + (size_t)DM * DPLE * 2;
constexpr size_t Z_QR = WS_Z6, Z_KR = Z_QR + (size_t)MP * 512 * 2, Z_VR = Z_KR + (size_t)MP * 512 * 2, Z_QG = Z_VR + (size_t)MP * DM * 2, Z_KG = Z_QG + (size_t)MP * DM * 2,
                 Z_VG = Z_KG + (size_t)MP * DM * 2, Z_END = Z_VG + (size_t)MP * DM * 2;
constexpr size_t WS_H = WS_Z6, WS_MB = WS_Z6 + (size_t)MP * DFF * 2;
static_assert(WS_MB == Z_VG, "MB overlays VG exactly");
constexpr size_t WS_GR = Z_END, WS_GG = WS_GR + (size_t)MP * DM * 2, WS_A5 = WS_GR, WS_A7 = WS_GG;
constexpr size_t WS_PB = WS_GG + (size_t)MP * DM * 2;
constexpr size_t WS_CS = WS_PB + (size_t)MP * DPLE * 2;
constexpr size_t WS_GL = WS_CS + (size_t)2049 * 64 * 8;
constexpr size_t WS_FS = WS_GL + (size_t)NCHUNK * DM * 4;
constexpr size_t WS_RSTD0 = WS_FS + (size_t)NDEC * DM * 4;
constexpr size_t WS_LB = WS_RSTD0 + (size_t)MP * 4;
constexpr size_t WS_PS1 = WS_LB + 4096, WS_PS2 = WS_PS1 + (size_t)MP * 64, WS_PS3 = WS_PS2 + (size_t)MP * 64, WS_PSS1 = WS_PS3 + (size_t)MP * 64, WS_PSS2 = WS_PSS1 + (size_t)NDEC * 256, WS_PSS3 = WS_PSS2 + (size_t)NDEC * 256, WS_END = WS_PSS3 + (size_t)NDEC * 256;
static_assert(WS_END <= 307920896, "d_ws map must fit sum(inputs) bytes");
static_assert(WS_WIN % 256 == 0 && WS_Z6 % 256 == 0 && WS_GR % 256 == 0 && WS_PB % 256 == 0 && WS_CS % 16 == 0 && WS_GL % 16 == 0 && WS_PS1 % 16 == 0, "alignment");
constexpr int CW_TMO = 0, CW_BAR = 4096;

constexpr int RING_OFF = 0, RING_BYTES = 131072;
constexpr int LDSCTL_OFF = RING_BYTES, MISC_OFF = LDSCTL_OFF + 320;
constexpr int LDS_BYTES = 147456;


namespace pg8 {
typedef unsigned u32x2 __attribute__((ext_vector_type(2)));
typedef float f32x2 __attribute__((ext_vector_type(2)));
__device__ __forceinline__ float bf2f(unsigned short b) { return __uint_as_float((unsigned)b << 16); }
__device__ __forceinline__ float bflo(unsigned w) { return __uint_as_float(w << 16); }
__device__ __forceinline__ float bfhi(unsigned w) { return __uint_as_float(w & 0xffff0000u); }
__device__ __forceinline__ float sigmoidf_(float x) { return 1.0f / (1.0f + __expf(-x)); }
__device__ __forceinline__ float siluf_(float x) { return x / (1.0f + __expf(-x)); }
__device__ __forceinline__ u32x2 pack4(f32x4 v) { u32x2 w; w.x = cvt_pk_bf16(v[0], v[1]); w.y = cvt_pk_bf16(v[2], v[3]); return w; }
__device__ __forceinline__ f32x4 unpack4(u32x2 w) { return (f32x4){bflo(w.x), bfhi(w.x), bflo(w.y), bfhi(w.y)}; }

typedef unsigned u32x4 __attribute__((ext_vector_type(4)));
#define DPP_ROW_SHR(x, n) __int_as_float(__builtin_amdgcn_update_dpp(0, __float_as_int(x), 0x110 + (n), 0xf, 0xf, true))
#define DPP_ROW_SHR1(x, n) __int_as_float(__builtin_amdgcn_update_dpp(0x3f800000, __float_as_int(x), 0x110 + (n), 0xf, 0xf, false))
#define DPP_ROW_BCAST15(x) __int_as_float(__builtin_amdgcn_update_dpp(0, __float_as_int(x), 0x15F, 0xf, 0xf, false))
struct EpiIn {
    static constexpr bool PERM = true, AFTER_DRAIN = false;
    const float* rstd0; const float* cs; const float* lb;
    bf16_t *QR, *KR, *VR, *GR, *QG, *KG, *VG, *GG, *AR, *AH; float *GL, *FS; unsigned char* wsb; unsigned char* outb;
    __device__ __forceinline__ void operator()(const f32x4 (&acc)[2][2][4][2], const Unit& u, int wr, int wc, int fr, int fq) const {
        const int pn = u.pn;
#pragma unroll
        for (int ai = 0; ai < 2; ++ai) {
            const int rbase = u.pm * BM + ai * HALF + wr * 64;
            float rs[4];
#pragma unroll
            for (int m = 0; m < 4; ++m) rs[m] = rstd0[rbase + m * 16 + fr];
            if (pn < 4) {
                const bool isk = pn >= 2; bf16_t* dst = isk ? KR : QR;
#pragma unroll
                for (int bj = 0; bj < 2; ++bj) {
                    const int head = 2 * (pn & 1) + bj;
                    const float lg = __logf(1.0f - exp2f(-5.0f - (float)head));
                    const int j0 = 16 * wc + 4 * fq;
#pragma unroll
                    for (int m = 0; m < 4; ++m) {
                        const int row = rbase + m * 16 + fr; const int pidx = row & (SEQ - 1);
                        const float e = lg * (float)(m * 16 + fr + 1);
                        const float sc = rs[m] * (isk ? 0.08838834764831845f * __expf(-e) : __expf(e));
                        const f32x4 t0 = *(const f32x4*)(cs + ((size_t)pidx * 64 + j0) * 2), t1 = *(const f32x4*)(cs + ((size_t)pidx * 64 + j0 + 2) * 2);
                        const f32x4 v0 = acc[ai][bj][m][0] * sc, v1 = acc[ai][bj][m][1] * sc;
                        u32x2 o1, o2;
                        o1.x = cvt_pk_bf16(v0[0] * t0[0] - v0[1] * t0[1], v0[2] * t0[2] - v0[3] * t0[3]); o1.y = cvt_pk_bf16(v1[0] * t1[0] - v1[1] * t1[1], v1[2] * t1[2] - v1[3] * t1[3]);
                        o2.x = cvt_pk_bf16(v0[0] * t0[1] + v0[1] * t0[0], v0[2] * t0[3] + v0[3] * t0[2]); o2.y = cvt_pk_bf16(v1[0] * t1[1] + v1[1] * t1[0], v1[2] * t1[3] + v1[3] * t1[2]);
                        bf16_t* p = dst + (size_t)row * 512 + head * 128 + j0;
                        *(u32x2*)p = o1; *(u32x2*)(p + 64) = o2;
                    }
                }
            } else if (pn >= 12 && pn < 20) {
                const int head = pn - 12;
#pragma unroll
                for (int bj = 0; bj < 2; ++bj) {
                    const int j0 = 64 * bj + 16 * wc + 4 * fq, c = head * 128 + j0;
                    const f32x4 lbv = *(const f32x4*)(lb + c);
                    float qa[4][4], ka[4][4], ba[4][4];
#pragma unroll
                    for (int q = 0; q < 4; ++q) {
                        const int n = q >> 1, e = q & 1; const float one_m_lb = 1.0f - lbv[q]; float carry = 1.f;
#pragma unroll
                        for (int m = 0; m < 4; ++m) {
                            const float vq = acc[ai][bj][m][n][2 * e] * rs[m], vf = acc[ai][bj][m][n][2 * e + 1] * rs[m];
                            const float kk = one_m_lb / (1.0f + __expf(vf));
                            float x = 1.0f - kk;
                            x *= DPP_ROW_SHR1(x, 1); x *= DPP_ROW_SHR1(x, 2); x *= DPP_ROW_SHR1(x, 4); x *= DPP_ROW_SHR1(x, 8);
                            x *= carry; carry = DPP_ROW_BCAST15(x);
                            qa[m][q] = siluf_(vq); ka[m][q] = kk; ba[m][q] = x;
                        }
                    }
#pragma unroll
                    for (int m = 0; m < 4; ++m) {
                        const int row = rbase + m * 16 + fr;
                        const float e0 = ba[m][0], e1 = ba[m][1], e2 = ba[m][2], e3 = ba[m][3];
                        u32x2 qw, kw;
                        qw.x = cvt_pk_bf16(qa[m][0] * e0, qa[m][1] * e1); qw.y = cvt_pk_bf16(qa[m][2] * e2, qa[m][3] * e3);
                        kw.x = cvt_pk_bf16(ka[m][0] * __builtin_amdgcn_rcpf(e0), ka[m][1] * __builtin_amdgcn_rcpf(e1)); kw.y = cvt_pk_bf16(ka[m][2] * __builtin_amdgcn_rcpf(e2), ka[m][3] * __builtin_amdgcn_rcpf(e3));
                        *(u32x2*)(QG + (size_t)row * DM + c) = qw; *(u32x2*)(KG + (size_t)row * DM + c) = kw;
                        if (m == 3 && fr == 15) *(f32x4*)(GL + (size_t)(row >> 6) * DM + c) = (f32x4){e0, e1, e2, e3};
                    }
                }
            } else {
                const int mode = pn >= 28 ? 2 : 0, cbase = (pn & 3) * BM;
                const size_t boff = pn < 8 ? Z_VR : pn < 12 ? WS_GR : pn < 24 ? Z_VG : pn < 28 ? WS_GG : pn < 32 ? (size_t)0 : (size_t)MTOT * DM * 2;
                bf16_t* dst = (bf16_t*)((pn >= 28 ? outb : wsb) + boff);
#pragma unroll
                for (int m = 0; m < 4; ++m) {
                    const int row = rbase + m * 16 + fr;
#pragma unroll
                    for (int bj = 0; bj < 2; ++bj) {
                        f32x4 v0 = acc[ai][bj][m][0] * rs[m], v1 = acc[ai][bj][m][1] * rs[m];
                        if (mode == 1) { v0[0] = siluf_(v0[0]); v0[1] = siluf_(v0[1]); v0[2] = siluf_(v0[2]); v0[3] = siluf_(v0[3]); v1[0] = siluf_(v1[0]); v1[1] = siluf_(v1[1]); v1[2] = siluf_(v1[2]); v1[3] = siluf_(v1[3]); }
                        else if (mode == 2) { v0[0] = sigmoidf_(v0[0]); v0[1] = sigmoidf_(v0[1]); v0[2] = sigmoidf_(v0[2]); v0[3] = sigmoidf_(v0[3]); v1[0] = sigmoidf_(v1[0]); v1[1] = sigmoidf_(v1[1]); v1[2] = sigmoidf_(v1[2]); v1[3] = sigmoidf_(v1[3]); }
                        const u32x2 a = pack4(v0), b = pack4(v1);
                        *(u32x4*)(dst + (size_t)row * DM + cbase + bj * HALF + wc * 32 + fq * 8) = (u32x4){a.x, a.y, b.x, b.y};
                    }
                }
            }
        }
    }
};

__device__ __forceinline__ void unpack8(u32x4 w, f32x4& a, f32x4& b) { a = (f32x4){bflo(w.x), bfhi(w.x), bflo(w.y), bfhi(w.y)}; b = (f32x4){bflo(w.z), bfhi(w.z), bflo(w.w), bfhi(w.w)}; }
__device__ __forceinline__ u32x4 pack8(f32x4 a, f32x4 b) { const u32x2 x = pack4(a), y = pack4(b); return (u32x4){x.x, x.y, y.x, y.y}; }
__device__ __forceinline__ float sumsq4(f32x4 r) { return (r[0] * r[0] + r[1] * r[1]) + (r[2] * r[2] + r[3] * r[3]); }
template <int MODE> struct EpiN {
    static constexpr bool PERM = true, AFTER_DRAIN = false;
    const bf16_t* gate; bf16_t* out16; int ld16; const float* xp; const float* xs; float* R; const float* g; float* PS; const float* PSin;
    __device__ __forceinline__ void operator()(const f32x4 (&acc)[2][2][4][2], const Unit& u, int wr, int wc, int fr, int fq) const {
#pragma unroll
        for (int ai = 0; ai < 2; ++ai) {
            const int rbase = u.pm * BM + ai * HALF + wr * 64;
#pragma unroll
            for (int m = 0; m < 4; ++m) {
                const int row = rbase + m * 16 + fr;
                float rstd = 1.f;
                if (MODE == 3 || MODE == 4) {
                    const f32x4* p = (const f32x4*)(PSin + (size_t)row * 16); const f32x4 a = p[0], b = p[1], c = p[2], d = p[3];
                    const float s = ((a[0] + a[1]) + (a[2] + a[3])) + ((b[0] + b[1]) + (b[2] + b[3])) + ((c[0] + c[1]) + (c[2] + c[3])) + ((d[0] + d[1]) + (d[2] + d[3]));
                    rstd = rsqrtf(s * (1.0f / 1024.0f) + EPS);
                }
                float ss = 0.f;
#pragma unroll
                for (int bj = 0; bj < 2; ++bj) {
                    const int col = u.pn * BM + bj * HALF + wc * 32 + fq * 8;
                    const f32x4 a0 = acc[ai][bj][m][0], a1 = acc[ai][bj][m][1];
                    if (MODE == 0) { f32x4 g0, g1; unpack8(*(const u32x4*)(gate + (size_t)row * DM + col), g0, g1); *(u32x4*)(out16 + (size_t)row * ld16 + col) = pack8(g0 * a0, g1 * a1); }
                    else if (MODE == 1) { f32x4 g0, g1, t0, t1; unpack8(*(const u32x4*)(gate + (size_t)row * DM + col), g0, g1); u32x4* o = (u32x4*)(out16 + (size_t)row * ld16 + col); unpack8(*o, t0, t1); *o = pack8(t0 + g0 * a0, t1 + g1 * a1); }
                    else if (MODE == 2) {
                        const float* bp = xp + (size_t)row * DM + col;
                        const f32x4 r0 = *(const f32x4*)bp + a0, r1 = *(const f32x4*)(bp + 4) + a1;
                        ss += sumsq4(r0) + sumsq4(r1);
                        *(u32x4*)(out16 + (size_t)row * ld16 + col) = pack8(r0, r1);
                    }
                    else if (MODE == 6) {
                        f32x4 b0, b1; unpack8(*(const u32x4*)(gate + (size_t)row * DM + col), b0, b1);
                        const f32x4 r0 = b0 + a0, r1 = b1 + a1;
                        ss += sumsq4(r0) + sumsq4(r1);
                        *(u32x4*)(out16 + (size_t)row * ld16 + col) = pack8(r0, r1);
                    }
                    else if (MODE == 3) { f32x4 v0 = a0 * rstd, v1 = a1 * rstd;
                        v0[0] = fmaxf(v0[0], 0.f); v0[1] = fmaxf(v0[1], 0.f); v0[2] = fmaxf(v0[2], 0.f); v0[3] = fmaxf(v0[3], 0.f); v1[0] = fmaxf(v1[0], 0.f); v1[1] = fmaxf(v1[1], 0.f); v1[2] = fmaxf(v1[2], 0.f); v1[3] = fmaxf(v1[3], 0.f);
                        *(u32x4*)(out16 + (size_t)row * ld16 + col) = pack8(v0 * v0, v1 * v1); }
                    else if (MODE == 4) { f32x4 v0 = a0 * rstd, v1 = a1 * rstd;
                        v0[0] = sigmoidf_(v0[0]); v0[1] = sigmoidf_(v0[1]); v0[2] = sigmoidf_(v0[2]); v0[3] = sigmoidf_(v0[3]); v1[0] = sigmoidf_(v1[0]); v1[1] = sigmoidf_(v1[1]); v1[2] = sigmoidf_(v1[2]); v1[3] = sigmoidf_(v1[3]);
                        *(u32x4*)(out16 + (size_t)row * ld16 + col) = pack8(v0, v1); }
                    else if (MODE == 5) { f32x4 t0, t1, b0, b1; unpack8(*(const u32x4*)(out16 + (size_t)row * ld16 + col), t0, t1); unpack8(*(const u32x4*)(gate + (size_t)row * DM + col), b0, b1);
                        const f32x4 r0 = b0 + t0 * a0, r1 = b1 + t1 * a1; *(u32x4*)((bf16_t*)R + (size_t)row * DM + col) = pack8(r0, r1); ss += sumsq4(r0) + sumsq4(r1); }
                }
                if (MODE == 2 || MODE == 5 || MODE == 6) { ss += __shfl_xor(ss, 16); ss += __shfl_xor(ss, 32); if (fq == 0) PS[(size_t)row * 16 + u.pn * 4 + wc] = ss; }
            }
        }
    }
};

__device__ __forceinline__ void samp_in(const EpiIn& E, int row, int pcol, f32x4 v) {
    const float rs = E.rstd0[row]; const int pn = __builtin_amdgcn_readfirstlane(pcol >> 8), p = pcol & 255;
    if (pn < 4) {
        const bool isk = pn >= 2; bf16_t* dst = isk ? E.KR : E.QR; const int head = 2 * (pn & 1) + (p >> 7), j = (p & 127) >> 1;
        const f32x4 t = *(const f32x4*)(E.cs + ((size_t)SEQ * 64 + j) * 2);
        v = v * (rs * (isk ? 0.08838834764831845f : 1.0f));
        const float o1a = v[0] * t[0] - v[1] * t[1], o2a = v[0] * t[1] + v[1] * t[0], o1b = v[2] * t[2] - v[3] * t[3], o2b = v[2] * t[3] + v[3] * t[2];
        bf16_t* q = dst + (size_t)row * 512 + head * 128 + j;
        *(unsigned*)q = cvt_pk_bf16(o1a, o1b); *(unsigned*)(q + 64) = cvt_pk_bf16(o2a, o2b);
    } else if (pn >= 12 && pn < 20) {
        const int c = (pn - 12) * 128 + (p >> 1);
        const float k0 = (1.0f - E.lb[c]) / (1.0f + __expf(v[1] * rs)), k1 = (1.0f - E.lb[c + 1]) / (1.0f + __expf(v[3] * rs));
        *(unsigned*)(E.QG + (size_t)row * DM + c) = cvt_pk_bf16(siluf_(v[0] * rs), siluf_(v[2] * rs));
        *(unsigned*)(E.KG + (size_t)row * DM + c) = cvt_pk_bf16(k0, k1);
        *(f32x2*)(E.FS + (size_t)(row - MPROMPT) * DM + c) = (f32x2){1.0f - k0, 1.0f - k1};
    } else {
        v = v * rs;
        const bool sl = false, sg = pn >= 28;
        if (sl) { v[0] = siluf_(v[0]); v[1] = siluf_(v[1]); v[2] = siluf_(v[2]); v[3] = siluf_(v[3]); }
        else if (sg) { v[0] = sigmoidf_(v[0]); v[1] = sigmoidf_(v[1]); v[2] = sigmoidf_(v[2]); v[3] = sigmoidf_(v[3]); }
        const size_t boff = pn < 8 ? Z_VR : pn < 12 ? WS_GR : pn < 24 ? Z_VG : pn < 28 ? WS_GG : pn < 32 ? (size_t)0 : (size_t)MTOT * DM * 2;
        bf16_t* dst = (bf16_t*)((pn >= 28 ? E.outb : E.wsb) + boff);
        *(u32x2*)(dst + (size_t)row * DM + (pn & 3) * BM + p) = pack4(v);
    }
}
template <int MODE> __device__ __forceinline__ void samp_n(const EpiN<MODE>& E, const float* xs, float* PSS, const float* PSSin, int row, int col, f32x4 a) {
    const int rs_ = row - MPROMPT; float rstd = 1.f;
    if (MODE == 3 || MODE == 4) { const f32x4* p = (const f32x4*)(PSSin + (size_t)rs_ * 64); float s = 0.f;
#pragma unroll
        for (int i = 0; i < 16; ++i) { const f32x4 q = p[i]; s += (q[0] + q[1]) + (q[2] + q[3]); }
        rstd = rsqrtf(s * (1.0f / 1024.0f) + EPS); }
    float ss = 0.f;
    if (MODE == 0) { const f32x4 gt = unpack4(*(const u32x2*)(E.gate + (size_t)row * DM + col)); *(u32x2*)(E.out16 + (size_t)row * E.ld16 + col) = pack4(gt * a); }
    else if (MODE == 1) { const f32x4 gt = unpack4(*(const u32x2*)(E.gate + (size_t)row * DM + col)); u32x2* o = (u32x2*)(E.out16 + (size_t)row * E.ld16 + col); const f32x4 t = unpack4(*o); *o = pack4(t + gt * a); }
    else if (MODE == 2) { const f32x4 r = *(const f32x4*)(xs + (size_t)rs_ * DM + col) + a; ss = sumsq4(r); *(u32x2*)(E.out16 + (size_t)row * E.ld16 + col) = pack4(r); }
    else if (MODE == 6) { const f32x4 r = unpack4(*(const u32x2*)(E.gate + (size_t)row * DM + col)) + a; ss = sumsq4(r); *(u32x2*)(E.out16 + (size_t)row * E.ld16 + col) = pack4(r); }
    else if (MODE == 3) { f32x4 v = a * rstd; v[0] = fmaxf(v[0], 0.f); v[1] = fmaxf(v[1], 0.f); v[2] = fmaxf(v[2], 0.f); v[3] = fmaxf(v[3], 0.f); *(u32x2*)(E.out16 + (size_t)row * E.ld16 + col) = pack4(v * v); }
    else if (MODE == 4) { f32x4 v = a * rstd; v[0] = sigmoidf_(v[0]); v[1] = sigmoidf_(v[1]); v[2] = sigmoidf_(v[2]); v[3] = sigmoidf_(v[3]); *(u32x2*)(E.out16 + (size_t)row * E.ld16 + col) = pack4(v); }
    else if (MODE == 5) { const f32x4 t = unpack4(*(const u32x2*)(E.out16 + (size_t)row * E.ld16 + col)), b = unpack4(*(const u32x2*)(E.gate + (size_t)row * DM + col));
        const f32x4 r = b + t * a; *(u32x2*)((bf16_t*)E.R + (size_t)row * DM + col) = pack4(r); ss = sumsq4(r); }
    if (MODE == 2 || MODE == 5 || MODE == 6) { ss += __shfl_xor(ss, 16); ss += __shfl_xor(ss, 32); if ((threadIdx.x & 63) < 16) PSS[(size_t)rs_ * 64 + (col >> 4)] = ss; }
}
}

#define GAS __attribute__((address_space(1)))
#define LAS __attribute__((address_space(3)))
typedef unsigned short bf16;
typedef unsigned v4u __attribute__((ext_vector_type(4)));
typedef float f32x4 __attribute__((ext_vector_type(4)));
typedef short bf16x8 __attribute__((ext_vector_type(8)));
typedef GAS unsigned gu32;
typedef GAS unsigned long long gu64;
#define RLX_AGENT __ATOMIC_RELAXED, __HIP_MEMORY_SCOPE_AGENT
#define LDS_WAIT() asm volatile("s_waitcnt lgkmcnt(0)" ::: "memory")
#define VM_WAIT() asm volatile("s_waitcnt vmcnt(0)" ::: "memory")
__device__ __forceinline__ unsigned long long rt() { return __builtin_amdgcn_s_memrealtime(); }
__device__ __forceinline__ unsigned f2bf(float f) { unsigned u = __builtin_bit_cast(unsigned, f); return (u + 0x7fffu + ((u >> 16) & 1u)) >> 16; }
__device__ __forceinline__ unsigned pk2(float lo, float hi) { return f2bf(lo) | (f2bf(hi) << 16); }

#define XB_TMO      128
#define XB_XCNT(j)  (256  + 64 * (j))
#define XB_XSUB(j)  (1280 + 64 * (j))
#define XB_XGEN(j)  (2304 + 64 * (j))
#define XB_TOP      3328
#define XB_TOPGEN   3392
#define XCD_BAR_WORDS 3456
#define XB_SPIN_CAP (1u << 18)

__device__ __forceinline__ unsigned xb_ld(unsigned* p)              { return __hip_atomic_load(p, __ATOMIC_RELAXED, __HIP_MEMORY_SCOPE_AGENT); }
__device__ __forceinline__ unsigned xb_add(unsigned* p, unsigned v) { return __hip_atomic_fetch_add(p, v, __ATOMIC_RELAXED, __HIP_MEMORY_SCOPE_AGENT); }
__device__ __forceinline__ unsigned xb_xcc_id() { return (unsigned)__builtin_amdgcn_s_getreg((3 << 11) | 20) & 0xFu; }
#define XB_SPIN(cond, bar) do { unsigned _sp = 0; while (cond) { __builtin_amdgcn_s_sleep(1); \
    if ((++_sp & 255u) == 0u) { if (xb_ld(&(bar)[XB_TMO])) break; if (_sp > XB_SPIN_CAP) { atomicAdd(&(bar)[XB_TMO], 1u); break; } } } } while (0)

struct XcdBarrier {
    unsigned* bar; unsigned x;
    volatile LAS unsigned* st;
};

__device__ __forceinline__ XcdBarrier xcd_barrier_post(unsigned* bar, volatile LAS unsigned* st) {
    XcdBarrier b; b.bar = bar; b.x = xb_xcc_id(); b.st = st;
    if (threadIdx.x == 0) (void)xb_add(&bar[XB_XCNT(b.x)], 1u);
    return b;
}
__device__ __forceinline__ void xcd_barrier_complete(unsigned* bar, unsigned x, unsigned& nloc, unsigned& nx) {
    const unsigned G = gridDim.x * gridDim.y * gridDim.z;
    unsigned sum, cnt, mine, sp = 0u;
    for (;;) {
        sum = 0u; cnt = 0u; mine = 0u;
#pragma unroll
        for (unsigned j = 0; j < 16; ++j) { const unsigned c = xb_ld(&bar[XB_XCNT(j)]); sum += c; cnt += (c > 0u) ? 1u : 0u; mine = (j == x) ? c : mine; }
        if (sum == G) break;
        __builtin_amdgcn_s_sleep(1);
        if ((++sp & 255u) == 0u) { if (xb_ld(&bar[XB_TMO])) break; if (sp > XB_SPIN_CAP) { atomicAdd(&bar[XB_TMO], 1u); break; } }
    }
    nloc = mine > 0u ? mine : 1u; nx = cnt > 0u ? cnt : 1u;
}

__device__ __forceinline__ void xcd_barrier(const XcdBarrier& b) {
    asm volatile("s_waitcnt vmcnt(0)" ::: "memory");
    __syncthreads();
    if (threadIdx.x == 0) {
        unsigned* bar = b.bar;
        __builtin_amdgcn_s_waitcnt(0);
        unsigned nloc = b.st[0], nx = b.st[1];
        if (nloc == 0u) { xcd_barrier_complete(bar, b.x, nloc, nx); b.st[0] = nloc; b.st[1] = nx; }
        const unsigned old = xb_add(&bar[XB_XSUB(b.x)], 1u);
        const unsigned gen = old / nloc;
        if (old + 1u == (gen + 1u) * nloc) {
            __builtin_amdgcn_fence(__ATOMIC_RELEASE, "agent");
            asm volatile("s_waitcnt vmcnt(0)" ::: "memory");
            const unsigned og = xb_add(&bar[XB_TOP], 1u);
            const unsigned tg = og / nx;
            if (og + 1u == (tg + 1u) * nx) xb_add(&bar[XB_TOPGEN], 1u);
            else XB_SPIN(xb_ld(&bar[XB_TOPGEN]) == tg, bar);
            __builtin_amdgcn_fence(__ATOMIC_ACQUIRE, "agent");
            xb_add(&bar[XB_XGEN(b.x)], 1u);
            asm volatile("s_waitcnt vmcnt(0)" ::: "memory");
        } else {
            XB_SPIN(xb_ld(&bar[XB_XGEN(b.x)]) == gen, bar);
            __builtin_amdgcn_fence(__ATOMIC_ACQUIRE, "agent");
            asm volatile("s_waitcnt vmcnt(0)" ::: "memory");
        }
    }
    __syncthreads();
}


struct Args { const float* in[21]; float* out; unsigned char* ws; int ph_lo, ph_hi, use_bar, pad; };
struct Frame {
    LAS unsigned char* lds; volatile LAS unsigned* MISC; gu32* ctl;
    int vcu, G;
};
__device__ __forceinline__ int tid_() { int t = threadIdx.x; asm volatile("" : "+v"(t)); return t; }
#define FTID (tid_())
#define FLANE (tid_() & 63)
#define FWAVE (__builtin_amdgcn_readfirstlane(tid_() >> 6))
__device__ __forceinline__ float wave_sum(float v) {
#pragma unroll
    for (int o = 1; o < 64; o <<= 1) v += __shfl_xor(v, o);
    return v;
}
#define LBAR() do { asm volatile("s_waitcnt lgkmcnt(0)" ::: "memory"); __builtin_amdgcn_s_barrier(); asm volatile("" ::: "memory"); } while (0)
__device__ __forceinline__ float bf2f_(unsigned short b) { return __uint_as_float((unsigned)b << 16); }
__device__ __forceinline__ float bflo_(unsigned w) { return __uint_as_float(w << 16); }
__device__ __forceinline__ float bfhi_(unsigned w) { return __uint_as_float(w & 0xffff0000u); }

__device__ __forceinline__ int win_src_col(int np) {
    const int tile = np >> 8, p = np & 255;
    if (tile < 4) { const int base = (tile >> 1) * 512, head = 2 * (tile & 1) + (p >> 7), pp = p & 127; return base + head * 128 + (pp & 1) * 64 + (pp >> 1); }
    if (tile >= 12 && tile < 20) { const int h = tile - 12; return 3072 + (p & 1) * 1024 + h * 128 + (p >> 1); }
    return np;
}
template <bool MAP> __device__ __forceinline__ void p0_transpose_item(const float* W, int K, int N, bf16* WT, LAS float* scr, int item, int lane, const float* gk = nullptr) {
    const int nblk = N / 32, kb = item / nblk, nb = item % nblk, k0 = 64 * kb, n0 = 32 * nb;
    const int srcc = MAP ? win_src_col(n0 + (lane & 31)) : n0 + (lane & 31);
#pragma unroll 8
    for (int i = 0; i < 32; ++i) { const int kk = 2 * i + (lane >> 5); scr[kk * 33 + (lane & 31)] = W[(size_t)(k0 + kk) * N + srcc]; }
    LDS_WAIT(); asm volatile("" ::: "memory");
    const int c = lane & 7;
    f32x4 ga = (f32x4){1.f, 1.f, 1.f, 1.f}, gb = ga;
    if (gk) { ga = *(const f32x4*)(gk + k0 + 8 * c); gb = *(const f32x4*)(gk + k0 + 8 * c + 4); }
#pragma unroll
    for (int j = 0; j < 4; ++j) { const int n = (lane >> 3) + 8 * j; const LAS float* s = scr + (8 * c) * 33 + n;
        v4u o; o.x = pk2(s[0 * 33] * ga.x, s[1 * 33] * ga.y); o.y = pk2(s[2 * 33] * ga.z, s[3 * 33] * ga.w); o.z = pk2(s[4 * 33] * gb.x, s[5 * 33] * gb.y); o.w = pk2(s[6 * 33] * gb.z, s[7 * 33] * gb.w);
        *(GAS v4u*)(WT + (size_t)(n0 + n) * K + k0 + 8 * c) = o; }
    LDS_WAIT(); asm volatile("" ::: "memory");
}
__device__ __forceinline__ void p0_prologue(Frame& F, const Args& a) { const int tid_v = tid_(); const int lane_v = tid_v & 63; const int wave_v = __builtin_amdgcn_readfirstlane(tid_v >> 6); (void)lane_v; (void)wave_v;
    unsigned char* ws = a.ws;
    LAS float* scr = (LAS float*)(F.lds + RING_OFF + wave_v * 16384);
    const int gw = F.vcu * NWAVES + wave_v, NGW = F.G * NWAVES;
    constexpr int I_IN = (DM / 64) * (DIN / 32), I_SQ = (DM / 64) * (DM / 32), I_F1 = (DM / 64) * (DFF / 32), I_F2 = (DFF / 64) * (DM / 32), I_PJ = (DPLE / 64) * (DM / 32);
    constexpr int NITEMS = I_IN + 4 * I_SQ + I_F1 + I_F2 + I_PJ;
    for (int it = gw; it < NITEMS; it += NGW) {
        int r = it;
        if (r < I_IN) { p0_transpose_item<true>(a.in[7], DM, DIN, (bf16*)(ws + WS_WIN), scr, r, lane_v, a.in[6]); continue; } r -= I_IN;
        if (r < I_SQ) { p0_transpose_item<false>(a.in[11], DM, DM, (bf16*)(ws + WS_WUPR), scr, r, lane_v); continue; } r -= I_SQ;
        if (r < I_SQ) { p0_transpose_item<false>(a.in[12], DM, DM, (bf16*)(ws + WS_WUPH), scr, r, lane_v); continue; } r -= I_SQ;
        if (r < I_SQ) { p0_transpose_item<false>(a.in[13], DM, DM, (bf16*)(ws + WS_WO), scr, r, lane_v); continue; } r -= I_SQ;
        if (r < I_SQ) { p0_transpose_item<false>(a.in[18], DM, DM, (bf16*)(ws + WS_WGATE), scr, r, lane_v, a.in[17]); continue; } r -= I_SQ;
        if (r < I_F1) { p0_transpose_item<false>(a.in[15], DM, DFF, (bf16*)(ws + WS_WFF1), scr, r, lane_v, a.in[14]); continue; } r -= I_F1;
        if (r < I_F2) { p0_transpose_item<false>(a.in[16], DFF, DM, (bf16*)(ws + WS_WFF2), scr, r, lane_v); continue; } r -= I_F2;
        p0_transpose_item<false>(a.in[19], DPLE, DM, (bf16*)(ws + WS_WPROJ), scr, r, lane_v);
    }
    bf16* XB = (bf16*)(a.out + OFF_RETS); float* RSTD0 = (float*)(ws + WS_RSTD0); bf16* PB = (bf16*)(ws + WS_PB);
    for (int m = gw; m < MP; m += NGW) {
        GAS unsigned long long* o8 = (GAS unsigned long long*)(XB + (size_t)m * DM) + lane_v;
        GAS unsigned long long* p8 = (GAS unsigned long long*)(PB + (size_t)m * DPLE) + lane_v;
        if (m >= MTOT) {
#pragma unroll
            for (int j = 0; j < 4; ++j) o8[64 * j] = 0ull;
            p8[0] = 0ull; if (lane_v == 0) RSTD0[m] = 0.f; continue;
        }
        const float* xrow = m < MPROMPT ? a.in[0] + (size_t)m * DM : a.in[1] + (size_t)(m - MPROMPT) * DM;
        const float* prow = m < MPROMPT ? a.in[4] + (size_t)m * DPLE : a.in[5] + (size_t)(m - MPROMPT) * DPLE;
        const GAS f32x4* xr = (const GAS f32x4*)xrow + lane_v;
        f32x4 v[4]; float s = 0.f;
#pragma unroll
        for (int j = 0; j < 4; ++j) { v[j] = xr[64 * j]; s += (v[j].x * v[j].x + v[j].y * v[j].y) + (v[j].z * v[j].z + v[j].w * v[j].w); }
        s = wave_sum(s);
        if (lane_v == 0) RSTD0[m] = rsqrtf(s * (1.0f / DM) + EPS);
#pragma unroll
        for (int j = 0; j < 4; ++j) o8[64 * j] = (unsigned long long)pk2(v[j].x, v[j].y) | ((unsigned long long)pk2(v[j].z, v[j].w) << 32);
        const f32x4 pv = *((const GAS f32x4*)prow + lane_v);
        p8[0] = (unsigned long long)pk2(pv.x, pv.y) | ((unsigned long long)pk2(pv.z, pv.w) << 32);
    }
    float* CS = (float*)(ws + WS_CS); float* LB = (float*)(ws + WS_LB);
    const int gt = (F.vcu * NWAVES + wave_v) * 64 + lane_v, NGT = NGW * 64;
    for (int i = gt; i < 2049 * 64; i += NGT) {
        const int pi = i >> 6, j = i & 63; const double pos = pi == SEQ ? 16384.0 : (double)pi;
        const double ang = pos * pow(10000.0, -(double)j / 64.0);
        CS[2 * i] = (float)cos(ang); CS[2 * i + 1] = (float)sin(ang);
    }
    for (int i = gt; i < DM; i += NGT) { const float a0 = a.in[10][i], a1 = a.in[10][DM + i]; LB[i] = 1.0f / (1.0f + expf(a1 - a0)); }
}

typedef float f32x16 __attribute__((ext_vector_type(16)));
typedef short v4i16_t __attribute__((ext_vector_type(4)));
typedef unsigned u32x2 __attribute__((ext_vector_type(2)));
typedef float f32x2_t __attribute__((ext_vector_type(2))); typedef __bf16 bf16x2_t __attribute__((ext_vector_type(2)));
__device__ __forceinline__ unsigned cvtpk_s(float lo, float hi) { f32x2_t v = {lo, hi}; bf16x2_t b = __builtin_convertvector(v, bf16x2_t); return __builtin_bit_cast(unsigned, b); }
__device__ __forceinline__ unsigned off_b(unsigned row, unsigned ch) { return 256u * row + 16u * (ch ^ (((row & 3) << 2) | ((row >> 2) & 3))); }
__device__ __forceinline__ bf16x8 rd_row(LAS unsigned char* img, unsigned row, unsigned ks, unsigned h) { return *(const LAS bf16x8*)(img + off_b(row, 2 * ks + h)); }
__device__ __forceinline__ bf16x8 rd_tr(LAS unsigned char* img, unsigned lane, unsigned c, unsigned ks) {
    const unsigned h = lane >> 5, blk = (lane >> 4) & 1, q = (lane & 15) >> 2, p = lane & 3;
    const unsigned a0 = off_b(16 * ks + 8 * h + q, 4 * c + 2 * blk + (p >> 1)) + 8 * (p & 1);
    const unsigned a1 = off_b(16 * ks + 8 * h + 4 + q, 4 * c + 2 * blk + (p >> 1)) + 8 * (p & 1);
    const v4i16_t lo = __builtin_amdgcn_ds_read_tr16_b64_v4i16((LAS v4i16_t*)(img + a0));
    const v4i16_t hi = __builtin_amdgcn_ds_read_tr16_b64_v4i16((LAS v4i16_t*)(img + a1));
    return __builtin_shufflevector(lo, hi, 0, 1, 2, 3, 4, 5, 6, 7);
}
#define MFMA32(a, b, c) __builtin_amdgcn_mfma_f32_32x32x16_bf16((a), (b), (c), 0, 0, 0)
__device__ __forceinline__ void scan_item(Frame& F, const Args& a, int item) { const int tid_v = tid_(); const int lane_v = tid_v & 63; const int wave_v = __builtin_amdgcn_readfirstlane(tid_v >> 6); (void)lane_v; (void)wave_v;
    unsigned char* ws = a.ws;
    const bool isg = item >= 128; const int it = isg ? item - 128 : item;
    int b, hd, dv0, ldq; const bf16 *Qp, *Kp; bf16* Vp; float* Sout; const float* GLp = nullptr; float sdec = 1.f;
    if (!isg) { b = it >> 4; hd = (it >> 2) & 3; dv0 = (it & 3) * 64; ldq = 512;
        Qp = (const bf16*)(ws + Z_QR) + hd * 128; Kp = (const bf16*)(ws + Z_KR) + hd * 128; Vp = (bf16*)(ws + Z_VR) + hd * 256 + dv0;
        Sout = a.out + OFF_RETP + ((size_t)(b * HR + hd) * DKR) * DVR + dv0; sdec = __expf(64.0f * __logf(1.0f - exp2f(-5.0f - (float)hd))); }
    else { b = it >> 4; hd = (it >> 1) & 7; dv0 = (it & 1) * 64; ldq = 1024;
        Qp = (const bf16*)(ws + Z_QG) + hd * 128; Kp = (const bf16*)(ws + Z_KG) + hd * 128; Vp = (bf16*)(ws + Z_VG) + hd * 128 + dv0;
        Sout = a.out + OFF_HGP + ((size_t)(b * HG + hd) * DKG) * DVG + dv0; GLp = (const float*)(ws + WS_GL) + hd * 128; }
    const int ldo = isg ? DVG : DVR;
    LAS unsigned char* QI = F.lds; LAS unsigned char* KI = QI + 16384; LAS unsigned char* VI = KI + 16384; LAS unsigned char* PI = VI + 16384; LAS unsigned char* SI = PI + 16384;
    LAS unsigned char* OI = SI + 16384;
    const int tid = tid_v, lane = lane_v, w = wave_v; const unsigned r = lane & 31, h = lane >> 5;
    const int kb = w >> 1, dvb = w & 1;
    for (int i = tid; i < 16384 / 4; i += 512) ((LAS unsigned*)SI)[i] = 0u;
    f32x16 S;
#pragma unroll
    for (int i = 0; i < 16; ++i) S[i] = 0.f;
    const int qr0 = tid >> 4, qc0 = tid & 15, vr0 = tid >> 3, vc0 = tid & 7;
    const size_t rowb = (size_t)b * SEQ;
    v4u pq0, pq1, pk0, pk1, pv; f32x4 gn0, gn1, gn2, gn3;
    const float* glb = isg ? GLp + (size_t)b * (SEQ / CH) * DM + 32 * kb + 4 * h : nullptr;
#define SCAN_LOAD(c) do { const size_t r0_ = rowb + (size_t)(c) * CH; \
        pq0 = *(const v4u*)(Qp + (r0_ + qr0) * ldq + qc0 * 8); pq1 = *(const v4u*)(Qp + (r0_ + qr0 + 32) * ldq + qc0 * 8); \
        pk0 = *(const v4u*)(Kp + (r0_ + qr0) * ldq + qc0 * 8); pk1 = *(const v4u*)(Kp + (r0_ + qr0 + 32) * ldq + qc0 * 8); \
        pv = *(const v4u*)(Vp + (r0_ + vr0) * DM + vc0 * 8); \
        if (isg) { const float* g_ = glb + (size_t)(c) * DM; gn0 = *(const f32x4*)g_; gn1 = *(const f32x4*)(g_ + 8); gn2 = *(const f32x4*)(g_ + 16); gn3 = *(const f32x4*)(g_ + 24); } } while (0)
    gn0 = gn1 = gn2 = gn3 = (f32x4){sdec, sdec, sdec, sdec};
    SCAN_LOAD(0);
    const unsigned oi_off = (unsigned)(vr0 * 128 + 16 * (vc0 ^ (vr0 & 7)));
    for (int c = 0; c < SEQ / CH; ++c) {
        LBAR();
        if (c > 0) *(v4u*)(Vp + (rowb + (size_t)(c - 1) * CH + vr0) * DM + vc0 * 8) = *(const LAS v4u*)(OI + oi_off);
        *(LAS v4u*)(QI + off_b(qr0, qc0)) = pq0; *(LAS v4u*)(QI + off_b(qr0 + 32, qc0)) = pq1;
        *(LAS v4u*)(KI + off_b(qr0, qc0)) = pk0; *(LAS v4u*)(KI + off_b(qr0 + 32, qc0)) = pk1;
        *(LAS v4u*)(VI + off_b(vr0, vc0)) = pv;
        const f32x4 g0 = gn0, g1 = gn1, g2 = gn2, g3 = gn3;
        if (c > 0) {
#pragma unroll
            for (int g = 0; g < 4; ++g) { u32x2 wv; wv.x = cvtpk_s(S[4 * g], S[4 * g + 1]); wv.y = cvtpk_s(S[4 * g + 2], S[4 * g + 3]);
                *(LAS u32x2*)(SI + off_b(32 * dvb + r, 4 * kb + g) + 8 * h) = wv; }
        }
        if (c + 1 < SEQ / CH) SCAN_LOAD(c + 1);
        LBAR();
        {
            bf16x8 A[4], B[4];
#pragma unroll
            for (int ks = 0; ks < 4; ++ks) { A[ks] = rd_tr(KI, lane, kb, ks); B[ks] = rd_tr(VI, lane, dvb, ks); }
            __builtin_amdgcn_sched_barrier(0);
            f32x16 d;
#pragma unroll
            for (int i = 0; i < 16; ++i) d[i] = 0.f;
#pragma unroll
            for (int ks = 0; ks < 4; ++ks) d = MFMA32(A[ks], B[ks], d);
#pragma unroll
            for (int i = 0; i < 4; ++i) { S[i] = g0[i] * (S[i] + d[i]); S[4 + i] = g1[i] * (S[4 + i] + d[4 + i]); S[8 + i] = g2[i] * (S[8 + i] + d[8 + i]); S[12 + i] = g3[i] * (S[12 + i] + d[12 + i]); }
        }
        if (w < 3) {
            const int sb = w >> 1, tb = (w + 1) >> 1;
            bf16x8 A[8], B[8];
#pragma unroll
            for (int ks = 0; ks < 8; ++ks) { A[ks] = rd_row(KI, 32 * sb + r, ks, h); B[ks] = rd_row(QI, 32 * tb + r, ks, h); }
            __builtin_amdgcn_sched_barrier(0);
            f32x16 p;
#pragma unroll
            for (int i = 0; i < 16; ++i) p[i] = 0.f;
#pragma unroll
            for (int ks = 0; ks < 8; ++ks) p = MFMA32(A[ks], B[ks], p);
#pragma unroll
            for (int g = 0; g < 4; ++g) {
                float v[4];
#pragma unroll
                for (int i = 0; i < 4; ++i) { const int sl = 8 * g + 4 * (int)h + i; v[i] = (sb != tb || sl <= (int)r) ? p[4 * g + i] : 0.f; }
                u32x2 wv; wv.x = cvtpk_s(v[0], v[1]); wv.y = cvtpk_s(v[2], v[3]);
                *(LAS u32x2*)(PI + off_b(32 * tb + r, 4 * sb + g) + 8 * h) = wv;
            }
        }
        LBAR();
        if (w < 4) {
            const int ob = w >> 1, tb = w & 1;
            f32x16 o;
#pragma unroll
            for (int i = 0; i < 16; ++i) o[i] = 0.f;
            {   bf16x8 A[4], B[4];
#pragma unroll
                for (int ks = 0; ks < 4; ++ks) { A[ks] = rd_tr(VI, lane, ob, ks); B[ks] = rd_row(PI, 32 * tb + r, ks, h); }
                __builtin_amdgcn_sched_barrier(0);
#pragma unroll
                for (int ks = 0; ks < 4; ++ks) if (ks < 2 || tb == 1) o = MFMA32(A[ks], B[ks], o); }
            {   bf16x8 A[8], B[8];
#pragma unroll
                for (int ks = 0; ks < 8; ++ks) { A[ks] = rd_row(SI, 32 * ob + r, ks, h); B[ks] = rd_row(QI, 32 * tb + r, ks, h); }
                __builtin_amdgcn_sched_barrier(0);
#pragma unroll
                for (int ks = 0; ks < 8; ++ks) o = MFMA32(A[ks], B[ks], o); }
#pragma unroll
            for (int g = 0; g < 4; ++g) { u32x2 wv; wv.x = cvtpk_s(o[4 * g], o[4 * g + 1]); wv.y = cvtpk_s(o[4 * g + 2], o[4 * g + 3]);
                const unsigned t_ = 32 * tb + r, ch_ = 4 * ob + g; *(LAS u32x2*)(OI + t_ * 128 + 16 * (ch_ ^ (t_ & 7)) + 8 * h) = wv; }
        }
    }
#undef SCAN_LOAD
    LBAR();
    *(v4u*)(Vp + (rowb + (size_t)(SEQ / CH - 1) * CH + vr0) * DM + vc0 * 8) = *(const LAS v4u*)(OI + oi_off);
#pragma unroll
    for (int i = 0; i < 16; ++i) { const int k = 32 * kb + (i & 3) + 8 * (i >> 2) + 4 * (int)h; Sout[(size_t)k * ldo + 32 * dvb + r] = S[i]; }
    __syncthreads();
}

__device__ __forceinline__ void decode_ret(Frame& F, const Args& a, int item) { const int tid_v = tid_(); const int lane_v = tid_v & 63; const int wave_v = __builtin_amdgcn_readfirstlane(tid_v >> 6); (void)lane_v; (void)wave_v;
    unsigned char* ws = a.ws; const int n = item >> 2, h = item & 3, row = MPROMPT + n;
    LAS float* qs = (LAS float*)(F.lds); LAS float* ks = qs + 128; LAS float* red = ks + 128;
    LAS float* part = red + 8 * 256;
    const int tid = tid_v, lane = lane_v, w = wave_v;
    if (tid < 128) qs[tid] = bf2f_(((const bf16*)(ws + Z_QR))[(size_t)row * 512 + h * 128 + tid]);
    else if (tid < 256) ks[tid - 128] = bf2f_(((const bf16*)(ws + Z_KR))[(size_t)row * 512 + h * 128 + tid - 128]);
    const unsigned long long vw = *(const unsigned long long*)((const bf16*)(ws + Z_VR) + (size_t)row * DM + h * 256 + 4 * lane);
    const f32x4 v = (f32x4){bflo_((unsigned)vw), bfhi_((unsigned)vw), bflo_((unsigned)(vw >> 32)), bfhi_((unsigned)(vw >> 32))};
    const float gam = 1.0f - exp2f(-5.0f - (float)h);
    LBAR();
    const float* S0 = a.in[2] + ((size_t)(n * HR + h) * DKR) * DVR; float* S1 = a.out + OFF_RETS + ((size_t)(n * HR + h) * DKR) * DVR;
    f32x4 o = (f32x4){0.f, 0.f, 0.f, 0.f};
    f32x4 s[16];
#pragma unroll
    for (int i = 0; i < 16; ++i) s[i] = *(const f32x4*)(S0 + (size_t)(w + 8 * i) * DVR + 4 * lane);
#pragma unroll
    for (int i = 0; i < 16; ++i) { const int k = w + 8 * i; const f32x4 sn = s[i] * gam + v * ks[k]; *(f32x4*)(S1 + (size_t)k * DVR + 4 * lane) = sn; o += sn * qs[k]; }
    *(LAS f32x4*)(red + w * 256 + 4 * lane) = o;
    LBAR();
    float ov = 0.f;
    if (tid < 256) {
#pragma unroll
        for (int i = 0; i < 8; ++i) ov += red[i * 256 + tid];
        const float ss = wave_sum(ov * ov); if (lane == 0) part[w] = ss;
    }
    LBAR();
    if (tid < 256) {
        const float rstd = rsqrtf(((part[0] + part[1]) + (part[2] + part[3])) * (1.0f / DVR) + EPS);
        bf16* gp = (bf16*)(ws + WS_GR) + (size_t)row * DM + h * 256 + tid;
        const float gv_ = bf2f_(*gp); *gp = (bf16)f2bf(ov * rstd * a.in[8][h * 256 + tid] * (gv_ / (1.0f + __expf(-gv_))));
    }
    LBAR();
}
__device__ __forceinline__ void decode_hg(Frame& F, const Args& a, int item) { const int tid_v = tid_(); const int lane_v = tid_v & 63; const int wave_v = __builtin_amdgcn_readfirstlane(tid_v >> 6); (void)lane_v; (void)wave_v;
    unsigned char* ws = a.ws; const int n = item >> 3, h = item & 7, row = MPROMPT + n;
    LAS float* qs = (LAS float*)(F.lds); LAS float* ks = qs + 128; LAS float* fs = ks + 128; LAS float* red = fs + 128;
    LAS float* part = red + 16 * 128;
    const int tid = tid_v, lane = lane_v, w = wave_v, l32 = lane & 31, half = lane >> 5;
    if (tid < 128) qs[tid] = bf2f_(((const bf16*)(ws + Z_QG))[(size_t)row * DM + h * 128 + tid]);
    else if (tid < 256) ks[tid - 128] = bf2f_(((const bf16*)(ws + Z_KG))[(size_t)row * DM + h * 128 + tid - 128]);
    else if (tid < 384) fs[tid - 256] = ((const float*)(ws + WS_FS))[(size_t)n * DM + h * 128 + tid - 256];
    const unsigned long long vw = *(const unsigned long long*)((const bf16*)(ws + Z_VG) + (size_t)row * DM + h * 128 + 4 * l32);
    const f32x4 v = (f32x4){bflo_((unsigned)vw), bfhi_((unsigned)vw), bflo_((unsigned)(vw >> 32)), bfhi_((unsigned)(vw >> 32))};
    LBAR();
    const float* S0 = a.in[3] + ((size_t)(n * HG + h) * DKG) * DVG; float* S1 = a.out + OFF_HGS + ((size_t)(n * HG + h) * DKG) * DVG;
    f32x4 o = (f32x4){0.f, 0.f, 0.f, 0.f};
    f32x4 s[8];
#pragma unroll
    for (int i = 0; i < 8; ++i) s[i] = *(const f32x4*)(S0 + (size_t)(2 * (w + 8 * i) + half) * DVG + 4 * l32);
#pragma unroll
    for (int i = 0; i < 8; ++i) { const int k = 2 * (w + 8 * i) + half; const f32x4 sn = s[i] * fs[k] + v * ks[k]; *(f32x4*)(S1 + (size_t)k * DVG + 4 * l32) = sn; o += sn * qs[k]; }
    *(LAS f32x4*)(red + (2 * w + half) * 128 + 4 * l32) = o;
    LBAR();
    float ov = 0.f;
    if (tid < 128) {
#pragma unroll
        for (int i = 0; i < 16; ++i) ov += red[i * 128 + tid];
        const float ss = wave_sum(ov * ov); if (lane == 0) part[w] = ss;
    }
    LBAR();
    if (tid < 128) {
        const float rstd = rsqrtf((part[0] + part[1]) * (1.0f / DVG) + EPS);
        bf16* gp = (bf16*)(ws + WS_GG) + (size_t)row * DM + h * 128 + tid;
        const float gv_ = bf2f_(*gp); *gp = (bf16)f2bf(ov * rstd * a.in[9][h * 128 + tid] * (gv_ / (1.0f + __expf(-gv_))));
    }
    LBAR();
}

__device__ __forceinline__ void p3_headnorm(Frame& F, const Args& a) { const int tid_v = tid_(); const int lane_v = tid_v & 63; const int wave_v = __builtin_amdgcn_readfirstlane(tid_v >> 6); (void)lane_v; (void)wave_v;
    unsigned char* ws = a.ws; const int gw = F.vcu * NWAVES + wave_v, NGW = F.G * NWAVES, lane = lane_v;
    for (int it = gw; it < MPROMPT * 8; it += NGW) {
        const bool isg = it >= MPROMPT * 4; const int i2 = isg ? it - MPROMPT * 4 : it; const int row = i2 >> 2, q = i2 & 3;
        const size_t off = (size_t)row * DM + q * 256 + 4 * lane;
        const unsigned long long ow = *(const unsigned long long*)((const bf16*)(ws + (isg ? Z_VG : Z_VR)) + off);
        unsigned long long* gp = (unsigned long long*)((bf16*)(ws + (isg ? WS_GG : WS_GR)) + off); const unsigned long long gwd = *gp;
        const f32x4 gn = *(const f32x4*)(a.in[isg ? 9 : 8] + q * 256 + 4 * lane);
        const f32x4 o = (f32x4){bflo_((unsigned)ow), bfhi_((unsigned)ow), bflo_((unsigned)(ow >> 32)), bfhi_((unsigned)(ow >> 32))};
        f32x4 gt = (f32x4){bflo_((unsigned)gwd), bfhi_((unsigned)gwd), bflo_((unsigned)(gwd >> 32)), bfhi_((unsigned)(gwd >> 32))};
        gt.x = gt.x / (1.0f + __expf(-gt.x)); gt.y = gt.y / (1.0f + __expf(-gt.y)); gt.z = gt.z / (1.0f + __expf(-gt.z)); gt.w = gt.w / (1.0f + __expf(-gt.w));
        float ss = (o.x * o.x + o.y * o.y) + (o.z * o.z + o.w * o.w);
#pragma unroll
        for (int d = 1; d < 32; d <<= 1) ss += __shfl_xor(ss, d);
        if (!isg) ss += __shfl_xor(ss, 32);
        const float rstd = rsqrtf(ss * (isg ? 1.0f / DVG : 1.0f / DVR) + EPS);
        const f32x4 x = o * rstd * gn * gt;
        *gp = (unsigned long long)pk2(x.x, x.y) | ((unsigned long long)pk2(x.z, x.w) << 32);
    }
}

__device__ __forceinline__ void p9_final(Frame& F, const Args& a) { const int tid_v = tid_(); const int lane_v = tid_v & 63; const int wave_v = __builtin_amdgcn_readfirstlane(tid_v >> 6); (void)lane_v; (void)wave_v;
    const int gw = F.vcu * NWAVES + wave_v, NGW = F.G * NWAVES, lane = lane_v; const float* PS3 = (const float*)(a.ws + WS_PS3); const float* gf = a.in[20];
    for (int m = gw; m < MTOT; m += NGW) {
        const float pv = m < MPROMPT ? (lane < 16 ? PS3[(size_t)m * 16 + lane] : 0.f) : ((const float*)(a.ws + WS_PSS3))[(size_t)(m - MPROMPT) * 64 + lane];
        const float rstd = rsqrtf(wave_sum(pv) * (1.0f / DM) + EPS);
        const unsigned long long* r16 = (const unsigned long long*)((const bf16*)(a.ws + WS_A5) + (size_t)m * DM) + lane;
        f32x4* y = (f32x4*)(a.out + (size_t)m * DM) + lane;
#pragma unroll
        for (int j = 0; j < 4; ++j) { const unsigned long long w = r16[64 * j]; const f32x4 gv = *((const f32x4*)gf + 64 * j + lane);
            y[64 * j] = (f32x4){bflo_((unsigned)w), bfhi_((unsigned)w), bflo_((unsigned)(w >> 32)), bfhi_((unsigned)(w >> 32))} * rstd * gv; }
    }
}

template <int K, class FE> __device__ __forceinline__ void skinny_gemm(Frame& F, const bf16* As, const bf16* Wt, int N, const FE& fe, int it0 = 0, int it1 = 1 << 30) {     const int tid_v = tid_(); const int lane_v = tid_v & 63; const int wave_v = __builtin_amdgcn_readfirstlane(tid_v >> 6); (void)lane_v; (void)wave_v;
    constexpr int KW = K / 4, NKS = KW / 32, CH_KS = NKS < 8 ? NKS : 8, NCH = NKS / CH_KS;
    const int lane = lane_v, fr = lane & 15, fq = lane >> 4, rg = wave_v >> 2, ks = wave_v & 3;
    LAS f32x4* red = (LAS f32x4*)(F.lds);
    const int ntile = 4 * (N / 16);
#if PROBE_ON && PROBE_SKINNY
    const unsigned ps0_ = (unsigned)rt();
#endif
    for (int itn = it0; itn < it1; ++itn) {
        const int tile = F.vcu + itn * F.G; if (tile >= ntile) break;
        const int rb = tile & 3, cb = tile >> 2;
        const bf16* ap = Wt + (size_t)(16 * cb + fr) * K + ks * KW + 8 * fq;
        const bf16* bp = As + (size_t)(32 * rb + 16 * rg + fr) * K + ks * KW + 8 * fq;
        f32x4 acc = (f32x4){0.f, 0.f, 0.f, 0.f};
#pragma unroll 1
        for (int c = 0; c < NCH; ++c) {
            bf16x8 a[CH_KS], b[CH_KS];
#pragma unroll
            for (int i = 0; i < CH_KS; ++i) { a[i] = *(const bf16x8*)(ap + (c * CH_KS + i) * 32); b[i] = *(const bf16x8*)(bp + (c * CH_KS + i) * 32); }
#pragma unroll
            for (int i = 0; i < CH_KS; ++i) acc = __builtin_amdgcn_mfma_f32_16x16x32_bf16(a[i], b[i], acc, 0, 0, 0);
        }
        red[wave_v * 64 + lane] = acc;
        __syncthreads();
        if (ks == 0) {
            const f32x4 v = (red[(4 * rg + 0) * 64 + lane] + red[(4 * rg + 1) * 64 + lane]) + (red[(4 * rg + 2) * 64 + lane] + red[(4 * rg + 3) * 64 + lane]);
            fe(MPROMPT + 32 * rb + 16 * rg + fr, 16 * cb + 4 * fq, v);
        }
        __syncthreads();
    }
#if PROBE_ON && PROBE_SKINNY
    if (threadIdx.x == 0) F.MISC[18] += (unsigned)rt() - ps0_;
#endif
}
struct FeIn { pg8::EpiIn E; __device__ __forceinline__ void operator()(int row, int col, f32x4 v) const { pg8::samp_in(E, row, col, v); } };
template <int MODE> struct FeN { pg8::EpiN<MODE> E; const float* xs; float* PSS; const float* PSSin;
    __device__ __forceinline__ void operator()(int row, int col, f32x4 v) const { pg8::samp_n<MODE>(E, xs, PSS, PSSin, row, col, v); } };

struct PairOrder { pg8::StaticOrder S0;
    __device__ __forceinline__ bool next(int i, pg8::Unit& u) const { pg8::Unit t; if (!S0.next(i >> 1, t)) return false; if ((i & 1) == 0) { u.pm = t.pm + MP / 256; u.pn = t.pn + DM / 256; } else u = t; return true; }
    __device__ __forceinline__ void a_ready(const pg8::Unit&) const {}
    __device__ __forceinline__ void done(const pg8::Unit&) const {} };
struct EpiUp { static constexpr bool PERM = true, AFTER_DRAIN = false; pg8::EpiN<0> E0; pg8::EpiN<1> E1;
    __device__ __forceinline__ void operator()(const f32x4 (&acc)[2][2][4][2], const pg8::Unit& u, int wr, int wc, int fr, int fq) const {
        if (u.pn >= DM / 256) { const pg8::Unit v{u.pm - MP / 256, u.pn - DM / 256}; E0(acc, v, wr, wc, fr, fq); } else E1(acc, u, wr, wc, fr, fq); } };

__global__ void __launch_bounds__(NWAVES * 64, 2) fwd_kernel(Args args) {
#define tid_v ((int)threadIdx.x)
    extern __shared__ __attribute__((aligned(16))) unsigned char lds[];
    Frame F;
    F.lds = (LAS unsigned char*)lds;
    F.MISC = (volatile LAS unsigned*)(F.lds + MISC_OFF);
        F.G = gridDim.x; { const int bx = blockIdx.x; F.vcu = (F.G % 8 == 0) ? (bx % 8) * (F.G / 8) + bx / 8 : bx; }
    unsigned char* ws = args.ws;
    F.ctl = (gu32*)(ws + WS_CTL);
    for (int u = tid_v; u < (LDS_BYTES - LDSCTL_OFF) / 4; u += NWAVES * 64) ((LAS unsigned*)(F.lds + LDSCTL_OFF))[u] = 0u;
    __syncthreads();
    XcdBarrier bar; bar.bar = (unsigned*)(F.ctl + CW_BAR); bar.x = 0; bar.st = nullptr;
    if (args.use_bar) bar = xcd_barrier_post((unsigned*)(F.ctl + CW_BAR), F.MISC + 8);
    const int lo = args.ph_lo, hi = args.ph_hi;
#define IN(k) (lo <= (k) && (k) < hi)
#if PROBE_ON
    volatile LAS unsigned* PW = F.MISC + 16;
    if (tid_v == 0) { PW[0] = (unsigned)rt(); PW[1] = 0u; PW[2] = 0u; }
#define STAMP(k) do { if (blockIdx.x == 0 && tid_v == 0) { const unsigned t_ = (unsigned)rt(); unsigned q_ = (t_ - PW[0] + (unsigned)PROBE_UNIT / 2) / (unsigned)PROBE_UNIT; if (q_ > 49u) q_ = 49u; \
        if ((k) == PROBE_A) PW[1] += q_ * 400u; else if ((k) == PROBE_B) PW[1] += q_ * 20000u; else if (PROBE_E < 0 && (k) == PROBE_C) PW[1] += q_ * 1000000u; \
        if ((k) == PROBE_E) { unsigned e_ = (PW[2] + (unsigned)PROBE_UNIT / 2) / (unsigned)PROBE_UNIT; if (e_ > 49u) e_ = 49u; PW[1] += e_ * 1000000u; } PW[2] = 0u; PW[0] = t_; } } while (0)
#else
#define STAMP(k) do { } while (0)
#endif
#define SEAM(k) do { if (IN(k) && IN((k) + 1)) xcd_barrier(bar); STAMP(k); } while (0)
    using namespace pg8;
    bf16_t* XB = (bf16_t*)(args.out + OFF_RETS);
    bf16_t* AR = (bf16_t*)(args.out + OFF_Y); bf16_t* AH = AR + (size_t)MTOT * DM;
    float* R = args.out + OFF_Y;
    float* PS1 = (float*)(ws + WS_PS1); float* PS2 = (float*)(ws + WS_PS2); float* PS3 = (float*)(ws + WS_PS3);

    if (IN(0)) { p0_prologue(F, args); SEAM(0); }
    const bf16_t* SROW = nullptr; (void)SROW;
    float* PSS1 = (float*)(ws + WS_PSS1); float* PSS2 = (float*)(ws + WS_PSS2); float* PSS3 = (float*)(ws + WS_PSS3);
#define SAMP(buf, ld) ((const bf16*)(buf) + (size_t)MPROMPT * (ld))
    if (IN(1)) {
        Gemm g{XB, (const bf16_t*)(ws + WS_WIN), MPROMPT, DIN, DM}; StaticOrder S; S.init(MPROMPT, DIN, F.G, (int)blockIdx.x);
        EpiIn E{(const float*)(ws + WS_RSTD0), (const float*)(ws + WS_CS), (const float*)(ws + WS_LB),
                (bf16_t*)(ws + Z_QR), (bf16_t*)(ws + Z_KR), (bf16_t*)(ws + Z_VR), (bf16_t*)(ws + WS_GR), (bf16_t*)(ws + Z_QG), (bf16_t*)(ws + Z_KG), (bf16_t*)(ws + Z_VG), (bf16_t*)(ws + WS_GG),
                AR, AH, (float*)(ws + WS_GL), (float*)(ws + WS_FS), ws, (unsigned char*)args.out};
        const int nfirst = (F.vcu & 3) * 3;
        { FeIn fe{E}; skinny_gemm<DM>(F, SAMP(XB, DM), (const bf16*)(ws + WS_WIN), DIN, fe, 0, nfirst); }
        gemm_phase<EpiIn, StaticOrder, true, true>(F.lds + RING_OFF, g, S, E);
        { FeIn fe{E}; skinny_gemm<DM>(F, SAMP(XB, DM), (const bf16*)(ws + WS_WIN), DIN, fe, nfirst); }
        SEAM(1);
    }
    if (IN(2)) {
        const bool dec_first = (F.vcu & 1) != 0;
        if (dec_first) {
            for (int it = F.vcu; it < NDEC * HR; it += F.G) decode_ret(F, args, it);
            for (int it = F.vcu; it < NDEC * HG; it += F.G) decode_hg(F, args, it);
        }
        for (int it = F.vcu; it < 256; it += F.G) scan_item(F, args, it);
#if PROBE_ON
        xcd_barrier(bar); STAMP(10);
#endif
        if (!dec_first) {
            for (int it = F.vcu; it < NDEC * HR; it += F.G) decode_ret(F, args, it);
            for (int it = F.vcu; it < NDEC * HG; it += F.G) decode_hg(F, args, it);
        }
        SEAM(2);
    }
    if (IN(3)) { p3_headnorm(F, args); SEAM(3); }
    if (IN(4)) {
        Gemm g{(const bf16_t*)(ws + WS_GR), (const bf16_t*)(ws + WS_WUPR), 2 * MP, 2 * DM, DM}; PairOrder S; S.S0.init(MPROMPT, DM, F.G, (int)blockIdx.x);
        EpiN<0> E0{AH, (bf16_t*)(ws + WS_MB), DM, nullptr, nullptr, nullptr, nullptr, nullptr, nullptr};
        EpiN<1> E1{AR, (bf16_t*)(ws + WS_MB), DM, nullptr, nullptr, nullptr, nullptr, nullptr, nullptr};
        EpiUp E{E0, E1};
        gemm_phase<EpiUp, PairOrder, true, true>(F.lds + RING_OFF, g, S, E);
        { FeN<0> fe{E0, nullptr, nullptr, nullptr}; skinny_gemm<DM>(F, SAMP(ws + WS_GG, DM), (const bf16*)(ws + WS_WUPH), DM, fe); }
        { FeN<1> fe{E1, nullptr, nullptr, nullptr}; skinny_gemm<DM>(F, SAMP(ws + WS_GR, DM), (const bf16*)(ws + WS_WUPR), DM, fe); }
        SEAM(4);
    }
    if (IN(5)) {
        Gemm g{(const bf16_t*)(ws + WS_MB), (const bf16_t*)(ws + WS_WO), MPROMPT, DM, DM}; StaticOrder S; S.init(MPROMPT, DM, F.G, (int)blockIdx.x);
        EpiN<2> E{nullptr, (bf16_t*)(ws + WS_A5), DM, args.in[0], nullptr, nullptr, nullptr, PS1, nullptr};
        gemm_phase<EpiN<2>, StaticOrder, true, true>(F.lds + RING_OFF, g, S, E);
        FeN<2> fe{E, args.in[1], PSS1, nullptr}; skinny_gemm<DM>(F, SAMP(ws + WS_MB, DM), (const bf16*)(ws + WS_WO), DM, fe);
        SEAM(5);
    }
    if (IN(6)) {
        Gemm g{(const bf16_t*)(ws + WS_A5), (const bf16_t*)(ws + WS_WFF1), MPROMPT, DFF, DM}; StaticOrder S; S.init(MPROMPT, DFF, F.G, (int)blockIdx.x);
        EpiN<3> E{nullptr, (bf16_t*)(ws + WS_H), DFF, nullptr, nullptr, nullptr, nullptr, nullptr, PS1};
        const int nfirst = (F.vcu & 3) + ((F.vcu & 3) == 3 ? 1 : 0); FeN<3> fe{E, nullptr, nullptr, PSS1};
        skinny_gemm<DM>(F, SAMP(ws + WS_A5, DM), (const bf16*)(ws + WS_WFF1), DFF, fe, 0, nfirst);
        gemm_phase<EpiN<3>, StaticOrder, true, true>(F.lds + RING_OFF, g, S, E);
        skinny_gemm<DM>(F, SAMP(ws + WS_A5, DM), (const bf16*)(ws + WS_WFF1), DFF, fe, nfirst);
        SEAM(6);
    }
    if (IN(7)) {
        Gemm g{(const bf16_t*)(ws + WS_H), (const bf16_t*)(ws + WS_WFF2), MPROMPT, DM, DFF}; StaticOrder S; S.init(MPROMPT, DM, F.G, (int)blockIdx.x);
        EpiN<6> E{(const bf16_t*)(ws + WS_A5), (bf16_t*)(ws + WS_A7), DM, nullptr, nullptr, nullptr, nullptr, PS2, nullptr};
        gemm_phase<EpiN<6>, StaticOrder, true, true>(F.lds + RING_OFF, g, S, E);
        FeN<6> fe{E, nullptr, PSS2, nullptr}; skinny_gemm<DFF>(F, SAMP(ws + WS_H, DFF), (const bf16*)(ws + WS_WFF2), DM, fe);
        SEAM(7);
    }
    if (IN(8)) {
        { Gemm g{(const bf16_t*)(ws + WS_A7), (const bf16_t*)(ws + WS_WGATE), MPROMPT, DM, DM}; StaticOrder S; S.init(MPROMPT, DM, F.G, (int)blockIdx.x);
          EpiN<4> E{nullptr, (bf16_t*)(ws + WS_MB), DM, nullptr, nullptr, nullptr, nullptr, nullptr, PS2};
          gemm_phase<EpiN<4>, StaticOrder, true, true>(F.lds + RING_OFF, g, S, E);
          FeN<4> fe{E, nullptr, nullptr, PSS2}; skinny_gemm<DM>(F, SAMP(ws + WS_A7, DM), (const bf16*)(ws + WS_WGATE), DM, fe); }
        { Gemm g{(const bf16_t*)(ws + WS_PB), (const bf16_t*)(ws + WS_WPROJ), MPROMPT, DM, DPLE}; StaticOrder S; S.init(MPROMPT, DM, F.G, (int)blockIdx.x);
          EpiN<5> E{(const bf16_t*)(ws + WS_A7), (bf16_t*)(ws + WS_MB), DM, nullptr, nullptr, (float*)(ws + WS_A5), nullptr, PS3, nullptr};
          gemm_phase<EpiN<5>, StaticOrder, true, true>(F.lds + RING_OFF, g, S, E);
          FeN<5> fe{E, nullptr, PSS3, nullptr}; skinny_gemm<DPLE>(F, SAMP(ws + WS_PB, DPLE), (const bf16*)(ws + WS_WPROJ), DM, fe); }
        SEAM(8);
    }
    if (IN(9)) { p9_final(F, args); }
#if PROBE_ON
    STAMP(9);
    if (blockIdx.x == 0 && tid_v == 0) { const unsigned t0_ = (unsigned)rt(); const unsigned dly_ = PW[1]; while ((unsigned)rt() - t0_ < dly_) __builtin_amdgcn_s_sleep(16); }
#endif
#undef IN
#undef SEAM
#undef tid_v
}

extern "C" void kernel_launch(void* const* d_in, const int* in_sizes, int n_in, void* d_out, int out_size, void* d_ws, size_t ws_size, hipStream_t stream) {
    static int grid = 0;
    if (grid == 0) {
        if (n_in != 21 || out_size != (int)OUT_TOTAL || ws_size < WS_END) { fprintf(stderr, "kernel_launch: unexpected problem (n_in %d out %d ws %zu need %zu)\n", n_in, out_size, ws_size, (size_t)WS_END); grid = -1; return; }
        int dev = 0, cus = 0;
        if (hipGetDevice(&dev) != hipSuccess || hipDeviceGetAttribute(&cus, hipDeviceAttributeMultiprocessorCount, dev) != hipSuccess) { grid = -1; return; }
        if (hipFuncSetAttribute((const void*)fwd_kernel, hipFuncAttributeMaxDynamicSharedMemorySize, LDS_BYTES) != hipSuccess) { fprintf(stderr, "kernel_launch: hipFuncSetAttribute failed\n"); grid = -1; return; }
        (void)hipGetLastError();
        grid = cus;
    }
    if (grid < 0) return;
    (void)hipMemsetAsync((char*)d_ws + WS_CTL, 0, CTL_ZERO_BYTES, stream);
    Args a{};
    for (int i = 0; i < 21; ++i) a.in[i] = (const float*)d_in[i];
    a.out = (float*)d_out; a.ws = (unsigned char*)d_ws;
#if MK_ONE_LAUNCH
    a.ph_lo = 0; a.ph_hi = NPH; a.use_bar = 1;
    hipLaunchKernelGGL(fwd_kernel, dim3(grid), dim3(NWAVES * 64), LDS_BYTES, stream, a);
#else
    for (int p = 0; p < NPH; ++p) { a.ph_lo = p; a.ph_hi = p + 1; a.use_bar = 0; hipLaunchKernelGGL(fwd_kernel, dim3(grid), dim3(NWAVES * 64), LDS_BYTES, stream, a); }
#endif
}
```

```cpp
#include <hip/hip_runtime.h>
#include <cstdio>
#include <cstdint>
#ifndef PROBE_ON
#define PROBE_ON 0
#endif
#define PROBE_UNIT 800ull
#ifndef PROBE_A
#define PROBE_A 0
#define PROBE_B 1
#define PROBE_C 2
#endif
#ifndef PROBE_E
#define PROBE_E -1
#endif
#ifndef PROBE_SKINNY
#define PROBE_SKINNY 0
#endif
namespace pg8 {
#define PG8_LAS __attribute__((address_space(3)))
typedef unsigned short bf16_t;
typedef short bf16x8 __attribute__((ext_vector_type(8)));
typedef float f32x4 __attribute__((ext_vector_type(4)));
typedef unsigned u32x4 __attribute__((ext_vector_type(4)));
constexpr int BM = 256, BK = 64, HALF = 128, HTB = HALF * BK * 2  , STAGE_BYTES = 8 * HTB, NXCD = 8, WGM = 8;

__host__ __device__ __forceinline__ int lds_byte(int r, int c) { const int st = (r >> 4) * 2 + (c >> 5), rr = r & 15, cc = c & 31, ob = rr * 64 + cc * 2; return st * 1024 + (ob ^ (((ob >> 9) & 1) << 5)); }
__host__ __device__ __forceinline__ void stage_rc(int b, int& R, int& C) { const int st = b / 1024, sb = b % 1024, swz = sb ^ (((sb >> 9) & 1) << 5); R = (st >> 1) * 16 + swz / 64; C = (st & 1) * 32 + (swz % 64) / 2; }
__host__ __device__ __forceinline__ int perm32(int rho) { const int n = rho >> 4, i = rho & 15; return 8 * (i >> 2) + 4 * n + (i & 3); }

struct Unit { int pm, pn; };
struct Gemm { const bf16_t* A; const bf16_t* Bt; int M, N, K; };

struct StaticOrder {
    int nM, nN, nwg, G, c;
    __host__ __device__ void init(int M, int N, int G_, int c_) { nM = M / BM; nN = N / BM; nwg = nM * nN; G = G_; c = c_; }
    __host__ __device__ bool next(int i, Unit& u) const {
        const long L = (long)i * G + c; if (L >= nwg) return false;
        int wgid = (int)L; { const int q = nwg / NXCD, r = nwg % NXCD, xcd = wgid % NXCD, off = wgid / NXCD; wgid = (xcd < r ? xcd * (q + 1) : r * (q + 1) + (xcd - r) * q) + off; }
        const int nig = WGM * nN, gid = wgid / nig, fm = gid * WGM, gsz = (nM - fm) < WGM ? (nM - fm) : WGM;
        u.pm = fm + ((wgid % nig) % gsz); u.pn = (wgid % nig) / gsz; return true;
    }
    __device__ __forceinline__ void a_ready(const Unit&) const {}
    __device__ __forceinline__ void done(const Unit&) const {}
};

__device__ __forceinline__ unsigned cvt_pk_bf16(float lo, float hi) { unsigned r; asm volatile("v_cvt_pk_bf16_f32 %0, %1, %2" : "=v"(r) : "v"(lo), "v"(hi)); return r; }

template <class Epi, class Sched, bool ALIGN_EPI = false, bool SP2 = false>
__device__ __forceinline__ void gemm_phase(PG8_LAS unsigned char* lds, const Gemm g, const Sched& S, const Epi& E) {
    const int tid = threadIdx.x, wid = __builtin_amdgcn_readfirstlane(tid >> 6), lane = tid & 63, wr = wid >> 2, wc = wid & 3, fr = lane & 15, fq = lane >> 4;
    const int K = g.K, nt = K / BK;
    unsigned voffA[2], voffB[2];
#pragma unroll
    for (int i = 0; i < 2; ++i) { int R, C; stage_rc(tid * 16 + i * 8192, R, C); const int Rb = Epi::PERM ? ((R & ~31) + perm32(R & 31)) : R;
        voffA[i] = (unsigned)(R * K + C) * 2u; voffB[i] = (unsigned)(Rb * K + C) * 2u; }
    const size_t kstep = (size_t)(BK * 2);
    const size_t hstep = (size_t)HALF * K * 2;
    const size_t tstep = 2 * hstep;
    const unsigned ldsw = (unsigned)wid * 1024u;
    const int aoff = lds_byte(wr * 64 + fr, fq * 8), boff = lds_byte(wc * 32 + fr, fq * 8);
#define PG8_SA(b, h) (((b) * 2 + (h)) * HTB)
#define PG8_SB(b, h) ((4 + (b) * 2 + (h)) * HTB)
#define PG8_STAGE(bufoff, gbase, voff) do { _Pragma("unroll") for (int _i = 0; _i < 2; ++_i) \
        __builtin_amdgcn_global_load_lds((const unsigned*)((const char*)(gbase) + (voff)[_i]), (PG8_LAS unsigned*)(lds + (bufoff) + ldsw + _i * 8192), 16, 0, 0); } while (0)
#define PG8_LDA(dst, b, h) do { _Pragma("unroll") for (int m = 0; m < 4; ++m) _Pragma("unroll") for (int k = 0; k < 2; ++k) dst[m][k] = *(const PG8_LAS bf16x8*)(lds + PG8_SA(b, h) + aoff + m * 2048 + k * 1024); } while (0)
#define PG8_LDB(dst, b, h) do { _Pragma("unroll") for (int n = 0; n < 2; ++n) _Pragma("unroll") for (int k = 0; k < 2; ++k) dst[n][k] = *(const PG8_LAS bf16x8*)(lds + PG8_SB(b, h) + boff + n * 2048 + k * 1024); } while (0)
#define PG8_MMA(ai, bj, At, Bt) do { __builtin_amdgcn_s_setprio(1); _Pragma("unroll") for (int m = 0; m < 4; ++m) _Pragma("unroll") for (int n = 0; n < 2; ++n) _Pragma("unroll") for (int k = 0; k < 2; ++k) \
        acc[ai][bj][m][n] = __builtin_amdgcn_mfma_f32_16x16x32_bf16(Bt[n][k], At[m][k], acc[ai][bj][m][n], 0, 0, 0); __builtin_amdgcn_s_setprio(0); } while (0)
#define PG8_WAIT_V(n) asm volatile("s_waitcnt vmcnt(" #n ")" ::: "memory")
#define PG8_WAIT_L(n) asm volatile("s_waitcnt lgkmcnt(" #n ")" ::: "memory")
#define PG8_BAR __builtin_amdgcn_s_barrier()
#define PG8_SCHED __builtin_amdgcn_sched_barrier(0)
    Unit cur, nxt; int ui = 0;
    if (!S.next(0, cur)) return;
    f32x4 acc[2][2][4][2];
#pragma unroll
    for (int a = 0; a < 2; ++a)
#pragma unroll
        for (int b = 0; b < 2; ++b)
#pragma unroll
            for (int m = 0; m < 4; ++m)
#pragma unroll
                for (int n = 0; n < 2; ++n) acc[a][b][m][n] = (f32x4){0.f, 0.f, 0.f, 0.f};
    bf16x8 At[4][2], B0[2][2], B1[2][2];
    const char* cA = (const char*)g.A + (size_t)cur.pm * tstep; const char* cB = (const char*)g.Bt + (size_t)cur.pn * tstep;
    S.a_ready(cur);
    if constexpr (SP2) {
        PG8_STAGE(PG8_SB(0, 0), cB, voffB); PG8_STAGE(PG8_SB(0, 1), cB + hstep, voffB); PG8_STAGE(PG8_SA(0, 0), cA, voffA); PG8_STAGE(PG8_SA(0, 1), cA + hstep, voffA);
        if (wr == 1) PG8_BAR;
        PG8_WAIT_V(2); PG8_BAR;
        PG8_STAGE(PG8_SB(1, 0), cB + kstep, voffB); PG8_STAGE(PG8_SA(1, 0), cA + kstep, voffA); PG8_STAGE(PG8_SB(1, 1), cB + hstep + kstep, voffB);
        PG8_WAIT_V(6); PG8_BAR;
    } else {
        PG8_STAGE(PG8_SB(0, 0), cB, voffB); PG8_STAGE(PG8_SA(0, 0), cA, voffA); PG8_STAGE(PG8_SB(0, 1), cB + hstep, voffB); PG8_STAGE(PG8_SA(0, 1), cA + hstep, voffA);
        if (wr == 1) PG8_BAR;
        PG8_WAIT_V(4); PG8_BAR;
        PG8_STAGE(PG8_SB(1, 0), cB + kstep, voffB); PG8_STAGE(PG8_SA(1, 0), cA + kstep, voffA); PG8_STAGE(PG8_SB(1, 1), cB + hstep + kstep, voffB);
        PG8_WAIT_V(6); PG8_BAR;
    }
    for (;;) {
        const bool has_next = S.next(ui + 1, nxt);
        const char* nA = has_next ? (const char*)g.A + (size_t)nxt.pm * tstep : cA; const char* nB = has_next ? (const char*)g.Bt + (size_t)nxt.pn * tstep : cB;
        for (int t = 0; t < nt; t += 2) {
            const bool last = (t == nt - 2);
            const char* a1 = cA + (size_t)(t + 1) * kstep;
            const char* a2 = last ? nA : cA + (size_t)(t + 2) * kstep; const char* b2 = last ? nB : cB + (size_t)(t + 2) * kstep;
            const char* a3 = a2 + kstep; const char* b3 = b2 + kstep;
            if (last && has_next) S.a_ready(nxt);
            if constexpr (SP2) {
            PG8_LDB(B0, 0, 0); PG8_LDB(B1, 0, 1); PG8_SCHED; PG8_LDA(At, 0, 0); PG8_STAGE(PG8_SA(1, 1), a1 + hstep, voffA);
            PG8_WAIT_V(8); PG8_WAIT_L(0); PG8_BAR; PG8_MMA(0, 0, At, B0); PG8_MMA(0, 1, At, B1); PG8_BAR; PG8_SCHED;
            PG8_LDA(At, 0, 1); PG8_STAGE(PG8_SB(0, 0), b2, voffB); PG8_STAGE(PG8_SB(0, 1), b2 + hstep, voffB); PG8_STAGE(PG8_SA(0, 0), a2, voffA);
            PG8_WAIT_V(8); PG8_WAIT_L(0); PG8_BAR; PG8_MMA(1, 0, At, B0); PG8_MMA(1, 1, At, B1); PG8_BAR; PG8_SCHED;
            PG8_LDB(B0, 1, 0); PG8_LDB(B1, 1, 1); PG8_SCHED; PG8_LDA(At, 1, 0); PG8_STAGE(PG8_SA(0, 1), a2 + hstep, voffA);
            PG8_WAIT_V(8); PG8_WAIT_L(0); PG8_BAR; PG8_MMA(0, 0, At, B0); PG8_MMA(0, 1, At, B1); PG8_BAR; PG8_SCHED;
            PG8_LDA(At, 1, 1); PG8_STAGE(PG8_SB(1, 0), b3, voffB); PG8_STAGE(PG8_SB(1, 1), b3 + hstep, voffB); PG8_STAGE(PG8_SA(1, 0), a3, voffA);
            PG8_WAIT_V(8); PG8_WAIT_L(0); PG8_BAR; PG8_MMA(1, 0, At, B0); PG8_MMA(1, 1, At, B1); PG8_BAR; PG8_SCHED;
            } else {
            PG8_LDB(B0, 0, 0); PG8_SCHED; PG8_LDA(At, 0, 0); PG8_STAGE(PG8_SA(1, 1), a1 + hstep, voffA);
            PG8_WAIT_L(8); PG8_BAR; PG8_WAIT_L(0); PG8_MMA(0, 0, At, B0); PG8_BAR; PG8_SCHED;
            PG8_LDB(B1, 0, 1); PG8_STAGE(PG8_SB(0, 0), b2, voffB);
            PG8_BAR; PG8_WAIT_L(0); PG8_MMA(0, 1, At, B1); PG8_BAR;
            PG8_LDA(At, 0, 1); PG8_STAGE(PG8_SA(0, 0), a2, voffA);
            PG8_BAR; PG8_WAIT_L(0); PG8_MMA(1, 0, At, B0); PG8_BAR; PG8_SCHED;
            PG8_STAGE(PG8_SB(0, 1), b2 + hstep, voffB);
            PG8_WAIT_V(6); PG8_BAR; PG8_MMA(1, 1, At, B1); PG8_BAR;
            PG8_LDB(B0, 1, 0); PG8_SCHED; PG8_LDA(At, 1, 0); PG8_STAGE(PG8_SA(0, 1), a2 + hstep, voffA);
            PG8_WAIT_L(8); PG8_BAR; PG8_WAIT_L(0); PG8_MMA(0, 0, At, B0); PG8_BAR; PG8_SCHED;
            PG8_LDB(B1, 1, 1); PG8_STAGE(PG8_SB(1, 0), b3, voffB);
            PG8_BAR; PG8_WAIT_L(0); PG8_MMA(0, 1, At, B1); PG8_BAR;
            PG8_LDA(At, 1, 1); PG8_STAGE(PG8_SA(1, 0), a3, voffA);
            PG8_BAR; PG8_WAIT_L(0); PG8_MMA(1, 0, At, B0); PG8_BAR; PG8_SCHED;
            PG8_STAGE(PG8_SB(1, 1), b3 + hstep, voffB);
            PG8_WAIT_V(6); PG8_BAR; PG8_MMA(1, 1, At, B1); PG8_BAR;
            }
        }
        if constexpr (ALIGN_EPI) { if (wr == 0) PG8_BAR; }
#if PROBE_ON && !PROBE_SKINNY
        const unsigned pe0_ = (unsigned)__builtin_amdgcn_s_memrealtime();
#endif
        if constexpr (!Epi::AFTER_DRAIN) { E(acc, cur, wr, wc, fr, fq); S.done(cur); }
#if PROBE_ON && !PROBE_SKINNY
        if (threadIdx.x == 0) { *(volatile PG8_LAS unsigned*)(lds + 131072 + 320 + 4 * 18) += (unsigned)__builtin_amdgcn_s_memrealtime() - pe0_; }
#endif
        if (!has_next) break;
#pragma unroll
        for (int a = 0; a < 2; ++a)
#pragma unroll
            for (int b = 0; b < 2; ++b)
#pragma unroll
                for (int m = 0; m < 4; ++m)
#pragma unroll
                    for (int n = 0; n < 2; ++n) acc[a][b][m][n] = (f32x4){0.f, 0.f, 0.f, 0.f};
        cur = nxt; cA = nA; cB = nB; ++ui;
        if constexpr (ALIGN_EPI) { if (wr == 1) PG8_BAR; }
    }
    PG8_WAIT_V(0);
    if constexpr (!ALIGN_EPI) { if (wr == 0) PG8_BAR; }
    PG8_BAR;
    if constexpr (Epi::AFTER_DRAIN) { E.fused(acc, cur, wr, wc, fr, fq, lds, wid, lane); S.done(cur); }
#undef PG8_SA
#undef PG8_SB
#undef PG8_STAGE
#undef PG8_LDA
#undef PG8_LDB
#undef PG8_MMA
#undef PG8_WAIT_V
#undef PG8_WAIT_L
#undef PG8_BAR
#undef PG8_SCHED
}
}


constexpr int DM = 1024, NB = 8, SEQ = 2048, NDEC = 128, MPROMPT = NB * SEQ, MTOT = MPROMPT + NDEC, MP = 16640  ;
constexpr int HR = 4, DKR = 128, DVR = 256, HG = 8, DKG = 128, DVG = 128, DFF = 4096, DPLE = 256, DIN = 9216, CH = 64, NCHUNK = MPROMPT / CH;
constexpr float EPS = 1e-6f;
constexpr size_t OFF_Y = 0, OFF_RETP = (size_t)MTOT * DM, OFF_HGP = OFF_RETP + (size_t)NB * HR * DKR * DVR, OFF_RETS = OFF_HGP + (size_t)NB * HG * DKG * DVG,
                 OFF_HGS = OFF_RETS + (size_t)NDEC * HR * DKR * DVR, OUT_TOTAL = OFF_HGS + (size_t)NDEC * HG * DKG * DVG;
static_assert(OUT_TOTAL == 52559872, "output size");


constexpr int NWAVES = 8;
constexpr int NPH = 10;
#ifndef MK_ONE_LAUNCH
#define MK_ONE_LAUNCH 1
#endif

constexpr size_t MiB = 1u << 20;
constexpr size_t WS_CTL = 0, CTL_ZERO_BYTES = 1 * MiB;
constexpr size_t WS_WIN = 1 * MiB;
constexpr size_t WS_WUPR = WS_WIN + (size_t)DIN * DM * 2;
constexpr size_t WS_WUPH = WS_WUPR + (size_t)DM * DM * 2;
constexpr size_t WS_WO = WS_WUPH + (size_t)DM * DM * 2;
constexpr size_t WS_WFF1 = WS_WO + (size_t)DM * DM * 2;
constexpr size_t WS_WFF2 = WS_WFF1 + (size_t)DFF * DM * 2;
constexpr size_t WS_WGATE = WS_WFF2 + (size_t)DFF * DM * 2;
constexpr size_t WS_WPROJ = WS_WGATE + (size_t)DM * DM * 2;
constexpr size_t WS_Z6 = WS_WPROJ + (size_t)DM * DPLE * 2;
constexpr size_t Z_QR = WS_Z6, Z_KR = Z_QR + (size_t)MP * 512 * 2, Z_VR = Z_KR + (size_t)MP * 512 * 2, Z_QG = Z_VR + (size_t)MP * DM * 2, Z_KG = Z_QG + (size_t)MP * DM * 2,
                 Z_VG = Z_KG + (size_t)MP * DM * 2, Z_END = Z_VG + (size_t)MP * DM * 2;
constexpr size_t WS_H = WS_Z6, WS_MB = WS_Z6 + (size_t)MP * DFF * 2;
static_assert(WS_MB == Z_VG, "MB overlays VG exactly");
constexpr size_t WS_GR = Z_END, WS_GG = WS_GR + (size_t)MP * DM * 2, WS_A5 = WS_GR, WS_A7 = WS_GG;
constexpr size_t WS_PB = WS_GG + (size_t)MP * DM * 2;
constexpr size_t WS_CS = WS_PB + (size_t)MP * DPLE * 2;
constexpr size_t WS_GL = WS_CS + (size_t)2049 * 64 * 8;
constexpr size_t WS_FS = WS_GL + (size_t)NCHUNK * DM * 4;
constexpr size_t WS_RSTD0 = WS_FS + (size_t)NDEC * DM * 4;
constexpr size_t WS_LB = WS_RSTD0 + (size_t)MP * 4;
constexpr size_t WS_PS1 = WS_LB + 4096, WS_PS2 = WS_PS1 + (size_t)MP * 64, WS_PS3 = WS_PS2 + (size_t)MP * 64, WS_PSS1 = WS_PS3 + (size_t)MP * 64, WS_PSS2 = WS_PSS1 + (size_t)NDEC * 256, WS_PSS3 = WS_PSS2 + (size_t)NDEC * 256, WS_END = WS_PSS3 + (size_t)NDEC * 256;
static_assert(WS_END <= 307920896, "d_ws map must fit sum(inputs) bytes");
static_assert(WS_WIN % 256 == 0 && WS_Z6 % 256 == 0 && WS_GR % 256 == 0 && WS_PB % 256 == 0 && WS_CS % 16 == 0 && WS_GL % 16 == 0 && WS_PS1 % 16 == 0, "alignment");
constexpr int CW_TMO = 0, CW_BAR = 4096;

constexpr int RING_OFF = 0, RING_BYTES = 131072;
constexpr int LDSCTL_OFF = RING_BYTES, MISC_OFF = LDSCTL_OFF + 320;
constexpr int LDS_BYTES = 147456;


namespace pg8 {
typedef unsigned u32x2 __attribute__((ext_vector_type(2)));
typedef float f32x2 __attribute__((ext_vector_type(2)));
__device__ __forceinline__ float bf2f(unsigned short b) { return __uint_as_float((unsigned)b << 16); }
__device__ __forceinline__ float bflo(unsigned w) { return __uint_as_float(w << 16); }
__device__ __forceinline__ float bfhi(unsigned w) { return __uint_as_float(w & 0xffff0000u); }
__device__ __forceinline__ float sigmoidf_(float x) { return 1.0f / (1.0f + __expf(-x)); }
__device__ __forceinline__ float siluf_(float x) { return x / (1.0f + __expf(-x)); }
__device__ __forceinline__ u32x2 pack4(f32x4 v) { u32x2 w; w.x = cvt_pk_bf16(v[0], v[1]); w.y = cvt_pk_bf16(v[2], v[3]); return w; }
__device__ __forceinline__ f32x4 unpack4(u32x2 w) { return (f32x4){bflo(w.x), bfhi(w.x), bflo(w.y), bfhi(w.y)}; }

typedef unsigned u32x4 __attribute__((ext_vector_type(4)));
#define DPP_ROW_SHR(x, n) __int_as_float(__builtin_amdgcn_update_dpp(0, __float_as_int(x), 0x110 + (n), 0xf, 0xf, true))
#define DPP_ROW_SHR1(x, n) __int_as_float(__builtin_amdgcn_update_dpp(0x3f800000, __float_as_int(x), 0x110 + (n), 0xf, 0xf, false))
#define DPP_ROW_BCAST15(x) __int_as_float(__builtin_amdgcn_update_dpp(0, __float_as_int(x), 0x15F, 0xf, 0xf, false))
struct EpiIn {
    static constexpr bool PERM = true, AFTER_DRAIN = false;
    const float* rstd0; const float* cs; const float* lb;
    bf16_t *QR, *KR, *VR, *GR, *QG, *KG, *VG, *GG, *AR, *AH; float *GL, *FS; unsigned char* wsb; unsigned char* outb;
    __device__ __forceinline__ void operator()(const f32x4 (&acc)[2][2][4][2], const Unit& u, int wr, int wc, int fr, int fq) const {
        const int pn = u.pn;
#pragma unroll
        for (int ai = 0; ai < 2; ++ai) {
            const int rbase = u.pm * BM + ai * HALF + wr * 64;
            float rs[4];
#pragma unroll
            for (int m = 0; m < 4; ++m) rs[m] = rstd0[rbase + m * 16 + fr];
            if (pn < 4) {
                const bool isk = pn >= 2; bf16_t* dst = isk ? KR : QR;
#pragma unroll
                for (int bj = 0; bj < 2; ++bj) {
                    const int head = 2 * (pn & 1) + bj;
                    const float lg = __logf(1.0f - exp2f(-5.0f - (float)head));
                    const int j0 = 16 * wc + 4 * fq;
#pragma unroll
                    for (int m = 0; m < 4; ++m) {
                        const int row = rbase + m * 16 + fr; const int pidx = row & (SEQ - 1);
                        const float e = lg * (float)(m * 16 + fr + 1);
                        const float sc = rs[m] * (isk ? 0.08838834764831845f * __expf(-e) : __expf(e));
                        const f32x4 t0 = *(const f32x4*)(cs + ((size_t)pidx * 64 + j0) * 2), t1 = *(const f32x4*)(cs + ((size_t)pidx * 64 + j0 + 2) * 2);
                        const f32x4 v0 = acc[ai][bj][m][0] * sc, v1 = acc[ai][bj][m][1] * sc;
                        u32x2 o1, o2;
                        o1.x = cvt_pk_bf16(v0[0] * t0[0] - v0[1] * t0[1], v0[2] * t0[2] - v0[3] * t0[3]); o1.y = cvt_pk_bf16(v1[0] * t1[0] - v1[1] * t1[1], v1[2] * t1[2] - v1[3] * t1[3]);
                        o2.x = cvt_pk_bf16(v0[0] * t0[1] + v0[1] * t0[0], v0[2] * t0[3] + v0[3] * t0[2]); o2.y = cvt_pk_bf16(v1[0] * t1[1] + v1[1] * t1[0], v1[2] * t1[3] + v1[3] * t1[2]);
                        bf16_t* p = dst + (size_t)row * 512 + head * 128 + j0;
                        *(u32x2*)p = o1; *(u32x2*)(p + 64) = o2;
                    }
                }
            } else if (pn >= 12 && pn < 20) {
                const int head = pn - 12;
#pragma unroll
                for (int bj = 0; bj < 2; ++bj) {
                    const int j0 = 64 * bj + 16 * wc + 4 * fq, c = head * 128 + j0;
                    const f32x4 lbv = *(const f32x4*)(lb + c);
                    float qa[4][4], ka[4][4], ba[4][4];
#pragma unroll
                    for (int q = 0; q < 4; ++q) {
                        const int n = q >> 1, e = q & 1; const float one_m_lb = 1.0f - lbv[q]; float carry = 1.f;
#pragma unroll
                        for (int m = 0; m < 4; ++m) {
                            const float vq = acc[ai][bj][m][n][2 * e] * rs[m], vf = acc[ai][bj][m][n][2 * e + 1] * rs[m];
                            const float kk = one_m_lb / (1.0f + __expf(vf));
                            float x = 1.0f - kk;
                            x *= DPP_ROW_SHR1(x, 1); x *= DPP_ROW_SHR1(x, 2); x *= DPP_ROW_SHR1(x, 4); x *= DPP_ROW_SHR1(x, 8);
                            x *= carry; carry = DPP_ROW_BCAST15(x);
                            qa[m][q] = siluf_(vq); ka[m][q] = kk; ba[m][q] = x;
                        }
                    }
#pragma unroll
                    for (int m = 0; m < 4; ++m) {
                        const int row = rbase + m * 16 + fr;
                        const float e0 = ba[m][0], e1 = ba[m][1], e2 = ba[m][2], e3 = ba[m][3];
                        u32x2 qw, kw;
                        qw.x = cvt_pk_bf16(qa[m][0] * e0, qa[m][1] * e1); qw.y = cvt_pk_bf16(qa[m][2] * e2, qa[m][3] * e3);
                        kw.x = cvt_pk_bf16(ka[m][0] * __builtin_amdgcn_rcpf(e0), ka[m][1] * __builtin_amdgcn_rcpf(e1)); kw.y = cvt_pk_bf16(ka[m][2] * __builtin_amdgcn_rcpf(e2), ka[m][3] * __builtin_amdgcn_rcpf(e3));
                        *(u32x2*)(QG + (size_t)row * DM + c) = qw; *(u32x2*)(KG + (size_t)row * DM + c) = kw;
                        if (m == 3 && fr == 15) *(f32x4*)(GL + (size_t)(row >> 6) * DM + c) = (f32x4){e0, e1, e2, e3};
                    }
                }
            } else {
                const int mode = pn >= 28 ? 2 : 0, cbase = (pn & 3) * BM;
                const size_t boff = pn < 8 ? Z_VR : pn < 12 ? WS_GR : pn < 24 ? Z_VG : pn < 28 ? WS_GG : pn < 32 ? (size_t)0 : (size_t)MTOT * DM * 2;
                bf16_t* dst = (bf16_t*)((pn >= 28 ? outb : wsb) + boff);
#pragma unroll
                for (int m = 0; m < 4; ++m) {
                    const int row = rbase + m * 16 + fr;
#pragma unroll
                    for (int bj = 0; bj < 2; ++bj) {
                        f32x4 v0 = acc[ai][bj][m][0] * rs[m], v1 = acc[ai][bj][m][1] * rs[m];
                        if (mode == 1) { v0[0] = siluf_(v0[0]); v0[1] = siluf_(v0[1]); v0[2] = siluf_(v0[2]); v0[3] = siluf_(v0[3]); v1[0] = siluf_(v1[0]); v1[1] = siluf_(v1[1]); v1[2] = siluf_(v1[2]); v1[3] = siluf_(v1[3]); }
                        else if (mode == 2) { v0[0] = sigmoidf_(v0[0]); v0[1] = sigmoidf_(v0[1]); v0[2] = sigmoidf_(v0[2]); v0[3] = sigmoidf_(v0[3]); v1[0] = sigmoidf_(v1[0]); v1[1] = sigmoidf_(v1[1]); v1[2] = sigmoidf_(v1[2]); v1[3] = sigmoidf_(v1[3]); }
                        const u32x2 a = pack4(v0), b = pack4(v1);
                        *(u32x4*)(dst + (size_t)row * DM + cbase + bj * HALF + wc * 32 + fq * 8) = (u32x4){a.x, a.y, b.x, b.y};
                    }
                }
            }
        }
    }
};

__device__ __forceinline__ void unpack8(u32x4 w, f32x4& a, f32x4& b) { a = (f32x4){bflo(w.x), bfhi(w.x), bflo(w.y), bfhi(w.y)}; b = (f32x4){bflo(w.z), bfhi(w.z), bflo(w.w), bfhi(w.w)}; }
__device__ __forceinline__ u32x4 pack8(f32x4 a, f32x4 b) { const u32x2 x = pack4(a), y = pack4(b); return (u32x4){x.x, x.y, y.x, y.y}; }
__device__ __forceinline__ float sumsq4(f32x4 r) { return (r[0] * r[0] + r[1] * r[1]) + (r[2] * r[2] + r[3] * r[3]); }
template <int MODE> struct EpiN {
    static constexpr bool PERM = true, AFTER_DRAIN = false;
    const bf16_t* gate; bf16_t* out16; int ld16; const float* xp; const float* xs; float* R; const float* g; float* PS; const float* PSin;
    __device__ __forceinline__ void operator()(const f32x4 (&acc)[2][2][4][2], const Unit& u, int wr, int wc, int fr, int fq) const {
#pragma unroll
        for (int ai = 0; ai < 2; ++ai) {
            const int rbase = u.pm * BM + ai * HALF + wr * 64;
#pragma unroll
            for (int m = 0; m < 4; ++m) {
                const int row = rbase + m * 16 + fr;
                float rstd = 1.f;
                if (MODE == 3 || MODE == 4) {
                    const f32x4* p = (const f32x4*)(PSin + (size_t)row * 16); const f32x4 a = p[0], b = p[1], c = p[2], d = p[3];
                    const float s = ((a[0] + a[1]) + (a[2] + a[3])) + ((b[0] + b[1]) + (b[2] + b[3])) + ((c[0] + c[1]) + (c[2] + c[3])) + ((d[0] + d[1]) + (d[2] + d[3]));
                    rstd = rsqrtf(s * (1.0f / 1024.0f) + EPS);
                }
                float ss = 0.f;
#pragma unroll
                for (int bj = 0; bj < 2; ++bj) {
                    const int col = u.pn * BM + bj * HALF + wc * 32 + fq * 8;
                    const f32x4 a0 = acc[ai][bj][m][0], a1 = acc[ai][bj][m][1];
                    if (MODE == 0) { f32x4 g0, g1; unpack8(*(const u32x4*)(gate + (size_t)row * DM + col), g0, g1); *(u32x4*)(out16 + (size_t)row * ld16 + col) = pack8(g0 * a0, g1 * a1); }
                    else if (MODE == 1) { f32x4 g0, g1, t0, t1; unpack8(*(const u32x4*)(gate + (size_t)row * DM + col), g0, g1); u32x4* o = (u32x4*)(out16 + (size_t)row * ld16 + col); unpack8(*o, t0, t1); *o = pack8(t0 + g0 * a0, t1 + g1 * a1); }
                    else if (MODE == 2) {
                        const float* bp = xp + (size_t)row * DM + col;
                        const f32x4 r0 = *(const f32x4*)bp + a0, r1 = *(const f32x4*)(bp + 4) + a1;
                        ss += sumsq4(r0) + sumsq4(r1);
                        *(u32x4*)(out16 + (size_t)row * ld16 + col) = pack8(r0, r1);
                    }
                    else if (MODE == 6) {
                        f32x4 b0, b1; unpack8(*(const u32x4*)(gate + (size_t)row * DM + col), b0, b1);
                        const f32x4 r0 = b0 + a0, r1 = b1 + a1;
                        ss += sumsq4(r0) + sumsq4(r1);
                        *(u32x4*)(out16 + (size_t)row * ld16 + col) = pack8(r0, r1);
                    }
                    else if (MODE == 3) { f32x4 v0 = a0 * rstd, v1 = a1 * rstd;
                        v0[0] = fmaxf(v0[0], 0.f); v0[1] = fmaxf(v0[1], 0.f); v0[2] = fmaxf(v0[2], 0.f); v0[3] = fmaxf(v0[3], 0.f); v1[0] = fmaxf(v1[0], 0.f); v1[1] = fmaxf(v1[1], 0.f); v1[2] = fmaxf(v1[2], 0.f); v1[3] = fmaxf(v1[3], 0.f);
                        *(u32x4*)(out16 + (size_t)row * ld16 + col) = pack8(v0 * v0, v1 * v1); }
                    else if (MODE == 4) { f32x4 v0 = a0 * rstd, v1 = a1 * rstd;
                        v0[0] = sigmoidf_(v0[0]); v0[1] = sigmoidf_(v0[1]); v0[2] = sigmoidf_(v0[2]); v0[3] = sigmoidf_(v0[3]); v1[0] = sigmoidf_(v1[0]); v1[1] = sigmoidf_(v1[1]); v1[2] = sigmoidf_(v1[2]); v1[3] = sigmoidf_(v1[3]);
                        *(u32x4*)(out16 + (size_t)row * ld16 + col) = pack8(v0, v1); }
                    else if (MODE == 5) { f32x4 t0, t1, b0, b1; unpack8(*(const u32x4*)(out16 + (size_t)row * ld16 + col), t0, t1); unpack8(*(const u32x4*)(gate + (size_t)row * DM + col), b0, b1);
                        const f32x4 r0 = b0 + t0 * a0, r1 = b1 + t1 * a1; *(u32x4*)((bf16_t*)R + (size_t)row * DM + col) = pack8(r0, r1); ss += sumsq4(r0) + sumsq4(r1); }
                }
                if (MODE == 2 || MODE == 5 || MODE == 6) { ss += __shfl_xor(ss, 16); ss += __shfl_xor(ss, 32); if (fq == 0) PS[(size_t)row * 16 + u.pn * 4 + wc] = ss; }
            }
        }
    }
};

__device__ __forceinline__ void samp_in(const EpiIn& E, int row, int pcol, f32x4 v) {
    const float rs = E.rstd0[row]; const int pn = __builtin_amdgcn_readfirstlane(pcol >> 8), p = pcol & 255;
    if (pn < 4) {
        const bool isk = pn >= 2; bf16_t* dst = isk ? E.KR : E.QR; const int head = 2 * (pn & 1) + (p >> 7), j = (p & 127) >> 1;
        const f32x4 t = *(const f32x4*)(E.cs + ((size_t)SEQ * 64 + j) * 2);
        v = v * (rs * (isk ? 0.08838834764831845f : 1.0f));
        const float o1a = v[0] * t[0] - v[1] * t[1], o2a = v[0] * t[1] + v[1] * t[0], o1b = v[2] * t[2] - v[3] * t[3], o2b = v[2] * t[3] + v[3] * t[2];
        bf16_t* q = dst + (size_t)row * 512 + head * 128 + j;
        *(unsigned*)q = cvt_pk_bf16(o1a, o1b); *(unsigned*)(q + 64) = cvt_pk_bf16(o2a, o2b);
    } else if (pn >= 12 && pn < 20) {
        const int c = (pn - 12) * 128 + (p >> 1);
        const float k0 = (1.0f - E.lb[c]) / (1.0f + __expf(v[1] * rs)), k1 = (1.0f - E.lb[c + 1]) / (1.0f + __expf(v[3] * rs));
        *(unsigned*)(E.QG + (size_t)row * DM + c) = cvt_pk_bf16(siluf_(v[0] * rs), siluf_(v[2] * rs));
        *(unsigned*)(E.KG + (size_t)row * DM + c) = cvt_pk_bf16(k0, k1);
        *(f32x2*)(E.FS + (size_t)(row - MPROMPT) * DM + c) = (f32x2){1.0f - k0, 1.0f - k1};
    } else {
        v = v * rs;
        const bool sl = false, sg = pn >= 28;
        if (sl) { v[0] = siluf_(v[0]); v[1] = siluf_(v[1]); v[2] = siluf_(v[2]); v[3] = siluf_(v[3]); }
        else if (sg) { v[0] = sigmoidf_(v[0]); v[1] = sigmoidf_(v[1]); v[2] = sigmoidf_(v[2]); v[3] = sigmoidf_(v[3]); }
        const size_t boff = pn < 8 ? Z_VR : pn < 12 ? WS_GR : pn < 24 ? Z_VG : pn < 28 ? WS_GG : pn < 32 ? (size_t)0 : (size_t)MTOT * DM * 2;
        bf16_t* dst = (bf16_t*)((pn >= 28 ? E.outb : E.wsb) + boff);
        *(u32x2*)(dst + (size_t)row * DM + (pn & 3) * BM + p) = pack4(v);
    }
}
template <int MODE> __device__ __forceinline__ void samp_n(const EpiN<MODE>& E, const float* xs, float* PSS, const float* PSSin, int row, int col, f32x4 a) {
    const int rs_ = row - MPROMPT; float rstd = 1.f;
    if (MODE == 3 || MODE == 4) { const f32x4* p = (const f32x4*)(PSSin + (size_t)rs_ * 64); float s = 0.f;
#pragma unroll
        for (int i = 0; i < 16; ++i) { const f32x4 q = p[i]; s += (q[0] + q[1]) + (q[2] + q[3]); }
        rstd = rsqrtf(s * (1.0f / 1024.0f) + EPS); }
    float ss = 0.f;
    if (MODE == 0) { const f32x4 gt = unpack4(*(const u32x2*)(E.gate + (size_t)row * DM + col)); *(u32x2*)(E.out16 + (size_t)row * E.ld16 + col) = pack4(gt * a); }
    else if (MODE == 1) { const f32x4 gt = unpack4(*(const u32x2*)(E.gate + (size_t)row * DM + col)); u32x2* o = (u32x2*)(E.out16 + (size_t)row * E.ld16 + col); const f32x4 t = unpack4(*o); *o = pack4(t + gt * a); }
    else if (MODE == 2) { const f32x4 r = *(const f32x4*)(xs + (size_t)rs_ * DM + col) + a; ss = sumsq4(r); *(u32x2*)(E.out16 + (size_t)row * E.ld16 + col) = pack4(r); }
    else if (MODE == 6) { const f32x4 r = unpack4(*(const u32x2*)(E.gate + (size_t)row * DM + col)) + a; ss = sumsq4(r); *(u32x2*)(E.out16 + (size_t)row * E.ld16 + col) = pack4(r); }
    else if (MODE == 3) { f32x4 v = a * rstd; v[0] = fmaxf(v[0], 0.f); v[1] = fmaxf(v[1], 0.f); v[2] = fmaxf(v[2], 0.f); v[3] = fmaxf(v[3], 0.f); *(u32x2*)(E.out16 + (size_t)row * E.ld16 + col) = pack4(v * v); }
    else if (MODE == 4) { f32x4 v = a * rstd; v[0] = sigmoidf_(v[0]); v[1] = sigmoidf_(v[1]); v[2] = sigmoidf_(v[2]); v[3] = sigmoidf_(v[3]); *(u32x2*)(E.out16 + (size_t)row * E.ld16 + col) = pack4(v); }
    else if (MODE == 5) { const f32x4 t = unpack4(*(const u32x2*)(E.out16 + (size_t)row * E.ld16 + col)), b = unpack4(*(const u32x2*)(E.gate + (size_t)row * DM + col));
        const f32x4 r = b + t * a; *(u32x2*)((bf16_t*)E.R + (size_t)row * DM + col) = pack4(r); ss = sumsq4(r); }
    if (MODE == 2 || MODE == 5 || MODE == 6) { ss += __shfl_xor(ss, 16); ss += __shfl_xor(ss, 32); if ((threadIdx.x & 63) < 16) PSS[(size_t)rs_ * 64 + (col >> 4)] = ss; }
}
}

#define GAS __attribute__((address_space(1)))
#define LAS __attribute__((address_space(3)))
typedef unsigned short bf16;
typedef unsigned v4u __attribute__((ext_vector_type(4)));
typedef float f32x4 __attribute__((ext_vector_type(4)));
typedef short bf16x8 __attribute__((ext_vector_type(8)));
typedef GAS unsigned gu32;
typedef GAS unsigned long long gu64;
#define RLX_AGENT __ATOMIC_RELAXED, __HIP_MEMORY_SCOPE_AGENT
#define LDS_WAIT() asm volatile("s_waitcnt lgkmcnt(0)" ::: "memory")
#define VM_WAIT() asm volatile("s_waitcnt vmcnt(0)" ::: "memory")
__device__ __forceinline__ unsigned long long rt() { return __builtin_amdgcn_s_memrealtime(); }
__device__ __forceinline__ unsigned f2bf(float f) { unsigned u = __builtin_bit_cast(unsigned, f); return (u + 0x7fffu + ((u >> 16) & 1u)) >> 16; }
__device__ __forceinline__ unsigned pk2(float lo, float hi) { return f2bf(lo) | (f2bf(hi) << 16); }

#define XB_TMO      128
#define XB_XCNT(j)  (256  + 64 * (j))
#define XB_XSUB(j)  (1280 + 64 * (j))
#define XB_XGEN(j)  (2304 + 64 * (j))
#define XB_TOP      3328
#define XB_TOPGEN   3392
#define XCD_BAR_WORDS 3456
#define XB_SPIN_CAP (1u << 18)

__device__ __forceinline__ unsigned xb_ld(unsigned* p)              { return __hip_atomic_load(p, __ATOMIC_RELAXED, __HIP_MEMORY_SCOPE_AGENT); }
__device__ __forceinline__ unsigned xb_add(unsigned* p, unsigned v) { return __hip_atomic_fetch_add(p, v, __ATOMIC_RELAXED, __HIP_MEMORY_SCOPE_AGENT); }
__device__ __forceinline__ unsigned xb_xcc_id() { return (unsigned)__builtin_amdgcn_s_getreg((3 << 11) | 20) & 0xFu; }
#define XB_SPIN(cond, bar) do { unsigned _sp = 0; while (cond) { __builtin_amdgcn_s_sleep(1); \
    if ((++_sp & 255u) == 0u) { if (xb_ld(&(bar)[XB_TMO])) break; if (_sp > XB_SPIN_CAP) { atomicAdd(&(bar)[XB_TMO], 1u); break; } } } } while (0)

struct XcdBarrier {
    unsigned* bar; unsigned x;
    volatile LAS unsigned* st;
};

__device__ __forceinline__ XcdBarrier xcd_barrier_post(unsigned* bar, volatile LAS unsigned* st) {
    XcdBarrier b; b.bar = bar; b.x = xb_xcc_id(); b.st = st;
    if (threadIdx.x == 0) (void)xb_add(&bar[XB_XCNT(b.x)], 1u);
    return b;
}
__device__ __forceinline__ void xcd_barrier_complete(unsigned* bar, unsigned x, unsigned& nloc, unsigned& nx) {
    const unsigned G = gridDim.x * gridDim.y * gridDim.z;
    unsigned sum, cnt, mine, sp = 0u;
    for (;;) {
        sum = 0u; cnt = 0u; mine = 0u;
#pragma unroll
        for (unsigned j = 0; j < 16; ++j) { const unsigned c = xb_ld(&bar[XB_XCNT(j)]); sum += c; cnt += (c > 0u) ? 1u : 0u; mine = (j == x) ? c : mine; }
        if (sum == G) break;
        __builtin_amdgcn_s_sleep(1);
        if ((++sp & 255u) == 0u) { if (xb_ld(&bar[XB_TMO])) break; if (sp > XB_SPIN_CAP) { atomicAdd(&bar[XB_TMO], 1u); break; } }
    }
    nloc = mine > 0u ? mine : 1u; nx = cnt > 0u ? cnt : 1u;
}

__device__ __forceinline__ void xcd_barrier(const XcdBarrier& b) {
    asm volatile("s_waitcnt vmcnt(0)" ::: "memory");
    __syncthreads();
    if (threadIdx.x == 0) {
        unsigned* bar = b.bar;
        __builtin_amdgcn_s_waitcnt(0);
        unsigned nloc = b.st[0], nx = b.st[1];
        if (nloc == 0u) { xcd_barrier_complete(bar, b.x, nloc, nx); b.st[0] = nloc; b.st[1] = nx; }
        const unsigned old = xb_add(&bar[XB_XSUB(b.x)], 1u);
        const unsigned gen = old / nloc;
        if (old + 1u == (gen + 1u) * nloc) {
            __builtin_amdgcn_fence(__ATOMIC_RELEASE, "agent");
            asm volatile("s_waitcnt vmcnt(0)" ::: "memory");
            const unsigned og = xb_add(&bar[XB_TOP], 1u);
            const unsigned tg = og / nx;
            if (og + 1u == (tg + 1u) * nx) xb_add(&bar[XB_TOPGEN], 1u);
            else XB_SPIN(xb_ld(&bar[XB_TOPGEN]) == tg, bar);
            __builtin_amdgcn_fence(__ATOMIC_ACQUIRE, "agent");
            xb_add(&bar[XB_XGEN(b.x)], 1u);
            asm volatile("s_waitcnt vmcnt(0)" ::: "memory");
        } else {
            XB_SPIN(xb_ld(&bar[XB_XGEN(b.x)]) == gen, bar);
            __builtin_amdgcn_fence(__ATOMIC_ACQUIRE, "agent");
            asm volatile("s_waitcnt vmcnt(0)" ::: "memory");
        }
    }
    __syncthreads();
}


struct Args { const float* in[21]; float* out; unsigned char* ws; int ph_lo, ph_hi, use_bar, pad; };
struct Frame {
    LAS unsigned char* lds; volatile LAS unsigned* MISC; gu32* ctl;
    int vcu, G;
};
__device__ __forceinline__ int tid_() { int t = threadIdx.x; asm volatile("" : "+v"(t)); return t; }
#define FTID (tid_())
#define FLANE (tid_() & 63)
#define FWAVE (__builtin_amdgcn_readfirstlane(tid_() >> 6))
__device__ __forceinline__ float wave_sum(float v) {
#pragma unroll
    for (int o = 1; o < 64; o <<= 1) v += __shfl_xor(v, o);
    return v;
}
#define LBAR() do { asm volatile("s_waitcnt lgkmcnt(0)" ::: "memory"); __builtin_amdgcn_s_barrier(); asm volatile("" ::: "memory"); } while (0)
__device__ __forceinline__ float bf2f_(unsigned short b) { return __uint_as_float((unsigned)b << 16); }
__device__ __forceinline__ float bflo_(unsigned w) { return __uint_as_float(w << 16); }
__device__ __forceinline__ float bfhi_(unsigned w) { return __uint_as_float(w & 0xffff0000u); }

__device__ __forceinline__ int win_src_col(int np) {
    const int tile = np >> 8, p = np & 255;
    if (tile < 4) { const int base = (tile >> 1) * 512, head = 2 * (tile & 1) + (p >> 7), pp = p & 127; return base + head * 128 + (pp & 1) * 64 + (pp >> 1); }
    if (tile >= 12 && tile < 20) { const int h = tile - 12; return 3072 + (p & 1) * 1024 + h * 128 + (p >> 1); }
    return np;
}
template <bool MAP> __device__ __forceinline__ void p0_transpose_item(const float* W, int K, int N, bf16* WT, LAS float* scr, int item, int lane, const float* gk = nullptr) {
    const int nblk = N / 32, kb = item / nblk, nb = item % nblk, k0 = 64 * kb, n0 = 32 * nb;
    const int srcc = MAP ? win_src_col(n0 + (lane & 31)) : n0 + (lane & 31);
#pragma unroll 8
    for (int i = 0; i < 32; ++i) { const int kk = 2 * i + (lane >> 5); scr[kk * 33 + (lane & 31)] = W[(size_t)(k0 + kk) * N + srcc]; }
    LDS_WAIT(); asm volatile("" ::: "memory");
    const int c = lane & 7;
    f32x4 ga = (f32x4){1.f, 1.f, 1.f, 1.f}, gb = ga;
    if (gk) { ga = *(const f32x4*)(gk + k0 + 8 * c); gb = *(const f32x4*)(gk + k0 + 8 * c + 4); }
#pragma unroll
    for (int j = 0; j < 4; ++j) { const int n = (lane >> 3) + 8 * j; const LAS float* s = scr + (8 * c) * 33 + n;
        v4u o; o.x = pk2(s[0 * 33] * ga.x, s[1 * 33] * ga.y); o.y = pk2(s[2 * 33] * ga.z, s[3 * 33] * ga.w); o.z = pk2(s[4 * 33] * gb.x, s[5 * 33] * gb.y); o.w = pk2(s[6 * 33] * gb.z, s[7 * 33] * gb.w);
        *(GAS v4u*)(WT + (size_t)(n0 + n) * K + k0 + 8 * c) = o; }
    LDS_WAIT(); asm volatile("" ::: "memory");
}
__device__ __forceinline__ void p0_prologue(Frame& F, const Args& a) { const int tid_v = tid_(); const int lane_v = tid_v & 63; const int wave_v = __builtin_amdgcn_readfirstlane(tid_v >> 6); (void)lane_v; (void)wave_v;
    unsigned char* ws = a.ws;
    LAS float* scr = (LAS float*)(F.lds + RING_OFF + wave_v * 16384);
    const int gw = F.vcu * NWAVES + wave_v, NGW = F.G * NWAVES;
    constexpr int I_IN = (DM / 64) * (DIN / 32), I_SQ = (DM / 64) * (DM / 32), I_F1 = (DM / 64) * (DFF / 32), I_F2 = (DFF / 64) * (DM / 32), I_PJ = (DPLE / 64) * (DM / 32);
    constexpr int NITEMS = I_IN + 4 * I_SQ + I_F1 + I_F2 + I_PJ;
    for (int it = gw; it < NITEMS; it += NGW) {
        int r = it;
        if (r < I_IN) { p0_transpose_item<true>(a.in[7], DM, DIN, (bf16*)(ws + WS_WIN), scr, r, lane_v, a.in[6]); continue; } r -= I_IN;
        if (r < I_SQ) { p0_transpose_item<false>(a.in[11], DM, DM, (bf16*)(ws + WS_WUPR), scr, r, lane_v); continue; } r -= I_SQ;
        if (r < I_SQ) { p0_transpose_item<false>(a.in[12], DM, DM, (bf16*)(ws + WS_WUPH), scr, r, lane_v); continue; } r -= I_SQ;
        if (r < I_SQ) { p0_transpose_item<false>(a.in[13], DM, DM, (bf16*)(ws + WS_WO), scr, r, lane_v); continue; } r -= I_SQ;
        if (r < I_SQ) { p0_transpose_item<false>(a.in[18], DM, DM, (bf16*)(ws + WS_WGATE), scr, r, lane_v, a.in[17]); continue; } r -= I_SQ;
        if (r < I_F1) { p0_transpose_item<false>(a.in[15], DM, DFF, (bf16*)(ws + WS_WFF1), scr, r, lane_v, a.in[14]); continue; } r -= I_F1;
        if (r < I_F2) { p0_transpose_item<false>(a.in[16], DFF, DM, (bf16*)(ws + WS_WFF2), scr, r, lane_v); continue; } r -= I_F2;
        p0_transpose_item<false>(a.in[19], DPLE, DM, (bf16*)(ws + WS_WPROJ), scr, r, lane_v);
    }
    bf16* XB = (bf16*)(a.out + OFF_RETS); float* RSTD0 = (float*)(ws + WS_RSTD0); bf16* PB = (bf16*)(ws + WS_PB);
    for (int m = gw; m < MP; m += NGW) {
        GAS unsigned long long* o8 = (GAS unsigned long long*)(XB + (size_t)m * DM) + lane_v;
        GAS unsigned long long* p8 = (GAS unsigned long long*)(PB + (size_t)m * DPLE) + lane_v;
        if (m >= MTOT) {
#pragma unroll
            for (int j = 0; j < 4; ++j) o8[64 * j] = 0ull;
            p8[0] = 0ull; if (lane_v == 0) RSTD0[m] = 0.f; continue;
        }
        const float* xrow = m < MPROMPT ? a.in[0] + (size_t)m * DM : a.in[1] + (size_t)(m - MPROMPT) * DM;
        const float* prow = m < MPROMPT ? a.in[4] + (size_t)m * DPLE : a.in[5] + (size_t)(m - MPROMPT) * DPLE;
        const GAS f32x4* xr = (const GAS f32x4*)xrow + lane_v;
        f32x4 v[4]; float s = 0.f;
#pragma unroll
        for (int j = 0; j < 4; ++j) { v[j] = xr[64 * j]; s += (v[j].x * v[j].x + v[j].y * v[j].y) + (v[j].z * v[j].z + v[j].w * v[j].w); }
        s = wave_sum(s);
        if (lane_v == 0) RSTD0[m] = rsqrtf(s * (1.0f / DM) + EPS);
#pragma unroll
        for (int j = 0; j < 4; ++j) o8[64 * j] = (unsigned long long)pk2(v[j].x, v[j].y) | ((unsigned long long)pk2(v[j].z, v[j].w) << 32);
        const f32x4 pv = *((const GAS f32x4*)prow + lane_v);
        p8[0] = (unsigned long long)pk2(pv.x, pv.y) | ((unsigned long long)pk2(pv.z, pv.w) << 32);
    }
    float* CS = (float*)(ws + WS_CS); float* LB = (float*)(ws + WS_LB);
    const int gt = (F.vcu * NWAVES + wave_v) * 64 + lane_v, NGT = NGW * 64;
    for (int i = gt; i < 2049 * 64; i += NGT) {
        const int pi = i >> 6, j = i & 63; const double pos = pi == SEQ ? 16384.0 : (double)pi;
        const double ang = pos * pow(10000.0, -(double)j / 64.0);
        CS[2 * i] = (float)cos(ang); CS[2 * i + 1] = (float)sin(ang);
    }
    for (int i = gt; i < DM; i += NGT) { const float a0 = a.in[10][i], a1 = a.in[10][DM + i]; LB[i] = 1.0f / (1.0f + expf(a1 - a0)); }
}

typedef float f32x16 __attribute__((ext_vector_type(16)));
typedef short v4i16_t __attribute__((ext_vector_type(4)));
typedef unsigned u32x2 __attribute__((ext_vector_type(2)));
typedef float f32x2_t __attribute__((ext_vector_type(2))); typedef __bf16 bf16x2_t __attribute__((ext_vector_type(2)));
__device__ __forceinline__ unsigned cvtpk_s(float lo, float hi) { f32x2_t v = {lo, hi}; bf16x2_t b = __builtin_convertvector(v, bf16x2_t); return __builtin_bit_cast(unsigned, b); }
__device__ __forceinline__ unsigned off_b(unsigned row, unsigned ch) { return 256u * row + 16u * (ch ^ (((row & 3) << 2) | ((row >> 2) & 3))); }
__device__ __forceinline__ bf16x8 rd_row(LAS unsigned char* img, unsigned row, unsigned ks, unsigned h) { return *(const LAS bf16x8*)(img + off_b(row, 2 * ks + h)); }
__device__ __forceinline__ bf16x8 rd_tr(LAS unsigned char* img, unsigned lane, unsigned c, unsigned ks) {
    const unsigned h = lane >> 5, blk = (lane >> 4) & 1, q = (lane & 15) >> 2, p = lane & 3;
    const unsigned a0 = off_b(16 * ks + 8 * h + q, 4 * c + 2 * blk + (p >> 1)) + 8 * (p & 1);
    const unsigned a1 = off_b(16 * ks + 8 * h + 4 + q, 4 * c + 2 * blk + (p >> 1)) + 8 * (p & 1);
    const v4i16_t lo = __builtin_amdgcn_ds_read_tr16_b64_v4i16((LAS v4i16_t*)(img + a0));
    const v4i16_t hi = __builtin_amdgcn_ds_read_tr16_b64_v4i16((LAS v4i16_t*)(img + a1));
    return __builtin_shufflevector(lo, hi, 0, 1, 2, 3, 4, 5, 6, 7);
}
#define MFMA32(a, b, c) __builtin_amdgcn_mfma_f32_32x32x16_bf16((a), (b), (c), 0, 0, 0)
__device__ __forceinline__ void scan_item(Frame& F, const Args& a, int item) { const int tid_v = tid_(); const int lane_v = tid_v & 63; const int wave_v = __builtin_amdgcn_readfirstlane(tid_v >> 6); (void)lane_v; (void)wave_v;
    unsigned char* ws = a.ws;
    const bool isg = item >= 128; const int it = isg ? item - 128 : item;
    int b, hd, dv0, ldq; const bf16 *Qp, *Kp; bf16* Vp; float* Sout; const float* GLp = nullptr; float sdec = 1.f;
    if (!isg) { b = it >> 4; hd = (it >> 2) & 3; dv0 = (it & 3) * 64; ldq = 512;
        Qp = (const bf16*)(ws + Z_QR) + hd * 128; Kp = (const bf16*)(ws + Z_KR) + hd * 128; Vp = (bf16*)(ws + Z_VR) + hd * 256 + dv0;
        Sout = a.out + OFF_RETP + ((size_t)(b * HR + hd) * DKR) * DVR + dv0; sdec = __expf(64.0f * __logf(1.0f - exp2f(-5.0f - (float)hd))); }
    else { b = it >> 4; hd = (it >> 1) & 7; dv0 = (it & 1) * 64; ldq = 1024;
        Qp = (const bf16*)(ws + Z_QG) + hd * 128; Kp = (const bf16*)(ws + Z_KG) + hd * 128; Vp = (bf16*)(ws + Z_VG) + hd * 128 + dv0;
        Sout = a.out + OFF_HGP + ((size_t)(b * HG + hd) * DKG) * DVG + dv0; GLp = (const float*)(ws + WS_GL) + hd * 128; }
#if PROBE_ON && PROBE_SKINNY == 2
    const unsigned pt0_ = (unsigned)rt();
#endif
    const int ldo = isg ? DVG : DVR;
    LAS unsigned char* QI = F.lds; LAS unsigned char* KI = QI + 16384; LAS unsigned char* VI = KI + 16384; LAS unsigned char* PI = VI + 16384; LAS unsigned char* SI = PI + 16384;
    LAS unsigned char* OI = SI + 16384;
    const int tid = tid_v, lane = lane_v, w = wave_v; const unsigned r = lane & 31, h = lane >> 5;
    const int kb = w >> 1, dvb = w & 1;
    for (int i = tid; i < 16384 / 4; i += 512) ((LAS unsigned*)SI)[i] = 0u;
    f32x16 S;
#pragma unroll
    for (int i = 0; i < 16; ++i) S[i] = 0.f;
    const int qr0 = tid >> 4, qc0 = tid & 15, vr0 = tid >> 3, vc0 = tid & 7;
    const size_t rowb = (size_t)b * SEQ;
    v4u aq0, aq1, ak0, ak1, av, bq0, bq1, bk0, bk1, bv; f32x4 ag0, ag1, ag2, ag3, bg0, bg1, bg2, bg3;
    const float* glb = isg ? GLp + (size_t)b * (SEQ / CH) * DM + 32 * kb + 4 * h : nullptr;
#define SCAN_LOAD(c, Q0, Q1, K0, K1, V, G0, G1, G2, G3) do { const size_t r0_ = rowb + (size_t)(c) * CH; \
        Q0 = *(const v4u*)(Qp + (r0_ + qr0) * ldq + qc0 * 8); Q1 = *(const v4u*)(Qp + (r0_ + qr0 + 32) * ldq + qc0 * 8); \
        K0 = *(const v4u*)(Kp + (r0_ + qr0) * ldq + qc0 * 8); K1 = *(const v4u*)(Kp + (r0_ + qr0 + 32) * ldq + qc0 * 8); \
        V = *(const v4u*)(Vp + (r0_ + vr0) * DM + vc0 * 8); \
        if (isg) { const float* g_ = glb + (size_t)(c) * DM; G0 = *(const f32x4*)g_; G1 = *(const f32x4*)(g_ + 8); G2 = *(const f32x4*)(g_ + 16); G3 = *(const f32x4*)(g_ + 24); } } while (0)
    ag0 = ag1 = ag2 = ag3 = bg0 = bg1 = bg2 = bg3 = (f32x4){sdec, sdec, sdec, sdec};
    SCAN_LOAD(0, aq0, aq1, ak0, ak1, av, ag0, ag1, ag2, ag3);
    SCAN_LOAD(1, bq0, bq1, bk0, bk1, bv, bg0, bg1, bg2, bg3);
    const unsigned oi_off = (unsigned)(vr0 * 128 + 16 * (vc0 ^ (vr0 & 7)));
#define SCAN_DS(G0, G1, G2, G3) do { bf16x8 A[4], B[4]; \
        _Pragma("unroll") for (int ks = 0; ks < 4; ++ks) { A[ks] = rd_tr(KI, lane, kb, ks); B[ks] = rd_tr(VI, lane, dvb, ks); } \
        __builtin_amdgcn_sched_barrier(0); \
        f32x16 d; _Pragma("unroll") for (int i = 0; i < 16; ++i) d[i] = 0.f; \
        _Pragma("unroll") for (int ks = 0; ks < 4; ++ks) d = MFMA32(A[ks], B[ks], d); \
        _Pragma("unroll") for (int i = 0; i < 4; ++i) { S[i] = G0[i] * (S[i] + d[i]); S[4 + i] = G1[i] * (S[4 + i] + d[4 + i]); S[8 + i] = G2[i] * (S[8 + i] + d[8 + i]); S[12 + i] = G3[i] * (S[12 + i] + d[12 + i]); } } while (0)
#define SCAN_BODY(c, Q0, Q1, K0, K1, V, G0, G1, G2, G3) do { \
        LBAR();                                                   \
        if ((c) > 0) *(v4u*)(Vp + (rowb + (size_t)((c) - 1) * CH + vr0) * DM + vc0 * 8) = *(const LAS v4u*)(OI + oi_off);     \
        *(LAS v4u*)(QI + off_b(qr0, qc0)) = Q0; *(LAS v4u*)(QI + off_b(qr0 + 32, qc0)) = Q1; \
        *(LAS v4u*)(KI + off_b(qr0, qc0)) = K0; *(LAS v4u*)(KI + off_b(qr0 + 32, qc0)) = K1; \
        *(LAS v4u*)(VI + off_b(vr0, vc0)) = V; \
        const f32x4 g0 = G0, g1 = G1, g2 = G2, g3 = G3;          \
        if ((c) > 0) {                                            \
            _Pragma("unroll") for (int g = 0; g < 4; ++g) { u32x2 wv; wv.x = cvtpk_s(S[4 * g], S[4 * g + 1]); wv.y = cvtpk_s(S[4 * g + 2], S[4 * g + 3]); \
                *(LAS u32x2*)(SI + off_b(32 * dvb + r, 4 * kb + g) + 8 * h) = wv; } \
        } \
        if ((c) + 2 < SEQ / CH) SCAN_LOAD((c) + 2, Q0, Q1, K0, K1, V, G0, G1, G2, G3); \
        LBAR(); \
        if (w < 4) SCAN_DS(g0, g1, g2, g3); \
        else if (w < 7) {                                         \
            const int sb = (w - 4) >> 1, tb = (w - 3) >> 1; \
            bf16x8 A[8], B[8]; \
            _Pragma("unroll") for (int ks = 0; ks < 8; ++ks) { A[ks] = rd_row(KI, 32 * sb + r, ks, h); B[ks] = rd_row(QI, 32 * tb + r, ks, h); } \
            __builtin_amdgcn_sched_barrier(0); \
            f32x16 p; _Pragma("unroll") for (int i = 0; i < 16; ++i) p[i] = 0.f; \
            _Pragma("unroll") for (int ks = 0; ks < 8; ++ks) p = MFMA32(A[ks], B[ks], p); \
            _Pragma("unroll") for (int g = 0; g < 4; ++g) { float v[4]; \
                _Pragma("unroll") for (int i = 0; i < 4; ++i) { const int sl = 8 * g + 4 * (int)h + i; v[i] = (sb != tb || sl <= (int)r) ? p[4 * g + i] : 0.f; } \
                u32x2 wv; wv.x = cvtpk_s(v[0], v[1]); wv.y = cvtpk_s(v[2], v[3]); \
                *(LAS u32x2*)(PI + off_b(32 * tb + r, 4 * sb + g) + 8 * h) = wv; } \
        } \
        LBAR(); \
        if (w < 4) {                                              \
            const int ob = w >> 1, tb = w & 1; \
            f32x16 o; _Pragma("unroll") for (int i = 0; i < 16; ++i) o[i] = 0.f; \
            {   bf16x8 A[4], B[4]; \
                _Pragma("unroll") for (int ks = 0; ks < 4; ++ks) { A[ks] = rd_tr(VI, lane, ob, ks); B[ks] = rd_row(PI, 32 * tb + r, ks, h); } \
                __builtin_amdgcn_sched_barrier(0); \
                _Pragma("unroll") for (int ks = 0; ks < 4; ++ks) if (ks < 2 || tb == 1) o = MFMA32(A[ks], B[ks], o); } \
            {   bf16x8 A[8], B[8]; \
                _Pragma("unroll") for (int ks = 0; ks < 8; ++ks) { A[ks] = rd_row(SI, 32 * ob + r, ks, h); B[ks] = rd_row(QI, 32 * tb + r, ks, h); } \
                __builtin_amdgcn_sched_barrier(0); \
                _Pragma("unroll") for (int ks = 0; ks < 8; ++ks) o = MFMA32(A[ks], B[ks], o); } \
              \
            _Pragma("unroll") for (int g = 0; g < 4; ++g) { u32x2 wv; wv.x = cvtpk_s(o[4 * g], o[4 * g + 1]); wv.y = cvtpk_s(o[4 * g + 2], o[4 * g + 3]); \
                const unsigned t_ = 32 * tb + r, ch_ = 4 * ob + g; *(LAS u32x2*)(OI + t_ * 128 + 16 * (ch_ ^ (t_ & 7)) + 8 * h) = wv; } \
        } else SCAN_DS(g0, g1, g2, g3); \
    } while (0)
#pragma unroll 1
    for (int c = 0; c < SEQ / CH; c += 2) {
        SCAN_BODY(c, aq0, aq1, ak0, ak1, av, ag0, ag1, ag2, ag3);
        SCAN_BODY(c + 1, bq0, bq1, bk0, bk1, bv, bg0, bg1, bg2, bg3);
    }
#undef SCAN_BODY
#undef SCAN_DS
#undef SCAN_LOAD
    LBAR();
    *(v4u*)(Vp + (rowb + (size_t)(SEQ / CH - 1) * CH + vr0) * DM + vc0 * 8) = *(const LAS v4u*)(OI + oi_off);
#pragma unroll
    for (int i = 0; i < 16; ++i) { const int k = 32 * kb + (i & 3) + 8 * (i >> 2) + 4 * (int)h; Sout[(size_t)k * ldo + 32 * dvb + r] = S[i]; }
    __syncthreads();
#if PROBE_ON && PROBE_SKINNY == 2
    if (threadIdx.x == 0) F.MISC[18] += (unsigned)rt() - pt0_;
#endif
}

template <bool ISG> __device__ __forceinline__ void dec_load(const Args& a, int item, int tid, int lane, int w, f32x4 (&s)[16], float& qkf, unsigned long long& vw) {
    unsigned char* ws = a.ws;
    if (!ISG) { const int n = item >> 2, h = item & 3, row = MPROMPT + n;
        const float* S0 = a.in[2] + ((size_t)(n * HR + h) * DKR) * DVR;
#pragma unroll
        for (int i = 0; i < 16; ++i) s[i] = *(const f32x4*)(S0 + ((size_t)(w + 8 * i) * 64 + lane) * 4);
        qkf = tid < 128 ? bf2f_(((const bf16*)(ws + Z_QR))[(size_t)row * 512 + h * 128 + tid]) : tid < 256 ? bf2f_(((const bf16*)(ws + Z_KR))[(size_t)row * 512 + h * 128 + tid - 128]) : 0.f;
        vw = *(const unsigned long long*)((const bf16*)(ws + Z_VR) + (size_t)row * DM + h * 256 + 4 * lane);
    } else { const int n = item >> 3, h = item & 7, row = MPROMPT + n;
        const float* S0 = a.in[3] + ((size_t)(n * HG + h) * DKG) * DVG;
#pragma unroll
        for (int i = 0; i < 8; ++i) s[i] = *(const f32x4*)(S0 + ((size_t)(w + 8 * i) * 64 + lane) * 4);
        qkf = tid < 128 ? bf2f_(((const bf16*)(ws + Z_QG))[(size_t)row * DM + h * 128 + tid]) : tid < 256 ? bf2f_(((const bf16*)(ws + Z_KG))[(size_t)row * DM + h * 128 + tid - 128])
            : tid < 384 ? ((const float*)(ws + WS_FS))[(size_t)n * DM + h * 128 + tid - 256] : 0.f;
        vw = *(const unsigned long long*)((const bf16*)(ws + Z_VG) + (size_t)row * DM + h * 128 + 4 * (lane & 31));
    }
}
template <bool ISG> __device__ __forceinline__ void dec_compute(Frame& F, const Args& a, int item, int tid, int lane, int w, const f32x4 (&s)[16], float qkf, unsigned long long vw) {
    unsigned char* ws = a.ws;
    LAS float* qs = (LAS float*)(F.lds); LAS float* red = qs + 384; LAS float* part = red + 8 * 256;
    LAS float* ks = qs + 128; LAS float* fs = qs + 256;
    if (tid < 384) qs[tid] = qkf;
    const f32x4 v = (f32x4){bflo_((unsigned)vw), bfhi_((unsigned)vw), bflo_((unsigned)(vw >> 32)), bfhi_((unsigned)(vw >> 32))};
    LBAR();
    f32x4 o = (f32x4){0.f, 0.f, 0.f, 0.f};
    if (!ISG) { const int n = item >> 2, h = item & 3; const float gam = 1.0f - exp2f(-5.0f - (float)h);
        float* S1 = a.out + OFF_RETS + ((size_t)(n * HR + h) * DKR) * DVR;
#pragma unroll
        for (int i = 0; i < 16; ++i) { const int k = w + 8 * i; const f32x4 sn = s[i] * gam + v * ks[k]; *(f32x4*)(S1 + ((size_t)k * 64 + lane) * 4) = sn; o += sn * qs[k]; }
    } else { const int n = item >> 3, h = item & 7;
        float* S1 = a.out + OFF_HGS + ((size_t)(n * HG + h) * DKG) * DVG;
#pragma unroll
        for (int i = 0; i < 8; ++i) { const int k = 2 * (w + 8 * i) + (lane >> 5); const f32x4 sn = s[i] * fs[k] + v * ks[k]; *(f32x4*)(S1 + ((size_t)(w + 8 * i) * 64 + lane) * 4) = sn; o += sn * qs[k]; }
    }
    *(LAS f32x4*)(red + w * 256 + 4 * lane) = o;
    LBAR();
    constexpr int NDV = ISG ? 128 : 256; float ov = 0.f;
    if (tid < NDV) {
        if (!ISG) {
#pragma unroll
            for (int i = 0; i < 8; ++i) ov += red[i * 256 + tid];
        } else {
#pragma unroll
            for (int i = 0; i < 8; ++i) ov += red[i * 256 + tid] + red[i * 256 + 128 + tid];
        }
        const float ss = wave_sum(ov * ov); if (lane == 0) part[w] = ss;
    }
    LBAR();
    if (tid < NDV) {
        const float rstd = rsqrtf((ISG ? (part[0] + part[1]) : ((part[0] + part[1]) + (part[2] + part[3]))) * (1.0f / NDV) + EPS);
        const int n = ISG ? item >> 3 : item >> 2, h = ISG ? item & 7 : item & 3, row = MPROMPT + n;
        bf16* gp = (bf16*)(ws + (ISG ? WS_GG : WS_GR)) + (size_t)row * DM + h * NDV + tid;
        const float gv_ = bf2f_(*gp); *gp = (bf16)f2bf(ov * rstd * a.in[ISG ? 9 : 8][h * NDV + tid] * (gv_ / (1.0f + __expf(-gv_))));
    }
    LBAR();
}
__device__ __forceinline__ void decode_all(Frame& F, const Args& a) { const int tid_v = tid_(); const int lane_v = tid_v & 63; const int wave_v = __builtin_amdgcn_readfirstlane(tid_v >> 6);
    const int tid = tid_v, lane = lane_v, w = wave_v, c = F.vcu, G = F.G;
    f32x4 sa[16], sb[16]; float qa, qb; unsigned long long va, vb;
    dec_load<false>(a, c, tid, lane, w, sa, qa, va);
    dec_load<false>(a, c + G, tid, lane, w, sb, qb, vb);          dec_compute<false>(F, a, c, tid, lane, w, sa, qa, va);
    dec_load<true>(a, c, tid, lane, w, sa, qa, va);              dec_compute<false>(F, a, c + G, tid, lane, w, sb, qb, vb);
    dec_load<true>(a, c + G, tid, lane, w, sb, qb, vb);          dec_compute<true>(F, a, c, tid, lane, w, sa, qa, va);
    dec_load<true>(a, c + 2 * G, tid, lane, w, sa, qa, va);      dec_compute<true>(F, a, c + G, tid, lane, w, sb, qb, vb);
    dec_load<true>(a, c + 3 * G, tid, lane, w, sb, qb, vb);      dec_compute<true>(F, a, c + 2 * G, tid, lane, w, sa, qa, va);
    dec_compute<true>(F, a, c + 3 * G, tid, lane, w, sb, qb, vb);
}

__device__ __forceinline__ void p3_headnorm(Frame& F, const Args& a) { const int tid_v = tid_(); const int lane_v = tid_v & 63; const int wave_v = __builtin_amdgcn_readfirstlane(tid_v >> 6); (void)lane_v; (void)wave_v;
    unsigned char* ws = a.ws; const int gw = F.vcu * NWAVES + wave_v, NGW = F.G * NWAVES, lane = lane_v;
    constexpr int NIT = MPROMPT * 8, U = 4;
    for (int it0 = gw; it0 < NIT; it0 += U * NGW) {
        unsigned long long ow[U], gwd[U]; f32x4 gn[U]; unsigned long long* gp[U]; bool isg[U], ok[U];
#pragma unroll
        for (int u = 0; u < U; ++u) {
            const int it = it0 + u * NGW; ok[u] = it < NIT; const int itc = ok[u] ? it : gw;
            isg[u] = itc >= MPROMPT * 4; const int i2 = isg[u] ? itc - MPROMPT * 4 : itc; const int row = i2 >> 2, q = i2 & 3;
            const size_t off = (size_t)row * DM + q * 256 + 4 * lane;
            ow[u] = *(const unsigned long long*)((const bf16*)(ws + (isg[u] ? Z_VG : Z_VR)) + off);
            gp[u] = (unsigned long long*)((bf16*)(ws + (isg[u] ? WS_GG : WS_GR)) + off); gwd[u] = *gp[u];
            gn[u] = *(const f32x4*)(a.in[isg[u] ? 9 : 8] + q * 256 + 4 * lane);
        }
#pragma unroll
        for (int u = 0; u < U; ++u) {
            const f32x4 o = (f32x4){bflo_((unsigned)ow[u]), bfhi_((unsigned)ow[u]), bflo_((unsigned)(ow[u] >> 32)), bfhi_((unsigned)(ow[u] >> 32))};
            f32x4 gt = (f32x4){bflo_((unsigned)gwd[u]), bfhi_((unsigned)gwd[u]), bflo_((unsigned)(gwd[u] >> 32)), bfhi_((unsigned)(gwd[u] >> 32))};
            gt.x = gt.x / (1.0f + __expf(-gt.x)); gt.y = gt.y / (1.0f + __expf(-gt.y)); gt.z = gt.z / (1.0f + __expf(-gt.z)); gt.w = gt.w / (1.0f + __expf(-gt.w));
            float ss = (o.x * o.x + o.y * o.y) + (o.z * o.z + o.w * o.w);
#pragma unroll
            for (int d = 1; d < 32; d <<= 1) ss += __shfl_xor(ss, d);
            if (!isg[u]) ss += __shfl_xor(ss, 32);
            const float rstd = rsqrtf(ss * (isg[u] ? 1.0f / DVG : 1.0f / DVR) + EPS);
            const f32x4 x = o * rstd * gn[u] * gt;
            if (ok[u]) *gp[u] = (unsigned long long)pk2(x.x, x.y) | ((unsigned long long)pk2(x.z, x.w) << 32);
        }
    }
}

__device__ __forceinline__ void p9_final(Frame& F, const Args& a) { const int tid_v = tid_(); const int lane_v = tid_v & 63; const int wave_v = __builtin_amdgcn_readfirstlane(tid_v >> 6); (void)lane_v; (void)wave_v;
    const int gw = F.vcu * NWAVES + wave_v, NGW = F.G * NWAVES, lane = lane_v; const float* PS3 = (const float*)(a.ws + WS_PS3); const float* gf = a.in[20];
    for (int m = gw; m < MTOT; m += NGW) {
        const float pv = m < MPROMPT ? (lane < 16 ? PS3[(size_t)m * 16 + lane] : 0.f) : ((const float*)(a.ws + WS_PSS3))[(size_t)(m - MPROMPT) * 64 + lane];
        const float rstd = rsqrtf(wave_sum(pv) * (1.0f / DM) + EPS);
        const unsigned long long* r16 = (const unsigned long long*)((const bf16*)(a.ws + WS_A5) + (size_t)m * DM) + lane;
        f32x4* y = (f32x4*)(a.out + (size_t)m * DM) + lane;
#pragma unroll
        for (int j = 0; j < 4; ++j) { const unsigned long long w = r16[64 * j]; const f32x4 gv = *((const f32x4*)gf + 64 * j + lane);
            y[64 * j] = (f32x4){bflo_((unsigned)w), bfhi_((unsigned)w), bflo_((unsigned)(w >> 32)), bfhi_((unsigned)(w >> 32))} * rstd * gv; }
    }
}

template <int K, class FE> __device__ __forceinline__ void skinny_gemm(Frame& F, const bf16* As, const bf16* Wt, int N, const FE& fe, int it0 = 0, int it1 = 1 << 30) {     const int tid_v = tid_(); const int lane_v = tid_v & 63; const int wave_v = __builtin_amdgcn_readfirstlane(tid_v >> 6); (void)lane_v; (void)wave_v;
    constexpr int KW = K / 4, NKS = KW / 32, CH_KS = NKS < 8 ? NKS : 8, NCH = NKS / CH_KS;
    const int lane = lane_v, fr = lane & 15, fq = lane >> 4, rg = wave_v >> 2, ks = wave_v & 3;
    LAS f32x4* red = (LAS f32x4*)(F.lds);
    const int ntile = 4 * (N / 16);
#if PROBE_ON && PROBE_SKINNY == 1
    const unsigned ps0_ = (unsigned)rt();
#endif
    for (int itn = it0; itn < it1; ++itn) {
        const int tile = F.vcu + itn * F.G; if (tile >= ntile) break;
        const int rb = tile & 3, cb = tile >> 2;
        const bf16* ap = Wt + (size_t)(16 * cb + fr) * K + ks * KW + 8 * fq;
        const bf16* bp = As + (size_t)(32 * rb + 16 * rg + fr) * K + ks * KW + 8 * fq;
        f32x4 acc = (f32x4){0.f, 0.f, 0.f, 0.f};
#pragma unroll 1
        for (int c = 0; c < NCH; ++c) {
            bf16x8 a[CH_KS], b[CH_KS];
#pragma unroll
            for (int i = 0; i < CH_KS; ++i) { a[i] = *(const bf16x8*)(ap + (c * CH_KS + i) * 32); b[i] = *(const bf16x8*)(bp + (c * CH_KS + i) * 32); }
#pragma unroll
            for (int i = 0; i < CH_KS; ++i) acc = __builtin_amdgcn_mfma_f32_16x16x32_bf16(a[i], b[i], acc, 0, 0, 0);
        }
        red[wave_v * 64 + lane] = acc;
        __syncthreads();
        if (ks == 0) {
            const f32x4 v = (red[(4 * rg + 0) * 64 + lane] + red[(4 * rg + 1) * 64 + lane]) + (red[(4 * rg + 2) * 64 + lane] + red[(4 * rg + 3) * 64 + lane]);
            fe(MPROMPT + 32 * rb + 16 * rg + fr, 16 * cb + 4 * fq, v);
        }
        __syncthreads();
    }
#if PROBE_ON && PROBE_SKINNY == 1
    if (threadIdx.x == 0) F.MISC[18] += (unsigned)rt() - ps0_;
#endif
}
struct FeIn { pg8::EpiIn E; __device__ __forceinline__ void operator()(int row, int col, f32x4 v) const { pg8::samp_in(E, row, col, v); } };
template <int MODE> struct FeN { pg8::EpiN<MODE> E; const float* xs; float* PSS; const float* PSSin;
    __device__ __forceinline__ void operator()(int row, int col, f32x4 v) const { pg8::samp_n<MODE>(E, xs, PSS, PSSin, row, col, v); } };

struct PairOrder { pg8::StaticOrder S0;
    __device__ __forceinline__ bool next(int i, pg8::Unit& u) const { pg8::Unit t; if (!S0.next(i >> 1, t)) return false; if ((i & 1) == 0) { u.pm = t.pm + MP / 256; u.pn = t.pn + DM / 256; } else u = t; return true; }
    __device__ __forceinline__ void a_ready(const pg8::Unit&) const {}
    __device__ __forceinline__ void done(const pg8::Unit&) const {} };
struct EpiUp { static constexpr bool PERM = true, AFTER_DRAIN = false; pg8::EpiN<0> E0; pg8::EpiN<1> E1;
    __device__ __forceinline__ void operator()(const f32x4 (&acc)[2][2][4][2], const pg8::Unit& u, int wr, int wc, int fr, int fq) const {
        if (u.pn >= DM / 256) { const pg8::Unit v{u.pm - MP / 256, u.pn - DM / 256}; E0(acc, v, wr, wc, fr, fq); } else E1(acc, u, wr, wc, fr, fq); } };

__global__ void __launch_bounds__(NWAVES * 64, 2) fwd_kernel(Args args) {
#define tid_v ((int)threadIdx.x)
    extern __shared__ __attribute__((aligned(16))) unsigned char lds[];
    Frame F;
    F.lds = (LAS unsigned char*)lds;
    F.MISC = (volatile LAS unsigned*)(F.lds + MISC_OFF);
        F.G = gridDim.x; { const int bx = blockIdx.x; F.vcu = (F.G % 8 == 0) ? (bx % 8) * (F.G / 8) + bx / 8 : bx; }
    unsigned char* ws = args.ws;
    F.ctl = (gu32*)(ws + WS_CTL);
    for (int u = tid_v; u < (LDS_BYTES - LDSCTL_OFF) / 4; u += NWAVES * 64) ((LAS unsigned*)(F.lds + LDSCTL_OFF))[u] = 0u;
    __syncthreads();
    XcdBarrier bar; bar.bar = (unsigned*)(F.ctl + CW_BAR); bar.x = 0; bar.st = nullptr;
    if (args.use_bar) bar = xcd_barrier_post((unsigned*)(F.ctl + CW_BAR), F.MISC + 8);
    const int lo = args.ph_lo, hi = args.ph_hi;
#define IN(k) (lo <= (k) && (k) < hi)
#if PROBE_ON
    volatile LAS unsigned* PW = F.MISC + 16;
    if (tid_v == 0) { PW[0] = (unsigned)rt(); PW[1] = 0u; PW[2] = 0u; }
#define STAMP(k) do { if (blockIdx.x == 0 && tid_v == 0) { const unsigned t_ = (unsigned)rt(); unsigned q_ = (t_ - PW[0] + (unsigned)PROBE_UNIT / 2) / (unsigned)PROBE_UNIT; if (q_ > 49u) q_ = 49u; \
        if ((k) == PROBE_A) PW[1] += q_ * 400u; else if ((k) == PROBE_B) PW[1] += q_ * 20000u; else if (PROBE_E < 0 && (k) == PROBE_C) PW[1] += q_ * 1000000u; \
        if ((k) == PROBE_E) { unsigned e_ = (PW[2] + (unsigned)PROBE_UNIT / 2) / (unsigned)PROBE_UNIT; if (e_ > 49u) e_ = 49u; PW[1] += e_ * 1000000u; } PW[2] = 0u; PW[0] = t_; } } while (0)
#else
#define STAMP(k) do { } while (0)
#endif
#define SEAM(k) do { if (IN(k) && IN((k) + 1)) xcd_barrier(bar); STAMP(k); } while (0)
    using namespace pg8;
    bf16_t* XB = (bf16_t*)(args.out + OFF_RETS);
    bf16_t* AR = (bf16_t*)(args.out + OFF_Y); bf16_t* AH = AR + (size_t)MTOT * DM;
    float* R = args.out + OFF_Y;
    float* PS1 = (float*)(ws + WS_PS1); float* PS2 = (float*)(ws + WS_PS2); float* PS3 = (float*)(ws + WS_PS3);

    if (IN(0)) { p0_prologue(F, args); SEAM(0); }
    const bf16_t* SROW = nullptr; (void)SROW;
    float* PSS1 = (float*)(ws + WS_PSS1); float* PSS2 = (float*)(ws + WS_PSS2); float* PSS3 = (float*)(ws + WS_PSS3);
#define SAMP(buf, ld) ((const bf16*)(buf) + (size_t)MPROMPT * (ld))
    if (IN(1)) {
        Gemm g{XB, (const bf16_t*)(ws + WS_WIN), MPROMPT, DIN, DM}; StaticOrder S; S.init(MPROMPT, DIN, F.G, (int)blockIdx.x);
        EpiIn E{(const float*)(ws + WS_RSTD0), (const float*)(ws + WS_CS), (const float*)(ws + WS_LB),
                (bf16_t*)(ws + Z_QR), (bf16_t*)(ws + Z_KR), (bf16_t*)(ws + Z_VR), (bf16_t*)(ws + WS_GR), (bf16_t*)(ws + Z_QG), (bf16_t*)(ws + Z_KG), (bf16_t*)(ws + Z_VG), (bf16_t*)(ws + WS_GG),
                AR, AH, (float*)(ws + WS_GL), (float*)(ws + WS_FS), ws, (unsigned char*)args.out};
        const int nfirst = (F.vcu & 3) * 3;
        { FeIn fe{E}; skinny_gemm<DM>(F, SAMP(XB, DM), (const bf16*)(ws + WS_WIN), DIN, fe, 0, nfirst); }
        gemm_phase<EpiIn, StaticOrder, true, true>(F.lds + RING_OFF, g, S, E);
        { FeIn fe{E}; skinny_gemm<DM>(F, SAMP(XB, DM), (const bf16*)(ws + WS_WIN), DIN, fe, nfirst); }
        SEAM(1);
    }
    if (IN(2)) {
        const bool dec_first = (F.vcu & 1) != 0;
        if (dec_first) decode_all(F, args);
        for (int it = F.vcu; it < 256; it += F.G) scan_item(F, args, it);
        if (!dec_first) decode_all(F, args);
        SEAM(2);
    }
    if (IN(3)) { p3_headnorm(F, args); SEAM(3); }
    if (IN(4)) {
        Gemm g{(const bf16_t*)(ws + WS_GR), (const bf16_t*)(ws + WS_WUPR), 2 * MP, 2 * DM, DM}; PairOrder S; S.S0.init(MPROMPT, DM, F.G, (int)blockIdx.x);
        EpiN<0> E0{AH, (bf16_t*)(ws + WS_MB), DM, nullptr, nullptr, nullptr, nullptr, nullptr, nullptr};
        EpiN<1> E1{AR, (bf16_t*)(ws + WS_MB), DM, nullptr, nullptr, nullptr, nullptr, nullptr, nullptr};
        EpiUp E{E0, E1};
        gemm_phase<EpiUp, PairOrder, true, true>(F.lds + RING_OFF, g, S, E);
        { FeN<0> fe{E0, nullptr, nullptr, nullptr}; skinny_gemm<DM>(F, SAMP(ws + WS_GG, DM), (const bf16*)(ws + WS_WUPH), DM, fe); }
        { FeN<1> fe{E1, nullptr, nullptr, nullptr}; skinny_gemm<DM>(F, SAMP(ws + WS_GR, DM), (const bf16*)(ws + WS_WUPR), DM, fe); }
        SEAM(4);
    }
    if (IN(5)) {
        Gemm g{(const bf16_t*)(ws + WS_MB), (const bf16_t*)(ws + WS_WO), MPROMPT, DM, DM}; StaticOrder S; S.init(MPROMPT, DM, F.G, (int)blockIdx.x);
        EpiN<2> E{nullptr, (bf16_t*)(ws + WS_A5), DM, args.in[0], nullptr, nullptr, nullptr, PS1, nullptr};
        gemm_phase<EpiN<2>, StaticOrder, true, true>(F.lds + RING_OFF, g, S, E);
        FeN<2> fe{E, args.in[1], PSS1, nullptr}; skinny_gemm<DM>(F, SAMP(ws + WS_MB, DM), (const bf16*)(ws + WS_WO), DM, fe);
        SEAM(5);
    }
    if (IN(6)) {
        Gemm g{(const bf16_t*)(ws + WS_A5), (const bf16_t*)(ws + WS_WFF1), MPROMPT, DFF, DM}; StaticOrder S; S.init(MPROMPT, DFF, F.G, (int)blockIdx.x);
        EpiN<3> E{nullptr, (bf16_t*)(ws + WS_H), DFF, nullptr, nullptr, nullptr, nullptr, nullptr, PS1};
        const int nfirst = (F.vcu & 3) + ((F.vcu & 3) == 3 ? 1 : 0); FeN<3> fe{E, nullptr, nullptr, PSS1};
        skinny_gemm<DM>(F, SAMP(ws + WS_A5, DM), (const bf16*)(ws + WS_WFF1), DFF, fe, 0, nfirst);
        gemm_phase<EpiN<3>, StaticOrder, true, true>(F.lds + RING_OFF, g, S, E);
        skinny_gemm<DM>(F, SAMP(ws + WS_A5, DM), (const bf16*)(ws + WS_WFF1), DFF, fe, nfirst);
        SEAM(6);
    }
    if (IN(7)) {
        Gemm g{(const bf16_t*)(ws + WS_H), (const bf16_t*)(ws + WS_WFF2), MPROMPT, DM, DFF}; StaticOrder S; S.init(MPROMPT, DM, F.G, (int)blockIdx.x);
        EpiN<6> E{(const bf16_t*)(ws + WS_A5), (bf16_t*)(ws + WS_A7), DM, nullptr, nullptr, nullptr, nullptr, PS2, nullptr};
        gemm_phase<EpiN<6>, StaticOrder, true, true>(F.lds + RING_OFF, g, S, E);
        FeN<6> fe{E, nullptr, PSS2, nullptr}; skinny_gemm<DFF>(F, SAMP(ws + WS_H, DFF), (const bf16*)(ws + WS_WFF2), DM, fe);
        SEAM(7);
    }
    if (IN(8)) {
        { Gemm g{(const bf16_t*)(ws + WS_A7), (const bf16_t*)(ws + WS_WGATE), MPROMPT, DM, DM}; StaticOrder S; S.init(MPROMPT, DM, F.G, (int)blockIdx.x);
          EpiN<4> E{nullptr, (bf16_t*)(ws + WS_MB), DM, nullptr, nullptr, nullptr, nullptr, nullptr, PS2};
          gemm_phase<EpiN<4>, StaticOrder, true, true>(F.lds + RING_OFF, g, S, E);
          FeN<4> fe{E, nullptr, nullptr, PSS2}; skinny_gemm<DM>(F, SAMP(ws + WS_A7, DM), (const bf16*)(ws + WS_WGATE), DM, fe); }
        { Gemm g{(const bf16_t*)(ws + WS_PB), (const bf16_t*)(ws + WS_WPROJ), MPROMPT, DM, DPLE}; StaticOrder S; S.init(MPROMPT, DM, F.G, (int)blockIdx.x);
          EpiN<5> E{(const bf16_t*)(ws + WS_A7), (bf16_t*)(ws + WS_MB), DM, nullptr, nullptr, (float*)(ws + WS_A5), nullptr, PS3, nullptr};
          gemm_phase<EpiN<5>, StaticOrder, true, true>(F.lds + RING_OFF, g, S, E);
          FeN<5> fe{E, nullptr, PSS3, nullptr}; skinny_gemm<DPLE>(F, SAMP(ws + WS_PB, DPLE), (const bf16*)(ws + WS_WPROJ), DM, fe); }
        SEAM(8);
    }
    if (IN(9)) { p9_final(F, args); }
#if PROBE_ON
    STAMP(9);
    if (blockIdx.x == 0 && tid_v == 0) { const unsigned t0_ = (unsigned)rt(); const unsigned dly_ = PW[1]; while ((unsigned)rt() - t0_ < dly_) __builtin_amdgcn_s_sleep(16); }
#endif
#undef IN
#undef SEAM
#undef tid_v
}

extern "C" void kernel_launch(void* const* d_in, const int* in_sizes, int n_in, void* d_out, int out_size, void* d_ws, size_t ws_size, hipStream_t stream) {
    static int grid = 0;
    if (grid == 0) {
        if (n_in != 21 || out_size != (int)OUT_TOTAL || ws_size < WS_END) { fprintf(stderr, "kernel_launch: unexpected problem (n_in %d out %d ws %zu need %zu)\n", n_in, out_size, ws_size, (size_t)WS_END); grid = -1; return; }
        int dev = 0, cus = 0;
        if (hipGetDevice(&dev) != hipSuccess || hipDeviceGetAttribute(&cus, hipDeviceAttributeMultiprocessorCount, dev) != hipSuccess) { grid = -1; return; }
        if (hipFuncSetAttribute((const void*)fwd_kernel, hipFuncAttributeMaxDynamicSharedMemorySize, LDS_BYTES) != hipSuccess) { fprintf(stderr, "kernel_launch: hipFuncSetAttribute failed\n"); grid = -1; return; }
        (void)hipGetLastError();
        grid = cus;
    }
    if (grid < 0) return;
    (void)hipMemsetAsync((char*)d_ws + WS_CTL, 0, CTL_ZERO_BYTES, stream);
    Args a{};
    for (int i = 0; i < 21; ++i) a.in[i] = (const float*)d_in[i];
    a.out = (float*)d_out; a.ws = (unsigned char*)d_ws;
#if MK_ONE_LAUNCH
    a.ph_lo = 0; a.ph_hi = NPH; a.use_bar = 1;
    hipLaunchKernelGGL(fwd_kernel, dim3(grid), dim3(NWAVES * 64), LDS_BYTES, stream, a);
#else
    for (int p = 0; p < NPH; ++p) { a.ph_lo = p; a.ph_hi = p + 1; a.use_bar = 0; hipLaunchKernelGGL(fwd_kernel, dim3(grid), dim3(NWAVES * 64), LDS_BYTES, stream, a); }
#endif
}
```

```cpp
#include <hip/hip_runtime.h>
#include <cstdio>
#include <cstdint>
#ifndef PROBE_ON
#define PROBE_ON 0
#endif
#define PROBE_UNIT 800ull
#ifndef PROBE_A
#define PROBE_A 0
#define PROBE_B 1
#define PROBE_C 2
#endif
#ifndef PROBE_E
#define PROBE_E -1
#endif
#ifndef PROBE_SKINNY
#define PROBE_SKINNY 0
#endif
namespace pg8 {
#define PG8_LAS __attribute__((address_space(3)))
typedef unsigned short bf16_t;
typedef short bf16x8 __attribute__((ext_vector_type(8)));
typedef float f32x4 __attribute__((ext_vector_type(4)));
typedef unsigned u32x4 __attribute__((ext_vector_type(4)));
constexpr int BM = 256, BK = 64, HALF = 128, HTB = HALF * BK * 2  , STAGE_BYTES = 8 * HTB, NXCD = 8, WGM = 8;

__host__ __device__ __forceinline__ int lds_byte(int r, int c) { const int st = (r >> 4) * 2 + (c >> 5), rr = r & 15, cc = c & 31, ob = rr * 64 + cc * 2; return st * 1024 + (ob ^ (((ob >> 9) & 1) << 5)); }
__host__ __device__ __forceinline__ void stage_rc(int b, int& R, int& C) { const int st = b / 1024, sb = b % 1024, swz = sb ^ (((sb >> 9) & 1) << 5); R = (st >> 1) * 16 + swz / 64; C = (st & 1) * 32 + (swz % 64) / 2; }
__host__ __device__ __forceinline__ int perm32(int rho) { const int n = rho >> 4, i = rho & 15; return 8 * (i >> 2) + 4 * n + (i & 3); }

struct Unit { int pm, pn; };
struct Gemm { const bf16_t* A; const bf16_t* Bt; int M, N, K; };

struct StaticOrder {
    int nM, nN, nwg, G, c;
    __host__ __device__ void init(int M, int N, int G_, int c_) { nM = M / BM; nN = N / BM; nwg = nM * nN; G = G_; c = c_; }
    __host__ __device__ bool next(int i, Unit& u) const {
        const long L = (long)i * G + c; if (L >= nwg) return false;
        int wgid = (int)L; { const int q = nwg / NXCD, r = nwg % NXCD, xcd = wgid % NXCD, off = wgid / NXCD; wgid = (xcd < r ? xcd * (q + 1) : r * (q + 1) + (xcd - r) * q) + off; }
        const int nig = WGM * nN, gid = wgid / nig, fm = gid * WGM, gsz = (nM - fm) < WGM ? (nM - fm) : WGM;
        u.pm = fm + ((wgid % nig) % gsz); u.pn = (wgid % nig) / gsz; return true;
    }
    __device__ __forceinline__ void a_ready(const Unit&) const {}
    __device__ __forceinline__ void done(const Unit&) const {}
};

__device__ __forceinline__ unsigned cvt_pk_bf16(float lo, float hi) { unsigned r; asm volatile("v_cvt_pk_bf16_f32 %0, %1, %2" : "=v"(r) : "v"(lo), "v"(hi)); return r; }

template <class Epi, class Sched, bool ALIGN_EPI = false, bool SP2 = false>
__device__ __forceinline__ void gemm_phase(PG8_LAS unsigned char* lds, const Gemm g, const Sched& S, const Epi& E) {
    const int tid = threadIdx.x, wid = __builtin_amdgcn_readfirstlane(tid >> 6), lane = tid & 63, wr = wid >> 2, wc = wid & 3, fr = lane & 15, fq = lane >> 4;
    const int K = g.K, nt = K / BK;
    unsigned voffA[2], voffB[2];
#pragma unroll
    for (int i = 0; i < 2; ++i) { int R, C; stage_rc(tid * 16 + i * 8192, R, C); const int Rb = Epi::PERM ? ((R & ~31) + perm32(R & 31)) : R;
        voffA[i] = (unsigned)(R * K + C) * 2u; voffB[i] = (unsigned)(Rb * K + C) * 2u; }
    const size_t kstep = (size_t)(BK * 2);
    const size_t hstep = (size_t)HALF * K * 2;
    const size_t tstep = 2 * hstep;
    const unsigned ldsw = (unsigned)wid * 1024u;
    const int aoff = lds_byte(wr * 64 + fr, fq * 8), boff = lds_byte(wc * 32 + fr, fq * 8);
#define PG8_SA(b, h) (((b) * 2 + (h)) * HTB)
#define PG8_SB(b, h) ((4 + (b) * 2 + (h)) * HTB)
#define PG8_STAGE(bufoff, gbase, voff) do { _Pragma("unroll") for (int _i = 0; _i < 2; ++_i) \
        __builtin_amdgcn_global_load_lds((const unsigned*)((const char*)(gbase) + (voff)[_i]), (PG8_LAS unsigned*)(lds + (bufoff) + ldsw + _i * 8192), 16, 0, 0); } while (0)
#define PG8_LDA(dst, b, h) do { _Pragma("unroll") for (int m = 0; m < 4; ++m) _Pragma("unroll") for (int k = 0; k < 2; ++k) dst[m][k] = *(const PG8_LAS bf16x8*)(lds + PG8_SA(b, h) + aoff + m * 2048 + k * 1024); } while (0)
#define PG8_LDB(dst, b, h) do { _Pragma("unroll") for (int n = 0; n < 2; ++n) _Pragma("unroll") for (int k = 0; k < 2; ++k) dst[n][k] = *(const PG8_LAS bf16x8*)(lds + PG8_SB(b, h) + boff + n * 2048 + k * 1024); } while (0)
#define PG8_MMA(ai, bj, At, Bt) do { __builtin_amdgcn_s_setprio(1); _Pragma("unroll") for (int m = 0; m < 4; ++m) _Pragma("unroll") for (int n = 0; n < 2; ++n) _Pragma("unroll") for (int k = 0; k < 2; ++k) \
        acc[ai][bj][m][n] = __builtin_amdgcn_mfma_f32_16x16x32_bf16(Bt[n][k], At[m][k], acc[ai][bj][m][n], 0, 0, 0); __builtin_amdgcn_s_setprio(0); } while (0)
#define PG8_WAIT_V(n) asm volatile("s_waitcnt vmcnt(" #n ")" ::: "memory")
#define PG8_WAIT_L(n) asm volatile("s_waitcnt lgkmcnt(" #n ")" ::: "memory")
#define PG8_BAR __builtin_amdgcn_s_barrier()
#define PG8_SCHED __builtin_amdgcn_sched_barrier(0)
    Unit cur, nxt; int ui = 0;
    if (!S.next(0, cur)) return;
    f32x4 acc[2][2][4][2];
#pragma unroll
    for (int a = 0; a < 2; ++a)
#pragma unroll
        for (int b = 0; b < 2; ++b)
#pragma unroll
            for (int m = 0; m < 4; ++m)
#pragma unroll
                for (int n = 0; n < 2; ++n) acc[a][b][m][n] = (f32x4){0.f, 0.f, 0.f, 0.f};
    bf16x8 At[4][2], B0[2][2], B1[2][2];
    const char* cA = (const char*)g.A + (size_t)cur.pm * tstep; const char* cB = (const char*)g.Bt + (size_t)cur.pn * tstep;
    S.a_ready(cur);
    if constexpr (SP2) {
        PG8_STAGE(PG8_SB(0, 0), cB, voffB); PG8_STAGE(PG8_SB(0, 1), cB + hstep, voffB); PG8_STAGE(PG8_SA(0, 0), cA, voffA); PG8_STAGE(PG8_SA(0, 1), cA + hstep, voffA);
        if (wr == 1) PG8_BAR;
        PG8_WAIT_V(2); PG8_BAR;
        PG8_STAGE(PG8_SB(1, 0), cB + kstep, voffB); PG8_STAGE(PG8_SA(1, 0), cA + kstep, voffA); PG8_STAGE(PG8_SB(1, 1), cB + hstep + kstep, voffB);
        PG8_WAIT_V(6); PG8_BAR;
    } else {
        PG8_STAGE(PG8_SB(0, 0), cB, voffB); PG8_STAGE(PG8_SA(0, 0), cA, voffA); PG8_STAGE(PG8_SB(0, 1), cB + hstep, voffB); PG8_STAGE(PG8_SA(0, 1), cA + hstep, voffA);
        if (wr == 1) PG8_BAR;
        PG8_WAIT_V(4); PG8_BAR;
        PG8_STAGE(PG8_SB(1, 0), cB + kstep, voffB); PG8_STAGE(PG8_SA(1, 0), cA + kstep, voffA); PG8_STAGE(PG8_SB(1, 1), cB + hstep + kstep, voffB);
        PG8_WAIT_V(6); PG8_BAR;
    }
    for (;;) {
        const bool has_next = S.next(ui + 1, nxt);
        const char* nA = has_next ? (const char*)g.A + (size_t)nxt.pm * tstep : cA; const char* nB = has_next ? (const char*)g.Bt + (size_t)nxt.pn * tstep : cB;
        for (int t = 0; t < nt; t += 2) {
            const bool last = (t == nt - 2);
            const char* a1 = cA + (size_t)(t + 1) * kstep;
            const char* a2 = last ? nA : cA + (size_t)(t + 2) * kstep; const char* b2 = last ? nB : cB + (size_t)(t + 2) * kstep;
            const char* a3 = a2 + kstep; const char* b3 = b2 + kstep;
            if (last && has_next) S.a_ready(nxt);
            if constexpr (SP2) {
            PG8_LDB(B0, 0, 0); PG8_LDB(B1, 0, 1); PG8_SCHED; PG8_LDA(At, 0, 0); PG8_STAGE(PG8_SA(1, 1), a1 + hstep, voffA);
            PG8_WAIT_V(8); PG8_WAIT_L(0); PG8_BAR; PG8_MMA(0, 0, At, B0); PG8_MMA(0, 1, At, B1); PG8_BAR; PG8_SCHED;
            PG8_LDA(At, 0, 1); PG8_STAGE(PG8_SB(0, 0), b2, voffB); PG8_STAGE(PG8_SB(0, 1), b2 + hstep, voffB); PG8_STAGE(PG8_SA(0, 0), a2, voffA);
            PG8_WAIT_V(8); PG8_WAIT_L(0); PG8_BAR; PG8_MMA(1, 0, At, B0); PG8_MMA(1, 1, At, B1); PG8_BAR; PG8_SCHED;
            PG8_LDB(B0, 1, 0); PG8_LDB(B1, 1, 1); PG8_SCHED; PG8_LDA(At, 1, 0); PG8_STAGE(PG8_SA(0, 1), a2 + hstep, voffA);
            PG8_WAIT_V(8); PG8_WAIT_L(0); PG8_BAR; PG8_MMA(0, 0, At, B0); PG8_MMA(0, 1, At, B1); PG8_BAR; PG8_SCHED;
            PG8_LDA(At, 1, 1); PG8_STAGE(PG8_SB(1, 0), b3, voffB); PG8_STAGE(PG8_SB(1, 1), b3 + hstep, voffB); PG8_STAGE(PG8_SA(1, 0), a3, voffA);
            PG8_WAIT_V(8); PG8_WAIT_L(0); PG8_BAR; PG8_MMA(1, 0, At, B0); PG8_MMA(1, 1, At, B1); PG8_BAR; PG8_SCHED;
            } else {
            PG8_LDB(B0, 0, 0); PG8_SCHED; PG8_LDA(At, 0, 0); PG8_STAGE(PG8_SA(1, 1), a1 + hstep, voffA);
            PG8_WAIT_L(8); PG8_BAR; PG8_WAIT_L(0); PG8_MMA(0, 0, At, B0); PG8_BAR; PG8_SCHED;
            PG8_LDB(B1, 0, 1); PG8_STAGE(PG8_SB(0, 0), b2, voffB);
            PG8_BAR; PG8_WAIT_L(0); PG8_MMA(0, 1, At, B1); PG8_BAR;
            PG8_LDA(At, 0, 1); PG8_STAGE(PG8_SA(0, 0), a2, voffA);
            PG8_BAR; PG8_WAIT_L(0); PG8_MMA(1, 0, At, B0); PG8_BAR; PG8_SCHED;
            PG8_STAGE(PG8_SB(0, 1), b2 + hstep, voffB);
            PG8_WAIT_V(6); PG8_BAR; PG8_MMA(1, 1, At, B1); PG8_BAR;
            PG8_LDB(B0, 1, 0); PG8_SCHED; PG8_LDA(At, 1, 0); PG8_STAGE(PG8_SA(0, 1), a2 + hstep, voffA);
            PG8_WAIT_L(8); PG8_BAR; PG8_WAIT_L(0); PG8_MMA(0, 0, At, B0); PG8_BAR; PG8_SCHED;
            PG8_LDB(B1, 1, 1); PG8_STAGE(PG8_SB(1, 0), b3, voffB);
            PG8_BAR; PG8_WAIT_L(0); PG8_MMA(0, 1, At, B1); PG8_BAR;
            PG8_LDA(At, 1, 1); PG8_STAGE(PG8_SA(1, 0), a3, voffA);
            PG8_BAR; PG8_WAIT_L(0); PG8_MMA(1, 0, At, B0); PG8_BAR; PG8_SCHED;
            PG8_STAGE(PG8_SB(1, 1), b3 + hstep, voffB);
            PG8_WAIT_V(6); PG8_BAR; PG8_MMA(1, 1, At, B1); PG8_BAR;
            }
        }
        if constexpr (ALIGN_EPI) { if (wr == 0) PG8_BAR; }
#if PROBE_ON && !PROBE_SKINNY
        const unsigned pe0_ = (unsigned)__builtin_amdgcn_s_memrealtime();
#endif
        if constexpr (!Epi::AFTER_DRAIN) { E(acc, cur, wr, wc, fr, fq); S.done(cur); }
#if PROBE_ON && !PROBE_SKINNY
        if (threadIdx.x == 0) { *(volatile PG8_LAS unsigned*)(lds + 131072 + 320 + 4 * 18) += (unsigned)__builtin_amdgcn_s_memrealtime() - pe0_; }
#endif
        if (!has_next) break;
        if (!E.keep_acc(cur))
#pragma unroll
        for (int a = 0; a < 2; ++a)
#pragma unroll
            for (int b = 0; b < 2; ++b)
#pragma unroll
                for (int m = 0; m < 4; ++m)
#pragma unroll
                    for (int n = 0; n < 2; ++n) acc[a][b][m][n] = (f32x4){0.f, 0.f, 0.f, 0.f};
        cur = nxt; cA = nA; cB = nB; ++ui;
        if constexpr (ALIGN_EPI) { if (wr == 1) PG8_BAR; }
    }
    PG8_WAIT_V(0);
    if constexpr (!ALIGN_EPI) { if (wr == 0) PG8_BAR; }
    PG8_BAR;
    if constexpr (Epi::AFTER_DRAIN) { E.fused(acc, cur, wr, wc, fr, fq, lds, wid, lane); S.done(cur); }
#undef PG8_SA
#undef PG8_SB
#undef PG8_STAGE
#undef PG8_LDA
#undef PG8_LDB
#undef PG8_MMA
#undef PG8_WAIT_V
#undef PG8_WAIT_L
#undef PG8_BAR
#undef PG8_SCHED
}
}


constexpr int DM = 1024, NB = 8, SEQ = 2048, NDEC = 128, MPROMPT = NB * SEQ, MTOT = MPROMPT + NDEC, MP = 16640  ;
constexpr int HR = 4, DKR = 128, DVR = 256, HG = 8, DKG = 128, DVG = 128, DFF = 4096, DPLE = 256, DIN = 9216, CH = 64, NCHUNK = MPROMPT / CH;
constexpr float EPS = 1e-6f;
constexpr size_t OFF_Y = 0, OFF_RETP = (size_t)MTOT * DM, OFF_HGP = OFF_RETP + (size_t)NB * HR * DKR * DVR, OFF_RETS = OFF_HGP + (size_t)NB * HG * DKG * DVG,
                 OFF_HGS = OFF_RETS + (size_t)NDEC * HR * DKR * DVR, OUT_TOTAL = OFF_HGS + (size_t)NDEC * HG * DKG * DVG;
static_assert(OUT_TOTAL == 52559872, "output size");


constexpr int NWAVES = 8;
constexpr int NPH = 10;
#ifndef MK_ONE_LAUNCH
#define MK_ONE_LAUNCH 1
#endif

constexpr size_t MiB = 1u << 20;
constexpr size_t WS_CTL = 0, CTL_ZERO_BYTES = 1 * MiB;
constexpr size_t WS_WIN = 1 * MiB;
constexpr size_t WS_WUPR = WS_WIN + (size_t)DIN * DM * 2;
constexpr size_t WS_WUPH = WS_WUPR + (size_t)DM * DM * 2;
constexpr size_t WS_WO = WS_WUPH + (size_t)DM * DM * 2;
constexpr size_t WS_WFF1 = WS_WO + (size_t)DM * DM * 2;
constexpr size_t WS_WFF2 = WS_WFF1 + (size_t)DFF * DM * 2;
constexpr size_t WS_WGATE = WS_WFF2 + (size_t)DFF * DM * 2;
constexpr size_t WS_WPROJ = WS_WGATE + (size_t)DM * DM * 2;
constexpr size_t WS_Z6 = WS_WPROJ + (size_t)DM * DPLE * 2;
constexpr size_t Z_QR = WS_Z6, Z_KR = Z_QR + (size_t)MP * 512 * 2, Z_VR = Z_KR + (size_t)MP * 512 * 2, Z_QG = Z_VR + (size_t)MP * DM * 2, Z_KG = Z_QG + (size_t)MP * DM * 2,
                 Z_VG = Z_KG + (size_t)MP * DM * 2, Z_END = Z_VG + (size_t)MP * DM * 2;
constexpr size_t WS_H = WS_Z6, WS_MB = WS_Z6 + (size_t)MP * DFF * 2;
static_assert(WS_MB == Z_VG, "MB overlays VG exactly");
constexpr size_t WS_GR = Z_END, WS_GG = WS_GR + (size_t)MP * DM * 2, WS_A5 = WS_GR, WS_A7 = WS_GG;
constexpr size_t WS_PB = WS_GG + (size_t)MP * DM * 2;
constexpr size_t WS_CS = WS_PB + (size_t)MP * DPLE * 2;
constexpr size_t WS_GL = WS_CS + (size_t)2049 * 64 * 8;
constexpr size_t WS_FS = WS_GL + (size_t)NCHUNK * DM * 4;
constexpr size_t WS_RSTD0 = WS_FS + (size_t)NDEC * DM * 4;
constexpr size_t WS_LB = WS_RSTD0 + (size_t)MP * 4;
constexpr size_t WS_PS1 = WS_LB + 4096, WS_PS2 = WS_PS1 + (size_t)MP * 64, WS_PS3 = WS_PS2 + (size_t)MP * 64, WS_PSS1 = WS_PS3 + (size_t)MP * 64, WS_PSS2 = WS_PSS1 + (size_t)NDEC * 256, WS_PSS3 = WS_PSS2 + (size_t)NDEC * 256, WS_END = WS_PSS3 + (size_t)NDEC * 256;
static_assert(WS_END <= 307920896, "d_ws map must fit sum(inputs) bytes");
static_assert(WS_WIN % 256 == 0 && WS_Z6 % 256 == 0 && WS_GR % 256 == 0 && WS_PB % 256 == 0 && WS_CS % 16 == 0 && WS_GL % 16 == 0 && WS_PS1 % 16 == 0, "alignment");
constexpr int CW_TMO = 0, CW_BAR = 4096;

constexpr int RING_OFF = 0, RING_BYTES = 131072;
constexpr int LDSCTL_OFF = RING_BYTES, MISC_OFF = LDSCTL_OFF + 320;
constexpr int LDS_BYTES = 147456;


namespace pg8 {
typedef unsigned u32x2 __attribute__((ext_vector_type(2)));
typedef float f32x2 __attribute__((ext_vector_type(2)));
__device__ __forceinline__ float bf2f(unsigned short b) { return __uint_as_float((unsigned)b << 16); }
__device__ __forceinline__ float bflo(unsigned w) { return __uint_as_float(w << 16); }
__device__ __forceinline__ float bfhi(unsigned w) { return __uint_as_float(w & 0xffff0000u); }
__device__ __forceinline__ float sigmoidf_(float x) { return 1.0f / (1.0f + __expf(-x)); }
__device__ __forceinline__ float siluf_(float x) { return x / (1.0f + __expf(-x)); }
__device__ __forceinline__ u32x2 pack4(f32x4 v) { u32x2 w; w.x = cvt_pk_bf16(v[0], v[1]); w.y = cvt_pk_bf16(v[2], v[3]); return w; }
__device__ __forceinline__ f32x4 unpack4(u32x2 w) { return (f32x4){bflo(w.x), bfhi(w.x), bflo(w.y), bfhi(w.y)}; }

typedef unsigned u32x4 __attribute__((ext_vector_type(4)));
#define DPP_ROW_SHR(x, n) __int_as_float(__builtin_amdgcn_update_dpp(0, __float_as_int(x), 0x110 + (n), 0xf, 0xf, true))
#define DPP_ROW_SHR1(x, n) __int_as_float(__builtin_amdgcn_update_dpp(0x3f800000, __float_as_int(x), 0x110 + (n), 0xf, 0xf, false))
#define DPP_ROW_BCAST15(x) __int_as_float(__builtin_amdgcn_update_dpp(0, __float_as_int(x), 0x15F, 0xf, 0xf, false))
struct EpiIn {
    static constexpr bool PERM = true, AFTER_DRAIN = false;
    const float* rstd0; const float* cs; const float* lb;
    bf16_t *QR, *KR, *VR, *GR, *QG, *KG, *VG, *GG, *AR, *AH; float *GL, *FS; unsigned char* wsb; unsigned char* outb;
    __device__ __forceinline__ bool keep_acc(const Unit&) const { return false; }
    __device__ __forceinline__ void operator()(const f32x4 (&acc)[2][2][4][2], const Unit& u, int wr, int wc, int fr, int fq) const {
        const int pn = u.pn;
#pragma unroll
        for (int ai = 0; ai < 2; ++ai) {
            const int rbase = u.pm * BM + ai * HALF + wr * 64;
            float rs[4];
#pragma unroll
            for (int m = 0; m < 4; ++m) rs[m] = rstd0[rbase + m * 16 + fr];
            if (pn < 4) {
                const bool isk = pn >= 2; bf16_t* dst = isk ? KR : QR;
#pragma unroll
                for (int bj = 0; bj < 2; ++bj) {
                    const int head = 2 * (pn & 1) + bj;
                    const float lg = __logf(1.0f - exp2f(-5.0f - (float)head));
                    const int j0 = 16 * wc + 4 * fq;
#pragma unroll
                    for (int m = 0; m < 4; ++m) {
                        const int row = rbase + m * 16 + fr; const int pidx = row & (SEQ - 1);
                        const float e = lg * (float)(m * 16 + fr + 1);
                        const float sc = rs[m] * (isk ? 0.08838834764831845f * __expf(-e) : __expf(e));
                        const f32x4 t0 = *(const f32x4*)(cs + ((size_t)pidx * 64 + j0) * 2), t1 = *(const f32x4*)(cs + ((size_t)pidx * 64 + j0 + 2) * 2);
                        const f32x4 v0 = acc[ai][bj][m][0] * sc, v1 = acc[ai][bj][m][1] * sc;
                        u32x2 o1, o2;
                        o1.x = cvt_pk_bf16(v0[0] * t0[0] - v0[1] * t0[1], v0[2] * t0[2] - v0[3] * t0[3]); o1.y = cvt_pk_bf16(v1[0] * t1[0] - v1[1] * t1[1], v1[2] * t1[2] - v1[3] * t1[3]);
                        o2.x = cvt_pk_bf16(v0[0] * t0[1] + v0[1] * t0[0], v0[2] * t0[3] + v0[3] * t0[2]); o2.y = cvt_pk_bf16(v1[0] * t1[1] + v1[1] * t1[0], v1[2] * t1[3] + v1[3] * t1[2]);
                        bf16_t* p = dst + (size_t)row * 512 + head * 128 + j0;
                        *(u32x2*)p = o1; *(u32x2*)(p + 64) = o2;
                    }
                }
            } else if (pn >= 12 && pn < 20) {
                const int head = pn - 12;
#pragma unroll
                for (int bj = 0; bj < 2; ++bj) {
                    const int j0 = 64 * bj + 16 * wc + 4 * fq, c = head * 128 + j0;
                    const f32x4 lbv = *(const f32x4*)(lb + c);
                    float qa[4][4], ka[4][4], ba[4][4];
#pragma unroll
                    for (int q = 0; q < 4; ++q) {
                        const int n = q >> 1, e = q & 1; const float one_m_lb = 1.0f - lbv[q]; float carry = 1.f;
#pragma unroll
                        for (int m = 0; m < 4; ++m) {
                            const float vq = acc[ai][bj][m][n][2 * e] * rs[m], vf = acc[ai][bj][m][n][2 * e + 1] * rs[m];
                            const float kk = one_m_lb / (1.0f + __expf(vf));
                            float x = 1.0f - kk;
                            x *= DPP_ROW_SHR1(x, 1); x *= DPP_ROW_SHR1(x, 2); x *= DPP_ROW_SHR1(x, 4); x *= DPP_ROW_SHR1(x, 8);
                            x *= carry; carry = DPP_ROW_BCAST15(x);
                            qa[m][q] = siluf_(vq); ka[m][q] = kk; ba[m][q] = x;
                        }
                    }
#pragma unroll
                    for (int m = 0; m < 4; ++m) {
                        const int row = rbase + m * 16 + fr;
                        const float e0 = ba[m][0], e1 = ba[m][1], e2 = ba[m][2], e3 = ba[m][3];
                        u32x2 qw, kw;
                        qw.x = cvt_pk_bf16(qa[m][0] * e0, qa[m][1] * e1); qw.y = cvt_pk_bf16(qa[m][2] * e2, qa[m][3] * e3);
                        kw.x = cvt_pk_bf16(ka[m][0] * __builtin_amdgcn_rcpf(e0), ka[m][1] * __builtin_amdgcn_rcpf(e1)); kw.y = cvt_pk_bf16(ka[m][2] * __builtin_amdgcn_rcpf(e2), ka[m][3] * __builtin_amdgcn_rcpf(e3));
                        *(u32x2*)(QG + (size_t)row * DM + c) = qw; *(u32x2*)(KG + (size_t)row * DM + c) = kw;
                        if (m == 3 && fr == 15) *(f32x4*)(GL + (size_t)(row >> 6) * DM + c) = (f32x4){e0, e1, e2, e3};
                    }
                }
            } else {
                const int mode = pn >= 28 ? 2 : 0, cbase = (pn & 3) * BM;
                const size_t boff = pn < 8 ? Z_VR : pn < 12 ? WS_GR : pn < 24 ? Z_VG : pn < 28 ? WS_GG : pn < 32 ? (size_t)0 : (size_t)MTOT * DM * 2;
                bf16_t* dst = (bf16_t*)((pn >= 28 ? outb : wsb) + boff);
#pragma unroll
                for (int m = 0; m < 4; ++m) {
                    const int row = rbase + m * 16 + fr;
#pragma unroll
                    for (int bj = 0; bj < 2; ++bj) {
                        f32x4 v0 = acc[ai][bj][m][0] * rs[m], v1 = acc[ai][bj][m][1] * rs[m];
                        if (mode == 1) { v0[0] = siluf_(v0[0]); v0[1] = siluf_(v0[1]); v0[2] = siluf_(v0[2]); v0[3] = siluf_(v0[3]); v1[0] = siluf_(v1[0]); v1[1] = siluf_(v1[1]); v1[2] = siluf_(v1[2]); v1[3] = siluf_(v1[3]); }
                        else if (mode == 2) { v0[0] = sigmoidf_(v0[0]); v0[1] = sigmoidf_(v0[1]); v0[2] = sigmoidf_(v0[2]); v0[3] = sigmoidf_(v0[3]); v1[0] = sigmoidf_(v1[0]); v1[1] = sigmoidf_(v1[1]); v1[2] = sigmoidf_(v1[2]); v1[3] = sigmoidf_(v1[3]); }
                        const u32x2 a = pack4(v0), b = pack4(v1);
                        *(u32x4*)(dst + (size_t)row * DM + cbase + bj * HALF + wc * 32 + fq * 8) = (u32x4){a.x, a.y, b.x, b.y};
                    }
                }
            }
        }
    }
};

__device__ __forceinline__ void unpack8(u32x4 w, f32x4& a, f32x4& b) { a = (f32x4){bflo(w.x), bfhi(w.x), bflo(w.y), bfhi(w.y)}; b = (f32x4){bflo(w.z), bfhi(w.z), bflo(w.w), bfhi(w.w)}; }
__device__ __forceinline__ u32x4 pack8(f32x4 a, f32x4 b) { const u32x2 x = pack4(a), y = pack4(b); return (u32x4){x.x, x.y, y.x, y.y}; }
__device__ __forceinline__ float sumsq4(f32x4 r) { return (r[0] * r[0] + r[1] * r[1]) + (r[2] * r[2] + r[3] * r[3]); }
template <int MODE> struct EpiN {
    static constexpr bool PERM = true, AFTER_DRAIN = false;
    const bf16_t* gate; bf16_t* out16; int ld16; const float* xp; const float* xs; float* R; const float* g; float* PS; const float* PSin;
    __device__ __forceinline__ bool keep_acc(const Unit&) const { return false; }
    __device__ __forceinline__ void operator()(const f32x4 (&acc)[2][2][4][2], const Unit& u, int wr, int wc, int fr, int fq) const {
#pragma unroll
        for (int ai = 0; ai < 2; ++ai) {
            const int rbase = u.pm * BM + ai * HALF + wr * 64;
#pragma unroll
            for (int m = 0; m < 4; ++m) {
                const int row = rbase + m * 16 + fr;
                float rstd = 1.f;
                if (MODE == 3 || MODE == 4) {
                    const f32x4* p = (const f32x4*)(PSin + (size_t)row * 16); const f32x4 a = p[0], b = p[1], c = p[2], d = p[3];
                    const float s = ((a[0] + a[1]) + (a[2] + a[3])) + ((b[0] + b[1]) + (b[2] + b[3])) + ((c[0] + c[1]) + (c[2] + c[3])) + ((d[0] + d[1]) + (d[2] + d[3]));
                    rstd = rsqrtf(s * (1.0f / 1024.0f) + EPS);
                }
                float ss = 0.f;
#pragma unroll
                for (int bj = 0; bj < 2; ++bj) {
                    const int col = u.pn * BM + bj * HALF + wc * 32 + fq * 8;
                    const f32x4 a0 = acc[ai][bj][m][0], a1 = acc[ai][bj][m][1];
                    if (MODE == 0) { f32x4 g0, g1; unpack8(*(const u32x4*)(gate + (size_t)row * DM + col), g0, g1); *(u32x4*)(out16 + (size_t)row * ld16 + col) = pack8(g0 * a0, g1 * a1); }
                    else if (MODE == 1) { f32x4 g0, g1, t0, t1; unpack8(*(const u32x4*)(gate + (size_t)row * DM + col), g0, g1); u32x4* o = (u32x4*)(out16 + (size_t)row * ld16 + col); unpack8(*o, t0, t1); *o = pack8(t0 + g0 * a0, t1 + g1 * a1); }
                    else if (MODE == 2) {
                        const float* bp = xp + (size_t)row * DM + col;
                        const f32x4 r0 = *(const f32x4*)bp + a0, r1 = *(const f32x4*)(bp + 4) + a1;
                        ss += sumsq4(r0) + sumsq4(r1);
                        *(u32x4*)(out16 + (size_t)row * ld16 + col) = pack8(r0, r1);
                    }
                    else if (MODE == 6) {
                        f32x4 b0, b1; unpack8(*(const u32x4*)(gate + (size_t)row * DM + col), b0, b1);
                        const f32x4 r0 = b0 + a0, r1 = b1 + a1;
                        ss += sumsq4(r0) + sumsq4(r1);
                        *(u32x4*)(out16 + (size_t)row * ld16 + col) = pack8(r0, r1);
                    }
                    else if (MODE == 3) { f32x4 v0 = a0 * rstd, v1 = a1 * rstd;
                        v0[0] = fmaxf(v0[0], 0.f); v0[1] = fmaxf(v0[1], 0.f); v0[2] = fmaxf(v0[2], 0.f); v0[3] = fmaxf(v0[3], 0.f); v1[0] = fmaxf(v1[0], 0.f); v1[1] = fmaxf(v1[1], 0.f); v1[2] = fmaxf(v1[2], 0.f); v1[3] = fmaxf(v1[3], 0.f);
                        *(u32x4*)(out16 + (size_t)row * ld16 + col) = pack8(v0 * v0, v1 * v1); }
                    else if (MODE == 4) { f32x4 v0 = a0 * rstd, v1 = a1 * rstd;
                        v0[0] = sigmoidf_(v0[0]); v0[1] = sigmoidf_(v0[1]); v0[2] = sigmoidf_(v0[2]); v0[3] = sigmoidf_(v0[3]); v1[0] = sigmoidf_(v1[0]); v1[1] = sigmoidf_(v1[1]); v1[2] = sigmoidf_(v1[2]); v1[3] = sigmoidf_(v1[3]);
                        *(u32x4*)(out16 + (size_t)row * ld16 + col) = pack8(v0, v1); }
                    else if (MODE == 5) { f32x4 t0, t1, b0, b1; unpack8(*(const u32x4*)(out16 + (size_t)row * ld16 + col), t0, t1); unpack8(*(const u32x4*)(gate + (size_t)row * DM + col), b0, b1);
                        const f32x4 r0 = b0 + t0 * a0, r1 = b1 + t1 * a1; *(u32x4*)((bf16_t*)R + (size_t)row * DM + col) = pack8(r0, r1); ss += sumsq4(r0) + sumsq4(r1); }
                }
                if (MODE == 2 || MODE == 5 || MODE == 6) { ss += __shfl_xor(ss, 16); ss += __shfl_xor(ss, 32); if (fq == 0) PS[(size_t)row * 16 + u.pn * 4 + wc] = ss; }
            }
        }
    }
};

__device__ __forceinline__ void samp_in(const EpiIn& E, int row, int pcol, f32x4 v) {
    const float rs = E.rstd0[row]; const int pn = __builtin_amdgcn_readfirstlane(pcol >> 8), p = pcol & 255;
    if (pn < 4) {
        const bool isk = pn >= 2; bf16_t* dst = isk ? E.KR : E.QR; const int head = 2 * (pn & 1) + (p >> 7), j = (p & 127) >> 1;
        const f32x4 t = *(const f32x4*)(E.cs + ((size_t)SEQ * 64 + j) * 2);
        v = v * (rs * (isk ? 0.08838834764831845f : 1.0f));
        const float o1a = v[0] * t[0] - v[1] * t[1], o2a = v[0] * t[1] + v[1] * t[0], o1b = v[2] * t[2] - v[3] * t[3], o2b = v[2] * t[3] + v[3] * t[2];
        bf16_t* q = dst + (size_t)row * 512 + head * 128 + j;
        *(unsigned*)q = cvt_pk_bf16(o1a, o1b); *(unsigned*)(q + 64) = cvt_pk_bf16(o2a, o2b);
    } else if (pn >= 12 && pn < 20) {
        const int c = (pn - 12) * 128 + (p >> 1);
        const float k0 = (1.0f - E.lb[c]) / (1.0f + __expf(v[1] * rs)), k1 = (1.0f - E.lb[c + 1]) / (1.0f + __expf(v[3] * rs));
        *(unsigned*)(E.QG + (size_t)row * DM + c) = cvt_pk_bf16(siluf_(v[0] * rs), siluf_(v[2] * rs));
        *(unsigned*)(E.KG + (size_t)row * DM + c) = cvt_pk_bf16(k0, k1);
        *(f32x2*)(E.FS + (size_t)(row - MPROMPT) * DM + c) = (f32x2){1.0f - k0, 1.0f - k1};
    } else {
        v = v * rs;
        const bool sl = false, sg = pn >= 28;
        if (sl) { v[0] = siluf_(v[0]); v[1] = siluf_(v[1]); v[2] = siluf_(v[2]); v[3] = siluf_(v[3]); }
        else if (sg) { v[0] = sigmoidf_(v[0]); v[1] = sigmoidf_(v[1]); v[2] = sigmoidf_(v[2]); v[3] = sigmoidf_(v[3]); }
        const size_t boff = pn < 8 ? Z_VR : pn < 12 ? WS_GR : pn < 24 ? Z_VG : pn < 28 ? WS_GG : pn < 32 ? (size_t)0 : (size_t)MTOT * DM * 2;
        bf16_t* dst = (bf16_t*)((pn >= 28 ? E.outb : E.wsb) + boff);
        *(u32x2*)(dst + (size_t)row * DM + (pn & 3) * BM + p) = pack4(v);
    }
}
template <int MODE> __device__ __forceinline__ void samp_n(const EpiN<MODE>& E, const float* xs, float* PSS, const float* PSSin, int row, int col, f32x4 a) {
    const int rs_ = row - MPROMPT; float rstd = 1.f;
    if (MODE == 3 || MODE == 4) { const f32x4* p = (const f32x4*)(PSSin + (size_t)rs_ * 64); float s = 0.f;
#pragma unroll
        for (int i = 0; i < 16; ++i) { const f32x4 q = p[i]; s += (q[0] + q[1]) + (q[2] + q[3]); }
        rstd = rsqrtf(s * (1.0f / 1024.0f) + EPS); }
    float ss = 0.f;
    if (MODE == 0) { const f32x4 gt = unpack4(*(const u32x2*)(E.gate + (size_t)row * DM + col)); *(u32x2*)(E.out16 + (size_t)row * E.ld16 + col) = pack4(gt * a); }
    else if (MODE == 1) { const f32x4 gt = unpack4(*(const u32x2*)(E.gate + (size_t)row * DM + col)); u32x2* o = (u32x2*)(E.out16 + (size_t)row * E.ld16 + col); const f32x4 t = unpack4(*o); *o = pack4(t + gt * a); }
    else if (MODE == 2) { const f32x4 r = *(const f32x4*)(xs + (size_t)rs_ * DM + col) + a; ss = sumsq4(r); *(u32x2*)(E.out16 + (size_t)row * E.ld16 + col) = pack4(r); }
    else if (MODE == 6) { const f32x4 r = unpack4(*(const u32x2*)(E.gate + (size_t)row * DM + col)) + a; ss = sumsq4(r); *(u32x2*)(E.out16 + (size_t)row * E.ld16 + col) = pack4(r); }
    else if (MODE == 3) { f32x4 v = a * rstd; v[0] = fmaxf(v[0], 0.f); v[1] = fmaxf(v[1], 0.f); v[2] = fmaxf(v[2], 0.f); v[3] = fmaxf(v[3], 0.f); *(u32x2*)(E.out16 + (size_t)row * E.ld16 + col) = pack4(v * v); }
    else if (MODE == 4) { f32x4 v = a * rstd; v[0] = sigmoidf_(v[0]); v[1] = sigmoidf_(v[1]); v[2] = sigmoidf_(v[2]); v[3] = sigmoidf_(v[3]); *(u32x2*)(E.out16 + (size_t)row * E.ld16 + col) = pack4(v); }
    else if (MODE == 5) { const f32x4 t = unpack4(*(const u32x2*)(E.out16 + (size_t)row * E.ld16 + col)), b = unpack4(*(const u32x2*)(E.gate + (size_t)row * DM + col));
        const f32x4 r = b + t * a; *(u32x2*)((bf16_t*)E.R + (size_t)row * DM + col) = pack4(r); ss = sumsq4(r); }
    if (MODE == 2 || MODE == 5 || MODE == 6) { ss += __shfl_xor(ss, 16); ss += __shfl_xor(ss, 32); if ((threadIdx.x & 63) < 16) PSS[(size_t)rs_ * 64 + (col >> 4)] = ss; }
}
}

#define GAS __attribute__((address_space(1)))
#define LAS __attribute__((address_space(3)))
typedef unsigned short bf16;
typedef unsigned v4u __attribute__((ext_vector_type(4)));
typedef float f32x4 __attribute__((ext_vector_type(4)));
typedef short bf16x8 __attribute__((ext_vector_type(8)));
typedef GAS unsigned gu32;
typedef GAS unsigned long long gu64;
#define RLX_AGENT __ATOMIC_RELAXED, __HIP_MEMORY_SCOPE_AGENT
#define LDS_WAIT() asm volatile("s_waitcnt lgkmcnt(0)" ::: "memory")
#define VM_WAIT() asm volatile("s_waitcnt vmcnt(0)" ::: "memory")
__device__ __forceinline__ unsigned long long rt() { return __builtin_amdgcn_s_memrealtime(); }
__device__ __forceinline__ unsigned f2bf(float f) { unsigned u = __builtin_bit_cast(unsigned, f); return (u + 0x7fffu + ((u >> 16) & 1u)) >> 16; }
__device__ __forceinline__ unsigned pk2(float lo, float hi) { return f2bf(lo) | (f2bf(hi) << 16); }

#define XB_TMO      128
#define XB_XCNT(j)  (256  + 64 * (j))
#define XB_XSUB(j)  (1280 + 64 * (j))
#define XB_XGEN(j)  (2304 + 64 * (j))
#define XB_TOP      3328
#define XB_TOPGEN   3392
#define XCD_BAR_WORDS 3456
#define XB_SPIN_CAP (1u << 18)

__device__ __forceinline__ unsigned xb_ld(unsigned* p)              { return __hip_atomic_load(p, __ATOMIC_RELAXED, __HIP_MEMORY_SCOPE_AGENT); }
__device__ __forceinline__ unsigned xb_add(unsigned* p, unsigned v) { return __hip_atomic_fetch_add(p, v, __ATOMIC_RELAXED, __HIP_MEMORY_SCOPE_AGENT); }
__device__ __forceinline__ unsigned xb_xcc_id() { return (unsigned)__builtin_amdgcn_s_getreg((3 << 11) | 20) & 0xFu; }
#define XB_SPIN(cond, bar) do { unsigned _sp = 0; while (cond) { __builtin_amdgcn_s_sleep(1); \
    if ((++_sp & 255u) == 0u) { if (xb_ld(&(bar)[XB_TMO])) break; if (_sp > XB_SPIN_CAP) { atomicAdd(&(bar)[XB_TMO], 1u); break; } } } } while (0)

struct XcdBarrier {
    unsigned* bar; unsigned x;
    volatile LAS unsigned* st;
};

__device__ __forceinline__ XcdBarrier xcd_barrier_post(unsigned* bar, volatile LAS unsigned* st) {
    XcdBarrier b; b.bar = bar; b.x = xb_xcc_id(); b.st = st;
    if (threadIdx.x == 0) (void)xb_add(&bar[XB_XCNT(b.x)], 1u);
    return b;
}
__device__ __forceinline__ void xcd_barrier_complete(unsigned* bar, unsigned x, unsigned& nloc, unsigned& nx) {
    const unsigned G = gridDim.x * gridDim.y * gridDim.z;
    unsigned sum, cnt, mine, sp = 0u;
    for (;;) {
        sum = 0u; cnt = 0u; mine = 0u;
#pragma unroll
        for (unsigned j = 0; j < 16; ++j) { const unsigned c = xb_ld(&bar[XB_XCNT(j)]); sum += c; cnt += (c > 0u) ? 1u : 0u; mine = (j == x) ? c : mine; }
        if (sum == G) break;
        __builtin_amdgcn_s_sleep(1);
        if ((++sp & 255u) == 0u) { if (xb_ld(&bar[XB_TMO])) break; if (sp > XB_SPIN_CAP) { atomicAdd(&bar[XB_TMO], 1u); break; } }
    }
    nloc = mine > 0u ? mine : 1u; nx = cnt > 0u ? cnt : 1u;
}

__device__ __forceinline__ void xcd_barrier(const XcdBarrier& b) {
    asm volatile("s_waitcnt vmcnt(0)" ::: "memory");
    __syncthreads();
    if (threadIdx.x == 0) {
        unsigned* bar = b.bar;
        __builtin_amdgcn_s_waitcnt(0);
        unsigned nloc = b.st[0], nx = b.st[1];
        if (nloc == 0u) { xcd_barrier_complete(bar, b.x, nloc, nx); b.st[0] = nloc; b.st[1] = nx; }
        const unsigned old = xb_add(&bar[XB_XSUB(b.x)], 1u);
        const unsigned gen = old / nloc;
        if (old + 1u == (gen + 1u) * nloc) {
            __builtin_amdgcn_fence(__ATOMIC_RELEASE, "agent");
            asm volatile("s_waitcnt vmcnt(0)" ::: "memory");
            const unsigned og = xb_add(&bar[XB_TOP], 1u);
            const unsigned tg = og / nx;
            if (og + 1u == (tg + 1u) * nx) xb_add(&bar[XB_TOPGEN], 1u);
            else XB_SPIN(xb_ld(&bar[XB_TOPGEN]) == tg, bar);
            __builtin_amdgcn_fence(__ATOMIC_ACQUIRE, "agent");
            xb_add(&bar[XB_XGEN(b.x)], 1u);
            asm volatile("s_waitcnt vmcnt(0)" ::: "memory");
        } else {
            XB_SPIN(xb_ld(&bar[XB_XGEN(b.x)]) == gen, bar);
            __builtin_amdgcn_fence(__ATOMIC_ACQUIRE, "agent");
            asm volatile("s_waitcnt vmcnt(0)" ::: "memory");
        }
    }
    __syncthreads();
}


struct Args { const float* in[21]; float* out; unsigned char* ws; int ph_lo, ph_hi, use_bar, pad; };
struct Frame {
    LAS unsigned char* lds; volatile LAS unsigned* MISC; gu32* ctl;
    int vcu, G;
};
__device__ __forceinline__ int tid_() { int t = threadIdx.x; asm volatile("" : "+v"(t)); return t; }
#define FTID (tid_())
#define FLANE (tid_() & 63)
#define FWAVE (__builtin_amdgcn_readfirstlane(tid_() >> 6))
__device__ __forceinline__ float wave_sum(float v) {
#pragma unroll
    for (int o = 1; o < 64; o <<= 1) v += __shfl_xor(v, o);
    return v;
}
#define LBAR() do { asm volatile("s_waitcnt lgkmcnt(0)" ::: "memory"); __builtin_amdgcn_s_barrier(); asm volatile("" ::: "memory"); } while (0)
__device__ __forceinline__ float bf2f_(unsigned short b) { return __uint_as_float((unsigned)b << 16); }
__device__ __forceinline__ float bflo_(unsigned w) { return __uint_as_float(w << 16); }
__device__ __forceinline__ float bfhi_(unsigned w) { return __uint_as_float(w & 0xffff0000u); }

__device__ __forceinline__ int win_src_col(int np) {
    const int tile = np >> 8, p = np & 255;
    if (tile < 4) { const int base = (tile >> 1) * 512, head = 2 * (tile & 1) + (p >> 7), pp = p & 127; return base + head * 128 + (pp & 1) * 64 + (pp >> 1); }
    if (tile >= 12 && tile < 20) { const int h = tile - 12; return 3072 + (p & 1) * 1024 + h * 128 + (p >> 1); }
    return np;
}
template <bool MAP> __device__ __forceinline__ void p0_transpose_item(const float* W, int K, int N, bf16* WT, LAS float* scr, int item, int lane, const float* gk = nullptr) {
    const int nblk = N / 32, kb = item / nblk, nb = item % nblk, k0 = 64 * kb, n0 = 32 * nb;
    const int srcc = MAP ? win_src_col(n0 + (lane & 31)) : n0 + (lane & 31);
    float wv[32];
#pragma unroll
    for (int i = 0; i < 32; ++i) wv[i] = W[(size_t)(k0 + 2 * i + (lane >> 5)) * N + srcc];
#pragma unroll
    for (int i = 0; i < 32; ++i) scr[(2 * i + (lane >> 5)) * 33 + (lane & 31)] = wv[i];
    LDS_WAIT(); asm volatile("" ::: "memory");
    const int c = lane & 7;
    f32x4 ga = (f32x4){1.f, 1.f, 1.f, 1.f}, gb = ga;
    if (gk) { ga = *(const f32x4*)(gk + k0 + 8 * c); gb = *(const f32x4*)(gk + k0 + 8 * c + 4); }
#pragma unroll
    for (int j = 0; j < 4; ++j) { const int n = (lane >> 3) + 8 * j; const LAS float* s = scr + (8 * c) * 33 + n;
        v4u o; o.x = pk2(s[0 * 33] * ga.x, s[1 * 33] * ga.y); o.y = pk2(s[2 * 33] * ga.z, s[3 * 33] * ga.w); o.z = pk2(s[4 * 33] * gb.x, s[5 * 33] * gb.y); o.w = pk2(s[6 * 33] * gb.z, s[7 * 33] * gb.w);
        *(GAS v4u*)(WT + (size_t)(n0 + n) * K + k0 + 8 * c) = o; }
    LDS_WAIT(); asm volatile("" ::: "memory");
}
__device__ __forceinline__ void p0_prologue(Frame& F, const Args& a) { const int tid_v = tid_(); const int lane_v = tid_v & 63; const int wave_v = __builtin_amdgcn_readfirstlane(tid_v >> 6); (void)lane_v; (void)wave_v;
    unsigned char* ws = a.ws;
    LAS float* scr = (LAS float*)(F.lds + RING_OFF + wave_v * 16384);
    const int gw = F.vcu * NWAVES + wave_v, NGW = F.G * NWAVES;
    constexpr int I_IN = (DM / 64) * (DIN / 32), I_SQ = (DM / 64) * (DM / 32), I_F1 = (DM / 64) * (DFF / 32), I_F2 = (DFF / 64) * (DM / 32), I_PJ = (DPLE / 64) * (DM / 32);
    constexpr int NITEMS = I_IN + 4 * I_SQ + I_F1 + I_F2 + I_PJ;
    for (int it = gw; it < NITEMS; it += NGW) {
        int r = it;
        if (r < I_IN) { p0_transpose_item<true>(a.in[7], DM, DIN, (bf16*)(ws + WS_WIN), scr, r, lane_v, a.in[6]); continue; } r -= I_IN;
        if (r < I_SQ) { p0_transpose_item<false>(a.in[11], DM, DM, (bf16*)(ws + WS_WUPR), scr, r, lane_v); continue; } r -= I_SQ;
        if (r < I_SQ) { p0_transpose_item<false>(a.in[12], DM, DM, (bf16*)(ws + WS_WUPH), scr, r, lane_v); continue; } r -= I_SQ;
        if (r < I_SQ) { p0_transpose_item<false>(a.in[13], DM, DM, (bf16*)(ws + WS_WO), scr, r, lane_v); continue; } r -= I_SQ;
        if (r < I_SQ) { p0_transpose_item<false>(a.in[18], DM, DM, (bf16*)(ws + WS_WGATE), scr, r, lane_v, a.in[17]); continue; } r -= I_SQ;
        if (r < I_F1) { p0_transpose_item<false>(a.in[15], DM, DFF, (bf16*)(ws + WS_WFF1), scr, r, lane_v, a.in[14]); continue; } r -= I_F1;
        if (r < I_F2) { p0_transpose_item<false>(a.in[16], DFF, DM, (bf16*)(ws + WS_WFF2), scr, r, lane_v); continue; } r -= I_F2;
        p0_transpose_item<false>(a.in[19], DPLE, DM, (bf16*)(ws + WS_WPROJ), scr, r, lane_v);
    }
    bf16* XB = (bf16*)(a.out + OFF_RETS); float* RSTD0 = (float*)(ws + WS_RSTD0); bf16* PB = (bf16*)(ws + WS_PB);
    for (int m0 = gw; m0 < MP; m0 += 2 * NGW) {
        f32x4 v[2][4]; f32x4 pv[2]; bool ok[2], real[2];
#pragma unroll
        for (int u = 0; u < 2; ++u) {
            const int m = m0 + u * NGW; ok[u] = m < MP; real[u] = m < MTOT; const int mc = real[u] ? m : 0;
            const float* xrow = mc < MPROMPT ? a.in[0] + (size_t)mc * DM : a.in[1] + (size_t)(mc - MPROMPT) * DM;
            const float* prow = mc < MPROMPT ? a.in[4] + (size_t)mc * DPLE : a.in[5] + (size_t)(mc - MPROMPT) * DPLE;
            const GAS f32x4* xr = (const GAS f32x4*)xrow + lane_v;
#pragma unroll
            for (int j = 0; j < 4; ++j) v[u][j] = xr[64 * j];
            pv[u] = *((const GAS f32x4*)prow + lane_v);
        }
#pragma unroll
        for (int u = 0; u < 2; ++u) {
            const int m = m0 + u * NGW; if (!ok[u]) continue;
            GAS unsigned long long* o8 = (GAS unsigned long long*)(XB + (size_t)m * DM) + lane_v;
            GAS unsigned long long* p8 = (GAS unsigned long long*)(PB + (size_t)m * DPLE) + lane_v;
            if (!real[u]) {
#pragma unroll
                for (int j = 0; j < 4; ++j) o8[64 * j] = 0ull;
                p8[0] = 0ull; if (lane_v == 0) RSTD0[m] = 0.f; continue;
            }
            float s = 0.f;
#pragma unroll
            for (int j = 0; j < 4; ++j) s += (v[u][j].x * v[u][j].x + v[u][j].y * v[u][j].y) + (v[u][j].z * v[u][j].z + v[u][j].w * v[u][j].w);
            s = wave_sum(s);
            if (lane_v == 0) RSTD0[m] = rsqrtf(s * (1.0f / DM) + EPS);
#pragma unroll
            for (int j = 0; j < 4; ++j) o8[64 * j] = (unsigned long long)pk2(v[u][j].x, v[u][j].y) | ((unsigned long long)pk2(v[u][j].z, v[u][j].w) << 32);
            p8[0] = (unsigned long long)pk2(pv[u].x, pv[u].y) | ((unsigned long long)pk2(pv[u].z, pv[u].w) << 32);
        }
    }
    float* CS = (float*)(ws + WS_CS); float* LB = (float*)(ws + WS_LB);
    const int gt = (F.vcu * NWAVES + wave_v) * 64 + lane_v, NGT = NGW * 64;
    for (int i = gt; i < 2049 * 64; i += NGT) {
        const int pi = i >> 6, j = i & 63; const double pos = pi == SEQ ? 16384.0 : (double)pi;
        const double ang = pos * pow(10000.0, -(double)j / 64.0);
        CS[2 * i] = (float)cos(ang); CS[2 * i + 1] = (float)sin(ang);
    }
    for (int i = gt; i < DM; i += NGT) { const float a0 = a.in[10][i], a1 = a.in[10][DM + i]; LB[i] = 1.0f / (1.0f + expf(a1 - a0)); }
}

typedef float f32x16 __attribute__((ext_vector_type(16)));
typedef short v4i16_t __attribute__((ext_vector_type(4)));
typedef unsigned u32x2 __attribute__((ext_vector_type(2)));
typedef float f32x2_t __attribute__((ext_vector_type(2))); typedef __bf16 bf16x2_t __attribute__((ext_vector_type(2)));
__device__ __forceinline__ unsigned cvtpk_s(float lo, float hi) { f32x2_t v = {lo, hi}; bf16x2_t b = __builtin_convertvector(v, bf16x2_t); return __builtin_bit_cast(unsigned, b); }
__device__ __forceinline__ unsigned off_b(unsigned row, unsigned ch) { return 256u * row + 16u * (ch ^ (((row & 3) << 2) | ((row >> 2) & 3))); }
__device__ __forceinline__ bf16x8 rd_row(LAS unsigned char* img, unsigned row, unsigned ks, unsigned h) { return *(const LAS bf16x8*)(img + off_b(row, 2 * ks + h)); }
__device__ __forceinline__ bf16x8 rd_tr(LAS unsigned char* img, unsigned lane, unsigned c, unsigned ks) {
    const unsigned h = lane >> 5, blk = (lane >> 4) & 1, q = (lane & 15) >> 2, p = lane & 3;
    const unsigned a0 = off_b(16 * ks + 8 * h + q, 4 * c + 2 * blk + (p >> 1)) + 8 * (p & 1);
    const unsigned a1 = off_b(16 * ks + 8 * h + 4 + q, 4 * c + 2 * blk + (p >> 1)) + 8 * (p & 1);
    const v4i16_t lo = __builtin_amdgcn_ds_read_tr16_b64_v4i16((LAS v4i16_t*)(img + a0));
    const v4i16_t hi = __builtin_amdgcn_ds_read_tr16_b64_v4i16((LAS v4i16_t*)(img + a1));
    return __builtin_shufflevector(lo, hi, 0, 1, 2, 3, 4, 5, 6, 7);
}
#define MFMA32(a, b, c) __builtin_amdgcn_mfma_f32_32x32x16_bf16((a), (b), (c), 0, 0, 0)
__device__ __forceinline__ void scan_item(Frame& F, const Args& a, int item) { const int tid_v = tid_(); const int lane_v = tid_v & 63; const int wave_v = __builtin_amdgcn_readfirstlane(tid_v >> 6); (void)lane_v; (void)wave_v;
    unsigned char* ws = a.ws;
    const bool isg = item >= 128; const int it = isg ? item - 128 : item;
    int b, hd, dv0, ldq; const bf16 *Qp, *Kp; bf16* Vp; float* Sout; const float* GLp = nullptr; float sdec = 1.f;
    if (!isg) { b = it >> 4; hd = (it >> 2) & 3; dv0 = (it & 3) * 64; ldq = 512;
        Qp = (const bf16*)(ws + Z_QR) + hd * 128; Kp = (const bf16*)(ws + Z_KR) + hd * 128; Vp = (bf16*)(ws + Z_VR) + hd * 256 + dv0;
        Sout = a.out + OFF_RETP + ((size_t)(b * HR + hd) * DKR) * DVR + dv0; sdec = __expf(64.0f * __logf(1.0f - exp2f(-5.0f - (float)hd))); }
    else { b = it >> 4; hd = (it >> 1) & 7; dv0 = (it & 1) * 64; ldq = 1024;
        Qp = (const bf16*)(ws + Z_QG) + hd * 128; Kp = (const bf16*)(ws + Z_KG) + hd * 128; Vp = (bf16*)(ws + Z_VG) + hd * 128 + dv0;
        Sout = a.out + OFF_HGP + ((size_t)(b * HG + hd) * DKG) * DVG + dv0; GLp = (const float*)(ws + WS_GL) + hd * 128; }
#if PROBE_ON && PROBE_SKINNY == 2
    const unsigned pt0_ = (unsigned)rt();
#endif
    const int ldo = isg ? DVG : DVR;
    LAS unsigned char* QI = F.lds; LAS unsigned char* KI = QI + 16384; LAS unsigned char* VI = KI + 16384; LAS unsigned char* PI = VI + 16384; LAS unsigned char* SI = PI + 16384;
    LAS unsigned char* OI = SI + 16384;
    const int tid = tid_v, lane = lane_v, w = wave_v; const unsigned r = lane & 31, h = lane >> 5;
    const int kb = w >> 1, dvb = w & 1;
    for (int i = tid; i < 16384 / 4; i += 512) ((LAS unsigned*)SI)[i] = 0u;
    f32x16 S;
#pragma unroll
    for (int i = 0; i < 16; ++i) S[i] = 0.f;
    const int qr0 = tid >> 4, qc0 = tid & 15, vr0 = tid >> 3, vc0 = tid & 7;
    const size_t rowb = (size_t)b * SEQ;
    v4u aq0, aq1, ak0, ak1, av, bq0, bq1, bk0, bk1, bv; f32x4 ag0, ag1, ag2, ag3, bg0, bg1, bg2, bg3;
    const float* glb = isg ? GLp + (size_t)b * (SEQ / CH) * DM + 32 * kb + 4 * h : nullptr;
#define SCAN_LOAD(c, Q0, Q1, K0, K1, V, G0, G1, G2, G3) do { const size_t r0_ = rowb + (size_t)(c) * CH; \
        Q0 = *(const v4u*)(Qp + (r0_ + qr0) * ldq + qc0 * 8); Q1 = *(const v4u*)(Qp + (r0_ + qr0 + 32) * ldq + qc0 * 8); \
        K0 = *(const v4u*)(Kp + (r0_ + qr0) * ldq + qc0 * 8); K1 = *(const v4u*)(Kp + (r0_ + qr0 + 32) * ldq + qc0 * 8); \
        V = *(const v4u*)(Vp + (r0_ + vr0) * DM + vc0 * 8); \
        if (isg) { const float* g_ = glb + (size_t)(c) * DM; G0 = *(const f32x4*)g_; G1 = *(const f32x4*)(g_ + 8); G2 = *(const f32x4*)(g_ + 16); G3 = *(const f32x4*)(g_ + 24); } } while (0)
    ag0 = ag1 = ag2 = ag3 = bg0 = bg1 = bg2 = bg3 = (f32x4){sdec, sdec, sdec, sdec};
    SCAN_LOAD(0, aq0, aq1, ak0, ak1, av, ag0, ag1, ag2, ag3);
    SCAN_LOAD(1, bq0, bq1, bk0, bk1, bv, bg0, bg1, bg2, bg3);
    const unsigned oi_off = (unsigned)(vr0 * 128 + 16 * (vc0 ^ (vr0 & 7)));
#define SCAN_DS(G0, G1, G2, G3) do { bf16x8 A[4], B[4]; \
        _Pragma("unroll") for (int ks = 0; ks < 4; ++ks) { A[ks] = rd_tr(KI, lane, kb, ks); B[ks] = rd_tr(VI, lane, dvb, ks); } \
        __builtin_amdgcn_sched_barrier(0); \
        f32x16 d; _Pragma("unroll") for (int i = 0; i < 16; ++i) d[i] = 0.f; \
        _Pragma("unroll") for (int ks = 0; ks < 4; ++ks) d = MFMA32(A[ks], B[ks], d); \
        _Pragma("unroll") for (int i = 0; i < 4; ++i) { S[i] = G0[i] * (S[i] + d[i]); S[4 + i] = G1[i] * (S[4 + i] + d[4 + i]); S[8 + i] = G2[i] * (S[8 + i] + d[8 + i]); S[12 + i] = G3[i] * (S[12 + i] + d[12 + i]); } } while (0)
#define SCAN_BODY(c, Q0, Q1, K0, K1, V, G0, G1, G2, G3) do { \
        LBAR();                                                   \
        if ((c) > 0) *(v4u*)(Vp + (rowb + (size_t)((c) - 1) * CH + vr0) * DM + vc0 * 8) = *(const LAS v4u*)(OI + oi_off);     \
        *(LAS v4u*)(QI + off_b(qr0, qc0)) = Q0; *(LAS v4u*)(QI + off_b(qr0 + 32, qc0)) = Q1; \
        *(LAS v4u*)(KI + off_b(qr0, qc0)) = K0; *(LAS v4u*)(KI + off_b(qr0 + 32, qc0)) = K1; \
        *(LAS v4u*)(VI + off_b(vr0, vc0)) = V; \
        const f32x4 g0 = G0, g1 = G1, g2 = G2, g3 = G3;          \
        if ((c) > 0) {                                            \
            _Pragma("unroll") for (int g = 0; g < 4; ++g) { u32x2 wv; wv.x = cvtpk_s(S[4 * g], S[4 * g + 1]); wv.y = cvtpk_s(S[4 * g + 2], S[4 * g + 3]); \
                *(LAS u32x2*)(SI + off_b(32 * dvb + r, 4 * kb + g) + 8 * h) = wv; } \
        } \
        if ((c) + 2 < SEQ / CH) SCAN_LOAD((c) + 2, Q0, Q1, K0, K1, V, G0, G1, G2, G3); \
        LBAR(); \
        if (w < 4) SCAN_DS(g0, g1, g2, g3); \
        else if (w < 7) {                                         \
            const int sb = (w - 4) >> 1, tb = (w - 3) >> 1; \
            bf16x8 A[8], B[8]; \
            _Pragma("unroll") for (int ks = 0; ks < 8; ++ks) { A[ks] = rd_row(KI, 32 * sb + r, ks, h); B[ks] = rd_row(QI, 32 * tb + r, ks, h); } \
            __builtin_amdgcn_sched_barrier(0); \
            f32x16 p; _Pragma("unroll") for (int i = 0; i < 16; ++i) p[i] = 0.f; \
            _Pragma("unroll") for (int ks = 0; ks < 8; ++ks) p = MFMA32(A[ks], B[ks], p); \
            _Pragma("unroll") for (int g = 0; g < 4; ++g) { float v[4]; \
                _Pragma("unroll") for (int i = 0; i < 4; ++i) { const int sl = 8 * g + 4 * (int)h + i; v[i] = (sb != tb || sl <= (int)r) ? p[4 * g + i] : 0.f; } \
                u32x2 wv; wv.x = cvtpk_s(v[0], v[1]); wv.y = cvtpk_s(v[2], v[3]); \
                *(LAS u32x2*)(PI + off_b(32 * tb + r, 4 * sb + g) + 8 * h) = wv; } \
        } \
        LBAR(); \
        if (w < 4) {                                              \
            const int ob = w >> 1, tb = w & 1; \
            f32x16 o; _Pragma("unroll") for (int i = 0; i < 16; ++i) o[i] = 0.f; \
            {   bf16x8 A[4], B[4]; \
                _Pragma("unroll") for (int ks = 0; ks < 4; ++ks) { A[ks] = rd_tr(VI, lane, ob, ks); B[ks] = rd_row(PI, 32 * tb + r, ks, h); } \
                __builtin_amdgcn_sched_barrier(0); \
                _Pragma("unroll") for (int ks = 0; ks < 4; ++ks) if (ks < 2 || tb == 1) o = MFMA32(A[ks], B[ks], o); } \
            {   bf16x8 A[8], B[8]; \
                _Pragma("unroll") for (int ks = 0; ks < 8; ++ks) { A[ks] = rd_row(SI, 32 * ob + r, ks, h); B[ks] = rd_row(QI, 32 * tb + r, ks, h); } \
                __builtin_amdgcn_sched_barrier(0); \
                _Pragma("unroll") for (int ks = 0; ks < 8; ++ks) o = MFMA32(A[ks], B[ks], o); } \
              \
            _Pragma("unroll") for (int g = 0; g < 4; ++g) { u32x2 wv; wv.x = cvtpk_s(o[4 * g], o[4 * g + 1]); wv.y = cvtpk_s(o[4 * g + 2], o[4 * g + 3]); \
                const unsigned t_ = 32 * tb + r, ch_ = 4 * ob + g; *(LAS u32x2*)(OI + t_ * 128 + 16 * (ch_ ^ (t_ & 7)) + 8 * h) = wv; } \
        } else SCAN_DS(g0, g1, g2, g3); \
    } while (0)
#pragma unroll 1
    for (int c = 0; c < SEQ / CH; c += 2) {
        SCAN_BODY(c, aq0, aq1, ak0, ak1, av, ag0, ag1, ag2, ag3);
        SCAN_BODY(c + 1, bq0, bq1, bk0, bk1, bv, bg0, bg1, bg2, bg3);
    }
#undef SCAN_BODY
#undef SCAN_DS
#undef SCAN_LOAD
    LBAR();
    *(v4u*)(Vp + (rowb + (size_t)(SEQ / CH - 1) * CH + vr0) * DM + vc0 * 8) = *(const LAS v4u*)(OI + oi_off);
#pragma unroll
    for (int i = 0; i < 16; ++i) { const int k = 32 * kb + (i & 3) + 8 * (i >> 2) + 4 * (int)h; Sout[(size_t)k * ldo + 32 * dvb + r] = S[i]; }
    __syncthreads();
#if PROBE_ON && PROBE_SKINNY == 2
    if (threadIdx.x == 0) F.MISC[18] += (unsigned)rt() - pt0_;
#endif
}

template <bool ISG> __device__ __forceinline__ void dec_load(const Args& a, int item, int tid, int lane, int w, f32x4 (&s)[16], float& qkf, unsigned long long& vw) {
    unsigned char* ws = a.ws;
    if (!ISG) { const int n = item >> 2, h = item & 3, row = MPROMPT + n;
        const float* S0 = a.in[2] + ((size_t)(n * HR + h) * DKR) * DVR;
#pragma unroll
        for (int i = 0; i < 16; ++i) s[i] = *(const f32x4*)(S0 + ((size_t)(w + 8 * i) * 64 + lane) * 4);
        qkf = tid < 128 ? bf2f_(((const bf16*)(ws + Z_QR))[(size_t)row * 512 + h * 128 + tid]) : tid < 256 ? bf2f_(((const bf16*)(ws + Z_KR))[(size_t)row * 512 + h * 128 + tid - 128]) : 0.f;
        vw = *(const unsigned long long*)((const bf16*)(ws + Z_VR) + (size_t)row * DM + h * 256 + 4 * lane);
    } else { const int n = item >> 3, h = item & 7, row = MPROMPT + n;
        const float* S0 = a.in[3] + ((size_t)(n * HG + h) * DKG) * DVG;
#pragma unroll
        for (int i = 0; i < 8; ++i) s[i] = *(const f32x4*)(S0 + ((size_t)(w + 8 * i) * 64 + lane) * 4);
        qkf = tid < 128 ? bf2f_(((const bf16*)(ws + Z_QG))[(size_t)row * DM + h * 128 + tid]) : tid < 256 ? bf2f_(((const bf16*)(ws + Z_KG))[(size_t)row * DM + h * 128 + tid - 128])
            : tid < 384 ? ((const float*)(ws + WS_FS))[(size_t)n * DM + h * 128 + tid - 256] : 0.f;
        vw = *(const unsigned long long*)((const bf16*)(ws + Z_VG) + (size_t)row * DM + h * 128 + 4 * (lane & 31));
    }
}
template <bool ISG> __device__ __forceinline__ void dec_compute(Frame& F, const Args& a, int item, int tid, int lane, int w, const f32x4 (&s)[16], float qkf, unsigned long long vw) {
    unsigned char* ws = a.ws;
    LAS float* qs = (LAS float*)(F.lds); LAS float* red = qs + 384; LAS float* part = red + 8 * 256;
    LAS float* ks = qs + 128; LAS float* fs = qs + 256;
    if (tid < 384) qs[tid] = qkf;
    const f32x4 v = (f32x4){bflo_((unsigned)vw), bfhi_((unsigned)vw), bflo_((unsigned)(vw >> 32)), bfhi_((unsigned)(vw >> 32))};
    LBAR();
    f32x4 o = (f32x4){0.f, 0.f, 0.f, 0.f};
    if (!ISG) { const int n = item >> 2, h = item & 3; const float gam = 1.0f - exp2f(-5.0f - (float)h);
        float* S1 = a.out + OFF_RETS + ((size_t)(n * HR + h) * DKR) * DVR;
#pragma unroll
        for (int i = 0; i < 16; ++i) { const int k = w + 8 * i; const f32x4 sn = s[i] * gam + v * ks[k]; *(f32x4*)(S1 + ((size_t)k * 64 + lane) * 4) = sn; o += sn * qs[k]; }
    } else { const int n = item >> 3, h = item & 7;
        float* S1 = a.out + OFF_HGS + ((size_t)(n * HG + h) * DKG) * DVG;
#pragma unroll
        for (int i = 0; i < 8; ++i) { const int k = 2 * (w + 8 * i) + (lane >> 5); const f32x4 sn = s[i] * fs[k] + v * ks[k]; *(f32x4*)(S1 + ((size_t)(w + 8 * i) * 64 + lane) * 4) = sn; o += sn * qs[k]; }
    }
    *(LAS f32x4*)(red + w * 256 + 4 * lane) = o;
    LBAR();
    constexpr int NDV = ISG ? 128 : 256; float ov = 0.f;
    if (tid < NDV) {
        if (!ISG) {
#pragma unroll
            for (int i = 0; i < 8; ++i) ov += red[i * 256 + tid];
        } else {
#pragma unroll
            for (int i = 0; i < 8; ++i) ov += red[i * 256 + tid] + red[i * 256 + 128 + tid];
        }
        const float ss = wave_sum(ov * ov); if (lane == 0) part[w] = ss;
    }
    LBAR();
    if (tid < NDV) {
        const float rstd = rsqrtf((ISG ? (part[0] + part[1]) : ((part[0] + part[1]) + (part[2] + part[3]))) * (1.0f / NDV) + EPS);
        const int n = ISG ? item >> 3 : item >> 2, h = ISG ? item & 7 : item & 3, row = MPROMPT + n;
        bf16* gp = (bf16*)(ws + (ISG ? WS_GG : WS_GR)) + (size_t)row * DM + h * NDV + tid;
        const float gv_ = bf2f_(*gp); *gp = (bf16)f2bf(ov * rstd * a.in[ISG ? 9 : 8][h * NDV + tid] * (gv_ / (1.0f + __expf(-gv_))));
    }
    LBAR();
}
__device__ __forceinline__ void decode_all(Frame& F, const Args& a) { const int tid_v = tid_(); const int lane_v = tid_v & 63; const int wave_v = __builtin_amdgcn_readfirstlane(tid_v >> 6);
    const int tid = tid_v, lane = lane_v, w = wave_v, c = F.vcu, G = F.G;
    f32x4 sa[16], sb[16]; float qa, qb; unsigned long long va, vb;
    dec_load<false>(a, c, tid, lane, w, sa, qa, va);
    dec_load<false>(a, c + G, tid, lane, w, sb, qb, vb);          dec_compute<false>(F, a, c, tid, lane, w, sa, qa, va);
    dec_load<true>(a, c, tid, lane, w, sa, qa, va);              dec_compute<false>(F, a, c + G, tid, lane, w, sb, qb, vb);
    dec_load<true>(a, c + G, tid, lane, w, sb, qb, vb);          dec_compute<true>(F, a, c, tid, lane, w, sa, qa, va);
    dec_load<true>(a, c + 2 * G, tid, lane, w, sa, qa, va);      dec_compute<true>(F, a, c + G, tid, lane, w, sb, qb, vb);
    dec_load<true>(a, c + 3 * G, tid, lane, w, sb, qb, vb);      dec_compute<true>(F, a, c + 2 * G, tid, lane, w, sa, qa, va);
    dec_compute<true>(F, a, c + 3 * G, tid, lane, w, sb, qb, vb);
}

__device__ __forceinline__ void p3_headnorm(Frame& F, const Args& a) { const int tid_v = tid_(); const int lane_v = tid_v & 63; const int wave_v = __builtin_amdgcn_readfirstlane(tid_v >> 6); (void)lane_v; (void)wave_v;
    unsigned char* ws = a.ws; const int gw = F.vcu * NWAVES + wave_v, NGW = F.G * NWAVES, lane = lane_v;
    constexpr int NIT = MPROMPT * 8, U = 4;
    for (int it0 = gw; it0 < NIT; it0 += U * NGW) {
        unsigned long long ow[U], gwd[U]; f32x4 gn[U]; unsigned long long* gp[U]; bool isg[U], ok[U];
#pragma unroll
        for (int u = 0; u < U; ++u) {
            const int it = it0 + u * NGW; ok[u] = it < NIT; const int itc = ok[u] ? it : gw;
            isg[u] = itc >= MPROMPT * 4; const int i2 = isg[u] ? itc - MPROMPT * 4 : itc; const int row = i2 >> 2, q = i2 & 3;
            const size_t off = (size_t)row * DM + q * 256 + 4 * lane;
            ow[u] = *(const unsigned long long*)((const bf16*)(ws + (isg[u] ? Z_VG : Z_VR)) + off);
            gp[u] = (unsigned long long*)((bf16*)(ws + (isg[u] ? WS_GG : WS_GR)) + off); gwd[u] = *gp[u];
            gn[u] = *(const f32x4*)(a.in[isg[u] ? 9 : 8] + q * 256 + 4 * lane);
        }
#pragma unroll
        for (int u = 0; u < U; ++u) {
            const f32x4 o = (f32x4){bflo_((unsigned)ow[u]), bfhi_((unsigned)ow[u]), bflo_((unsigned)(ow[u] >> 32)), bfhi_((unsigned)(ow[u] >> 32))};
            f32x4 gt = (f32x4){bflo_((unsigned)gwd[u]), bfhi_((unsigned)gwd[u]), bflo_((unsigned)(gwd[u] >> 32)), bfhi_((unsigned)(gwd[u] >> 32))};
            gt.x = gt.x / (1.0f + __expf(-gt.x)); gt.y = gt.y / (1.0f + __expf(-gt.y)); gt.z = gt.z / (1.0f + __expf(-gt.z)); gt.w = gt.w / (1.0f + __expf(-gt.w));
            float ss = (o.x * o.x + o.y * o.y) + (o.z * o.z + o.w * o.w);
#pragma unroll
            for (int d = 1; d < 32; d <<= 1) ss += __shfl_xor(ss, d);
            if (!isg[u]) ss += __shfl_xor(ss, 32);
            const float rstd = rsqrtf(ss * (isg[u] ? 1.0f / DVG : 1.0f / DVR) + EPS);
            const f32x4 x = o * rstd * gn[u] * gt;
            if (ok[u]) *gp[u] = (unsigned long long)pk2(x.x, x.y) | ((unsigned long long)pk2(x.z, x.w) << 32);
        }
    }
}

__device__ __forceinline__ void p9_final(Frame& F, const Args& a) { const int tid_v = tid_(); const int lane_v = tid_v & 63; const int wave_v = __builtin_amdgcn_readfirstlane(tid_v >> 6); (void)lane_v; (void)wave_v;
    const int gw = F.vcu * NWAVES + wave_v, NGW = F.G * NWAVES, lane = lane_v; const float* PS3 = (const float*)(a.ws + WS_PS3); const float* gf = a.in[20];
    for (int m = gw; m < MTOT; m += NGW) {
        const float pv = m < MPROMPT ? (lane < 16 ? PS3[(size_t)m * 16 + lane] : 0.f) : ((const float*)(a.ws + WS_PSS3))[(size_t)(m - MPROMPT) * 64 + lane];
        const float rstd = rsqrtf(wave_sum(pv) * (1.0f / DM) + EPS);
        const unsigned long long* r16 = (const unsigned long long*)((const bf16*)(a.ws + WS_A5) + (size_t)m * DM) + lane;
        f32x4* y = (f32x4*)(a.out + (size_t)m * DM) + lane;
#pragma unroll
        for (int j = 0; j < 4; ++j) { const unsigned long long w = r16[64 * j]; const f32x4 gv = *((const f32x4*)gf + 64 * j + lane);
            y[64 * j] = (f32x4){bflo_((unsigned)w), bfhi_((unsigned)w), bflo_((unsigned)(w >> 32)), bfhi_((unsigned)(w >> 32))} * rstd * gv; }
    }
}

template <int K, class FE> __device__ __forceinline__ void skinny_gemm(Frame& F, const bf16* As, const bf16* Wt, int N, const FE& fe, int it0 = 0, int it1 = 1 << 30) {     const int tid_v = tid_(); const int lane_v = tid_v & 63; const int wave_v = __builtin_amdgcn_readfirstlane(tid_v >> 6); (void)lane_v; (void)wave_v;
    constexpr int KW = K / 4, NKS = KW / 32, CH_KS = NKS < 8 ? NKS : 8, NCH = NKS / CH_KS;
    const int lane = lane_v, fr = lane & 15, fq = lane >> 4, rg = wave_v >> 2, ks = wave_v & 3;
    LAS f32x4* red = (LAS f32x4*)(F.lds);
    const int ntile = 4 * (N / 16);
#if PROBE_ON && PROBE_SKINNY == 1
    const unsigned ps0_ = (unsigned)rt();
#endif
    for (int itn = it0; itn < it1; ++itn) {
        const int tile = F.vcu + itn * F.G; if (tile >= ntile) break;
        const int rb = tile & 3, cb = tile >> 2;
        const bf16* ap = Wt + (size_t)(16 * cb + fr) * K + ks * KW + 8 * fq;
        const bf16* bp = As + (size_t)(32 * rb + 16 * rg + fr) * K + ks * KW + 8 * fq;
        f32x4 acc = (f32x4){0.f, 0.f, 0.f, 0.f};
#pragma unroll 1
        for (int c = 0; c < NCH; ++c) {
            bf16x8 a[CH_KS], b[CH_KS];
#pragma unroll
            for (int i = 0; i < CH_KS; ++i) { a[i] = *(const bf16x8*)(ap + (c * CH_KS + i) * 32); b[i] = *(const bf16x8*)(bp + (c * CH_KS + i) * 32); }
#pragma unroll
            for (int i = 0; i < CH_KS; ++i) acc = __builtin_amdgcn_mfma_f32_16x16x32_bf16(a[i], b[i], acc, 0, 0, 0);
        }
        red[wave_v * 64 + lane] = acc;
        __syncthreads();
        if (ks == 0) {
            const f32x4 v = (red[(4 * rg + 0) * 64 + lane] + red[(4 * rg + 1) * 64 + lane]) + (red[(4 * rg + 2) * 64 + lane] + red[(4 * rg + 3) * 64 + lane]);
            fe(MPROMPT + 32 * rb + 16 * rg + fr, 16 * cb + 4 * fq, v);
        }
        __syncthreads();
    }
#if PROBE_ON && PROBE_SKINNY == 1
    if (threadIdx.x == 0) F.MISC[18] += (unsigned)rt() - ps0_;
#endif
}
struct FeIn { pg8::EpiIn E; __device__ __forceinline__ void operator()(int row, int col, f32x4 v) const { pg8::samp_in(E, row, col, v); } };
template <int MODE> struct FeN { pg8::EpiN<MODE> E; const float* xs; float* PSS; const float* PSSin;
    __device__ __forceinline__ void operator()(int row, int col, f32x4 v) const { pg8::samp_n<MODE>(E, xs, PSS, PSSin, row, col, v); } };

struct PairOrder { pg8::StaticOrder S0;
    __device__ __forceinline__ bool next(int i, pg8::Unit& u) const { pg8::Unit t; if (!S0.next(i >> 1, t)) return false; if ((i & 1) == 0) { u.pm = t.pm + MP / 256; u.pn = t.pn + DM / 256; } else u = t; return true; }
    __device__ __forceinline__ void a_ready(const pg8::Unit&) const {}
    __device__ __forceinline__ void done(const pg8::Unit&) const {} };
struct EpiUp { static constexpr bool PERM = true, AFTER_DRAIN = false; const pg8::bf16_t* AR; const pg8::bf16_t* AH; pg8::bf16_t* M;
    __device__ __forceinline__ bool keep_acc(const pg8::Unit& u) const { return u.pn >= DM / 256; }
    __device__ __forceinline__ void operator()(f32x4 (&acc)[2][2][4][2], const pg8::Unit& u, int wr, int wc, int fr, int fq) const {
        using namespace pg8;
        const bool first = u.pn >= DM / 256; const int pm = first ? u.pm - MP / 256 : u.pm, pn = first ? u.pn - DM / 256 : u.pn;
#pragma unroll
        for (int ai = 0; ai < 2; ++ai)
#pragma unroll
            for (int m = 0; m < 4; ++m) {
                const int row = pm * BM + ai * HALF + wr * 64 + m * 16 + fr;
#pragma unroll
                for (int bj = 0; bj < 2; ++bj) {
                    const int col = pn * BM + bj * HALF + wc * 32 + fq * 8; const size_t o = (size_t)row * DM + col;
                    f32x4 r0, r1; unpack8(*(const u32x4*)(AR + o), r0, r1);
                    if (first) { f32x4 h0, h1; unpack8(*(const u32x4*)(AH + o), h0, h1);
#pragma unroll
                        for (int e = 0; e < 4; ++e) { acc[ai][bj][m][0][e] *= h0[e] * __builtin_amdgcn_rcpf(fmaxf(r0[e], 1e-20f)); acc[ai][bj][m][1][e] *= h1[e] * __builtin_amdgcn_rcpf(fmaxf(r1[e], 1e-20f)); } }
                    else *(u32x4*)(M + o) = pack8(r0 * acc[ai][bj][m][0], r1 * acc[ai][bj][m][1]);
                }
            }
    } };

__global__ void __launch_bounds__(NWAVES * 64, 2) fwd_kernel(Args args) {
#define tid_v ((int)threadIdx.x)
    extern __shared__ __attribute__((aligned(16))) unsigned char lds[];
    Frame F;
    F.lds = (LAS unsigned char*)lds;
    F.MISC = (volatile LAS unsigned*)(F.lds + MISC_OFF);
        F.G = gridDim.x; { const int bx = blockIdx.x; F.vcu = (F.G % 8 == 0) ? (bx % 8) * (F.G / 8) + bx / 8 : bx; }
    unsigned char* ws = args.ws;
    F.ctl = (gu32*)(ws + WS_CTL);
    for (int u = tid_v; u < (LDS_BYTES - LDSCTL_OFF) / 4; u += NWAVES * 64) ((LAS unsigned*)(F.lds + LDSCTL_OFF))[u] = 0u;
    __syncthreads();
    XcdBarrier bar; bar.bar = (unsigned*)(F.ctl + CW_BAR); bar.x = 0; bar.st = nullptr;
    if (args.use_bar) bar = xcd_barrier_post((unsigned*)(F.ctl + CW_BAR), F.MISC + 8);
    const int lo = args.ph_lo, hi = args.ph_hi;
#define IN(k) (lo <= (k) && (k) < hi)
#if PROBE_ON
    volatile LAS unsigned* PW = F.MISC + 16;
    if (tid_v == 0) { PW[0] = (unsigned)rt(); PW[1] = 0u; PW[2] = 0u; }
#define STAMP(k) do { if (blockIdx.x == 0 && tid_v == 0) { const unsigned t_ = (unsigned)rt(); unsigned q_ = (t_ - PW[0] + (unsigned)PROBE_UNIT / 2) / (unsigned)PROBE_UNIT; if (q_ > 49u) q_ = 49u; \
        if ((k) == PROBE_A) PW[1] += q_ * 400u; else if ((k) == PROBE_B) PW[1] += q_ * 20000u; else if (PROBE_E < 0 && (k) == PROBE_C) PW[1] += q_ * 1000000u; \
        if ((k) == PROBE_E) { unsigned e_ = (PW[2] + (unsigned)PROBE_UNIT / 2) / (unsigned)PROBE_UNIT; if (e_ > 49u) e_ = 49u; PW[1] += e_ * 1000000u; } PW[2] = 0u; PW[0] = t_; } } while (0)
#else
#define STAMP(k) do { } while (0)
#endif
#define SEAM(k) do { if (IN(k) && IN((k) + 1)) xcd_barrier(bar); STAMP(k); } while (0)
    using namespace pg8;
    bf16_t* XB = (bf16_t*)(args.out + OFF_RETS);
    bf16_t* AR = (bf16_t*)(args.out + OFF_Y); bf16_t* AH = AR + (size_t)MTOT * DM;
    float* R = args.out + OFF_Y;
    float* PS1 = (float*)(ws + WS_PS1); float* PS2 = (float*)(ws + WS_PS2); float* PS3 = (float*)(ws + WS_PS3);

    if (IN(0)) { p0_prologue(F, args); SEAM(0); }
    const bf16_t* SROW = nullptr; (void)SROW;
    float* PSS1 = (float*)(ws + WS_PSS1); float* PSS2 = (float*)(ws + WS_PSS2); float* PSS3 = (float*)(ws + WS_PSS3);
#define SAMP(buf, ld) ((const bf16*)(buf) + (size_t)MPROMPT * (ld))
    if (IN(1)) {
        Gemm g{XB, (const bf16_t*)(ws + WS_WIN), MPROMPT, DIN, DM}; StaticOrder S; S.init(MPROMPT, DIN, F.G, (int)blockIdx.x);
        EpiIn E{(const float*)(ws + WS_RSTD0), (const float*)(ws + WS_CS), (const float*)(ws + WS_LB),
                (bf16_t*)(ws + Z_QR), (bf16_t*)(ws + Z_KR), (bf16_t*)(ws + Z_VR), (bf16_t*)(ws + WS_GR), (bf16_t*)(ws + Z_QG), (bf16_t*)(ws + Z_KG), (bf16_t*)(ws + Z_VG), (bf16_t*)(ws + WS_GG),
                AR, AH, (float*)(ws + WS_GL), (float*)(ws + WS_FS), ws, (unsigned char*)args.out};
        const int nfirst = (F.vcu & 3) * 3;
        { FeIn fe{E}; skinny_gemm<DM>(F, SAMP(XB, DM), (const bf16*)(ws + WS_WIN), DIN, fe, 0, nfirst); }
        gemm_phase<EpiIn, StaticOrder, true, true>(F.lds + RING_OFF, g, S, E);
        { FeIn fe{E}; skinny_gemm<DM>(F, SAMP(XB, DM), (const bf16*)(ws + WS_WIN), DIN, fe, nfirst); }
        SEAM(1);
    }
    if (IN(2)) {
        const bool dec_first = (F.vcu & 1) != 0;
        if (dec_first) decode_all(F, args);
        for (int it = F.vcu; it < 256; it += F.G) scan_item(F, args, it);
        if (!dec_first) decode_all(F, args);
        SEAM(2);
    }
    if (IN(3)) { p3_headnorm(F, args); SEAM(3); }
    if (IN(4)) {
        Gemm g{(const bf16_t*)(ws + WS_GR), (const bf16_t*)(ws + WS_WUPR), 2 * MP, 2 * DM, DM}; PairOrder S; S.S0.init(MPROMPT, DM, F.G, (int)blockIdx.x);
        EpiN<0> E0{AH, (bf16_t*)(ws + WS_MB), DM, nullptr, nullptr, nullptr, nullptr, nullptr, nullptr};
        EpiN<1> E1{AR, (bf16_t*)(ws + WS_MB), DM, nullptr, nullptr, nullptr, nullptr, nullptr, nullptr};
        EpiUp E{AR, AH, (bf16_t*)(ws + WS_MB)};
        const bool sk_first = (F.vcu & 1) != 0;
        if (sk_first) { { FeN<0> fe{E0, nullptr, nullptr, nullptr}; skinny_gemm<DM>(F, SAMP(ws + WS_GG, DM), (const bf16*)(ws + WS_WUPH), DM, fe); }
                        { FeN<1> fe{E1, nullptr, nullptr, nullptr}; skinny_gemm<DM>(F, SAMP(ws + WS_GR, DM), (const bf16*)(ws + WS_WUPR), DM, fe); } }
        gemm_phase<EpiUp, PairOrder, true, true>(F.lds + RING_OFF, g, S, E);
        if (!sk_first) { { FeN<0> fe{E0, nullptr, nullptr, nullptr}; skinny_gemm<DM>(F, SAMP(ws + WS_GG, DM), (const bf16*)(ws + WS_WUPH), DM, fe); }
                         { FeN<1> fe{E1, nullptr, nullptr, nullptr}; skinny_gemm<DM>(F, SAMP(ws + WS_GR, DM), (const bf16*)(ws + WS_WUPR), DM, fe); } }
        SEAM(4);
    }
    if (IN(5)) {
        Gemm g{(const bf16_t*)(ws + WS_MB), (const bf16_t*)(ws + WS_WO), MPROMPT, DM, DM}; StaticOrder S; S.init(MPROMPT, DM, F.G, (int)blockIdx.x);
        EpiN<2> E{nullptr, (bf16_t*)(ws + WS_A5), DM, args.in[0], nullptr, nullptr, nullptr, PS1, nullptr};
        const bool sk_first = (F.vcu & 1) != 0; FeN<2> fe{E, args.in[1], PSS1, nullptr};
        if (sk_first) skinny_gemm<DM>(F, SAMP(ws + WS_MB, DM), (const bf16*)(ws + WS_WO), DM, fe);
        gemm_phase<EpiN<2>, StaticOrder, true, true>(F.lds + RING_OFF, g, S, E);
        if (!sk_first) skinny_gemm<DM>(F, SAMP(ws + WS_MB, DM), (const bf16*)(ws + WS_WO), DM, fe);
        SEAM(5);
    }
    if (IN(6)) {
        Gemm g{(const bf16_t*)(ws + WS_A5), (const bf16_t*)(ws + WS_WFF1), MPROMPT, DFF, DM}; StaticOrder S; S.init(MPROMPT, DFF, F.G, (int)blockIdx.x);
        EpiN<3> E{nullptr, (bf16_t*)(ws + WS_H), DFF, nullptr, nullptr, nullptr, nullptr, nullptr, PS1};
        const int nfirst = (F.vcu & 3) + ((F.vcu & 3) == 3 ? 1 : 0); FeN<3> fe{E, nullptr, nullptr, PSS1};
        skinny_gemm<DM>(F, SAMP(ws + WS_A5, DM), (const bf16*)(ws + WS_WFF1), DFF, fe, 0, nfirst);
        gemm_phase<EpiN<3>, StaticOrder, true, true>(F.lds + RING_OFF, g, S, E);
        skinny_gemm<DM>(F, SAMP(ws + WS_A5, DM), (const bf16*)(ws + WS_WFF1), DFF, fe, nfirst);
        SEAM(6);
    }
    if (IN(7)) {
        Gemm g{(const bf16_t*)(ws + WS_H), (const bf16_t*)(ws + WS_WFF2), MPROMPT, DM, DFF}; StaticOrder S; S.init(MPROMPT, DM, F.G, (int)blockIdx.x);
        EpiN<6> E{(const bf16_t*)(ws + WS_A5), (bf16_t*)(ws + WS_A7), DM, nullptr, nullptr, nullptr, nullptr, PS2, nullptr};
        const bool sk_first = (F.vcu & 1) != 0; FeN<6> fe{E, nullptr, PSS2, nullptr};
        if (sk_first) skinny_gemm<DFF>(F, SAMP(ws + WS_H, DFF), (const bf16*)(ws + WS_WFF2), DM, fe);
        gemm_phase<EpiN<6>, StaticOrder, true, true>(F.lds + RING_OFF, g, S, E);
        if (!sk_first) skinny_gemm<DFF>(F, SAMP(ws + WS_H, DFF), (const bf16*)(ws + WS_WFF2), DM, fe);
        SEAM(7);
    }
    if (IN(8)) {
        { Gemm g{(const bf16_t*)(ws + WS_A7), (const bf16_t*)(ws + WS_WGATE), MPROMPT, DM, DM}; StaticOrder S; S.init(MPROMPT, DM, F.G, (int)blockIdx.x);
          EpiN<4> E{nullptr, (bf16_t*)(ws + WS_MB), DM, nullptr, nullptr, nullptr, nullptr, nullptr, PS2};
          gemm_phase<EpiN<4>, StaticOrder, true, true>(F.lds + RING_OFF, g, S, E);
          FeN<4> fe{E, nullptr, nullptr, PSS2}; skinny_gemm<DM>(F, SAMP(ws + WS_A7, DM), (const bf16*)(ws + WS_WGATE), DM, fe); }
        { Gemm g{(const bf16_t*)(ws + WS_PB), (const bf16_t*)(ws + WS_WPROJ), MPROMPT, DM, DPLE}; StaticOrder S; S.init(MPROMPT, DM, F.G, (int)blockIdx.x);
          EpiN<5> E{(const bf16_t*)(ws + WS_A7), (bf16_t*)(ws + WS_MB), DM, nullptr, nullptr, (float*)(ws + WS_A5), nullptr, PS3, nullptr};
          gemm_phase<EpiN<5>, StaticOrder, true, true>(F.lds + RING_OFF, g, S, E);
          FeN<5> fe{E, nullptr, PSS3, nullptr}; skinny_gemm<DPLE>(F, SAMP(ws + WS_PB, DPLE), (const bf16*)(ws + WS_WPROJ), DM, fe); }
        SEAM(8);
    }
    if (IN(9)) { p9_final(F, args); }
#if PROBE_ON
    STAMP(9);
    if (blockIdx.x == 0 && tid_v == 0) { const unsigned t0_ = (unsigned)rt(); const unsigned dly_ = PW[1]; while ((unsigned)rt() - t0_ < dly_) __builtin_amdgcn_s_sleep(16); }
#endif
#undef IN
#undef SEAM
#undef tid_v
}

extern "C" void kernel_launch(void* const* d_in, const int* in_sizes, int n_in, void* d_out, int out_size, void* d_ws, size_t ws_size, hipStream_t stream) {
    static int grid = 0;
    if (grid == 0) {
        if (n_in != 21 || out_size != (int)OUT_TOTAL || ws_size < WS_END) { fprintf(stderr, "kernel_launch: unexpected problem (n_in %d out %d ws %zu need %zu)\n", n_in, out_size, ws_size, (size_t)WS_END); grid = -1; return; }
        int dev = 0, cus = 0;
        if (hipGetDevice(&dev) != hipSuccess || hipDeviceGetAttribute(&cus, hipDeviceAttributeMultiprocessorCount, dev) != hipSuccess) { grid = -1; return; }
        if (hipFuncSetAttribute((const void*)fwd_kernel, hipFuncAttributeMaxDynamicSharedMemorySize, LDS_BYTES) != hipSuccess) { fprintf(stderr, "kernel_launch: hipFuncSetAttribute failed\n"); grid = -1; return; }
        (void)hipGetLastError();
        grid = cus;
    }
    if (grid < 0) return;
    (void)hipMemsetAsync((char*)d_ws + WS_CTL, 0, CTL_ZERO_BYTES, stream);
    Args a{};
    for (int i = 0; i < 21; ++i) a.in[i] = (const float*)d_in[i];
    a.out = (float*)d_out; a.ws = (unsigned char*)d_ws;
#if MK_ONE_LAUNCH
    a.ph_lo = 0; a.ph_hi = NPH; a.use_bar = 1;
    hipLaunchKernelGGL(fwd_kernel, dim3(grid), dim3(NWAVES * 64), LDS_BYTES, stream, a);
#else
    for (int p = 0; p < NPH; ++p) { a.ph_lo = p; a.ph_hi = p + 1; a.use_bar = 0; hipLaunchKernelGGL(fwd_kernel, dim3(grid), dim3(NWAVES * 64), LDS_BYTES, stream, a); }
#endif
}
```

```cpp
#include <hip/hip_runtime.h>
#include <cstdio>
#include <cstdint>
#ifndef PROBE_ON
#define PROBE_ON 0
#endif
#define PROBE_UNIT 800ull
#ifndef PROBE_A
#define PROBE_A 0
#define PROBE_B 1
#define PROBE_C 2
#endif
#ifndef PROBE_E
#define PROBE_E -1
#endif
#ifndef PROBE_SKINNY
#define PROBE_SKINNY 0
#endif
namespace pg8 {
#define PG8_LAS __attribute__((address_space(3)))
typedef unsigned short bf16_t;
typedef short bf16x8 __attribute__((ext_vector_type(8)));
typedef float f32x4 __attribute__((ext_vector_type(4)));
typedef unsigned u32x4 __attribute__((ext_vector_type(4)));
constexpr int BM = 256, BK = 64, HALF = 128, HTB = HALF * BK * 2  , STAGE_BYTES = 8 * HTB, NXCD = 8, WGM = 8;

__host__ __device__ __forceinline__ int lds_byte(int r, int c) { const int st = (r >> 4) * 2 + (c >> 5), rr = r & 15, cc = c & 31, ob = rr * 64 + cc * 2; return st * 1024 + (ob ^ (((ob >> 9) & 1) << 5)); }
__host__ __device__ __forceinline__ void stage_rc(int b, int& R, int& C) { const int st = b / 1024, sb = b % 1024, swz = sb ^ (((sb >> 9) & 1) << 5); R = (st >> 1) * 16 + swz / 64; C = (st & 1) * 32 + (swz % 64) / 2; }
__host__ __device__ __forceinline__ int perm32(int rho) { const int n = rho >> 4, i = rho & 15; return 8 * (i >> 2) + 4 * n + (i & 3); }

struct Unit { int pm, pn; };
struct Gemm { const bf16_t* A; const bf16_t* Bt; int M, N, K; };

struct StaticOrder {
    int nM, nN, nwg, G, c;
    __host__ __device__ void init(int M, int N, int G_, int c_) { nM = M / BM; nN = N / BM; nwg = nM * nN; G = G_; c = c_; }
    __host__ __device__ __forceinline__ bool next(int i, Unit& u) const {
        const long L = (long)i * G + c; if (L >= nwg) return false;
        int wgid = (int)L; { const int q = nwg / NXCD, r = nwg % NXCD, xcd = wgid % NXCD, off = wgid / NXCD; wgid = (xcd < r ? xcd * (q + 1) : r * (q + 1) + (xcd - r) * q) + off; }
        const int nig = WGM * nN, gid = wgid / nig, fm = gid * WGM, gsz = (nM - fm) < WGM ? (nM - fm) : WGM;
        u.pm = fm + ((wgid % nig) % gsz); u.pn = (wgid % nig) / gsz; return true;
    }
    __device__ __forceinline__ void a_ready(const Unit&) const {}
    __device__ __forceinline__ void done(const Unit&) const {}
};

typedef float pg8_f32x2_t __attribute__((ext_vector_type(2))); typedef __bf16 pg8_bf16x2_t __attribute__((ext_vector_type(2)));
__device__ __forceinline__ unsigned cvt_pk_bf16(float lo, float hi) { pg8_f32x2_t v = {lo, hi}; pg8_bf16x2_t b = __builtin_convertvector(v, pg8_bf16x2_t); return __builtin_bit_cast(unsigned, b); }

template <class Epi, class Sched, bool ALIGN_EPI = false, bool SP2 = false>
__device__ __forceinline__ void gemm_phase(PG8_LAS unsigned char* lds, const Gemm g, const Sched& S, const Epi& E) {
    const int tid = threadIdx.x, wid = __builtin_amdgcn_readfirstlane(tid >> 6), lane = tid & 63, wr = wid >> 2, wc = wid & 3, fr = lane & 15, fq = lane >> 4;
    const int K = g.K, nt = K / BK;
    unsigned voffA[2], voffB[2];
#pragma unroll
    for (int i = 0; i < 2; ++i) { int R, C; stage_rc(tid * 16 + i * 8192, R, C); const int Rb = Epi::PERM ? ((R & ~31) + perm32(R & 31)) : R;
        voffA[i] = (unsigned)(R * K + C) * 2u; voffB[i] = (unsigned)(Rb * K + C) * 2u; }
    const size_t kstep = (size_t)(BK * 2);
    const size_t hstep = (size_t)HALF * K * 2;
    const size_t tstep = 2 * hstep;
    const unsigned ldsw = (unsigned)wid * 1024u;
    const int aoff = lds_byte(wr * 64 + fr, fq * 8), boff = lds_byte(wc * 32 + fr, fq * 8);
#define PG8_SA(b, h) (((b) * 2 + (h)) * HTB)
#define PG8_SB(b, h) ((4 + (b) * 2 + (h)) * HTB)
#define PG8_STAGE(bufoff, gbase, voff) do { _Pragma("unroll") for (int _i = 0; _i < 2; ++_i) \
        __builtin_amdgcn_global_load_lds((const unsigned*)((const char*)(gbase) + (voff)[_i]), (PG8_LAS unsigned*)(lds + (bufoff) + ldsw + _i * 8192), 16, 0, 0); } while (0)
#define PG8_LDA(dst, b, h) do { _Pragma("unroll") for (int m = 0; m < 4; ++m) _Pragma("unroll") for (int k = 0; k < 2; ++k) dst[m][k] = *(const PG8_LAS bf16x8*)(lds + PG8_SA(b, h) + aoff + m * 2048 + k * 1024); } while (0)
#define PG8_LDB(dst, b, h) do { _Pragma("unroll") for (int n = 0; n < 2; ++n) _Pragma("unroll") for (int k = 0; k < 2; ++k) dst[n][k] = *(const PG8_LAS bf16x8*)(lds + PG8_SB(b, h) + boff + n * 2048 + k * 1024); } while (0)
#define PG8_MMA(ai, bj, At, Bt) do { __builtin_amdgcn_s_setprio(1); _Pragma("unroll") for (int m = 0; m < 4; ++m) _Pragma("unroll") for (int n = 0; n < 2; ++n) _Pragma("unroll") for (int k = 0; k < 2; ++k) \
        acc[ai][bj][m][n] = __builtin_amdgcn_mfma_f32_16x16x32_bf16(Bt[n][k], At[m][k], acc[ai][bj][m][n], 0, 0, 0); __builtin_amdgcn_s_setprio(0); } while (0)
#define PG8_WAIT_V(n) asm volatile("s_waitcnt vmcnt(" #n ")" ::: "memory")
#define PG8_WAIT_L(n) asm volatile("s_waitcnt lgkmcnt(" #n ")" ::: "memory")
#define PG8_BAR __builtin_amdgcn_s_barrier()
#define PG8_SCHED __builtin_amdgcn_sched_barrier(0)
    Unit cur, nxt; int ui = 0;
    if (!S.next(0, cur)) return;
    f32x4 acc[2][2][4][2];
#pragma unroll
    for (int a = 0; a < 2; ++a)
#pragma unroll
        for (int b = 0; b < 2; ++b)
#pragma unroll
            for (int m = 0; m < 4; ++m)
#pragma unroll
                for (int n = 0; n < 2; ++n) acc[a][b][m][n] = (f32x4){0.f, 0.f, 0.f, 0.f};
    bf16x8 At[4][2], B0[2][2], B1[2][2];
    const char* cA = (const char*)g.A + (size_t)cur.pm * tstep; const char* cB = (const char*)g.Bt + (size_t)cur.pn * tstep;
    S.a_ready(cur);
    if constexpr (SP2) {
        PG8_STAGE(PG8_SB(0, 0), cB, voffB); PG8_STAGE(PG8_SB(0, 1), cB + hstep, voffB); PG8_STAGE(PG8_SA(0, 0), cA, voffA); PG8_STAGE(PG8_SA(0, 1), cA + hstep, voffA);
        if (wr == 1) PG8_BAR;
        PG8_WAIT_V(2); PG8_BAR;
        PG8_STAGE(PG8_SB(1, 0), cB + kstep, voffB); PG8_STAGE(PG8_SA(1, 0), cA + kstep, voffA); PG8_STAGE(PG8_SB(1, 1), cB + hstep + kstep, voffB);
        PG8_WAIT_V(6); PG8_BAR;
    } else {
        PG8_STAGE(PG8_SB(0, 0), cB, voffB); PG8_STAGE(PG8_SA(0, 0), cA, voffA); PG8_STAGE(PG8_SB(0, 1), cB + hstep, voffB); PG8_STAGE(PG8_SA(0, 1), cA + hstep, voffA);
        if (wr == 1) PG8_BAR;
        PG8_WAIT_V(4); PG8_BAR;
        PG8_STAGE(PG8_SB(1, 0), cB + kstep, voffB); PG8_STAGE(PG8_SA(1, 0), cA + kstep, voffA); PG8_STAGE(PG8_SB(1, 1), cB + hstep + kstep, voffB);
        PG8_WAIT_V(6); PG8_BAR;
    }
    for (;;) {
        const bool has_next = S.next(ui + 1, nxt);
        const char* nA = has_next ? (const char*)g.A + (size_t)nxt.pm * tstep : cA; const char* nB = has_next ? (const char*)g.Bt + (size_t)nxt.pn * tstep : cB;
        for (int t = 0; t < nt; t += 2) {
            const bool last = (t == nt - 2);
            const char* a1 = cA + (size_t)(t + 1) * kstep;
            const char* a2 = last ? nA : cA + (size_t)(t + 2) * kstep; const char* b2 = last ? nB : cB + (size_t)(t + 2) * kstep;
            const char* a3 = a2 + kstep; const char* b3 = b2 + kstep;
            if (last && has_next) S.a_ready(nxt);
            if constexpr (SP2) {
            PG8_LDB(B0, 0, 0); PG8_LDB(B1, 0, 1); PG8_SCHED; PG8_LDA(At, 0, 0); PG8_STAGE(PG8_SA(1, 1), a1 + hstep, voffA);
            PG8_WAIT_V(8); PG8_WAIT_L(0); PG8_BAR; PG8_MMA(0, 0, At, B0); PG8_MMA(0, 1, At, B1); PG8_BAR; PG8_SCHED;
            PG8_LDA(At, 0, 1); PG8_STAGE(PG8_SB(0, 0), b2, voffB); PG8_STAGE(PG8_SB(0, 1), b2 + hstep, voffB); PG8_STAGE(PG8_SA(0, 0), a2, voffA);
            PG8_WAIT_V(8); PG8_WAIT_L(0); PG8_BAR; PG8_MMA(1, 0, At, B0); PG8_MMA(1, 1, At, B1); PG8_BAR; PG8_SCHED;
            PG8_LDB(B0, 1, 0); PG8_LDB(B1, 1, 1); PG8_SCHED; PG8_LDA(At, 1, 0); PG8_STAGE(PG8_SA(0, 1), a2 + hstep, voffA);
            PG8_WAIT_V(8); PG8_WAIT_L(0); PG8_BAR; PG8_MMA(0, 0, At, B0); PG8_MMA(0, 1, At, B1); PG8_BAR; PG8_SCHED;
            PG8_LDA(At, 1, 1); PG8_STAGE(PG8_SB(1, 0), b3, voffB); PG8_STAGE(PG8_SB(1, 1), b3 + hstep, voffB); PG8_STAGE(PG8_SA(1, 0), a3, voffA);
            PG8_WAIT_V(8); PG8_WAIT_L(0); PG8_BAR; PG8_MMA(1, 0, At, B0); PG8_MMA(1, 1, At, B1); PG8_BAR; PG8_SCHED;
            E.khook(acc, cur, t, wr, fr);
            } else {
            PG8_LDB(B0, 0, 0); PG8_SCHED; PG8_LDA(At, 0, 0); PG8_STAGE(PG8_SA(1, 1), a1 + hstep, voffA);
            PG8_WAIT_L(8); PG8_BAR; PG8_WAIT_L(0); PG8_MMA(0, 0, At, B0); PG8_BAR; PG8_SCHED;
            PG8_LDB(B1, 0, 1); PG8_STAGE(PG8_SB(0, 0), b2, voffB);
            PG8_BAR; PG8_WAIT_L(0); PG8_MMA(0, 1, At, B1); PG8_BAR;
            PG8_LDA(At, 0, 1); PG8_STAGE(PG8_SA(0, 0), a2, voffA);
            PG8_BAR; PG8_WAIT_L(0); PG8_MMA(1, 0, At, B0); PG8_BAR; PG8_SCHED;
            PG8_STAGE(PG8_SB(0, 1), b2 + hstep, voffB);
            PG8_WAIT_V(6); PG8_BAR; PG8_MMA(1, 1, At, B1); PG8_BAR;
            PG8_LDB(B0, 1, 0); PG8_SCHED; PG8_LDA(At, 1, 0); PG8_STAGE(PG8_SA(0, 1), a2 + hstep, voffA);
            PG8_WAIT_L(8); PG8_BAR; PG8_WAIT_L(0); PG8_MMA(0, 0, At, B0); PG8_BAR; PG8_SCHED;
            PG8_LDB(B1, 1, 1); PG8_STAGE(PG8_SB(1, 0), b3, voffB);
            PG8_BAR; PG8_WAIT_L(0); PG8_MMA(0, 1, At, B1); PG8_BAR;
            PG8_LDA(At, 1, 1); PG8_STAGE(PG8_SA(1, 0), a3, voffA);
            PG8_BAR; PG8_WAIT_L(0); PG8_MMA(1, 0, At, B0); PG8_BAR; PG8_SCHED;
            PG8_STAGE(PG8_SB(1, 1), b3 + hstep, voffB);
            PG8_WAIT_V(6); PG8_BAR; PG8_MMA(1, 1, At, B1); PG8_BAR;
            }
        }
        if constexpr (ALIGN_EPI) { if (wr == 0) PG8_BAR; }
#if PROBE_ON && !PROBE_SKINNY
        const unsigned pe0_ = (unsigned)__builtin_amdgcn_s_memrealtime();
#endif
        if constexpr (!Epi::AFTER_DRAIN) { E(acc, cur, wr, wc, fr, fq); S.done(cur); }
#if PROBE_ON && !PROBE_SKINNY
        if (threadIdx.x == 0) { *(volatile PG8_LAS unsigned*)(lds + 131072 + 320 + 4 * 18) += (unsigned)__builtin_amdgcn_s_memrealtime() - pe0_; }
#endif
        if (!has_next) break;
        if (!E.keep_acc(cur))
#pragma unroll
        for (int a = 0; a < 2; ++a)
#pragma unroll
            for (int b = 0; b < 2; ++b)
#pragma unroll
                for (int m = 0; m < 4; ++m)
#pragma unroll
                    for (int n = 0; n < 2; ++n) acc[a][b][m][n] = (f32x4){0.f, 0.f, 0.f, 0.f};
        cur = nxt; cA = nA; cB = nB; ++ui;
        if constexpr (ALIGN_EPI) { if (wr == 1) PG8_BAR; }
    }
    PG8_WAIT_V(0);
    if constexpr (!ALIGN_EPI) { if (wr == 0) PG8_BAR; }
    PG8_BAR;
    if constexpr (Epi::AFTER_DRAIN) { E.fused(acc, cur, wr, wc, fr, fq, lds, wid, lane); S.done(cur); }
#undef PG8_SA
#undef PG8_SB
#undef PG8_STAGE
#undef PG8_LDA
#undef PG8_LDB
#undef PG8_MMA
#undef PG8_WAIT_V
#undef PG8_WAIT_L
#undef PG8_BAR
#undef PG8_SCHED
}
}


constexpr int DM = 1024, NB = 8, SEQ = 2048, NDEC = 128, MPROMPT = NB * SEQ, MTOT = MPROMPT + NDEC, MP = 16640  ;
constexpr int HR = 4, DKR = 128, DVR = 256, HG = 8, DKG = 128, DVG = 128, DFF = 4096, DPLE = 256, DIN = 9216, CH = 64, NCHUNK = MPROMPT / CH;
constexpr float EPS = 1e-6f;
constexpr size_t OFF_Y = 0, OFF_RETP = (size_t)MTOT * DM, OFF_HGP = OFF_RETP + (size_t)NB * HR * DKR * DVR, OFF_RETS = OFF_HGP + (size_t)NB * HG * DKG * DVG,
                 OFF_HGS = OFF_RETS + (size_t)NDEC * HR * DKR * DVR, OUT_TOTAL = OFF_HGS + (size_t)NDEC * HG * DKG * DVG;
static_assert(OUT_TOTAL == 52559872, "output size");


constexpr int NWAVES = 8;
constexpr int NPH = 10;
#ifndef MK_ONE_LAUNCH
#define MK_ONE_LAUNCH 1
#endif

constexpr size_t MiB = 1u << 20;
constexpr size_t WS_CTL = 0, CTL_ZERO_BYTES = 32768;
constexpr size_t WS_WIN = 1 * MiB;
constexpr size_t WS_WUPR = WS_WIN + (size_t)DIN * DM * 2;
constexpr size_t WS_WUPH = WS_WUPR + (size_t)DM * DM * 2;
constexpr size_t WS_WO = WS_WUPH + (size_t)DM * DM * 2;
constexpr size_t WS_WFF1 = WS_WO + (size_t)DM * DM * 2;
constexpr size_t WS_WFF2 = WS_WFF1 + (size_t)DFF * DM * 2;
constexpr size_t WS_WGATE = WS_WFF2 + (size_t)DFF * DM * 2;
constexpr size_t WS_WPROJ = WS_WGATE + (size_t)DM * DM * 2;
constexpr size_t WS_Z6 = WS_WPROJ + (size_t)DM * DPLE * 2;
constexpr size_t Z_QR = WS_Z6, Z_KR = Z_QR + (size_t)MP * 512 * 2, Z_VR = Z_KR + (size_t)MP * 512 * 2, Z_QG = Z_VR + (size_t)MP * DM * 2, Z_KG = Z_QG + (size_t)MP * DM * 2,
                 Z_VG = Z_KG + (size_t)MP * DM * 2, Z_END = Z_VG + (size_t)MP * DM * 2;
constexpr size_t WS_H = WS_Z6, WS_MB = WS_Z6 + (size_t)MP * DFF * 2;
static_assert(WS_MB == Z_VG, "MB overlays VG exactly");
constexpr size_t WS_GR = Z_END, WS_GG = WS_GR + (size_t)MP * DM * 2, WS_A5 = WS_GR, WS_A7 = WS_GG;
constexpr size_t WS_PB = WS_GG + (size_t)MP * DM * 2;
constexpr size_t WS_CS = WS_PB + (size_t)MP * DPLE * 2;
constexpr size_t WS_GL = WS_CS + (size_t)2049 * 64 * 8;
constexpr size_t WS_FS = WS_GL + (size_t)NCHUNK * DM * 4;
constexpr size_t WS_RSTD0 = WS_FS + (size_t)NDEC * DM * 4;
constexpr size_t WS_LB = WS_RSTD0 + (size_t)MP * 4;
constexpr size_t WS_PS1 = WS_LB + 4096, WS_PS2 = WS_PS1 + (size_t)MP * 64, WS_PS3 = WS_PS2 + (size_t)MP * 64, WS_PSS1 = WS_PS3 + (size_t)MP * 64, WS_PSS2 = WS_PSS1 + (size_t)NDEC * 256, WS_PSS3 = WS_PSS2 + (size_t)NDEC * 256,
                 WS_PSQR = WS_PSS3 + (size_t)NDEC * 256, WS_PSQG = WS_PSQR + (size_t)MP * 128, WS_END = WS_PSQG + (size_t)MP * 128;
static_assert(WS_END <= 307920896, "d_ws map must fit sum(inputs) bytes");
static_assert(WS_WIN % 256 == 0 && WS_Z6 % 256 == 0 && WS_GR % 256 == 0 && WS_PB % 256 == 0 && WS_CS % 16 == 0 && WS_GL % 16 == 0 && WS_PS1 % 16 == 0, "alignment");
constexpr int CW_TMO = 0, CW_SAMP = 128, CW_BAR = 4096;

constexpr int RING_OFF = 0, RING_BYTES = 131072;
constexpr int LDSCTL_OFF = RING_BYTES, MISC_OFF = LDSCTL_OFF + 320;
constexpr int LDS_BYTES = 147456;
constexpr int RSTD_LDS_OFF = RING_BYTES + 1024;
constexpr int HT_LDS_OFF = RING_BYTES + 1024;


namespace pg8 {
typedef unsigned u32x2 __attribute__((ext_vector_type(2)));
typedef float f32x2 __attribute__((ext_vector_type(2)));
__device__ __forceinline__ float bf2f(unsigned short b) { return __uint_as_float((unsigned)b << 16); }
__device__ __forceinline__ float bflo(unsigned w) { return __uint_as_float(w << 16); }
__device__ __forceinline__ float bfhi(unsigned w) { return __uint_as_float(w & 0xffff0000u); }
__device__ __forceinline__ float sigmoidf_(float x) { return __builtin_amdgcn_rcpf(1.0f + __expf(-x)); }
__device__ __forceinline__ float siluf_(float x) { return x * __builtin_amdgcn_rcpf(1.0f + __expf(-x)); }
__device__ __forceinline__ u32x2 pack4(f32x4 v) { u32x2 w; w.x = cvt_pk_bf16(v[0], v[1]); w.y = cvt_pk_bf16(v[2], v[3]); return w; }
__device__ __forceinline__ f32x4 unpack4(u32x2 w) { return (f32x4){bflo(w.x), bfhi(w.x), bflo(w.y), bfhi(w.y)}; }

typedef unsigned u32x4 __attribute__((ext_vector_type(4)));
#define DPP_ROW_SHR(x, n) __int_as_float(__builtin_amdgcn_update_dpp(0, __float_as_int(x), 0x110 + (n), 0xf, 0xf, true))
#define DPP_ROW_SHR1(x, n) __int_as_float(__builtin_amdgcn_update_dpp(0x3f800000, __float_as_int(x), 0x110 + (n), 0xf, 0xf, false))
#define DPP_ROW_BCAST15(x) __int_as_float(__builtin_amdgcn_update_dpp(0, __float_as_int(x), 0x15F, 0xf, 0xf, false))
struct EpiIn {
    static constexpr bool PERM = true, AFTER_DRAIN = false;
    const float* rstd0; const float* cs; const float* lb;
    bf16_t *QR, *KR, *VR, *GR, *QG, *KG, *VG, *GG, *AR, *AH; float *GL, *FS; unsigned char* wsb; unsigned char* outb;
    __device__ __forceinline__ bool keep_acc(const Unit&) const { return false; }
    __device__ __forceinline__ void khook(f32x4 (&)[2][2][4][2], const Unit&, int, int, int) const {}
    __device__ __forceinline__ void operator()(const f32x4 (&acc)[2][2][4][2], const Unit& u, int wr, int wc, int fr, int fq) const {
        const int pn = u.pn;
#pragma unroll
        for (int ai = 0; ai < 2; ++ai) {
            const int rbase = u.pm * BM + ai * HALF + wr * 64;
            float rs[4];
#pragma unroll
            for (int m = 0; m < 4; ++m) rs[m] = ((const PG8_LAS float*)(unsigned long)RSTD_LDS_OFF)[ai * HALF + wr * 64 + m * 16 + fr];
            if (pn < 4) {
                const bool isk = pn >= 2; bf16_t* dst = isk ? KR : QR;
#pragma unroll
                for (int bj = 0; bj < 2; ++bj) {
                    const int head = 2 * (pn & 1) + bj;
                    const float lg = __logf(1.0f - exp2f(-5.0f - (float)head));
                    const int j0 = 16 * wc + 4 * fq;
#pragma unroll
                    for (int m = 0; m < 4; ++m) {
                        const int row = rbase + m * 16 + fr; const int pidx = row & (SEQ - 1);
                        const float e = lg * (float)(m * 16 + fr + 1);
                        const float sc = rs[m] * (isk ? 0.08838834764831845f * __expf(-e) : __expf(e));
                        const f32x4 t0 = *(const f32x4*)(cs + ((size_t)pidx * 64 + j0) * 2), t1 = *(const f32x4*)(cs + ((size_t)pidx * 64 + j0 + 2) * 2);
                        const f32x4 v0 = acc[ai][bj][m][0] * sc, v1 = acc[ai][bj][m][1] * sc;
                        u32x2 o1, o2;
                        o1.x = cvt_pk_bf16(v0[0] * t0[0] - v0[1] * t0[1], v0[2] * t0[2] - v0[3] * t0[3]); o1.y = cvt_pk_bf16(v1[0] * t1[0] - v1[1] * t1[1], v1[2] * t1[2] - v1[3] * t1[3]);
                        o2.x = cvt_pk_bf16(v0[0] * t0[1] + v0[1] * t0[0], v0[2] * t0[3] + v0[3] * t0[2]); o2.y = cvt_pk_bf16(v1[0] * t1[1] + v1[1] * t1[0], v1[2] * t1[3] + v1[3] * t1[2]);
                        bf16_t* p = dst + (size_t)row * 512 + head * 128 + j0;
                        *(u32x2*)p = o1; *(u32x2*)(p + 64) = o2;
                    }
                }
            } else if (pn >= 12 && pn < 20) {
                const int head = pn - 12;
#pragma unroll
                for (int bj = 0; bj < 2; ++bj) {
                    const int j0 = 64 * bj + 16 * wc + 4 * fq, c = head * 128 + j0;
                    const f32x4 lbv = *(const f32x4*)(lb + c);
                    float qa[4][4], ka[4][4], ba[4][4];
#pragma unroll
                    for (int q = 0; q < 4; ++q) {
                        const int n = q >> 1, e = q & 1; const float one_m_lb = 1.0f - lbv[q]; float carry = 1.f;
#pragma unroll
                        for (int m = 0; m < 4; ++m) {
                            const float vq = acc[ai][bj][m][n][2 * e] * rs[m], vf = acc[ai][bj][m][n][2 * e + 1] * rs[m];
                            const float kk = one_m_lb * __builtin_amdgcn_rcpf(1.0f + __expf(vf));
                            float x = 1.0f - kk;
                            x *= DPP_ROW_SHR1(x, 1); x *= DPP_ROW_SHR1(x, 2); x *= DPP_ROW_SHR1(x, 4); x *= DPP_ROW_SHR1(x, 8);
                            x *= carry; carry = DPP_ROW_BCAST15(x);
                            qa[m][q] = siluf_(vq); ka[m][q] = kk; ba[m][q] = x;
                        }
                    }
#pragma unroll
                    for (int m = 0; m < 4; ++m) {
                        const int row = rbase + m * 16 + fr;
                        const float e0 = ba[m][0], e1 = ba[m][1], e2 = ba[m][2], e3 = ba[m][3];
                        u32x2 qw, kw;
                        qw.x = cvt_pk_bf16(qa[m][0] * e0, qa[m][1] * e1); qw.y = cvt_pk_bf16(qa[m][2] * e2, qa[m][3] * e3);
                        kw.x = cvt_pk_bf16(ka[m][0] * __builtin_amdgcn_rcpf(e0), ka[m][1] * __builtin_amdgcn_rcpf(e1)); kw.y = cvt_pk_bf16(ka[m][2] * __builtin_amdgcn_rcpf(e2), ka[m][3] * __builtin_amdgcn_rcpf(e3));
                        *(u32x2*)(QG + (size_t)row * DM + c) = qw; *(u32x2*)(KG + (size_t)row * DM + c) = kw;
                        if (m == 3 && fr == 15) *(f32x4*)(GL + (size_t)(row >> 6) * DM + c) = (f32x4){e0, e1, e2, e3};
                    }
                }
            } else if (pn >= 28) {
#pragma unroll
                for (int bj = 0; bj < 2; ++bj) {
                    const int c = (pn - 28) * 128 + 64 * bj + 16 * wc + 4 * fq;
#pragma unroll
                    for (int m = 0; m < 4; ++m) {
                        const int row = rbase + m * 16 + fr; float sr[4], rho[4];
#pragma unroll
                        for (int q = 0; q < 4; ++q) { const int n = q >> 1, e = q & 1;
                            const float er = 1.0f + __expf(fminf(-acc[ai][bj][m][n][2 * e] * rs[m], 40.f)), eg = 1.0f + __expf(fminf(-acc[ai][bj][m][n][2 * e + 1] * rs[m], 40.f));
                            sr[q] = __builtin_amdgcn_rcpf(er); rho[q] = er * __builtin_amdgcn_rcpf(eg); }
                        u32x2 a, h; a.x = cvt_pk_bf16(sr[0], sr[1]); a.y = cvt_pk_bf16(sr[2], sr[3]); h.x = cvt_pk_bf16(rho[0], rho[1]); h.y = cvt_pk_bf16(rho[2], rho[3]);
                        *(u32x2*)(AR + (size_t)row * DM + c) = a; *(u32x2*)(AH + (size_t)row * DM + c) = h;
                    }
                }
            } else {
                const int mode = 0, cbase = (pn & 3) * BM;
                const size_t boff = pn < 8 ? Z_VR : pn < 12 ? WS_GR : pn < 24 ? Z_VG : WS_GG;
                bf16_t* dst = (bf16_t*)(wsb + boff);
#pragma unroll
                for (int m = 0; m < 4; ++m) {
                    const int row = rbase + m * 16 + fr;
#pragma unroll
                    for (int bj = 0; bj < 2; ++bj) {
                        f32x4 v0 = acc[ai][bj][m][0] * rs[m], v1 = acc[ai][bj][m][1] * rs[m];
                        if (mode == 1) { v0[0] = siluf_(v0[0]); v0[1] = siluf_(v0[1]); v0[2] = siluf_(v0[2]); v0[3] = siluf_(v0[3]); v1[0] = siluf_(v1[0]); v1[1] = siluf_(v1[1]); v1[2] = siluf_(v1[2]); v1[3] = siluf_(v1[3]); }
                        else if (mode == 2) { v0[0] = sigmoidf_(v0[0]); v0[1] = sigmoidf_(v0[1]); v0[2] = sigmoidf_(v0[2]); v0[3] = sigmoidf_(v0[3]); v1[0] = sigmoidf_(v1[0]); v1[1] = sigmoidf_(v1[1]); v1[2] = sigmoidf_(v1[2]); v1[3] = sigmoidf_(v1[3]); }
                        const u32x2 a = pack4(v0), b = pack4(v1);
                        *(u32x4*)(dst + (size_t)row * DM + cbase + bj * HALF + wc * 32 + fq * 8) = (u32x4){a.x, a.y, b.x, b.y};
                    }
                }
            }
        }
    }
};

__device__ __forceinline__ void unpack8(u32x4 w, f32x4& a, f32x4& b) { a = (f32x4){bflo(w.x), bfhi(w.x), bflo(w.y), bfhi(w.y)}; b = (f32x4){bflo(w.z), bfhi(w.z), bflo(w.w), bfhi(w.w)}; }
__device__ __forceinline__ u32x4 pack8(f32x4 a, f32x4 b) { const u32x2 x = pack4(a), y = pack4(b); return (u32x4){x.x, x.y, y.x, y.y}; }
__device__ __forceinline__ float sumsq4(f32x4 r) { return (r[0] * r[0] + r[1] * r[1]) + (r[2] * r[2] + r[3] * r[3]); }
template <int MODE> struct EpiN {
    static constexpr bool PERM = true, AFTER_DRAIN = false;
    const bf16_t* gate; bf16_t* out16; int ld16; const float* xp; const float* xs; float* R; const float* g; float* PS; const float* PSin;
    int use_rl;
    __device__ __forceinline__ bool keep_acc(const Unit&) const { return false; }
    __device__ __forceinline__ void khook(f32x4 (&)[2][2][4][2], const Unit&, int, int, int) const {}
    __device__ __forceinline__ void operator()(const f32x4 (&acc)[2][2][4][2], const Unit& u, int wr, int wc, int fr, int fq) const {
#pragma unroll
        for (int ai = 0; ai < 2; ++ai) {
            const int rbase = u.pm * BM + ai * HALF + wr * 64;
#pragma unroll
            for (int m = 0; m < 4; ++m) {
                const int row = rbase + m * 16 + fr;
                float rstd = 1.f;
                if ((MODE == 3 || MODE == 4) && use_rl) rstd = ((const PG8_LAS float*)(unsigned long)RSTD_LDS_OFF)[ai * HALF + wr * 64 + m * 16 + fr];
                else if (MODE == 3 || MODE == 4) {
                    const f32x4* p = (const f32x4*)(PSin + (size_t)row * 16); const f32x4 a = p[0], b = p[1], c = p[2], d = p[3];
                    const float s = ((a[0] + a[1]) + (a[2] + a[3])) + ((b[0] + b[1]) + (b[2] + b[3])) + ((c[0] + c[1]) + (c[2] + c[3])) + ((d[0] + d[1]) + (d[2] + d[3]));
                    rstd = rsqrtf(s * (1.0f / 1024.0f) + EPS);
                }
                float ss = 0.f;
#pragma unroll
                for (int bj = 0; bj < 2; ++bj) {
                    const int col = u.pn * BM + bj * HALF + wc * 32 + fq * 8;
                    const f32x4 a0 = acc[ai][bj][m][0], a1 = acc[ai][bj][m][1];
                    if (MODE == 0) { f32x4 g0, g1; unpack8(*(const u32x4*)(gate + (size_t)row * DM + col), g0, g1); *(u32x4*)(out16 + (size_t)row * ld16 + col) = pack8(g0 * a0, g1 * a1); }
                    else if (MODE == 1) { f32x4 g0, g1, t0, t1; unpack8(*(const u32x4*)(gate + (size_t)row * DM + col), g0, g1); u32x4* o = (u32x4*)(out16 + (size_t)row * ld16 + col); unpack8(*o, t0, t1); *o = pack8(g0 * (t0 + a0), g1 * (t1 + a1)); }
                    else if (MODE == 2) {
                        const float* bp = xp + (size_t)row * DM + col;
                        const f32x4 r0 = __builtin_nontemporal_load((const f32x4*)bp) + a0, r1 = __builtin_nontemporal_load((const f32x4*)(bp + 4)) + a1;
                        ss += sumsq4(r0) + sumsq4(r1);
                        *(u32x4*)(out16 + (size_t)row * ld16 + col) = pack8(r0, r1);
                    }
                    else if (MODE == 6) {
                        f32x4 b0, b1; unpack8(*(const u32x4*)(gate + (size_t)row * DM + col), b0, b1);
                        const f32x4 r0 = b0 + a0, r1 = b1 + a1;
                        ss += sumsq4(r0) + sumsq4(r1);
                        *(u32x4*)(out16 + (size_t)row * ld16 + col) = pack8(r0, r1);
                    }
                    else if (MODE == 3) { f32x4 v0 = a0 * rstd, v1 = a1 * rstd;
                        v0[0] = fmaxf(v0[0], 0.f); v0[1] = fmaxf(v0[1], 0.f); v0[2] = fmaxf(v0[2], 0.f); v0[3] = fmaxf(v0[3], 0.f); v1[0] = fmaxf(v1[0], 0.f); v1[1] = fmaxf(v1[1], 0.f); v1[2] = fmaxf(v1[2], 0.f); v1[3] = fmaxf(v1[3], 0.f);
                        *(u32x4*)(out16 + (size_t)row * ld16 + col) = pack8(v0 * v0, v1 * v1); }
                    else if (MODE == 4) { f32x4 v0 = a0 * rstd, v1 = a1 * rstd;
                        v0[0] = sigmoidf_(v0[0]); v0[1] = sigmoidf_(v0[1]); v0[2] = sigmoidf_(v0[2]); v0[3] = sigmoidf_(v0[3]); v1[0] = sigmoidf_(v1[0]); v1[1] = sigmoidf_(v1[1]); v1[2] = sigmoidf_(v1[2]); v1[3] = sigmoidf_(v1[3]);
                        *(u32x4*)(out16 + (size_t)row * ld16 + col) = pack8(v0, v1); }
                    else if (MODE == 5) { f32x4 t0, t1, b0, b1; unpack8(*(const u32x4*)(out16 + (size_t)row * ld16 + col), t0, t1); unpack8(*(const u32x4*)(gate + (size_t)row * DM + col), b0, b1);
                        const f32x4 r0 = b0 + t0 * a0, r1 = b1 + t1 * a1; *(u32x4*)((bf16_t*)R + (size_t)row * DM + col) = pack8(r0, r1); ss += sumsq4(r0) + sumsq4(r1); }
                }
                if (MODE == 2 || MODE == 5 || MODE == 6) { ss += __shfl_xor(ss, 16); ss += __shfl_xor(ss, 32); if (fq == 0) PS[(size_t)row * 16 + u.pn * 4 + wc] = ss; }
            }
        }
    }
};

__device__ __forceinline__ void samp_in(const EpiIn& E, int row, int pcol, f32x4 v) {
    const float rs = E.rstd0[row]; const int pn = __builtin_amdgcn_readfirstlane(pcol >> 8), p = pcol & 255;
    if (pn < 4) {
        const bool isk = pn >= 2; bf16_t* dst = isk ? E.KR : E.QR; const int head = 2 * (pn & 1) + (p >> 7), j = (p & 127) >> 1;
        const f32x4 t = *(const f32x4*)(E.cs + ((size_t)SEQ * 64 + j) * 2);
        v = v * (rs * (isk ? 0.08838834764831845f : 1.0f));
        const float o1a = v[0] * t[0] - v[1] * t[1], o2a = v[0] * t[1] + v[1] * t[0], o1b = v[2] * t[2] - v[3] * t[3], o2b = v[2] * t[3] + v[3] * t[2];
        bf16_t* q = dst + (size_t)row * 512 + head * 128 + j;
        *(unsigned*)q = cvt_pk_bf16(o1a, o1b); *(unsigned*)(q + 64) = cvt_pk_bf16(o2a, o2b);
    } else if (pn >= 12 && pn < 20) {
        const int c = (pn - 12) * 128 + (p >> 1);
        const float k0 = (1.0f - E.lb[c]) * __builtin_amdgcn_rcpf(1.0f + __expf(v[1] * rs)), k1 = (1.0f - E.lb[c + 1]) * __builtin_amdgcn_rcpf(1.0f + __expf(v[3] * rs));
        *(unsigned*)(E.QG + (size_t)row * DM + c) = cvt_pk_bf16(siluf_(v[0] * rs), siluf_(v[2] * rs));
        *(unsigned*)(E.KG + (size_t)row * DM + c) = cvt_pk_bf16(k0, k1);
        *(f32x2*)(E.FS + (size_t)(row - MPROMPT) * DM + c) = (f32x2){1.0f - k0, 1.0f - k1};
    } else if (pn >= 28) {
        const int c = (pn - 28) * 128 + (p >> 1);
        const float er0 = 1.0f + __expf(fminf(-v[0] * rs, 40.f)), eg0 = 1.0f + __expf(fminf(-v[1] * rs, 40.f)), er1 = 1.0f + __expf(fminf(-v[2] * rs, 40.f)), eg1 = 1.0f + __expf(fminf(-v[3] * rs, 40.f));
        *(unsigned*)(E.AR + (size_t)row * DM + c) = cvt_pk_bf16(__builtin_amdgcn_rcpf(er0), __builtin_amdgcn_rcpf(er1));
        *(unsigned*)(E.AH + (size_t)row * DM + c) = cvt_pk_bf16(er0 * __builtin_amdgcn_rcpf(eg0), er1 * __builtin_amdgcn_rcpf(eg1));
    } else {
        v = v * rs;
        const size_t boff = pn < 8 ? Z_VR : pn < 12 ? WS_GR : pn < 24 ? Z_VG : WS_GG;
        bf16_t* dst = (bf16_t*)(E.wsb + boff);
        *(u32x2*)(dst + (size_t)row * DM + (pn & 3) * BM + p) = pack4(v);
    }
}
template <int MODE> __device__ __forceinline__ float samp_rstd(const float* PSSin, int row) {
    if (MODE != 3 && MODE != 4) return 1.f;
    const f32x4* p = (const f32x4*)(PSSin + (size_t)(row - MPROMPT) * 64); float s = 0.f;
#pragma unroll
    for (int i = 0; i < 16; ++i) { const f32x4 q = p[i]; s += (q[0] + q[1]) + (q[2] + q[3]); }
    return rsqrtf(s * (1.0f / 1024.0f) + EPS);
}
template <int MODE> __device__ __forceinline__ void samp_n(const EpiN<MODE>& E, const float* xs, float* PSS, const float* PSSin, int row, int col, f32x4 a, float rstd) {
    const int rs_ = row - MPROMPT;
    float ss = 0.f;
    if (MODE == 0) { const f32x4 gt = unpack4(*(const u32x2*)(E.gate + (size_t)row * DM + col)); *(u32x2*)(E.out16 + (size_t)row * E.ld16 + col) = pack4(gt * a); }
    else if (MODE == 1) { const f32x4 gt = unpack4(*(const u32x2*)(E.gate + (size_t)row * DM + col)); u32x2* o = (u32x2*)(E.out16 + (size_t)row * E.ld16 + col); const f32x4 t = unpack4(*o); *o = pack4(gt * (t + a)); }
    else if (MODE == 2) { const f32x4 r = *(const f32x4*)(xs + (size_t)rs_ * DM + col) + a; ss = sumsq4(r); *(u32x2*)(E.out16 + (size_t)row * E.ld16 + col) = pack4(r); }
    else if (MODE == 6) { const f32x4 r = unpack4(*(const u32x2*)(E.gate + (size_t)row * DM + col)) + a; ss = sumsq4(r); *(u32x2*)(E.out16 + (size_t)row * E.ld16 + col) = pack4(r); }
    else if (MODE == 3) { f32x4 v = a * rstd; v[0] = fmaxf(v[0], 0.f); v[1] = fmaxf(v[1], 0.f); v[2] = fmaxf(v[2], 0.f); v[3] = fmaxf(v[3], 0.f); *(u32x2*)(E.out16 + (size_t)row * E.ld16 + col) = pack4(v * v); }
    else if (MODE == 4) { f32x4 v = a * rstd; v[0] = sigmoidf_(v[0]); v[1] = sigmoidf_(v[1]); v[2] = sigmoidf_(v[2]); v[3] = sigmoidf_(v[3]); *(u32x2*)(E.out16 + (size_t)row * E.ld16 + col) = pack4(v); }
    else if (MODE == 5) { const f32x4 t = unpack4(*(const u32x2*)(E.out16 + (size_t)row * E.ld16 + col)), b = unpack4(*(const u32x2*)(E.gate + (size_t)row * DM + col));
        const f32x4 r = b + t * a; *(u32x2*)((bf16_t*)E.R + (size_t)row * DM + col) = pack4(r); ss = sumsq4(r); }
    if (MODE == 2 || MODE == 5 || MODE == 6) { ss += __shfl_xor(ss, 16); ss += __shfl_xor(ss, 32); if ((threadIdx.x & 63) < 16) PSS[(size_t)rs_ * 64 + (col >> 4)] = ss; }
}
}

#define GAS __attribute__((address_space(1)))
#define LAS __attribute__((address_space(3)))
typedef unsigned short bf16;
typedef unsigned v4u __attribute__((ext_vector_type(4)));
typedef float f32x4 __attribute__((ext_vector_type(4)));
typedef short bf16x8 __attribute__((ext_vector_type(8)));
typedef GAS unsigned gu32;
typedef GAS unsigned long long gu64;
#define RLX_AGENT __ATOMIC_RELAXED, __HIP_MEMORY_SCOPE_AGENT
#define LDS_WAIT() asm volatile("s_waitcnt lgkmcnt(0)" ::: "memory")
#define VM_WAIT() asm volatile("s_waitcnt vmcnt(0)" ::: "memory")
__device__ __forceinline__ unsigned long long rt() { return __builtin_amdgcn_s_memrealtime(); }
__device__ __forceinline__ unsigned f2bf(float f) { unsigned u = __builtin_bit_cast(unsigned, f); return (u + 0x7fffu + ((u >> 16) & 1u)) >> 16; }
__device__ __forceinline__ unsigned pk2(float lo, float hi) { return f2bf(lo) | (f2bf(hi) << 16); }

#define XB_TMO      128
#define XB_XCNT(j)  (256  + 64 * (j))
#define XB_XSUB(j)  (1280 + 64 * (j))
#define XB_XGEN(j)  (2304 + 64 * (j))
#define XB_TOP      3328
#define XB_TOPGEN   3392
#define XCD_BAR_WORDS 3456
#define XB_SPIN_CAP (1u << 18)

__device__ __forceinline__ unsigned xb_ld(unsigned* p)              { return __hip_atomic_load(p, __ATOMIC_RELAXED, __HIP_MEMORY_SCOPE_AGENT); }
__device__ __forceinline__ unsigned xb_add(unsigned* p, unsigned v) { return __hip_atomic_fetch_add(p, v, __ATOMIC_RELAXED, __HIP_MEMORY_SCOPE_AGENT); }
__device__ __forceinline__ unsigned xb_xcc_id() { return (unsigned)__builtin_amdgcn_s_getreg((3 << 11) | 20) & 0xFu; }
#define XB_SPIN(cond, bar) do { unsigned _sp = 0; while (cond) { __builtin_amdgcn_s_sleep(1); \
    if ((++_sp & 255u) == 0u) { if (xb_ld(&(bar)[XB_TMO])) break; if (_sp > XB_SPIN_CAP) { atomicAdd(&(bar)[XB_TMO], 1u); break; } } } } while (0)

struct XcdBarrier {
    unsigned* bar; unsigned x;
    volatile LAS unsigned* st;
};

__device__ __forceinline__ XcdBarrier xcd_barrier_post(unsigned* bar, volatile LAS unsigned* st) {
    XcdBarrier b; b.bar = bar; b.x = xb_xcc_id(); b.st = st;
    if (threadIdx.x == 0) (void)xb_add(&bar[XB_XCNT(b.x)], 1u);
    return b;
}
__device__ __forceinline__ void xcd_barrier_complete(unsigned* bar, unsigned x, unsigned& nloc, unsigned& nx) {
    const unsigned G = gridDim.x * gridDim.y * gridDim.z;
    unsigned sum, cnt, mine, sp = 0u;
    for (;;) {
        sum = 0u; cnt = 0u; mine = 0u;
#pragma unroll
        for (unsigned j = 0; j < 16; ++j) { const unsigned c = xb_ld(&bar[XB_XCNT(j)]); sum += c; cnt += (c > 0u) ? 1u : 0u; mine = (j == x) ? c : mine; }
        if (sum == G) break;
        __builtin_amdgcn_s_sleep(1);
        if ((++sp & 255u) == 0u) { if (xb_ld(&bar[XB_TMO])) break; if (sp > XB_SPIN_CAP) { atomicAdd(&bar[XB_TMO], 1u); break; } }
    }
    nloc = mine > 0u ? mine : 1u; nx = cnt > 0u ? cnt : 1u;
}

__device__ __forceinline__ void xcd_barrier(const XcdBarrier& b) {
    asm volatile("s_waitcnt vmcnt(0)" ::: "memory");
    __syncthreads();
    if (threadIdx.x == 0) {
        unsigned* bar = b.bar;
        __builtin_amdgcn_s_waitcnt(0);
        unsigned nloc = b.st[0], nx = b.st[1];
        if (nloc == 0u) { xcd_barrier_complete(bar, b.x, nloc, nx); b.st[0] = nloc; b.st[1] = nx; }
        const unsigned old = xb_add(&bar[XB_XSUB(b.x)], 1u);
        const unsigned gen = old / nloc;
        if (old + 1u == (gen + 1u) * nloc) {
            __builtin_amdgcn_fence(__ATOMIC_RELEASE, "agent");
            asm volatile("s_waitcnt vmcnt(0)" ::: "memory");
            const unsigned og = xb_add(&bar[XB_TOP], 1u);
            const unsigned tg = og / nx;
            if (og + 1u == (tg + 1u) * nx) xb_add(&bar[XB_TOPGEN], 1u);
            else XB_SPIN(xb_ld(&bar[XB_TOPGEN]) == tg, bar);
            __builtin_amdgcn_fence(__ATOMIC_ACQUIRE, "agent");
            xb_add(&bar[XB_XGEN(b.x)], 1u);
            asm volatile("s_waitcnt vmcnt(0)" ::: "memory");
        } else {
            XB_SPIN(xb_ld(&bar[XB_XGEN(b.x)]) == gen, bar);
            __builtin_amdgcn_fence(__ATOMIC_ACQUIRE, "agent");
            asm volatile("s_waitcnt vmcnt(0)" ::: "memory");
        }
    }
    __syncthreads();
}


static_assert((CW_BAR + XCD_BAR_WORDS) * 4 <= (int)CTL_ZERO_BYTES, "the per-call memset must cover every barrier word");
struct Args { const float* in[21]; float* out; unsigned char* ws; int ph_lo, ph_hi, use_bar, pad; };
struct Frame {
    LAS unsigned char* lds; volatile LAS unsigned* MISC; gu32* ctl;
    int vcu, G;
};
__device__ __forceinline__ int tid_() { int t = threadIdx.x; asm volatile("" : "+v"(t)); return t; }
#define FTID (tid_())
#define FLANE (tid_() & 63)
#define FWAVE (__builtin_amdgcn_readfirstlane(tid_() >> 6))
__device__ __forceinline__ float wave_sum(float v) {
#pragma unroll
    for (int o = 1; o < 64; o <<= 1) v += __shfl_xor(v, o);
    return v;
}
#define LBAR() do { asm volatile("s_waitcnt lgkmcnt(0)" ::: "memory"); __builtin_amdgcn_s_barrier(); asm volatile("" ::: "memory"); } while (0)
__device__ __forceinline__ float bf2f_(unsigned short b) { return __uint_as_float((unsigned)b << 16); }
__device__ __forceinline__ float bflo_(unsigned w) { return __uint_as_float(w << 16); }
__device__ __forceinline__ float bfhi_(unsigned w) { return __uint_as_float(w & 0xffff0000u); }

__device__ __forceinline__ int win_src_col(int np) {
    const int tile = np >> 8, p = np & 255;
    if (tile < 4) { const int base = (tile >> 1) * 512, head = 2 * (tile & 1) + (p >> 7), pp = p & 127; return base + head * 128 + (pp & 1) * 64 + (pp >> 1); }
    if (tile >= 12 && tile < 20) { const int h = tile - 12; return 3072 + (p & 1) * 1024 + h * 128 + (p >> 1); }
    if (tile >= 28) { const int t = tile - 28; return 7168 + (p & 1) * 1024 + t * 128 + (p >> 1); }
    return np;
}
template <bool MAP> __device__ __forceinline__ void p0_transpose_item(const float* W, int K, int N, bf16* WT, LAS float* scr, int item, int lane, const float* gk = nullptr) {
    const int nblk = N / 32, kb = item / nblk, nb = item % nblk, k0 = 64 * kb, n0 = 32 * nb;
    const int srcc = MAP ? win_src_col(n0 + (lane & 31)) : n0 + (lane & 31);
    float wv[32];
#pragma unroll
    for (int i = 0; i < 32; ++i) wv[i] = __builtin_nontemporal_load(W + (size_t)(k0 + 2 * i + (lane >> 5)) * N + srcc);
#pragma unroll
    for (int i = 0; i < 32; ++i) scr[(2 * i + (lane >> 5)) * 33 + (lane & 31)] = wv[i];
    LDS_WAIT(); asm volatile("" ::: "memory");
    const int c = lane & 7;
    f32x4 ga = (f32x4){1.f, 1.f, 1.f, 1.f}, gb = ga;
    if (gk) { ga = *(const f32x4*)(gk + k0 + 8 * c); gb = *(const f32x4*)(gk + k0 + 8 * c + 4); }
#pragma unroll
    for (int j = 0; j < 4; ++j) { const int n = (lane >> 3) + 8 * j; const LAS float* s = scr + (8 * c) * 33 + n;
        v4u o; o.x = pk2(s[0 * 33] * ga.x, s[1 * 33] * ga.y); o.y = pk2(s[2 * 33] * ga.z, s[3 * 33] * ga.w); o.z = pk2(s[4 * 33] * gb.x, s[5 * 33] * gb.y); o.w = pk2(s[6 * 33] * gb.z, s[7 * 33] * gb.w);
        *(GAS v4u*)(WT + (size_t)(n0 + n) * K + k0 + 8 * c) = o; }
    LDS_WAIT(); asm volatile("" ::: "memory");
}
template <int PART> __device__ __forceinline__ void p0_prologue(Frame& F, const Args& a) {     const int tid_v = tid_(); const int lane_v = tid_v & 63; const int wave_v = __builtin_amdgcn_readfirstlane(tid_v >> 6); (void)lane_v; (void)wave_v;
    unsigned char* ws = a.ws;
    LAS float* scr = (LAS float*)(F.lds + RING_OFF + wave_v * 16384);
    const int gw = F.vcu * NWAVES + wave_v, NGW = F.G * NWAVES;
    constexpr int I_IN = (DM / 64) * (DIN / 32), I_SQ = (DM / 64) * (DM / 32), I_F1 = (DM / 64) * (DFF / 32), I_F2 = (DFF / 64) * (DM / 32), I_PJ = (DPLE / 64) * (DM / 32);
    constexpr int NITEMS = I_IN + 4 * I_SQ + I_F1 + I_F2 + I_PJ;
    for (int it = (PART == 0 ? 0 : I_IN) + gw; it < (PART == 0 ? I_IN : NITEMS); it += NGW) {
        int r = it;
        if (r < I_IN) { p0_transpose_item<true>(a.in[7], DM, DIN, (bf16*)(ws + WS_WIN), scr, r, lane_v, a.in[6]); continue; } r -= I_IN;
        if (r < I_SQ) { p0_transpose_item<false>(a.in[11], DM, DM, (bf16*)(ws + WS_WUPR), scr, r, lane_v); continue; } r -= I_SQ;
        if (r < I_SQ) { p0_transpose_item<false>(a.in[12], DM, DM, (bf16*)(ws + WS_WUPH), scr, r, lane_v); continue; } r -= I_SQ;
        if (r < I_SQ) { p0_transpose_item<false>(a.in[13], DM, DM, (bf16*)(ws + WS_WO), scr, r, lane_v); continue; } r -= I_SQ;
        if (r < I_SQ) { p0_transpose_item<false>(a.in[18], DM, DM, (bf16*)(ws + WS_WGATE), scr, r, lane_v, a.in[17]); continue; } r -= I_SQ;
        if (r < I_F1) { p0_transpose_item<false>(a.in[15], DM, DFF, (bf16*)(ws + WS_WFF1), scr, r, lane_v, a.in[14]); continue; } r -= I_F1;
        if (r < I_F2) { p0_transpose_item<false>(a.in[16], DFF, DM, (bf16*)(ws + WS_WFF2), scr, r, lane_v); continue; } r -= I_F2;
        p0_transpose_item<false>(a.in[19], DPLE, DM, (bf16*)(ws + WS_WPROJ), scr, r, lane_v);
    }
    if (PART == 0) {
    bf16* XB = (bf16*)(a.out + OFF_RETS); float* RSTD0 = (float*)(ws + WS_RSTD0);
    for (int m0 = gw; m0 < MP; m0 += 2 * NGW) {
        f32x4 v[2][4]; bool ok[2], real[2];
#pragma unroll
        for (int u = 0; u < 2; ++u) {
            const int m = m0 + u * NGW; ok[u] = m < MP; real[u] = m < MTOT; const int mc = real[u] ? m : 0;
            const float* xrow = mc < MPROMPT ? a.in[0] + (size_t)mc * DM : a.in[1] + (size_t)(mc - MPROMPT) * DM;
            const GAS f32x4* xr = (const GAS f32x4*)xrow + lane_v;
#pragma unroll
            for (int j = 0; j < 4; ++j) v[u][j] = __builtin_nontemporal_load((const f32x4*)xr + 64 * j);
        }
#pragma unroll
        for (int u = 0; u < 2; ++u) {
            const int m = m0 + u * NGW; if (!ok[u]) continue;
            GAS unsigned long long* o8 = (GAS unsigned long long*)(XB + (size_t)m * DM) + lane_v;
            if (!real[u]) {
#pragma unroll
                for (int j = 0; j < 4; ++j) o8[64 * j] = 0ull;
                if (lane_v == 0) RSTD0[m] = 0.f; continue;
            }
            float s = 0.f;
#pragma unroll
            for (int j = 0; j < 4; ++j) s += (v[u][j].x * v[u][j].x + v[u][j].y * v[u][j].y) + (v[u][j].z * v[u][j].z + v[u][j].w * v[u][j].w);
            s = wave_sum(s);
            if (lane_v == 0) RSTD0[m] = rsqrtf(s * (1.0f / DM) + EPS);
#pragma unroll
            for (int j = 0; j < 4; ++j) o8[64 * j] = (unsigned long long)pk2(v[u][j].x, v[u][j].y) | ((unsigned long long)pk2(v[u][j].z, v[u][j].w) << 32);
        }
    }
    float* CS = (float*)(ws + WS_CS); float* LB = (float*)(ws + WS_LB);
    const int gt = (F.vcu * NWAVES + wave_v) * 64 + lane_v, NGT = NGW * 64;
    for (int i = gt; i < 2049 * 64; i += NGT) {
        const int pi = i >> 6, j = i & 63; const double pos = pi == SEQ ? 16384.0 : (double)pi;
        const double ang = pos * pow(10000.0, -(double)j / 64.0);
        CS[2 * i] = (float)cos(ang); CS[2 * i + 1] = (float)sin(ang);
    }
    for (int i = gt; i < DM; i += NGT) { const float a0 = a.in[10][i], a1 = a.in[10][DM + i]; LB[i] = 1.0f / (1.0f + expf(a1 - a0)); }
    }
}

typedef float f32x16 __attribute__((ext_vector_type(16)));
typedef short v4i16_t __attribute__((ext_vector_type(4)));
typedef unsigned u32x2 __attribute__((ext_vector_type(2)));
typedef float f32x2_t __attribute__((ext_vector_type(2))); typedef __bf16 bf16x2_t __attribute__((ext_vector_type(2)));
__device__ __forceinline__ unsigned cvtpk_s(float lo, float hi) { f32x2_t v = {lo, hi}; bf16x2_t b = __builtin_convertvector(v, bf16x2_t); return __builtin_bit_cast(unsigned, b); }
__device__ __forceinline__ unsigned off_b(unsigned row, unsigned ch) { return 256u * row + 16u * (ch ^ (((row & 3) << 2) | ((row >> 2) & 3))); }
__device__ __forceinline__ bf16x8 rd_row(LAS unsigned char* img, unsigned row, unsigned ks, unsigned h) { return *(const LAS bf16x8*)(img + off_b(row, 2 * ks + h)); }
__device__ __forceinline__ bf16x8 rd_tr(LAS unsigned char* img, unsigned lane, unsigned c, unsigned ks) {
    const unsigned h = lane >> 5, blk = (lane >> 4) & 1, q = (lane & 15) >> 2, p = lane & 3;
    const unsigned a0 = off_b(16 * ks + 8 * h + q, 4 * c + 2 * blk + (p >> 1)) + 8 * (p & 1);
    const unsigned a1 = off_b(16 * ks + 8 * h + 4 + q, 4 * c + 2 * blk + (p >> 1)) + 8 * (p & 1);
    const v4i16_t lo = __builtin_amdgcn_ds_read_tr16_b64_v4i16((LAS v4i16_t*)(img + a0));
    const v4i16_t hi = __builtin_amdgcn_ds_read_tr16_b64_v4i16((LAS v4i16_t*)(img + a1));
    return __builtin_shufflevector(lo, hi, 0, 1, 2, 3, 4, 5, 6, 7);
}
#define MFMA32(a, b, c) __builtin_amdgcn_mfma_f32_32x32x16_bf16((a), (b), (c), 0, 0, 0)
__device__ __forceinline__ void scan_item(Frame& F, const Args& a, int item) { const int tid_v = tid_(); const int lane_v = tid_v & 63; const int wave_v = __builtin_amdgcn_readfirstlane(tid_v >> 6); (void)lane_v; (void)wave_v;
    unsigned char* ws = a.ws;
    asm volatile("" : "+s"(item));
    const bool isg = item >= 128; const int it = isg ? item - 128 : item;
    int b, hd, dv0, ldq; const bf16 *Qp, *Kp; bf16* Vp; float* Sout; const float* GLp = nullptr; float sdec = 1.f;
    if (!isg) { b = it >> 4; hd = (it >> 2) & 3; dv0 = (it & 3) * 64; ldq = 512;
        Qp = (const bf16*)(ws + Z_QR) + hd * 128; Kp = (const bf16*)(ws + Z_KR) + hd * 128; Vp = (bf16*)(ws + Z_VR) + hd * 256 + dv0;
        Sout = a.out + OFF_RETP + ((size_t)(b * HR + hd) * DKR) * DVR + dv0; sdec = __expf(64.0f * __logf(1.0f - exp2f(-5.0f - (float)hd))); }
    else { b = it >> 4; hd = (it >> 1) & 7; dv0 = (it & 1) * 64; ldq = 1024;
        Qp = (const bf16*)(ws + Z_QG) + hd * 128; Kp = (const bf16*)(ws + Z_KG) + hd * 128; Vp = (bf16*)(ws + Z_VG) + hd * 128 + dv0;
        Sout = a.out + OFF_HGP + ((size_t)(b * HG + hd) * DKG) * DVG + dv0; GLp = (const float*)(ws + WS_GL) + hd * 128; }
#if PROBE_ON && PROBE_SKINNY == 2
    const unsigned pt0_ = (unsigned)rt();
#endif
    const int ldo = isg ? DVG : DVR;
    bf16* Gp = (bf16*)(ws + (isg ? WS_GG : WS_GR)) + hd * ldo + dv0;
    float* PSQp = (float*)(ws + (isg ? WS_PSQG : WS_PSQR)) + (isg ? 4 * hd + 2 * (it & 1) : 8 * hd + 2 * (it & 3));
    LAS unsigned char* QI = F.lds; LAS unsigned char* KI = QI + 16384; LAS unsigned char* VI = KI + 16384; LAS unsigned char* PI = VI + 16384; LAS unsigned char* SI = PI + 16384;
    LAS unsigned char* OI = SI + 16384;
    const int tid = tid_v, lane = lane_v, w = wave_v; const unsigned r = lane & 31, h = lane >> 5;
    const int kb = w >> 1, dvb = w & 1;
    for (int i = tid; i < 16384 / 4; i += 512) ((LAS unsigned*)SI)[i] = 0u;
    f32x16 S;
#pragma unroll
    for (int i = 0; i < 16; ++i) S[i] = 0.f;
    const int qr0 = tid >> 4, qc0 = tid & 15, vr0 = tid >> 3, vc0 = tid & 7;
    const size_t rowb = (size_t)b * SEQ;
    v4u aq0, aq1, ak0, ak1, av, agt, ghold;
#define SCAN_LOAD(c, Q0, Q1, K0, K1, V, GT) do { const size_t r0_ = rowb + (size_t)(c) * CH; \
        Q0 = *(const v4u*)(Qp + (r0_ + qr0) * ldq + qc0 * 8); Q1 = *(const v4u*)(Qp + (r0_ + qr0 + 32) * ldq + qc0 * 8); \
        K0 = *(const v4u*)(Kp + (r0_ + qr0) * ldq + qc0 * 8); K1 = *(const v4u*)(Kp + (r0_ + qr0 + 32) * ldq + qc0 * 8); \
        V = *(const v4u*)(Vp + (r0_ + vr0) * DM + vc0 * 8); GT = *(const v4u*)(Gp + (r0_ + vr0) * DM + vc0 * 8); } while (0)
    LAS float* DT = (LAS float*)(OI + 8192); LAS float* GN = DT + 32 * 128;
    { const int c_ = tid >> 4, k8_ = (tid & 15) * 8; f32x4 d0_ = (f32x4){sdec, sdec, sdec, sdec}, d1_ = d0_;
      if (isg) { const float* g_ = GLp + ((size_t)b * (SEQ / CH) + c_) * DM + k8_; d0_ = *(const f32x4*)g_; d1_ = *(const f32x4*)(g_ + 4); }
      *(LAS f32x4*)(DT + c_ * 128 + k8_) = d0_; *(LAS f32x4*)(DT + c_ * 128 + k8_ + 4) = d1_;
      if (tid < 16) *(LAS f32x4*)(GN + tid * 4) = *(const f32x4*)(a.in[isg ? 9 : 8] + hd * ldo + dv0 + tid * 4); }
    SCAN_LOAD(0, aq0, aq1, ak0, ak1, av, agt);
    const unsigned oi_off = (unsigned)(vr0 * 128 + 16 * (vc0 ^ (vr0 & 7)));
#define SCAN_SW(gn_, g_) ((gn_) * (g_) * __builtin_amdgcn_rcpf(1.0f + __expf(-(g_))))
#define SCAN_XSTORE(cc) do { const v4u ov_ = *(const LAS v4u*)(OI + oi_off); v4u xw_; const f32x4 gnA = *(const LAS f32x4*)(GN + vc0 * 8), gnB = *(const LAS f32x4*)(GN + vc0 * 8 + 4); \
        xw_[0] = cvtpk_s(bflo_(ov_[0]) * SCAN_SW(gnA[0], bflo_(ghold[0])), bfhi_(ov_[0]) * SCAN_SW(gnA[1], bfhi_(ghold[0]))); \
        xw_[1] = cvtpk_s(bflo_(ov_[1]) * SCAN_SW(gnA[2], bflo_(ghold[1])), bfhi_(ov_[1]) * SCAN_SW(gnA[3], bfhi_(ghold[1]))); \
        xw_[2] = cvtpk_s(bflo_(ov_[2]) * SCAN_SW(gnB[0], bflo_(ghold[2])), bfhi_(ov_[2]) * SCAN_SW(gnB[1], bfhi_(ghold[2]))); \
        xw_[3] = cvtpk_s(bflo_(ov_[3]) * SCAN_SW(gnB[2], bflo_(ghold[3])), bfhi_(ov_[3]) * SCAN_SW(gnB[3], bfhi_(ghold[3]))); \
        *(v4u*)(Gp + (rowb + (size_t)(cc) * CH + vr0) * DM + vc0 * 8) = xw_; } while (0)
#define SCAN_DS(cc) do { bf16x8 A[4], B[4]; \
        _Pragma("unroll") for (int ks = 0; ks < 4; ++ks) { A[ks] = rd_tr(KI, lane, kb, ks); B[ks] = rd_tr(VI, lane, dvb, ks); } \
        __builtin_amdgcn_sched_barrier(0); \
        f32x16 d; _Pragma("unroll") for (int i = 0; i < 16; ++i) d[i] = 0.f; \
        _Pragma("unroll") for (int ks = 0; ks < 4; ++ks) d = MFMA32(A[ks], B[ks], d); \
        __builtin_amdgcn_sched_barrier(0); \
        const LAS float* dp_ = DT + (cc) * 128 + 32 * kb + 4 * (int)h;     \
        _Pragma("unroll") for (int j = 0; j < 4; ++j) { const f32x4 G = *(const LAS f32x4*)(dp_ + 8 * j); \
            _Pragma("unroll") for (int i = 0; i < 4; ++i) S[4 * j + i] = G[i] * (S[4 * j + i] + d[4 * j + i]); } } while (0)
#define SCAN_BODY(c, Q0, Q1, K0, K1, V, GT) do { \
        LBAR();                                                   \
        if ((c) > 0) SCAN_XSTORE((c) - 1); \
        ghold = GT;                                               \
        *(LAS v4u*)(QI + off_b(qr0, qc0)) = Q0; *(LAS v4u*)(QI + off_b(qr0 + 32, qc0)) = Q1; \
        *(LAS v4u*)(KI + off_b(qr0, qc0)) = K0; *(LAS v4u*)(KI + off_b(qr0 + 32, qc0)) = K1; \
        *(LAS v4u*)(VI + off_b(vr0, vc0)) = V; \
        if ((c) > 0) {                                            \
            _Pragma("unroll") for (int g = 0; g < 4; ++g) { u32x2 wv; wv.x = cvtpk_s(S[4 * g], S[4 * g + 1]); wv.y = cvtpk_s(S[4 * g + 2], S[4 * g + 3]); \
                *(LAS u32x2*)(SI + off_b(32 * dvb + r, 4 * kb + g) + 8 * h) = wv; } \
        } \
        if ((c) + 1 < SEQ / CH) SCAN_LOAD((c) + 1, Q0, Q1, K0, K1, V, GT); \
        LBAR(); \
        f32x16 o; \
        if (w < 4) {                                              \
            const int ob = w >> 1, tb = w & 1; \
            _Pragma("unroll") for (int i = 0; i < 16; ++i) o[i] = 0.f; \
            bf16x8 A[8], B[8]; \
            _Pragma("unroll") for (int ks = 0; ks < 8; ++ks) { A[ks] = rd_row(SI, 32 * ob + r, ks, h); B[ks] = rd_row(QI, 32 * tb + r, ks, h); } \
            __builtin_amdgcn_sched_barrier(0); \
            _Pragma("unroll") for (int ks = 0; ks < 8; ++ks) o = MFMA32(A[ks], B[ks], o); \
        } else if (w == 7) { SCAN_DS(c); } \
        else {                                         \
            const int sb = (w - 4) >> 1, tb = (w - 3) >> 1; \
            bf16x8 A[8], B[8]; \
            _Pragma("unroll") for (int ks = 0; ks < 8; ++ks) { A[ks] = rd_row(KI, 32 * sb + r, ks, h); B[ks] = rd_row(QI, 32 * tb + r, ks, h); } \
            __builtin_amdgcn_sched_barrier(0); \
            f32x16 p; _Pragma("unroll") for (int i = 0; i < 16; ++i) p[i] = 0.f; \
            _Pragma("unroll") for (int ks = 0; ks < 8; ++ks) p = MFMA32(A[ks], B[ks], p); \
            _Pragma("unroll") for (int g = 0; g < 4; ++g) { float v[4]; \
                _Pragma("unroll") for (int i = 0; i < 4; ++i) { const int sl = 8 * g + 4 * (int)h + i; v[i] = (sb != tb || sl <= (int)r) ? p[4 * g + i] : 0.f; } \
                u32x2 wv; wv.x = cvtpk_s(v[0], v[1]); wv.y = cvtpk_s(v[2], v[3]); \
                *(LAS u32x2*)(PI + off_b(32 * tb + r, 4 * sb + g) + 8 * h) = wv; } \
        } \
        LBAR(); \
        if (w < 4) {                                              \
            const int ob = w >> 1, tb = w & 1; \
            {   bf16x8 A[4], B[4]; \
                _Pragma("unroll") for (int ks = 0; ks < 4; ++ks) { A[ks] = rd_tr(VI, lane, ob, ks); B[ks] = rd_row(PI, 32 * tb + r, ks, h); } \
                __builtin_amdgcn_sched_barrier(0); \
                _Pragma("unroll") for (int ks = 0; ks < 4; ++ks) if (ks < 2 || tb == 1) o = MFMA32(A[ks], B[ks], o); } \
            {   float ss_ = 0.f; _Pragma("unroll") for (int i = 0; i < 16; ++i) ss_ += o[i] * o[i]; ss_ += __shfl_xor(ss_, 32);     \
                if (h == 0) PSQp[(rowb + (size_t)(c) * CH + 32 * tb + r) * 32 + ob] = ss_; } \
              \
            _Pragma("unroll") for (int g = 0; g < 4; ++g) { u32x2 wv; wv.x = cvtpk_s(o[4 * g], o[4 * g + 1]); wv.y = cvtpk_s(o[4 * g + 2], o[4 * g + 3]); \
                const unsigned t_ = 32 * tb + r, ch_ = 4 * ob + g; *(LAS u32x2*)(OI + t_ * 128 + 16 * (ch_ ^ (t_ & 7)) + 8 * h) = wv; } \
            SCAN_DS(c); \
        } else if (w < 7) { SCAN_DS(c); } \
    } while (0)
#pragma unroll 1
    for (int c = 0; c < SEQ / CH; c += 2) {
        SCAN_BODY(c, aq0, aq1, ak0, ak1, av, agt);
        SCAN_BODY(c + 1, aq0, aq1, ak0, ak1, av, agt);
    }
#undef SCAN_BODY
#undef SCAN_DS
#undef SCAN_LOAD
    LBAR();
    SCAN_XSTORE(SEQ / CH - 1);
#undef SCAN_XSTORE
#undef SCAN_SW
#pragma unroll
    for (int i = 0; i < 16; ++i) { const int k = 32 * kb + (i & 3) + 8 * (i >> 2) + 4 * (int)h; Sout[(size_t)k * ldo + 32 * dvb + r] = S[i]; }
    __syncthreads();
#if PROBE_ON && PROBE_SKINNY == 2
    if (threadIdx.x == 0) F.MISC[18] += (unsigned)rt() - pt0_;
#endif
}

__device__ __forceinline__ void p_rows_to_bf16(Frame& F, const Args& a) { const int tid_v = tid_(); const int lane_v = tid_v & 63; const int wave_v = __builtin_amdgcn_readfirstlane(tid_v >> 6);
    const int gw = F.vcu * NWAVES + wave_v, NGW = F.G * NWAVES; bf16* PB = (bf16*)(a.ws + WS_PB);
    for (int m0 = gw; m0 < MTOT; m0 += 4 * NGW) {
        f32x4 pv[4];
#pragma unroll
        for (int u = 0; u < 4; ++u) { const int m = m0 + u * NGW, mc = m < MTOT ? m : 0;
            pv[u] = __builtin_nontemporal_load((const f32x4*)(mc < MPROMPT ? a.in[4] + (size_t)mc * DPLE : a.in[5] + (size_t)(mc - MPROMPT) * DPLE) + lane_v); }
#pragma unroll
        for (int u = 0; u < 4; ++u) { const int m = m0 + u * NGW; if (m < MTOT)
            *((GAS unsigned long long*)(PB + (size_t)m * DPLE) + lane_v) = (unsigned long long)pk2(pv[u].x, pv[u].y) | ((unsigned long long)pk2(pv[u].z, pv[u].w) << 32); }
    }
}

template <bool ISG> __device__ __forceinline__ void dec_load(const Args& a, int item, int tid, int lane, int w, f32x4 (&s)[16], float& qkf, unsigned long long& vw) {
    unsigned char* ws = a.ws;
    if (!ISG) { const int n = item >> 2, h = item & 3, row = MPROMPT + n;
        const float* S0 = a.in[2] + ((size_t)(n * HR + h) * DKR) * DVR;
#pragma unroll
        for (int i = 0; i < 16; ++i) s[i] = __builtin_nontemporal_load((const f32x4*)(S0 + ((size_t)(w + 8 * i) * 64 + lane) * 4));
        qkf = tid < 128 ? bf2f_(((const bf16*)(ws + Z_QR))[(size_t)row * 512 + h * 128 + tid]) : tid < 256 ? bf2f_(((const bf16*)(ws + Z_KR))[(size_t)row * 512 + h * 128 + tid - 128]) : 0.f;
        vw = *(const unsigned long long*)((const bf16*)(ws + Z_VR) + (size_t)row * DM + h * 256 + 4 * lane);
    } else { const int n = item >> 3, h = item & 7, row = MPROMPT + n;
        const float* S0 = a.in[3] + ((size_t)(n * HG + h) * DKG) * DVG;
#pragma unroll
        for (int i = 0; i < 8; ++i) s[i] = __builtin_nontemporal_load((const f32x4*)(S0 + ((size_t)(w + 8 * i) * 64 + lane) * 4));
        qkf = tid < 128 ? bf2f_(((const bf16*)(ws + Z_QG))[(size_t)row * DM + h * 128 + tid]) : tid < 256 ? bf2f_(((const bf16*)(ws + Z_KG))[(size_t)row * DM + h * 128 + tid - 128])
            : tid < 384 ? ((const float*)(ws + WS_FS))[(size_t)n * DM + h * 128 + tid - 256] : 0.f;
        vw = *(const unsigned long long*)((const bf16*)(ws + Z_VG) + (size_t)row * DM + h * 128 + 4 * (lane & 31));
    }
}
template <bool ISG> __device__ __forceinline__ void dec_compute(Frame& F, const Args& a, int item, int tid, int lane, int w, const f32x4 (&s)[16], float qkf, unsigned long long vw) {
    unsigned char* ws = a.ws;
    LAS float* qs = (LAS float*)(F.lds); LAS float* red = qs + 384; LAS float* part = red + 8 * 256;
    LAS float* ks = qs + 128; LAS float* fs = qs + 256;
    if (tid < 384) qs[tid] = qkf;
    const f32x4 v = (f32x4){bflo_((unsigned)vw), bfhi_((unsigned)vw), bflo_((unsigned)(vw >> 32)), bfhi_((unsigned)(vw >> 32))};
    LBAR();
    f32x4 o = (f32x4){0.f, 0.f, 0.f, 0.f};
    if (!ISG) { const int n = item >> 2, h = item & 3; const float gam = 1.0f - exp2f(-5.0f - (float)h);
        float* S1 = a.out + OFF_RETS + ((size_t)(n * HR + h) * DKR) * DVR;
#pragma unroll
        for (int i = 0; i < 16; ++i) { const int k = w + 8 * i; const f32x4 sn = s[i] * gam + v * ks[k]; __builtin_nontemporal_store(sn, (f32x4*)(S1 + ((size_t)k * 64 + lane) * 4)); o += sn * qs[k]; }
    } else { const int n = item >> 3, h = item & 7;
        float* S1 = a.out + OFF_HGS + ((size_t)(n * HG + h) * DKG) * DVG;
#pragma unroll
        for (int i = 0; i < 8; ++i) { const int k = 2 * (w + 8 * i) + (lane >> 5); const f32x4 sn = s[i] * fs[k] + v * ks[k]; __builtin_nontemporal_store(sn, (f32x4*)(S1 + ((size_t)(w + 8 * i) * 64 + lane) * 4)); o += sn * qs[k]; }
    }
    *(LAS f32x4*)(red + w * 256 + 4 * lane) = o;
    LBAR();
    constexpr int NDV = ISG ? 128 : 256; float ov = 0.f;
    if (tid < NDV) {
        if (!ISG) {
#pragma unroll
            for (int i = 0; i < 8; ++i) ov += red[i * 256 + tid];
        } else {
#pragma unroll
            for (int i = 0; i < 8; ++i) ov += red[i * 256 + tid] + red[i * 256 + 128 + tid];
        }
        const float ss = wave_sum(ov * ov); if (lane == 0) part[w] = ss;
    }
    LBAR();
    if (tid < NDV) {
        const float rstd = rsqrtf((ISG ? (part[0] + part[1]) : ((part[0] + part[1]) + (part[2] + part[3]))) * (1.0f / NDV) + EPS);
        const int n = ISG ? item >> 3 : item >> 2, h = ISG ? item & 7 : item & 3, row = MPROMPT + n;
        bf16* gp = (bf16*)(ws + (ISG ? WS_GG : WS_GR)) + (size_t)row * DM + h * NDV + tid;
        const float gv_ = bf2f_(*gp); *gp = (bf16)f2bf(ov * rstd * a.in[ISG ? 9 : 8][h * NDV + tid] * (gv_ * __builtin_amdgcn_rcpf(1.0f + __expf(-gv_))));
    }
    LBAR();
}
constexpr int XB_SAMPLES = (int)(((size_t)MP * DM * 2 + (size_t)HR * DKR * DVR * 4 - 1) / ((size_t)HR * DKR * DVR * 4));
template <int PART> __device__ __forceinline__ void decode_part(Frame& F, const Args& a) { const int tid_v = tid_(); const int lane_v = tid_v & 63; const int wave_v = __builtin_amdgcn_readfirstlane(tid_v >> 6);
    const int tid = tid_v, lane = lane_v, w = wave_v, c = F.vcu, G = F.G;
    const bool r1_early = ((c + G) >> 2) >= XB_SAMPLES;
    f32x4 sa[16], sb[16]; float qa, qb; unsigned long long va, vb;
    if (PART == 1) {
        dec_load<true>(a, c, tid, lane, w, sa, qa, va);
        dec_load<true>(a, c + G, tid, lane, w, sb, qb, vb);          dec_compute<true>(F, a, c, tid, lane, w, sa, qa, va);
        dec_load<true>(a, c + 2 * G, tid, lane, w, sa, qa, va);      dec_compute<true>(F, a, c + G, tid, lane, w, sb, qb, vb);
        dec_load<true>(a, c + 3 * G, tid, lane, w, sb, qb, vb);      dec_compute<true>(F, a, c + 2 * G, tid, lane, w, sa, qa, va);
        if (r1_early) dec_load<false>(a, c + G, tid, lane, w, sa, qa, va);
        dec_compute<true>(F, a, c + 3 * G, tid, lane, w, sb, qb, vb);
        if (r1_early) dec_compute<false>(F, a, c + G, tid, lane, w, sa, qa, va);
    } else {
        dec_load<false>(a, c, tid, lane, w, sa, qa, va);
        if (!r1_early) dec_load<false>(a, c + G, tid, lane, w, sb, qb, vb);
        dec_compute<false>(F, a, c, tid, lane, w, sa, qa, va);
        if (!r1_early) dec_compute<false>(F, a, c + G, tid, lane, w, sb, qb, vb);
    }
}

__device__ __forceinline__ void p3_headnorm(Frame& F, const Args& a) { const int tid_v = tid_(); const int lane_v = tid_v & 63; const int wave_v = __builtin_amdgcn_readfirstlane(tid_v >> 6); (void)lane_v; (void)wave_v;
    unsigned char* ws = a.ws; const int gw = F.vcu * NWAVES + wave_v, NGW = F.G * NWAVES, lane = lane_v;
    constexpr int NIT = MPROMPT * 8, U = 4;
    for (int it0 = gw; it0 < NIT; it0 += U * NGW) {
        unsigned long long ow[U], gwd[U]; f32x4 gn[U]; unsigned long long* gp[U]; bool isg[U], ok[U];
#pragma unroll
        for (int u = 0; u < U; ++u) {
            const int it = it0 + u * NGW; ok[u] = it < NIT; const int itc = ok[u] ? it : gw;
            isg[u] = itc >= MPROMPT * 4; const int i2 = isg[u] ? itc - MPROMPT * 4 : itc; const int row = i2 >> 2, q = i2 & 3;
            const size_t off = (size_t)row * DM + q * 256 + 4 * lane;
            ow[u] = __builtin_nontemporal_load((const unsigned long long*)((const bf16*)(ws + (isg[u] ? Z_VG : Z_VR)) + off));
            gp[u] = (unsigned long long*)((bf16*)(ws + (isg[u] ? WS_GG : WS_GR)) + off); gwd[u] = *gp[u];
            gn[u] = *(const f32x4*)(a.in[isg[u] ? 9 : 8] + q * 256 + 4 * lane);
        }
#pragma unroll
        for (int u = 0; u < U; ++u) {
            const f32x4 o = (f32x4){bflo_((unsigned)ow[u]), bfhi_((unsigned)ow[u]), bflo_((unsigned)(ow[u] >> 32)), bfhi_((unsigned)(ow[u] >> 32))};
            f32x4 gt = (f32x4){bflo_((unsigned)gwd[u]), bfhi_((unsigned)gwd[u]), bflo_((unsigned)(gwd[u] >> 32)), bfhi_((unsigned)(gwd[u] >> 32))};
            gt.x *= __builtin_amdgcn_rcpf(1.0f + __expf(-gt.x)); gt.y *= __builtin_amdgcn_rcpf(1.0f + __expf(-gt.y)); gt.z *= __builtin_amdgcn_rcpf(1.0f + __expf(-gt.z)); gt.w *= __builtin_amdgcn_rcpf(1.0f + __expf(-gt.w));
            float ss = (o.x * o.x + o.y * o.y) + (o.z * o.z + o.w * o.w);
#pragma unroll
            for (int d = 1; d < 32; d <<= 1) ss += __shfl_xor(ss, d);
            if (!isg[u]) ss += __shfl_xor(ss, 32);
            const float rstd = rsqrtf(ss * (isg[u] ? 1.0f / DVG : 1.0f / DVR) + EPS);
            const f32x4 x = o * rstd * gn[u] * gt;
            if (ok[u]) *gp[u] = (unsigned long long)pk2(x.x, x.y) | ((unsigned long long)pk2(x.z, x.w) << 32);
        }
    }
}

__device__ __forceinline__ void p9_final(Frame& F, const Args& a) { const int tid_v = tid_(); const int lane_v = tid_v & 63; const int wave_v = __builtin_amdgcn_readfirstlane(tid_v >> 6); (void)lane_v; (void)wave_v;
    const int gw = F.vcu * NWAVES + wave_v, NGW = F.G * NWAVES, lane = lane_v; const float* PS3 = (const float*)(a.ws + WS_PS3); const float* gf = a.in[20];
    for (int m = gw; m < MTOT; m += NGW) {
        const float pv = m < MPROMPT ? (lane < 16 ? PS3[(size_t)m * 16 + lane] : 0.f) : ((const float*)(a.ws + WS_PSS3))[(size_t)(m - MPROMPT) * 64 + lane];
        const float rstd = rsqrtf(wave_sum(pv) * (1.0f / DM) + EPS);
        const unsigned long long* r16 = (const unsigned long long*)((const bf16*)(a.ws + WS_A5) + (size_t)m * DM) + lane;
        f32x4* y = (f32x4*)(a.out + (size_t)m * DM) + lane;
#pragma unroll
        for (int j = 0; j < 4; ++j) { const unsigned long long w = r16[64 * j]; const f32x4 gv = *((const f32x4*)gf + 64 * j + lane);
            __builtin_nontemporal_store((f32x4){bflo_((unsigned)w), bfhi_((unsigned)w), bflo_((unsigned)(w >> 32)), bfhi_((unsigned)(w >> 32))} * rstd * gv, y + 64 * j); }
    }
}

template <int K, class FE> __device__ __forceinline__ void skinny_gemm(Frame& F, const bf16* As, const bf16* Wt, int N, const FE& fe, int it0 = 0, int it1 = 1 << 30) {     const int tid_v = tid_(); const int lane_v = tid_v & 63; const int wave_v = __builtin_amdgcn_readfirstlane(tid_v >> 6); (void)lane_v; (void)wave_v;
    constexpr int KW = K / 4, NKS = KW / 32, CH_KS = NKS < 8 ? NKS : 8, NCH = NKS / CH_KS;
    const int lane = lane_v, fr = lane & 15, fq = lane >> 4, rg = wave_v >> 2, ks = wave_v & 3;
    LAS f32x4* red = (LAS f32x4*)(F.lds);
    const int ntile = 4 * (N / 16);
#if PROBE_ON && PROBE_SKINNY == 1
    const unsigned ps0_ = (unsigned)rt();
#endif
    const int rb = F.vcu & 3;
    const bf16* bp = As + (size_t)(32 * rb + 16 * rg + fr) * K + ks * KW + 8 * fq;
    const bool fin = (NCH == 1) ? (ks == 0) : (wave_v < 2); const int frow = MPROMPT + 32 * rb + 16 * ((NCH == 1) ? rg : wave_v) + fr;
    const float faux = fin ? fe.prep(frow) : 1.f;
    if constexpr (NCH == 1) {
        bf16x8 act[CH_KS], wa[CH_KS], wb[CH_KS];
#pragma unroll
        for (int i = 0; i < CH_KS; ++i) act[i] = *(const bf16x8*)(bp + i * 32);
        int itn = it0; int tile = F.vcu + itn * F.G; bool have = itn < it1 && tile < ntile;
        if (have) { const bf16* ap = Wt + (size_t)(16 * (tile >> 2) + fr) * K + ks * KW + 8 * fq;
#pragma unroll
            for (int i = 0; i < CH_KS; ++i) wa[i] = *(const bf16x8*)(ap + i * 32); }
        while (have) {
            const int ntile_ = tile + F.G; const bool nhave = (itn + 1) < it1 && ntile_ < ntile;
            if (nhave) { const bf16* ap = Wt + (size_t)(16 * (ntile_ >> 2) + fr) * K + ks * KW + 8 * fq;
#pragma unroll
                for (int i = 0; i < CH_KS; ++i) wb[i] = *(const bf16x8*)(ap + i * 32); }
            f32x4 acc = (f32x4){0.f, 0.f, 0.f, 0.f};
#pragma unroll
            for (int i = 0; i < CH_KS; ++i) acc = __builtin_amdgcn_mfma_f32_16x16x32_bf16(wa[i], act[i], acc, 0, 0, 0);
            red[wave_v * 64 + lane] = acc;
            __syncthreads();
            if (ks == 0) {
                const f32x4 v = (red[(4 * rg + 0) * 64 + lane] + red[(4 * rg + 1) * 64 + lane]) + (red[(4 * rg + 2) * 64 + lane] + red[(4 * rg + 3) * 64 + lane]);
                fe(frow, 16 * (tile >> 2) + 4 * fq, v, faux);
            }
            __syncthreads();
            if (nhave) {
#pragma unroll
                for (int i = 0; i < CH_KS; ++i) wa[i] = wb[i]; }
            ++itn; tile = ntile_; have = nhave;
        }
    } else {
        constexpr int KW8 = K / 8, NS8 = KW8 / 32;
        const bf16* bp0 = As + (size_t)(32 * rb + fr) * K + wave_v * KW8 + 8 * fq; const bf16* bp1 = bp0 + (size_t)16 * K;
        for (int itn = it0; itn < it1; ++itn) {
            const int tile = F.vcu + itn * F.G; if (tile >= ntile) break;
            const int cb = tile >> 2;
            const bf16* ap = Wt + (size_t)(16 * cb + fr) * K + wave_v * KW8 + 8 * fq;
            f32x4 acc0 = (f32x4){0.f, 0.f, 0.f, 0.f}, acc1 = acc0;
            bf16x8 a[2][4], b0[2][4], b1[2][4];
#define SK_LD(s, c) do { _Pragma("unroll") for (int i = 0; i < 4; ++i) { a[s][i] = *(const bf16x8*)(ap + ((c) * 4 + i) * 32); b0[s][i] = *(const bf16x8*)(bp0 + ((c) * 4 + i) * 32); b1[s][i] = *(const bf16x8*)(bp1 + ((c) * 4 + i) * 32); } } while (0)
            SK_LD(0, 0);
#pragma unroll
            for (int c = 0; c < NS8 / 4; ++c) {
                if (c + 1 < NS8 / 4) SK_LD((c + 1) & 1, c + 1);
#pragma unroll
                for (int i = 0; i < 4; ++i) { acc0 = __builtin_amdgcn_mfma_f32_16x16x32_bf16(a[c & 1][i], b0[c & 1][i], acc0, 0, 0, 0); acc1 = __builtin_amdgcn_mfma_f32_16x16x32_bf16(a[c & 1][i], b1[c & 1][i], acc1, 0, 0, 0); }
            }
#undef SK_LD
            red[(wave_v * 2 + 0) * 64 + lane] = acc0; red[(wave_v * 2 + 1) * 64 + lane] = acc1;
            __syncthreads();
            if (wave_v < 2) {
                f32x4 v = red[wave_v * 64 + lane];
#pragma unroll
                for (int s = 1; s < 8; ++s) v += red[(s * 2 + wave_v) * 64 + lane];
                fe(frow, 16 * cb + 4 * fq, v, faux);
            }
            __syncthreads();
        }
    }
#if PROBE_ON && PROBE_SKINNY == 1
    if (threadIdx.x == 0) F.MISC[18] += (unsigned)rt() - ps0_;
#endif
}
__device__ __forceinline__ void skinny_up_pair(Frame& F, const bf16* Ag, const bf16* Wg, const bf16* Ar, const bf16* Wr, const pg8::bf16_t* AR, const pg8::bf16_t* AH, pg8::bf16_t* M) {
    const int tid_v = tid_(); const int lane = tid_v & 63; const int wave_v = __builtin_amdgcn_readfirstlane(tid_v >> 6);
    const int fr = lane & 15, fq = lane >> 4, rg = wave_v >> 2, ks = wave_v & 3;
    LAS f32x4* red = (LAS f32x4*)(F.lds);
    const int tile = F.vcu; if (tile >= 4 * (DM / 16)) return;
    const int rb = tile & 3, cb = tile >> 2;
    const size_t ao = (size_t)(32 * rb + 16 * rg + fr) * DM + ks * 256 + 8 * fq, wo = (size_t)(16 * cb + fr) * DM + ks * 256 + 8 * fq;
    bf16x8 xg[8], wg[8], xr[8], wr_[8];
#pragma unroll
    for (int i = 0; i < 8; ++i) { xg[i] = *(const bf16x8*)(Ag + ao + i * 32); wg[i] = *(const bf16x8*)(Wg + wo + i * 32); xr[i] = *(const bf16x8*)(Ar + ao + i * 32); wr_[i] = *(const bf16x8*)(Wr + wo + i * 32); }
    const int row = MPROMPT + 32 * rb + 16 * rg + fr, col = 16 * cb + 4 * fq;
    u32x2 gr = (u32x2){0u, 0u}, gh = gr;
    if (ks == 0) { gr = *(const u32x2*)(AR + (size_t)row * DM + col); gh = *(const u32x2*)(AH + (size_t)row * DM + col); }
    f32x4 ag = (f32x4){0.f, 0.f, 0.f, 0.f}, ar = ag;
#pragma unroll
    for (int i = 0; i < 8; ++i) { ag = __builtin_amdgcn_mfma_f32_16x16x32_bf16(wg[i], xg[i], ag, 0, 0, 0); ar = __builtin_amdgcn_mfma_f32_16x16x32_bf16(wr_[i], xr[i], ar, 0, 0, 0); }
    red[(wave_v * 2 + 0) * 64 + lane] = ag; red[(wave_v * 2 + 1) * 64 + lane] = ar;
    __syncthreads();
    if (ks == 0) {
        f32x4 ug = red[((4 * rg) * 2 + 0) * 64 + lane], ur = red[((4 * rg) * 2 + 1) * 64 + lane];
#pragma unroll
        for (int s = 1; s < 4; ++s) { ug += red[((4 * rg + s) * 2 + 0) * 64 + lane]; ur += red[((4 * rg + s) * 2 + 1) * 64 + lane]; }
        const f32x4 sr = pg8::unpack4(gr), rho = pg8::unpack4(gh);
        *(u32x2*)(M + (size_t)row * DM + col) = pg8::pack4(sr * (ur + rho * ug));
    }
    __syncthreads();
}
struct FeIn { pg8::EpiIn E; __device__ __forceinline__ float prep(int) const { return 1.f; } __device__ __forceinline__ void operator()(int row, int col, f32x4 v, float) const { pg8::samp_in(E, row, col, v); } };
template <int MODE> struct FeN { pg8::EpiN<MODE> E; const float* xs; float* PSS; const float* PSSin;
    __device__ __forceinline__ float prep(int row) const { return pg8::samp_rstd<MODE>(PSSin, row); }
    __device__ __forceinline__ void operator()(int row, int col, f32x4 v, float aux) const { pg8::samp_n<MODE>(E, xs, PSS, PSSin, row, col, v, aux); } };

struct PairOrder { pg8::StaticOrder S0;
    __device__ __forceinline__ bool next(int i, pg8::Unit& u) const { pg8::Unit t; if (!S0.next(i >> 1, t)) return false; if ((i & 1) == 0) { u.pm = t.pm + MP / 256; u.pn = t.pn + DM / 256; } else u = t; return true; }
    __device__ __forceinline__ void a_ready(const pg8::Unit&) const {}
    __device__ __forceinline__ void done(const pg8::Unit&) const {} };
struct EpiUp { static constexpr bool PERM = true, AFTER_DRAIN = false; const pg8::bf16_t* AR; const pg8::bf16_t* AH; pg8::bf16_t* M;
    __device__ __forceinline__ bool keep_acc(const pg8::Unit& u) const { return u.pn >= DM / 256; }
    __device__ __forceinline__ static const LAS float* tab(int idx) { return (const LAS float*)(unsigned long)HT_LDS_OFF + idx * 256; }
    __device__ __forceinline__ static void scale_rows(f32x4 (&acc)[2][2][4][2], const LAS float* t, int wr, int fr) {
#pragma unroll
        for (int ai = 0; ai < 2; ++ai)
#pragma unroll
            for (int m = 0; m < 4; ++m) { const float f = t[ai * 128 + wr * 64 + m * 16 + fr];
#pragma unroll
                for (int bj = 0; bj < 2; ++bj) { acc[ai][bj][m][0] *= f; acc[ai][bj][m][1] *= f; } }
    }
    __device__ __forceinline__ void khook(f32x4 (&acc)[2][2][4][2], const pg8::Unit& u, int t, int wr, int fr) const {
        if (u.pn >= DM / 256) { const int h = t >> 1; if (h < 7) scale_rows(acc, tab(h), wr, fr); }
        else if (t & 2) { const int h = t >> 2; if (h < 3) scale_rows(acc, tab(9 + h), wr, fr); }
    }
    __device__ __forceinline__ void operator()(f32x4 (&acc)[2][2][4][2], const pg8::Unit& u, int wr, int wc, int fr, int fq) const {
        using namespace pg8;
        const bool first = u.pn >= DM / 256; const int pm = first ? u.pm - MP / 256 : u.pm, pn = first ? u.pn - DM / 256 : u.pn;
#pragma unroll
        for (int ai = 0; ai < 2; ++ai)
#pragma unroll
            for (int m = 0; m < 4; ++m) {
                const int rl = ai * HALF + wr * 64 + m * 16 + fr, row = pm * BM + rl;
                const float rf = first ? tab(7)[rl] * tab(8)[rl] : tab(12)[rl];
#pragma unroll
                for (int bj = 0; bj < 2; ++bj) {
                    const int col = pn * BM + bj * HALF + wc * 32 + fq * 8; const size_t o = (size_t)row * DM + col;
                    if (first) { f32x4 h0, h1; unpack8(*(const u32x4*)(AH + o), h0, h1); acc[ai][bj][m][0] *= h0 * rf; acc[ai][bj][m][1] *= h1 * rf; }
                    else { f32x4 r0, r1; unpack8(*(const u32x4*)(AR + o), r0, r1); *(u32x4*)(M + o) = pack8(r0 * rf * acc[ai][bj][m][0], r1 * rf * acc[ai][bj][m][1]); }
                }
            }
    } };
__device__ __forceinline__ void head_tables_to_lds(Frame& F, const unsigned char* ws, int pm) { const int t = tid_();
    LAS float* T = (LAS float*)(F.lds + HT_LDS_OFF);
    if (t < 256) { const size_t row = (size_t)pm * 256 + t; float sg[8], sr[4];
        const f32x4* pg = (const f32x4*)((const float*)(ws + WS_PSQG) + row * 32); const f32x4* pr = (const f32x4*)((const float*)(ws + WS_PSQR) + row * 32);
#pragma unroll
        for (int h = 0; h < 8; ++h) { const f32x4 v = pg[h]; sg[h] = rsqrtf(((v[0] + v[1]) + (v[2] + v[3])) * (1.0f / DVG) + EPS); }
#pragma unroll
        for (int h = 0; h < 4; ++h) { const f32x4 v = pr[2 * h], w = pr[2 * h + 1]; sr[h] = rsqrtf((((v[0] + v[1]) + (v[2] + v[3])) + ((w[0] + w[1]) + (w[2] + w[3]))) * (1.0f / DVR) + EPS); }
#pragma unroll
        for (int h = 0; h < 7; ++h) T[h * 256 + t] = sg[h] * __builtin_amdgcn_rcpf(sg[h + 1]);
        T[7 * 256 + t] = sg[7]; T[8 * 256 + t] = __builtin_amdgcn_rcpf(sr[0]);
#pragma unroll
        for (int h = 0; h < 3; ++h) T[(9 + h) * 256 + t] = sr[h] * __builtin_amdgcn_rcpf(sr[h + 1]);
        T[12 * 256 + t] = sr[3]; }
    __syncthreads();
}

__device__ __forceinline__ const LAS float* rstd_to_lds(Frame& F, const float* PS, int pm) { const int t = tid_();
    LAS float* rl = (LAS float*)(F.lds + RSTD_LDS_OFF);
    if (t < 256) { const f32x4* p = (const f32x4*)(PS + ((size_t)pm * 256 + t) * 16); const f32x4 a = p[0], b = p[1], c = p[2], e = p[3];
        const float s = ((a[0] + a[1]) + (a[2] + a[3])) + ((b[0] + b[1]) + (b[2] + b[3])) + ((c[0] + c[1]) + (c[2] + c[3])) + ((e[0] + e[1]) + (e[2] + e[3]));
        rl[t] = rsqrtf(s * (1.0f / 1024.0f) + EPS); }
    __syncthreads();
    return rl;
}

__global__ void __launch_bounds__(NWAVES * 64, 2) fwd_kernel(Args args) {
#define tid_v ((int)threadIdx.x)
    extern __shared__ __attribute__((aligned(16))) unsigned char lds[];
    Frame F;
    F.lds = (LAS unsigned char*)lds;
    F.MISC = (volatile LAS unsigned*)(F.lds + MISC_OFF);
        F.G = gridDim.x; { const int bx = blockIdx.x; F.vcu = (F.G % 8 == 0) ? (bx % 8) * (F.G / 8) + bx / 8 : bx; }
    unsigned char* ws = args.ws;
    F.ctl = (gu32*)(ws + WS_CTL);
    for (int u = tid_v; u < (LDS_BYTES - LDSCTL_OFF) / 4; u += NWAVES * 64) ((LAS unsigned*)(F.lds + LDSCTL_OFF))[u] = 0u;
    __syncthreads();
    XcdBarrier bar; bar.bar = (unsigned*)(F.ctl + CW_BAR); bar.x = 0; bar.st = nullptr;
    if (args.use_bar) bar = xcd_barrier_post((unsigned*)(F.ctl + CW_BAR), F.MISC + 8);
    const int lo = args.ph_lo, hi = args.ph_hi;
#define IN(k) (lo <= (k) && (k) < hi)
#if PROBE_ON
    volatile LAS unsigned* PW = F.MISC + 16;
    if (tid_v == 0) { PW[0] = (unsigned)rt(); PW[1] = 0u; PW[2] = 0u; }
#define STAMP(k) do { if (blockIdx.x == 0 && tid_v == 0) { const unsigned t_ = (unsigned)rt(); unsigned q_ = (t_ - PW[0] + (unsigned)PROBE_UNIT / 2) / (unsigned)PROBE_UNIT; if (q_ > 49u) q_ = 49u; \
        if ((k) == PROBE_A) PW[1] += q_ * 400u; else if ((k) == PROBE_B) PW[1] += q_ * 20000u; else if (PROBE_E < 0 && (k) == PROBE_C) PW[1] += q_ * 1000000u; \
        if ((k) == PROBE_E) { unsigned e_ = (PW[2] + (unsigned)PROBE_UNIT / 2) / (unsigned)PROBE_UNIT; if (e_ > 49u) e_ = 49u; PW[1] += e_ * 1000000u; } PW[2] = 0u; PW[0] = t_; } } while (0)
#else
#define STAMP(k) do { } while (0)
#endif
#define SEAM(k) do { if (IN(k) && IN((k) + 1)) xcd_barrier(bar); STAMP(k); } while (0)
    using namespace pg8;
    bf16_t* XB = (bf16_t*)(args.out + OFF_RETS);
    bf16_t* AR = (bf16_t*)(args.out + OFF_Y); bf16_t* AH = AR + (size_t)MTOT * DM;
    float* R = args.out + OFF_Y;
    float* PS1 = (float*)(ws + WS_PS1); float* PS2 = (float*)(ws + WS_PS2); float* PS3 = (float*)(ws + WS_PS3);

    if (IN(0)) { p0_prologue<0>(F, args); SEAM(0); }
    const bf16_t* SROW = nullptr; (void)SROW;
    float* PSS1 = (float*)(ws + WS_PSS1); float* PSS2 = (float*)(ws + WS_PSS2); float* PSS3 = (float*)(ws + WS_PSS3);
#define SAMP(buf, ld) ((const bf16*)(buf) + (size_t)MPROMPT * (ld))
    if (IN(1)) {
        Gemm g{XB, (const bf16_t*)(ws + WS_WIN), MPROMPT, DIN, DM}; StaticOrder S; S.init(MPROMPT, DIN, F.G, (int)blockIdx.x);
        EpiIn E{(const float*)(ws + WS_RSTD0), (const float*)(ws + WS_CS), (const float*)(ws + WS_LB),
                (bf16_t*)(ws + Z_QR), (bf16_t*)(ws + Z_KR), (bf16_t*)(ws + Z_VR), (bf16_t*)(ws + WS_GR), (bf16_t*)(ws + Z_QG), (bf16_t*)(ws + Z_KG), (bf16_t*)(ws + Z_VG), (bf16_t*)(ws + WS_GG),
                AR, AH, (float*)(ws + WS_GL), (float*)(ws + WS_FS), ws, (unsigned char*)args.out};
        { Unit u0; S.next(0, u0); const int t = tid_v; if (t < 256) ((LAS float*)(F.lds + RSTD_LDS_OFF))[t] = ((const float*)(ws + WS_RSTD0))[u0.pm * 256 + t]; __syncthreads(); }
        { FeIn fe{E}; skinny_gemm<DM>(F, SAMP(XB, DM), (const bf16*)(ws + WS_WIN), DIN, fe); }
        asm volatile("s_waitcnt vmcnt(0)" ::: "memory"); __syncthreads();
        if (tid_v == 0) { __builtin_amdgcn_fence(__ATOMIC_RELEASE, "agent"); asm volatile("s_waitcnt vmcnt(0)" ::: "memory"); __hip_atomic_fetch_add(F.ctl + CW_SAMP, 1u, RLX_AGENT); }
        const bool dec_first = (F.vcu & 1) != 0, late_first = (F.vcu & 2) != 0;
#define SAMP_WAIT() do { if (tid_v == 0) { unsigned sp_ = 0; while (__hip_atomic_load(F.ctl + CW_SAMP, RLX_AGENT) < gridDim.x) { __builtin_amdgcn_s_sleep(2); if (++sp_ > (1u << 22)) break; } \
                                             __builtin_amdgcn_fence(__ATOMIC_ACQUIRE, "agent"); asm volatile("s_waitcnt vmcnt(0)" ::: "memory"); } __syncthreads(); } while (0)
        if (dec_first) { SAMP_WAIT(); decode_part<1>(F, args); }
        if (late_first) { p0_prologue<1>(F, args); __syncthreads(); }
        gemm_phase<EpiIn, StaticOrder, true, true>(F.lds + RING_OFF, g, S, E);
        if (!late_first) { p0_prologue<1>(F, args); __syncthreads(); }
        if (!dec_first) { SAMP_WAIT(); decode_part<1>(F, args); }
#undef SAMP_WAIT
        SEAM(1);
    }
    if (IN(2)) {
        const bool dfirst = (F.vcu & 1) != 0;
        if (dfirst) decode_part<2>(F, args);
        for (int it = F.vcu; it < 256; it += F.G) scan_item(F, args, it);
        if (!dfirst) decode_part<2>(F, args);
        SEAM(2);
    }
    if (IN(4)) {
        Gemm g{(const bf16_t*)(ws + WS_GR), (const bf16_t*)(ws + WS_WUPR), 2 * MP, 2 * DM, DM}; PairOrder S; S.S0.init(MPROMPT, DM, F.G, (int)blockIdx.x);
        EpiUp E{AR, AH, (bf16_t*)(ws + WS_MB)};
        { Unit u0; S.S0.next(0, u0); head_tables_to_lds(F, ws, u0.pm); }
        const bool sk_first = (F.vcu & 1) != 0;
        if (sk_first) skinny_up_pair(F, SAMP(ws + WS_GG, DM), (const bf16*)(ws + WS_WUPH), SAMP(ws + WS_GR, DM), (const bf16*)(ws + WS_WUPR), AR, AH, (bf16_t*)(ws + WS_MB));
        gemm_phase<EpiUp, PairOrder, true, true>(F.lds + RING_OFF, g, S, E);
        if (!sk_first) skinny_up_pair(F, SAMP(ws + WS_GG, DM), (const bf16*)(ws + WS_WUPH), SAMP(ws + WS_GR, DM), (const bf16*)(ws + WS_WUPR), AR, AH, (bf16_t*)(ws + WS_MB));
        SEAM(4);
    }
    if (IN(5)) {
        Gemm g{(const bf16_t*)(ws + WS_MB), (const bf16_t*)(ws + WS_WO), MPROMPT, DM, DM}; StaticOrder S; S.init(MPROMPT, DM, F.G, (int)blockIdx.x);
        EpiN<2> E{nullptr, (bf16_t*)(ws + WS_A5), DM, args.in[0], nullptr, nullptr, nullptr, PS1, nullptr};
        const bool sk_first = (F.vcu & 1) != 0; FeN<2> fe{E, args.in[1], PSS1, nullptr};
        if (sk_first) skinny_gemm<DM>(F, SAMP(ws + WS_MB, DM), (const bf16*)(ws + WS_WO), DM, fe);
        gemm_phase<EpiN<2>, StaticOrder, true, true>(F.lds + RING_OFF, g, S, E);
        if (!sk_first) skinny_gemm<DM>(F, SAMP(ws + WS_MB, DM), (const bf16*)(ws + WS_WO), DM, fe);
        SEAM(5);
    }
    if (IN(6)) {
        Gemm g{(const bf16_t*)(ws + WS_A5), (const bf16_t*)(ws + WS_WFF1), MPROMPT, DFF, DM}; StaticOrder S; S.init(MPROMPT, DFF, F.G, (int)blockIdx.x);
        Unit u0; S.next(0, u0);
        EpiN<3> E{nullptr, (bf16_t*)(ws + WS_H), DFF, nullptr, nullptr, nullptr, nullptr, nullptr, PS1, (rstd_to_lds(F, PS1, u0.pm), 1)};
        const int nfirst = (F.vcu & 3) + ((F.vcu & 3) == 3 ? 1 : 0); FeN<3> fe{E, nullptr, nullptr, PSS1};
        const bool pb_first = (F.vcu & 2) != 0;
        skinny_gemm<DM>(F, SAMP(ws + WS_A5, DM), (const bf16*)(ws + WS_WFF1), DFF, fe, 0, nfirst);
        if (pb_first) p_rows_to_bf16(F, args);
        gemm_phase<EpiN<3>, StaticOrder, true, true>(F.lds + RING_OFF, g, S, E);
        if (!pb_first) p_rows_to_bf16(F, args);
        skinny_gemm<DM>(F, SAMP(ws + WS_A5, DM), (const bf16*)(ws + WS_WFF1), DFF, fe, nfirst);
        SEAM(6);
    }
    if (IN(7)) {
        Gemm g{(const bf16_t*)(ws + WS_H), (const bf16_t*)(ws + WS_WFF2), MPROMPT, DM, DFF}; StaticOrder S; S.init(MPROMPT, DM, F.G, (int)blockIdx.x);
        EpiN<6> E{(const bf16_t*)(ws + WS_A5), (bf16_t*)(ws + WS_A7), DM, nullptr, nullptr, nullptr, nullptr, PS2, nullptr};
        const bool sk_first = (F.vcu & 1) != 0; FeN<6> fe{E, nullptr, PSS2, nullptr};
        if (sk_first) skinny_gemm<DFF>(F, SAMP(ws + WS_H, DFF), (const bf16*)(ws + WS_WFF2), DM, fe);
        gemm_phase<EpiN<6>, StaticOrder, true, true>(F.lds + RING_OFF, g, S, E);
        if (!sk_first) skinny_gemm<DFF>(F, SAMP(ws + WS_H, DFF), (const bf16*)(ws + WS_WFF2), DM, fe);
        SEAM(7);
    }
    if (IN(8)) {
        { Gemm g{(const bf16_t*)(ws + WS_A7), (const bf16_t*)(ws + WS_WGATE), MPROMPT, DM, DM}; StaticOrder S; S.init(MPROMPT, DM, F.G, (int)blockIdx.x);
          Unit u0; S.next(0, u0);
          EpiN<4> E{nullptr, (bf16_t*)(ws + WS_MB), DM, nullptr, nullptr, nullptr, nullptr, nullptr, PS2, (rstd_to_lds(F, PS2, u0.pm), 1)};
          gemm_phase<EpiN<4>, StaticOrder, true, true>(F.lds + RING_OFF, g, S, E);
          FeN<4> fe{E, nullptr, nullptr, PSS2}; skinny_gemm<DM>(F, SAMP(ws + WS_A7, DM), (const bf16*)(ws + WS_WGATE), DM, fe); }
        { Gemm g{(const bf16_t*)(ws + WS_PB), (const bf16_t*)(ws + WS_WPROJ), MPROMPT, DM, DPLE}; StaticOrder S; S.init(MPROMPT, DM, F.G, (int)blockIdx.x);
          EpiN<5> E{(const bf16_t*)(ws + WS_A7), (bf16_t*)(ws + WS_MB), DM, nullptr, nullptr, (float*)(ws + WS_A5), nullptr, PS3, nullptr};
          gemm_phase<EpiN<5>, StaticOrder, true, true>(F.lds + RING_OFF, g, S, E);
          FeN<5> fe{E, nullptr, PSS3, nullptr}; skinny_gemm<DPLE>(F, SAMP(ws + WS_PB, DPLE), (const bf16*)(ws + WS_WPROJ), DM, fe); }
        SEAM(8);
    }
    if (IN(9)) { p9_final(F, args); }
#ifdef GEMM_TAIL
    xcd_barrier(bar);
#if GEMM_TAIL == 5 || GEMM_TAIL == 55
    { Gemm g{(const bf16_t*)(ws + WS_MB), (const bf16_t*)(ws + WS_WO), MPROMPT, DM, DM}; StaticOrder S; S.init(MPROMPT, DM, F.G, (int)blockIdx.x);
      EpiN<2> E{nullptr, (bf16_t*)(ws + WS_A5), DM, args.in[0], nullptr, nullptr, nullptr, PS1, nullptr}; FeN<2> fe{E, args.in[1], PSS1, nullptr};
      gemm_phase<EpiN<2>, StaticOrder, true, true>(F.lds + RING_OFF, g, S, E);
#if GEMM_TAIL == 5
      skinny_gemm<DM>(F, SAMP(ws + WS_MB, DM), (const bf16*)(ws + WS_WO), DM, fe);
#endif
    }
#elif GEMM_TAIL == 7 || GEMM_TAIL == 77
    { Gemm g{(const bf16_t*)(ws + WS_H), (const bf16_t*)(ws + WS_WFF2), MPROMPT, DM, DFF}; StaticOrder S; S.init(MPROMPT, DM, F.G, (int)blockIdx.x);
      EpiN<6> E{(const bf16_t*)(ws + WS_A5), (bf16_t*)(ws + WS_A7), DM, nullptr, nullptr, nullptr, nullptr, PS2, nullptr}; FeN<6> fe{E, nullptr, PSS2, nullptr};
      gemm_phase<EpiN<6>, StaticOrder, true, true>(F.lds + RING_OFF, g, S, E);
#if GEMM_TAIL == 7
      skinny_gemm<DFF>(F, SAMP(ws + WS_H, DFF), (const bf16*)(ws + WS_WFF2), DM, fe);
#endif
    }
#elif GEMM_TAIL == 4 || GEMM_TAIL == 44
    { Gemm g{(const bf16_t*)(ws + WS_GR), (const bf16_t*)(ws + WS_WUPR), 2 * MP, 2 * DM, DM}; PairOrder S; S.S0.init(MPROMPT, DM, F.G, (int)blockIdx.x);
      EpiUp E{AR, AH, (bf16_t*)(ws + WS_MB)};
      { Unit u0; S.S0.next(0, u0); head_tables_to_lds(F, ws, u0.pm); }
      gemm_phase<EpiUp, PairOrder, true, true>(F.lds + RING_OFF, g, S, E);
#if GEMM_TAIL == 4
      skinny_up_pair(F, SAMP(ws + WS_GG, DM), (const bf16*)(ws + WS_WUPH), SAMP(ws + WS_GR, DM), (const bf16*)(ws + WS_WUPR), AR, AH, (bf16_t*)(ws + WS_MB));
#endif
    }
#elif GEMM_TAIL == 6 || GEMM_TAIL == 66
    { Gemm g{(const bf16_t*)(ws + WS_A5), (const bf16_t*)(ws + WS_WFF1), MPROMPT, DFF, DM}; StaticOrder S; S.init(MPROMPT, DFF, F.G, (int)blockIdx.x);
      Unit u0; S.next(0, u0);
      EpiN<3> E{nullptr, (bf16_t*)(ws + WS_H), DFF, nullptr, nullptr, nullptr, nullptr, nullptr, PS1, (rstd_to_lds(F, PS1, u0.pm), 1)}; FeN<3> fe{E, nullptr, nullptr, PSS1};
      gemm_phase<EpiN<3>, StaticOrder, true, true>(F.lds + RING_OFF, g, S, E);
#if GEMM_TAIL == 6
      p_rows_to_bf16(F, args);
      skinny_gemm<DM>(F, SAMP(ws + WS_A5, DM), (const bf16*)(ws + WS_WFF1), DFF, fe);
#endif
    }
#elif GEMM_TAIL == 8
    { { Gemm g{(const bf16_t*)(ws + WS_A7), (const bf16_t*)(ws + WS_WGATE), MPROMPT, DM, DM}; StaticOrder S; S.init(MPROMPT, DM, F.G, (int)blockIdx.x);
          Unit u0; S.next(0, u0);
          EpiN<4> E{nullptr, (bf16_t*)(ws + WS_MB), DM, nullptr, nullptr, nullptr, nullptr, nullptr, PS2, (rstd_to_lds(F, PS2, u0.pm), 1)};
          gemm_phase<EpiN<4>, StaticOrder, true, true>(F.lds + RING_OFF, g, S, E);
          FeN<4> fe{E, nullptr, nullptr, PSS2}; skinny_gemm<DM>(F, SAMP(ws + WS_A7, DM), (const bf16*)(ws + WS_WGATE), DM, fe); }
        { Gemm g{(const bf16_t*)(ws + WS_PB), (const bf16_t*)(ws + WS_WPROJ), MPROMPT, DM, DPLE}; StaticOrder S; S.init(MPROMPT, DM, F.G, (int)blockIdx.x);
          EpiN<5> E{(const bf16_t*)(ws + WS_A7), (bf16_t*)(ws + WS_MB), DM, nullptr, nullptr, (float*)(ws + WS_Z6), nullptr, PS3, nullptr};
          gemm_phase<EpiN<5>, StaticOrder, true, true>(F.lds + RING_OFF, g, S, E);
          FeN<5> fe{E, nullptr, PSS3, nullptr}; skinny_gemm<DPLE>(F, SAMP(ws + WS_PB, DPLE), (const bf16*)(ws + WS_WPROJ), DM, fe); } }
#elif GEMM_TAIL == 9
    p9_final(F, args);
#elif GEMM_TAIL == 10
    p0_prologue<1>(F, args);
#elif GEMM_TAIL == 1
    xcd_barrier(bar);
#endif
#endif
#if PROBE_ON
    STAMP(9);
    if (blockIdx.x == 0 && tid_v == 0) { const unsigned t0_ = (unsigned)rt(); const unsigned dly_ = PW[1]; while ((unsigned)rt() - t0_ < dly_) __builtin_amdgcn_s_sleep(16); }
#endif
#undef IN
#undef SEAM
#undef tid_v
}

extern "C" void kernel_launch(void* const* d_in, const int* in_sizes, int n_in, void* d_out, int out_size, void* d_ws, size_t ws_size, hipStream_t stream) {
    static int grid = 0;
    if (grid == 0) {
        if (n_in != 21 || out_size != (int)OUT_TOTAL || ws_size < WS_END) { fprintf(stderr, "kernel_launch: unexpected problem (n_in %d out %d ws %zu need %zu)\n", n_in, out_size, ws_size, (size_t)WS_END); grid = -1; return; }
        int dev = 0, cus = 0;
        if (hipGetDevice(&dev) != hipSuccess || hipDeviceGetAttribute(&cus, hipDeviceAttributeMultiprocessorCount, dev) != hipSuccess) { grid = -1; return; }
        if (hipFuncSetAttribute((const void*)fwd_kernel, hipFuncAttributeMaxDynamicSharedMemorySize, LDS_BYTES) != hipSuccess) { fprintf(stderr, "kernel_launch: hipFuncSetAttribute failed\n"); grid = -1; return; }
        (void)hipGetLastError();
        if (cus < 256) { fprintf(stderr, "kernel_launch: this kernel needs 256 co-resident workgroups (one per CU); the device has %d CUs\n", cus); grid = -1; return; }
        grid = 256;
    }
    if (grid < 0) return;
    (void)hipMemsetAsync((char*)d_ws + WS_CTL, 0, CTL_ZERO_BYTES, stream);
    Args a{};
    for (int i = 0; i < 21; ++i) a.in[i] = (const float*)d_in[i];
    a.out = (float*)d_out; a.ws = (unsigned char*)d_ws;
#if MK_ONE_LAUNCH
    a.ph_lo = 0; a.ph_hi = NPH; a.use_bar = 1;
    hipLaunchKernelGGL(fwd_kernel, dim3(grid), dim3(NWAVES * 64), LDS_BYTES, stream, a);
#else
    for (int p = 0; p < NPH; ++p) { a.ph_lo = p; a.ph_hi = p + 1; a.use_bar = 0; hipLaunchKernelGGL(fwd_kernel, dim3(grid), dim3(NWAVES * 64), LDS_BYTES, stream, a); }
#endif
}
```

```cpp
#include <hip/hip_runtime.h>
#include <cstdio>
#include <cstdint>
#ifndef PROBE_ON
#define PROBE_ON 0
#endif
#define PROBE_UNIT 800ull
#ifndef PROBE_A
#define PROBE_A 0
#define PROBE_B 1
#define PROBE_C 2
#endif
#ifndef PROBE_E
#define PROBE_E -1
#endif
#ifndef PROBE_SKINNY
#define PROBE_SKINNY 0
#endif
namespace pg8 {
#define PG8_LAS __attribute__((address_space(3)))
typedef unsigned short bf16_t;
typedef short bf16x8 __attribute__((ext_vector_type(8)));
typedef float f32x4 __attribute__((ext_vector_type(4)));
typedef unsigned u32x4 __attribute__((ext_vector_type(4)));
constexpr int BM = 256, BK = 64, HALF = 128, HTB = HALF * BK * 2  , STAGE_BYTES = 8 * HTB, NXCD = 8, WGM = 8;

__host__ __device__ __forceinline__ int lds_byte(int r, int c) { const int st = (r >> 4) * 2 + (c >> 5), rr = r & 15, cc = c & 31, ob = rr * 64 + cc * 2; return st * 1024 + (ob ^ (((ob >> 9) & 1) << 5)); }
__host__ __device__ __forceinline__ void stage_rc(int b, int& R, int& C) { const int st = b / 1024, sb = b % 1024, swz = sb ^ (((sb >> 9) & 1) << 5); R = (st >> 1) * 16 + swz / 64; C = (st & 1) * 32 + (swz % 64) / 2; }
__host__ __device__ __forceinline__ int perm32(int rho) { const int n = rho >> 4, i = rho & 15; return 8 * (i >> 2) + 4 * n + (i & 3); }

struct Unit { int pm, pn; };
struct Gemm { const bf16_t* A; const bf16_t* Bt; int M, N, K; };

struct StaticOrder {
    int nM, nN, nwg, G, c;
    __host__ __device__ void init(int M, int N, int G_, int c_) { nM = M / BM; nN = N / BM; nwg = nM * nN; G = G_; c = c_; }
    __host__ __device__ __forceinline__ bool next(int i, Unit& u) const {
        const long L = (long)i * G + c; if (L >= nwg) return false;
        int wgid = (int)L; { const int q = nwg / NXCD, r = nwg % NXCD, xcd = wgid % NXCD, off = wgid / NXCD; wgid = (xcd < r ? xcd * (q + 1) : r * (q + 1) + (xcd - r) * q) + off; }
        const int nig = WGM * nN, gid = wgid / nig, fm = gid * WGM, gsz = (nM - fm) < WGM ? (nM - fm) : WGM;
        u.pm = fm + ((wgid % nig) % gsz); u.pn = (wgid % nig) / gsz; return true;
    }
    __device__ __forceinline__ void a_ready(const Unit&) const {}
    __device__ __forceinline__ void done(const Unit&) const {}
};

typedef float pg8_f32x2_t __attribute__((ext_vector_type(2))); typedef __bf16 pg8_bf16x2_t __attribute__((ext_vector_type(2)));
__device__ __forceinline__ unsigned cvt_pk_bf16(float lo, float hi) { pg8_f32x2_t v = {lo, hi}; pg8_bf16x2_t b = __builtin_convertvector(v, pg8_bf16x2_t); return __builtin_bit_cast(unsigned, b); }

template <class Epi, class Sched, bool ALIGN_EPI = false, bool SP2 = false>
__device__ __forceinline__ void gemm_phase(PG8_LAS unsigned char* lds, const Gemm g, const Sched& S, const Epi& E) {
    const int tid = threadIdx.x, wid = __builtin_amdgcn_readfirstlane(tid >> 6), lane = tid & 63, wr = wid >> 2, wc = wid & 3, fr = lane & 15, fq = lane >> 4;
    const int K = g.K, nt = K / BK;
    unsigned voffA[2], voffB[2];
#pragma unroll
    for (int i = 0; i < 2; ++i) { int R, C; stage_rc(tid * 16 + i * 8192, R, C); const int Rb = Epi::PERM ? ((R & ~31) + perm32(R & 31)) : R;
        voffA[i] = (unsigned)(R * K + C) * 2u; voffB[i] = (unsigned)(Rb * K + C) * 2u; }
    const size_t kstep = (size_t)(BK * 2);
    const size_t hstep = (size_t)HALF * K * 2;
    const size_t tstep = 2 * hstep;
    const unsigned ldsw = (unsigned)wid * 1024u;
    const int aoff = lds_byte(wr * 64 + fr, fq * 8), boff = lds_byte(wc * 32 + fr, fq * 8);
#define PG8_SA(b, h) (((b) * 2 + (h)) * HTB)
#define PG8_SB(b, h) ((4 + (b) * 2 + (h)) * HTB)
#define PG8_STAGE(bufoff, gbase, voff) do { _Pragma("unroll") for (int _i = 0; _i < 2; ++_i) \
        __builtin_amdgcn_global_load_lds((const unsigned*)((const char*)(gbase) + (voff)[_i]), (PG8_LAS unsigned*)(lds + (bufoff) + ldsw + _i * 8192), 16, 0, 0); } while (0)
#define PG8_LDA(dst, b, h) do { _Pragma("unroll") for (int m = 0; m < 4; ++m) _Pragma("unroll") for (int k = 0; k < 2; ++k) dst[m][k] = *(const PG8_LAS bf16x8*)(lds + PG8_SA(b, h) + aoff + m * 2048 + k * 1024); } while (0)
#define PG8_LDB(dst, b, h) do { _Pragma("unroll") for (int n = 0; n < 2; ++n) _Pragma("unroll") for (int k = 0; k < 2; ++k) dst[n][k] = *(const PG8_LAS bf16x8*)(lds + PG8_SB(b, h) + boff + n * 2048 + k * 1024); } while (0)
#define PG8_MMA(ai, bj, At, Bt) do { __builtin_amdgcn_s_setprio(1); _Pragma("unroll") for (int m = 0; m < 4; ++m) _Pragma("unroll") for (int n = 0; n < 2; ++n) _Pragma("unroll") for (int k = 0; k < 2; ++k) \
        acc[ai][bj][m][n] = __builtin_amdgcn_mfma_f32_16x16x32_bf16(Bt[n][k], At[m][k], acc[ai][bj][m][n], 0, 0, 0); __builtin_amdgcn_s_setprio(0); } while (0)
#define PG8_WAIT_V(n) asm volatile("s_waitcnt vmcnt(" #n ")" ::: "memory")
#define PG8_WAIT_L(n) asm volatile("s_waitcnt lgkmcnt(" #n ")" ::: "memory")
#define PG8_BAR __builtin_amdgcn_s_barrier()
#define PG8_SCHED __builtin_amdgcn_sched_barrier(0)
    Unit cur, nxt; int ui = 0;
    if (!S.next(0, cur)) return;
    f32x4 acc[2][2][4][2];
#pragma unroll
    for (int a = 0; a < 2; ++a)
#pragma unroll
        for (int b = 0; b < 2; ++b)
#pragma unroll
            for (int m = 0; m < 4; ++m)
#pragma unroll
                for (int n = 0; n < 2; ++n) acc[a][b][m][n] = (f32x4){0.f, 0.f, 0.f, 0.f};
    bf16x8 At[4][2], B0[2][2], B1[2][2];
    const char* cA = (const char*)g.A + (size_t)cur.pm * tstep; const char* cB = (const char*)g.Bt + (size_t)cur.pn * tstep;
    S.a_ready(cur);
    if constexpr (SP2) {
        PG8_STAGE(PG8_SB(0, 0), cB, voffB); PG8_STAGE(PG8_SB(0, 1), cB + hstep, voffB); PG8_STAGE(PG8_SA(0, 0), cA, voffA); PG8_STAGE(PG8_SA(0, 1), cA + hstep, voffA);
        if (wr == 1) PG8_BAR;
        PG8_WAIT_V(2); PG8_BAR;
        PG8_STAGE(PG8_SB(1, 0), cB + kstep, voffB); PG8_STAGE(PG8_SA(1, 0), cA + kstep, voffA); PG8_STAGE(PG8_SB(1, 1), cB + hstep + kstep, voffB);
        PG8_WAIT_V(6); PG8_BAR;
    } else {
        PG8_STAGE(PG8_SB(0, 0), cB, voffB); PG8_STAGE(PG8_SA(0, 0), cA, voffA); PG8_STAGE(PG8_SB(0, 1), cB + hstep, voffB); PG8_STAGE(PG8_SA(0, 1), cA + hstep, voffA);
        if (wr == 1) PG8_BAR;
        PG8_WAIT_V(4); PG8_BAR;
        PG8_STAGE(PG8_SB(1, 0), cB + kstep, voffB); PG8_STAGE(PG8_SA(1, 0), cA + kstep, voffA); PG8_STAGE(PG8_SB(1, 1), cB + hstep + kstep, voffB);
        PG8_WAIT_V(6); PG8_BAR;
    }
    for (;;) {
        const bool has_next = S.next(ui + 1, nxt);
        const char* nA = has_next ? (const char*)g.A + (size_t)nxt.pm * tstep : cA; const char* nB = has_next ? (const char*)g.Bt + (size_t)nxt.pn * tstep : cB;
        for (int t = 0; t < nt; t += 2) {
            const bool last = (t == nt - 2);
            const char* a1 = cA + (size_t)(t + 1) * kstep;
            const char* a2 = last ? nA : cA + (size_t)(t + 2) * kstep; const char* b2 = last ? nB : cB + (size_t)(t + 2) * kstep;
            const char* a3 = a2 + kstep; const char* b3 = b2 + kstep;
            if (last && has_next) S.a_ready(nxt);
            if constexpr (SP2) {
            PG8_LDB(B0, 0, 0); PG8_LDB(B1, 0, 1); PG8_SCHED; PG8_LDA(At, 0, 0); PG8_STAGE(PG8_SA(1, 1), a1 + hstep, voffA);
            PG8_WAIT_V(8); PG8_WAIT_L(0); PG8_BAR; PG8_MMA(0, 0, At, B0); PG8_MMA(0, 1, At, B1); PG8_BAR; PG8_SCHED;
            PG8_LDA(At, 0, 1); PG8_STAGE(PG8_SB(0, 0), b2, voffB); PG8_STAGE(PG8_SB(0, 1), b2 + hstep, voffB); PG8_STAGE(PG8_SA(0, 0), a2, voffA);
            PG8_WAIT_V(8); PG8_WAIT_L(0); PG8_BAR; PG8_MMA(1, 0, At, B0); PG8_MMA(1, 1, At, B1); PG8_BAR; PG8_SCHED;
            PG8_LDB(B0, 1, 0); PG8_LDB(B1, 1, 1); PG8_SCHED; PG8_LDA(At, 1, 0); PG8_STAGE(PG8_SA(0, 1), a2 + hstep, voffA);
            PG8_WAIT_V(8); PG8_WAIT_L(0); PG8_BAR; PG8_MMA(0, 0, At, B0); PG8_MMA(0, 1, At, B1); PG8_BAR; PG8_SCHED;
            PG8_LDA(At, 1, 1); PG8_STAGE(PG8_SB(1, 0), b3, voffB); PG8_STAGE(PG8_SB(1, 1), b3 + hstep, voffB); PG8_STAGE(PG8_SA(1, 0), a3, voffA);
            PG8_WAIT_V(8); PG8_WAIT_L(0); PG8_BAR; PG8_MMA(1, 0, At, B0); PG8_MMA(1, 1, At, B1); PG8_BAR; PG8_SCHED;
            E.khook(acc, cur, t, wr, fr);
            } else {
            PG8_LDB(B0, 0, 0); PG8_SCHED; PG8_LDA(At, 0, 0); PG8_STAGE(PG8_SA(1, 1), a1 + hstep, voffA);
            PG8_WAIT_L(8); PG8_BAR; PG8_WAIT_L(0); PG8_MMA(0, 0, At, B0); PG8_BAR; PG8_SCHED;
            PG8_LDB(B1, 0, 1); PG8_STAGE(PG8_SB(0, 0), b2, voffB);
            PG8_BAR; PG8_WAIT_L(0); PG8_MMA(0, 1, At, B1); PG8_BAR;
            PG8_LDA(At, 0, 1); PG8_STAGE(PG8_SA(0, 0), a2, voffA);
            PG8_BAR; PG8_WAIT_L(0); PG8_MMA(1, 0, At, B0); PG8_BAR; PG8_SCHED;
            PG8_STAGE(PG8_SB(0, 1), b2 + hstep, voffB);
            PG8_WAIT_V(6); PG8_BAR; PG8_MMA(1, 1, At, B1); PG8_BAR;
            PG8_LDB(B0, 1, 0); PG8_SCHED; PG8_LDA(At, 1, 0); PG8_STAGE(PG8_SA(0, 1), a2 + hstep, voffA);
            PG8_WAIT_L(8); PG8_BAR; PG8_WAIT_L(0); PG8_MMA(0, 0, At, B0); PG8_BAR; PG8_SCHED;
            PG8_LDB(B1, 1, 1); PG8_STAGE(PG8_SB(1, 0), b3, voffB);
            PG8_BAR; PG8_WAIT_L(0); PG8_MMA(0, 1, At, B1); PG8_BAR;
            PG8_LDA(At, 1, 1); PG8_STAGE(PG8_SA(1, 0), a3, voffA);
            PG8_BAR; PG8_WAIT_L(0); PG8_MMA(1, 0, At, B0); PG8_BAR; PG8_SCHED;
            PG8_STAGE(PG8_SB(1, 1), b3 + hstep, voffB);
            PG8_WAIT_V(6); PG8_BAR; PG8_MMA(1, 1, At, B1); PG8_BAR;
            }
        }
        if constexpr (ALIGN_EPI) { if (wr == 0) PG8_BAR; }
#if PROBE_ON && !PROBE_SKINNY
        const unsigned pe0_ = (unsigned)__builtin_amdgcn_s_memrealtime();
#endif
        if constexpr (!Epi::AFTER_DRAIN) { E(acc, cur, wr, wc, fr, fq); S.done(cur); }
#if PROBE_ON && !PROBE_SKINNY
        if (threadIdx.x == 0) { *(volatile PG8_LAS unsigned*)(lds + 131072 + 320 + 4 * 18) += (unsigned)__builtin_amdgcn_s_memrealtime() - pe0_; }
#endif
        if (!has_next) break;
        if (!E.keep_acc(cur))
#pragma unroll
        for (int a = 0; a < 2; ++a)
#pragma unroll
            for (int b = 0; b < 2; ++b)
#pragma unroll
                for (int m = 0; m < 4; ++m)
#pragma unroll
                    for (int n = 0; n < 2; ++n) acc[a][b][m][n] = (f32x4){0.f, 0.f, 0.f, 0.f};
        cur = nxt; cA = nA; cB = nB; ++ui;
        if constexpr (ALIGN_EPI) { if (wr == 1) PG8_BAR; }
    }
    PG8_WAIT_V(0);
    if constexpr (!ALIGN_EPI) { if (wr == 0) PG8_BAR; }
    PG8_BAR;
    if constexpr (Epi::AFTER_DRAIN) { E.fused(acc, cur, wr, wc, fr, fq, lds, wid, lane); S.done(cur); }
#undef PG8_SA
#undef PG8_SB
#undef PG8_STAGE
#undef PG8_LDA
#undef PG8_LDB
#undef PG8_MMA
#undef PG8_WAIT_V
#undef PG8_WAIT_L
#undef PG8_BAR
#undef PG8_SCHED
}
}


constexpr int DM = 1024, NB = 8, SEQ = 2048, NDEC = 128, MPROMPT = NB * SEQ, MTOT = MPROMPT + NDEC, MP = 16640  ;
constexpr int HR = 4, DKR = 128, DVR = 256, HG = 8, DKG = 128, DVG = 128, DFF = 4096, DPLE = 256, DIN = 9216, CH = 64, NCHUNK = MPROMPT / CH;
constexpr float EPS = 1e-6f;
constexpr size_t OFF_Y = 0, OFF_RETP = (size_t)MTOT * DM, OFF_HGP = OFF_RETP + (size_t)NB * HR * DKR * DVR, OFF_RETS = OFF_HGP + (size_t)NB * HG * DKG * DVG,
                 OFF_HGS = OFF_RETS + (size_t)NDEC * HR * DKR * DVR, OUT_TOTAL = OFF_HGS + (size_t)NDEC * HG * DKG * DVG;
static_assert(OUT_TOTAL == 52559872, "output size");


constexpr int NWAVES = 8;
constexpr int NPH = 10;
#ifndef MK_ONE_LAUNCH
#define MK_ONE_LAUNCH 1
#endif

constexpr size_t MiB = 1u << 20;
constexpr size_t WS_CTL = 0, CTL_ZERO_BYTES = 65536;
constexpr size_t WS_WIN = 1 * MiB;
constexpr size_t WS_WUPR = WS_WIN + (size_t)DIN * DM * 2;
constexpr size_t WS_WUPH = WS_WUPR + (size_t)DM * DM * 2;
constexpr size_t WS_WO = WS_WUPH + (size_t)DM * DM * 2;
constexpr size_t WS_WFF1 = WS_WO + (size_t)DM * DM * 2;
constexpr size_t WS_WFF2 = WS_WFF1 + (size_t)DFF * DM * 2;
constexpr size_t WS_WGATE = WS_WFF2 + (size_t)DFF * DM * 2;
constexpr size_t WS_WPROJ = WS_WGATE + (size_t)DM * DM * 2;
constexpr size_t WS_Z6 = WS_WPROJ + (size_t)DM * DPLE * 2;
constexpr size_t Z_QR = WS_Z6, Z_KR = Z_QR + (size_t)MP * 512 * 2, Z_VR = Z_KR + (size_t)MP * 512 * 2, Z_QG = Z_VR + (size_t)MP * DM * 2, Z_KG = Z_QG + (size_t)MP * DM * 2,
                 Z_VG = Z_KG + (size_t)MP * DM * 2, Z_END = Z_VG + (size_t)MP * DM * 2;
constexpr size_t WS_H = WS_Z6, WS_MB = WS_Z6 + (size_t)MP * DFF * 2;
static_assert(WS_MB == Z_VG, "MB overlays VG exactly");
constexpr size_t WS_GR = Z_END, WS_GG = WS_GR + (size_t)MP * DM * 2, WS_A5 = WS_GR, WS_A7 = WS_GG;
constexpr size_t WS_PB = WS_GG + (size_t)MP * DM * 2;
constexpr size_t WS_CS = WS_PB + (size_t)MP * DPLE * 2;
constexpr size_t WS_GL = WS_CS + (size_t)2049 * 64 * 8;
constexpr size_t WS_FS = WS_GL + (size_t)NCHUNK * DM * 4;
constexpr size_t WS_RSTD0 = WS_FS + (size_t)NDEC * DM * 4;
constexpr size_t WS_LB = WS_RSTD0 + (size_t)MP * 4;
constexpr size_t WS_PS1 = WS_LB + 4096, WS_PS2 = WS_PS1 + (size_t)MP * 64, WS_PS3 = WS_PS2 + (size_t)MP * 64, WS_PSS1 = WS_PS3 + (size_t)MP * 64, WS_PSS2 = WS_PSS1 + (size_t)NDEC * 256, WS_PSS3 = WS_PSS2 + (size_t)NDEC * 256,
                 WS_PSQR = WS_PSS3 + (size_t)NDEC * 256, WS_PSQG = WS_PSQR + (size_t)MP * 128, WS_END = WS_PSQG + (size_t)MP * 128;
static_assert(WS_END <= 307920896, "d_ws map must fit sum(inputs) bytes");
static_assert(WS_WIN % 256 == 0 && WS_Z6 % 256 == 0 && WS_GR % 256 == 0 && WS_PB % 256 == 0 && WS_CS % 16 == 0 && WS_GL % 16 == 0 && WS_PS1 % 16 == 0, "alignment");
constexpr int CW_TMO = 0, CW_SAMP = 8192  , CW_BAR = 4096;

constexpr int RING_OFF = 0, RING_BYTES = 131072;
constexpr int LDSCTL_OFF = RING_BYTES, MISC_OFF = LDSCTL_OFF + 320;
constexpr int LDS_BYTES = 147456;
constexpr int RSTD_LDS_OFF = RING_BYTES + 1024;
constexpr int HT_LDS_OFF = RING_BYTES + 1024;


namespace pg8 {
typedef unsigned u32x2 __attribute__((ext_vector_type(2)));
typedef float f32x2 __attribute__((ext_vector_type(2)));
__device__ __forceinline__ float bf2f(unsigned short b) { return __uint_as_float((unsigned)b << 16); }
__device__ __forceinline__ float bflo(unsigned w) { return __uint_as_float(w << 16); }
__device__ __forceinline__ float bfhi(unsigned w) { return __uint_as_float(w & 0xffff0000u); }
__device__ __forceinline__ float sigmoidf_(float x) { return __builtin_amdgcn_rcpf(1.0f + __expf(-x)); }
__device__ __forceinline__ float siluf_(float x) { return x * __builtin_amdgcn_rcpf(1.0f + __expf(-x)); }
__device__ __forceinline__ u32x2 pack4(f32x4 v) { u32x2 w; w.x = cvt_pk_bf16(v[0], v[1]); w.y = cvt_pk_bf16(v[2], v[3]); return w; }
__device__ __forceinline__ f32x4 unpack4(u32x2 w) { return (f32x4){bflo(w.x), bfhi(w.x), bflo(w.y), bfhi(w.y)}; }

typedef unsigned u32x4 __attribute__((ext_vector_type(4)));
#define DPP_ROW_SHR(x, n) __int_as_float(__builtin_amdgcn_update_dpp(0, __float_as_int(x), 0x110 + (n), 0xf, 0xf, true))
#define DPP_ROW_SHR1(x, n) __int_as_float(__builtin_amdgcn_update_dpp(0x3f800000, __float_as_int(x), 0x110 + (n), 0xf, 0xf, false))
#define DPP_ROW_BCAST15(x) __int_as_float(__builtin_amdgcn_update_dpp(0, __float_as_int(x), 0x15F, 0xf, 0xf, false))
struct EpiIn {
    static constexpr bool PERM = true, AFTER_DRAIN = false;
    const float* rstd0; const float* cs; const float* lb;
    bf16_t *QR, *KR, *VR, *GR, *QG, *KG, *VG, *GG, *AR, *AH; float *GL, *FS; unsigned char* wsb; unsigned char* outb;
    __device__ __forceinline__ bool keep_acc(const Unit&) const { return false; }
    __device__ __forceinline__ void khook(f32x4 (&)[2][2][4][2], const Unit&, int, int, int) const {}
    __device__ __forceinline__ void operator()(const f32x4 (&acc)[2][2][4][2], const Unit& u, int wr, int wc, int fr, int fq) const {
        const int pn = u.pn;
#pragma unroll
        for (int ai = 0; ai < 2; ++ai) {
            const int rbase = u.pm * BM + ai * HALF + wr * 64;
            float rs[4];
#pragma unroll
            for (int m = 0; m < 4; ++m) rs[m] = ((const PG8_LAS float*)(unsigned long)RSTD_LDS_OFF)[ai * HALF + wr * 64 + m * 16 + fr];
            if (pn < 4) {
                const bool isk = pn >= 2; bf16_t* dst = isk ? KR : QR;
#pragma unroll
                for (int bj = 0; bj < 2; ++bj) {
                    const int head = 2 * (pn & 1) + bj;
                    const float lg = __logf(1.0f - exp2f(-5.0f - (float)head));
                    const int j0 = 16 * wc + 4 * fq;
#pragma unroll
                    for (int m = 0; m < 4; ++m) {
                        const int row = rbase + m * 16 + fr; const int pidx = row & (SEQ - 1);
                        const float e = lg * (float)(m * 16 + fr + 1);
                        const float sc = rs[m] * (isk ? 0.08838834764831845f * __expf(-e) : __expf(e));
                        const f32x4 t0 = *(const f32x4*)(cs + ((size_t)pidx * 64 + j0) * 2), t1 = *(const f32x4*)(cs + ((size_t)pidx * 64 + j0 + 2) * 2);
                        const f32x4 v0 = acc[ai][bj][m][0] * sc, v1 = acc[ai][bj][m][1] * sc;
                        u32x2 o1, o2;
                        o1.x = cvt_pk_bf16(v0[0] * t0[0] - v0[1] * t0[1], v0[2] * t0[2] - v0[3] * t0[3]); o1.y = cvt_pk_bf16(v1[0] * t1[0] - v1[1] * t1[1], v1[2] * t1[2] - v1[3] * t1[3]);
                        o2.x = cvt_pk_bf16(v0[0] * t0[1] + v0[1] * t0[0], v0[2] * t0[3] + v0[3] * t0[2]); o2.y = cvt_pk_bf16(v1[0] * t1[1] + v1[1] * t1[0], v1[2] * t1[3] + v1[3] * t1[2]);
                        bf16_t* p = dst + (size_t)row * 512 + head * 128 + j0;
                        *(u32x2*)p = o1; *(u32x2*)(p + 64) = o2;
                    }
                }
            } else if (pn >= 12 && pn < 20) {
                const int head = pn - 12;
#pragma unroll
                for (int bj = 0; bj < 2; ++bj) {
                    const int j0 = 64 * bj + 16 * wc + 4 * fq, c = head * 128 + j0;
                    const f32x4 lbv = *(const f32x4*)(lb + c);
                    float qa[4][4], ka[4][4], ba[4][4];
#pragma unroll
                    for (int q = 0; q < 4; ++q) {
                        const int n = q >> 1, e = q & 1; const float one_m_lb = 1.0f - lbv[q]; float carry = 1.f;
#pragma unroll
                        for (int m = 0; m < 4; ++m) {
                            const float vq = acc[ai][bj][m][n][2 * e] * rs[m], vf = acc[ai][bj][m][n][2 * e + 1] * rs[m];
                            const float kk = one_m_lb * __builtin_amdgcn_rcpf(1.0f + __expf(vf));
                            float x = 1.0f - kk;
                            x *= DPP_ROW_SHR1(x, 1); x *= DPP_ROW_SHR1(x, 2); x *= DPP_ROW_SHR1(x, 4); x *= DPP_ROW_SHR1(x, 8);
                            x *= carry; carry = DPP_ROW_BCAST15(x);
                            qa[m][q] = siluf_(vq); ka[m][q] = kk; ba[m][q] = x;
                        }
                    }
#pragma unroll
                    for (int m = 0; m < 4; ++m) {
                        const int row = rbase + m * 16 + fr;
                        const float e0 = ba[m][0], e1 = ba[m][1], e2 = ba[m][2], e3 = ba[m][3];
                        u32x2 qw, kw;
                        qw.x = cvt_pk_bf16(qa[m][0] * e0, qa[m][1] * e1); qw.y = cvt_pk_bf16(qa[m][2] * e2, qa[m][3] * e3);
                        kw.x = cvt_pk_bf16(ka[m][0] * __builtin_amdgcn_rcpf(e0), ka[m][1] * __builtin_amdgcn_rcpf(e1)); kw.y = cvt_pk_bf16(ka[m][2] * __builtin_amdgcn_rcpf(e2), ka[m][3] * __builtin_amdgcn_rcpf(e3));
                        *(u32x2*)(QG + (size_t)row * DM + c) = qw; *(u32x2*)(KG + (size_t)row * DM + c) = kw;
                        if (m == 3 && fr == 15) *(f32x4*)(GL + (size_t)(row >> 6) * DM + c) = (f32x4){e0, e1, e2, e3};
                    }
                }
            } else if (pn >= 28) {
#pragma unroll
                for (int bj = 0; bj < 2; ++bj) {
                    const int c = (pn - 28) * 128 + 64 * bj + 16 * wc + 4 * fq;
#pragma unroll
                    for (int m = 0; m < 4; ++m) {
                        const int row = rbase + m * 16 + fr; float sr[4], rho[4];
#pragma unroll
                        for (int q = 0; q < 4; ++q) { const int n = q >> 1, e = q & 1;
                            const float er = 1.0f + __expf(fminf(-acc[ai][bj][m][n][2 * e] * rs[m], 40.f)), eg = 1.0f + __expf(fminf(-acc[ai][bj][m][n][2 * e + 1] * rs[m], 40.f));
                            sr[q] = __builtin_amdgcn_rcpf(er); rho[q] = er * __builtin_amdgcn_rcpf(eg); }
                        u32x2 a, h; a.x = cvt_pk_bf16(sr[0], sr[1]); a.y = cvt_pk_bf16(sr[2], sr[3]); h.x = cvt_pk_bf16(rho[0], rho[1]); h.y = cvt_pk_bf16(rho[2], rho[3]);
                        *(u32x2*)(AR + (size_t)row * DM + c) = a; *(u32x2*)(AH + (size_t)row * DM + c) = h;
                    }
                }
            } else {
                const int mode = 0, cbase = (pn & 3) * BM;
                const size_t boff = pn < 8 ? Z_VR : pn < 12 ? WS_GR : pn < 24 ? Z_VG : WS_GG;
                bf16_t* dst = (bf16_t*)(wsb + boff);
#pragma unroll
                for (int m = 0; m < 4; ++m) {
                    const int row = rbase + m * 16 + fr;
#pragma unroll
                    for (int bj = 0; bj < 2; ++bj) {
                        f32x4 v0 = acc[ai][bj][m][0] * rs[m], v1 = acc[ai][bj][m][1] * rs[m];
                        if (mode == 1) { v0[0] = siluf_(v0[0]); v0[1] = siluf_(v0[1]); v0[2] = siluf_(v0[2]); v0[3] = siluf_(v0[3]); v1[0] = siluf_(v1[0]); v1[1] = siluf_(v1[1]); v1[2] = siluf_(v1[2]); v1[3] = siluf_(v1[3]); }
                        else if (mode == 2) { v0[0] = sigmoidf_(v0[0]); v0[1] = sigmoidf_(v0[1]); v0[2] = sigmoidf_(v0[2]); v0[3] = sigmoidf_(v0[3]); v1[0] = sigmoidf_(v1[0]); v1[1] = sigmoidf_(v1[1]); v1[2] = sigmoidf_(v1[2]); v1[3] = sigmoidf_(v1[3]); }
                        const u32x2 a = pack4(v0), b = pack4(v1);
                        *(u32x4*)(dst + (size_t)row * DM + cbase + bj * HALF + wc * 32 + fq * 8) = (u32x4){a.x, a.y, b.x, b.y};
                    }
                }
            }
        }
    }
};

__device__ __forceinline__ void unpack8(u32x4 w, f32x4& a, f32x4& b) { a = (f32x4){bflo(w.x), bfhi(w.x), bflo(w.y), bfhi(w.y)}; b = (f32x4){bflo(w.z), bfhi(w.z), bflo(w.w), bfhi(w.w)}; }
__device__ __forceinline__ u32x4 pack8(f32x4 a, f32x4 b) { const u32x2 x = pack4(a), y = pack4(b); return (u32x4){x.x, x.y, y.x, y.y}; }
__device__ __forceinline__ float sumsq4(f32x4 r) { return (r[0] * r[0] + r[1] * r[1]) + (r[2] * r[2] + r[3] * r[3]); }
template <int MODE> struct EpiN {
    static constexpr bool PERM = true, AFTER_DRAIN = false;
    const bf16_t* gate; bf16_t* out16; int ld16; const float* xp; const float* xs; float* R; const float* g; float* PS; const float* PSin;
    int use_rl;
    __device__ __forceinline__ bool keep_acc(const Unit&) const { return false; }
    __device__ __forceinline__ void khook(f32x4 (&)[2][2][4][2], const Unit&, int, int, int) const {}
    __device__ __forceinline__ void operator()(const f32x4 (&acc)[2][2][4][2], const Unit& u, int wr, int wc, int fr, int fq) const {
#pragma unroll
        for (int ai = 0; ai < 2; ++ai) {
            const int rbase = u.pm * BM + ai * HALF + wr * 64;
#pragma unroll
            for (int m = 0; m < 4; ++m) {
                const int row = rbase + m * 16 + fr;
                float rstd = 1.f;
                if ((MODE == 3 || MODE == 4) && use_rl) rstd = ((const PG8_LAS float*)(unsigned long)RSTD_LDS_OFF)[ai * HALF + wr * 64 + m * 16 + fr];
                else if (MODE == 3 || MODE == 4) {
                    const f32x4* p = (const f32x4*)(PSin + (size_t)row * 16); const f32x4 a = p[0], b = p[1], c = p[2], d = p[3];
                    const float s = ((a[0] + a[1]) + (a[2] + a[3])) + ((b[0] + b[1]) + (b[2] + b[3])) + ((c[0] + c[1]) + (c[2] + c[3])) + ((d[0] + d[1]) + (d[2] + d[3]));
                    rstd = rsqrtf(s * (1.0f / 1024.0f) + EPS);
                }
                float ss = 0.f;
#pragma unroll
                for (int bj = 0; bj < 2; ++bj) {
                    const int col = u.pn * BM + bj * HALF + wc * 32 + fq * 8;
                    const f32x4 a0 = acc[ai][bj][m][0], a1 = acc[ai][bj][m][1];
                    if (MODE == 0) { f32x4 g0, g1; unpack8(*(const u32x4*)(gate + (size_t)row * DM + col), g0, g1); *(u32x4*)(out16 + (size_t)row * ld16 + col) = pack8(g0 * a0, g1 * a1); }
                    else if (MODE == 1) { f32x4 g0, g1, t0, t1; unpack8(*(const u32x4*)(gate + (size_t)row * DM + col), g0, g1); u32x4* o = (u32x4*)(out16 + (size_t)row * ld16 + col); unpack8(*o, t0, t1); *o = pack8(g0 * (t0 + a0), g1 * (t1 + a1)); }
                    else if (MODE == 2) {
                        const float* bp = xp + (size_t)row * DM + col;
                        const f32x4 r0 = __builtin_nontemporal_load((const f32x4*)bp) + a0, r1 = __builtin_nontemporal_load((const f32x4*)(bp + 4)) + a1;
                        ss += sumsq4(r0) + sumsq4(r1);
                        *(u32x4*)(out16 + (size_t)row * ld16 + col) = pack8(r0, r1);
                    }
                    else if (MODE == 6) {
                        f32x4 b0, b1; unpack8(*(const u32x4*)(gate + (size_t)row * DM + col), b0, b1);
                        const f32x4 r0 = b0 + a0, r1 = b1 + a1;
                        ss += sumsq4(r0) + sumsq4(r1);
                        *(u32x4*)(out16 + (size_t)row * ld16 + col) = pack8(r0, r1);
                    }
                    else if (MODE == 3) { f32x4 v0 = a0 * rstd, v1 = a1 * rstd;
                        v0[0] = fmaxf(v0[0], 0.f); v0[1] = fmaxf(v0[1], 0.f); v0[2] = fmaxf(v0[2], 0.f); v0[3] = fmaxf(v0[3], 0.f); v1[0] = fmaxf(v1[0], 0.f); v1[1] = fmaxf(v1[1], 0.f); v1[2] = fmaxf(v1[2], 0.f); v1[3] = fmaxf(v1[3], 0.f);
                        *(u32x4*)(out16 + (size_t)row * ld16 + col) = pack8(v0 * v0, v1 * v1); }
                    else if (MODE == 4) { f32x4 v0 = a0 * rstd, v1 = a1 * rstd;
                        v0[0] = sigmoidf_(v0[0]); v0[1] = sigmoidf_(v0[1]); v0[2] = sigmoidf_(v0[2]); v0[3] = sigmoidf_(v0[3]); v1[0] = sigmoidf_(v1[0]); v1[1] = sigmoidf_(v1[1]); v1[2] = sigmoidf_(v1[2]); v1[3] = sigmoidf_(v1[3]);
                        *(u32x4*)(out16 + (size_t)row * ld16 + col) = pack8(v0, v1); }
                    else if (MODE == 5) { f32x4 t0, t1, b0, b1; unpack8(*(const u32x4*)(out16 + (size_t)row * ld16 + col), t0, t1); unpack8(*(const u32x4*)(gate + (size_t)row * DM + col), b0, b1);
                        const f32x4 r0 = b0 + t0 * a0, r1 = b1 + t1 * a1; *(u32x4*)((bf16_t*)R + (size_t)row * DM + col) = pack8(r0, r1); ss += sumsq4(r0) + sumsq4(r1); }
                }
                if (MODE == 2 || MODE == 5 || MODE == 6) { ss += __shfl_xor(ss, 16); ss += __shfl_xor(ss, 32); if (fq == 0) PS[(size_t)row * 16 + u.pn * 4 + wc] = ss; }
            }
        }
    }
};

__device__ __forceinline__ void samp_in(const EpiIn& E, int row, int pcol, f32x4 v) {
    const float rs = E.rstd0[row]; const int pn = __builtin_amdgcn_readfirstlane(pcol >> 8), p = pcol & 255;
    if (pn < 4) {
        const bool isk = pn >= 2; bf16_t* dst = isk ? E.KR : E.QR; const int head = 2 * (pn & 1) + (p >> 7), j = (p & 127) >> 1;
        const f32x4 t = *(const f32x4*)(E.cs + ((size_t)SEQ * 64 + j) * 2);
        v = v * (rs * (isk ? 0.08838834764831845f : 1.0f));
        const float o1a = v[0] * t[0] - v[1] * t[1], o2a = v[0] * t[1] + v[1] * t[0], o1b = v[2] * t[2] - v[3] * t[3], o2b = v[2] * t[3] + v[3] * t[2];
        bf16_t* q = dst + (size_t)row * 512 + head * 128 + j;
        *(unsigned*)q = cvt_pk_bf16(o1a, o1b); *(unsigned*)(q + 64) = cvt_pk_bf16(o2a, o2b);
    } else if (pn >= 12 && pn < 20) {
        const int c = (pn - 12) * 128 + (p >> 1);
        const float k0 = (1.0f - E.lb[c]) * __builtin_amdgcn_rcpf(1.0f + __expf(v[1] * rs)), k1 = (1.0f - E.lb[c + 1]) * __builtin_amdgcn_rcpf(1.0f + __expf(v[3] * rs));
        *(unsigned*)(E.QG + (size_t)row * DM + c) = cvt_pk_bf16(siluf_(v[0] * rs), siluf_(v[2] * rs));
        *(unsigned*)(E.KG + (size_t)row * DM + c) = cvt_pk_bf16(k0, k1);
        *(f32x2*)(E.FS + (size_t)(row - MPROMPT) * DM + c) = (f32x2){1.0f - k0, 1.0f - k1};
    } else if (pn >= 28) {
        const int c = (pn - 28) * 128 + (p >> 1);
        const float er0 = 1.0f + __expf(fminf(-v[0] * rs, 40.f)), eg0 = 1.0f + __expf(fminf(-v[1] * rs, 40.f)), er1 = 1.0f + __expf(fminf(-v[2] * rs, 40.f)), eg1 = 1.0f + __expf(fminf(-v[3] * rs, 40.f));
        *(unsigned*)(E.AR + (size_t)row * DM + c) = cvt_pk_bf16(__builtin_amdgcn_rcpf(er0), __builtin_amdgcn_rcpf(er1));
        *(unsigned*)(E.AH + (size_t)row * DM + c) = cvt_pk_bf16(er0 * __builtin_amdgcn_rcpf(eg0), er1 * __builtin_amdgcn_rcpf(eg1));
    } else {
        v = v * rs;
        const size_t boff = pn < 8 ? Z_VR : pn < 12 ? WS_GR : pn < 24 ? Z_VG : WS_GG;
        bf16_t* dst = (bf16_t*)(E.wsb + boff);
        *(u32x2*)(dst + (size_t)row * DM + (pn & 3) * BM + p) = pack4(v);
    }
}
template <int MODE> __device__ __forceinline__ void samp_n(const EpiN<MODE>& E, const float* xs, float* PSS, const float* PSSin, int row, int col, f32x4 a) {
    const int rs_ = row - MPROMPT; float rstd = 1.f;
    if (MODE == 3 || MODE == 4) { const f32x4* p = (const f32x4*)(PSSin + (size_t)rs_ * 64); float s = 0.f;
#pragma unroll
        for (int i = 0; i < 16; ++i) { const f32x4 q = p[i]; s += (q[0] + q[1]) + (q[2] + q[3]); }
        rstd = rsqrtf(s * (1.0f / 1024.0f) + EPS); }
    float ss = 0.f;
    if (MODE == 0) { const f32x4 gt = unpack4(*(const u32x2*)(E.gate + (size_t)row * DM + col)); *(u32x2*)(E.out16 + (size_t)row * E.ld16 + col) = pack4(gt * a); }
    else if (MODE == 1) { const f32x4 gt = unpack4(*(const u32x2*)(E.gate + (size_t)row * DM + col)); u32x2* o = (u32x2*)(E.out16 + (size_t)row * E.ld16 + col); const f32x4 t = unpack4(*o); *o = pack4(gt * (t + a)); }
    else if (MODE == 2) { const f32x4 r = *(const f32x4*)(xs + (size_t)rs_ * DM + col) + a; ss = sumsq4(r); *(u32x2*)(E.out16 + (size_t)row * E.ld16 + col) = pack4(r); }
    else if (MODE == 6) { const f32x4 r = unpack4(*(const u32x2*)(E.gate + (size_t)row * DM + col)) + a; ss = sumsq4(r); *(u32x2*)(E.out16 + (size_t)row * E.ld16 + col) = pack4(r); }
    else if (MODE == 3) { f32x4 v = a * rstd; v[0] = fmaxf(v[0], 0.f); v[1] = fmaxf(v[1], 0.f); v[2] = fmaxf(v[2], 0.f); v[3] = fmaxf(v[3], 0.f); *(u32x2*)(E.out16 + (size_t)row * E.ld16 + col) = pack4(v * v); }
    else if (MODE == 4) { f32x4 v = a * rstd; v[0] = sigmoidf_(v[0]); v[1] = sigmoidf_(v[1]); v[2] = sigmoidf_(v[2]); v[3] = sigmoidf_(v[3]); *(u32x2*)(E.out16 + (size_t)row * E.ld16 + col) = pack4(v); }
    else if (MODE == 5) { const f32x4 t = unpack4(*(const u32x2*)(E.out16 + (size_t)row * E.ld16 + col)), b = unpack4(*(const u32x2*)(E.gate + (size_t)row * DM + col));
        const f32x4 r = b + t * a; *(u32x2*)((bf16_t*)E.R + (size_t)row * DM + col) = pack4(r); ss = sumsq4(r); }
    if (MODE == 2 || MODE == 5 || MODE == 6) { ss += __shfl_xor(ss, 16); ss += __shfl_xor(ss, 32); if ((threadIdx.x & 63) < 16) PSS[(size_t)rs_ * 64 + (col >> 4)] = ss; }
}
}

#define GAS __attribute__((address_space(1)))
#define LAS __attribute__((address_space(3)))
typedef unsigned short bf16;
typedef unsigned v4u __attribute__((ext_vector_type(4)));
typedef float f32x4 __attribute__((ext_vector_type(4)));
typedef short bf16x8 __attribute__((ext_vector_type(8)));
typedef GAS unsigned gu32;
typedef GAS unsigned long long gu64;
#define RLX_AGENT __ATOMIC_RELAXED, __HIP_MEMORY_SCOPE_AGENT
#define LDS_WAIT() asm volatile("s_waitcnt lgkmcnt(0)" ::: "memory")
#define VM_WAIT() asm volatile("s_waitcnt vmcnt(0)" ::: "memory")
__device__ __forceinline__ unsigned long long rt() { return __builtin_amdgcn_s_memrealtime(); }
__device__ __forceinline__ unsigned f2bf(float f) { unsigned u = __builtin_bit_cast(unsigned, f); return (u + 0x7fffu + ((u >> 16) & 1u)) >> 16; }
__device__ __forceinline__ unsigned pk2(float lo, float hi) { return f2bf(lo) | (f2bf(hi) << 16); }

#define XB_TMO      128
#define XB_XCNT(j)  (256  + 64 * (j))
#define XB_XSUB(j)  (1280 + 64 * (j))
#define XB_XGEN(j)  (2304 + 64 * (j))
#define XB_TOP      3328
#define XB_TOPGEN   3392
#define XCD_BAR_WORDS 3456
#define XB_SPIN_CAP (1u << 18)

__device__ __forceinline__ unsigned xb_ld(unsigned* p)              { return __hip_atomic_load(p, __ATOMIC_RELAXED, __HIP_MEMORY_SCOPE_AGENT); }
__device__ __forceinline__ unsigned xb_add(unsigned* p, unsigned v) { return __hip_atomic_fetch_add(p, v, __ATOMIC_RELAXED, __HIP_MEMORY_SCOPE_AGENT); }
__device__ __forceinline__ unsigned xb_xcc_id() { return (unsigned)__builtin_amdgcn_s_getreg((3 << 11) | 20) & 0xFu; }
#define XB_SPIN(cond, bar) do { unsigned _sp = 0; while (cond) { __builtin_amdgcn_s_sleep(1); \
    if ((++_sp & 255u) == 0u) { if (xb_ld(&(bar)[XB_TMO])) break; if (_sp > XB_SPIN_CAP) { atomicAdd(&(bar)[XB_TMO], 1u); break; } } } } while (0)

struct XcdBarrier {
    unsigned* bar; unsigned x;
    volatile LAS unsigned* st;
};

__device__ __forceinline__ XcdBarrier xcd_barrier_post(unsigned* bar, volatile LAS unsigned* st) {
    XcdBarrier b; b.bar = bar; b.x = xb_xcc_id(); b.st = st;
    if (threadIdx.x == 0) (void)xb_add(&bar[XB_XCNT(b.x)], 1u);
    return b;
}
__device__ __forceinline__ void xcd_barrier_complete(unsigned* bar, unsigned x, unsigned& nloc, unsigned& nx) {
    const unsigned G = gridDim.x * gridDim.y * gridDim.z;
    unsigned sum, cnt, mine, sp = 0u;
    for (;;) {
        sum = 0u; cnt = 0u; mine = 0u;
#pragma unroll
        for (unsigned j = 0; j < 16; ++j) { const unsigned c = xb_ld(&bar[XB_XCNT(j)]); sum += c; cnt += (c > 0u) ? 1u : 0u; mine = (j == x) ? c : mine; }
        if (sum == G) break;
        __builtin_amdgcn_s_sleep(1);
        if ((++sp & 255u) == 0u) { if (xb_ld(&bar[XB_TMO])) break; if (sp > XB_SPIN_CAP) { atomicAdd(&bar[XB_TMO], 1u); break; } }
    }
    nloc = mine > 0u ? mine : 1u; nx = cnt > 0u ? cnt : 1u;
}

__device__ __forceinline__ void xcd_barrier(const XcdBarrier& b) {
    asm volatile("s_waitcnt vmcnt(0)" ::: "memory");
    __syncthreads();
    if (threadIdx.x == 0) {
        unsigned* bar = b.bar;
        __builtin_amdgcn_s_waitcnt(0);
        unsigned nloc = b.st[0], nx = b.st[1];
        if (nloc == 0u) { xcd_barrier_complete(bar, b.x, nloc, nx); b.st[0] = nloc; b.st[1] = nx; }
        const unsigned old = xb_add(&bar[XB_XSUB(b.x)], 1u);
        const unsigned gen = old / nloc;
        if (old + 1u == (gen + 1u) * nloc) {
            __builtin_amdgcn_fence(__ATOMIC_RELEASE, "agent");
            asm volatile("s_waitcnt vmcnt(0)" ::: "memory");
            const unsigned og = xb_add(&bar[XB_TOP], 1u);
            const unsigned tg = og / nx;
            if (og + 1u == (tg + 1u) * nx) xb_add(&bar[XB_TOPGEN], 1u);
            else XB_SPIN(xb_ld(&bar[XB_TOPGEN]) == tg, bar);
            __builtin_amdgcn_fence(__ATOMIC_ACQUIRE, "agent");
            xb_add(&bar[XB_XGEN(b.x)], 1u);
            asm volatile("s_waitcnt vmcnt(0)" ::: "memory");
        } else {
            XB_SPIN(xb_ld(&bar[XB_XGEN(b.x)]) == gen, bar);
            __builtin_amdgcn_fence(__ATOMIC_ACQUIRE, "agent");
            asm volatile("s_waitcnt vmcnt(0)" ::: "memory");
        }
    }
    __syncthreads();
}


static_assert((CW_BAR + XCD_BAR_WORDS) * 4 <= (int)CTL_ZERO_BYTES, "the per-call memset must cover every barrier word");
struct Args { const float* in[21]; float* out; unsigned char* ws; int ph_lo, ph_hi, use_bar, pad; };
struct Frame {
    LAS unsigned char* lds; volatile LAS unsigned* MISC; gu32* ctl;
    int vcu, G;
};
__device__ __forceinline__ int tid_() { int t = threadIdx.x; asm volatile("" : "+v"(t)); return t; }
#define FTID (tid_())
#define FLANE (tid_() & 63)
#define FWAVE (__builtin_amdgcn_readfirstlane(tid_() >> 6))
__device__ __forceinline__ float wave_sum(float v) {
#pragma unroll
    for (int o = 1; o < 64; o <<= 1) v += __shfl_xor(v, o);
    return v;
}
#define LBAR() do { asm volatile("s_waitcnt lgkmcnt(0)" ::: "memory"); __builtin_amdgcn_s_barrier(); asm volatile("" ::: "memory"); } while (0)
__device__ __forceinline__ float bf2f_(unsigned short b) { return __uint_as_float((unsigned)b << 16); }
__device__ __forceinline__ float bflo_(unsigned w) { return __uint_as_float(w << 16); }
__device__ __forceinline__ float bfhi_(unsigned w) { return __uint_as_float(w & 0xffff0000u); }

__device__ __forceinline__ int win_src_col(int np) {
    const int tile = np >> 8, p = np & 255;
    if (tile < 4) { const int base = (tile >> 1) * 512, head = 2 * (tile & 1) + (p >> 7), pp = p & 127; return base + head * 128 + (pp & 1) * 64 + (pp >> 1); }
    if (tile >= 12 && tile < 20) { const int h = tile - 12; return 3072 + (p & 1) * 1024 + h * 128 + (p >> 1); }
    if (tile >= 28) { const int t = tile - 28; return 7168 + (p & 1) * 1024 + t * 128 + (p >> 1); }
    return np;
}
template <bool MAP> __device__ __forceinline__ void p0_transpose_item(const float* W, int K, int N, bf16* WT, LAS float* scr, int item, int lane, const float* gk = nullptr) {
    const int nblk = N / 32, kb = item / nblk, nb = item % nblk, k0 = 64 * kb, n0 = 32 * nb;
    const int srcc = MAP ? win_src_col(n0 + (lane & 31)) : n0 + (lane & 31);
    float wv[32];
#pragma unroll
    for (int i = 0; i < 32; ++i) wv[i] = __builtin_nontemporal_load(W + (size_t)(k0 + 2 * i + (lane >> 5)) * N + srcc);
#pragma unroll
    for (int i = 0; i < 32; ++i) scr[(2 * i + (lane >> 5)) * 33 + (lane & 31)] = wv[i];
    LDS_WAIT(); asm volatile("" ::: "memory");
    const int c = lane & 7;
    f32x4 ga = (f32x4){1.f, 1.f, 1.f, 1.f}, gb = ga;
    if (gk) { ga = *(const f32x4*)(gk + k0 + 8 * c); gb = *(const f32x4*)(gk + k0 + 8 * c + 4); }
#pragma unroll
    for (int j = 0; j < 4; ++j) { const int n = (lane >> 3) + 8 * j; const LAS float* s = scr + (8 * c) * 33 + n;
        v4u o; o.x = pk2(s[0 * 33] * ga.x, s[1 * 33] * ga.y); o.y = pk2(s[2 * 33] * ga.z, s[3 * 33] * ga.w); o.z = pk2(s[4 * 33] * gb.x, s[5 * 33] * gb.y); o.w = pk2(s[6 * 33] * gb.z, s[7 * 33] * gb.w);
        *(GAS v4u*)(WT + (size_t)(n0 + n) * K + k0 + 8 * c) = o; }
    LDS_WAIT(); asm volatile("" ::: "memory");
}
template <int PART> __device__ __forceinline__ void p0_prologue(Frame& F, const Args& a) {     const int tid_v = tid_(); const int lane_v = tid_v & 63; const int wave_v = __builtin_amdgcn_readfirstlane(tid_v >> 6); (void)lane_v; (void)wave_v;
    unsigned char* ws = a.ws;
    LAS float* scr = (LAS float*)(F.lds + RING_OFF + wave_v * 16384);
    const int gw = F.vcu * NWAVES + wave_v, NGW = F.G * NWAVES;
    constexpr int I_IN = (DM / 64) * (DIN / 32), I_SQ = (DM / 64) * (DM / 32), I_F1 = (DM / 64) * (DFF / 32), I_F2 = (DFF / 64) * (DM / 32), I_PJ = (DPLE / 64) * (DM / 32);
    constexpr int NITEMS = I_IN + 4 * I_SQ + I_F1 + I_F2 + I_PJ;
    for (int it = (PART == 0 ? 0 : I_IN) + gw; it < (PART == 0 ? I_IN : NITEMS); it += NGW) {
        int r = it;
        if (r < I_IN) { p0_transpose_item<true>(a.in[7], DM, DIN, (bf16*)(ws + WS_WIN), scr, r, lane_v, a.in[6]); continue; } r -= I_IN;
        if (r < I_SQ) { p0_transpose_item<false>(a.in[11], DM, DM, (bf16*)(ws + WS_WUPR), scr, r, lane_v); continue; } r -= I_SQ;
        if (r < I_SQ) { p0_transpose_item<false>(a.in[12], DM, DM, (bf16*)(ws + WS_WUPH), scr, r, lane_v); continue; } r -= I_SQ;
        if (r < I_SQ) { p0_transpose_item<false>(a.in[13], DM, DM, (bf16*)(ws + WS_WO), scr, r, lane_v); continue; } r -= I_SQ;
        if (r < I_SQ) { p0_transpose_item<false>(a.in[18], DM, DM, (bf16*)(ws + WS_WGATE), scr, r, lane_v, a.in[17]); continue; } r -= I_SQ;
        if (r < I_F1) { p0_transpose_item<false>(a.in[15], DM, DFF, (bf16*)(ws + WS_WFF1), scr, r, lane_v, a.in[14]); continue; } r -= I_F1;
        if (r < I_F2) { p0_transpose_item<false>(a.in[16], DFF, DM, (bf16*)(ws + WS_WFF2), scr, r, lane_v); continue; } r -= I_F2;
        p0_transpose_item<false>(a.in[19], DPLE, DM, (bf16*)(ws + WS_WPROJ), scr, r, lane_v);
    }
    if (PART == 0) {
    bf16* XB = (bf16*)(a.out + OFF_RETS); float* RSTD0 = (float*)(ws + WS_RSTD0);
    for (int m0 = gw; m0 < MP; m0 += 2 * NGW) {
        f32x4 v[2][4]; bool ok[2], real[2];
#pragma unroll
        for (int u = 0; u < 2; ++u) {
            const int m = m0 + u * NGW; ok[u] = m < MP; real[u] = m < MTOT; const int mc = real[u] ? m : 0;
            const float* xrow = mc < MPROMPT ? a.in[0] + (size_t)mc * DM : a.in[1] + (size_t)(mc - MPROMPT) * DM;
            const GAS f32x4* xr = (const GAS f32x4*)xrow + lane_v;
#pragma unroll
            for (int j = 0; j < 4; ++j) v[u][j] = __builtin_nontemporal_load((const f32x4*)xr + 64 * j);
        }
#pragma unroll
        for (int u = 0; u < 2; ++u) {
            const int m = m0 + u * NGW; if (!ok[u]) continue;
            GAS unsigned long long* o8 = (GAS unsigned long long*)(XB + (size_t)m * DM) + lane_v;
            if (!real[u]) {
#pragma unroll
                for (int j = 0; j < 4; ++j) o8[64 * j] = 0ull;
                if (lane_v == 0) RSTD0[m] = 0.f; continue;
            }
            float s = 0.f;
#pragma unroll
            for (int j = 0; j < 4; ++j) s += (v[u][j].x * v[u][j].x + v[u][j].y * v[u][j].y) + (v[u][j].z * v[u][j].z + v[u][j].w * v[u][j].w);
            s = wave_sum(s);
            if (lane_v == 0) RSTD0[m] = rsqrtf(s * (1.0f / DM) + EPS);
#pragma unroll
            for (int j = 0; j < 4; ++j) o8[64 * j] = (unsigned long long)pk2(v[u][j].x, v[u][j].y) | ((unsigned long long)pk2(v[u][j].z, v[u][j].w) << 32);
        }
    }
    float* CS = (float*)(ws + WS_CS); float* LB = (float*)(ws + WS_LB);
    const int gt = (F.vcu * NWAVES + wave_v) * 64 + lane_v, NGT = NGW * 64;
    for (int i = gt; i < 2049 * 64; i += NGT) {
        const int pi = i >> 6, j = i & 63; const double pos = pi == SEQ ? 16384.0 : (double)pi;
        const double ang = pos * pow(10000.0, -(double)j / 64.0);
        CS[2 * i] = (float)cos(ang); CS[2 * i + 1] = (float)sin(ang);
    }
    for (int i = gt; i < DM; i += NGT) { const float a0 = a.in[10][i], a1 = a.in[10][DM + i]; LB[i] = 1.0f / (1.0f + expf(a1 - a0)); }
    }
}

typedef float f32x16 __attribute__((ext_vector_type(16)));
typedef short v4i16_t __attribute__((ext_vector_type(4)));
typedef unsigned u32x2 __attribute__((ext_vector_type(2)));
typedef float f32x2_t __attribute__((ext_vector_type(2))); typedef __bf16 bf16x2_t __attribute__((ext_vector_type(2)));
__device__ __forceinline__ unsigned cvtpk_s(float lo, float hi) { f32x2_t v = {lo, hi}; bf16x2_t b = __builtin_convertvector(v, bf16x2_t); return __builtin_bit_cast(unsigned, b); }
__device__ __forceinline__ unsigned off_b(unsigned row, unsigned ch) { return 256u * row + 16u * (ch ^ (((row & 3) << 2) | ((row >> 2) & 3))); }
__device__ __forceinline__ bf16x8 rd_row(LAS unsigned char* img, unsigned row, unsigned ks, unsigned h) { return *(const LAS bf16x8*)(img + off_b(row, 2 * ks + h)); }
__device__ __forceinline__ bf16x8 rd_tr(LAS unsigned char* img, unsigned lane, unsigned c, unsigned ks) {
    const unsigned h = lane >> 5, blk = (lane >> 4) & 1, q = (lane & 15) >> 2, p = lane & 3;
    const unsigned a0 = off_b(16 * ks + 8 * h + q, 4 * c + 2 * blk + (p >> 1)) + 8 * (p & 1);
    const unsigned a1 = off_b(16 * ks + 8 * h + 4 + q, 4 * c + 2 * blk + (p >> 1)) + 8 * (p & 1);
    const v4i16_t lo = __builtin_amdgcn_ds_read_tr16_b64_v4i16((LAS v4i16_t*)(img + a0));
    const v4i16_t hi = __builtin_amdgcn_ds_read_tr16_b64_v4i16((LAS v4i16_t*)(img + a1));
    return __builtin_shufflevector(lo, hi, 0, 1, 2, 3, 4, 5, 6, 7);
}
#define MFMA32(a, b, c) __builtin_amdgcn_mfma_f32_32x32x16_bf16((a), (b), (c), 0, 0, 0)
__device__ __forceinline__ void scan_item(Frame& F, const Args& a, int item) { const int tid_v = tid_(); const int lane_v = tid_v & 63; const int wave_v = __builtin_amdgcn_readfirstlane(tid_v >> 6); (void)lane_v; (void)wave_v;
    unsigned char* ws = a.ws;
    asm volatile("" : "+s"(item));
    const bool isg = item >= 128; const int it = isg ? item - 128 : item;
    int b, hd, dv0, ldq; const bf16 *Qp, *Kp; bf16* Vp; float* Sout; const float* GLp = nullptr; float sdec = 1.f;
    if (!isg) { b = it >> 4; hd = (it >> 2) & 3; dv0 = (it & 3) * 64; ldq = 512;
        Qp = (const bf16*)(ws + Z_QR) + hd * 128; Kp = (const bf16*)(ws + Z_KR) + hd * 128; Vp = (bf16*)(ws + Z_VR) + hd * 256 + dv0;
        Sout = a.out + OFF_RETP + ((size_t)(b * HR + hd) * DKR) * DVR + dv0; sdec = __expf(64.0f * __logf(1.0f - exp2f(-5.0f - (float)hd))); }
    else { b = it >> 4; hd = (it >> 1) & 7; dv0 = (it & 1) * 64; ldq = 1024;
        Qp = (const bf16*)(ws + Z_QG) + hd * 128; Kp = (const bf16*)(ws + Z_KG) + hd * 128; Vp = (bf16*)(ws + Z_VG) + hd * 128 + dv0;
        Sout = a.out + OFF_HGP + ((size_t)(b * HG + hd) * DKG) * DVG + dv0; GLp = (const float*)(ws + WS_GL) + hd * 128; }
#if PROBE_ON && PROBE_SKINNY == 2
    const unsigned pt0_ = (unsigned)rt();
#endif
    const int ldo = isg ? DVG : DVR;
    bf16* Gp = (bf16*)(ws + (isg ? WS_GG : WS_GR)) + hd * ldo + dv0;
    float* PSQp = (float*)(ws + (isg ? WS_PSQG : WS_PSQR)) + (isg ? 4 * hd + 2 * (it & 1) : 8 * hd + 2 * (it & 3));
    LAS unsigned char* QI = F.lds; LAS unsigned char* KI = QI + 16384; LAS unsigned char* VI = KI + 16384; LAS unsigned char* PI = VI + 16384; LAS unsigned char* SI = PI + 16384;
    LAS unsigned char* OI = SI + 16384;
    const int tid = tid_v, lane = lane_v, w = wave_v; const unsigned r = lane & 31, h = lane >> 5;
    const int kb = w >> 1, dvb = w & 1;
    for (int i = tid; i < 16384 / 4; i += 512) ((LAS unsigned*)SI)[i] = 0u;
    f32x16 S;
#pragma unroll
    for (int i = 0; i < 16; ++i) S[i] = 0.f;
    const int qr0 = tid >> 4, qc0 = tid & 15, vr0 = tid >> 3, vc0 = tid & 7;
    const size_t rowb = (size_t)b * SEQ;
    v4u aq0, aq1, ak0, ak1, av, agt, ghold;
#define SCAN_LOAD(c, Q0, Q1, K0, K1, V, GT) do { const size_t r0_ = rowb + (size_t)(c) * CH; \
        Q0 = *(const v4u*)(Qp + (r0_ + qr0) * ldq + qc0 * 8); Q1 = *(const v4u*)(Qp + (r0_ + qr0 + 32) * ldq + qc0 * 8); \
        K0 = *(const v4u*)(Kp + (r0_ + qr0) * ldq + qc0 * 8); K1 = *(const v4u*)(Kp + (r0_ + qr0 + 32) * ldq + qc0 * 8); \
        V = *(const v4u*)(Vp + (r0_ + vr0) * DM + vc0 * 8); GT = *(const v4u*)(Gp + (r0_ + vr0) * DM + vc0 * 8); } while (0)
    LAS float* DT = (LAS float*)(OI + 8192); LAS float* GN = DT + 32 * 128;
    { const int c_ = tid >> 4, k8_ = (tid & 15) * 8; f32x4 d0_ = (f32x4){sdec, sdec, sdec, sdec}, d1_ = d0_;
      if (isg) { const float* g_ = GLp + ((size_t)b * (SEQ / CH) + c_) * DM + k8_; d0_ = *(const f32x4*)g_; d1_ = *(const f32x4*)(g_ + 4); }
      *(LAS f32x4*)(DT + c_ * 128 + k8_) = d0_; *(LAS f32x4*)(DT + c_ * 128 + k8_ + 4) = d1_;
      if (tid < 16) *(LAS f32x4*)(GN + tid * 4) = *(const f32x4*)(a.in[isg ? 9 : 8] + hd * ldo + dv0 + tid * 4); }
    SCAN_LOAD(0, aq0, aq1, ak0, ak1, av, agt);
    const unsigned oi_off = (unsigned)(vr0 * 128 + 16 * (vc0 ^ (vr0 & 7)));
#define SCAN_SW(gn_, g_) ((gn_) * (g_) * __builtin_amdgcn_rcpf(1.0f + __expf(-(g_))))
#define SCAN_XSTORE(cc) do { const v4u ov_ = *(const LAS v4u*)(OI + oi_off); v4u xw_; const f32x4 gnA = *(const LAS f32x4*)(GN + vc0 * 8), gnB = *(const LAS f32x4*)(GN + vc0 * 8 + 4); \
        xw_[0] = cvtpk_s(bflo_(ov_[0]) * SCAN_SW(gnA[0], bflo_(ghold[0])), bfhi_(ov_[0]) * SCAN_SW(gnA[1], bfhi_(ghold[0]))); \
        xw_[1] = cvtpk_s(bflo_(ov_[1]) * SCAN_SW(gnA[2], bflo_(ghold[1])), bfhi_(ov_[1]) * SCAN_SW(gnA[3], bfhi_(ghold[1]))); \
        xw_[2] = cvtpk_s(bflo_(ov_[2]) * SCAN_SW(gnB[0], bflo_(ghold[2])), bfhi_(ov_[2]) * SCAN_SW(gnB[1], bfhi_(ghold[2]))); \
        xw_[3] = cvtpk_s(bflo_(ov_[3]) * SCAN_SW(gnB[2], bflo_(ghold[3])), bfhi_(ov_[3]) * SCAN_SW(gnB[3], bfhi_(ghold[3]))); \
        *(v4u*)(Gp + (rowb + (size_t)(cc) * CH + vr0) * DM + vc0 * 8) = xw_; } while (0)
#define SCAN_DS(cc) do { bf16x8 A[4], B[4]; \
        _Pragma("unroll") for (int ks = 0; ks < 4; ++ks) { A[ks] = rd_tr(KI, lane, kb, ks); B[ks] = rd_tr(VI, lane, dvb, ks); } \
        __builtin_amdgcn_sched_barrier(0); \
        f32x16 d; _Pragma("unroll") for (int i = 0; i < 16; ++i) d[i] = 0.f; \
        _Pragma("unroll") for (int ks = 0; ks < 4; ++ks) d = MFMA32(A[ks], B[ks], d); \
        __builtin_amdgcn_sched_barrier(0); \
        const LAS float* dp_ = DT + (cc) * 128 + 32 * kb + 4 * (int)h;     \
        _Pragma("unroll") for (int j = 0; j < 4; ++j) { const f32x4 G = *(const LAS f32x4*)(dp_ + 8 * j); \
            _Pragma("unroll") for (int i = 0; i < 4; ++i) S[4 * j + i] = G[i] * (S[4 * j + i] + d[4 * j + i]); } } while (0)
#define SCAN_BODY(c, Q0, Q1, K0, K1, V, GT) do { \
        LBAR();                                                   \
        if ((c) > 0) SCAN_XSTORE((c) - 1); \
        ghold = GT;                                               \
        *(LAS v4u*)(QI + off_b(qr0, qc0)) = Q0; *(LAS v4u*)(QI + off_b(qr0 + 32, qc0)) = Q1; \
        *(LAS v4u*)(KI + off_b(qr0, qc0)) = K0; *(LAS v4u*)(KI + off_b(qr0 + 32, qc0)) = K1; \
        *(LAS v4u*)(VI + off_b(vr0, vc0)) = V; \
        if ((c) > 0) {                                            \
            _Pragma("unroll") for (int g = 0; g < 4; ++g) { u32x2 wv; wv.x = cvtpk_s(S[4 * g], S[4 * g + 1]); wv.y = cvtpk_s(S[4 * g + 2], S[4 * g + 3]); \
                *(LAS u32x2*)(SI + off_b(32 * dvb + r, 4 * kb + g) + 8 * h) = wv; } \
        } \
        if ((c) + 1 < SEQ / CH) SCAN_LOAD((c) + 1, Q0, Q1, K0, K1, V, GT); \
        LBAR(); \
        f32x16 o; \
        if (w < 4) {                                              \
            const int ob = w >> 1, tb = w & 1; \
            _Pragma("unroll") for (int i = 0; i < 16; ++i) o[i] = 0.f; \
            bf16x8 A[8], B[8]; \
            _Pragma("unroll") for (int ks = 0; ks < 8; ++ks) { A[ks] = rd_row(SI, 32 * ob + r, ks, h); B[ks] = rd_row(QI, 32 * tb + r, ks, h); } \
            __builtin_amdgcn_sched_barrier(0); \
            _Pragma("unroll") for (int ks = 0; ks < 8; ++ks) o = MFMA32(A[ks], B[ks], o); \
        } else if (w == 7) { SCAN_DS(c); } \
        else {                                         \
            const int sb = (w - 4) >> 1, tb = (w - 3) >> 1; \
            bf16x8 A[8], B[8]; \
            _Pragma("unroll") for (int ks = 0; ks < 8; ++ks) { A[ks] = rd_row(KI, 32 * sb + r, ks, h); B[ks] = rd_row(QI, 32 * tb + r, ks, h); } \
            __builtin_amdgcn_sched_barrier(0); \
            f32x16 p; _Pragma("unroll") for (int i = 0; i < 16; ++i) p[i] = 0.f; \
            _Pragma("unroll") for (int ks = 0; ks < 8; ++ks) p = MFMA32(A[ks], B[ks], p); \
            _Pragma("unroll") for (int g = 0; g < 4; ++g) { float v[4]; \
                _Pragma("unroll") for (int i = 0; i < 4; ++i) { const int sl = 8 * g + 4 * (int)h + i; v[i] = (sb != tb || sl <= (int)r) ? p[4 * g + i] : 0.f; } \
                u32x2 wv; wv.x = cvtpk_s(v[0], v[1]); wv.y = cvtpk_s(v[2], v[3]); \
                *(LAS u32x2*)(PI + off_b(32 * tb + r, 4 * sb + g) + 8 * h) = wv; } \
        } \
        LBAR(); \
        if (w < 4) {                                              \
            const int ob = w >> 1, tb = w & 1; \
            {   bf16x8 A[4], B[4]; \
                _Pragma("unroll") for (int ks = 0; ks < 4; ++ks) { A[ks] = rd_tr(VI, lane, ob, ks); B[ks] = rd_row(PI, 32 * tb + r, ks, h); } \
                __builtin_amdgcn_sched_barrier(0); \
                _Pragma("unroll") for (int ks = 0; ks < 4; ++ks) if (ks < 2 || tb == 1) o = MFMA32(A[ks], B[ks], o); } \
            {   float ss_ = 0.f; _Pragma("unroll") for (int i = 0; i < 16; ++i) ss_ += o[i] * o[i]; ss_ += __shfl_xor(ss_, 32);     \
                if (h == 0) PSQp[(rowb + (size_t)(c) * CH + 32 * tb + r) * 32 + ob] = ss_; } \
              \
            _Pragma("unroll") for (int g = 0; g < 4; ++g) { u32x2 wv; wv.x = cvtpk_s(o[4 * g], o[4 * g + 1]); wv.y = cvtpk_s(o[4 * g + 2], o[4 * g + 3]); \
                const unsigned t_ = 32 * tb + r, ch_ = 4 * ob + g; *(LAS u32x2*)(OI + t_ * 128 + 16 * (ch_ ^ (t_ & 7)) + 8 * h) = wv; } \
            SCAN_DS(c); \
        } else if (w < 7) { SCAN_DS(c); } \
    } while (0)
#pragma unroll 1
    for (int c = 0; c < SEQ / CH; c += 2) {
        SCAN_BODY(c, aq0, aq1, ak0, ak1, av, agt);
        SCAN_BODY(c + 1, aq0, aq1, ak0, ak1, av, agt);
    }
#undef SCAN_BODY
#undef SCAN_DS
#undef SCAN_LOAD
    LBAR();
    SCAN_XSTORE(SEQ / CH - 1);
#undef SCAN_XSTORE
#undef SCAN_SW
#pragma unroll
    for (int i = 0; i < 16; ++i) { const int k = 32 * kb + (i & 3) + 8 * (i >> 2) + 4 * (int)h; Sout[(size_t)k * ldo + 32 * dvb + r] = S[i]; }
    __syncthreads();
#if PROBE_ON && PROBE_SKINNY == 2
    if (threadIdx.x == 0) F.MISC[18] += (unsigned)rt() - pt0_;
#endif
}

__device__ __forceinline__ void p_rows_to_bf16(Frame& F, const Args& a) { const int tid_v = tid_(); const int lane_v = tid_v & 63; const int wave_v = __builtin_amdgcn_readfirstlane(tid_v >> 6);
    const int gw = F.vcu * NWAVES + wave_v, NGW = F.G * NWAVES; bf16* PB = (bf16*)(a.ws + WS_PB);
    for (int m0 = gw; m0 < MTOT; m0 += 4 * NGW) {
        f32x4 pv[4];
#pragma unroll
        for (int u = 0; u < 4; ++u) { const int m = m0 + u * NGW, mc = m < MTOT ? m : 0;
            pv[u] = __builtin_nontemporal_load((const f32x4*)(mc < MPROMPT ? a.in[4] + (size_t)mc * DPLE : a.in[5] + (size_t)(mc - MPROMPT) * DPLE) + lane_v); }
#pragma unroll
        for (int u = 0; u < 4; ++u) { const int m = m0 + u * NGW; if (m < MTOT)
            *((GAS unsigned long long*)(PB + (size_t)m * DPLE) + lane_v) = (unsigned long long)pk2(pv[u].x, pv[u].y) | ((unsigned long long)pk2(pv[u].z, pv[u].w) << 32); }
    }
}

template <bool ISG> __device__ __forceinline__ void dec_load(const Args& a, int item, int tid, int lane, int w, f32x4 (&s)[16], float& qkf, unsigned long long& vw) {
    unsigned char* ws = a.ws;
    if (!ISG) { const int n = item >> 2, h = item & 3, row = MPROMPT + n;
        const float* S0 = a.in[2] + ((size_t)(n * HR + h) * DKR) * DVR;
#pragma unroll
        for (int i = 0; i < 16; ++i) s[i] = __builtin_nontemporal_load((const f32x4*)(S0 + ((size_t)(w + 8 * i) * 64 + lane) * 4));
        qkf = tid < 128 ? bf2f_(((const bf16*)(ws + Z_QR))[(size_t)row * 512 + h * 128 + tid]) : tid < 256 ? bf2f_(((const bf16*)(ws + Z_KR))[(size_t)row * 512 + h * 128 + tid - 128]) : 0.f;
        vw = *(const unsigned long long*)((const bf16*)(ws + Z_VR) + (size_t)row * DM + h * 256 + 4 * lane);
    } else { const int n = item >> 3, h = item & 7, row = MPROMPT + n;
        const float* S0 = a.in[3] + ((size_t)(n * HG + h) * DKG) * DVG;
#pragma unroll
        for (int i = 0; i < 8; ++i) s[i] = __builtin_nontemporal_load((const f32x4*)(S0 + ((size_t)(w + 8 * i) * 64 + lane) * 4));
        qkf = tid < 128 ? bf2f_(((const bf16*)(ws + Z_QG))[(size_t)row * DM + h * 128 + tid]) : tid < 256 ? bf2f_(((const bf16*)(ws + Z_KG))[(size_t)row * DM + h * 128 + tid - 128])
            : tid < 384 ? ((const float*)(ws + WS_FS))[(size_t)n * DM + h * 128 + tid - 256] : 0.f;
        vw = *(const unsigned long long*)((const bf16*)(ws + Z_VG) + (size_t)row * DM + h * 128 + 4 * (lane & 31));
    }
}
template <bool ISG> __device__ __forceinline__ void dec_compute(Frame& F, const Args& a, int item, int tid, int lane, int w, const f32x4 (&s)[16], float qkf, unsigned long long vw) {
    unsigned char* ws = a.ws;
    LAS float* qs = (LAS float*)(F.lds); LAS float* red = qs + 384; LAS float* part = red + 8 * 256;
    LAS float* ks = qs + 128; LAS float* fs = qs + 256;
    if (tid < 384) qs[tid] = qkf;
    const f32x4 v = (f32x4){bflo_((unsigned)vw), bfhi_((unsigned)vw), bflo_((unsigned)(vw >> 32)), bfhi_((unsigned)(vw >> 32))};
    LBAR();
    f32x4 o = (f32x4){0.f, 0.f, 0.f, 0.f};
    if (!ISG) { const int n = item >> 2, h = item & 3; const float gam = 1.0f - exp2f(-5.0f - (float)h);
        float* S1 = a.out + OFF_RETS + ((size_t)(n * HR + h) * DKR) * DVR;
#pragma unroll
        for (int i = 0; i < 16; ++i) { const int k = w + 8 * i; const f32x4 sn = s[i] * gam + v * ks[k]; __builtin_nontemporal_store(sn, (f32x4*)(S1 + ((size_t)k * 64 + lane) * 4)); o += sn * qs[k]; }
    } else { const int n = item >> 3, h = item & 7;
        float* S1 = a.out + OFF_HGS + ((size_t)(n * HG + h) * DKG) * DVG;
#pragma unroll
        for (int i = 0; i < 8; ++i) { const int k = 2 * (w + 8 * i) + (lane >> 5); const f32x4 sn = s[i] * fs[k] + v * ks[k]; __builtin_nontemporal_store(sn, (f32x4*)(S1 + ((size_t)(w + 8 * i) * 64 + lane) * 4)); o += sn * qs[k]; }
    }
    *(LAS f32x4*)(red + w * 256 + 4 * lane) = o;
    LBAR();
    constexpr int NDV = ISG ? 128 : 256; float ov = 0.f;
    if (tid < NDV) {
        if (!ISG) {
#pragma unroll
            for (int i = 0; i < 8; ++i) ov += red[i * 256 + tid];
        } else {
#pragma unroll
            for (int i = 0; i < 8; ++i) ov += red[i * 256 + tid] + red[i * 256 + 128 + tid];
        }
        const float ss = wave_sum(ov * ov); if (lane == 0) part[w] = ss;
    }
    LBAR();
    if (tid < NDV) {
        const float rstd = rsqrtf((ISG ? (part[0] + part[1]) : ((part[0] + part[1]) + (part[2] + part[3]))) * (1.0f / NDV) + EPS);
        const int n = ISG ? item >> 3 : item >> 2, h = ISG ? item & 7 : item & 3, row = MPROMPT + n;
        bf16* gp = (bf16*)(ws + (ISG ? WS_GG : WS_GR)) + (size_t)row * DM + h * NDV + tid;
        const float gv_ = bf2f_(*gp); *gp = (bf16)f2bf(ov * rstd * a.in[ISG ? 9 : 8][h * NDV + tid] * (gv_ * __builtin_amdgcn_rcpf(1.0f + __expf(-gv_))));
    }
    LBAR();
}
constexpr int XB_SAMPLES = (int)(((size_t)MP * DM * 2 + (size_t)HR * DKR * DVR * 4 - 1) / ((size_t)HR * DKR * DVR * 4));
template <int PART> __device__ __forceinline__ void decode_part(Frame& F, const Args& a) { const int tid_v = tid_(); const int lane_v = tid_v & 63; const int wave_v = __builtin_amdgcn_readfirstlane(tid_v >> 6);
    const int tid = tid_v, lane = lane_v, w = wave_v, c = F.vcu, G = F.G;
    const bool r1_early = ((c + G) >> 2) >= XB_SAMPLES;
    f32x4 sa[16], sb[16]; float qa, qb; unsigned long long va, vb;
    if (PART == 1) {
        dec_load<true>(a, c, tid, lane, w, sa, qa, va);
        dec_load<true>(a, c + G, tid, lane, w, sb, qb, vb);          dec_compute<true>(F, a, c, tid, lane, w, sa, qa, va);
        dec_load<true>(a, c + 2 * G, tid, lane, w, sa, qa, va);      dec_compute<true>(F, a, c + G, tid, lane, w, sb, qb, vb);
        dec_load<true>(a, c + 3 * G, tid, lane, w, sb, qb, vb);      dec_compute<true>(F, a, c + 2 * G, tid, lane, w, sa, qa, va);
        if (r1_early) dec_load<false>(a, c + G, tid, lane, w, sa, qa, va);
        dec_compute<true>(F, a, c + 3 * G, tid, lane, w, sb, qb, vb);
        if (r1_early) dec_compute<false>(F, a, c + G, tid, lane, w, sa, qa, va);
    } else {
        dec_load<false>(a, c, tid, lane, w, sa, qa, va);
        if (!r1_early) dec_load<false>(a, c + G, tid, lane, w, sb, qb, vb);
        dec_compute<false>(F, a, c, tid, lane, w, sa, qa, va);
        if (!r1_early) dec_compute<false>(F, a, c + G, tid, lane, w, sb, qb, vb);
    }
}

__device__ __forceinline__ void p3_headnorm(Frame& F, const Args& a) { const int tid_v = tid_(); const int lane_v = tid_v & 63; const int wave_v = __builtin_amdgcn_readfirstlane(tid_v >> 6); (void)lane_v; (void)wave_v;
    unsigned char* ws = a.ws; const int gw = F.vcu * NWAVES + wave_v, NGW = F.G * NWAVES, lane = lane_v;
    constexpr int NIT = MPROMPT * 8, U = 4;
    for (int it0 = gw; it0 < NIT; it0 += U * NGW) {
        unsigned long long ow[U], gwd[U]; f32x4 gn[U]; unsigned long long* gp[U]; bool isg[U], ok[U];
#pragma unroll
        for (int u = 0; u < U; ++u) {
            const int it = it0 + u * NGW; ok[u] = it < NIT; const int itc = ok[u] ? it : gw;
            isg[u] = itc >= MPROMPT * 4; const int i2 = isg[u] ? itc - MPROMPT * 4 : itc; const int row = i2 >> 2, q = i2 & 3;
            const size_t off = (size_t)row * DM + q * 256 + 4 * lane;
            ow[u] = __builtin_nontemporal_load((const unsigned long long*)((const bf16*)(ws + (isg[u] ? Z_VG : Z_VR)) + off));
            gp[u] = (unsigned long long*)((bf16*)(ws + (isg[u] ? WS_GG : WS_GR)) + off); gwd[u] = *gp[u];
            gn[u] = *(const f32x4*)(a.in[isg[u] ? 9 : 8] + q * 256 + 4 * lane);
        }
#pragma unroll
        for (int u = 0; u < U; ++u) {
            const f32x4 o = (f32x4){bflo_((unsigned)ow[u]), bfhi_((unsigned)ow[u]), bflo_((unsigned)(ow[u] >> 32)), bfhi_((unsigned)(ow[u] >> 32))};
            f32x4 gt = (f32x4){bflo_((unsigned)gwd[u]), bfhi_((unsigned)gwd[u]), bflo_((unsigned)(gwd[u] >> 32)), bfhi_((unsigned)(gwd[u] >> 32))};
            gt.x *= __builtin_amdgcn_rcpf(1.0f + __expf(-gt.x)); gt.y *= __builtin_amdgcn_rcpf(1.0f + __expf(-gt.y)); gt.z *= __builtin_amdgcn_rcpf(1.0f + __expf(-gt.z)); gt.w *= __builtin_amdgcn_rcpf(1.0f + __expf(-gt.w));
            float ss = (o.x * o.x + o.y * o.y) + (o.z * o.z + o.w * o.w);
#pragma unroll
            for (int d = 1; d < 32; d <<= 1) ss += __shfl_xor(ss, d);
            if (!isg[u]) ss += __shfl_xor(ss, 32);
            const float rstd = rsqrtf(ss * (isg[u] ? 1.0f / DVG : 1.0f / DVR) + EPS);
            const f32x4 x = o * rstd * gn[u] * gt;
            if (ok[u]) *gp[u] = (unsigned long long)pk2(x.x, x.y) | ((unsigned long long)pk2(x.z, x.w) << 32);
        }
    }
}

__device__ __forceinline__ void p9_final(Frame& F, const Args& a) { const int tid_v = tid_(); const int lane_v = tid_v & 63; const int wave_v = __builtin_amdgcn_readfirstlane(tid_v >> 6); (void)lane_v; (void)wave_v;
    const int gw = F.vcu * NWAVES + wave_v, NGW = F.G * NWAVES, lane = lane_v; const float* PS3 = (const float*)(a.ws + WS_PS3); const float* gf = a.in[20];
    for (int m = gw; m < MTOT; m += NGW) {
        const float pv = m < MPROMPT ? (lane < 16 ? PS3[(size_t)m * 16 + lane] : 0.f) : ((const float*)(a.ws + WS_PSS3))[(size_t)(m - MPROMPT) * 64 + lane];
        const float rstd = rsqrtf(wave_sum(pv) * (1.0f / DM) + EPS);
        const unsigned long long* r16 = (const unsigned long long*)((const bf16*)(a.ws + WS_A5) + (size_t)m * DM) + lane;
        f32x4* y = (f32x4*)(a.out + (size_t)m * DM) + lane;
#pragma unroll
        for (int j = 0; j < 4; ++j) { const unsigned long long w = r16[64 * j]; const f32x4 gv = *((const f32x4*)gf + 64 * j + lane);
            __builtin_nontemporal_store((f32x4){bflo_((unsigned)w), bfhi_((unsigned)w), bflo_((unsigned)(w >> 32)), bfhi_((unsigned)(w >> 32))} * rstd * gv, y + 64 * j); }
    }
}

template <int K, class FE> __device__ __forceinline__ void skinny_gemm(Frame& F, const bf16* As, const bf16* Wt, int N, const FE& fe, int it0 = 0, int it1 = 1 << 30) {     const int tid_v = tid_(); const int lane_v = tid_v & 63; const int wave_v = __builtin_amdgcn_readfirstlane(tid_v >> 6); (void)lane_v; (void)wave_v;
    constexpr int KW = K / 4, NKS = KW / 32, CH_KS = NKS < 8 ? NKS : 8, NCH = NKS / CH_KS;
    const int lane = lane_v, fr = lane & 15, fq = lane >> 4, rg = wave_v >> 2, ks = wave_v & 3;
    LAS f32x4* red = (LAS f32x4*)(F.lds);
    const int ntile = 4 * (N / 16);
#if PROBE_ON && PROBE_SKINNY == 1
    const unsigned ps0_ = (unsigned)rt();
#endif
    const int rb = F.vcu & 3;
    const bf16* bp = As + (size_t)(32 * rb + 16 * rg + fr) * K + ks * KW + 8 * fq;
    if constexpr (NCH == 1) {
        bf16x8 act[CH_KS], wa[CH_KS], wb[CH_KS];
#pragma unroll
        for (int i = 0; i < CH_KS; ++i) act[i] = *(const bf16x8*)(bp + i * 32);
        int itn = it0; int tile = F.vcu + itn * F.G; bool have = itn < it1 && tile < ntile;
        if (have) { const bf16* ap = Wt + (size_t)(16 * (tile >> 2) + fr) * K + ks * KW + 8 * fq;
#pragma unroll
            for (int i = 0; i < CH_KS; ++i) wa[i] = *(const bf16x8*)(ap + i * 32); }
        while (have) {
            const int ntile_ = tile + F.G; const bool nhave = (itn + 1) < it1 && ntile_ < ntile;
            if (nhave) { const bf16* ap = Wt + (size_t)(16 * (ntile_ >> 2) + fr) * K + ks * KW + 8 * fq;
#pragma unroll
                for (int i = 0; i < CH_KS; ++i) wb[i] = *(const bf16x8*)(ap + i * 32); }
            f32x4 acc = (f32x4){0.f, 0.f, 0.f, 0.f};
#pragma unroll
            for (int i = 0; i < CH_KS; ++i) acc = __builtin_amdgcn_mfma_f32_16x16x32_bf16(wa[i], act[i], acc, 0, 0, 0);
            red[wave_v * 64 + lane] = acc;
            __syncthreads();
            if (ks == 0) {
                const f32x4 v = (red[(4 * rg + 0) * 64 + lane] + red[(4 * rg + 1) * 64 + lane]) + (red[(4 * rg + 2) * 64 + lane] + red[(4 * rg + 3) * 64 + lane]);
                fe(MPROMPT + 32 * rb + 16 * rg + fr, 16 * (tile >> 2) + 4 * fq, v);
            }
            __syncthreads();
            if (nhave) {
#pragma unroll
                for (int i = 0; i < CH_KS; ++i) wa[i] = wb[i]; }
            ++itn; tile = ntile_; have = nhave;
        }
    } else {
        constexpr int KW8 = K / 8, NS8 = KW8 / 32;
        const bf16* bp0 = As + (size_t)(32 * rb + fr) * K + wave_v * KW8 + 8 * fq; const bf16* bp1 = bp0 + (size_t)16 * K;
        for (int itn = it0; itn < it1; ++itn) {
            const int tile = F.vcu + itn * F.G; if (tile >= ntile) break;
            const int cb = tile >> 2;
            const bf16* ap = Wt + (size_t)(16 * cb + fr) * K + wave_v * KW8 + 8 * fq;
            f32x4 acc0 = (f32x4){0.f, 0.f, 0.f, 0.f}, acc1 = acc0;
            bf16x8 a[2][4], b0[2][4], b1[2][4];
#define SK_LD(s, c) do { _Pragma("unroll") for (int i = 0; i < 4; ++i) { a[s][i] = *(const bf16x8*)(ap + ((c) * 4 + i) * 32); b0[s][i] = *(const bf16x8*)(bp0 + ((c) * 4 + i) * 32); b1[s][i] = *(const bf16x8*)(bp1 + ((c) * 4 + i) * 32); } } while (0)
            SK_LD(0, 0);
#pragma unroll
            for (int c = 0; c < NS8 / 4; ++c) {
                if (c + 1 < NS8 / 4) SK_LD((c + 1) & 1, c + 1);
#pragma unroll
                for (int i = 0; i < 4; ++i) { acc0 = __builtin_amdgcn_mfma_f32_16x16x32_bf16(a[c & 1][i], b0[c & 1][i], acc0, 0, 0, 0); acc1 = __builtin_amdgcn_mfma_f32_16x16x32_bf16(a[c & 1][i], b1[c & 1][i], acc1, 0, 0, 0); }
            }
#undef SK_LD
            red[(wave_v * 2 + 0) * 64 + lane] = acc0; red[(wave_v * 2 + 1) * 64 + lane] = acc1;
            __syncthreads();
            if (wave_v < 2) {
                f32x4 v = red[wave_v * 64 + lane];
#pragma unroll
                for (int s = 1; s < 8; ++s) v += red[(s * 2 + wave_v) * 64 + lane];
                fe(MPROMPT + 32 * rb + 16 * wave_v + fr, 16 * cb + 4 * fq, v);
            }
            __syncthreads();
        }
    }
#if PROBE_ON && PROBE_SKINNY == 1
    if (threadIdx.x == 0) F.MISC[18] += (unsigned)rt() - ps0_;
#endif
}
struct FeIn { pg8::EpiIn E; __device__ __forceinline__ void operator()(int row, int col, f32x4 v) const { pg8::samp_in(E, row, col, v); } };
template <int MODE> struct FeN { pg8::EpiN<MODE> E; const float* xs; float* PSS; const float* PSSin;
    __device__ __forceinline__ void operator()(int row, int col, f32x4 v) const { pg8::samp_n<MODE>(E, xs, PSS, PSSin, row, col, v); } };

struct PairOrder { pg8::StaticOrder S0;
    __device__ __forceinline__ bool next(int i, pg8::Unit& u) const { pg8::Unit t; if (!S0.next(i >> 1, t)) return false; if ((i & 1) == 0) { u.pm = t.pm + MP / 256; u.pn = t.pn + DM / 256; } else u = t; return true; }
    __device__ __forceinline__ void a_ready(const pg8::Unit&) const {}
    __device__ __forceinline__ void done(const pg8::Unit&) const {} };
struct EpiUp { static constexpr bool PERM = true, AFTER_DRAIN = false; const pg8::bf16_t* AR; const pg8::bf16_t* AH; pg8::bf16_t* M;
    __device__ __forceinline__ bool keep_acc(const pg8::Unit& u) const { return u.pn >= DM / 256; }
    __device__ __forceinline__ static const LAS float* tab(int idx) { return (const LAS float*)(unsigned long)HT_LDS_OFF + idx * 256; }
    __device__ __forceinline__ static void scale_rows(f32x4 (&acc)[2][2][4][2], const LAS float* t, int wr, int fr) {
#pragma unroll
        for (int ai = 0; ai < 2; ++ai)
#pragma unroll
            for (int m = 0; m < 4; ++m) { const float f = t[ai * 128 + wr * 64 + m * 16 + fr];
#pragma unroll
                for (int bj = 0; bj < 2; ++bj) { acc[ai][bj][m][0] *= f; acc[ai][bj][m][1] *= f; } }
    }
    __device__ __forceinline__ void khook(f32x4 (&acc)[2][2][4][2], const pg8::Unit& u, int t, int wr, int fr) const {
        if (u.pn >= DM / 256) { const int h = t >> 1; if (h < 7) scale_rows(acc, tab(h), wr, fr); }
        else if (t & 2) { const int h = t >> 2; if (h < 3) scale_rows(acc, tab(9 + h), wr, fr); }
    }
    __device__ __forceinline__ void operator()(f32x4 (&acc)[2][2][4][2], const pg8::Unit& u, int wr, int wc, int fr, int fq) const {
        using namespace pg8;
        const bool first = u.pn >= DM / 256; const int pm = first ? u.pm - MP / 256 : u.pm, pn = first ? u.pn - DM / 256 : u.pn;
#pragma unroll
        for (int ai = 0; ai < 2; ++ai)
#pragma unroll
            for (int m = 0; m < 4; ++m) {
                const int rl = ai * HALF + wr * 64 + m * 16 + fr, row = pm * BM + rl;
                const float rf = first ? tab(7)[rl] * tab(8)[rl] : tab(12)[rl];
#pragma unroll
                for (int bj = 0; bj < 2; ++bj) {
                    const int col = pn * BM + bj * HALF + wc * 32 + fq * 8; const size_t o = (size_t)row * DM + col;
                    if (first) { f32x4 h0, h1; unpack8(*(const u32x4*)(AH + o), h0, h1); acc[ai][bj][m][0] *= h0 * rf; acc[ai][bj][m][1] *= h1 * rf; }
                    else { f32x4 r0, r1; unpack8(*(const u32x4*)(AR + o), r0, r1); *(u32x4*)(M + o) = pack8(r0 * rf * acc[ai][bj][m][0], r1 * rf * acc[ai][bj][m][1]); }
                }
            }
    } };
__device__ __forceinline__ void head_tables_to_lds(Frame& F, const unsigned char* ws, int pm) { const int t = tid_();
    LAS float* T = (LAS float*)(F.lds + HT_LDS_OFF);
    if (t < 256) { const size_t row = (size_t)pm * 256 + t; float sg[8], sr[4];
        const f32x4* pg = (const f32x4*)((const float*)(ws + WS_PSQG) + row * 32); const f32x4* pr = (const f32x4*)((const float*)(ws + WS_PSQR) + row * 32);
#pragma unroll
        for (int h = 0; h < 8; ++h) { const f32x4 v = pg[h]; sg[h] = rsqrtf(((v[0] + v[1]) + (v[2] + v[3])) * (1.0f / DVG) + EPS); }
#pragma unroll
        for (int h = 0; h < 4; ++h) { const f32x4 v = pr[2 * h], w = pr[2 * h + 1]; sr[h] = rsqrtf((((v[0] + v[1]) + (v[2] + v[3])) + ((w[0] + w[1]) + (w[2] + w[3]))) * (1.0f / DVR) + EPS); }
#pragma unroll
        for (int h = 0; h < 7; ++h) T[h * 256 + t] = sg[h] * __builtin_amdgcn_rcpf(sg[h + 1]);
        T[7 * 256 + t] = sg[7]; T[8 * 256 + t] = __builtin_amdgcn_rcpf(sr[0]);
#pragma unroll
        for (int h = 0; h < 3; ++h) T[(9 + h) * 256 + t] = sr[h] * __builtin_amdgcn_rcpf(sr[h + 1]);
        T[12 * 256 + t] = sr[3]; }
    __syncthreads();
}

__device__ __forceinline__ const LAS float* rstd_to_lds(Frame& F, const float* PS, int pm) { const int t = tid_();
    LAS float* rl = (LAS float*)(F.lds + RSTD_LDS_OFF);
    if (t < 256) { const f32x4* p = (const f32x4*)(PS + ((size_t)pm * 256 + t) * 16); const f32x4 a = p[0], b = p[1], c = p[2], e = p[3];
        const float s = ((a[0] + a[1]) + (a[2] + a[3])) + ((b[0] + b[1]) + (b[2] + b[3])) + ((c[0] + c[1]) + (c[2] + c[3])) + ((e[0] + e[1]) + (e[2] + e[3]));
        rl[t] = rsqrtf(s * (1.0f / 1024.0f) + EPS); }
    __syncthreads();
    return rl;
}

__global__ void __launch_bounds__(NWAVES * 64, 2) fwd_kernel(Args args) {
#define tid_v ((int)threadIdx.x)
    extern __shared__ __attribute__((aligned(16))) unsigned char lds[];
    Frame F;
    F.lds = (LAS unsigned char*)lds;
    F.MISC = (volatile LAS unsigned*)(F.lds + MISC_OFF);
        F.G = gridDim.x; { const int bx = blockIdx.x; F.vcu = (F.G % 8 == 0) ? (bx % 8) * (F.G / 8) + bx / 8 : bx; }
    unsigned char* ws = args.ws;
    F.ctl = (gu32*)(ws + WS_CTL);
    for (int u = tid_v; u < (LDS_BYTES - LDSCTL_OFF) / 4; u += NWAVES * 64) ((LAS unsigned*)(F.lds + LDSCTL_OFF))[u] = 0u;
    __syncthreads();
    XcdBarrier bar; bar.bar = (unsigned*)(F.ctl + CW_BAR); bar.x = 0; bar.st = nullptr;
    if (args.use_bar) bar = xcd_barrier_post((unsigned*)(F.ctl + CW_BAR), F.MISC + 8);
    const int lo = args.ph_lo, hi = args.ph_hi;
#define IN(k) (lo <= (k) && (k) < hi)
#if PROBE_ON
    volatile LAS unsigned* PW = F.MISC + 16;
    if (tid_v == 0) { PW[0] = (unsigned)rt(); PW[1] = 0u; PW[2] = 0u; }
#define STAMP(k) do { if (blockIdx.x == 0 && tid_v == 0) { const unsigned t_ = (unsigned)rt(); unsigned q_ = (t_ - PW[0] + (unsigned)PROBE_UNIT / 2) / (unsigned)PROBE_UNIT; if (q_ > 49u) q_ = 49u; \
        if ((k) == PROBE_A) PW[1] += q_ * 400u; else if ((k) == PROBE_B) PW[1] += q_ * 20000u; else if (PROBE_E < 0 && (k) == PROBE_C) PW[1] += q_ * 1000000u; \
        if ((k) == PROBE_E) { unsigned e_ = (PW[2] + (unsigned)PROBE_UNIT / 2) / (unsigned)PROBE_UNIT; if (e_ > 49u) e_ = 49u; PW[1] += e_ * 1000000u; } PW[2] = 0u; PW[0] = t_; } } while (0)
#else
#define STAMP(k) do { } while (0)
#endif
#define SEAM(k) do { if (IN(k) && IN((k) + 1)) xcd_barrier(bar); STAMP(k); } while (0)
    using namespace pg8;
    bf16_t* XB = (bf16_t*)(args.out + OFF_RETS);
    bf16_t* AR = (bf16_t*)(args.out + OFF_Y); bf16_t* AH = AR + (size_t)MTOT * DM;
    float* R = args.out + OFF_Y;
    float* PS1 = (float*)(ws + WS_PS1); float* PS2 = (float*)(ws + WS_PS2); float* PS3 = (float*)(ws + WS_PS3);

    if (IN(0)) { p0_prologue<0>(F, args); SEAM(0); }
    const bf16_t* SROW = nullptr; (void)SROW;
    float* PSS1 = (float*)(ws + WS_PSS1); float* PSS2 = (float*)(ws + WS_PSS2); float* PSS3 = (float*)(ws + WS_PSS3);
#define SAMP(buf, ld) ((const bf16*)(buf) + (size_t)MPROMPT * (ld))
    if (IN(1)) {
        Gemm g{XB, (const bf16_t*)(ws + WS_WIN), MPROMPT, DIN, DM}; StaticOrder S; S.init(MPROMPT, DIN, F.G, (int)blockIdx.x);
        EpiIn E{(const float*)(ws + WS_RSTD0), (const float*)(ws + WS_CS), (const float*)(ws + WS_LB),
                (bf16_t*)(ws + Z_QR), (bf16_t*)(ws + Z_KR), (bf16_t*)(ws + Z_VR), (bf16_t*)(ws + WS_GR), (bf16_t*)(ws + Z_QG), (bf16_t*)(ws + Z_KG), (bf16_t*)(ws + Z_VG), (bf16_t*)(ws + WS_GG),
                AR, AH, (float*)(ws + WS_GL), (float*)(ws + WS_FS), ws, (unsigned char*)args.out};
        { Unit u0; S.next(0, u0); const int t = tid_v; if (t < 256) ((LAS float*)(F.lds + RSTD_LDS_OFF))[t] = ((const float*)(ws + WS_RSTD0))[u0.pm * 256 + t]; __syncthreads(); }
        { FeIn fe{E}; skinny_gemm<DM>(F, SAMP(XB, DM), (const bf16*)(ws + WS_WIN), DIN, fe); }
        asm volatile("s_waitcnt vmcnt(0)" ::: "memory"); __syncthreads();
        if (tid_v == 0) {
            unsigned* sb = (unsigned*)(F.ctl + CW_SAMP); const unsigned nloc = F.MISC[8];
            if (xb_add(&sb[XB_XSUB(bar.x)], 1u) + 1u == nloc) { __builtin_amdgcn_fence(__ATOMIC_RELEASE, "agent"); asm volatile("s_waitcnt vmcnt(0)" ::: "memory"); xb_add(&sb[XB_TOP], 1u); } }
        const bool dec_first = (F.vcu & 1) != 0, late_first = (F.vcu & 2) != 0;
#define SAMP_WAIT() do { if (tid_v == 0) { unsigned sp_ = 0; while (__hip_atomic_load(F.ctl + CW_SAMP + XB_TOP, RLX_AGENT) < F.MISC[9]) { __builtin_amdgcn_s_sleep(2); if (++sp_ > (1u << 22)) break; } \
                                             __builtin_amdgcn_fence(__ATOMIC_ACQUIRE, "agent"); asm volatile("s_waitcnt vmcnt(0)" ::: "memory"); } __syncthreads(); } while (0)
        if (dec_first) { SAMP_WAIT(); decode_part<1>(F, args); }
        if (late_first) { p0_prologue<1>(F, args); __syncthreads(); }
        gemm_phase<EpiIn, StaticOrder, true, true>(F.lds + RING_OFF, g, S, E);
        if (!late_first) { p0_prologue<1>(F, args); __syncthreads(); }
        if (!dec_first) { SAMP_WAIT(); decode_part<1>(F, args); }
#undef SAMP_WAIT
        SEAM(1);
    }
    if (IN(2)) {
        const bool dfirst = (F.vcu & 1) != 0;
        if (dfirst) decode_part<2>(F, args);
        for (int it = F.vcu; it < 256; it += F.G) scan_item(F, args, it);
        if (!dfirst) decode_part<2>(F, args);
        SEAM(2);
    }
    if (IN(4)) {
        Gemm g{(const bf16_t*)(ws + WS_GR), (const bf16_t*)(ws + WS_WUPR), 2 * MP, 2 * DM, DM}; PairOrder S; S.S0.init(MPROMPT, DM, F.G, (int)blockIdx.x);
        EpiN<0> E0{AH, (bf16_t*)(ws + WS_MB), DM, nullptr, nullptr, nullptr, nullptr, nullptr, nullptr};
        EpiN<1> E1{AR, (bf16_t*)(ws + WS_MB), DM, nullptr, nullptr, nullptr, nullptr, nullptr, nullptr};
        EpiUp E{AR, AH, (bf16_t*)(ws + WS_MB)};
        { Unit u0; S.S0.next(0, u0); head_tables_to_lds(F, ws, u0.pm); }
        const bool sk_first = (F.vcu & 1) != 0;
        if (sk_first) { { FeN<0> fe{E0, nullptr, nullptr, nullptr}; skinny_gemm<DM>(F, SAMP(ws + WS_GG, DM), (const bf16*)(ws + WS_WUPH), DM, fe); }
                        { FeN<1> fe{E1, nullptr, nullptr, nullptr}; skinny_gemm<DM>(F, SAMP(ws + WS_GR, DM), (const bf16*)(ws + WS_WUPR), DM, fe); } }
        gemm_phase<EpiUp, PairOrder, true, true>(F.lds + RING_OFF, g, S, E);
        if (!sk_first) { { FeN<0> fe{E0, nullptr, nullptr, nullptr}; skinny_gemm<DM>(F, SAMP(ws + WS_GG, DM), (const bf16*)(ws + WS_WUPH), DM, fe); }
                         { FeN<1> fe{E1, nullptr, nullptr, nullptr}; skinny_gemm<DM>(F, SAMP(ws + WS_GR, DM), (const bf16*)(ws + WS_WUPR), DM, fe); } }
        SEAM(4);
    }
    if (IN(5)) {
        Gemm g{(const bf16_t*)(ws + WS_MB), (const bf16_t*)(ws + WS_WO), MPROMPT, DM, DM}; StaticOrder S; S.init(MPROMPT, DM, F.G, (int)blockIdx.x);
        EpiN<2> E{nullptr, (bf16_t*)(ws + WS_A5), DM, args.in[0], nullptr, nullptr, nullptr, PS1, nullptr};
        const bool sk_first = (F.vcu & 1) != 0; FeN<2> fe{E, args.in[1], PSS1, nullptr};
        if (sk_first) skinny_gemm<DM>(F, SAMP(ws + WS_MB, DM), (const bf16*)(ws + WS_WO), DM, fe);
        gemm_phase<EpiN<2>, StaticOrder, true, true>(F.lds + RING_OFF, g, S, E);
        if (!sk_first) skinny_gemm<DM>(F, SAMP(ws + WS_MB, DM), (const bf16*)(ws + WS_WO), DM, fe);
        SEAM(5);
    }
    if (IN(6)) {
        Gemm g{(const bf16_t*)(ws + WS_A5), (const bf16_t*)(ws + WS_WFF1), MPROMPT, DFF, DM}; StaticOrder S; S.init(MPROMPT, DFF, F.G, (int)blockIdx.x);
        Unit u0; S.next(0, u0);
        EpiN<3> E{nullptr, (bf16_t*)(ws + WS_H), DFF, nullptr, nullptr, nullptr, nullptr, nullptr, PS1, (rstd_to_lds(F, PS1, u0.pm), 1)};
        const int nfirst = (F.vcu & 3) + ((F.vcu & 3) == 3 ? 1 : 0); FeN<3> fe{E, nullptr, nullptr, PSS1};
        const bool pb_first = (F.vcu & 2) != 0;
        skinny_gemm<DM>(F, SAMP(ws + WS_A5, DM), (const bf16*)(ws + WS_WFF1), DFF, fe, 0, nfirst);
        if (pb_first) p_rows_to_bf16(F, args);
        gemm_phase<EpiN<3>, StaticOrder, true, true>(F.lds + RING_OFF, g, S, E);
        if (!pb_first) p_rows_to_bf16(F, args);
        skinny_gemm<DM>(F, SAMP(ws + WS_A5, DM), (const bf16*)(ws + WS_WFF1), DFF, fe, nfirst);
        SEAM(6);
    }
    if (IN(7)) {
        Gemm g{(const bf16_t*)(ws + WS_H), (const bf16_t*)(ws + WS_WFF2), MPROMPT, DM, DFF}; StaticOrder S; S.init(MPROMPT, DM, F.G, (int)blockIdx.x);
        EpiN<6> E{(const bf16_t*)(ws + WS_A5), (bf16_t*)(ws + WS_A7), DM, nullptr, nullptr, nullptr, nullptr, PS2, nullptr};
        const bool sk_first = (F.vcu & 1) != 0; FeN<6> fe{E, nullptr, PSS2, nullptr};
        if (sk_first) skinny_gemm<DFF>(F, SAMP(ws + WS_H, DFF), (const bf16*)(ws + WS_WFF2), DM, fe);
        gemm_phase<EpiN<6>, StaticOrder, true, true>(F.lds + RING_OFF, g, S, E);
        if (!sk_first) skinny_gemm<DFF>(F, SAMP(ws + WS_H, DFF), (const bf16*)(ws + WS_WFF2), DM, fe);
        SEAM(7);
    }
    if (IN(8)) {
        { Gemm g{(const bf16_t*)(ws + WS_A7), (const bf16_t*)(ws + WS_WGATE), MPROMPT, DM, DM}; StaticOrder S; S.init(MPROMPT, DM, F.G, (int)blockIdx.x);
          Unit u0; S.next(0, u0);
          EpiN<4> E{nullptr, (bf16_t*)(ws + WS_MB), DM, nullptr, nullptr, nullptr, nullptr, nullptr, PS2, (rstd_to_lds(F, PS2, u0.pm), 1)};
          gemm_phase<EpiN<4>, StaticOrder, true, true>(F.lds + RING_OFF, g, S, E);
          FeN<4> fe{E, nullptr, nullptr, PSS2}; skinny_gemm<DM>(F, SAMP(ws + WS_A7, DM), (const bf16*)(ws + WS_WGATE), DM, fe); }
        { Gemm g{(const bf16_t*)(ws + WS_PB), (const bf16_t*)(ws + WS_WPROJ), MPROMPT, DM, DPLE}; StaticOrder S; S.init(MPROMPT, DM, F.G, (int)blockIdx.x);
          EpiN<5> E{(const bf16_t*)(ws + WS_A7), (bf16_t*)(ws + WS_MB), DM, nullptr, nullptr, (float*)(ws + WS_A5), nullptr, PS3, nullptr};
          gemm_phase<EpiN<5>, StaticOrder, true, true>(F.lds + RING_OFF, g, S, E);
          FeN<5> fe{E, nullptr, PSS3, nullptr}; skinny_gemm<DPLE>(F, SAMP(ws + WS_PB, DPLE), (const bf16*)(ws + WS_WPROJ), DM, fe); }
        SEAM(8);
    }
    if (IN(9)) { p9_final(F, args); }
#ifdef GEMM_TAIL
    xcd_barrier(bar);
#if GEMM_TAIL == 5 || GEMM_TAIL == 55
    { Gemm g{(const bf16_t*)(ws + WS_MB), (const bf16_t*)(ws + WS_WO), MPROMPT, DM, DM}; StaticOrder S; S.init(MPROMPT, DM, F.G, (int)blockIdx.x);
      EpiN<2> E{nullptr, (bf16_t*)(ws + WS_A5), DM, args.in[0], nullptr, nullptr, nullptr, PS1, nullptr}; FeN<2> fe{E, args.in[1], PSS1, nullptr};
      gemm_phase<EpiN<2>, StaticOrder, true, true>(F.lds + RING_OFF, g, S, E);
#if GEMM_TAIL == 5
      skinny_gemm<DM>(F, SAMP(ws + WS_MB, DM), (const bf16*)(ws + WS_WO), DM, fe);
#endif
    }
#elif GEMM_TAIL == 7 || GEMM_TAIL == 77
    { Gemm g{(const bf16_t*)(ws + WS_H), (const bf16_t*)(ws + WS_WFF2), MPROMPT, DM, DFF}; StaticOrder S; S.init(MPROMPT, DM, F.G, (int)blockIdx.x);
      EpiN<6> E{(const bf16_t*)(ws + WS_A5), (bf16_t*)(ws + WS_A7), DM, nullptr, nullptr, nullptr, nullptr, PS2, nullptr}; FeN<6> fe{E, nullptr, PSS2, nullptr};
      gemm_phase<EpiN<6>, StaticOrder, true, true>(F.lds + RING_OFF, g, S, E);
#if GEMM_TAIL == 7
      skinny_gemm<DFF>(F, SAMP(ws + WS_H, DFF), (const bf16*)(ws + WS_WFF2), DM, fe);
#endif
    }
#elif GEMM_TAIL == 1
    xcd_barrier(bar);
#endif
#endif
#if PROBE_ON
    STAMP(9);
    if (blockIdx.x == 0 && tid_v == 0) { const unsigned t0_ = (unsigned)rt(); const unsigned dly_ = PW[1]; while ((unsigned)rt() - t0_ < dly_) __builtin_amdgcn_s_sleep(16); }
#endif
#undef IN
#undef SEAM
#undef tid_v
}

extern "C" void kernel_launch(void* const* d_in, const int* in_sizes, int n_in, void* d_out, int out_size, void* d_ws, size_t ws_size, hipStream_t stream) {
    static int grid = 0;
    if (grid == 0) {
        if (n_in != 21 || out_size != (int)OUT_TOTAL || ws_size < WS_END) { fprintf(stderr, "kernel_launch: unexpected problem (n_in %d out %d ws %zu need %zu)\n", n_in, out_size, ws_size, (size_t)WS_END); grid = -1; return; }
        int dev = 0, cus = 0;
        if (hipGetDevice(&dev) != hipSuccess || hipDeviceGetAttribute(&cus, hipDeviceAttributeMultiprocessorCount, dev) != hipSuccess) { grid = -1; return; }
        if (hipFuncSetAttribute((const void*)fwd_kernel, hipFuncAttributeMaxDynamicSharedMemorySize, LDS_BYTES) != hipSuccess) { fprintf(stderr, "kernel_launch: hipFuncSetAttribute failed\n"); grid = -1; return; }
        (void)hipGetLastError();
        if (cus < 256) { fprintf(stderr, "kernel_launch: this kernel needs 256 co-resident workgroups (one per CU); the device has %d CUs\n", cus); grid = -1; return; }
        grid = 256;
    }
    if (grid < 0) return;
    (void)hipMemsetAsync((char*)d_ws + WS_CTL, 0, CTL_ZERO_BYTES, stream);
    Args a{};
    for (int i = 0; i < 21; ++i) a.in[i] = (const float*)d_in[i];
    a.out = (float*)d_out; a.ws = (unsigned char*)d_ws;
#if MK_ONE_LAUNCH
    a.ph_lo = 0; a.ph_hi = NPH; a.use_bar = 1;
    hipLaunchKernelGGL(fwd_kernel, dim3(grid), dim3(NWAVES * 64), LDS_BYTES, stream, a);
#else
    for (int p = 0; p < NPH; ++p) { a.ph_lo = p; a.ph_hi = p + 1; a.use_bar = 0; hipLaunchKernelGGL(fwd_kernel, dim3(grid), dim3(NWAVES * 64), LDS_BYTES, stream, a); }
#endif
}
```

```cpp
#include <hip/hip_runtime.h>
#include <cstdio>
#include <cstdint>
#ifndef PROBE_ON
#define PROBE_ON 0
#endif
#define PROBE_UNIT 800ull
#ifndef PROBE_A
#define PROBE_A 0
#define PROBE_B 1
#define PROBE_C 2
#endif
#ifndef PROBE_E
#define PROBE_E -1
#endif
#ifndef PROBE_SKINNY
#define PROBE_SKINNY 0
#endif
namespace pg8 {
#define PG8_LAS __attribute__((address_space(3)))
typedef unsigned short bf16_t;
typedef short bf16x8 __attribute__((ext_vector_type(8)));
typedef float f32x4 __attribute__((ext_vector_type(4)));
typedef unsigned u32x4 __attribute__((ext_vector_type(4)));
constexpr int BM = 256, BK = 64, HALF = 128, HTB = HALF * BK * 2  , STAGE_BYTES = 8 * HTB, NXCD = 8, WGM = 8;

__host__ __device__ __forceinline__ int lds_byte(int r, int c) { const int st = (r >> 4) * 2 + (c >> 5), rr = r & 15, cc = c & 31, ob = rr * 64 + cc * 2; return st * 1024 + (ob ^ (((ob >> 9) & 1) << 5)); }
__host__ __device__ __forceinline__ void stage_rc(int b, int& R, int& C) { const int st = b / 1024, sb = b % 1024, swz = sb ^ (((sb >> 9) & 1) << 5); R = (st >> 1) * 16 + swz / 64; C = (st & 1) * 32 + (swz % 64) / 2; }
__host__ __device__ __forceinline__ int perm32(int rho) { const int n = rho >> 4, i = rho & 15; return 8 * (i >> 2) + 4 * n + (i & 3); }

struct Unit { int pm, pn; };
struct Gemm { const bf16_t* A; const bf16_t* Bt; int M, N, K; };

struct StaticOrder {
    int nM, nN, nwg, G, c;
    __host__ __device__ void init(int M, int N, int G_, int c_) { nM = M / BM; nN = N / BM; nwg = nM * nN; G = G_; c = c_; }
    __host__ __device__ __forceinline__ bool next(int i, Unit& u) const {
        const long L = (long)i * G + c; if (L >= nwg) return false;
        int wgid = (int)L; { const int q = nwg / NXCD, r = nwg % NXCD, xcd = wgid % NXCD, off = wgid / NXCD; wgid = (xcd < r ? xcd * (q + 1) : r * (q + 1) + (xcd - r) * q) + off; }
        const int nig = WGM * nN, gid = wgid / nig, fm = gid * WGM, gsz = (nM - fm) < WGM ? (nM - fm) : WGM;
        u.pm = fm + ((wgid % nig) % gsz); u.pn = (wgid % nig) / gsz; return true;
    }
    __device__ __forceinline__ void a_ready(const Unit&) const {}
    __device__ __forceinline__ void done(const Unit&) const {}
};

typedef float pg8_f32x2_t __attribute__((ext_vector_type(2))); typedef __bf16 pg8_bf16x2_t __attribute__((ext_vector_type(2)));
__device__ __forceinline__ unsigned cvt_pk_bf16(float lo, float hi) { pg8_f32x2_t v = {lo, hi}; pg8_bf16x2_t b = __builtin_convertvector(v, pg8_bf16x2_t); return __builtin_bit_cast(unsigned, b); }

template <class Epi, class Sched, bool ALIGN_EPI = false, bool SP2 = false>
__device__ __forceinline__ void gemm_phase(PG8_LAS unsigned char* lds, const Gemm g, const Sched& S, const Epi& E) {
    const int tid = threadIdx.x, wid = __builtin_amdgcn_readfirstlane(tid >> 6), lane = tid & 63, wr = wid >> 2, wc = wid & 3, fr = lane & 15, fq = lane >> 4;
    const int K = g.K, nt = K / BK;
    unsigned voffA[2], voffB[2];
#pragma unroll
    for (int i = 0; i < 2; ++i) { int R, C; stage_rc(tid * 16 + i * 8192, R, C); const int Rb = Epi::PERM ? ((R & ~31) + perm32(R & 31)) : R;
        voffA[i] = (unsigned)(R * K + C) * 2u; voffB[i] = (unsigned)(Rb * K + C) * 2u; }
    const size_t kstep = (size_t)(BK * 2);
    const size_t hstep = (size_t)HALF * K * 2;
    const size_t tstep = 2 * hstep;
    const unsigned ldsw = (unsigned)wid * 1024u;
    const int aoff = lds_byte(wr * 64 + fr, fq * 8), boff = lds_byte(wc * 32 + fr, fq * 8);
#define PG8_SA(b, h) (((b) * 2 + (h)) * HTB)
#define PG8_SB(b, h) ((4 + (b) * 2 + (h)) * HTB)
#define PG8_STAGE(bufoff, gbase, voff) do { _Pragma("unroll") for (int _i = 0; _i < 2; ++_i) \
        __builtin_amdgcn_global_load_lds((const unsigned*)((const char*)(gbase) + (voff)[_i]), (PG8_LAS unsigned*)(lds + (bufoff) + ldsw + _i * 8192), 16, 0, 0); } while (0)
#define PG8_LDA(dst, b, h) do { _Pragma("unroll") for (int m = 0; m < 4; ++m) _Pragma("unroll") for (int k = 0; k < 2; ++k) dst[m][k] = *(const PG8_LAS bf16x8*)(lds + PG8_SA(b, h) + aoff + m * 2048 + k * 1024); } while (0)
#define PG8_LDB(dst, b, h) do { _Pragma("unroll") for (int n = 0; n < 2; ++n) _Pragma("unroll") for (int k = 0; k < 2; ++k) dst[n][k] = *(const PG8_LAS bf16x8*)(lds + PG8_SB(b, h) + boff + n * 2048 + k * 1024); } while (0)
#define PG8_MMA(ai, bj, At, Bt) do { __builtin_amdgcn_s_setprio(1); _Pragma("unroll") for (int m = 0; m < 4; ++m) _Pragma("unroll") for (int n = 0; n < 2; ++n) _Pragma("unroll") for (int k = 0; k < 2; ++k) \
        acc[ai][bj][m][n] = __builtin_amdgcn_mfma_f32_16x16x32_bf16(Bt[n][k], At[m][k], acc[ai][bj][m][n], 0, 0, 0); __builtin_amdgcn_s_setprio(0); } while (0)
#define PG8_WAIT_V(n) asm volatile("s_waitcnt vmcnt(" #n ")" ::: "memory")
#define PG8_WAIT_L(n) asm volatile("s_waitcnt lgkmcnt(" #n ")" ::: "memory")
#define PG8_BAR __builtin_amdgcn_s_barrier()
#define PG8_SCHED __builtin_amdgcn_sched_barrier(0)
    Unit cur, nxt; int ui = 0;
    if (!S.next(0, cur)) return;
    f32x4 acc[2][2][4][2];
#pragma unroll
    for (int a = 0; a < 2; ++a)
#pragma unroll
        for (int b = 0; b < 2; ++b)
#pragma unroll
            for (int m = 0; m < 4; ++m)
#pragma unroll
                for (int n = 0; n < 2; ++n) acc[a][b][m][n] = (f32x4){0.f, 0.f, 0.f, 0.f};
    bf16x8 At[4][2], B0[2][2], B1[2][2];
    const char* cA = (const char*)g.A + (size_t)cur.pm * tstep; const char* cB = (const char*)g.Bt + (size_t)cur.pn * tstep;
    S.a_ready(cur);
    if constexpr (SP2) {
        PG8_STAGE(PG8_SB(0, 0), cB, voffB); PG8_STAGE(PG8_SB(0, 1), cB + hstep, voffB); PG8_STAGE(PG8_SA(0, 0), cA, voffA); PG8_STAGE(PG8_SA(0, 1), cA + hstep, voffA);
        if (wr == 1) PG8_BAR;
        PG8_WAIT_V(2); PG8_BAR;
        PG8_STAGE(PG8_SB(1, 0), cB + kstep, voffB); PG8_STAGE(PG8_SA(1, 0), cA + kstep, voffA); PG8_STAGE(PG8_SB(1, 1), cB + hstep + kstep, voffB);
        PG8_WAIT_V(6); PG8_BAR;
    } else {
        PG8_STAGE(PG8_SB(0, 0), cB, voffB); PG8_STAGE(PG8_SA(0, 0), cA, voffA); PG8_STAGE(PG8_SB(0, 1), cB + hstep, voffB); PG8_STAGE(PG8_SA(0, 1), cA + hstep, voffA);
        if (wr == 1) PG8_BAR;
        PG8_WAIT_V(4); PG8_BAR;
        PG8_STAGE(PG8_SB(1, 0), cB + kstep, voffB); PG8_STAGE(PG8_SA(1, 0), cA + kstep, voffA); PG8_STAGE(PG8_SB(1, 1), cB + hstep + kstep, voffB);
        PG8_WAIT_V(6); PG8_BAR;
    }
    for (;;) {
        const bool has_next = S.next(ui + 1, nxt);
        const char* nA = has_next ? (const char*)g.A + (size_t)nxt.pm * tstep : cA; const char* nB = has_next ? (const char*)g.Bt + (size_t)nxt.pn * tstep : cB;
        for (int t = 0; t < nt; t += 2) {
            const bool last = (t == nt - 2);
            const char* a1 = cA + (size_t)(t + 1) * kstep;
            const char* a2 = last ? nA : cA + (size_t)(t + 2) * kstep; const char* b2 = last ? nB : cB + (size_t)(t + 2) * kstep;
            const char* a3 = a2 + kstep; const char* b3 = b2 + kstep;
            if (last && has_next) S.a_ready(nxt);
            if constexpr (SP2) {
            PG8_LDB(B0, 0, 0); PG8_LDB(B1, 0, 1); PG8_SCHED; PG8_LDA(At, 0, 0); PG8_STAGE(PG8_SA(1, 1), a1 + hstep, voffA);
            PG8_WAIT_V(8); PG8_WAIT_L(0); PG8_BAR; PG8_MMA(0, 0, At, B0); PG8_MMA(0, 1, At, B1); PG8_BAR; PG8_SCHED;
            PG8_LDA(At, 0, 1); PG8_STAGE(PG8_SB(0, 0), b2, voffB); PG8_STAGE(PG8_SB(0, 1), b2 + hstep, voffB); PG8_STAGE(PG8_SA(0, 0), a2, voffA);
            PG8_WAIT_V(8); PG8_WAIT_L(0); PG8_BAR; PG8_MMA(1, 0, At, B0); PG8_MMA(1, 1, At, B1); PG8_BAR; PG8_SCHED;
            PG8_LDB(B0, 1, 0); PG8_LDB(B1, 1, 1); PG8_SCHED; PG8_LDA(At, 1, 0); PG8_STAGE(PG8_SA(0, 1), a2 + hstep, voffA);
            PG8_WAIT_V(8); PG8_WAIT_L(0); PG8_BAR; PG8_MMA(0, 0, At, B0); PG8_MMA(0, 1, At, B1); PG8_BAR; PG8_SCHED;
            PG8_LDA(At, 1, 1); PG8_STAGE(PG8_SB(1, 0), b3, voffB); PG8_STAGE(PG8_SB(1, 1), b3 + hstep, voffB); PG8_STAGE(PG8_SA(1, 0), a3, voffA);
            PG8_WAIT_V(8); PG8_WAIT_L(0); PG8_BAR; PG8_MMA(1, 0, At, B0); PG8_MMA(1, 1, At, B1); PG8_BAR; PG8_SCHED;
            E.khook(acc, cur, t, wr, fr);
            } else {
            PG8_LDB(B0, 0, 0); PG8_SCHED; PG8_LDA(At, 0, 0); PG8_STAGE(PG8_SA(1, 1), a1 + hstep, voffA);
            PG8_WAIT_L(8); PG8_BAR; PG8_WAIT_L(0); PG8_MMA(0, 0, At, B0); PG8_BAR; PG8_SCHED;
            PG8_LDB(B1, 0, 1); PG8_STAGE(PG8_SB(0, 0), b2, voffB);
            PG8_BAR; PG8_WAIT_L(0); PG8_MMA(0, 1, At, B1); PG8_BAR;
            PG8_LDA(At, 0, 1); PG8_STAGE(PG8_SA(0, 0), a2, voffA);
            PG8_BAR; PG8_WAIT_L(0); PG8_MMA(1, 0, At, B0); PG8_BAR; PG8_SCHED;
            PG8_STAGE(PG8_SB(0, 1), b2 + hstep, voffB);
            PG8_WAIT_V(6); PG8_BAR; PG8_MMA(1, 1, At, B1); PG8_BAR;
            PG8_LDB(B0, 1, 0); PG8_SCHED; PG8_LDA(At, 1, 0); PG8_STAGE(PG8_SA(0, 1), a2 + hstep, voffA);
            PG8_WAIT_L(8); PG8_BAR; PG8_WAIT_L(0); PG8_MMA(0, 0, At, B0); PG8_BAR; PG8_SCHED;
            PG8_LDB(B1, 1, 1); PG8_STAGE(PG8_SB(1, 0), b3, voffB);
            PG8_BAR; PG8_WAIT_L(0); PG8_MMA(0, 1, At, B1); PG8_BAR;
            PG8_LDA(At, 1, 1); PG8_STAGE(PG8_SA(1, 0), a3, voffA);
            PG8_BAR; PG8_WAIT_L(0); PG8_MMA(1, 0, At, B0); PG8_BAR; PG8_SCHED;
            PG8_STAGE(PG8_SB(1, 1), b3 + hstep, voffB);
            PG8_WAIT_V(6); PG8_BAR; PG8_MMA(1, 1, At, B1); PG8_BAR;
            }
        }
        if constexpr (ALIGN_EPI) { if (wr == 0) PG8_BAR; }
#if PROBE_ON && !PROBE_SKINNY
        const unsigned pe0_ = (unsigned)__builtin_amdgcn_s_memrealtime();
#endif
        if constexpr (!Epi::AFTER_DRAIN) { E(acc, cur, wr, wc, fr, fq); S.done(cur); }
#if PROBE_ON && !PROBE_SKINNY
        if (threadIdx.x == 0) { *(volatile PG8_LAS unsigned*)(lds + 131072 + 320 + 4 * 18) += (unsigned)__builtin_amdgcn_s_memrealtime() - pe0_; }
#endif
        if (!has_next) break;
        if (!E.keep_acc(cur))
#pragma unroll
        for (int a = 0; a < 2; ++a)
#pragma unroll
            for (int b = 0; b < 2; ++b)
#pragma unroll
                for (int m = 0; m < 4; ++m)
#pragma unroll
                    for (int n = 0; n < 2; ++n) acc[a][b][m][n] = (f32x4){0.f, 0.f, 0.f, 0.f};
        cur = nxt; cA = nA; cB = nB; ++ui;
        if constexpr (ALIGN_EPI) { if (wr == 1) PG8_BAR; }
    }
    PG8_WAIT_V(0);
    if constexpr (!ALIGN_EPI) { if (wr == 0) PG8_BAR; }
    PG8_BAR;
    if constexpr (Epi::AFTER_DRAIN) { E.fused(acc, cur, wr, wc, fr, fq, lds, wid, lane); S.done(cur); }
#undef PG8_SA
#undef PG8_SB
#undef PG8_STAGE
#undef PG8_LDA
#undef PG8_LDB
#undef PG8_MMA
#undef PG8_WAIT_V
#undef PG8_WAIT_L
#undef PG8_BAR
#undef PG8_SCHED
}
}


constexpr int DM = 1024, NB = 8, SEQ = 2048, NDEC = 128, MPROMPT = NB * SEQ, MTOT = MPROMPT + NDEC, MP = 16640  ;
constexpr int HR = 4, DKR = 128, DVR = 256, HG = 8, DKG = 128, DVG = 128, DFF = 4096, DPLE = 256, DIN = 9216, CH = 64, NCHUNK = MPROMPT / CH;
constexpr float EPS = 1e-6f;
constexpr size_t OFF_Y = 0, OFF_RETP = (size_t)MTOT * DM, OFF_HGP = OFF_RETP + (size_t)NB * HR * DKR * DVR, OFF_RETS = OFF_HGP + (size_t)NB * HG * DKG * DVG,
                 OFF_HGS = OFF_RETS + (size_t)NDEC * HR * DKR * DVR, OUT_TOTAL = OFF_HGS + (size_t)NDEC * HG * DKG * DVG;
static_assert(OUT_TOTAL == 52559872, "output size");


constexpr int NWAVES = 8;
constexpr int NPH = 10;
#ifndef MK_ONE_LAUNCH
#define MK_ONE_LAUNCH 1
#endif

constexpr size_t MiB = 1u << 20;
constexpr size_t WS_CTL = 0, CTL_ZERO_BYTES = 65536;
constexpr size_t WS_WIN = 1 * MiB;
constexpr size_t WS_WUPR = WS_WIN + (size_t)DIN * DM * 2;
constexpr size_t WS_WUPH = WS_WUPR + (size_t)DM * DM * 2;
constexpr size_t WS_WO = WS_WUPH + (size_t)DM * DM * 2;
constexpr size_t WS_WFF1 = WS_WO + (size_t)DM * DM * 2;
constexpr size_t WS_WFF2 = WS_WFF1 + (size_t)DFF * DM * 2;
constexpr size_t WS_WGATE = WS_WFF2 + (size_t)DFF * DM * 2;
constexpr size_t WS_WPROJ = WS_WGATE + (size_t)DM * DM * 2;
constexpr size_t WS_Z6 = WS_WPROJ + (size_t)DM * DPLE * 2;
constexpr size_t Z_QR = WS_Z6, Z_KR = Z_QR + (size_t)MP * 512 * 2, Z_VR = Z_KR + (size_t)MP * 512 * 2, Z_QG = Z_VR + (size_t)MP * DM * 2, Z_KG = Z_QG + (size_t)MP * DM * 2,
                 Z_VG = Z_KG + (size_t)MP * DM * 2, Z_END = Z_VG + (size_t)MP * DM * 2;
constexpr size_t WS_H = WS_Z6, WS_MB = WS_Z6 + (size_t)MP * DFF * 2;
static_assert(WS_MB == Z_VG, "MB overlays VG exactly");
constexpr size_t WS_GR = Z_END, WS_GG = WS_GR + (size_t)MP * DM * 2, WS_A5 = WS_GR, WS_A7 = WS_GG;
constexpr size_t WS_PB = WS_GG + (size_t)MP * DM * 2;
constexpr size_t WS_CS = WS_PB + (size_t)MP * DPLE * 2;
constexpr size_t WS_GL = WS_CS + (size_t)2049 * 64 * 8;
constexpr size_t WS_FS = WS_GL + (size_t)NCHUNK * DM * 4;
constexpr size_t WS_RSTD0 = WS_FS + (size_t)NDEC * DM * 4;
constexpr size_t WS_LB = WS_RSTD0 + (size_t)MP * 4;
constexpr size_t WS_PS1 = WS_LB + 4096, WS_PS2 = WS_PS1 + (size_t)MP * 64, WS_PS3 = WS_PS2 + (size_t)MP * 64, WS_PSS1 = WS_PS3 + (size_t)MP * 64, WS_PSS2 = WS_PSS1 + (size_t)NDEC * 256, WS_PSS3 = WS_PSS2 + (size_t)NDEC * 256,
                 WS_PSQR = WS_PSS3 + (size_t)NDEC * 256, WS_PSQG = WS_PSQR + (size_t)MP * 128, WS_END = WS_PSQG + (size_t)MP * 128;
static_assert(WS_END <= 307920896, "d_ws map must fit sum(inputs) bytes");
static_assert(WS_WIN % 256 == 0 && WS_Z6 % 256 == 0 && WS_GR % 256 == 0 && WS_PB % 256 == 0 && WS_CS % 16 == 0 && WS_GL % 16 == 0 && WS_PS1 % 16 == 0, "alignment");
constexpr int CW_TMO = 0, CW_SAMP = 8192  , CW_BAR = 4096;

constexpr int RING_OFF = 0, RING_BYTES = 131072;
constexpr int LDSCTL_OFF = RING_BYTES, MISC_OFF = LDSCTL_OFF + 320;
constexpr int LDS_BYTES = 147456;
constexpr int RSTD_LDS_OFF = RING_BYTES + 1024;
constexpr int HT_LDS_OFF = RING_BYTES + 1024;


namespace pg8 {
typedef unsigned u32x2 __attribute__((ext_vector_type(2)));
typedef float f32x2 __attribute__((ext_vector_type(2)));
__device__ __forceinline__ float bf2f(unsigned short b) { return __uint_as_float((unsigned)b << 16); }
__device__ __forceinline__ float bflo(unsigned w) { return __uint_as_float(w << 16); }
__device__ __forceinline__ float bfhi(unsigned w) { return __uint_as_float(w & 0xffff0000u); }
__device__ __forceinline__ float sigmoidf_(float x) { return __builtin_amdgcn_rcpf(1.0f + __expf(-x)); }
__device__ __forceinline__ float siluf_(float x) { return x * __builtin_amdgcn_rcpf(1.0f + __expf(-x)); }
__device__ __forceinline__ u32x2 pack4(f32x4 v) { u32x2 w; w.x = cvt_pk_bf16(v[0], v[1]); w.y = cvt_pk_bf16(v[2], v[3]); return w; }
__device__ __forceinline__ f32x4 unpack4(u32x2 w) { return (f32x4){bflo(w.x), bfhi(w.x), bflo(w.y), bfhi(w.y)}; }

typedef unsigned u32x4 __attribute__((ext_vector_type(4)));
#define DPP_ROW_SHR(x, n) __int_as_float(__builtin_amdgcn_update_dpp(0, __float_as_int(x), 0x110 + (n), 0xf, 0xf, true))
#define DPP_ROW_SHR1(x, n) __int_as_float(__builtin_amdgcn_update_dpp(0x3f800000, __float_as_int(x), 0x110 + (n), 0xf, 0xf, false))
#define DPP_ROW_BCAST15(x) __int_as_float(__builtin_amdgcn_update_dpp(0, __float_as_int(x), 0x15F, 0xf, 0xf, false))
struct EpiIn {
    static constexpr bool PERM = true, AFTER_DRAIN = false;
    const float* rstd0; const float* cs; const float* lb;
    bf16_t *QR, *KR, *VR, *GR, *QG, *KG, *VG, *GG, *AR, *AH; float *GL, *FS; unsigned char* wsb; unsigned char* outb;
    __device__ __forceinline__ bool keep_acc(const Unit&) const { return false; }
    __device__ __forceinline__ void khook(f32x4 (&)[2][2][4][2], const Unit&, int, int, int) const {}
    __device__ __forceinline__ void operator()(const f32x4 (&acc)[2][2][4][2], const Unit& u, int wr, int wc, int fr, int fq) const {
        const int pn = u.pn;
#pragma unroll
        for (int ai = 0; ai < 2; ++ai) {
            const int rbase = u.pm * BM + ai * HALF + wr * 64;
            float rs[4];
#pragma unroll
            for (int m = 0; m < 4; ++m) rs[m] = ((const PG8_LAS float*)(unsigned long)RSTD_LDS_OFF)[ai * HALF + wr * 64 + m * 16 + fr];
            if (pn < 4) {
                const bool isk = pn >= 2; bf16_t* dst = isk ? KR : QR;
#pragma unroll
                for (int bj = 0; bj < 2; ++bj) {
                    const int head = 2 * (pn & 1) + bj;
                    const float lg = __logf(1.0f - exp2f(-5.0f - (float)head));
                    const int j0 = 16 * wc + 4 * fq;
#pragma unroll
                    for (int m = 0; m < 4; ++m) {
                        const int row = rbase + m * 16 + fr; const int pidx = row & (SEQ - 1);
                        const float e = lg * (float)(m * 16 + fr + 1);
                        const float sc = rs[m] * (isk ? 0.08838834764831845f * __expf(-e) : __expf(e));
                        const f32x4 t0 = *(const f32x4*)(cs + ((size_t)pidx * 64 + j0) * 2), t1 = *(const f32x4*)(cs + ((size_t)pidx * 64 + j0 + 2) * 2);
                        const f32x4 v0 = acc[ai][bj][m][0] * sc, v1 = acc[ai][bj][m][1] * sc;
                        u32x2 o1, o2;
                        o1.x = cvt_pk_bf16(v0[0] * t0[0] - v0[1] * t0[1], v0[2] * t0[2] - v0[3] * t0[3]); o1.y = cvt_pk_bf16(v1[0] * t1[0] - v1[1] * t1[1], v1[2] * t1[2] - v1[3] * t1[3]);
                        o2.x = cvt_pk_bf16(v0[0] * t0[1] + v0[1] * t0[0], v0[2] * t0[3] + v0[3] * t0[2]); o2.y = cvt_pk_bf16(v1[0] * t1[1] + v1[1] * t1[0], v1[2] * t1[3] + v1[3] * t1[2]);
                        bf16_t* p = dst + (size_t)row * 512 + head * 128 + j0;
                        *(u32x2*)p = o1; *(u32x2*)(p + 64) = o2;
                    }
                }
            } else if (pn >= 12 && pn < 20) {
                const int head = pn - 12;
#pragma unroll
                for (int bj = 0; bj < 2; ++bj) {
                    const int j0 = 64 * bj + 16 * wc + 4 * fq, c = head * 128 + j0;
                    const f32x4 lbv = *(const f32x4*)(lb + c);
                    float qa[4][4], ka[4][4], ba[4][4];
#pragma unroll
                    for (int q = 0; q < 4; ++q) {
                        const int n = q >> 1, e = q & 1; const float one_m_lb = 1.0f - lbv[q]; float carry = 1.f;
#pragma unroll
                        for (int m = 0; m < 4; ++m) {
                            const float vq = acc[ai][bj][m][n][2 * e] * rs[m], vf = acc[ai][bj][m][n][2 * e + 1] * rs[m];
                            const float kk = one_m_lb * __builtin_amdgcn_rcpf(1.0f + __expf(vf));
                            float x = 1.0f - kk;
                            x *= DPP_ROW_SHR1(x, 1); x *= DPP_ROW_SHR1(x, 2); x *= DPP_ROW_SHR1(x, 4); x *= DPP_ROW_SHR1(x, 8);
                            x *= carry; carry = DPP_ROW_BCAST15(x);
                            qa[m][q] = siluf_(vq); ka[m][q] = kk; ba[m][q] = x;
                        }
                    }
#pragma unroll
                    for (int m = 0; m < 4; ++m) {
                        const int row = rbase + m * 16 + fr;
                        const float e0 = ba[m][0], e1 = ba[m][1], e2 = ba[m][2], e3 = ba[m][3];
                        u32x2 qw, kw;
                        qw.x = cvt_pk_bf16(qa[m][0] * e0, qa[m][1] * e1); qw.y = cvt_pk_bf16(qa[m][2] * e2, qa[m][3] * e3);
                        kw.x = cvt_pk_bf16(ka[m][0] * __builtin_amdgcn_rcpf(e0), ka[m][1] * __builtin_amdgcn_rcpf(e1)); kw.y = cvt_pk_bf16(ka[m][2] * __builtin_amdgcn_rcpf(e2), ka[m][3] * __builtin_amdgcn_rcpf(e3));
                        *(u32x2*)(QG + (size_t)row * DM + c) = qw; *(u32x2*)(KG + (size_t)row * DM + c) = kw;
                        if (m == 3 && fr == 15) *(f32x4*)(GL + (size_t)(row >> 6) * DM + c) = (f32x4){e0, e1, e2, e3};
                    }
                }
            } else if (pn >= 28) {
#pragma unroll
                for (int bj = 0; bj < 2; ++bj) {
                    const int c = (pn - 28) * 128 + 64 * bj + 16 * wc + 4 * fq;
#pragma unroll
                    for (int m = 0; m < 4; ++m) {
                        const int row = rbase + m * 16 + fr; float sr[4], rho[4];
#pragma unroll
                        for (int q = 0; q < 4; ++q) { const int n = q >> 1, e = q & 1;
                            const float er = 1.0f + __expf(fminf(-acc[ai][bj][m][n][2 * e] * rs[m], 40.f)), eg = 1.0f + __expf(fminf(-acc[ai][bj][m][n][2 * e + 1] * rs[m], 40.f));
                            sr[q] = __builtin_amdgcn_rcpf(er); rho[q] = er * __builtin_amdgcn_rcpf(eg); }
                        u32x2 a, h; a.x = cvt_pk_bf16(sr[0], sr[1]); a.y = cvt_pk_bf16(sr[2], sr[3]); h.x = cvt_pk_bf16(rho[0], rho[1]); h.y = cvt_pk_bf16(rho[2], rho[3]);
                        *(u32x2*)(AR + (size_t)row * DM + c) = a; *(u32x2*)(AH + (size_t)row * DM + c) = h;
                    }
                }
            } else {
                const int mode = 0, cbase = (pn & 3) * BM;
                const size_t boff = pn < 8 ? Z_VR : pn < 12 ? WS_GR : pn < 24 ? Z_VG : WS_GG;
                bf16_t* dst = (bf16_t*)(wsb + boff);
#pragma unroll
                for (int m = 0; m < 4; ++m) {
                    const int row = rbase + m * 16 + fr;
#pragma unroll
                    for (int bj = 0; bj < 2; ++bj) {
                        f32x4 v0 = acc[ai][bj][m][0] * rs[m], v1 = acc[ai][bj][m][1] * rs[m];
                        if (mode == 1) { v0[0] = siluf_(v0[0]); v0[1] = siluf_(v0[1]); v0[2] = siluf_(v0[2]); v0[3] = siluf_(v0[3]); v1[0] = siluf_(v1[0]); v1[1] = siluf_(v1[1]); v1[2] = siluf_(v1[2]); v1[3] = siluf_(v1[3]); }
                        else if (mode == 2) { v0[0] = sigmoidf_(v0[0]); v0[1] = sigmoidf_(v0[1]); v0[2] = sigmoidf_(v0[2]); v0[3] = sigmoidf_(v0[3]); v1[0] = sigmoidf_(v1[0]); v1[1] = sigmoidf_(v1[1]); v1[2] = sigmoidf_(v1[2]); v1[3] = sigmoidf_(v1[3]); }
                        const u32x2 a = pack4(v0), b = pack4(v1);
                        *(u32x4*)(dst + (size_t)row * DM + cbase + bj * HALF + wc * 32 + fq * 8) = (u32x4){a.x, a.y, b.x, b.y};
                    }
                }
            }
        }
    }
};

__device__ __forceinline__ void unpack8(u32x4 w, f32x4& a, f32x4& b) { a = (f32x4){bflo(w.x), bfhi(w.x), bflo(w.y), bfhi(w.y)}; b = (f32x4){bflo(w.z), bfhi(w.z), bflo(w.w), bfhi(w.w)}; }
__device__ __forceinline__ u32x4 pack8(f32x4 a, f32x4 b) { const u32x2 x = pack4(a), y = pack4(b); return (u32x4){x.x, x.y, y.x, y.y}; }
__device__ __forceinline__ float sumsq4(f32x4 r) { return (r[0] * r[0] + r[1] * r[1]) + (r[2] * r[2] + r[3] * r[3]); }
template <int MODE> struct EpiN {
    static constexpr bool PERM = true, AFTER_DRAIN = false;
    const bf16_t* gate; bf16_t* out16; int ld16; const float* xp; const float* xs; float* R; const float* g; float* PS; const float* PSin;
    int use_rl;
    __device__ __forceinline__ bool keep_acc(const Unit&) const { return false; }
    __device__ __forceinline__ void khook(f32x4 (&)[2][2][4][2], const Unit&, int, int, int) const {}
    __device__ __forceinline__ void operator()(const f32x4 (&acc)[2][2][4][2], const Unit& u, int wr, int wc, int fr, int fq) const {
#pragma unroll
        for (int ai = 0; ai < 2; ++ai) {
            const int rbase = u.pm * BM + ai * HALF + wr * 64;
#pragma unroll
            for (int m = 0; m < 4; ++m) {
                const int row = rbase + m * 16 + fr;
                float rstd = 1.f;
                if ((MODE == 3 || MODE == 4) && use_rl) rstd = ((const PG8_LAS float*)(unsigned long)RSTD_LDS_OFF)[ai * HALF + wr * 64 + m * 16 + fr];
                else if (MODE == 3 || MODE == 4) {
                    const f32x4* p = (const f32x4*)(PSin + (size_t)row * 16); const f32x4 a = p[0], b = p[1], c = p[2], d = p[3];
                    const float s = ((a[0] + a[1]) + (a[2] + a[3])) + ((b[0] + b[1]) + (b[2] + b[3])) + ((c[0] + c[1]) + (c[2] + c[3])) + ((d[0] + d[1]) + (d[2] + d[3]));
                    rstd = rsqrtf(s * (1.0f / 1024.0f) + EPS);
                }
                float ss = 0.f;
#pragma unroll
                for (int bj = 0; bj < 2; ++bj) {
                    const int col = u.pn * BM + bj * HALF + wc * 32 + fq * 8;
                    const f32x4 a0 = acc[ai][bj][m][0], a1 = acc[ai][bj][m][1];
                    if (MODE == 0) { f32x4 g0, g1; unpack8(*(const u32x4*)(gate + (size_t)row * DM + col), g0, g1); *(u32x4*)(out16 + (size_t)row * ld16 + col) = pack8(g0 * a0, g1 * a1); }
                    else if (MODE == 1) { f32x4 g0, g1, t0, t1; unpack8(*(const u32x4*)(gate + (size_t)row * DM + col), g0, g1); u32x4* o = (u32x4*)(out16 + (size_t)row * ld16 + col); unpack8(*o, t0, t1); *o = pack8(g0 * (t0 + a0), g1 * (t1 + a1)); }
                    else if (MODE == 2) {
                        const float* bp = xp + (size_t)row * DM + col;
                        const f32x4 r0 = __builtin_nontemporal_load((const f32x4*)bp) + a0, r1 = __builtin_nontemporal_load((const f32x4*)(bp + 4)) + a1;
                        ss += sumsq4(r0) + sumsq4(r1);
                        *(u32x4*)(out16 + (size_t)row * ld16 + col) = pack8(r0, r1);
                    }
                    else if (MODE == 6) {
                        f32x4 b0, b1; unpack8(*(const u32x4*)(gate + (size_t)row * DM + col), b0, b1);
                        const f32x4 r0 = b0 + a0, r1 = b1 + a1;
                        ss += sumsq4(r0) + sumsq4(r1);
                        *(u32x4*)(out16 + (size_t)row * ld16 + col) = pack8(r0, r1);
                    }
                    else if (MODE == 3) { f32x4 v0 = a0 * rstd, v1 = a1 * rstd;
                        v0[0] = fmaxf(v0[0], 0.f); v0[1] = fmaxf(v0[1], 0.f); v0[2] = fmaxf(v0[2], 0.f); v0[3] = fmaxf(v0[3], 0.f); v1[0] = fmaxf(v1[0], 0.f); v1[1] = fmaxf(v1[1], 0.f); v1[2] = fmaxf(v1[2], 0.f); v1[3] = fmaxf(v1[3], 0.f);
                        *(u32x4*)(out16 + (size_t)row * ld16 + col) = pack8(v0 * v0, v1 * v1); }
                    else if (MODE == 4) { f32x4 v0 = a0 * rstd, v1 = a1 * rstd;
                        v0[0] = sigmoidf_(v0[0]); v0[1] = sigmoidf_(v0[1]); v0[2] = sigmoidf_(v0[2]); v0[3] = sigmoidf_(v0[3]); v1[0] = sigmoidf_(v1[0]); v1[1] = sigmoidf_(v1[1]); v1[2] = sigmoidf_(v1[2]); v1[3] = sigmoidf_(v1[3]);
                        *(u32x4*)(out16 + (size_t)row * ld16 + col) = pack8(v0, v1); }
                    else if (MODE == 5) { f32x4 t0, t1, b0, b1; unpack8(*(const u32x4*)(out16 + (size_t)row * ld16 + col), t0, t1); unpack8(*(const u32x4*)(gate + (size_t)row * DM + col), b0, b1);
                        const f32x4 r0 = b0 + t0 * a0, r1 = b1 + t1 * a1; *(u32x4*)((bf16_t*)R + (size_t)row * DM + col) = pack8(r0, r1); ss += sumsq4(r0) + sumsq4(r1); }
                }
                if (MODE == 2 || MODE == 5 || MODE == 6) { ss += __shfl_xor(ss, 16); ss += __shfl_xor(ss, 32); if (fq == 0) PS[(size_t)row * 16 + u.pn * 4 + wc] = ss; }
            }
        }
    }
};

__device__ __forceinline__ void samp_in(const EpiIn& E, int row, int pcol, f32x4 v) {
    const float rs = E.rstd0[row]; const int pn = __builtin_amdgcn_readfirstlane(pcol >> 8), p = pcol & 255;
    if (pn < 4) {
        const bool isk = pn >= 2; bf16_t* dst = isk ? E.KR : E.QR; const int head = 2 * (pn & 1) + (p >> 7), j = (p & 127) >> 1;
        const f32x4 t = *(const f32x4*)(E.cs + ((size_t)SEQ * 64 + j) * 2);
        v = v * (rs * (isk ? 0.08838834764831845f : 1.0f));
        const float o1a = v[0] * t[0] - v[1] * t[1], o2a = v[0] * t[1] + v[1] * t[0], o1b = v[2] * t[2] - v[3] * t[3], o2b = v[2] * t[3] + v[3] * t[2];
        bf16_t* q = dst + (size_t)row * 512 + head * 128 + j;
        *(unsigned*)q = cvt_pk_bf16(o1a, o1b); *(unsigned*)(q + 64) = cvt_pk_bf16(o2a, o2b);
    } else if (pn >= 12 && pn < 20) {
        const int c = (pn - 12) * 128 + (p >> 1);
        const float k0 = (1.0f - E.lb[c]) * __builtin_amdgcn_rcpf(1.0f + __expf(v[1] * rs)), k1 = (1.0f - E.lb[c + 1]) * __builtin_amdgcn_rcpf(1.0f + __expf(v[3] * rs));
        *(unsigned*)(E.QG + (size_t)row * DM + c) = cvt_pk_bf16(siluf_(v[0] * rs), siluf_(v[2] * rs));
        *(unsigned*)(E.KG + (size_t)row * DM + c) = cvt_pk_bf16(k0, k1);
        *(f32x2*)(E.FS + (size_t)(row - MPROMPT) * DM + c) = (f32x2){1.0f - k0, 1.0f - k1};
    } else if (pn >= 28) {
        const int c = (pn - 28) * 128 + (p >> 1);
        const float er0 = 1.0f + __expf(fminf(-v[0] * rs, 40.f)), eg0 = 1.0f + __expf(fminf(-v[1] * rs, 40.f)), er1 = 1.0f + __expf(fminf(-v[2] * rs, 40.f)), eg1 = 1.0f + __expf(fminf(-v[3] * rs, 40.f));
        *(unsigned*)(E.AR + (size_t)row * DM + c) = cvt_pk_bf16(__builtin_amdgcn_rcpf(er0), __builtin_amdgcn_rcpf(er1));
        *(unsigned*)(E.AH + (size_t)row * DM + c) = cvt_pk_bf16(er0 * __builtin_amdgcn_rcpf(eg0), er1 * __builtin_amdgcn_rcpf(eg1));
    } else {
        v = v * rs;
        const size_t boff = pn < 8 ? Z_VR : pn < 12 ? WS_GR : pn < 24 ? Z_VG : WS_GG;
        bf16_t* dst = (bf16_t*)(E.wsb + boff);
        *(u32x2*)(dst + (size_t)row * DM + (pn & 3) * BM + p) = pack4(v);
    }
}
template <int MODE> __device__ __forceinline__ void samp_n(const EpiN<MODE>& E, const float* xs, float* PSS, const float* PSSin, int row, int col, f32x4 a) {
    const int rs_ = row - MPROMPT; float rstd = 1.f;
    if (MODE == 3 || MODE == 4) { const f32x4* p = (const f32x4*)(PSSin + (size_t)rs_ * 64); float s = 0.f;
#pragma unroll
        for (int i = 0; i < 16; ++i) { const f32x4 q = p[i]; s += (q[0] + q[1]) + (q[2] + q[3]); }
        rstd = rsqrtf(s * (1.0f / 1024.0f) + EPS); }
    float ss = 0.f;
    if (MODE == 0) { const f32x4 gt = unpack4(*(const u32x2*)(E.gate + (size_t)row * DM + col)); *(u32x2*)(E.out16 + (size_t)row * E.ld16 + col) = pack4(gt * a); }
    else if (MODE == 1) { const f32x4 gt = unpack4(*(const u32x2*)(E.gate + (size_t)row * DM + col)); u32x2* o = (u32x2*)(E.out16 + (size_t)row * E.ld16 + col); const f32x4 t = unpack4(*o); *o = pack4(gt * (t + a)); }
    else if (MODE == 2) { const f32x4 r = *(const f32x4*)(xs + (size_t)rs_ * DM + col) + a; ss = sumsq4(r); *(u32x2*)(E.out16 + (size_t)row * E.ld16 + col) = pack4(r); }
    else if (MODE == 6) { const f32x4 r = unpack4(*(const u32x2*)(E.gate + (size_t)row * DM + col)) + a; ss = sumsq4(r); *(u32x2*)(E.out16 + (size_t)row * E.ld16 + col) = pack4(r); }
    else if (MODE == 3) { f32x4 v = a * rstd; v[0] = fmaxf(v[0], 0.f); v[1] = fmaxf(v[1], 0.f); v[2] = fmaxf(v[2], 0.f); v[3] = fmaxf(v[3], 0.f); *(u32x2*)(E.out16 + (size_t)row * E.ld16 + col) = pack4(v * v); }
    else if (MODE == 4) { f32x4 v = a * rstd; v[0] = sigmoidf_(v[0]); v[1] = sigmoidf_(v[1]); v[2] = sigmoidf_(v[2]); v[3] = sigmoidf_(v[3]); *(u32x2*)(E.out16 + (size_t)row * E.ld16 + col) = pack4(v); }
    else if (MODE == 5) { const f32x4 t = unpack4(*(const u32x2*)(E.out16 + (size_t)row * E.ld16 + col)), b = unpack4(*(const u32x2*)(E.gate + (size_t)row * DM + col));
        const f32x4 r = b + t * a; *(u32x2*)((bf16_t*)E.R + (size_t)row * DM + col) = pack4(r); ss = sumsq4(r); }
    if (MODE == 2 || MODE == 5 || MODE == 6) { ss += __shfl_xor(ss, 16); ss += __shfl_xor(ss, 32); if ((threadIdx.x & 63) < 16) PSS[(size_t)rs_ * 64 + (col >> 4)] = ss; }
}
}

#define GAS __attribute__((address_space(1)))
#define LAS __attribute__((address_space(3)))
typedef unsigned short bf16;
typedef unsigned v4u __attribute__((ext_vector_type(4)));
typedef float f32x4 __attribute__((ext_vector_type(4)));
typedef short bf16x8 __attribute__((ext_vector_type(8)));
typedef GAS unsigned gu32;
typedef GAS unsigned long long gu64;
#define RLX_AGENT __ATOMIC_RELAXED, __HIP_MEMORY_SCOPE_AGENT
#define LDS_WAIT() asm volatile("s_waitcnt lgkmcnt(0)" ::: "memory")
#define VM_WAIT() asm volatile("s_waitcnt vmcnt(0)" ::: "memory")
__device__ __forceinline__ unsigned long long rt() { return __builtin_amdgcn_s_memrealtime(); }
__device__ __forceinline__ unsigned f2bf(float f) { unsigned u = __builtin_bit_cast(unsigned, f); return (u + 0x7fffu + ((u >> 16) & 1u)) >> 16; }
__device__ __forceinline__ unsigned pk2(float lo, float hi) { return f2bf(lo) | (f2bf(hi) << 16); }

#define XB_TMO      128
#define XB_XCNT(j)  (256  + 64 * (j))
#define XB_XSUB(j)  (1280 + 64 * (j))
#define XB_XGEN(j)  (2304 + 64 * (j))
#define XB_TOP      3328
#define XB_TOPGEN   3392
#define XCD_BAR_WORDS 3456
#define XB_SPIN_CAP (1u << 18)

__device__ __forceinline__ unsigned xb_ld(unsigned* p)              { return __hip_atomic_load(p, __ATOMIC_RELAXED, __HIP_MEMORY_SCOPE_AGENT); }
__device__ __forceinline__ unsigned xb_add(unsigned* p, unsigned v) { return __hip_atomic_fetch_add(p, v, __ATOMIC_RELAXED, __HIP_MEMORY_SCOPE_AGENT); }
__device__ __forceinline__ unsigned xb_xcc_id() { return (unsigned)__builtin_amdgcn_s_getreg((3 << 11) | 20) & 0xFu; }
#define XB_SPIN(cond, bar) do { unsigned _sp = 0; while (cond) { __builtin_amdgcn_s_sleep(1); \
    if ((++_sp & 255u) == 0u) { if (xb_ld(&(bar)[XB_TMO])) break; if (_sp > XB_SPIN_CAP) { atomicAdd(&(bar)[XB_TMO], 1u); break; } } } } while (0)

struct XcdBarrier {
    unsigned* bar; unsigned x;
    volatile LAS unsigned* st;
};

__device__ __forceinline__ XcdBarrier xcd_barrier_post(unsigned* bar, volatile LAS unsigned* st) {
    XcdBarrier b; b.bar = bar; b.x = xb_xcc_id(); b.st = st;
    if (threadIdx.x == 0) (void)xb_add(&bar[XB_XCNT(b.x)], 1u);
    return b;
}
__device__ __forceinline__ void xcd_barrier_complete(unsigned* bar, unsigned x, unsigned& nloc, unsigned& nx) {
    const unsigned G = gridDim.x * gridDim.y * gridDim.z;
    unsigned sum, cnt, mine, sp = 0u;
    for (;;) {
        sum = 0u; cnt = 0u; mine = 0u;
#pragma unroll
        for (unsigned j = 0; j < 16; ++j) { const unsigned c = xb_ld(&bar[XB_XCNT(j)]); sum += c; cnt += (c > 0u) ? 1u : 0u; mine = (j == x) ? c : mine; }
        if (sum == G) break;
        __builtin_amdgcn_s_sleep(1);
        if ((++sp & 255u) == 0u) { if (xb_ld(&bar[XB_TMO])) break; if (sp > XB_SPIN_CAP) { atomicAdd(&bar[XB_TMO], 1u); break; } }
    }
    nloc = mine > 0u ? mine : 1u; nx = cnt > 0u ? cnt : 1u;
}

__device__ __forceinline__ void xcd_barrier(const XcdBarrier& b) {
    asm volatile("s_waitcnt vmcnt(0)" ::: "memory");
    __syncthreads();
    if (threadIdx.x == 0) {
        unsigned* bar = b.bar;
        __builtin_amdgcn_s_waitcnt(0);
        unsigned nloc = b.st[0], nx = b.st[1];
        if (nloc == 0u) { xcd_barrier_complete(bar, b.x, nloc, nx); b.st[0] = nloc; b.st[1] = nx; }
        const unsigned old = xb_add(&bar[XB_XSUB(b.x)], 1u);
        const unsigned gen = old / nloc;
        if (old + 1u == (gen + 1u) * nloc) {
            __builtin_amdgcn_fence(__ATOMIC_RELEASE, "agent");
            asm volatile("s_waitcnt vmcnt(0)" ::: "memory");
            const unsigned og = xb_add(&bar[XB_TOP], 1u);
            const unsigned tg = og / nx;
            if (og + 1u == (tg + 1u) * nx) xb_add(&bar[XB_TOPGEN], 1u);
            else XB_SPIN(xb_ld(&bar[XB_TOPGEN]) == tg, bar);
            __builtin_amdgcn_fence(__ATOMIC_ACQUIRE, "agent");
            xb_add(&bar[XB_XGEN(b.x)], 1u);
            asm volatile("s_waitcnt vmcnt(0)" ::: "memory");
        } else {
            XB_SPIN(xb_ld(&bar[XB_XGEN(b.x)]) == gen, bar);
            __builtin_amdgcn_fence(__ATOMIC_ACQUIRE, "agent");
            asm volatile("s_waitcnt vmcnt(0)" ::: "memory");
        }
    }
    __syncthreads();
}


static_assert((CW_BAR + XCD_BAR_WORDS) * 4 <= (int)CTL_ZERO_BYTES, "the per-call memset must cover every barrier word");
struct Args { const float* in[21]; float* out; unsigned char* ws; int ph_lo, ph_hi, use_bar, pad; };
struct Frame {
    LAS unsigned char* lds; volatile LAS unsigned* MISC; gu32* ctl;
    int vcu, G;
};
__device__ __forceinline__ int tid_() { int t = threadIdx.x; asm volatile("" : "+v"(t)); return t; }
#define FTID (tid_())
#define FLANE (tid_() & 63)
#define FWAVE (__builtin_amdgcn_readfirstlane(tid_() >> 6))
__device__ __forceinline__ float wave_sum(float v) {
#pragma unroll
    for (int o = 1; o < 64; o <<= 1) v += __shfl_xor(v, o);
    return v;
}
#define LBAR() do { asm volatile("s_waitcnt lgkmcnt(0)" ::: "memory"); __builtin_amdgcn_s_barrier(); asm volatile("" ::: "memory"); } while (0)
__device__ __forceinline__ float bf2f_(unsigned short b) { return __uint_as_float((unsigned)b << 16); }
__device__ __forceinline__ float bflo_(unsigned w) { return __uint_as_float(w << 16); }
__device__ __forceinline__ float bfhi_(unsigned w) { return __uint_as_float(w & 0xffff0000u); }

__device__ __forceinline__ int win_src_col(int np) {
    const int tile = np >> 8, p = np & 255;
    if (tile < 4) { const int base = (tile >> 1) * 512, head = 2 * (tile & 1) + (p >> 7), pp = p & 127; return base + head * 128 + (pp & 1) * 64 + (pp >> 1); }
    if (tile >= 12 && tile < 20) { const int h = tile - 12; return 3072 + (p & 1) * 1024 + h * 128 + (p >> 1); }
    if (tile >= 28) { const int t = tile - 28; return 7168 + (p & 1) * 1024 + t * 128 + (p >> 1); }
    return np;
}
template <bool MAP> __device__ __forceinline__ void p0_transpose_item(const float* W, int K, int N, bf16* WT, LAS float* scr, int item, int lane, const float* gk = nullptr) {
    const int nblk = N / 32, kb = item / nblk, nb = item % nblk, k0 = 64 * kb, n0 = 32 * nb;
    const int srcc = MAP ? win_src_col(n0 + (lane & 31)) : n0 + (lane & 31);
    float wv[32];
#pragma unroll
    for (int i = 0; i < 32; ++i) wv[i] = __builtin_nontemporal_load(W + (size_t)(k0 + 2 * i + (lane >> 5)) * N + srcc);
#pragma unroll
    for (int i = 0; i < 32; ++i) scr[(2 * i + (lane >> 5)) * 33 + (lane & 31)] = wv[i];
    LDS_WAIT(); asm volatile("" ::: "memory");
    const int c = lane & 7;
    f32x4 ga = (f32x4){1.f, 1.f, 1.f, 1.f}, gb = ga;
    if (gk) { ga = *(const f32x4*)(gk + k0 + 8 * c); gb = *(const f32x4*)(gk + k0 + 8 * c + 4); }
#pragma unroll
    for (int j = 0; j < 4; ++j) { const int n = (lane >> 3) + 8 * j; const LAS float* s = scr + (8 * c) * 33 + n;
        v4u o; o.x = pk2(s[0 * 33] * ga.x, s[1 * 33] * ga.y); o.y = pk2(s[2 * 33] * ga.z, s[3 * 33] * ga.w); o.z = pk2(s[4 * 33] * gb.x, s[5 * 33] * gb.y); o.w = pk2(s[6 * 33] * gb.z, s[7 * 33] * gb.w);
        *(GAS v4u*)(WT + (size_t)(n0 + n) * K + k0 + 8 * c) = o; }
    LDS_WAIT(); asm volatile("" ::: "memory");
}
template <int PART> __device__ __forceinline__ void p0_prologue(Frame& F, const Args& a) {     const int tid_v = tid_(); const int lane_v = tid_v & 63; const int wave_v = __builtin_amdgcn_readfirstlane(tid_v >> 6); (void)lane_v; (void)wave_v;
    unsigned char* ws = a.ws;
    LAS float* scr = (LAS float*)(F.lds + RING_OFF + wave_v * 16384);
    const int gw = F.vcu * NWAVES + wave_v, NGW = F.G * NWAVES;
    constexpr int I_IN = (DM / 64) * (DIN / 32), I_SQ = (DM / 64) * (DM / 32), I_F1 = (DM / 64) * (DFF / 32), I_F2 = (DFF / 64) * (DM / 32), I_PJ = (DPLE / 64) * (DM / 32);
    constexpr int NITEMS = I_IN + 4 * I_SQ + I_F1 + I_F2 + I_PJ;
    for (int it = (PART == 0 ? 0 : I_IN) + gw; it < (PART == 0 ? I_IN : NITEMS); it += NGW) {
        int r = it;
        if (r < I_IN) { p0_transpose_item<true>(a.in[7], DM, DIN, (bf16*)(ws + WS_WIN), scr, r, lane_v, a.in[6]); continue; } r -= I_IN;
        if (r < I_SQ) { p0_transpose_item<false>(a.in[11], DM, DM, (bf16*)(ws + WS_WUPR), scr, r, lane_v); continue; } r -= I_SQ;
        if (r < I_SQ) { p0_transpose_item<false>(a.in[12], DM, DM, (bf16*)(ws + WS_WUPH), scr, r, lane_v); continue; } r -= I_SQ;
        if (r < I_SQ) { p0_transpose_item<false>(a.in[13], DM, DM, (bf16*)(ws + WS_WO), scr, r, lane_v); continue; } r -= I_SQ;
        if (r < I_SQ) { p0_transpose_item<false>(a.in[18], DM, DM, (bf16*)(ws + WS_WGATE), scr, r, lane_v, a.in[17]); continue; } r -= I_SQ;
        if (r < I_F1) { p0_transpose_item<false>(a.in[15], DM, DFF, (bf16*)(ws + WS_WFF1), scr, r, lane_v, a.in[14]); continue; } r -= I_F1;
        if (r < I_F2) { p0_transpose_item<false>(a.in[16], DFF, DM, (bf16*)(ws + WS_WFF2), scr, r, lane_v); continue; } r -= I_F2;
        p0_transpose_item<false>(a.in[19], DPLE, DM, (bf16*)(ws + WS_WPROJ), scr, r, lane_v);
    }
    if (PART == 0) {
    bf16* XB = (bf16*)(a.out + OFF_RETS); float* RSTD0 = (float*)(ws + WS_RSTD0);
    for (int m0 = gw; m0 < MP; m0 += 2 * NGW) {
        f32x4 v[2][4]; bool ok[2], real[2];
#pragma unroll
        for (int u = 0; u < 2; ++u) {
            const int m = m0 + u * NGW; ok[u] = m < MP; real[u] = m < MTOT; const int mc = real[u] ? m : 0;
            const float* xrow = mc < MPROMPT ? a.in[0] + (size_t)mc * DM : a.in[1] + (size_t)(mc - MPROMPT) * DM;
            const GAS f32x4* xr = (const GAS f32x4*)xrow + lane_v;
#pragma unroll
            for (int j = 0; j < 4; ++j) v[u][j] = __builtin_nontemporal_load((const f32x4*)xr + 64 * j);
        }
#pragma unroll
        for (int u = 0; u < 2; ++u) {
            const int m = m0 + u * NGW; if (!ok[u]) continue;
            GAS unsigned long long* o8 = (GAS unsigned long long*)(XB + (size_t)m * DM) + lane_v;
            if (!real[u]) {
#pragma unroll
                for (int j = 0; j < 4; ++j) o8[64 * j] = 0ull;
                if (lane_v == 0) RSTD0[m] = 0.f; continue;
            }
            float s = 0.f;
#pragma unroll
            for (int j = 0; j < 4; ++j) s += (v[u][j].x * v[u][j].x + v[u][j].y * v[u][j].y) + (v[u][j].z * v[u][j].z + v[u][j].w * v[u][j].w);
            s = wave_sum(s);
            if (lane_v == 0) RSTD0[m] = rsqrtf(s * (1.0f / DM) + EPS);
#pragma unroll
            for (int j = 0; j < 4; ++j) o8[64 * j] = (unsigned long long)pk2(v[u][j].x, v[u][j].y) | ((unsigned long long)pk2(v[u][j].z, v[u][j].w) << 32);
        }
    }
    float* CS = (float*)(ws + WS_CS); float* LB = (float*)(ws + WS_LB);
    const int gt = (F.vcu * NWAVES + wave_v) * 64 + lane_v, NGT = NGW * 64;
    for (int i = gt; i < 2049 * 64; i += NGT) {
        const int pi = i >> 6, j = i & 63; const double pos = pi == SEQ ? 16384.0 : (double)pi;
        const double ang = pos * pow(10000.0, -(double)j / 64.0);
        CS[2 * i] = (float)cos(ang); CS[2 * i + 1] = (float)sin(ang);
    }
    for (int i = gt; i < DM; i += NGT) { const float a0 = a.in[10][i], a1 = a.in[10][DM + i]; LB[i] = 1.0f / (1.0f + expf(a1 - a0)); }
    }
}

typedef float f32x16 __attribute__((ext_vector_type(16)));
typedef short v4i16_t __attribute__((ext_vector_type(4)));
typedef unsigned u32x2 __attribute__((ext_vector_type(2)));
typedef float f32x2_t __attribute__((ext_vector_type(2))); typedef __bf16 bf16x2_t __attribute__((ext_vector_type(2)));
__device__ __forceinline__ unsigned cvtpk_s(float lo, float hi) { f32x2_t v = {lo, hi}; bf16x2_t b = __builtin_convertvector(v, bf16x2_t); return __builtin_bit_cast(unsigned, b); }
__device__ __forceinline__ unsigned off_b(unsigned row, unsigned ch) { return 256u * row + 16u * (ch ^ (((row & 3) << 2) | ((row >> 2) & 3))); }
__device__ __forceinline__ bf16x8 rd_row(LAS unsigned char* img, unsigned row, unsigned ks, unsigned h) { return *(const LAS bf16x8*)(img + off_b(row, 2 * ks + h)); }
__device__ __forceinline__ bf16x8 rd_tr(LAS unsigned char* img, unsigned lane, unsigned c, unsigned ks) {
    const unsigned h = lane >> 5, blk = (lane >> 4) & 1, q = (lane & 15) >> 2, p = lane & 3;
    const unsigned a0 = off_b(16 * ks + 8 * h + q, 4 * c + 2 * blk + (p >> 1)) + 8 * (p & 1);
    const unsigned a1 = off_b(16 * ks + 8 * h + 4 + q, 4 * c + 2 * blk + (p >> 1)) + 8 * (p & 1);
    const v4i16_t lo = __builtin_amdgcn_ds_read_tr16_b64_v4i16((LAS v4i16_t*)(img + a0));
    const v4i16_t hi = __builtin_amdgcn_ds_read_tr16_b64_v4i16((LAS v4i16_t*)(img + a1));
    return __builtin_shufflevector(lo, hi, 0, 1, 2, 3, 4, 5, 6, 7);
}
#define MFMA32(a, b, c) __builtin_amdgcn_mfma_f32_32x32x16_bf16((a), (b), (c), 0, 0, 0)
__device__ __forceinline__ void scan_item(Frame& F, const Args& a, int item) { const int tid_v = tid_(); const int lane_v = tid_v & 63; const int wave_v = __builtin_amdgcn_readfirstlane(tid_v >> 6); (void)lane_v; (void)wave_v;
    unsigned char* ws = a.ws;
    asm volatile("" : "+s"(item));
    const bool isg = item >= 128; const int it = isg ? item - 128 : item;
    int b, hd, dv0, ldq; const bf16 *Qp, *Kp; bf16* Vp; float* Sout; const float* GLp = nullptr; float sdec = 1.f;
    if (!isg) { b = it >> 4; hd = (it >> 2) & 3; dv0 = (it & 3) * 64; ldq = 512;
        Qp = (const bf16*)(ws + Z_QR) + hd * 128; Kp = (const bf16*)(ws + Z_KR) + hd * 128; Vp = (bf16*)(ws + Z_VR) + hd * 256 + dv0;
        Sout = a.out + OFF_RETP + ((size_t)(b * HR + hd) * DKR) * DVR + dv0; sdec = __expf(64.0f * __logf(1.0f - exp2f(-5.0f - (float)hd))); }
    else { b = it >> 4; hd = (it >> 1) & 7; dv0 = (it & 1) * 64; ldq = 1024;
        Qp = (const bf16*)(ws + Z_QG) + hd * 128; Kp = (const bf16*)(ws + Z_KG) + hd * 128; Vp = (bf16*)(ws + Z_VG) + hd * 128 + dv0;
        Sout = a.out + OFF_HGP + ((size_t)(b * HG + hd) * DKG) * DVG + dv0; GLp = (const float*)(ws + WS_GL) + hd * 128; }
#if PROBE_ON && PROBE_SKINNY == 2
    const unsigned pt0_ = (unsigned)rt();
#endif
    const int ldo = isg ? DVG : DVR;
    bf16* Gp = (bf16*)(ws + (isg ? WS_GG : WS_GR)) + hd * ldo + dv0;
    float* PSQp = (float*)(ws + (isg ? WS_PSQG : WS_PSQR)) + (isg ? 4 * hd + 2 * (it & 1) : 8 * hd + 2 * (it & 3));
    LAS unsigned char* QI = F.lds; LAS unsigned char* KI = QI + 16384; LAS unsigned char* VI = KI + 16384; LAS unsigned char* PI = VI + 16384; LAS unsigned char* SI = PI + 16384;
    LAS unsigned char* OI = SI + 16384;
    const int tid = tid_v, lane = lane_v, w = wave_v; const unsigned r = lane & 31, h = lane >> 5;
    const int kb = w >> 1, dvb = w & 1;
    for (int i = tid; i < 16384 / 4; i += 512) ((LAS unsigned*)SI)[i] = 0u;
    f32x16 S;
#pragma unroll
    for (int i = 0; i < 16; ++i) S[i] = 0.f;
    const int qr0 = tid >> 4, qc0 = tid & 15, vr0 = tid >> 3, vc0 = tid & 7;
    const size_t rowb = (size_t)b * SEQ;
    v4u aq0, aq1, ak0, ak1, av, agt, ghold;
#define SCAN_LOAD(c, Q0, Q1, K0, K1, V, GT) do { const size_t r0_ = rowb + (size_t)(c) * CH; \
        Q0 = *(const v4u*)(Qp + (r0_ + qr0) * ldq + qc0 * 8); Q1 = *(const v4u*)(Qp + (r0_ + qr0 + 32) * ldq + qc0 * 8); \
        K0 = *(const v4u*)(Kp + (r0_ + qr0) * ldq + qc0 * 8); K1 = *(const v4u*)(Kp + (r0_ + qr0 + 32) * ldq + qc0 * 8); \
        V = *(const v4u*)(Vp + (r0_ + vr0) * DM + vc0 * 8); GT = *(const v4u*)(Gp + (r0_ + vr0) * DM + vc0 * 8); } while (0)
    LAS float* DT = (LAS float*)(OI + 8192); LAS float* GN = DT + 32 * 128;
    { const int c_ = tid >> 4, k8_ = (tid & 15) * 8; f32x4 d0_ = (f32x4){sdec, sdec, sdec, sdec}, d1_ = d0_;
      if (isg) { const float* g_ = GLp + ((size_t)b * (SEQ / CH) + c_) * DM + k8_; d0_ = *(const f32x4*)g_; d1_ = *(const f32x4*)(g_ + 4); }
      *(LAS f32x4*)(DT + c_ * 128 + k8_) = d0_; *(LAS f32x4*)(DT + c_ * 128 + k8_ + 4) = d1_;
      if (tid < 16) *(LAS f32x4*)(GN + tid * 4) = *(const f32x4*)(a.in[isg ? 9 : 8] + hd * ldo + dv0 + tid * 4); }
    SCAN_LOAD(0, aq0, aq1, ak0, ak1, av, agt);
    const unsigned oi_off = (unsigned)(vr0 * 128 + 16 * (vc0 ^ (vr0 & 7)));
#define SCAN_SW(gn_, g_) ((gn_) * (g_) * __builtin_amdgcn_rcpf(1.0f + __expf(-(g_))))
#define SCAN_XSTORE(cc) do { const v4u ov_ = *(const LAS v4u*)(OI + oi_off); v4u xw_; const f32x4 gnA = *(const LAS f32x4*)(GN + vc0 * 8), gnB = *(const LAS f32x4*)(GN + vc0 * 8 + 4); \
        xw_[0] = cvtpk_s(bflo_(ov_[0]) * SCAN_SW(gnA[0], bflo_(ghold[0])), bfhi_(ov_[0]) * SCAN_SW(gnA[1], bfhi_(ghold[0]))); \
        xw_[1] = cvtpk_s(bflo_(ov_[1]) * SCAN_SW(gnA[2], bflo_(ghold[1])), bfhi_(ov_[1]) * SCAN_SW(gnA[3], bfhi_(ghold[1]))); \
        xw_[2] = cvtpk_s(bflo_(ov_[2]) * SCAN_SW(gnB[0], bflo_(ghold[2])), bfhi_(ov_[2]) * SCAN_SW(gnB[1], bfhi_(ghold[2]))); \
        xw_[3] = cvtpk_s(bflo_(ov_[3]) * SCAN_SW(gnB[2], bflo_(ghold[3])), bfhi_(ov_[3]) * SCAN_SW(gnB[3], bfhi_(ghold[3]))); \
        *(v4u*)(Gp + (rowb + (size_t)(cc) * CH + vr0) * DM + vc0 * 8) = xw_; } while (0)
#define SCAN_DS(cc) do { bf16x8 A[4], B[4]; \
        _Pragma("unroll") for (int ks = 0; ks < 4; ++ks) { A[ks] = rd_tr(KI, lane, kb, ks); B[ks] = rd_tr(VI, lane, dvb, ks); } \
        __builtin_amdgcn_sched_barrier(0); \
        f32x16 d; _Pragma("unroll") for (int i = 0; i < 16; ++i) d[i] = 0.f; \
        _Pragma("unroll") for (int ks = 0; ks < 4; ++ks) d = MFMA32(A[ks], B[ks], d); \
        __builtin_amdgcn_sched_barrier(0); \
        const LAS float* dp_ = DT + (cc) * 128 + 32 * kb + 4 * (int)h;     \
        _Pragma("unroll") for (int j = 0; j < 4; ++j) { const f32x4 G = *(const LAS f32x4*)(dp_ + 8 * j); \
            _Pragma("unroll") for (int i = 0; i < 4; ++i) S[4 * j + i] = G[i] * (S[4 * j + i] + d[4 * j + i]); } } while (0)
#define SCAN_BODY(c, Q0, Q1, K0, K1, V, GT) do { \
        LBAR();                                                   \
        if ((c) > 0) SCAN_XSTORE((c) - 1); \
        ghold = GT;                                               \
        *(LAS v4u*)(QI + off_b(qr0, qc0)) = Q0; *(LAS v4u*)(QI + off_b(qr0 + 32, qc0)) = Q1; \
        *(LAS v4u*)(KI + off_b(qr0, qc0)) = K0; *(LAS v4u*)(KI + off_b(qr0 + 32, qc0)) = K1; \
        *(LAS v4u*)(VI + off_b(vr0, vc0)) = V; \
        if ((c) > 0) {                                            \
            _Pragma("unroll") for (int g = 0; g < 4; ++g) { u32x2 wv; wv.x = cvtpk_s(S[4 * g], S[4 * g + 1]); wv.y = cvtpk_s(S[4 * g + 2], S[4 * g + 3]); \
                *(LAS u32x2*)(SI + off_b(32 * dvb + r, 4 * kb + g) + 8 * h) = wv; } \
        } \
        if ((c) + 1 < SEQ / CH) SCAN_LOAD((c) + 1, Q0, Q1, K0, K1, V, GT); \
        LBAR(); \
        f32x16 o; \
        if (w < 4) {                                              \
            const int ob = w >> 1, tb = w & 1; \
            _Pragma("unroll") for (int i = 0; i < 16; ++i) o[i] = 0.f; \
            bf16x8 A[8], B[8]; \
            _Pragma("unroll") for (int ks = 0; ks < 8; ++ks) { A[ks] = rd_row(SI, 32 * ob + r, ks, h); B[ks] = rd_row(QI, 32 * tb + r, ks, h); } \
            __builtin_amdgcn_sched_barrier(0); \
            _Pragma("unroll") for (int ks = 0; ks < 8; ++ks) o = MFMA32(A[ks], B[ks], o); \
        } else if (w == 7) { SCAN_DS(c); } \
        else {                                         \
            const int sb = (w - 4) >> 1, tb = (w - 3) >> 1; \
            bf16x8 A[8], B[8]; \
            _Pragma("unroll") for (int ks = 0; ks < 8; ++ks) { A[ks] = rd_row(KI, 32 * sb + r, ks, h); B[ks] = rd_row(QI, 32 * tb + r, ks, h); } \
            __builtin_amdgcn_sched_barrier(0); \
            f32x16 p; _Pragma("unroll") for (int i = 0; i < 16; ++i) p[i] = 0.f; \
            _Pragma("unroll") for (int ks = 0; ks < 8; ++ks) p = MFMA32(A[ks], B[ks], p); \
            _Pragma("unroll") for (int g = 0; g < 4; ++g) { float v[4]; \
                _Pragma("unroll") for (int i = 0; i < 4; ++i) { const int sl = 8 * g + 4 * (int)h + i; v[i] = (sb != tb || sl <= (int)r) ? p[4 * g + i] : 0.f; } \
                u32x2 wv; wv.x = cvtpk_s(v[0], v[1]); wv.y = cvtpk_s(v[2], v[3]); \
                *(LAS u32x2*)(PI + off_b(32 * tb + r, 4 * sb + g) + 8 * h) = wv; } \
        } \
        LBAR(); \
        if (w < 4) {                                              \
            const int ob = w >> 1, tb = w & 1; \
            {   bf16x8 A[4], B[4]; \
                _Pragma("unroll") for (int ks = 0; ks < 4; ++ks) { A[ks] = rd_tr(VI, lane, ob, ks); B[ks] = rd_row(PI, 32 * tb + r, ks, h); } \
                __builtin_amdgcn_sched_barrier(0); \
                _Pragma("unroll") for (int ks = 0; ks < 4; ++ks) if (ks < 2 || tb == 1) o = MFMA32(A[ks], B[ks], o); } \
            {   float ss_ = 0.f; _Pragma("unroll") for (int i = 0; i < 16; ++i) ss_ += o[i] * o[i]; ss_ += __shfl_xor(ss_, 32);     \
                if (h == 0) PSQp[(rowb + (size_t)(c) * CH + 32 * tb + r) * 32 + ob] = ss_; } \
              \
            _Pragma("unroll") for (int g = 0; g < 4; ++g) { u32x2 wv; wv.x = cvtpk_s(o[4 * g], o[4 * g + 1]); wv.y = cvtpk_s(o[4 * g + 2], o[4 * g + 3]); \
                const unsigned t_ = 32 * tb + r, ch_ = 4 * ob + g; *(LAS u32x2*)(OI + t_ * 128 + 16 * (ch_ ^ (t_ & 7)) + 8 * h) = wv; } \
            SCAN_DS(c); \
        } else if (w < 7) { SCAN_DS(c); } \
    } while (0)
#pragma unroll 1
    for (int c = 0; c < SEQ / CH; c += 2) {
        SCAN_BODY(c, aq0, aq1, ak0, ak1, av, agt);
        SCAN_BODY(c + 1, aq0, aq1, ak0, ak1, av, agt);
    }
#undef SCAN_BODY
#undef SCAN_DS
#undef SCAN_LOAD
    LBAR();
    SCAN_XSTORE(SEQ / CH - 1);
#undef SCAN_XSTORE
#undef SCAN_SW
#pragma unroll
    for (int i = 0; i < 16; ++i) { const int k = 32 * kb + (i & 3) + 8 * (i >> 2) + 4 * (int)h; Sout[(size_t)k * ldo + 32 * dvb + r] = S[i]; }
    __syncthreads();
#if PROBE_ON && PROBE_SKINNY == 2
    if (threadIdx.x == 0) F.MISC[18] += (unsigned)rt() - pt0_;
#endif
}

__device__ __forceinline__ void p_rows_to_bf16(Frame& F, const Args& a) { const int tid_v = tid_(); const int lane_v = tid_v & 63; const int wave_v = __builtin_amdgcn_readfirstlane(tid_v >> 6);
    const int gw = F.vcu * NWAVES + wave_v, NGW = F.G * NWAVES; bf16* PB = (bf16*)(a.ws + WS_PB);
    for (int m0 = gw; m0 < MTOT; m0 += 4 * NGW) {
        f32x4 pv[4];
#pragma unroll
        for (int u = 0; u < 4; ++u) { const int m = m0 + u * NGW, mc = m < MTOT ? m : 0;
            pv[u] = __builtin_nontemporal_load((const f32x4*)(mc < MPROMPT ? a.in[4] + (size_t)mc * DPLE : a.in[5] + (size_t)(mc - MPROMPT) * DPLE) + lane_v); }
#pragma unroll
        for (int u = 0; u < 4; ++u) { const int m = m0 + u * NGW; if (m < MTOT)
            *((GAS unsigned long long*)(PB + (size_t)m * DPLE) + lane_v) = (unsigned long long)pk2(pv[u].x, pv[u].y) | ((unsigned long long)pk2(pv[u].z, pv[u].w) << 32); }
    }
}

template <bool ISG> __device__ __forceinline__ void dec_load(const Args& a, int item, int tid, int lane, int w, f32x4 (&s)[16], float& qkf, unsigned long long& vw) {
    unsigned char* ws = a.ws;
    if (!ISG) { const int n = item >> 2, h = item & 3, row = MPROMPT + n;
        const float* S0 = a.in[2] + ((size_t)(n * HR + h) * DKR) * DVR;
#pragma unroll
        for (int i = 0; i < 16; ++i) s[i] = __builtin_nontemporal_load((const f32x4*)(S0 + ((size_t)(w + 8 * i) * 64 + lane) * 4));
        qkf = tid < 128 ? bf2f_(((const bf16*)(ws + Z_QR))[(size_t)row * 512 + h * 128 + tid]) : tid < 256 ? bf2f_(((const bf16*)(ws + Z_KR))[(size_t)row * 512 + h * 128 + tid - 128]) : 0.f;
        vw = *(const unsigned long long*)((const bf16*)(ws + Z_VR) + (size_t)row * DM + h * 256 + 4 * lane);
    } else { const int n = item >> 3, h = item & 7, row = MPROMPT + n;
        const float* S0 = a.in[3] + ((size_t)(n * HG + h) * DKG) * DVG;
#pragma unroll
        for (int i = 0; i < 8; ++i) s[i] = __builtin_nontemporal_load((const f32x4*)(S0 + ((size_t)(w + 8 * i) * 64 + lane) * 4));
        qkf = tid < 128 ? bf2f_(((const bf16*)(ws + Z_QG))[(size_t)row * DM + h * 128 + tid]) : tid < 256 ? bf2f_(((const bf16*)(ws + Z_KG))[(size_t)row * DM + h * 128 + tid - 128])
            : tid < 384 ? ((const float*)(ws + WS_FS))[(size_t)n * DM + h * 128 + tid - 256] : 0.f;
        vw = *(const unsigned long long*)((const bf16*)(ws + Z_VG) + (size_t)row * DM + h * 128 + 4 * (lane & 31));
    }
}
template <bool ISG> __device__ __forceinline__ void dec_compute(Frame& F, const Args& a, int item, int tid, int lane, int w, const f32x4 (&s)[16], float qkf, unsigned long long vw) {
    unsigned char* ws = a.ws;
    LAS float* qs = (LAS float*)(F.lds); LAS float* red = qs + 384; LAS float* part = red + 8 * 256;
    LAS float* ks = qs + 128; LAS float* fs = qs + 256;
    if (tid < 384) qs[tid] = qkf;
    const f32x4 v = (f32x4){bflo_((unsigned)vw), bfhi_((unsigned)vw), bflo_((unsigned)(vw >> 32)), bfhi_((unsigned)(vw >> 32))};
    LBAR();
    f32x4 o = (f32x4){0.f, 0.f, 0.f, 0.f};
    if (!ISG) { const int n = item >> 2, h = item & 3; const float gam = 1.0f - exp2f(-5.0f - (float)h);
        float* S1 = a.out + OFF_RETS + ((size_t)(n * HR + h) * DKR) * DVR;
#pragma unroll
        for (int i = 0; i < 16; ++i) { const int k = w + 8 * i; const f32x4 sn = s[i] * gam + v * ks[k]; __builtin_nontemporal_store(sn, (f32x4*)(S1 + ((size_t)k * 64 + lane) * 4)); o += sn * qs[k]; }
    } else { const int n = item >> 3, h = item & 7;
        float* S1 = a.out + OFF_HGS + ((size_t)(n * HG + h) * DKG) * DVG;
#pragma unroll
        for (int i = 0; i < 8; ++i) { const int k = 2 * (w + 8 * i) + (lane >> 5); const f32x4 sn = s[i] * fs[k] + v * ks[k]; __builtin_nontemporal_store(sn, (f32x4*)(S1 + ((size_t)(w + 8 * i) * 64 + lane) * 4)); o += sn * qs[k]; }
    }
    *(LAS f32x4*)(red + w * 256 + 4 * lane) = o;
    LBAR();
    constexpr int NDV = ISG ? 128 : 256; float ov = 0.f;
    if (tid < NDV) {
        if (!ISG) {
#pragma unroll
            for (int i = 0; i < 8; ++i) ov += red[i * 256 + tid];
        } else {
#pragma unroll
            for (int i = 0; i < 8; ++i) ov += red[i * 256 + tid] + red[i * 256 + 128 + tid];
        }
        const float ss = wave_sum(ov * ov); if (lane == 0) part[w] = ss;
    }
    LBAR();
    if (tid < NDV) {
        const float rstd = rsqrtf((ISG ? (part[0] + part[1]) : ((part[0] + part[1]) + (part[2] + part[3]))) * (1.0f / NDV) + EPS);
        const int n = ISG ? item >> 3 : item >> 2, h = ISG ? item & 7 : item & 3, row = MPROMPT + n;
        bf16* gp = (bf16*)(ws + (ISG ? WS_GG : WS_GR)) + (size_t)row * DM + h * NDV + tid;
        const float gv_ = bf2f_(*gp); *gp = (bf16)f2bf(ov * rstd * a.in[ISG ? 9 : 8][h * NDV + tid] * (gv_ * __builtin_amdgcn_rcpf(1.0f + __expf(-gv_))));
    }
    LBAR();
}
constexpr int XB_SAMPLES = (int)(((size_t)MP * DM * 2 + (size_t)HR * DKR * DVR * 4 - 1) / ((size_t)HR * DKR * DVR * 4));
template <int PART> __device__ __forceinline__ void decode_part(Frame& F, const Args& a) { const int tid_v = tid_(); const int lane_v = tid_v & 63; const int wave_v = __builtin_amdgcn_readfirstlane(tid_v >> 6);
    const int tid = tid_v, lane = lane_v, w = wave_v, c = F.vcu, G = F.G;
    const bool r1_early = ((c + G) >> 2) >= XB_SAMPLES;
    f32x4 sa[16], sb[16]; float qa, qb; unsigned long long va, vb;
    if (PART == 1) {
        dec_load<true>(a, c, tid, lane, w, sa, qa, va);
        dec_load<true>(a, c + G, tid, lane, w, sb, qb, vb);          dec_compute<true>(F, a, c, tid, lane, w, sa, qa, va);
        dec_load<true>(a, c + 2 * G, tid, lane, w, sa, qa, va);      dec_compute<true>(F, a, c + G, tid, lane, w, sb, qb, vb);
        dec_load<true>(a, c + 3 * G, tid, lane, w, sb, qb, vb);      dec_compute<true>(F, a, c + 2 * G, tid, lane, w, sa, qa, va);
        if (r1_early) dec_load<false>(a, c + G, tid, lane, w, sa, qa, va);
        dec_compute<true>(F, a, c + 3 * G, tid, lane, w, sb, qb, vb);
        if (r1_early) dec_compute<false>(F, a, c + G, tid, lane, w, sa, qa, va);
    } else {
        dec_load<false>(a, c, tid, lane, w, sa, qa, va);
        if (!r1_early) dec_load<false>(a, c + G, tid, lane, w, sb, qb, vb);
        dec_compute<false>(F, a, c, tid, lane, w, sa, qa, va);
        if (!r1_early) dec_compute<false>(F, a, c + G, tid, lane, w, sb, qb, vb);
    }
}

__device__ __forceinline__ void p3_headnorm(Frame& F, const Args& a) { const int tid_v = tid_(); const int lane_v = tid_v & 63; const int wave_v = __builtin_amdgcn_readfirstlane(tid_v >> 6); (void)lane_v; (void)wave_v;
    unsigned char* ws = a.ws; const int gw = F.vcu * NWAVES + wave_v, NGW = F.G * NWAVES, lane = lane_v;
    constexpr int NIT = MPROMPT * 8, U = 4;
    for (int it0 = gw; it0 < NIT; it0 += U * NGW) {
        unsigned long long ow[U], gwd[U]; f32x4 gn[U]; unsigned long long* gp[U]; bool isg[U], ok[U];
#pragma unroll
        for (int u = 0; u < U; ++u) {
            const int it = it0 + u * NGW; ok[u] = it < NIT; const int itc = ok[u] ? it : gw;
            isg[u] = itc >= MPROMPT * 4; const int i2 = isg[u] ? itc - MPROMPT * 4 : itc; const int row = i2 >> 2, q = i2 & 3;
            const size_t off = (size_t)row * DM + q * 256 + 4 * lane;
            ow[u] = __builtin_nontemporal_load((const unsigned long long*)((const bf16*)(ws + (isg[u] ? Z_VG : Z_VR)) + off));
            gp[u] = (unsigned long long*)((bf16*)(ws + (isg[u] ? WS_GG : WS_GR)) + off); gwd[u] = *gp[u];
            gn[u] = *(const f32x4*)(a.in[isg[u] ? 9 : 8] + q * 256 + 4 * lane);
        }
#pragma unroll
        for (int u = 0; u < U; ++u) {
            const f32x4 o = (f32x4){bflo_((unsigned)ow[u]), bfhi_((unsigned)ow[u]), bflo_((unsigned)(ow[u] >> 32)), bfhi_((unsigned)(ow[u] >> 32))};
            f32x4 gt = (f32x4){bflo_((unsigned)gwd[u]), bfhi_((unsigned)gwd[u]), bflo_((unsigned)(gwd[u] >> 32)), bfhi_((unsigned)(gwd[u] >> 32))};
            gt.x *= __builtin_amdgcn_rcpf(1.0f + __expf(-gt.x)); gt.y *= __builtin_amdgcn_rcpf(1.0f + __expf(-gt.y)); gt.z *= __builtin_amdgcn_rcpf(1.0f + __expf(-gt.z)); gt.w *= __builtin_amdgcn_rcpf(1.0f + __expf(-gt.w));
            float ss = (o.x * o.x + o.y * o.y) + (o.z * o.z + o.w * o.w);
#pragma unroll
            for (int d = 1; d < 32; d <<= 1) ss += __shfl_xor(ss, d);
            if (!isg[u]) ss += __shfl_xor(ss, 32);
            const float rstd = rsqrtf(ss * (isg[u] ? 1.0f / DVG : 1.0f / DVR) + EPS);
            const f32x4 x = o * rstd * gn[u] * gt;
            if (ok[u]) *gp[u] = (unsigned long long)pk2(x.x, x.y) | ((unsigned long long)pk2(x.z, x.w) << 32);
        }
    }
}

__device__ __forceinline__ void p9_final(Frame& F, const Args& a) { const int tid_v = tid_(); const int lane_v = tid_v & 63; const int wave_v = __builtin_amdgcn_readfirstlane(tid_v >> 6); (void)lane_v; (void)wave_v;
    const int gw = F.vcu * NWAVES + wave_v, NGW = F.G * NWAVES, lane = lane_v; const float* PS3 = (const float*)(a.ws + WS_PS3); const float* gf = a.in[20];
    for (int m = gw; m < MTOT; m += NGW) {
        const float pv = m < MPROMPT ? (lane < 16 ? PS3[(size_t)m * 16 + lane] : 0.f) : ((const float*)(a.ws + WS_PSS3))[(size_t)(m - MPROMPT) * 64 + lane];
        const float rstd = rsqrtf(wave_sum(pv) * (1.0f / DM) + EPS);
        const v4u* r16 = (const v4u*)((const bf16*)(a.ws + WS_A5) + (size_t)m * DM) + lane;
        float* y = a.out + (size_t)m * DM;
#pragma unroll
        for (int j = 0; j < 2; ++j) { const v4u w = __builtin_nontemporal_load(r16 + 64 * j); const int c0 = 8 * (64 * j + lane); const f32x4 g0 = *(const f32x4*)(gf + c0), g1 = *(const f32x4*)(gf + c0 + 4);
            __builtin_nontemporal_store((f32x4){bflo_(w[0]), bfhi_(w[0]), bflo_(w[1]), bfhi_(w[1])} * rstd * g0, (f32x4*)(y + c0));
            __builtin_nontemporal_store((f32x4){bflo_(w[2]), bfhi_(w[2]), bflo_(w[3]), bfhi_(w[3])} * rstd * g1, (f32x4*)(y + c0 + 4)); }
    }
}

template <int K, class FE> __device__ __forceinline__ void skinny_gemm(Frame& F, const bf16* As, const bf16* Wt, int N, const FE& fe, int it0 = 0, int it1 = 1 << 30) {     const int tid_v = tid_(); const int lane_v = tid_v & 63; const int wave_v = __builtin_amdgcn_readfirstlane(tid_v >> 6); (void)lane_v; (void)wave_v;
    constexpr int KW = K / 4, NKS = KW / 32, CH_KS = NKS < 8 ? NKS : 8, NCH = NKS / CH_KS;
    const int lane = lane_v, fr = lane & 15, fq = lane >> 4, rg = wave_v >> 2, ks = wave_v & 3;
    LAS f32x4* red = (LAS f32x4*)(F.lds);
    const int ntile = 4 * (N / 16);
#if PROBE_ON && PROBE_SKINNY == 1
    const unsigned ps0_ = (unsigned)rt();
#endif
    const int rb = F.vcu & 3;
    const bf16* bp = As + (size_t)(32 * rb + 16 * rg + fr) * K + ks * KW + 8 * fq;
    if constexpr (NCH == 1) {
        bf16x8 act[CH_KS], wa[CH_KS], wb[CH_KS];
#pragma unroll
        for (int i = 0; i < CH_KS; ++i) act[i] = *(const bf16x8*)(bp + i * 32);
        int itn = it0; int tile = F.vcu + itn * F.G; bool have = itn < it1 && tile < ntile;
        if (have) { const bf16* ap = Wt + (size_t)(16 * (tile >> 2) + fr) * K + ks * KW + 8 * fq;
#pragma unroll
            for (int i = 0; i < CH_KS; ++i) wa[i] = *(const bf16x8*)(ap + i * 32); }
        while (have) {
            const int ntile_ = tile + F.G; const bool nhave = (itn + 1) < it1 && ntile_ < ntile;
            if (nhave) { const bf16* ap = Wt + (size_t)(16 * (ntile_ >> 2) + fr) * K + ks * KW + 8 * fq;
#pragma unroll
                for (int i = 0; i < CH_KS; ++i) wb[i] = *(const bf16x8*)(ap + i * 32); }
            f32x4 acc = (f32x4){0.f, 0.f, 0.f, 0.f};
#pragma unroll
            for (int i = 0; i < CH_KS; ++i) acc = __builtin_amdgcn_mfma_f32_16x16x32_bf16(wa[i], act[i], acc, 0, 0, 0);
            red[wave_v * 64 + lane] = acc;
            __syncthreads();
            if (ks == 0) {
                const f32x4 v = (red[(4 * rg + 0) * 64 + lane] + red[(4 * rg + 1) * 64 + lane]) + (red[(4 * rg + 2) * 64 + lane] + red[(4 * rg + 3) * 64 + lane]);
                fe(MPROMPT + 32 * rb + 16 * rg + fr, 16 * (tile >> 2) + 4 * fq, v);
            }
            __syncthreads();
            if (nhave) {
#pragma unroll
                for (int i = 0; i < CH_KS; ++i) wa[i] = wb[i]; }
            ++itn; tile = ntile_; have = nhave;
        }
    } else {
        constexpr int KW8 = K / 8, NS8 = KW8 / 32;
        const bf16* bp0 = As + (size_t)(32 * rb + fr) * K + wave_v * KW8 + 8 * fq; const bf16* bp1 = bp0 + (size_t)16 * K;
        for (int itn = it0; itn < it1; ++itn) {
            const int tile = F.vcu + itn * F.G; if (tile >= ntile) break;
            const int cb = tile >> 2;
            const bf16* ap = Wt + (size_t)(16 * cb + fr) * K + wave_v * KW8 + 8 * fq;
            f32x4 acc0 = (f32x4){0.f, 0.f, 0.f, 0.f}, acc1 = acc0;
            bf16x8 a[2][4], b0[2][4], b1[2][4];
#define SK_LD(s, c) do { _Pragma("unroll") for (int i = 0; i < 4; ++i) { a[s][i] = *(const bf16x8*)(ap + ((c) * 4 + i) * 32); b0[s][i] = *(const bf16x8*)(bp0 + ((c) * 4 + i) * 32); b1[s][i] = *(const bf16x8*)(bp1 + ((c) * 4 + i) * 32); } } while (0)
            SK_LD(0, 0);
#pragma unroll
            for (int c = 0; c < NS8 / 4; ++c) {
                if (c + 1 < NS8 / 4) SK_LD((c + 1) & 1, c + 1);
#pragma unroll
                for (int i = 0; i < 4; ++i) { acc0 = __builtin_amdgcn_mfma_f32_16x16x32_bf16(a[c & 1][i], b0[c & 1][i], acc0, 0, 0, 0); acc1 = __builtin_amdgcn_mfma_f32_16x16x32_bf16(a[c & 1][i], b1[c & 1][i], acc1, 0, 0, 0); }
            }
#undef SK_LD
            red[(wave_v * 2 + 0) * 64 + lane] = acc0; red[(wave_v * 2 + 1) * 64 + lane] = acc1;
            __syncthreads();
            if (wave_v < 2) {
                f32x4 v = red[wave_v * 64 + lane];
#pragma unroll
                for (int s = 1; s < 8; ++s) v += red[(s * 2 + wave_v) * 64 + lane];
                fe(MPROMPT + 32 * rb + 16 * wave_v + fr, 16 * cb + 4 * fq, v);
            }
            __syncthreads();
        }
    }
#if PROBE_ON && PROBE_SKINNY == 1
    if (threadIdx.x == 0) F.MISC[18] += (unsigned)rt() - ps0_;
#endif
}
struct FeIn { pg8::EpiIn E; __device__ __forceinline__ void operator()(int row, int col, f32x4 v) const { pg8::samp_in(E, row, col, v); } };
template <int MODE> struct FeN { pg8::EpiN<MODE> E; const float* xs; float* PSS; const float* PSSin;
    __device__ __forceinline__ void operator()(int row, int col, f32x4 v) const { pg8::samp_n<MODE>(E, xs, PSS, PSSin, row, col, v); } };

struct PairOrder { pg8::StaticOrder S0;
    __device__ __forceinline__ bool next(int i, pg8::Unit& u) const { pg8::Unit t; if (!S0.next(i >> 1, t)) return false; if ((i & 1) == 0) { u.pm = t.pm + MP / 256; u.pn = t.pn + DM / 256; } else u = t; return true; }
    __device__ __forceinline__ void a_ready(const pg8::Unit&) const {}
    __device__ __forceinline__ void done(const pg8::Unit&) const {} };
struct EpiUp { static constexpr bool PERM = true, AFTER_DRAIN = false; const pg8::bf16_t* AR; const pg8::bf16_t* AH; pg8::bf16_t* M;
    __device__ __forceinline__ bool keep_acc(const pg8::Unit& u) const { return u.pn >= DM / 256; }
    __device__ __forceinline__ static const LAS float* tab(int idx) { return (const LAS float*)(unsigned long)HT_LDS_OFF + idx * 256; }
    __device__ __forceinline__ static void scale_rows(f32x4 (&acc)[2][2][4][2], const LAS float* t, int wr, int fr) {
#pragma unroll
        for (int ai = 0; ai < 2; ++ai)
#pragma unroll
            for (int m = 0; m < 4; ++m) { const float f = t[ai * 128 + wr * 64 + m * 16 + fr];
#pragma unroll
                for (int bj = 0; bj < 2; ++bj) { acc[ai][bj][m][0] *= f; acc[ai][bj][m][1] *= f; } }
    }
    __device__ __forceinline__ void khook(f32x4 (&acc)[2][2][4][2], const pg8::Unit& u, int t, int wr, int fr) const {
        if (u.pn >= DM / 256) { const int h = t >> 1; if (h < 7) scale_rows(acc, tab(h), wr, fr); }
        else if (t & 2) { const int h = t >> 2; if (h < 3) scale_rows(acc, tab(9 + h), wr, fr); }
    }
    __device__ __forceinline__ void operator()(f32x4 (&acc)[2][2][4][2], const pg8::Unit& u, int wr, int wc, int fr, int fq) const {
        using namespace pg8;
        const bool first = u.pn >= DM / 256; const int pm = first ? u.pm - MP / 256 : u.pm, pn = first ? u.pn - DM / 256 : u.pn;
#pragma unroll
        for (int ai = 0; ai < 2; ++ai)
#pragma unroll
            for (int m = 0; m < 4; ++m) {
                const int rl = ai * HALF + wr * 64 + m * 16 + fr, row = pm * BM + rl;
                const float rf = first ? tab(7)[rl] * tab(8)[rl] : tab(12)[rl];
#pragma unroll
                for (int bj = 0; bj < 2; ++bj) {
                    const int col = pn * BM + bj * HALF + wc * 32 + fq * 8; const size_t o = (size_t)row * DM + col;
                    if (first) { f32x4 h0, h1; unpack8(*(const u32x4*)(AH + o), h0, h1); acc[ai][bj][m][0] *= h0 * rf; acc[ai][bj][m][1] *= h1 * rf; }
                    else { f32x4 r0, r1; unpack8(*(const u32x4*)(AR + o), r0, r1); *(u32x4*)(M + o) = pack8(r0 * rf * acc[ai][bj][m][0], r1 * rf * acc[ai][bj][m][1]); }
                }
            }
    } };
__device__ __forceinline__ void head_tables_to_lds(Frame& F, const unsigned char* ws, int pm) { const int t = tid_();
    LAS float* T = (LAS float*)(F.lds + HT_LDS_OFF);
    if (t < 256) { const size_t row = (size_t)pm * 256 + t; float sg[8], sr[4];
        const f32x4* pg = (const f32x4*)((const float*)(ws + WS_PSQG) + row * 32); const f32x4* pr = (const f32x4*)((const float*)(ws + WS_PSQR) + row * 32);
#pragma unroll
        for (int h = 0; h < 8; ++h) { const f32x4 v = pg[h]; sg[h] = rsqrtf(((v[0] + v[1]) + (v[2] + v[3])) * (1.0f / DVG) + EPS); }
#pragma unroll
        for (int h = 0; h < 4; ++h) { const f32x4 v = pr[2 * h], w = pr[2 * h + 1]; sr[h] = rsqrtf((((v[0] + v[1]) + (v[2] + v[3])) + ((w[0] + w[1]) + (w[2] + w[3]))) * (1.0f / DVR) + EPS); }
#pragma unroll
        for (int h = 0; h < 7; ++h) T[h * 256 + t] = sg[h] * __builtin_amdgcn_rcpf(sg[h + 1]);
        T[7 * 256 + t] = sg[7]; T[8 * 256 + t] = __builtin_amdgcn_rcpf(sr[0]);
#pragma unroll
        for (int h = 0; h < 3; ++h) T[(9 + h) * 256 + t] = sr[h] * __builtin_amdgcn_rcpf(sr[h + 1]);
        T[12 * 256 + t] = sr[3]; }
    __syncthreads();
}

__device__ __forceinline__ const LAS float* rstd_to_lds(Frame& F, const float* PS, int pm) { const int t = tid_();
    LAS float* rl = (LAS float*)(F.lds + RSTD_LDS_OFF);
    if (t < 256) { const f32x4* p = (const f32x4*)(PS + ((size_t)pm * 256 + t) * 16); const f32x4 a = p[0], b = p[1], c = p[2], e = p[3];
        const float s = ((a[0] + a[1]) + (a[2] + a[3])) + ((b[0] + b[1]) + (b[2] + b[3])) + ((c[0] + c[1]) + (c[2] + c[3])) + ((e[0] + e[1]) + (e[2] + e[3]));
        rl[t] = rsqrtf(s * (1.0f / 1024.0f) + EPS); }
    __syncthreads();
    return rl;
}

__global__ void __launch_bounds__(NWAVES * 64, 2) fwd_kernel(Args args) {
#define tid_v ((int)threadIdx.x)
    extern __shared__ __attribute__((aligned(16))) unsigned char lds[];
    Frame F;
    F.lds = (LAS unsigned char*)lds;
    F.MISC = (volatile LAS unsigned*)(F.lds + MISC_OFF);
        F.G = gridDim.x; { const int bx = blockIdx.x; F.vcu = (F.G % 8 == 0) ? (bx % 8) * (F.G / 8) + bx / 8 : bx; }
    unsigned char* ws = args.ws;
    F.ctl = (gu32*)(ws + WS_CTL);
    for (int u = tid_v; u < (LDS_BYTES - LDSCTL_OFF) / 4; u += NWAVES * 64) ((LAS unsigned*)(F.lds + LDSCTL_OFF))[u] = 0u;
    __syncthreads();
    XcdBarrier bar; bar.bar = (unsigned*)(F.ctl + CW_BAR); bar.x = 0; bar.st = nullptr;
    if (args.use_bar) bar = xcd_barrier_post((unsigned*)(F.ctl + CW_BAR), F.MISC + 8);
    const int lo = args.ph_lo, hi = args.ph_hi;
#define IN(k) (lo <= (k) && (k) < hi)
#if PROBE_ON
    volatile LAS unsigned* PW = F.MISC + 16;
    if (tid_v == 0) { PW[0] = (unsigned)rt(); PW[1] = 0u; PW[2] = 0u; }
#define STAMP(k) do { if (blockIdx.x == 0 && tid_v == 0) { const unsigned t_ = (unsigned)rt(); unsigned q_ = (t_ - PW[0] + (unsigned)PROBE_UNIT / 2) / (unsigned)PROBE_UNIT; if (q_ > 49u) q_ = 49u; \
        if ((k) == PROBE_A) PW[1] += q_ * 400u; else if ((k) == PROBE_B) PW[1] += q_ * 20000u; else if (PROBE_E < 0 && (k) == PROBE_C) PW[1] += q_ * 1000000u; \
        if ((k) == PROBE_E) { unsigned e_ = (PW[2] + (unsigned)PROBE_UNIT / 2) / (unsigned)PROBE_UNIT; if (e_ > 49u) e_ = 49u; PW[1] += e_ * 1000000u; } PW[2] = 0u; PW[0] = t_; } } while (0)
#else
#define STAMP(k) do { } while (0)
#endif
#define SEAM(k) do { if (IN(k) && IN((k) + 1)) xcd_barrier(bar); STAMP(k); } while (0)
    using namespace pg8;
    bf16_t* XB = (bf16_t*)(args.out + OFF_RETS);
    bf16_t* AR = (bf16_t*)(args.out + OFF_Y); bf16_t* AH = AR + (size_t)MTOT * DM;
    float* R = args.out + OFF_Y;
    float* PS1 = (float*)(ws + WS_PS1); float* PS2 = (float*)(ws + WS_PS2); float* PS3 = (float*)(ws + WS_PS3);

    if (IN(0)) { p0_prologue<0>(F, args); SEAM(0); }
    const bf16_t* SROW = nullptr; (void)SROW;
    float* PSS1 = (float*)(ws + WS_PSS1); float* PSS2 = (float*)(ws + WS_PSS2); float* PSS3 = (float*)(ws + WS_PSS3);
#define SAMP(buf, ld) ((const bf16*)(buf) + (size_t)MPROMPT * (ld))
    if (IN(1)) {
        Gemm g{XB, (const bf16_t*)(ws + WS_WIN), MPROMPT, DIN, DM}; StaticOrder S; S.init(MPROMPT, DIN, F.G, (int)blockIdx.x);
        EpiIn E{(const float*)(ws + WS_RSTD0), (const float*)(ws + WS_CS), (const float*)(ws + WS_LB),
                (bf16_t*)(ws + Z_QR), (bf16_t*)(ws + Z_KR), (bf16_t*)(ws + Z_VR), (bf16_t*)(ws + WS_GR), (bf16_t*)(ws + Z_QG), (bf16_t*)(ws + Z_KG), (bf16_t*)(ws + Z_VG), (bf16_t*)(ws + WS_GG),
                AR, AH, (float*)(ws + WS_GL), (float*)(ws + WS_FS), ws, (unsigned char*)args.out};
        { Unit u0; S.next(0, u0); const int t = tid_v; if (t < 256) ((LAS float*)(F.lds + RSTD_LDS_OFF))[t] = ((const float*)(ws + WS_RSTD0))[u0.pm * 256 + t]; __syncthreads(); }
        { FeIn fe{E}; skinny_gemm<DM>(F, SAMP(XB, DM), (const bf16*)(ws + WS_WIN), DIN, fe); }
        asm volatile("s_waitcnt vmcnt(0)" ::: "memory"); __syncthreads();
        if (tid_v == 0) {
            unsigned* sb = (unsigned*)(F.ctl + CW_SAMP); const unsigned nloc = F.MISC[8];
            if (xb_add(&sb[XB_XSUB(bar.x)], 1u) + 1u == nloc) { __builtin_amdgcn_fence(__ATOMIC_RELEASE, "agent"); asm volatile("s_waitcnt vmcnt(0)" ::: "memory"); xb_add(&sb[XB_TOP], 1u); } }
        const bool dec_first = (F.vcu & 1) != 0, late_first = (F.vcu & 2) != 0;
#define SAMP_WAIT() do { if (tid_v == 0) { unsigned sp_ = 0; while (__hip_atomic_load(F.ctl + CW_SAMP + XB_TOP, RLX_AGENT) < F.MISC[9]) { __builtin_amdgcn_s_sleep(2); if (++sp_ > (1u << 22)) break; } \
                                             __builtin_amdgcn_fence(__ATOMIC_ACQUIRE, "agent"); asm volatile("s_waitcnt vmcnt(0)" ::: "memory"); } __syncthreads(); } while (0)
        if (dec_first) { SAMP_WAIT(); decode_part<1>(F, args); }
        if (late_first) { p0_prologue<1>(F, args); __syncthreads(); }
        gemm_phase<EpiIn, StaticOrder, true, true>(F.lds + RING_OFF, g, S, E);
        if (!late_first) { p0_prologue<1>(F, args); __syncthreads(); }
        if (!dec_first) { SAMP_WAIT(); decode_part<1>(F, args); }
#undef SAMP_WAIT
        SEAM(1);
    }
    if (IN(2)) {
        const bool dfirst = (F.vcu & 1) != 0;
        if (dfirst) decode_part<2>(F, args);
        for (int it = F.vcu; it < 256; it += F.G) scan_item(F, args, it);
        if (!dfirst) decode_part<2>(F, args);
        SEAM(2);
    }
    if (IN(4)) {
        Gemm g{(const bf16_t*)(ws + WS_GR), (const bf16_t*)(ws + WS_WUPR), 2 * MP, 2 * DM, DM}; PairOrder S; S.S0.init(MPROMPT, DM, F.G, (int)blockIdx.x);
        EpiN<0> E0{AH, (bf16_t*)(ws + WS_MB), DM, nullptr, nullptr, nullptr, nullptr, nullptr, nullptr};
        EpiN<1> E1{AR, (bf16_t*)(ws + WS_MB), DM, nullptr, nullptr, nullptr, nullptr, nullptr, nullptr};
        EpiUp E{AR, AH, (bf16_t*)(ws + WS_MB)};
        { Unit u0; S.S0.next(0, u0); head_tables_to_lds(F, ws, u0.pm); }
        const bool sk_first = (F.vcu & 1) != 0;
        if (sk_first) { { FeN<0> fe{E0, nullptr, nullptr, nullptr}; skinny_gemm<DM>(F, SAMP(ws + WS_GG, DM), (const bf16*)(ws + WS_WUPH), DM, fe); }
                        { FeN<1> fe{E1, nullptr, nullptr, nullptr}; skinny_gemm<DM>(F, SAMP(ws + WS_GR, DM), (const bf16*)(ws + WS_WUPR), DM, fe); } }
        gemm_phase<EpiUp, PairOrder, true, true>(F.lds + RING_OFF, g, S, E);
        if (!sk_first) { { FeN<0> fe{E0, nullptr, nullptr, nullptr}; skinny_gemm<DM>(F, SAMP(ws + WS_GG, DM), (const bf16*)(ws + WS_WUPH), DM, fe); }
                         { FeN<1> fe{E1, nullptr, nullptr, nullptr}; skinny_gemm<DM>(F, SAMP(ws + WS_GR, DM), (const bf16*)(ws + WS_WUPR), DM, fe); } }
        SEAM(4);
    }
    if (IN(5)) {
        Gemm g{(const bf16_t*)(ws + WS_MB), (const bf16_t*)(ws + WS_WO), MPROMPT, DM, DM}; StaticOrder S; S.init(MPROMPT, DM, F.G, (int)blockIdx.x);
        EpiN<2> E{nullptr, (bf16_t*)(ws + WS_A5), DM, args.in[0], nullptr, nullptr, nullptr, PS1, nullptr};
        const bool sk_first = (F.vcu & 1) != 0; FeN<2> fe{E, args.in[1], PSS1, nullptr};
        if (sk_first) skinny_gemm<DM>(F, SAMP(ws + WS_MB, DM), (const bf16*)(ws + WS_WO), DM, fe);
        gemm_phase<EpiN<2>, StaticOrder, true, true>(F.lds + RING_OFF, g, S, E);
        if (!sk_first) skinny_gemm<DM>(F, SAMP(ws + WS_MB, DM), (const bf16*)(ws + WS_WO), DM, fe);
        SEAM(5);
    }
    if (IN(6)) {
        Gemm g{(const bf16_t*)(ws + WS_A5), (const bf16_t*)(ws + WS_WFF1), MPROMPT, DFF, DM}; StaticOrder S; S.init(MPROMPT, DFF, F.G, (int)blockIdx.x);
        Unit u0; S.next(0, u0);
        EpiN<3> E{nullptr, (bf16_t*)(ws + WS_H), DFF, nullptr, nullptr, nullptr, nullptr, nullptr, PS1, (rstd_to_lds(F, PS1, u0.pm), 1)};
        const int nfirst = (F.vcu & 3) + ((F.vcu & 3) == 3 ? 1 : 0); FeN<3> fe{E, nullptr, nullptr, PSS1};
        const bool pb_first = (F.vcu & 2) != 0;
        skinny_gemm<DM>(F, SAMP(ws + WS_A5, DM), (const bf16*)(ws + WS_WFF1), DFF, fe, 0, nfirst);
        if (pb_first) p_rows_to_bf16(F, args);
        gemm_phase<EpiN<3>, StaticOrder, true, true>(F.lds + RING_OFF, g, S, E);
        if (!pb_first) p_rows_to_bf16(F, args);
        skinny_gemm<DM>(F, SAMP(ws + WS_A5, DM), (const bf16*)(ws + WS_WFF1), DFF, fe, nfirst);
        SEAM(6);
    }
    if (IN(7)) {
        Gemm g{(const bf16_t*)(ws + WS_H), (const bf16_t*)(ws + WS_WFF2), MPROMPT, DM, DFF}; StaticOrder S; S.init(MPROMPT, DM, F.G, (int)blockIdx.x);
        EpiN<6> E{(const bf16_t*)(ws + WS_A5), (bf16_t*)(ws + WS_A7), DM, nullptr, nullptr, nullptr, nullptr, PS2, nullptr};
        const bool sk_first = (F.vcu & 1) != 0; FeN<6> fe{E, nullptr, PSS2, nullptr};
        if (sk_first) skinny_gemm<DFF>(F, SAMP(ws + WS_H, DFF), (const bf16*)(ws + WS_WFF2), DM, fe);
        gemm_phase<EpiN<6>, StaticOrder, true, true>(F.lds + RING_OFF, g, S, E);
        if (!sk_first) skinny_gemm<DFF>(F, SAMP(ws + WS_H, DFF), (const bf16*)(ws + WS_WFF2), DM, fe);
        SEAM(7);
    }
    if (IN(8)) {
        { Gemm g{(const bf16_t*)(ws + WS_A7), (const bf16_t*)(ws + WS_WGATE), MPROMPT, DM, DM}; StaticOrder S; S.init(MPROMPT, DM, F.G, (int)blockIdx.x);
          Unit u0; S.next(0, u0);
          EpiN<4> E{nullptr, (bf16_t*)(ws + WS_MB), DM, nullptr, nullptr, nullptr, nullptr, nullptr, PS2, (rstd_to_lds(F, PS2, u0.pm), 1)};
          gemm_phase<EpiN<4>, StaticOrder, true, true>(F.lds + RING_OFF, g, S, E);
          FeN<4> fe{E, nullptr, nullptr, PSS2}; skinny_gemm<DM>(F, SAMP(ws + WS_A7, DM), (const bf16*)(ws + WS_WGATE), DM, fe); }
        { Gemm g{(const bf16_t*)(ws + WS_PB), (const bf16_t*)(ws + WS_WPROJ), MPROMPT, DM, DPLE}; StaticOrder S; S.init(MPROMPT, DM, F.G, (int)blockIdx.x);
          EpiN<5> E{(const bf16_t*)(ws + WS_A7), (bf16_t*)(ws + WS_MB), DM, nullptr, nullptr, (float*)(ws + WS_A5), nullptr, PS3, nullptr};
          gemm_phase<EpiN<5>, StaticOrder, true, true>(F.lds + RING_OFF, g, S, E);
          FeN<5> fe{E, nullptr, PSS3, nullptr}; skinny_gemm<DPLE>(F, SAMP(ws + WS_PB, DPLE), (const bf16*)(ws + WS_WPROJ), DM, fe); }
        SEAM(8);
    }
    if (IN(9)) { p9_final(F, args); }
#ifdef GEMM_TAIL
    xcd_barrier(bar);
#if GEMM_TAIL == 5 || GEMM_TAIL == 55
    { Gemm g{(const bf16_t*)(ws + WS_MB), (const bf16_t*)(ws + WS_WO), MPROMPT, DM, DM}; StaticOrder S; S.init(MPROMPT, DM, F.G, (int)blockIdx.x);
      EpiN<2> E{nullptr, (bf16_t*)(ws + WS_A5), DM, args.in[0], nullptr, nullptr, nullptr, PS1, nullptr}; FeN<2> fe{E, args.in[1], PSS1, nullptr};
      gemm_phase<EpiN<2>, StaticOrder, true, true>(F.lds + RING_OFF, g, S, E);
#if GEMM_TAIL == 5
      skinny_gemm<DM>(F, SAMP(ws + WS_MB, DM), (const bf16*)(ws + WS_WO), DM, fe);
#endif
    }
#elif GEMM_TAIL == 7 || GEMM_TAIL == 77
    { Gemm g{(const bf16_t*)(ws + WS_H), (const bf16_t*)(ws + WS_WFF2), MPROMPT, DM, DFF}; StaticOrder S; S.init(MPROMPT, DM, F.G, (int)blockIdx.x);
      EpiN<6> E{(const bf16_t*)(ws + WS_A5), (bf16_t*)(ws + WS_A7), DM, nullptr, nullptr, nullptr, nullptr, PS2, nullptr}; FeN<6> fe{E, nullptr, PSS2, nullptr};
      gemm_phase<EpiN<6>, StaticOrder, true, true>(F.lds + RING_OFF, g, S, E);
#if GEMM_TAIL == 7
      skinny_gemm<DFF>(F, SAMP(ws + WS_H, DFF), (const bf16*)(ws + WS_WFF2), DM, fe);
#endif
    }
#elif GEMM_TAIL == 1
    xcd_barrier(bar);
#endif
#endif
#if PROBE_ON
    STAMP(9);
    if (blockIdx.x == 0 && tid_v == 0) { const unsigned t0_ = (unsigned)rt(); const unsigned dly_ = PW[1]; while ((unsigned)rt() - t0_ < dly_) __builtin_amdgcn_s_sleep(16); }
#endif
#undef IN
#undef SEAM
#undef tid_v
}

extern "C" void kernel_launch(void* const* d_in, const int* in_sizes, int n_in, void* d_out, int out_size, void* d_ws, size_t ws_size, hipStream_t stream) {
    static int grid = 0;
    if (grid == 0) {
        if (n_in != 21 || out_size != (int)OUT_TOTAL || ws_size < WS_END) { fprintf(stderr, "kernel_launch: unexpected problem (n_in %d out %d ws %zu need %zu)\n", n_in, out_size, ws_size, (size_t)WS_END); grid = -1; return; }
        int dev = 0, cus = 0;
        if (hipGetDevice(&dev) != hipSuccess || hipDeviceGetAttribute(&cus, hipDeviceAttributeMultiprocessorCount, dev) != hipSuccess) { grid = -1; return; }
        if (hipFuncSetAttribute((const void*)fwd_kernel, hipFuncAttributeMaxDynamicSharedMemorySize, LDS_BYTES) != hipSuccess) { fprintf(stderr, "kernel_launch: hipFuncSetAttribute failed\n"); grid = -1; return; }
        (void)hipGetLastError();
        if (cus < 256) { fprintf(stderr, "kernel_launch: this kernel needs 256 co-resident workgroups (one per CU); the device has %d CUs\n", cus); grid = -1; return; }
        grid = 256;
    }
    if (grid < 0) return;
    (void)hipMemsetAsync((char*)d_ws + WS_CTL, 0, CTL_ZERO_BYTES, stream);
    Args a{};
    for (int i = 0; i < 21; ++i) a.in[i] = (const float*)d_in[i];
    a.out = (float*)d_out; a.ws = (unsigned char*)d_ws;
#if MK_ONE_LAUNCH
    a.ph_lo = 0; a.ph_hi = NPH; a.use_bar = 1;
    hipLaunchKernelGGL(fwd_kernel, dim3(grid), dim3(NWAVES * 64), LDS_BYTES, stream, a);
#else
    for (int p = 0; p < NPH; ++p) { a.ph_lo = p; a.ph_hi = p + 1; a.use_bar = 0; hipLaunchKernelGGL(fwd_kernel, dim3(grid), dim3(NWAVES * 64), LDS_BYTES, stream, a); }
#endif
}
```
